# Optimizing an MI355X kernel written in HIP

```python
import jax, jax.numpy as jnp
from jax import lax
import numpy as np

D_MODEL = 1024
BATCH = 4
SEQ = 4096
DEPTH = 1

CONV_GROUPS = 8
ATTN_HEADS = 8
HEAD_DIM = D_MODEL // (CONV_GROUPS + ATTN_HEADS)
CONV_WIDTH = CONV_GROUPS * HEAD_DIM
ATTN_WIDTH = ATTN_HEADS * HEAD_DIM
MIX_WIDTH = CONV_WIDTH + ATTN_WIDTH
IN_WIDTH = 3 * CONV_WIDTH + 3 * ATTN_WIDTH
CONV_K = 3
MOBA_BLOCK = 256
MOBA_TOPK = 3
ATTN_Q_CHUNK = 64
PEER_HEADS = 8
PEER_NKEYS = 128
PEER_N_EXPERTS = PEER_NKEYS * PEER_NKEYS
PEER_DKEY = 256
PEER_TOPK = 16
PEER_TOKEN_CHUNK = 128
NORM_EPS = 1e-6
NEG_INF = -1e30

kernel_name = "hybrid_conv_moba_peer_block"


def rms_norm(x, gain):
    xf = x.astype(jnp.float32)
    y = xf * lax.rsqrt(jnp.mean(xf * xf, axis=-1, keepdims=True) + NORM_EPS)
    return (y * gain.astype(jnp.float32)).astype(x.dtype)


def group_rms_norm(y, gain):
    shp = y.shape
    yg = y.reshape(shp[:-1] + (shp[-1] // HEAD_DIM, HEAD_DIM)).astype(jnp.float32)
    yg = yg * lax.rsqrt(jnp.mean(yg * yg, axis=-1, keepdims=True) + NORM_EPS)
    return (yg.reshape(shp) * gain.astype(jnp.float32)).astype(y.dtype)


def causal_depthwise_conv(u, w):
    C = u.shape[-1]
    rhs = w[:, None, :].astype(u.dtype)
    return lax.conv_general_dilated(u, rhs, window_strides=(1,), padding=[(CONV_K - 1, 0)],
                                    dimension_numbers=("NWC", "WIO", "NWC"),
                                    feature_group_count=C)


def gather_blocks(blocks, idx):
    return jax.vmap(jax.vmap(lambda t, i: t[i]))(blocks, idx)


def moba_attention(q, k, v):
    B, S, H, dh = q.shape
    nb = -(-S // MOBA_BLOCK)
    pad = nb * MOBA_BLOCK - S
    scale = dh ** -0.5
    qh = q.transpose(0, 2, 1, 3)
    kh = jnp.pad(k.transpose(0, 2, 1, 3), ((0, 0), (0, 0), (0, pad), (0, 0)))
    vh = jnp.pad(v.transpose(0, 2, 1, 3), ((0, 0), (0, 0), (0, pad), (0, 0)))
    kb = kh.reshape(B, H, nb, MOBA_BLOCK, dh)
    vb = vh.reshape(B, H, nb, MOBA_BLOCK, dh)
    qblk = jnp.arange(S) // MOBA_BLOCK
    n_sel = min(MOBA_TOPK, nb - 1)
    nc = S // ATTN_Q_CHUNK
    q_c = qh.reshape(B, H, nc, ATTN_Q_CHUNK, dh).transpose(2, 0, 1, 3, 4)
    xs = (jnp.arange(nc), q_c)
    if n_sel > 0:
        kmean = jnp.mean(kb.astype(jnp.float32), axis=3)
        gate = jnp.einsum("bhsd,bhnd->bhsn", qh.astype(jnp.float32), kmean)
        past = jnp.arange(nb)[None, :] < qblk[:, None]
        gate = jnp.where(past, gate, NEG_INF)
        _, sel = lax.top_k(gate, n_sel)
        valid = sel < qblk[:, None]
        sel_c = sel.reshape(B, H, nc, ATTN_Q_CHUNK, n_sel).transpose(2, 0, 1, 3, 4)
        valid_c = valid.reshape(B, H, nc, ATTN_Q_CHUNK, n_sel).transpose(2, 0, 1, 3, 4)
        xs = xs + (sel_c, valid_c)

    def chunk(args):
        ci, qc = args[0], args[1]
        q0 = ci * ATTN_Q_CHUNK
        blk = q0 // MOBA_BLOCK
        k_own = lax.dynamic_index_in_dim(kb, blk, axis=2, keepdims=False)
        v_own = lax.dynamic_index_in_dim(vb, blk, axis=2, keepdims=False)
        qpos = q0 + jnp.arange(ATTN_Q_CHUNK)
        kpos = blk * MOBA_BLOCK + jnp.arange(MOBA_BLOCK)
        own_mask = kpos[None, :] <= qpos[:, None]
        s_own = jnp.einsum("bhqd,bhkd->bhqk", qc, k_own,
                           preferred_element_type=jnp.float32) * scale
        s_own = jnp.where(own_mask, s_own, NEG_INF)
        if n_sel == 0:
            p_own = jax.nn.softmax(s_own, axis=-1).astype(v_own.dtype)
            return jnp.einsum("bhqk,bhkd->bhqd", p_own, v_own)
        selc, validc = args[2], args[3]
        k_sel = gather_blocks(kb, selc)
        v_sel = gather_blocks(vb, selc)
        s_sel = jnp.einsum("bhqd,bhqnkd->bhqnk", qc, k_sel,
                           preferred_element_type=jnp.float32) * scale
        s_sel = jnp.where(validc[..., None], s_sel, NEG_INF)
        n_past = n_sel * MOBA_BLOCK
        s_all = jnp.concatenate([s_sel.reshape(s_sel.shape[:3] + (n_past,)), s_own], axis=-1)
        p = jax.nn.softmax(s_all, axis=-1).astype(v_own.dtype)
        p_sel = p[..., :n_past].reshape(s_sel.shape)
        p_own = p[..., n_past:]
        return (jnp.einsum("bhqnk,bhqnkd->bhqd", p_sel, v_sel)
                + jnp.einsum("bhqk,bhkd->bhqd", p_own, v_own))

    out = lax.map(chunk, xs)
    return out.transpose(1, 0, 3, 2, 4).reshape(B, S, H * dh)


def hybrid_mixer(h, w_in, conv_w, group_gain, w_out):
    B, S, _ = h.shape
    p = h @ w_in
    cuts = [CONV_WIDTH, 2 * CONV_WIDTH, 3 * CONV_WIDTH,
            3 * CONV_WIDTH + ATTN_WIDTH, 3 * CONV_WIDTH + 2 * ATTN_WIDTH]
    gb, gc, hx, q, k, v = jnp.split(p, cuts, axis=-1)
    y_conv = gb * causal_depthwise_conv(gc * hx, conv_w)
    shp = (B, S, ATTN_HEADS, HEAD_DIM)
    y_attn = moba_attention(q.reshape(shp), k.reshape(shp), v.reshape(shp))
    y = group_rms_norm(jnp.concatenate([y_conv, y_attn], axis=-1), group_gain)
    return y @ w_out


def peer_ffn(h, w_pq, sub_keys, u, v):
    B, S, D = h.shape
    T = B * S
    ht = h.reshape(T, D)
    q = (ht @ w_pq).reshape(T, PEER_HEADS, 2, PEER_DKEY // 2)
    s = jnp.einsum("thpd,hpnd->thpn", q, sub_keys,
                   preferred_element_type=jnp.float32)
    s1, i1 = lax.top_k(s[:, :, 0], PEER_TOPK)
    s2, i2 = lax.top_k(s[:, :, 1], PEER_TOPK)
    cand_s = (s1[..., :, None] + s2[..., None, :]).reshape(T, PEER_HEADS, PEER_TOPK * PEER_TOPK)
    cand_i = (i1[..., :, None] * PEER_NKEYS + i2[..., None, :]).reshape(T, PEER_HEADS, PEER_TOPK * PEER_TOPK)
    top_s, pos = lax.top_k(cand_s, PEER_TOPK)
    eidx = jnp.take_along_axis(cand_i, pos, axis=-1)
    g = jax.nn.softmax(top_s, axis=-1)
    nc = T // PEER_TOKEN_CHUNK

    def chunk(args):
        xc, ec, gcw = args
        a = jnp.einsum("td,thkd->thk", xc, u[ec])
        w = (gcw * jax.nn.gelu(a.astype(jnp.float32))).astype(xc.dtype)
        return jnp.einsum("thk,thkd->td", w, v[ec])

    y = lax.map(chunk, (ht.reshape(nc, PEER_TOKEN_CHUNK, D),
                        eidx.reshape(nc, PEER_TOKEN_CHUNK, PEER_HEADS, PEER_TOPK),
                        g.reshape(nc, PEER_TOKEN_CHUNK, PEER_HEADS, PEER_TOPK)))
    return y.reshape(B, S, D)


def setup_inputs(seed: int = 0) -> dict:
    key = jax.random.key(seed)
    ks = jax.random.split(key, 16)
    D = D_MODEL

    def nrm(k, shape, scale):
        return jax.random.normal(k, shape, jnp.float32) * scale

    return {
        "x": nrm(ks[0], (BATCH, SEQ, D), 1.0),
        "c": nrm(ks[1], (BATCH, D), 1.0),
        "ada_w": nrm(ks[2], (DEPTH, D, 6 * D), 0.5 * D ** -0.5),
        "ada_b": nrm(ks[3], (DEPTH, 6 * D), 0.02),
        "mix_pre_gain": 1.0 + nrm(ks[4], (DEPTH, D), 0.02),
        "mix_post_gain": 1.0 + nrm(ks[5], (DEPTH, D), 0.02),
        "w_in": nrm(ks[6], (DEPTH, D, IN_WIDTH), D ** -0.5),
        "conv_w": nrm(ks[7], (DEPTH, CONV_K, CONV_WIDTH), CONV_K ** -0.5),
        "group_gain": 1.0 + nrm(ks[8], (DEPTH, MIX_WIDTH), 0.02),
        "w_out": nrm(ks[9], (DEPTH, MIX_WIDTH, D), MIX_WIDTH ** -0.5),
        "ffn_pre_gain": 1.0 + nrm(ks[10], (DEPTH, D), 0.02),
        "ffn_post_gain": 1.0 + nrm(ks[11], (DEPTH, D), 0.02),
        "peer_wq": nrm(ks[12], (DEPTH, D, PEER_HEADS * PEER_DKEY), D ** -0.5),
        "peer_keys": nrm(ks[13], (DEPTH, PEER_HEADS, 2, PEER_NKEYS, PEER_DKEY // 2), (PEER_DKEY // 2) ** -0.5),
        "peer_u": nrm(ks[14], (DEPTH, PEER_N_EXPERTS, D), D ** -0.5),
        "peer_v": nrm(ks[15], (DEPTH, PEER_N_EXPERTS, D), D ** -0.5),
    }


def reference(x, c, ada_w, ada_b, mix_pre_gain, mix_post_gain, w_in, conv_w, group_gain, w_out,
              ffn_pre_gain, ffn_post_gain, peer_wq, peer_keys, peer_u, peer_v):
    for l in range(DEPTH):
        mod = (jax.nn.silu(c) @ ada_w[l] + ada_b[l])[:, None, :]
        sh1, sc1, g1, sh2, sc2, g2 = jnp.split(mod, 6, axis=-1)
        h = rms_norm(x, mix_pre_gain[l]) * (1.0 + sc1) + sh1
        y = hybrid_mixer(h, w_in[l], conv_w[l], group_gain[l], w_out[l])
        x = x + g1 * rms_norm(y, mix_post_gain[l])
        h = rms_norm(x, ffn_pre_gain[l]) * (1.0 + sc2) + sh2
        y = peer_ffn(h, peer_wq[l], peer_keys[l], peer_u[l], peer_v[l])
        x = x + g2 * rms_norm(y, ffn_post_gain[l])
    return x
```

```cpp
#include <hip/hip_runtime.h>
#include <cstdio>
#include <cstdint>
namespace pg8 {
#define PG8_LAS __attribute__((address_space(3)))
typedef unsigned short bf16_t;
typedef short bf16x8 __attribute__((ext_vector_type(8)));
typedef float f32x4 __attribute__((ext_vector_type(4)));
typedef unsigned u32x4 __attribute__((ext_vector_type(4)));
constexpr int BM = 256, BK = 64, HALF = 128, HTB = HALF * BK * 2  , STAGE_BYTES = 8 * HTB, NXCD = 8, WGM = 8;

__host__ __device__ __forceinline__ int lds_byte(int r, int c) { const int st = (r >> 4) * 2 + (c >> 5), rr = r & 15, cc = c & 31, ob = rr * 64 + cc * 2; return st * 1024 + (ob ^ (((ob >> 9) & 1) << 5)); }
__host__ __device__ __forceinline__ void stage_rc(int b, int& R, int& C) { const int st = b / 1024, sb = b % 1024, swz = sb ^ (((sb >> 9) & 1) << 5); R = (st >> 1) * 16 + swz / 64; C = (st & 1) * 32 + (swz % 64) / 2; }
__host__ __device__ __forceinline__ int perm32(int rho) { const int n = rho >> 4, i = rho & 15; return 8 * (i >> 2) + 4 * n + (i & 3); }

struct Unit { int pm, pn; };
struct Gemm { const bf16_t* A; const bf16_t* Bt; int M, N, K; };

struct StaticOrder {
    int nM, nN, nwg, G, c;
    __host__ __device__ void init(int M, int N, int G_, int c_) { nM = M / BM; nN = N / BM; nwg = nM * nN; G = G_; c = c_; }
    __host__ __device__ bool next(int i, Unit& u) const {
        const long L = (long)i * G + c; if (L >= nwg) return false;
        int wgid = (int)L; { const int q = nwg / NXCD, r = nwg % NXCD, xcd = wgid % NXCD, off = wgid / NXCD; wgid = (xcd < r ? xcd * (q + 1) : r * (q + 1) + (xcd - r) * q) + off; }
        const int nig = WGM * nN, gid = wgid / nig, fm = gid * WGM, gsz = (nM - fm) < WGM ? (nM - fm) : WGM;
        u.pm = fm + ((wgid % nig) % gsz); u.pn = (wgid % nig) / gsz; return true;
    }
    __device__ __forceinline__ void a_ready(const Unit&) const {}
    __device__ __forceinline__ void done(const Unit&) const {}
};


__device__ __forceinline__ unsigned cvt_pk_bf16(float lo, float hi) { unsigned r; asm volatile("v_cvt_pk_bf16_f32 %0, %1, %2" : "=v"(r) : "v"(lo), "v"(hi)); return r; }
struct EpiBf16 {
    static constexpr bool PERM = true, AFTER_DRAIN = false;
    bf16_t* O; int ldc; int sc_lo, sc_hi; float scv;
    __device__ __forceinline__ void operator()(const f32x4 (&acc)[2][2][4][2], const Unit& u, int wr, int wc, int fr, int fq) const {
        const int row0 = u.pm * BM + wr * 64 + fr; const int colt = u.pn * BM;
        const float sc = (u.pn >= sc_lo && u.pn < sc_hi) ? scv : 1.f;
        const int col0 = colt + wc * 32 + 8 * fq;
#pragma unroll
        for (int ai = 0; ai < 2; ++ai)
#pragma unroll
            for (int m = 0; m < 4; ++m) { bf16_t* rowp = O + (size_t)(row0 + ai * HALF + m * 16) * ldc + col0;
#pragma unroll
                for (int bj = 0; bj < 2; ++bj) { f32x4 v0 = acc[ai][bj][m][0] * sc, v1 = acc[ai][bj][m][1] * sc;
                    u32x4 w; w.x = cvt_pk_bf16(v0[0], v0[1]); w.y = cvt_pk_bf16(v0[2], v0[3]); w.z = cvt_pk_bf16(v1[0], v1[1]); w.w = cvt_pk_bf16(v1[2], v1[3]);
                    *(u32x4*)(rowp + bj * HALF) = w; } }
    }
};

template <class Epi, class Sched, bool ALIGN_EPI = false, bool SP2 = false>
__device__ __forceinline__ void gemm_phase(PG8_LAS unsigned char* lds, const Gemm g, const Sched& S, const Epi& E) {
    const int tid = threadIdx.x, wid = __builtin_amdgcn_readfirstlane(tid >> 6), lane = tid & 63, wr = wid >> 2, wc = wid & 3, fr = lane & 15, fq = lane >> 4;
    const int K = g.K, nt = K / BK;
    unsigned voffA[2], voffB[2];
#pragma unroll
    for (int i = 0; i < 2; ++i) { int R, C; stage_rc(tid * 16 + i * 8192, R, C); const int Rb = Epi::PERM ? ((R & ~31) + perm32(R & 31)) : R;
        voffA[i] = (unsigned)(R * K + C) * 2u; voffB[i] = (unsigned)(Rb * K + C) * 2u; }
    const size_t kstep = (size_t)(BK * 2);
    const size_t hstep = (size_t)HALF * K * 2;
    const size_t tstep = 2 * hstep;
    const unsigned ldsw = (unsigned)wid * 1024u;
    const int aoff = lds_byte(wr * 64 + fr, fq * 8), boff = lds_byte(wc * 32 + fr, fq * 8);
#define PG8_SA(b, h) (((b) * 2 + (h)) * HTB)
#define PG8_SB(b, h) ((4 + (b) * 2 + (h)) * HTB)
#define PG8_STAGE(bufoff, gbase, voff) do { _Pragma("unroll") for (int _i = 0; _i < 2; ++_i) \
        __builtin_amdgcn_global_load_lds((const unsigned*)((const char*)(gbase) + (voff)[_i]), (PG8_LAS unsigned*)(lds + (bufoff) + ldsw + _i * 8192), 16, 0, 0); } while (0)
#define PG8_LDA(dst, b, h) do { _Pragma("unroll") for (int m = 0; m < 4; ++m) _Pragma("unroll") for (int k = 0; k < 2; ++k) dst[m][k] = *(const PG8_LAS bf16x8*)(lds + PG8_SA(b, h) + aoff + m * 2048 + k * 1024); } while (0)
#define PG8_LDB(dst, b, h) do { _Pragma("unroll") for (int n = 0; n < 2; ++n) _Pragma("unroll") for (int k = 0; k < 2; ++k) dst[n][k] = *(const PG8_LAS bf16x8*)(lds + PG8_SB(b, h) + boff + n * 2048 + k * 1024); } while (0)
#define PG8_MMA(ai, bj, At, Bt) do { __builtin_amdgcn_s_setprio(1); _Pragma("unroll") for (int m = 0; m < 4; ++m) _Pragma("unroll") for (int n = 0; n < 2; ++n) _Pragma("unroll") for (int k = 0; k < 2; ++k) \
        acc[ai][bj][m][n] = __builtin_amdgcn_mfma_f32_16x16x32_bf16(Bt[n][k], At[m][k], acc[ai][bj][m][n], 0, 0, 0); __builtin_amdgcn_s_setprio(0); } while (0)
#define PG8_WAIT_V(n) asm volatile("s_waitcnt vmcnt(" #n ")" ::: "memory")
#define PG8_WAIT_L(n) asm volatile("s_waitcnt lgkmcnt(" #n ")" ::: "memory")
#define PG8_BAR __builtin_amdgcn_s_barrier()
#define PG8_SCHED __builtin_amdgcn_sched_barrier(0)
    Unit cur, nxt; int ui = 0;
    if (!S.next(0, cur)) return;
    f32x4 acc[2][2][4][2];
#pragma unroll
    for (int a = 0; a < 2; ++a)
#pragma unroll
        for (int b = 0; b < 2; ++b)
#pragma unroll
            for (int m = 0; m < 4; ++m)
#pragma unroll
                for (int n = 0; n < 2; ++n) acc[a][b][m][n] = (f32x4){0.f, 0.f, 0.f, 0.f};
    bf16x8 At[4][2], B0[2][2], B1[2][2];
    const char* cA = (const char*)g.A + (size_t)cur.pm * tstep; const char* cB = (const char*)g.Bt + (size_t)cur.pn * tstep;
    S.a_ready(cur);
    if constexpr (SP2) {
        PG8_STAGE(PG8_SB(0, 0), cB, voffB); PG8_STAGE(PG8_SB(0, 1), cB + hstep, voffB); PG8_STAGE(PG8_SA(0, 0), cA, voffA); PG8_STAGE(PG8_SA(0, 1), cA + hstep, voffA);
        if (wr == 1) PG8_BAR;
        PG8_WAIT_V(2); PG8_BAR;
        PG8_STAGE(PG8_SB(1, 0), cB + kstep, voffB); PG8_STAGE(PG8_SA(1, 0), cA + kstep, voffA); PG8_STAGE(PG8_SB(1, 1), cB + hstep + kstep, voffB);
        PG8_WAIT_V(6); PG8_BAR;
    } else {
        PG8_STAGE(PG8_SB(0, 0), cB, voffB); PG8_STAGE(PG8_SA(0, 0), cA, voffA); PG8_STAGE(PG8_SB(0, 1), cB + hstep, voffB); PG8_STAGE(PG8_SA(0, 1), cA + hstep, voffA);
        if (wr == 1) PG8_BAR;
        PG8_WAIT_V(4); PG8_BAR;
        PG8_STAGE(PG8_SB(1, 0), cB + kstep, voffB); PG8_STAGE(PG8_SA(1, 0), cA + kstep, voffA); PG8_STAGE(PG8_SB(1, 1), cB + hstep + kstep, voffB);
        PG8_WAIT_V(6); PG8_BAR;
    }
    for (;;) {
        const bool has_next = S.next(ui + 1, nxt);
        const char* nA = has_next ? (const char*)g.A + (size_t)nxt.pm * tstep : cA; const char* nB = has_next ? (const char*)g.Bt + (size_t)nxt.pn * tstep : cB;
        for (int t = 0; t < nt; t += 2) {
            const bool last = (t == nt - 2);
            const char* a1 = cA + (size_t)(t + 1) * kstep;
            const char* a2 = last ? nA : cA + (size_t)(t + 2) * kstep; const char* b2 = last ? nB : cB + (size_t)(t + 2) * kstep;
            const char* a3 = a2 + kstep; const char* b3 = b2 + kstep;
            if (last && has_next) S.a_ready(nxt);
            if constexpr (SP2) {
            PG8_LDB(B0, 0, 0); PG8_LDB(B1, 0, 1); PG8_SCHED; PG8_LDA(At, 0, 0); PG8_STAGE(PG8_SA(1, 1), a1 + hstep, voffA);
            PG8_WAIT_V(8); PG8_WAIT_L(0); PG8_BAR; PG8_MMA(0, 0, At, B0); PG8_MMA(0, 1, At, B1); PG8_BAR; PG8_SCHED;
            PG8_LDA(At, 0, 1); PG8_STAGE(PG8_SB(0, 0), b2, voffB); PG8_STAGE(PG8_SB(0, 1), b2 + hstep, voffB); PG8_STAGE(PG8_SA(0, 0), a2, voffA);
            PG8_WAIT_V(8); PG8_WAIT_L(0); PG8_BAR; PG8_MMA(1, 0, At, B0); PG8_MMA(1, 1, At, B1); PG8_BAR; PG8_SCHED;
            PG8_LDB(B0, 1, 0); PG8_LDB(B1, 1, 1); PG8_SCHED; PG8_LDA(At, 1, 0); PG8_STAGE(PG8_SA(0, 1), a2 + hstep, voffA);
            PG8_WAIT_V(8); PG8_WAIT_L(0); PG8_BAR; PG8_MMA(0, 0, At, B0); PG8_MMA(0, 1, At, B1); PG8_BAR; PG8_SCHED;
            PG8_LDA(At, 1, 1); PG8_STAGE(PG8_SB(1, 0), b3, voffB); PG8_STAGE(PG8_SB(1, 1), b3 + hstep, voffB); PG8_STAGE(PG8_SA(1, 0), a3, voffA);
            PG8_WAIT_V(8); PG8_WAIT_L(0); PG8_BAR; PG8_MMA(1, 0, At, B0); PG8_MMA(1, 1, At, B1); PG8_BAR; PG8_SCHED;
            } else {
            PG8_LDB(B0, 0, 0); PG8_SCHED; PG8_LDA(At, 0, 0); PG8_STAGE(PG8_SA(1, 1), a1 + hstep, voffA);
            PG8_WAIT_L(8); PG8_BAR; PG8_WAIT_L(0); PG8_MMA(0, 0, At, B0); PG8_BAR; PG8_SCHED;
            PG8_LDB(B1, 0, 1); PG8_STAGE(PG8_SB(0, 0), b2, voffB);
            PG8_BAR; PG8_WAIT_L(0); PG8_MMA(0, 1, At, B1); PG8_BAR;
            PG8_LDA(At, 0, 1); PG8_STAGE(PG8_SA(0, 0), a2, voffA);
            PG8_BAR; PG8_WAIT_L(0); PG8_MMA(1, 0, At, B0); PG8_BAR; PG8_SCHED;
            PG8_STAGE(PG8_SB(0, 1), b2 + hstep, voffB);
            PG8_WAIT_V(6); PG8_BAR; PG8_MMA(1, 1, At, B1); PG8_BAR;
            PG8_LDB(B0, 1, 0); PG8_SCHED; PG8_LDA(At, 1, 0); PG8_STAGE(PG8_SA(0, 1), a2 + hstep, voffA);
            PG8_WAIT_L(8); PG8_BAR; PG8_WAIT_L(0); PG8_MMA(0, 0, At, B0); PG8_BAR; PG8_SCHED;
            PG8_LDB(B1, 1, 1); PG8_STAGE(PG8_SB(1, 0), b3, voffB);
            PG8_BAR; PG8_WAIT_L(0); PG8_MMA(0, 1, At, B1); PG8_BAR;
            PG8_LDA(At, 1, 1); PG8_STAGE(PG8_SA(1, 0), a3, voffA);
            PG8_BAR; PG8_WAIT_L(0); PG8_MMA(1, 0, At, B0); PG8_BAR; PG8_SCHED;
            PG8_STAGE(PG8_SB(1, 1), b3 + hstep, voffB);
            PG8_WAIT_V(6); PG8_BAR; PG8_MMA(1, 1, At, B1); PG8_BAR;
            }
        }
        if constexpr (ALIGN_EPI) { if (wr == 0) PG8_BAR; }
        if constexpr (!Epi::AFTER_DRAIN) { E(acc, cur, wr, wc, fr, fq); S.done(cur); }
        if (!has_next) break;
#pragma unroll
        for (int a = 0; a < 2; ++a)
#pragma unroll
            for (int b = 0; b < 2; ++b)
#pragma unroll
                for (int m = 0; m < 4; ++m)
#pragma unroll
                    for (int n = 0; n < 2; ++n) acc[a][b][m][n] = (f32x4){0.f, 0.f, 0.f, 0.f};
        cur = nxt; cA = nA; cB = nB; ++ui;
        if constexpr (ALIGN_EPI) { if (wr == 1) PG8_BAR; }
    }
    PG8_WAIT_V(0);
    if constexpr (!ALIGN_EPI) { if (wr == 0) PG8_BAR; }
    PG8_BAR;
    if constexpr (Epi::AFTER_DRAIN) { E.fused(acc, cur, wr, wc, fr, fq, lds, wid, lane); S.done(cur); }
#undef PG8_SA
#undef PG8_SB
#undef PG8_STAGE
#undef PG8_LDA
#undef PG8_LDB
#undef PG8_MMA
#undef PG8_WAIT_V
#undef PG8_WAIT_L
#undef PG8_BAR
#undef PG8_SCHED
}
}
#define GAS __attribute__((address_space(1)))
#define LAS __attribute__((address_space(3)))
typedef unsigned short bf16;
typedef unsigned v4u __attribute__((ext_vector_type(4)));
typedef float f32x4 __attribute__((ext_vector_type(4)));
typedef short bf16x8 __attribute__((ext_vector_type(8)));
typedef GAS unsigned gu32;
typedef GAS unsigned long long gu64;
#define RLX_AGENT __ATOMIC_RELAXED, __HIP_MEMORY_SCOPE_AGENT
#define LDS_WAIT() asm volatile("s_waitcnt lgkmcnt(0)" ::: "memory")
#define VM_WAIT() asm volatile("s_waitcnt vmcnt(0)" ::: "memory")
__device__ __forceinline__ unsigned long long rt() { return __builtin_amdgcn_s_memrealtime(); }
__device__ __forceinline__ unsigned f2bf(float f) { unsigned u = __builtin_bit_cast(unsigned, f); return (u + 0x7fffu + ((u >> 16) & 1u)) >> 16; }
__device__ __forceinline__ unsigned pk2(float lo, float hi) { return f2bf(lo) | (f2bf(hi) << 16); }

#define XB_TMO      128
#define XB_XCNT(j)  (256  + 64 * (j))
#define XB_XSUB(j)  (1280 + 64 * (j))
#define XB_XGEN(j)  (2304 + 64 * (j))
#define XB_TOP      3328
#define XB_TOPGEN   3392
#define XCD_BAR_WORDS 3456
#define XB_SPIN_CAP (1u << 18)

__device__ __forceinline__ unsigned xb_ld(unsigned* p)              { return __hip_atomic_load(p, __ATOMIC_RELAXED, __HIP_MEMORY_SCOPE_AGENT); }
__device__ __forceinline__ unsigned xb_add(unsigned* p, unsigned v) { return __hip_atomic_fetch_add(p, v, __ATOMIC_RELAXED, __HIP_MEMORY_SCOPE_AGENT); }
__device__ __forceinline__ unsigned xb_xcc_id() { return (unsigned)__builtin_amdgcn_s_getreg((3 << 11) | 20) & 0xFu; }
#define XB_SPIN(cond, bar) do { unsigned _sp = 0; while (cond) { __builtin_amdgcn_s_sleep(1); \
    if ((++_sp & 255u) == 0u) { if (xb_ld(&(bar)[XB_TMO])) break; if (_sp > XB_SPIN_CAP) { atomicAdd(&(bar)[XB_TMO], 1u); break; } } } } while (0)

struct XcdBarrier {
    unsigned* bar; unsigned x;
    volatile LAS unsigned* st;
};

__device__ __forceinline__ XcdBarrier xcd_barrier_post(unsigned* bar, volatile LAS unsigned* st) {
    XcdBarrier b; b.bar = bar; b.x = xb_xcc_id(); b.st = st;
    if (threadIdx.x == 0) (void)xb_add(&bar[XB_XCNT(b.x)], 1u);
    return b;
}
__device__ __forceinline__ void xcd_barrier_complete(unsigned* bar, unsigned x, unsigned& nloc, unsigned& nx) {
    const unsigned G = gridDim.x * gridDim.y * gridDim.z;
    unsigned sum, cnt, mine, sp = 0u;
    for (;;) {
        sum = 0u; cnt = 0u; mine = 0u;
#pragma unroll
        for (unsigned j = 0; j < 16; ++j) { const unsigned c = xb_ld(&bar[XB_XCNT(j)]); sum += c; cnt += (c > 0u) ? 1u : 0u; mine = (j == x) ? c : mine; }
        if (sum == G) break;
        __builtin_amdgcn_s_sleep(1);
        if ((++sp & 255u) == 0u) { if (xb_ld(&bar[XB_TMO])) break; if (sp > XB_SPIN_CAP) { atomicAdd(&bar[XB_TMO], 1u); break; } }
    }
    nloc = mine > 0u ? mine : 1u; nx = cnt > 0u ? cnt : 1u;
}

__device__ __forceinline__ void xcd_barrier(const XcdBarrier& b) {
    asm volatile("s_waitcnt vmcnt(0)" ::: "memory");
    __syncthreads();
    if (threadIdx.x == 0) {
        unsigned* bar = b.bar;
        __builtin_amdgcn_s_waitcnt(0);
        unsigned nloc = b.st[0], nx = b.st[1];
        if (nloc == 0u) { xcd_barrier_complete(bar, b.x, nloc, nx); b.st[0] = nloc; b.st[1] = nx; }
        const unsigned old = xb_add(&bar[XB_XSUB(b.x)], 1u);
        const unsigned gen = old / nloc;
        if (old + 1u == (gen + 1u) * nloc) {
            __builtin_amdgcn_fence(__ATOMIC_RELEASE, "agent");
            asm volatile("s_waitcnt vmcnt(0)" ::: "memory");
            const unsigned og = xb_add(&bar[XB_TOP], 1u);
            const unsigned tg = og / nx;
            if (og + 1u == (tg + 1u) * nx) xb_add(&bar[XB_TOPGEN], 1u);
            else XB_SPIN(xb_ld(&bar[XB_TOPGEN]) == tg, bar);
            __builtin_amdgcn_fence(__ATOMIC_ACQUIRE, "agent");
            xb_add(&bar[XB_XGEN(b.x)], 1u);
            asm volatile("s_waitcnt vmcnt(0)" ::: "memory");
        } else {
            XB_SPIN(xb_ld(&bar[XB_XGEN(b.x)]) == gen, bar);
            __builtin_amdgcn_fence(__ATOMIC_ACQUIRE, "agent");
            asm volatile("s_waitcnt vmcnt(0)" ::: "memory");
        }
    }
    __syncthreads();
}

constexpr int NWAVES = 8;
constexpr int NB = 4, S = 4096, D = 1024, M = NB * S;
constexpr int NIN = 3072, NQ = 2048, NEXP = 16384;
constexpr float EPS = 1e-6f;
constexpr float C2 = 0.125f * 1.4426950408889634f;

constexpr size_t MiB = 1u << 20;
constexpr size_t WS_CTL = 0, CTL_ZERO_BYTES = 64 * 1024;
constexpr size_t WS_MOD = 1 * MiB;
constexpr size_t WS_KMEAN = 1 * MiB + 128 * 1024;
constexpr size_t WS_SEL = 1 * MiB + 256 * 1024;
constexpr size_t WS_KEYS = 1 * MiB + 512 * 1024;
constexpr size_t WS_WIN = 2 * MiB, WS_WO = 8 * MiB, WS_WQ = 10 * MiB;
constexpr size_t WS_EIDX = 14 * MiB, WS_G = 22 * MiB;
constexpr size_t WS_U = 32 * MiB, WS_V = 64 * MiB;
constexpr size_t WS_H = 96 * MiB;
constexpr size_t WS_P = 128 * MiB;
constexpr size_t WS_QP = 128 * MiB, WS_O = 192 * MiB;
constexpr size_t WS_Y = 224 * MiB, WS_END = 256 * MiB;
constexpr int CW_BAR = 1024;

constexpr int RING_BYTES = 131072;
constexpr int LDSCTL_OFF = RING_BYTES, MISC_OFF = LDSCTL_OFF + 320;
constexpr int LDS_BYTES = 147456;

struct Frame {
    LAS unsigned char* lds;
    volatile LAS unsigned* MISC;
    gu32* ctl;
    int tid, lane, wave, G;
    const float *x, *c, *ada_w, *ada_b, *pre_gain, *post_gain, *w_in, *conv_w, *group_gain, *w_out, *fpre_gain, *fpost_gain, *wq, *keys, *pu, *pv;
    float* out;
    float* mod; float* kmean; unsigned short* sel; bf16* keysb; bf16 *WinT, *WoT, *WqT; int* eidx; float* gw; bf16 *U, *V, *H, *P, *QP, *O, *Y;
};

__device__ __forceinline__ float wave_sum(float v) {
#pragma unroll
    for (int o = 1; o < 64; o <<= 1) v += __shfl_xor(v, o);
    return v;
}
__device__ __forceinline__ float bflo(unsigned u) { return __uint_as_float(u << 16); }
__device__ __forceinline__ float bfhi(unsigned u) { return __uint_as_float(u & 0xffff0000u); }

__device__ __forceinline__ void p0_transpose_item(const float* W, int K, int N, bf16* WT, LAS float* scr, int item, int lane) {
    const int nblk = N / 32, kb = item / nblk, nb = item % nblk, k0 = 64 * kb, n0 = 32 * nb;
#pragma unroll 8
    for (int i = 0; i < 32; ++i) { const int kk = 2 * i + (lane >> 5); scr[kk * 33 + (lane & 31)] = W[(size_t)(k0 + kk) * N + n0 + (lane & 31)]; }
    LDS_WAIT(); asm volatile("" ::: "memory");
    const int c = lane & 7;
#pragma unroll
    for (int j = 0; j < 4; ++j) { const int n = (lane >> 3) + 8 * j; const LAS float* s = scr + (8 * c) * 33 + n;
        v4u o; o.x = pk2(s[0 * 33], s[1 * 33]); o.y = pk2(s[2 * 33], s[3 * 33]); o.z = pk2(s[4 * 33], s[5 * 33]); o.w = pk2(s[6 * 33], s[7 * 33]);
        *(GAS v4u*)(WT + (size_t)(n0 + n) * K + k0 + 8 * c) = o; }
    LDS_WAIT(); asm volatile("" ::: "memory");
}
__device__ __forceinline__ void cvt8(const float* src, bf16* dst, size_t i8) {
    const f32x4 a = *(const GAS f32x4*)(src + i8 * 8), b = *(const GAS f32x4*)(src + i8 * 8 + 4);
    v4u o; o.x = pk2(a.x, a.y); o.y = pk2(a.z, a.w); o.z = pk2(b.x, b.y); o.w = pk2(b.z, b.w);
    *(GAS v4u*)(dst + i8 * 8) = o;
}
__device__ __forceinline__ void p0_prep(Frame& F) {
    {
        LAS float* sc = (LAS float*)F.lds;
        LAS float* red = sc + 4096;
        bool did = false;
        for (int it = blockIdx.x; it < 96; it += F.G) {
            if (!did) { for (int i = F.tid; i < 4096; i += 512) { const float v = F.c[i]; sc[i] = v / (1.f + __expf(-v)); } did = true; }
            __syncthreads();
            const int jj = F.tid & 63, ks = F.tid >> 6, j = it * 64 + jj;
            float a0 = 0.f, a1 = 0.f, a2 = 0.f, a3 = 0.f;
#pragma unroll 8
            for (int i = ks * 128; i < ks * 128 + 128; ++i) { const float w = F.ada_w[(size_t)i * 6144 + j]; a0 += sc[i] * w; a1 += sc[1024 + i] * w; a2 += sc[2048 + i] * w; a3 += sc[3072 + i] * w; }
            red[(ks * 4 + 0) * 64 + jj] = a0; red[(ks * 4 + 1) * 64 + jj] = a1; red[(ks * 4 + 2) * 64 + jj] = a2; red[(ks * 4 + 3) * 64 + jj] = a3;
            __syncthreads();
            if (F.tid < 256) { const int b = F.tid >> 6; float s = 0.f;
#pragma unroll
                for (int k = 0; k < 8; ++k) s += red[(k * 4 + b) * 64 + jj];
                F.mod[b * 6144 + j] = s + F.ada_b[j]; }
        }
        __syncthreads();
    }
    LAS float* scr = (LAS float*)(F.lds + F.wave * 16384);
    const int gwv = blockIdx.x * NWAVES + F.wave, NGW = F.G * NWAVES;
    constexpr int I_IN = (D / 64) * (NIN / 32), I_O = (D / 64) * (D / 32), I_Q = (D / 64) * (NQ / 32);
    for (int it = gwv; it < I_IN + I_O + I_Q; it += NGW) {
        int r = it;
        if (r < I_IN) { p0_transpose_item(F.w_in, D, NIN, F.WinT, scr, r, F.lane); continue; } r -= I_IN;
        if (r < I_O) { p0_transpose_item(F.w_out, D, D, F.WoT, scr, r, F.lane); continue; } r -= I_O;
        p0_transpose_item(F.wq, D, NQ, F.WqT, scr, r, F.lane);
    }
    const size_t gt = (size_t)blockIdx.x * 512 + F.tid, NT = (size_t)F.G * 512;
    for (size_t i = gt; i < (size_t)16 * 128 * 128 / 8; i += NT) cvt8(F.keys, F.keysb, i);
    for (size_t i = gt; i < (size_t)NEXP * D / 8; i += NT) cvt8(F.pu, F.U, i);
    for (size_t i = gt; i < (size_t)NEXP * D / 8; i += NT) cvt8(F.pv, F.V, i);
}

__device__ __forceinline__ void p1_hnorm(Frame& F) {
    const int gwv = blockIdx.x * NWAVES + F.wave, NGW = F.G * NWAVES;
    for (int m = gwv; m < M; m += NGW) {
        const int b = m >> 12;
        const GAS f32x4* xr = (const GAS f32x4*)(F.x + (size_t)m * D) + F.lane;
        f32x4 v[4]; float ss = 0.f;
#pragma unroll
        for (int j = 0; j < 4; ++j) { v[j] = xr[64 * j]; ss += (v[j].x * v[j].x + v[j].y * v[j].y) + (v[j].z * v[j].z + v[j].w * v[j].w); }
        const float rstd = rsqrtf(wave_sum(ss) * (1.f / D) + EPS);
        GAS unsigned long long* o8 = (GAS unsigned long long*)(F.H + (size_t)m * D) + F.lane;
#pragma unroll
        for (int j = 0; j < 4; ++j) { const int col = 4 * F.lane + 256 * j;
            const f32x4 g = *(const GAS f32x4*)(F.pre_gain + col), sc = *(const GAS f32x4*)(F.mod + b * 6144 + 1024 + col), sh = *(const GAS f32x4*)(F.mod + b * 6144 + col);
            const f32x4 o = v[j] * rstd * g * (sc + 1.f) + sh;
            o8[64 * j] = (unsigned long long)pk2(o.x, o.y) | ((unsigned long long)pk2(o.z, o.w) << 32); }
    }
}

__device__ __forceinline__ void p3_kmean(Frame& F) {
    for (int i = blockIdx.x * 512 + F.tid; i < NB * 16 * 512; i += F.G * 512) {
        const int col = i & 511, bb = i >> 9;
        const bf16* kp = F.P + (size_t)bb * 256 * NIN + 2048 + col;
        float s = 0.f;
#pragma unroll 8
        for (int r = 0; r < 256; ++r) s += bflo((unsigned)kp[(size_t)r * NIN]);
        F.kmean[i] = s * (1.f / 256.f);
    }
}
__device__ __forceinline__ void p4_select(Frame& F) {
    for (int gid = blockIdx.x * 512 + F.tid; gid < M * 8; gid += F.G * 512) {
        const int t = gid >> 3, h = gid & 7, b = t >> 12, qb = (t & 4095) >> 8;
        unsigned mask;
        if (qb <= 3) mask = (1u << qb) - 1u;
        else {
            float q[64];
            const GAS v4u* qp = (const GAS v4u*)(F.P + (size_t)t * NIN + 1536 + h * 64);
#pragma unroll
            for (int i = 0; i < 8; ++i) { const v4u w = qp[i]; q[8 * i] = bflo(w.x); q[8 * i + 1] = bfhi(w.x); q[8 * i + 2] = bflo(w.y); q[8 * i + 3] = bfhi(w.y); q[8 * i + 4] = bflo(w.z); q[8 * i + 5] = bfhi(w.z); q[8 * i + 6] = bflo(w.w); q[8 * i + 7] = bfhi(w.w); }
            float g0 = -3e38f, g1 = -3e38f, g2 = -3e38f; int i0 = 0, i1 = 0, i2 = 0;
            for (int j = 0; j < qb; ++j) {
                const GAS f32x4* km = (const GAS f32x4*)(F.kmean + (size_t)(b * 16 + j) * 512 + h * 64);
                float s = 0.f;
#pragma unroll
                for (int i = 0; i < 16; ++i) { const f32x4 k4 = km[i]; s += q[4 * i] * k4.x + q[4 * i + 1] * k4.y + q[4 * i + 2] * k4.z + q[4 * i + 3] * k4.w; }
                if (s > g0) { g2 = g1; i2 = i1; g1 = g0; i1 = i0; g0 = s; i0 = j; }
                else if (s > g1) { g2 = g1; i2 = i1; g1 = s; i1 = j; }
                else if (s > g2) { g2 = s; i2 = j; }
            }
            mask = (1u << i0) | (1u << i1) | (1u << i2);
        }
        F.sel[gid] = (unsigned short)mask;
    }
}
__device__ __forceinline__ void p5_attn_naive(Frame& F) {
    for (int gid = blockIdx.x * 512 + F.tid; gid < M * 8; gid += F.G * 512) {
        const int h = gid >> 14, t = gid & 16383, b = t >> 12, s = t & 4095, qb = s >> 8, qoff = s & 255;
        float q[64], o[64];
        const GAS v4u* qp = (const GAS v4u*)(F.P + (size_t)t * NIN + 1536 + h * 64);
#pragma unroll
        for (int i = 0; i < 8; ++i) { const v4u w = qp[i]; q[8 * i] = bflo(w.x); q[8 * i + 1] = bfhi(w.x); q[8 * i + 2] = bflo(w.y); q[8 * i + 3] = bfhi(w.y); q[8 * i + 4] = bflo(w.z); q[8 * i + 5] = bfhi(w.z); q[8 * i + 6] = bflo(w.w); q[8 * i + 7] = bfhi(w.w); }
#pragma unroll
        for (int i = 0; i < 64; ++i) o[i] = 0.f;
        const unsigned mask = F.sel[t * 8 + h];
        float mx = -1e30f, l = 0.f;
        for (int j = 0; j <= qb; ++j) {
            const bool own = (j == qb);
            if (!own && !((mask >> j) & 1u)) continue;
            const int nk = own ? qoff + 1 : 256;
            const bf16* kb = F.P + (size_t)(b * 4096 + j * 256) * NIN + 2048 + h * 64;
            for (int key = 0; key < nk; ++key) {
                const GAS v4u* kp = (const GAS v4u*)(kb + (size_t)key * NIN);
                float sc = 0.f;
#pragma unroll
                for (int i = 0; i < 8; ++i) { const v4u w = kp[i]; sc += q[8 * i] * bflo(w.x) + q[8 * i + 1] * bfhi(w.x) + q[8 * i + 2] * bflo(w.y) + q[8 * i + 3] * bfhi(w.y) + q[8 * i + 4] * bflo(w.z) + q[8 * i + 5] * bfhi(w.z) + q[8 * i + 6] * bflo(w.w) + q[8 * i + 7] * bfhi(w.w); }
                if (sc > mx) { const float f = exp2f(mx - sc); l *= f;
#pragma unroll
                    for (int i = 0; i < 64; ++i) o[i] *= f;
                    mx = sc; }
                const float p = exp2f(sc - mx); l += p;
                const GAS v4u* vp = (const GAS v4u*)(kb + 512 + (size_t)key * NIN);
#pragma unroll
                for (int i = 0; i < 8; ++i) { const v4u w = vp[i]; o[8 * i] += p * bflo(w.x); o[8 * i + 1] += p * bfhi(w.x); o[8 * i + 2] += p * bflo(w.y); o[8 * i + 3] += p * bfhi(w.y); o[8 * i + 4] += p * bflo(w.z); o[8 * i + 5] += p * bfhi(w.z); o[8 * i + 6] += p * bflo(w.w); o[8 * i + 7] += p * bfhi(w.w); }
            }
        }
        const float il = 1.f / l; float ss = 0.f;
#pragma unroll
        for (int i = 0; i < 64; ++i) { o[i] *= il; ss += o[i] * o[i]; }
        const float rstd = rsqrtf(ss * (1.f / 64.f) + EPS);
        GAS v4u* yp = (GAS v4u*)(F.Y + (size_t)t * D + 512 + h * 64);
        const float* gg = F.group_gain + 512 + h * 64;
#pragma unroll
        for (int i = 0; i < 8; ++i) { v4u w; w.x = pk2(o[8 * i] * rstd * gg[8 * i], o[8 * i + 1] * rstd * gg[8 * i + 1]); w.y = pk2(o[8 * i + 2] * rstd * gg[8 * i + 2], o[8 * i + 3] * rstd * gg[8 * i + 3]);
            w.z = pk2(o[8 * i + 4] * rstd * gg[8 * i + 4], o[8 * i + 5] * rstd * gg[8 * i + 5]); w.w = pk2(o[8 * i + 6] * rstd * gg[8 * i + 6], o[8 * i + 7] * rstd * gg[8 * i + 7]); yp[i] = w; }
    }
}
__device__ __forceinline__ void unpack8(const v4u w, float* f) { f[0] = bflo(w.x); f[1] = bfhi(w.x); f[2] = bflo(w.y); f[3] = bfhi(w.y); f[4] = bflo(w.z); f[5] = bfhi(w.z); f[6] = bflo(w.w); f[7] = bfhi(w.w); }
__device__ __forceinline__ void p6_conv(Frame& F) {
    const int gwv = blockIdx.x * NWAVES + F.wave, NGW = F.G * NWAVES;
    const int col = 8 * F.lane;
    float cw[3][8], gg[8];
#pragma unroll
    for (int j = 0; j < 3; ++j)
#pragma unroll
        for (int i = 0; i < 8; ++i) cw[j][i] = F.conv_w[j * 512 + col + i];
#pragma unroll
    for (int i = 0; i < 8; ++i) gg[i] = F.group_gain[col + i];
    for (int t = gwv; t < M; t += NGW) {
        const int s = t & 4095;
        float acc[8], gb[8];
#pragma unroll
        for (int i = 0; i < 8; ++i) acc[i] = 0.f;
#pragma unroll
        for (int j = 0; j < 3; ++j) {
            if (s - 2 + j >= 0) {
                const bf16* rp = F.P + (size_t)(t - 2 + j) * NIN + col;
                float gc[8], hx[8]; unpack8(*(const GAS v4u*)(rp + 512), gc); unpack8(*(const GAS v4u*)(rp + 1024), hx);
#pragma unroll
                for (int i = 0; i < 8; ++i) acc[i] += cw[j][i] * gc[i] * hx[i];
            }
        }
        unpack8(*(const GAS v4u*)(F.P + (size_t)t * NIN + col), gb);
        float ss = 0.f;
#pragma unroll
        for (int i = 0; i < 8; ++i) { acc[i] *= gb[i]; ss += acc[i] * acc[i]; }
        ss += __shfl_xor(ss, 1); ss += __shfl_xor(ss, 2); ss += __shfl_xor(ss, 4);
        const float rstd = rsqrtf(ss * (1.f / 64.f) + EPS);
        v4u w; w.x = pk2(acc[0] * rstd * gg[0], acc[1] * rstd * gg[1]); w.y = pk2(acc[2] * rstd * gg[2], acc[3] * rstd * gg[3]); w.z = pk2(acc[4] * rstd * gg[4], acc[5] * rstd * gg[5]); w.w = pk2(acc[6] * rstd * gg[6], acc[7] * rstd * gg[7]);
        *(GAS v4u*)(F.Y + (size_t)t * D + col) = w;
    }
}
__device__ __forceinline__ void p8_resid(Frame& F) {
    const int gwv = blockIdx.x * NWAVES + F.wave, NGW = F.G * NWAVES;
    for (int m = gwv; m < M; m += NGW) {
        const int b = m >> 12;
        const float* md = F.mod + b * 6144;
        const GAS unsigned long long* orow = (const GAS unsigned long long*)(F.O + (size_t)m * D) + F.lane;
        f32x4 ov[4]; float ss = 0.f;
#pragma unroll
        for (int j = 0; j < 4; ++j) { const unsigned long long w = orow[64 * j]; const unsigned lo = (unsigned)w, hi = (unsigned)(w >> 32); ov[j] = (f32x4){bflo(lo), bfhi(lo), bflo(hi), bfhi(hi)};
            ss += (ov[j].x * ov[j].x + ov[j].y * ov[j].y) + (ov[j].z * ov[j].z + ov[j].w * ov[j].w); }
        const float rstd = rsqrtf(wave_sum(ss) * (1.f / D) + EPS);
        const GAS f32x4* xr = (const GAS f32x4*)(F.x + (size_t)m * D) + F.lane;
        GAS f32x4* outr = (GAS f32x4*)(F.out + (size_t)m * D) + F.lane;
        f32x4 x1[4]; float s2 = 0.f;
#pragma unroll
        for (int j = 0; j < 4; ++j) { const int col = 4 * F.lane + 256 * j;
            const f32x4 g = *(const GAS f32x4*)(F.post_gain + col), g1 = *(const GAS f32x4*)(md + 2048 + col);
            x1[j] = xr[64 * j] + g1 * (ov[j] * rstd * g); outr[64 * j] = x1[j];
            s2 += (x1[j].x * x1[j].x + x1[j].y * x1[j].y) + (x1[j].z * x1[j].z + x1[j].w * x1[j].w); }
        const float rstd2 = rsqrtf(wave_sum(s2) * (1.f / D) + EPS);
        GAS unsigned long long* o8 = (GAS unsigned long long*)(F.H + (size_t)m * D) + F.lane;
#pragma unroll
        for (int j = 0; j < 4; ++j) { const int col = 4 * F.lane + 256 * j;
            const f32x4 g = *(const GAS f32x4*)(F.fpre_gain + col), sc = *(const GAS f32x4*)(md + 4096 + col), sh = *(const GAS f32x4*)(md + 3072 + col);
            const f32x4 o = x1[j] * rstd2 * g * (sc + 1.f) + sh;
            o8[64 * j] = (unsigned long long)pk2(o.x, o.y) | ((unsigned long long)pk2(o.z, o.w) << 32); }
    }
}
#define INS16(TS, TI, sv, iv) do { float s_ = (sv); int i_ = (iv); _Pragma("unroll") for (int j_ = 0; j_ < 16; ++j_) { const bool gt_ = s_ > TS[j_]; const float ts_ = TS[j_]; const int ti_ = TI[j_]; TS[j_] = gt_ ? s_ : ts_; TI[j_] = gt_ ? i_ : ti_; s_ = gt_ ? ts_ : s_; i_ = gt_ ? ti_ : i_; } } while (0)
__device__ __forceinline__ void p10_route_naive(Frame& F) {
    const int nwv = F.G * NWAVES;
    for (int wv = blockIdx.x * NWAVES + F.wave; wv < M * 8 / 64; wv += nwv) {
        const int h = (wv >> 8) + (F.lane >> 6), t = ((wv & 255) << 6) + F.lane;
        float s1[16], s2[16]; int i1[16], i2[16];
#pragma unroll
        for (int p = 0; p < 2; ++p) {
            float q[128];
            const GAS v4u* qp = (const GAS v4u*)(F.QP + (size_t)t * NQ + h * 256 + p * 128);
#pragma unroll
            for (int i = 0; i < 16; ++i) unpack8(qp[i], q + 8 * i);
            float ts[16]; int ti[16];
#pragma unroll
            for (int j = 0; j < 16; ++j) { ts[j] = -3e38f; ti[j] = 0; }
            const bf16* kb = F.keysb + (size_t)(h * 2 + p) * 128 * 128;
            for (int n = 0; n < 128; ++n) {
                const v4u* kp = (const v4u*)(kb + n * 128);
                float sc = 0.f;
#pragma unroll
                for (int i = 0; i < 16; ++i) { const v4u w = kp[i]; sc += q[8 * i] * bflo(w.x) + q[8 * i + 1] * bfhi(w.x) + q[8 * i + 2] * bflo(w.y) + q[8 * i + 3] * bfhi(w.y) + q[8 * i + 4] * bflo(w.z) + q[8 * i + 5] * bfhi(w.z) + q[8 * i + 6] * bflo(w.w) + q[8 * i + 7] * bfhi(w.w); }
                INS16(ts, ti, sc, n);
            }
#pragma unroll
            for (int j = 0; j < 16; ++j) { if (p == 0) { s1[j] = ts[j]; i1[j] = ti[j]; } else { s2[j] = ts[j]; i2[j] = ti[j]; } }
        }
        float ts[16]; int ti[16];
#pragma unroll
        for (int j = 0; j < 16; ++j) { ts[j] = -3e38f; ti[j] = 0; }
#pragma unroll
        for (int a = 0; a < 16; ++a)
#pragma unroll
            for (int bq = 0; bq < 16; ++bq)
                if ((a + 1) * (bq + 1) <= 16) INS16(ts, ti, s1[a] + s2[bq], i1[a] * 128 + i2[bq]);
        float sum = 0.f, e[16];
#pragma unroll
        for (int j = 0; j < 16; ++j) { e[j] = __expf(ts[j] - ts[0]); sum += e[j]; }
        const float inv = 1.f / sum;
        int* ep = F.eidx + (size_t)t * 128 + h * 16; float* gp = F.gw + (size_t)t * 128 + h * 16;
#pragma unroll
        for (int j = 0; j < 16; ++j) { ep[j] = ti[j]; gp[j] = e[j] * inv; }
    }
}
__device__ __forceinline__ float gelu_tanh(float a) {
    const float z = 0.7978845608028654f * (a + 0.044715f * a * a * a);
    const float e = __expf(2.f * z);
    const float th = 1.f - 2.f / (e + 1.f);
    return 0.5f * a * (1.f + th);
}
__device__ __forceinline__ void p11_peer(Frame& F) {
    const int gwv = blockIdx.x * NWAVES + F.wave, NGW = F.G * NWAVES;
    for (int t = gwv; t < M; t += NGW) {
        const int b = t >> 12;
        float hv[16], acc[16];
        { const GAS v4u* hp = (const GAS v4u*)(F.H + (size_t)t * D + 16 * F.lane); unpack8(hp[0], hv); unpack8(hp[1], hv + 8); }
#pragma unroll
        for (int i = 0; i < 16; ++i) acc[i] = 0.f;
        const int e_lo = F.eidx[(size_t)t * 128 + F.lane], e_hi = F.eidx[(size_t)t * 128 + 64 + F.lane];
        const float g_lo = F.gw[(size_t)t * 128 + F.lane], g_hi = F.gw[(size_t)t * 128 + 64 + F.lane];
        for (int k0 = 0; k0 < 128; k0 += 8) {
            float av[8]; int ev[8]; float gv[8];
#pragma unroll
            for (int kk = 0; kk < 8; ++kk) {
                const int k = k0 + kk;
                ev[kk] = __shfl(k < 64 ? e_lo : e_hi, k & 63); gv[kk] = __shfl(k < 64 ? g_lo : g_hi, k & 63);
                const GAS v4u* up = (const GAS v4u*)(F.U + (size_t)ev[kk] * D + 16 * F.lane);
                float uf[16]; unpack8(up[0], uf); unpack8(up[1], uf + 8);
                float d = 0.f;
#pragma unroll
                for (int i = 0; i < 16; ++i) d += uf[i] * hv[i];
                av[kk] = d;
            }
#pragma unroll
            for (int kk = 0; kk < 8; ++kk) av[kk] = wave_sum(av[kk]);
#pragma unroll
            for (int kk = 0; kk < 8; ++kk) {
                const float w = gv[kk] * gelu_tanh(av[kk]);
                const GAS v4u* vp = (const GAS v4u*)(F.V + (size_t)ev[kk] * D + 16 * F.lane);
                float vf[16]; unpack8(vp[0], vf); unpack8(vp[1], vf + 8);
#pragma unroll
                for (int i = 0; i < 16; ++i) acc[i] += w * vf[i];
            }
        }
        float ss = 0.f;
#pragma unroll
        for (int i = 0; i < 16; ++i) ss += acc[i] * acc[i];
        const float rstd = rsqrtf(wave_sum(ss) * (1.f / D) + EPS);
        GAS f32x4* op = (GAS f32x4*)(F.out + (size_t)t * D + 16 * F.lane);
        const GAS f32x4* gp = (const GAS f32x4*)(F.fpost_gain + 16 * F.lane);
        const GAS f32x4* g2p = (const GAS f32x4*)(F.mod + b * 6144 + 5120 + 16 * F.lane);
#pragma unroll
        for (int i = 0; i < 4; ++i) { const f32x4 x1 = op[i], g = gp[i], g2 = g2p[i];
            const f32x4 y = (f32x4){acc[4 * i], acc[4 * i + 1], acc[4 * i + 2], acc[4 * i + 3]};
            op[i] = x1 + g2 * (y * rstd * g); }
    }
}

struct Args { const float* in[16]; float* out; unsigned char* ws; int ph_lo, ph_hi; };
constexpr int NPHASE = 12;
template <unsigned PM> __global__ void __launch_bounds__(NWAVES * 64, 2) fwd_kernel(Args args) {
    extern __shared__ __attribute__((aligned(16))) unsigned char lds[];
    Frame F;
    F.lds = (LAS unsigned char*)lds;
    F.MISC = (volatile LAS unsigned*)(F.lds + MISC_OFF);
    F.tid = threadIdx.x; F.lane = F.tid & 63; F.wave = __builtin_amdgcn_readfirstlane(F.tid >> 6);
    F.G = gridDim.x;
    unsigned char* ws = args.ws;
    F.ctl = (gu32*)(ws + WS_CTL);
    F.x = args.in[0]; F.c = args.in[1]; F.ada_w = args.in[2]; F.ada_b = args.in[3]; F.pre_gain = args.in[4]; F.post_gain = args.in[5]; F.w_in = args.in[6]; F.conv_w = args.in[7];
    F.group_gain = args.in[8]; F.w_out = args.in[9]; F.fpre_gain = args.in[10]; F.fpost_gain = args.in[11]; F.wq = args.in[12]; F.keys = args.in[13]; F.pu = args.in[14]; F.pv = args.in[15];
    F.out = args.out;
    F.mod = (float*)(ws + WS_MOD); F.kmean = (float*)(ws + WS_KMEAN); F.sel = (unsigned short*)(ws + WS_SEL); F.keysb = (bf16*)(ws + WS_KEYS);
    F.WinT = (bf16*)(ws + WS_WIN); F.WoT = (bf16*)(ws + WS_WO); F.WqT = (bf16*)(ws + WS_WQ); F.eidx = (int*)(ws + WS_EIDX); F.gw = (float*)(ws + WS_G);
    F.U = (bf16*)(ws + WS_U); F.V = (bf16*)(ws + WS_V); F.H = (bf16*)(ws + WS_H); F.P = (bf16*)(ws + WS_P); F.QP = (bf16*)(ws + WS_QP); F.O = (bf16*)(ws + WS_O); F.Y = (bf16*)(ws + WS_Y);
    for (int u = F.tid; u < (LDS_BYTES - LDSCTL_OFF) / 4; u += NWAVES * 64) ((LAS unsigned*)(F.lds + LDSCTL_OFF))[u] = 0u;
    __syncthreads();
    const int lo = args.ph_lo, hi = args.ph_hi;
    const bool multi = (hi - lo) > 1;
    XcdBarrier bar; bar.bar = (unsigned*)(F.ctl + CW_BAR); bar.x = 0; bar.st = nullptr;
    if (multi) bar = xcd_barrier_post((unsigned*)(F.ctl + CW_BAR), F.MISC + 8);
#define IN(k) ((((PM) >> (k)) & 1u) && lo <= (k) && (k) < hi)
#define BOTH(k) (IN(k) && IN((k) + 1))
#define SEAM(k) do { if (BOTH(k)) xcd_barrier(bar); } while (0)
    if (IN(0)) { p0_prep(F); SEAM(0); }
    if (IN(1)) { p1_hnorm(F); SEAM(1); }
    if (IN(2)) {
        pg8::Gemm g{F.H, F.WinT, M, NIN, D}; pg8::StaticOrder So; So.init(M, NIN, F.G, (int)blockIdx.x);
        pg8::EpiBf16 E{F.P, NIN, 6, 8, C2};
        pg8::gemm_phase<pg8::EpiBf16, pg8::StaticOrder, true, true>(F.lds, g, So, E);
        SEAM(2);
    }
    if (IN(3)) { p3_kmean(F); SEAM(3); }
    if (IN(4)) { p4_select(F); SEAM(4); }
    if (IN(5)) { p5_attn_naive(F); }
    if (IN(6)) { p6_conv(F); SEAM(6); }
    if (IN(7)) {
        pg8::Gemm g{F.Y, F.WoT, M, D, D}; pg8::StaticOrder So; So.init(M, D, F.G, (int)blockIdx.x);
        pg8::EpiBf16 E{F.O, D, 0, 0, 1.f};
        pg8::gemm_phase<pg8::EpiBf16, pg8::StaticOrder, true, true>(F.lds, g, So, E);
        SEAM(7);
    }
    if (IN(8)) { p8_resid(F); SEAM(8); }
    if (IN(9)) {
        pg8::Gemm g{F.H, F.WqT, M, NQ, D}; pg8::StaticOrder So; So.init(M, NQ, F.G, (int)blockIdx.x);
        pg8::EpiBf16 E{F.QP, NQ, 0, 0, 1.f};
        pg8::gemm_phase<pg8::EpiBf16, pg8::StaticOrder, true, true>(F.lds, g, So, E);
        SEAM(9);
    }
    if (IN(10)) { p10_route_naive(F); SEAM(10); }
    if (IN(11)) { p11_peer(F); }
#undef IN
#undef BOTH
#undef SEAM
}

#ifndef N_LAUNCH_MODE
#define N_LAUNCH_MODE 0
#endif
template <unsigned PM> static bool set_lds() { return hipFuncSetAttribute((const void*)fwd_kernel<PM>, hipFuncAttributeMaxDynamicSharedMemorySize, LDS_BYTES) == hipSuccess; }
template <unsigned PM> static void launch1(int grid, hipStream_t stream, Args a) { hipLaunchKernelGGL(fwd_kernel<PM>, dim3(grid), dim3(NWAVES * 64), LDS_BYTES, stream, a); }
extern "C" void kernel_launch(void* const* d_in, const int* in_sizes, int n_in, void* d_out, int out_size, void* d_ws, size_t ws_size, hipStream_t stream) {
    static int grid = 0;
    if (grid == 0) {
        if (n_in != 16 || out_size != M * D || ws_size < WS_END) { fprintf(stderr, "kernel_launch: unexpected shapes n_in %d out %d ws %zu\n", n_in, out_size, ws_size); grid = -1; return; }
        int dev = 0, cus = 0;
        if (hipGetDevice(&dev) != hipSuccess || hipDeviceGetAttribute(&cus, hipDeviceAttributeMultiprocessorCount, dev) != hipSuccess) { grid = -1; return; }
        bool ok = true;
#if N_LAUNCH_MODE == 1
        ok = set_lds<0xfffu>();
#else
        ok = set_lds<1u>() && set_lds<2u>() && set_lds<4u>() && set_lds<8u>() && set_lds<16u>() && set_lds<32u>() && set_lds<64u>() && set_lds<128u>() && set_lds<256u>() && set_lds<512u>() && set_lds<1024u>() && set_lds<2048u>();
#endif
        if (!ok) { fprintf(stderr, "kernel_launch: hipFuncSetAttribute failed\n"); grid = -1; return; }
        grid = cus;
    }
    if (grid < 0) return;
    (void)hipMemsetAsync((char*)d_ws + WS_CTL, 0, CTL_ZERO_BYTES, stream);
    Args a{};
    for (int i = 0; i < 16; ++i) a.in[i] = (const float*)d_in[i];
    a.out = (float*)d_out; a.ws = (unsigned char*)d_ws;
#if N_LAUNCH_MODE == 1
    a.ph_lo = 0; a.ph_hi = NPHASE; launch1<0xfffu>(grid, stream, a);
#else
#define L1(p) do { a.ph_lo = (p); a.ph_hi = (p) + 1; launch1<(1u << (p))>(grid, stream, a); } while (0)
    L1(0); L1(1); L1(2); L1(3); L1(4); L1(5); L1(6); L1(7); L1(8); L1(9); L1(10); L1(11);
#undef L1
#endif
}
```

```cpp
#include <hip/hip_runtime.h>
#include <cstdio>
#include <cstdint>
#ifndef WT_STORES
#define WT_STORES 1
#endif
typedef unsigned wt_v4u __attribute__((ext_vector_type(4)));
__device__ __forceinline__ int lane_id_fresh() { int l; asm volatile("v_mbcnt_lo_u32_b32 %0, -1, 0\n\tv_mbcnt_hi_u32_b32 %0, -1, %0" : "=v"(l)); return l; }
__device__ __forceinline__ void st16_wt(void* p, wt_v4u v) {
#if WT_STORES
    asm volatile("global_store_dwordx4 %0, %1, off sc1\n\ts_nop 1" :: "v"(p), "v"(v) : "memory");
#else
    *(wt_v4u*)p = v;
#endif
}
__device__ __forceinline__ void st4_wt(void* p, unsigned v) {
#if WT_STORES
    asm volatile("global_store_dword %0, %1, off sc1\n\ts_nop 1" :: "v"(p), "v"(v) : "memory");
#else
    *(unsigned*)p = v;
#endif
}
__device__ __forceinline__ void st8_wt(void* p, unsigned long long v) {
#if WT_STORES
    asm volatile("global_store_dwordx2 %0, %1, off sc1\n\ts_nop 1" :: "v"(p), "v"(v) : "memory");
#else
    *(unsigned long long*)p = v;
#endif
}
namespace pg8 {
#define PG8_LAS __attribute__((address_space(3)))
typedef unsigned short bf16_t;
typedef short bf16x8 __attribute__((ext_vector_type(8)));
typedef float f32x4 __attribute__((ext_vector_type(4)));
typedef unsigned u32x4 __attribute__((ext_vector_type(4)));
typedef int i32x4 __attribute__((ext_vector_type(4)));
typedef int i32x8 __attribute__((ext_vector_type(8)));
constexpr int BM = 256, BK = 64, HALF = 128, HTB = HALF * BK * 2  , STAGE_BYTES = 8 * HTB, NXCD = 8, WGM = 8;

__host__ __device__ __forceinline__ int lds_byte(int r, int c) { const int st = (r >> 4) * 2 + (c >> 5), rr = r & 15, cc = c & 31, ob = rr * 64 + cc * 2; return st * 1024 + (ob ^ (((ob >> 9) & 1) << 5)); }
__host__ __device__ __forceinline__ void stage_rc(int b, int& R, int& C) { const int st = b / 1024, sb = b % 1024, swz = sb ^ (((sb >> 9) & 1) << 5); R = (st >> 1) * 16 + swz / 64; C = (st & 1) * 32 + (swz % 64) / 2; }
__host__ __device__ __forceinline__ int perm32(int rho) { const int n = rho >> 4, i = rho & 15; return 8 * (i >> 2) + 4 * n + (i & 3); }

struct Unit { int pm, pn; };
struct Gemm { const bf16_t* A; const bf16_t* Bt; int M, N, K; };

struct StaticOrder {
    int nM, nN, nwg, G, c;
    __host__ __device__ void init(int M, int N, int G_, int c_) { nM = M / BM; nN = N / BM; nwg = nM * nN; G = G_; c = c_; }
    __host__ __device__ bool next(int i, Unit& u) const {
        const long L = (long)i * G + c; if (L >= nwg) return false;
        int wgid = (int)L; { const int q = nwg / NXCD, r = nwg % NXCD, xcd = wgid % NXCD, off = wgid / NXCD; wgid = (xcd < r ? xcd * (q + 1) : r * (q + 1) + (xcd - r) * q) + off; }
        const int nig = WGM * nN, gid = wgid / nig, fm = gid * WGM, gsz = (nM - fm) < WGM ? (nM - fm) : WGM;
        u.pm = fm + ((wgid % nig) % gsz); u.pn = (wgid % nig) / gsz; return true;
    }
    __device__ __forceinline__ void a_ready(const Unit&) const {}
    __device__ __forceinline__ void done(const Unit&) const {}
};


__device__ __forceinline__ unsigned cvt_pk_bf16(float lo, float hi) { unsigned r; asm volatile("v_cvt_pk_bf16_f32 %0, %1, %2" : "=v"(r) : "v"(lo), "v"(hi)); return r; }
template <bool ACC_I32> struct EpiBf16S {
    static constexpr bool PERM = true, AFTER_DRAIN = false;
    bf16_t* O; int ldc; int sc_lo, sc_hi; float scv; float* ksum; int ks_lo, ks_hi; const float* rs; const unsigned* cmax;
    __device__ __forceinline__ void operator()(const f32x4 (&acc)[2][2][4][2], const Unit& u, int wr, int wc, int fr_, int fq_) const {
        (void)fr_; (void)fq_;
        const int lane_ = lane_id_fresh(); const int fr = lane_ & 15, fq = lane_ >> 4;
        const int row0 = u.pm * BM + wr * 64 + fr; const int colt = u.pn * BM;
        const float sc = ((u.pn >= sc_lo && u.pn < sc_hi) ? scv : 1.f) * (ACC_I32 ? (1.f / 127.f) : (1.f / 224.f));
        const int col0 = colt + wc * 32 + 8 * fq;
        float rsv[2][4];
#pragma unroll
        for (int ai = 0; ai < 2; ++ai)
#pragma unroll
            for (int m = 0; m < 4; ++m) rsv[ai][m] = rs != nullptr ? rs[row0 + ai * HALF + m * 16] : 1.f;
        const bool do_ks = ksum != nullptr && u.pn >= ks_lo && u.pn < ks_hi;
#pragma unroll
        for (int bj = 0; bj < 2; ++bj) {
            const u32x4 cb0 = *(const u32x4*)(cmax + col0 + bj * HALF), cb1 = *(const u32x4*)(cmax + col0 + bj * HALF + 4);
            const f32x4 cs0 = (f32x4){__uint_as_float(cb0.x), __uint_as_float(cb0.y), __uint_as_float(cb0.z), __uint_as_float(cb0.w)} * sc;
            const f32x4 cs1 = (f32x4){__uint_as_float(cb1.x), __uint_as_float(cb1.y), __uint_as_float(cb1.z), __uint_as_float(cb1.w)} * sc;
            f32x4 sum0 = {0.f, 0.f, 0.f, 0.f}, sum1 = sum0;
#pragma unroll
            for (int ai = 0; ai < 2; ++ai)
#pragma unroll
                for (int m = 0; m < 4; ++m) { f32x4 a0 = acc[ai][bj][m][0], a1 = acc[ai][bj][m][1];
                    if constexpr (ACC_I32) { const i32x4 i0 = __builtin_bit_cast(i32x4, a0), i1 = __builtin_bit_cast(i32x4, a1);
                        a0 = (f32x4){(float)i0[0], (float)i0[1], (float)i0[2], (float)i0[3]}; a1 = (f32x4){(float)i1[0], (float)i1[1], (float)i1[2], (float)i1[3]}; }
                    const f32x4 v0 = a0 * rsv[ai][m] * cs0, v1 = a1 * rsv[ai][m] * cs1;
                    sum0 += v0; sum1 += v1;
                    u32x4 w; w.x = cvt_pk_bf16(v0[0], v0[1]); w.y = cvt_pk_bf16(v0[2], v0[3]); w.z = cvt_pk_bf16(v1[0], v1[1]); w.w = cvt_pk_bf16(v1[2], v1[3]);
                    st16_wt(O + (size_t)(row0 + ai * HALF + m * 16) * ldc + col0 + bj * HALF, w); }
            if (do_ks) {
                float* kd = ksum + (size_t)u.pm * ((ks_hi - ks_lo) * BM) + (u.pn - ks_lo) * BM + wc * 32 + 8 * fq + bj * HALF;
#pragma unroll
                for (int n = 0; n < 2; ++n)
#pragma unroll
                    for (int i = 0; i < 4; ++i) {
                        float v = n ? sum1[i] : sum0[i];
                        v += __uint_as_float((unsigned)__builtin_amdgcn_mov_dpp((int)__float_as_uint(v), 0xB1, 0xf, 0xf, true));
                        v += __uint_as_float((unsigned)__builtin_amdgcn_mov_dpp((int)__float_as_uint(v), 0x4E, 0xf, 0xf, true));
                        v += __uint_as_float((unsigned)__builtin_amdgcn_mov_dpp((int)__float_as_uint(v), 0x141, 0xf, 0xf, true));
                        v += __uint_as_float((unsigned)__builtin_amdgcn_mov_dpp((int)__float_as_uint(v), 0x140, 0xf, 0xf, true));
                        if (fr == 0) atomicAdd(kd + 4 * n + i, v);
                    }
            }
        }
    }
};
struct EpiBf16 {
    static constexpr bool PERM = true, AFTER_DRAIN = false;
    bf16_t* O; int ldc; int sc_lo, sc_hi; float scv; float* ksum; int ks_lo, ks_hi;
    __device__ __forceinline__ void operator()(const f32x4 (&acc)[2][2][4][2], const Unit& u, int wr, int wc, int fr, int fq) const {
        const int row0 = u.pm * BM + wr * 64 + fr; const int colt = u.pn * BM;
        const float sc = (u.pn >= sc_lo && u.pn < sc_hi) ? scv : 1.f;
        const int col0 = colt + wc * 32 + 8 * fq;
#pragma unroll
        for (int ai = 0; ai < 2; ++ai)
#pragma unroll
            for (int m = 0; m < 4; ++m) { bf16_t* rowp = O + (size_t)(row0 + ai * HALF + m * 16) * ldc + col0;
#pragma unroll
                for (int bj = 0; bj < 2; ++bj) { f32x4 v0 = acc[ai][bj][m][0] * sc, v1 = acc[ai][bj][m][1] * sc;
                    u32x4 w; w.x = cvt_pk_bf16(v0[0], v0[1]); w.y = cvt_pk_bf16(v0[2], v0[3]); w.z = cvt_pk_bf16(v1[0], v1[1]); w.w = cvt_pk_bf16(v1[2], v1[3]);
                    st16_wt(rowp + bj * HALF, w); } }
        if (ksum != nullptr && u.pn >= ks_lo && u.pn < ks_hi) {
            float* kd = ksum + (size_t)u.pm * ((ks_hi - ks_lo) * BM) + (u.pn - ks_lo) * BM + wc * 32 + 8 * fq;
#pragma unroll
            for (int bj = 0; bj < 2; ++bj)
#pragma unroll
                for (int n = 0; n < 2; ++n) {
                    f32x4 cs = acc[0][bj][0][n];
#pragma unroll
                    for (int m = 1; m < 4; ++m) cs += acc[0][bj][m][n];
#pragma unroll
                    for (int m = 0; m < 4; ++m) cs += acc[1][bj][m][n];
#pragma unroll
                    for (int i = 0; i < 4; ++i) {
                        float v = cs[i];
                        v += __uint_as_float((unsigned)__builtin_amdgcn_mov_dpp((int)__float_as_uint(v), 0xB1, 0xf, 0xf, true));
                        v += __uint_as_float((unsigned)__builtin_amdgcn_mov_dpp((int)__float_as_uint(v), 0x4E, 0xf, 0xf, true));
                        v += __uint_as_float((unsigned)__builtin_amdgcn_mov_dpp((int)__float_as_uint(v), 0x141, 0xf, 0xf, true));
                        v += __uint_as_float((unsigned)__builtin_amdgcn_mov_dpp((int)__float_as_uint(v), 0x140, 0xf, 0xf, true));
                        if (fr == 0) atomicAdd(kd + bj * HALF + 4 * n + i, v);
                    }
                }
        }
    }
};

template <int OFF> __device__ __forceinline__ void dma16s(const void* sbase, unsigned voff, unsigned lds_base) { unsigned keep;
    asm volatile("s_mov_b32 %0, m0\n\ts_add_u32 m0, %3, %4\n\ts_nop 0\n\tglobal_load_lds_dwordx4 %1, %2\n\ts_mov_b32 m0, %0" : "=&s"(keep) : "v"(voff), "s"(sbase), "s"(lds_base), "i"(OFF) : "memory", "scc"); }
__device__ __forceinline__ const char* uni_ptr(const char* p) {
    const unsigned long long v = (unsigned long long)p;
    return (const char*)(((unsigned long long)(unsigned)__builtin_amdgcn_readfirstlane((int)(unsigned)(v >> 32)) << 32) | (unsigned)__builtin_amdgcn_readfirstlane((int)(unsigned)v));
}
template <class Epi, class Sched, bool ALIGN_EPI = false, bool SP2 = false, bool FP8 = false, bool I8 = false>
__device__ __forceinline__ void gemm_phase(PG8_LAS unsigned char* lds, const Gemm g, const Sched& S, const Epi& E) {
    int tid_ = threadIdx.x; asm volatile("" : "+v"(tid_));
    const int tid = tid_, wid = __builtin_amdgcn_readfirstlane(tid >> 6), lane = tid & 63, wr = wid >> 2, wc = wid & 3, fr = lane & 15, fq = lane >> 4;
    const int K = g.K, nt = K / BK;
    unsigned voffA[2], voffB[2];
#pragma unroll
    for (int i = 0; i < 2; ++i) { int R, C; stage_rc(tid * 16 + i * 8192, R, C); const int Rb = Epi::PERM ? ((R & ~31) + perm32(R & 31)) : R;
        voffA[i] = (unsigned)(R * K + C) * 2u; voffB[i] = (unsigned)(Rb * K + C) * 2u; }
    const size_t qstep = (size_t)64 * K * 2;
    const size_t kstep = (size_t)(BK * 2);
    const size_t hstep = (size_t)HALF * K * 2;
    const size_t tstep = 2 * hstep;
    const unsigned ldsn = (unsigned)(size_t)lds;
    const unsigned ldsw = (unsigned)wid * 1024u;
    const unsigned ldsb = (unsigned)__builtin_amdgcn_readfirstlane((int)(ldsn + ldsw));
    const int aoff = lds_byte(wr * 64 + fr, fq * 8), boff = lds_byte(wc * 32 + fr, fq * 8);
    unsigned ldsAn = ldsn + (unsigned)aoff, ldsBn = ldsn + (unsigned)(4 * HTB) + (unsigned)boff; asm volatile("" : "+v"(ldsAn), "+v"(ldsBn));
    PG8_LAS unsigned char* const ldsA = (PG8_LAS unsigned char*)(size_t)ldsAn; PG8_LAS unsigned char* const ldsB = (PG8_LAS unsigned char*)(size_t)ldsBn;
#define PG8_SA(b, h) (((b) * 2 + (h)) * HTB)
#define PG8_SB(b, h) ((4 + (b) * 2 + (h)) * HTB)
#define PG8_STAGE(bufoff, gbase, voff) do { if constexpr (FP8 || I8) { const char* gb_ = uni_ptr((const char*)(gbase)); dma16s<(bufoff)>(gb_, (voff)[0], ldsb); dma16s<(bufoff) + 8192>(uni_ptr(gb_ + qstep), (voff)[0], ldsb); }        \
    else { _Pragma("unroll") for (int _i = 0; _i < 2; ++_i) \
        __builtin_amdgcn_global_load_lds((const unsigned*)((const char*)(gbase) + (voff)[_i]), (PG8_LAS unsigned*)(lds + (bufoff) + ldsw + _i * 8192), 16, 0, 0); } } while (0)
#define PG8_LDA(dst, b, h) do { _Pragma("unroll") for (int m = 0; m < 4; ++m) _Pragma("unroll") for (int k = 0; k < 2; ++k) dst[m][k] = *(const PG8_LAS bf16x8*)(lds + PG8_SA(b, h) + aoff + m * 2048 + k * 1024); } while (0)
#define PG8_LDB(dst, b, h) do { _Pragma("unroll") for (int n = 0; n < 2; ++n) _Pragma("unroll") for (int k = 0; k < 2; ++k) dst[n][k] = *(const PG8_LAS bf16x8*)(lds + PG8_SB(b, h) + boff + n * 2048 + k * 1024); } while (0)
#define PG8_LDA8(dst, b, h) do { _Pragma("unroll") for (int m = 0; m < 4; ++m) dst[m] = __builtin_shufflevector(*(const PG8_LAS i32x4*)(ldsA + PG8_SA(b, h) + m * 2048), *(const PG8_LAS i32x4*)(ldsA + PG8_SA(b, h) + m * 2048 + 1024), 0, 1, 2, 3, 4, 5, 6, 7); } while (0)
#define PG8_LDB8(dst, b, h) do { _Pragma("unroll") for (int n = 0; n < 2; ++n) dst[n] = __builtin_shufflevector(*(const PG8_LAS i32x4*)(ldsB + (PG8_SB(b, h) - 4 * HTB) + n * 2048), *(const PG8_LAS i32x4*)(ldsB + (PG8_SB(b, h) - 4 * HTB) + n * 2048 + 1024), 0, 1, 2, 3, 4, 5, 6, 7); } while (0)
#define PG8_MMA8(ai, bj, A8, B8) do { __builtin_amdgcn_s_setprio(1); _Pragma("unroll") for (int m = 0; m < 4; ++m) _Pragma("unroll") for (int n = 0; n < 2; ++n) \
        acc[ai][bj][m][n] = __builtin_amdgcn_mfma_scale_f32_16x16x128_f8f6f4(B8[n], A8[m], acc[ai][bj][m][n], 0, 0, 0, 0, 0, 0); __builtin_amdgcn_s_setprio(0); } while (0)
#define PG8_MMA(ai, bj, At, Bt) do { __builtin_amdgcn_s_setprio(1); _Pragma("unroll") for (int m = 0; m < 4; ++m) _Pragma("unroll") for (int n = 0; n < 2; ++n) _Pragma("unroll") for (int k = 0; k < 2; ++k) { \
        if constexpr (I8) acc[ai][bj][m][n] = __builtin_bit_cast(f32x4, __builtin_amdgcn_mfma_i32_16x16x64_i8(__builtin_bit_cast(i32x4, Bt[n][k]), __builtin_bit_cast(i32x4, At[m][k]), __builtin_bit_cast(i32x4, acc[ai][bj][m][n]), 0, 0, 0)); \
        else acc[ai][bj][m][n] = __builtin_amdgcn_mfma_f32_16x16x32_bf16(Bt[n][k], At[m][k], acc[ai][bj][m][n], 0, 0, 0); } __builtin_amdgcn_s_setprio(0); } while (0)
#define PG8_WAIT_V(n) asm volatile("s_waitcnt vmcnt(" #n ")" ::: "memory")
#define PG8_WAIT_L(n) asm volatile("s_waitcnt lgkmcnt(" #n ")" ::: "memory")
#define PG8_BAR __builtin_amdgcn_s_barrier()
#define PG8_SCHED __builtin_amdgcn_sched_barrier(0)
    Unit cur, nxt; int ui = 0;
    if (!S.next(0, cur)) return;
    f32x4 acc[2][2][4][2];
#pragma unroll
    for (int a = 0; a < 2; ++a)
#pragma unroll
        for (int b = 0; b < 2; ++b)
#pragma unroll
            for (int m = 0; m < 4; ++m)
#pragma unroll
                for (int n = 0; n < 2; ++n) acc[a][b][m][n] = (f32x4){0.f, 0.f, 0.f, 0.f};
    bf16x8 At[4][2], B0[2][2], B1[2][2];
    i32x8 A8[4], B08[2], B18[2];
    const char* cA = (const char*)g.A + (size_t)cur.pm * tstep; const char* cB = (const char*)g.Bt + (size_t)cur.pn * tstep;
    if constexpr (FP8 || I8) { cA = uni_ptr(cA); cB = uni_ptr(cB); }
    S.a_ready(cur);
    if constexpr (SP2) {
        PG8_STAGE(PG8_SB(0, 0), cB, voffB); PG8_STAGE(PG8_SB(0, 1), cB + hstep, voffB); PG8_STAGE(PG8_SA(0, 0), cA, voffA); PG8_STAGE(PG8_SA(0, 1), cA + hstep, voffA);
        if (wr == 1) PG8_BAR;
        PG8_WAIT_V(2); PG8_BAR;
        PG8_STAGE(PG8_SB(1, 0), cB + kstep, voffB); PG8_STAGE(PG8_SA(1, 0), cA + kstep, voffA); PG8_STAGE(PG8_SB(1, 1), cB + hstep + kstep, voffB);
        PG8_WAIT_V(6); PG8_BAR;
    } else {
        PG8_STAGE(PG8_SB(0, 0), cB, voffB); PG8_STAGE(PG8_SA(0, 0), cA, voffA); PG8_STAGE(PG8_SB(0, 1), cB + hstep, voffB); PG8_STAGE(PG8_SA(0, 1), cA + hstep, voffA);
        if (wr == 1) PG8_BAR;
        PG8_WAIT_V(4); PG8_BAR;
        PG8_STAGE(PG8_SB(1, 0), cB + kstep, voffB); PG8_STAGE(PG8_SA(1, 0), cA + kstep, voffA); PG8_STAGE(PG8_SB(1, 1), cB + hstep + kstep, voffB);
        PG8_WAIT_V(6); PG8_BAR;
    }
    for (;;) {
        const bool has_next = S.next(ui + 1, nxt);
        const char* nA = has_next ? (const char*)g.A + (size_t)nxt.pm * tstep : cA; const char* nB = has_next ? (const char*)g.Bt + (size_t)nxt.pn * tstep : cB;
        if constexpr (FP8 || I8) { nA = uni_ptr(nA); nB = uni_ptr(nB); }
        for (int t = 0; t < nt; t += 2) {
            const bool last = (t == nt - 2);
            if constexpr (FP8 || I8) asm volatile("" : "+v"(voffA[0]), "+v"(voffB[0]));
            const char* a1 = cA + (size_t)(t + 1) * kstep;
            const char* a2 = last ? nA : cA + (size_t)(t + 2) * kstep; const char* b2 = last ? nB : cB + (size_t)(t + 2) * kstep;
            const char* a3 = a2 + kstep; const char* b3 = b2 + kstep;
            if (last && has_next) S.a_ready(nxt);
            if constexpr (SP2 && FP8) {
            PG8_LDB8(B08, 0, 0); PG8_LDB8(B18, 0, 1); PG8_SCHED; PG8_LDA8(A8, 0, 0); PG8_STAGE(PG8_SA(1, 1), a1 + hstep, voffA);
            PG8_WAIT_V(8); PG8_WAIT_L(0); PG8_BAR; PG8_MMA8(0, 0, A8, B08); PG8_MMA8(0, 1, A8, B18); PG8_BAR; PG8_SCHED;
            PG8_LDA8(A8, 0, 1); PG8_STAGE(PG8_SB(0, 0), b2, voffB); PG8_STAGE(PG8_SB(0, 1), b2 + hstep, voffB); PG8_STAGE(PG8_SA(0, 0), a2, voffA);
            PG8_WAIT_V(8); PG8_WAIT_L(0); PG8_BAR; PG8_MMA8(1, 0, A8, B08); PG8_MMA8(1, 1, A8, B18); PG8_BAR; PG8_SCHED;
            PG8_LDB8(B08, 1, 0); PG8_LDB8(B18, 1, 1); PG8_SCHED; PG8_LDA8(A8, 1, 0); PG8_STAGE(PG8_SA(0, 1), a2 + hstep, voffA);
            PG8_WAIT_V(8); PG8_WAIT_L(0); PG8_BAR; PG8_MMA8(0, 0, A8, B08); PG8_MMA8(0, 1, A8, B18); PG8_BAR; PG8_SCHED;
            PG8_LDA8(A8, 1, 1); PG8_STAGE(PG8_SB(1, 0), b3, voffB); PG8_STAGE(PG8_SB(1, 1), b3 + hstep, voffB); PG8_STAGE(PG8_SA(1, 0), a3, voffA);
            PG8_WAIT_V(8); PG8_WAIT_L(0); PG8_BAR; PG8_MMA8(1, 0, A8, B08); PG8_MMA8(1, 1, A8, B18); PG8_BAR; PG8_SCHED;
            } else if constexpr (SP2) {
            PG8_LDB(B0, 0, 0); PG8_LDB(B1, 0, 1); PG8_SCHED; PG8_LDA(At, 0, 0); PG8_STAGE(PG8_SA(1, 1), a1 + hstep, voffA);
            PG8_WAIT_V(8); PG8_WAIT_L(0); PG8_BAR; PG8_MMA(0, 0, At, B0); PG8_MMA(0, 1, At, B1); PG8_BAR; PG8_SCHED;
            PG8_LDA(At, 0, 1); PG8_STAGE(PG8_SB(0, 0), b2, voffB); PG8_STAGE(PG8_SB(0, 1), b2 + hstep, voffB); PG8_STAGE(PG8_SA(0, 0), a2, voffA);
            PG8_WAIT_V(8); PG8_WAIT_L(0); PG8_BAR; PG8_MMA(1, 0, At, B0); PG8_MMA(1, 1, At, B1); PG8_BAR; PG8_SCHED;
            PG8_LDB(B0, 1, 0); PG8_LDB(B1, 1, 1); PG8_SCHED; PG8_LDA(At, 1, 0); PG8_STAGE(PG8_SA(0, 1), a2 + hstep, voffA);
            PG8_WAIT_V(8); PG8_WAIT_L(0); PG8_BAR; PG8_MMA(0, 0, At, B0); PG8_MMA(0, 1, At, B1); PG8_BAR; PG8_SCHED;
            PG8_LDA(At, 1, 1); PG8_STAGE(PG8_SB(1, 0), b3, voffB); PG8_STAGE(PG8_SB(1, 1), b3 + hstep, voffB); PG8_STAGE(PG8_SA(1, 0), a3, voffA);
            PG8_WAIT_V(8); PG8_WAIT_L(0); PG8_BAR; PG8_MMA(1, 0, At, B0); PG8_MMA(1, 1, At, B1); PG8_BAR; PG8_SCHED;
            } else {
            PG8_LDB(B0, 0, 0); PG8_SCHED; PG8_LDA(At, 0, 0); PG8_STAGE(PG8_SA(1, 1), a1 + hstep, voffA);
            PG8_WAIT_L(8); PG8_BAR; PG8_WAIT_L(0); PG8_MMA(0, 0, At, B0); PG8_BAR; PG8_SCHED;
            PG8_LDB(B1, 0, 1); PG8_STAGE(PG8_SB(0, 0), b2, voffB);
            PG8_BAR; PG8_WAIT_L(0); PG8_MMA(0, 1, At, B1); PG8_BAR;
            PG8_LDA(At, 0, 1); PG8_STAGE(PG8_SA(0, 0), a2, voffA);
            PG8_BAR; PG8_WAIT_L(0); PG8_MMA(1, 0, At, B0); PG8_BAR; PG8_SCHED;
            PG8_STAGE(PG8_SB(0, 1), b2 + hstep, voffB);
            PG8_WAIT_V(6); PG8_BAR; PG8_MMA(1, 1, At, B1); PG8_BAR;
            PG8_LDB(B0, 1, 0); PG8_SCHED; PG8_LDA(At, 1, 0); PG8_STAGE(PG8_SA(0, 1), a2 + hstep, voffA);
            PG8_WAIT_L(8); PG8_BAR; PG8_WAIT_L(0); PG8_MMA(0, 0, At, B0); PG8_BAR; PG8_SCHED;
            PG8_LDB(B1, 1, 1); PG8_STAGE(PG8_SB(1, 0), b3, voffB);
            PG8_BAR; PG8_WAIT_L(0); PG8_MMA(0, 1, At, B1); PG8_BAR;
            PG8_LDA(At, 1, 1); PG8_STAGE(PG8_SA(1, 0), a3, voffA);
            PG8_BAR; PG8_WAIT_L(0); PG8_MMA(1, 0, At, B0); PG8_BAR; PG8_SCHED;
            PG8_STAGE(PG8_SB(1, 1), b3 + hstep, voffB);
            PG8_WAIT_V(6); PG8_BAR; PG8_MMA(1, 1, At, B1); PG8_BAR;
            }
        }
        if constexpr (ALIGN_EPI) { if (wr == 0) PG8_BAR; }
        if constexpr (!Epi::AFTER_DRAIN) { E(acc, cur, wr, wc, fr, fq); S.done(cur); }
        if (!has_next) break;
#pragma unroll
        for (int a = 0; a < 2; ++a)
#pragma unroll
            for (int b = 0; b < 2; ++b)
#pragma unroll
                for (int m = 0; m < 4; ++m)
#pragma unroll
                    for (int n = 0; n < 2; ++n) acc[a][b][m][n] = (f32x4){0.f, 0.f, 0.f, 0.f};
        cur = nxt; cA = nA; cB = nB; ++ui;
        if constexpr (ALIGN_EPI) { if (wr == 1) PG8_BAR; }
    }
    PG8_WAIT_V(0);
    if constexpr (!ALIGN_EPI) { if (wr == 0) PG8_BAR; }
    PG8_BAR;
    if constexpr (Epi::AFTER_DRAIN) { E.fused(acc, cur, wr, wc, fr, fq, lds, wid, lane); S.done(cur); }
#undef PG8_SA
#undef PG8_SB
#undef PG8_STAGE
#undef PG8_LDA
#undef PG8_LDB
#undef PG8_LDA8
#undef PG8_LDB8
#undef PG8_MMA8
#undef PG8_MMA
#undef PG8_WAIT_V
#undef PG8_WAIT_L
#undef PG8_BAR
#undef PG8_SCHED
}
}
#include <hip/hip_bf16.h>
#include <cmath>
namespace attn_body {
using bf16=__hip_bfloat16;
using bf16x8=__attribute__((ext_vector_type(8)))short;
using s16x4=__attribute__((ext_vector_type(4)))short;
using f32x16=__attribute__((ext_vector_type(16)))float;
using u32x4=__attribute__((ext_vector_type(4)))unsigned;
constexpr int BATCH=4,NHEAD=8,SEQ=4096,D=64,DM=3072,OPITCH=1024;
constexpr int NW=8,QBLK=32,QB=QBLK*NW,KVBLK=64,NQB=SEQ/QB;
constexpr int ATTN_UNIT_ROWS=QB;
__device__ __forceinline__ int crow(int r,int hi){return (r&3)+8*(r>>2)+4*hi;}
#define SBAR() __builtin_amdgcn_sched_barrier(0)
__device__ __forceinline__ void cmask(f32x16&p0,f32x16&p1,int jb,int qrel,int hi){
  const float NEG=-INFINITY; int kb=64*jb+4*hi;
  #pragma unroll
  for(int r=0;r<16;++r){int kv=kb+(r&3)+8*(r>>2); if(kv>qrel)p0[r]=NEG; if(kv+32>qrel)p1[r]=NEG;}
}

constexpr int NSLOT=3, SLOTB=8192;
constexpr int LDS_K=0, LDS_V=NSLOT*SLOTB, LDS_WS=2*NSLOT*SLOTB, LDS_OST=LDS_WS+NW*64*4, LDS_BYTES=LDS_OST+NW*4096;
constexpr float C2=0.125f*1.4426950408889634f;
__device__ __forceinline__ void glds16(const void*gsrc,unsigned lds_dst){unsigned keep;
  asm volatile("s_mov_b32 %0, m0\n\ts_mov_b32 m0, %2\n\ts_nop 0\n\tglobal_load_lds_dwordx4 %1, off\n\ts_mov_b32 m0, %0":"=&s"(keep):"v"(gsrc),"s"(lds_dst):"memory");}
__device__ __forceinline__ void glds16s(const void*sbase,unsigned voff,unsigned lds_dst){unsigned keep;
  asm volatile("s_mov_b32 %0, m0\n\ts_mov_b32 m0, %3\n\ts_nop 0\n\tglobal_load_lds_dwordx4 %1, %2\n\ts_mov_b32 m0, %0":"=&s"(keep):"v"(voff),"s"(sbase),"s"(lds_dst):"memory");}
__device__ __forceinline__ float max3f(float a,float b,float c){float r;asm("v_max3_f32 %0, %1, %2, %3":"=v"(r):"v"(a),"v"(b),"v"(c));return r;}
__device__ __forceinline__ float max2f(float a,float b){float r;asm("v_max_f32_e32 %0, %1, %2":"=v"(r):"v"(a),"v"(b));return r;}
__device__ __forceinline__ float fadd_s(float a,float b){float r;asm("v_add_f32_e32 %0, %1, %2":"=v"(r):"v"(a),"v"(b));return r;}
__device__ __forceinline__ float fsub_s(float a,float b){float r;asm("v_sub_f32_e32 %0, %1, %2":"=v"(r):"v"(a),"v"(b));return r;}
typedef float f32x2_t __attribute__((ext_vector_type(2))); typedef __bf16 bf16x2_t __attribute__((ext_vector_type(2)));
__device__ __forceinline__ unsigned cvtpk_s(float lo,float hi){f32x2_t v={lo,hi};bf16x2_t b=__builtin_convertvector(v,bf16x2_t);return __builtin_bit_cast(unsigned,b);}
#define WAIT_BAR(N) asm volatile("s_waitcnt vmcnt(" #N ") lgkmcnt(0)\n\ts_barrier":::"memory")

__device__ __forceinline__ void qkt(f32x16&p0,f32x16&p1,const char*Kslot,const bf16x8*qr,int r32,int hi){
  const f32x16 negm=f32x16{};
  const char*kb=Kslot+hi*1024+r32*16;
  #pragma unroll
  for(int d0=0;d0<4;++d0){
    const bf16x8 b0=*reinterpret_cast<const bf16x8*>(kb+d0*2048);
    const bf16x8 b1=*reinterpret_cast<const bf16x8*>(kb+d0*2048+512);
    if(d0==0){p0=__builtin_amdgcn_mfma_f32_32x32x16_bf16(b0,qr[0],negm,0,0,0);p1=__builtin_amdgcn_mfma_f32_32x32x16_bf16(b1,qr[0],negm,0,0,0);}
    else{p0=__builtin_amdgcn_mfma_f32_32x32x16_bf16(b0,qr[d0],p0,0,0,0);p1=__builtin_amdgcn_mfma_f32_32x32x16_bf16(b1,qr[d0],p1,0,0,0);}}
}
typedef __attribute__((address_space(3))) const char* lds_cptr;
typedef short v4i16_t __attribute__((ext_vector_type(4)));
__device__ __forceinline__ void kload8(bf16x8*kf,lds_cptr kp){
  kf[0]=*(const __attribute__((address_space(3))) bf16x8*)(kp);      kf[1]=*(const __attribute__((address_space(3))) bf16x8*)(kp+512);
  kf[2]=*(const __attribute__((address_space(3))) bf16x8*)(kp+2048); kf[3]=*(const __attribute__((address_space(3))) bf16x8*)(kp+2560);
  kf[4]=*(const __attribute__((address_space(3))) bf16x8*)(kp+4096); kf[5]=*(const __attribute__((address_space(3))) bf16x8*)(kp+4608);
  kf[6]=*(const __attribute__((address_space(3))) bf16x8*)(kp+6144); kf[7]=*(const __attribute__((address_space(3))) bf16x8*)(kp+6656);
}
__device__ __forceinline__ void kload2(bf16x8*kf,lds_cptr kp,int j){ kf[2*j]=*(const __attribute__((address_space(3))) bf16x8*)(kp+j*2048); kf[2*j+1]=*(const __attribute__((address_space(3))) bf16x8*)(kp+j*2048+512); }
__device__ __forceinline__ s16x4 vtr(lds_cptr p){ return __builtin_bit_cast(s16x4,__builtin_amdgcn_ds_read_tr16_b64_v4i16((__attribute__((address_space(3))) v4i16_t*)p)); }
__device__ __forceinline__ float rowmax(const f32x16&p0,const f32x16&p1){
  float a=max3f(p0[0],p0[1],p1[0]),b=max3f(p0[2],p0[3],p1[1]);a=max3f(a,p1[2],p1[3]);
  #pragma unroll
  for(int r=4;r<16;r+=4){a=max3f(a,p0[r],p0[r+1]);b=max3f(b,p0[r+2],p0[r+3]);a=max3f(a,p1[r],p1[r+1]);b=max3f(b,p1[r+2],p1[r+3]);}
  const float m=max2f(a,b);
  auto rr=__builtin_amdgcn_permlane32_swap(__float_as_uint(m),__float_as_uint(m),false,false);
  return max2f(__uint_as_float(rr[0]),__uint_as_float(rr[1]));
}
__device__ __forceinline__ void pv(f32x16*o,int vb,bf16x8 pa0,bf16x8 pa1,bf16x8 pa2,bf16x8 pa3){
  #pragma unroll
  for(int d0=0;d0<2;++d0){s16x4 lo[4],hi[4];
    #pragma unroll
    for(int ks=0;ks<4;++ks){
      asm volatile("ds_read_b64_tr_b16 %0,%1 offset:%c2":"=&v"(lo[ks]):"v"(vb),"i"(d0*4096+ks*1024):"memory");
      asm volatile("ds_read_b64_tr_b16 %0,%1 offset:%c2":"=&v"(hi[ks]):"v"(vb),"i"(d0*4096+ks*1024+512):"memory");}
    asm volatile("s_waitcnt lgkmcnt(0)":::"memory");SBAR();
    #define PK(k) (bf16x8){lo[k][0],lo[k][1],lo[k][2],lo[k][3],hi[k][0],hi[k][1],hi[k][2],hi[k][3]}
    o[d0]=__builtin_amdgcn_mfma_f32_32x32x16_bf16(pa0,PK(0),o[d0],0,0,0);
    o[d0]=__builtin_amdgcn_mfma_f32_32x32x16_bf16(pa1,PK(1),o[d0],0,0,0);
    o[d0]=__builtin_amdgcn_mfma_f32_32x32x16_bf16(pa2,PK(2),o[d0],0,0,0);
    o[d0]=__builtin_amdgcn_mfma_f32_32x32x16_bf16(pa3,PK(3),o[d0],0,0,0);
    #undef PK
  }
}

#define ATTN_YQ (127.f/6.f)
#ifndef ATTN_STORE16
#define ATTN_STORE16(p,v) st16_wt((p),(v))
#endif
template<int THRL> __device__ __forceinline__ void attn_unit(int b,int h,int qb,const bf16*Q,const bf16*__restrict__ K,const bf16*__restrict__ V,bf16*O,const float*KSUM,const float*GG,char*shm){
  int tid_=threadIdx.x; asm volatile("":"+v"(tid_)); const int tid=tid_,lane=tid&63,r32=lane&31,hi=lane>>5; const int wid=__builtin_amdgcn_readfirstlane(tid>>6);
  const long rowbase=(long)b*SEQ; const int q0=qb*QB;
  const bf16*Qw=Q+(rowbase+q0+wid*QBLK)*DM+h*D;
  const bf16*Kh=K+rowbase*DM+h*D,*Vh=V+rowbase*DM+h*D;
  const unsigned lds0=(unsigned)(uintptr_t)shm;
  float*wsf=(float*)(shm+LDS_WS)+wid*64;
  const unsigned koff=(unsigned)((lane*DM+wid*8)*2);
  const unsigned voffs=(unsigned)(((16*(wid&3)+(lane>>2))*DM+(wid>>2)*32+(lane&3)*8)*2);
  const unsigned kdst=lds0+LDS_K+wid*1024, vdst=lds0+LDS_V+wid*1024;
  #define PT(t) (((t)<4)?(NT-4+(t)):((t)-4))
  #define DMA_K(t,slot) glds16s((const char*)Kh+(long)PT(t)*(KVBLK*DM*2),koff,(unsigned)__builtin_amdgcn_readfirstlane(kdst+(slot)))
  #define DMA_V(t,slot) glds16s((const char*)Vh+(long)PT(t)*(KVBLK*DM*2),voffs,(unsigned)__builtin_amdgcn_readfirstlane(vdst+(slot)))
  const int vb0=(int)(lds0+LDS_V)+((lane>>4)&1)*32+(lane&3)*8+(4*hi+((lane&15)>>2))*64;
  const char*Kbase=shm+LDS_K; bf16x8 kf[8];
  const lds_cptr shm3=(lds_cptr)shm; const lds_cptr kp0=shm3+LDS_K+hi*1024+r32*16; const lds_cptr vp0=shm3+LDS_V+((lane>>4)&1)*32+(lane&3)*8+(4*hi+((lane&15)>>2))*64;
  const int NT=(q0+QB)/KVBLK;
  DMA_K(0,0);DMA_V(0,0);DMA_K(1,SLOTB);
  bf16x8 qr[4];
  #pragma unroll
  for(int d0=0;d0<4;++d0)qr[d0]=*reinterpret_cast<const bf16x8*>(&Qw[(long)r32*DM+d0*16+hi*8]);
  float mhat=0.f,l_reg=0.f;f32x16 o[2];o[0]=f32x16{};o[1]=f32x16{};const f32x16 z16=f32x16{};
  unsigned selm=(1u<<qb)-1u;
  if(qb>3){
    f32x16 gt=f32x16{};
    #pragma unroll
    for(int d0=0;d0<4;++d0){ const float*kp=KSUM+((long)(b*16+(r32&15)))*512+h*D+d0*16+hi*8;
      const float4 k0=*reinterpret_cast<const float4*>(kp),k1=*reinterpret_cast<const float4*>(kp+4);
      u32x4 kw; kw.x=cvtpk_s(k0.x,k0.y);kw.y=cvtpk_s(k0.z,k0.w);kw.z=cvtpk_s(k1.x,k1.y);kw.w=cvtpk_s(k1.z,k1.w);
      gt=__builtin_amdgcn_mfma_f32_32x32x16_bf16(__builtin_bit_cast(bf16x8,kw),qr[d0],gt,0,0,0); }
    float v0=-INFINITY,v1=-INFINITY,v2=-INFINITY; int i0=0,i1=0,i2=0;
    #define INS3(vv,ii) do{ const float x_=(vv); const int j_=(ii); \
      if(x_>v0){v2=v1;i2=i1;v1=v0;i1=i0;v0=x_;i0=j_;} else if(x_>v1){v2=v1;i2=i1;v1=x_;i1=j_;} else if(x_>v2){v2=x_;i2=j_;} }while(0)
    #pragma unroll
    for(int r=0;r<8;++r){ const int j=crow(r,hi); INS3(j<qb?gt[r]:-INFINITY,j); }
    const float p0=__shfl_xor(v0,32),p1=__shfl_xor(v1,32),p2=__shfl_xor(v2,32); const int q0i=__shfl_xor(i0,32),q1i=__shfl_xor(i1,32),q2i=__shfl_xor(i2,32);
    INS3(p0,q0i); INS3(p1,q1i); INS3(p2,q2i);
    #undef INS3
    selm=(1u<<i0)|(1u<<i1)|(1u<<i2);
  }
  const int qrel=wid*QBLK+r32;
  #define CMASK(P0,P1,t) do{ if((t)<4)cmask(P0,P1,(t),qrel,hi); }while(0)
  bool resc=false;
  #define START(P0,P1) do{ const float rm=rowmax(P0,P1); resc=false; \
    { const float dl=rm; mhat=fadd_s(mhat,dl); \
      _Pragma("unroll") for(int r=0;r<16;++r){P0[r]=fsub_s(P0[r],dl);P1[r]=fsub_s(P1[r],dl);} \
      } \
    _Pragma("unroll") for(int r=0;r<16;++r)P0[r]=__builtin_amdgcn_exp2f(P0[r]); }while(0)
  #define RESC() do{ if(resc){ asm volatile("s_waitcnt lgkmcnt(0)":::"memory"); \
      _Pragma("unroll") for(int d_=0;d_<2;++d_) _Pragma("unroll") for(int r=0;r<16;++r)o[d_][r]*=wsf[crow(r,hi)]; } }while(0)
  f32x16 pA0,pA1,pB0,pB1;
  int sl_prev=0,sl_cur=0,sl_next=SLOTB;
  #define ROT() do{sl_prev=sl_cur;sl_cur=sl_next;sl_next=(sl_next==(NSLOT-1)*SLOTB)?0:sl_next+SLOTB;}while(0)
  DMA_K(2,2*SLOTB);
  WAIT_BAR(3);
  qkt(pA0,pA1,Kbase,qr,r32,hi);asm volatile("s_nop 15\n\ts_nop 7":"+v"(pA0),"+v"(pA1));CMASK(pA0,pA1,0);
  START(pA0,pA1);
  _Pragma("unroll") for(int r=0;r<16;++r)pA1[r]=__builtin_amdgcn_exp2f(pA1[r]);
  WAIT_BAR(0);
  DMA_K(3,0);DMA_V(1,SLOTB);
  ROT();
  kload8(kf,kp0+sl_cur);
  WAIT_BAR(2);
  s16x4 vlo[8],vhi[8]; u32x4 pw0,pw1,pw2,pw3;
  #define PKW(P,B) cvtpk_s(P[B],P[B+1])
  #define PAF(k) __builtin_bit_cast(bf16x8,pw##k)
  #define VFR(i) (bf16x8){vlo[i][0],vlo[i][1],vlo[i][2],vlo[i][3],vhi[i][0],vhi[i][1],vhi[i][2],vhi[i][3]}
  #define PIN(x) asm volatile("":"+v"(x))
  #define MX3(a,b,c) __builtin_fmaxf(__builtin_fmaxf((a),(b)),(c))
  #define GAPA(MF,A0,A1,A2,A3,W0,W1,PW) do{ MF; sacc+=A0; sacc+=A1; sacc+=A2; sacc+=A3; PIN(sacc); W0; W1; PIN(PW); SBAR(); }while(0)
  #define EX(v) __builtin_amdgcn_exp2f(v)
  #define GAPB(MF,X,B) do{ MF; X[B]=EX(X[B]); X[B+1]=EX(X[B+1]); X[B+2]=EX(X[B+2]); X[B+3]=EX(X[B+3]); PIN(X); SBAR(); }while(0)
  #define VRD(i) do{ vlo[i]=vtr(vp_+(((i)>>2)*4096+((i)&3)*1024)); vhi[i]=vtr(vp_+(((i)>>2)*4096+((i)&3)*1024+512)); }while(0)
  #define KRD(G,j) do{ if(G){ kload2(kf,kp0+sl_next,j); SBAR(); } }while(0)
  #define STEP(C0,C1,P0,P1,t,GK,GV,GL) do{ SBAR(); \
    const lds_cptr vp_=vp0+sl_prev; \
    VRD(0); SBAR(); float sacc=(P0[0]+P0[1]); \
    GAPA(C0=__builtin_amdgcn_mfma_f32_32x32x16_bf16(kf[0],qr[0],z16,0,0,0), P0[2],P0[3],P0[4],P0[5],     pw0[0]=PKW(P0,0), pw0[1]=PKW(P0,2), pw0); \
    VRD(4); SBAR(); GAPA(C1=__builtin_amdgcn_mfma_f32_32x32x16_bf16(kf[1],qr[0],z16,0,0,0), P0[6],P0[7],P0[8],P0[9],     pw0[2]=PKW(P0,4), pw0[3]=PKW(P0,6), pw0); \
    VRD(1); SBAR(); GAPA(C0=__builtin_amdgcn_mfma_f32_32x32x16_bf16(kf[2],qr[1],C0,0,0,0),   P0[10],P0[11],P0[12],P0[13], pw1[0]=PKW(P0,8), pw1[1]=PKW(P0,10), pw1); \
    VRD(5); SBAR(); GAPA(C1=__builtin_amdgcn_mfma_f32_32x32x16_bf16(kf[3],qr[1],C1,0,0,0),   P0[14],P0[15],P1[0],P1[1],   pw1[2]=PKW(P0,12),pw1[3]=PKW(P0,14), pw1); \
    VRD(2); SBAR(); GAPA(C0=__builtin_amdgcn_mfma_f32_32x32x16_bf16(kf[4],qr[2],C0,0,0,0),   P1[2],P1[3],P1[4],P1[5],     pw2[0]=PKW(P1,0), pw2[1]=PKW(P1,2), pw2); \
    VRD(6); SBAR(); GAPA(C1=__builtin_amdgcn_mfma_f32_32x32x16_bf16(kf[5],qr[2],C1,0,0,0),   P1[6],P1[7],P1[8],P1[9],     pw2[2]=PKW(P1,4), pw2[3]=PKW(P1,6), pw2); \
    VRD(3); SBAR(); GAPA(C0=__builtin_amdgcn_mfma_f32_32x32x16_bf16(kf[6],qr[3],C0,0,0,0),   P1[10],P1[11],P1[12],P1[13], pw3[0]=PKW(P1,8), pw3[1]=PKW(P1,10), pw3); \
    VRD(7); SBAR(); GAPA(C1=__builtin_amdgcn_mfma_f32_32x32x16_bf16(kf[7],qr[3],C1,0,0,0),   P1[14],P1[15],0.f,0.f,       pw3[2]=PKW(P1,12),pw3[3]=PKW(P1,14), pw3); \
    l_reg+=sacc; \
    if(GK){DMA_K((t)+3,sl_cur);} if(GV){DMA_V((t)+1,sl_next);} \
    { const bool v_=((t)<4)||((selm>>(((t)-4)>>2))&1u); const float nm_=v_?-mhat:-INFINITY; \
      _Pragma("unroll") for(int r=0;r<16;++r){C0[r]+=nm_;C1[r]+=nm_;} } \
    CMASK(C0,C1,t); \
    { float a=MX3(C0[0],C0[1],C1[0]),b=MX3(C0[2],C0[3],C1[1]); a=MX3(a,C1[2],C1[3]); \
      _Pragma("unroll") for(int r=4;r<16;r+=4){a=MX3(a,C0[r],C0[r+1]);b=MX3(b,C0[r+2],C0[r+3]);a=MX3(a,C1[r],C1[r+1]);b=MX3(b,C1[r+2],C1[r+3]);} \
      float rm=__builtin_fmaxf(a,b); { auto rr=__builtin_amdgcn_permlane32_swap(__float_as_uint(rm),__float_as_uint(rm),false,false); rm=__builtin_fmaxf(__uint_as_float(rr[0]),__uint_as_float(rr[1])); } \
      resc=false; \
      if(__builtin_expect(__any(rm>(float)THRL),0)){ const float dl=__builtin_fmaxf(rm,0.f); mhat+=dl; \
        _Pragma("unroll") for(int r=0;r<16;++r){C0[r]-=dl;C1[r]-=dl;} \
        const float f=__builtin_amdgcn_exp2f(-dl); l_reg*=f; if(hi==0)wsf[r32]=f; resc=true; } } \
    SBAR(); \
    GAPB(o[0]=__builtin_amdgcn_mfma_f32_32x32x16_bf16(PAF(0),VFR(0),o[0],0,0,0), C0,0); \
    GAPB(o[1]=__builtin_amdgcn_mfma_f32_32x32x16_bf16(PAF(0),VFR(4),o[1],0,0,0), C0,4); \
    KRD(GL,0); GAPB(o[0]=__builtin_amdgcn_mfma_f32_32x32x16_bf16(PAF(1),VFR(1),o[0],0,0,0), C0,8); \
    KRD(GL,1); GAPB(o[1]=__builtin_amdgcn_mfma_f32_32x32x16_bf16(PAF(1),VFR(5),o[1],0,0,0), C0,12); \
    KRD(GL,2); GAPB(o[0]=__builtin_amdgcn_mfma_f32_32x32x16_bf16(PAF(2),VFR(2),o[0],0,0,0), C1,0); \
    KRD(GL,3); GAPB(o[1]=__builtin_amdgcn_mfma_f32_32x32x16_bf16(PAF(2),VFR(6),o[1],0,0,0), C1,4); \
    GAPB(o[0]=__builtin_amdgcn_mfma_f32_32x32x16_bf16(PAF(3),VFR(3),o[0],0,0,0), C1,8); \
    GAPB(o[1]=__builtin_amdgcn_mfma_f32_32x32x16_bf16(PAF(3),VFR(7),o[1],0,0,0), C1,12); \
    }while(0)
  int t=1;
  #define ENDW(tt) do{ if((tt)+3<NT){WAIT_BAR(2);} else if((tt)+2<NT){WAIT_BAR(1);} else {WAIT_BAR(0);} }while(0)
  for(;t<5&&t+1<NT;t+=2){
    STEP(pB0,pB1,pA0,pA1,t,(t+3<NT),(t+1<NT),(t+1<NT));       ENDW(t);   RESC(); ROT();
    STEP(pA0,pA1,pB0,pB1,t+1,(t+4<NT),(t+2<NT),(t+2<NT));     ENDW(t+1); RESC(); ROT();
  }
  #undef CMASK
  #define CMASK(P0,P1,t) do{}while(0)
  for(;t+5<NT;t+=2){
    STEP(pB0,pB1,pA0,pA1,t,true,true,true);     WAIT_BAR(2); RESC(); ROT();
    STEP(pA0,pA1,pB0,pB1,t+1,true,true,true);   WAIT_BAR(2); RESC(); ROT();
  }
  #undef CMASK
  #define CMASK(P0,P1,t) do{ if((t)<4)cmask(P0,P1,(t),qrel,hi); }while(0)
  for(;t+1<NT;t+=2){
    STEP(pB0,pB1,pA0,pA1,t,(t+3<NT),(t+1<NT),(t+1<NT));       ENDW(t);   RESC(); ROT();
    STEP(pA0,pA1,pB0,pB1,t+1,(t+4<NT),(t+2<NT),(t+2<NT));     ENDW(t+1); RESC(); ROT();
  }
  STEP(pB0,pB1,pA0,pA1,NT-1,false,false,false); RESC();
  { float sacc=pB0[0]+pB0[1]; _Pragma("unroll") for(int r=2;r<16;++r)sacc+=pB0[r]; _Pragma("unroll") for(int r=0;r<16;++r)sacc+=pB1[r]; l_reg+=sacc;
    pw0=(u32x4){PKW(pB0,0),PKW(pB0,2),PKW(pB0,4),PKW(pB0,6)};pw1=(u32x4){PKW(pB0,8),PKW(pB0,10),PKW(pB0,12),PKW(pB0,14)};pw2=(u32x4){PKW(pB1,0),PKW(pB1,2),PKW(pB1,4),PKW(pB1,6)};pw3=(u32x4){PKW(pB1,8),PKW(pB1,10),PKW(pB1,12),PKW(pB1,14)};
    SBAR(); pv(o,vb0+sl_cur,PAF(0),PAF(1),PAF(2),PAF(3)); }
  #undef PKW
  #undef PAF
  #undef VFR
  #undef PIN
  #undef MX3
  #undef GAPA
  #undef GAPB
  #undef EX
  #undef VRD
  #undef KRD
  #undef STEP
  #undef ENDW
  {auto rr=__builtin_amdgcn_permlane32_swap(__float_as_uint(l_reg),__float_as_uint(l_reg),false,false);l_reg=__uint_as_float(rr[0])+__uint_as_float(rr[1]);}
  if(hi==0)wsf[32+r32]=l_reg;asm volatile("s_waitcnt lgkmcnt(0)":::"memory");
  float rli[16];
  #pragma unroll
  for(int r=0;r<16;++r)rli[r]=__builtin_amdgcn_rcpf(wsf[32+crow(r,hi)]);
  bf16*Ow=O+(rowbase+q0+wid*QBLK)*OPITCH+h*D;
  { bf16*stg=(bf16*)(shm+LDS_OST)+wid*2048;
    #pragma unroll
    for(int r=0;r<16;++r){const int orow=crow(r,hi);
      #pragma unroll
      for(int d0=0;d0<2;++d0)stg[orow*64+d0*32+r32]=__float2bfloat16(o[d0][r]*rli[r]);}
    asm volatile("s_waitcnt lgkmcnt(0)":::"memory");
    const int ch=lane&7; float gg[8];
    #pragma unroll
    for(int i=0;i<8;++i)gg[i]=GG[h*D+ch*8+i];
    #pragma unroll
    for(int i=0;i<4;++i){const int row=i*8+(lane>>3); const u32x4 v=*(const u32x4*)(stg+row*64+ch*8);
      float x[8]; x[0]=__uint_as_float(v.x<<16);x[1]=__uint_as_float(v.x&0xffff0000u);x[2]=__uint_as_float(v.y<<16);x[3]=__uint_as_float(v.y&0xffff0000u);
      x[4]=__uint_as_float(v.z<<16);x[5]=__uint_as_float(v.z&0xffff0000u);x[6]=__uint_as_float(v.w<<16);x[7]=__uint_as_float(v.w&0xffff0000u);
      float ss=0.f;
      #pragma unroll
      for(int k=0;k<8;++k)ss+=x[k]*x[k];
      ss+=__shfl_xor(ss,1);ss+=__shfl_xor(ss,2);ss+=__shfl_xor(ss,4);
      const float rs=rsqrtf(ss*(1.f/64.f)+1e-6f);
      const float qn=rs*ATTN_YQ; unsigned w0=0u,w1=0u;
      #pragma unroll
      for(int k=0;k<4;++k){const int a=(int)fminf(fmaxf(__builtin_rintf(x[k]*qn),-127.f),127.f),b=(int)fminf(fmaxf(__builtin_rintf(x[4+k]*qn),-127.f),127.f); w0|=((unsigned)a&0xffu)<<(8*k); w1|=((unsigned)b&0xffu)<<(8*k);}
      st8_wt((void*)((unsigned char*)O+((rowbase+q0+wid*QBLK+row)*(long)OPITCH+h*D+ch*8)),(unsigned long long)w0|((unsigned long long)w1<<32));} }
  asm volatile("s_waitcnt lgkmcnt(0)\n\ts_barrier":::"memory");
  #undef DMA_K
  #undef PT
  #undef DMA_V
  #undef CMASK
  #undef START
  #undef RESC
  #undef ROT
}
constexpr int ATTN_LDS_BYTES=LDS_BYTES;
struct AttnTensors { const bf16* Q; const bf16* K; const bf16* V; bf16* O; const float* KSUM; const float* GG; };
struct AttnUnit { int bh; int qb; };
struct StaticOrder {
  int vcu,G;
  __device__ __forceinline__ explicit StaticOrder(int grid,int block):vcu((grid%8==0)?(block%8)*(grid/8)+block/8:block),G(grid){}
  __device__ __forceinline__ bool next(int i,AttnUnit&u)const{ const int pr=vcu+(i>>1)*G; if(pr>=256)return false; const int s=pr&7; u.bh=pr>>3; u.qb=(i&1)?s:15-s; return true; }
  __device__ __forceinline__ void a_ready(const AttnUnit&)const{}
  __device__ __forceinline__ void done(const AttnUnit&)const{}
};
template<class Sched,int THRL=8> __device__ __forceinline__ void attn_phase(char*lds,const AttnTensors&T,const Sched&S){
  AttnUnit u;
  for(int i=0;S.next(i,u);++i){ S.a_ready(u); attn_unit<THRL>(u.bh/NHEAD,u.bh%NHEAD,u.qb,T.Q,T.K,T.V,T.O,T.KSUM,T.GG,lds); S.done(u); }
}
#undef SBAR
#undef WAIT_BAR
}

#define GAS __attribute__((address_space(1)))
#define LAS __attribute__((address_space(3)))
typedef unsigned short bf16;
typedef unsigned v4u __attribute__((ext_vector_type(4)));
typedef float f32x4 __attribute__((ext_vector_type(4)));
typedef short bf16x8 __attribute__((ext_vector_type(8)));
typedef GAS unsigned gu32;
typedef GAS unsigned long long gu64;
#define RLX_AGENT __ATOMIC_RELAXED, __HIP_MEMORY_SCOPE_AGENT
#define LDS_WAIT() asm volatile("s_waitcnt lgkmcnt(0)" ::: "memory")
#define VM_WAIT() asm volatile("s_waitcnt vmcnt(0)" ::: "memory")
__device__ __forceinline__ unsigned long long rt() { return __builtin_amdgcn_s_memrealtime(); }
__device__ __forceinline__ unsigned f2bf(float f) { unsigned u = __builtin_bit_cast(unsigned, f); return (u + 0x7fffu + ((u >> 16) & 1u)) >> 16; }
__device__ __forceinline__ unsigned pk2(float lo, float hi) { return f2bf(lo) | (f2bf(hi) << 16); }

#define XB_TMO      128
#define XB_XCNT(j)  (256  + 64 * (j))
#define XB_XSUB(j)  (1280 + 64 * (j))
#define XB_XGEN(j)  (2304 + 64 * (j))
#define XB_TOP      3328
#define XB_TOPGEN   3392
#define XCD_BAR_WORDS 3456
#define XB_SPIN_CAP (1u << 18)

__device__ __forceinline__ unsigned xb_ld(unsigned* p)              { return __hip_atomic_load(p, __ATOMIC_RELAXED, __HIP_MEMORY_SCOPE_AGENT); }
__device__ __forceinline__ unsigned xb_add(unsigned* p, unsigned v) { return __hip_atomic_fetch_add(p, v, __ATOMIC_RELAXED, __HIP_MEMORY_SCOPE_AGENT); }
__device__ __forceinline__ unsigned xb_xcc_id() { return (unsigned)__builtin_amdgcn_s_getreg((3 << 11) | 20) & 0xFu; }
#define XB_SPIN(cond, bar) do { unsigned _sp = 0; while (cond) { __builtin_amdgcn_s_sleep(1); \
    if ((++_sp & 255u) == 0u) { if (xb_ld(&(bar)[XB_TMO])) break; if (_sp > XB_SPIN_CAP) { atomicAdd(&(bar)[XB_TMO], 1u); break; } } } } while (0)

struct XcdBarrier {
    unsigned* bar; unsigned x;
    volatile LAS unsigned* st;
};

__device__ __forceinline__ XcdBarrier xcd_barrier_post(unsigned* bar, volatile LAS unsigned* st) {
    XcdBarrier b; b.bar = bar; b.x = xb_xcc_id(); b.st = st;
    if (threadIdx.x == 0) (void)xb_add(&bar[XB_XCNT(b.x)], 1u);
    return b;
}
__device__ __forceinline__ void xcd_barrier_complete(unsigned* bar, unsigned x, unsigned& nloc, unsigned& nx) {
    const unsigned G = gridDim.x * gridDim.y * gridDim.z;
    unsigned sum, cnt, mine, sp = 0u;
    for (;;) {
        sum = 0u; cnt = 0u; mine = 0u;
#pragma unroll
        for (unsigned j = 0; j < 16; ++j) { const unsigned c = xb_ld(&bar[XB_XCNT(j)]); sum += c; cnt += (c > 0u) ? 1u : 0u; mine = (j == x) ? c : mine; }
        if (sum == G) break;
        __builtin_amdgcn_s_sleep(1);
        if ((++sp & 255u) == 0u) { if (xb_ld(&bar[XB_TMO])) break; if (sp > XB_SPIN_CAP) { atomicAdd(&bar[XB_TMO], 1u); break; } }
    }
    nloc = mine > 0u ? mine : 1u; nx = cnt > 0u ? cnt : 1u;
}

__device__ __forceinline__ void xcd_barrier(const XcdBarrier& b) {
    asm volatile("s_waitcnt vmcnt(0)" ::: "memory");
    __syncthreads();
    if (threadIdx.x == 0) {
        unsigned* bar = b.bar;
        __builtin_amdgcn_s_waitcnt(0);
        unsigned nloc = b.st[0], nx = b.st[1];
        if (nloc == 0u) { xcd_barrier_complete(bar, b.x, nloc, nx); b.st[0] = nloc; b.st[1] = nx; }
        const unsigned old = xb_add(&bar[XB_XSUB(b.x)], 1u);
        const unsigned gen = old / nloc;
        if (old + 1u == (gen + 1u) * nloc) {
            asm volatile("s_waitcnt vmcnt(0)" ::: "memory");
            const unsigned og = xb_add(&bar[XB_TOP], 1u);
            const unsigned tg = og / nx;
            if (og + 1u == (tg + 1u) * nx) xb_add(&bar[XB_TOPGEN], 1u);
            else XB_SPIN(xb_ld(&bar[XB_TOPGEN]) == tg, bar);
            __builtin_amdgcn_fence(__ATOMIC_ACQUIRE, "agent");
            xb_add(&bar[XB_XGEN(b.x)], 1u);
            asm volatile("s_waitcnt vmcnt(0)" ::: "memory");
        } else {
            XB_SPIN(xb_ld(&bar[XB_XGEN(b.x)]) == gen, bar);
            __builtin_amdgcn_fence(__ATOMIC_ACQUIRE, "agent");
            asm volatile("s_waitcnt vmcnt(0)" ::: "memory");
        }
    }
    __syncthreads();
}

constexpr int NWAVES = 8;
constexpr int NB = 4, S = 4096, D = 1024, M = NB * S;
constexpr int NIN = 3072, NQ = 2048, NEXP = 16384;
constexpr float EPS = 1e-6f;
constexpr float C2 = 0.125f * 1.4426950408889634f;

constexpr size_t MiB = 1u << 20;
constexpr size_t WS_CTL = 0, CTL_ZERO_BYTES = 256 * 1024;
constexpr size_t WS_MOD = 1 * MiB;
constexpr size_t WS_KMEAN = 128 * 1024;
constexpr size_t WS_KEYS = 1 * MiB + 512 * 1024;
constexpr size_t WS_WIN = 2 * MiB, WS_WO = 8 * MiB, WS_WQ = 10 * MiB;
constexpr size_t WS_EIDX = 14 * MiB, WS_G = 22 * MiB;
constexpr size_t WS_U = 32 * MiB, WS_V = 64 * MiB;
constexpr size_t WS_SU = 48 * MiB, WS_SV = 48 * MiB + 64 * 1024;
constexpr size_t WS_H = 96 * MiB;
constexpr size_t WS_P = 128 * MiB;
constexpr size_t WS_QP = 128 * MiB, WS_O = 192 * MiB;
constexpr size_t WS_Y = 224 * MiB, WS_END = 256 * MiB;
constexpr int CW_BAR = 1024;
constexpr int CW_CMAX = 8192;
constexpr int CW_CMAX3 = CW_CMAX + 3072 + 2048;
constexpr float YQ = 127.f / 6.f;
constexpr int CW_CMAX2 = CW_CMAX + 3072;
constexpr size_t WS_WO8 = 47 * MiB;
constexpr size_t WS_WQ8 = 45 * MiB, WS_RS2 = 44 * MiB + 65536;
constexpr size_t WS_WIN8 = 40 * MiB, WS_RS = 44 * MiB;

constexpr int LDS_BYTES = 153600;
constexpr int LDSCTL_OFF = LDS_BYTES - 512, MISC_OFF = LDSCTL_OFF + 320;
constexpr int RING_BYTES = 131072;

struct Frame {
    LAS unsigned char* lds;
    volatile LAS unsigned* MISC;
    gu32* ctl;
    int tid, lane, wave, G;
    const float *x, *c, *ada_w, *ada_b, *pre_gain, *post_gain, *w_in, *conv_w, *group_gain, *w_out, *fpre_gain, *fpost_gain, *wq, *keys, *pu, *pv;
    float* out;
    float* mod; float* kmean; bf16* keysb; bf16 *WinT, *WoT, *WqT; int* eidx; float* gw; unsigned char *U8, *V8; float *su, *sv; bf16 *H, *P, *QP, *O, *Y; float* scratch; unsigned char* Win8; float* rs; unsigned char* Wq8; float* rs2; unsigned char* Wo8;
};

__device__ __forceinline__ float wave_sum(float v) {
#pragma unroll
    for (int o = 1; o < 64; o <<= 1) v += __shfl_xor(v, o);
    return v;
}
__device__ __forceinline__ float bflo(unsigned u) { return __uint_as_float(u << 16); }
__device__ __forceinline__ float bfhi(unsigned u) { return __uint_as_float(u & 0xffff0000u); }

template <bool CMAX = false, bool KSC = false> __device__ __forceinline__ void p0_transpose_item(const float* W, int K, int N, bf16* WT, LAS float* scr, int item, int lane, unsigned* cmax = nullptr, const float* ksc = nullptr) {
    const int nblk = N / 32, kb = item / nblk, nb = item % nblk, k0 = 64 * kb, n0 = 32 * nb;
#pragma unroll 8
    for (int i = 0; i < 32; ++i) { const int kk = 2 * i + (lane >> 5); float wv = W[(size_t)(k0 + kk) * N + n0 + (lane & 31)]; if (KSC) wv *= ksc[k0 + kk] * (1.f / YQ); scr[kk * 33 + (lane & 31)] = wv; }
    LDS_WAIT(); asm volatile("" ::: "memory");
    const int c = lane & 7;
#pragma unroll
    for (int j = 0; j < 4; ++j) { const int n = (lane >> 3) + 8 * j; const LAS float* s = scr + (8 * c) * 33 + n;
        v4u o; o.x = pk2(s[0 * 33], s[1 * 33]); o.y = pk2(s[2 * 33], s[3 * 33]); o.z = pk2(s[4 * 33], s[5 * 33]); o.w = pk2(s[6 * 33], s[7 * 33]);
        st16_wt((void*)(WT + (size_t)(n0 + n) * K + k0 + 8 * c), o);
        if (CMAX) {
            float am = fmaxf(fmaxf(fmaxf(fabsf(s[0 * 33]), fabsf(s[1 * 33])), fmaxf(fabsf(s[2 * 33]), fabsf(s[3 * 33]))), fmaxf(fmaxf(fabsf(s[4 * 33]), fabsf(s[5 * 33])), fmaxf(fabsf(s[6 * 33]), fabsf(s[7 * 33]))));
            am = fmaxf(am, __shfl_xor(am, 1)); am = fmaxf(am, __shfl_xor(am, 2)); am = fmaxf(am, __shfl_xor(am, 4));
            if (c == 0) atomicMax(cmax + n0 + n, __float_as_uint(am));
        } }
    LDS_WAIT(); asm volatile("" ::: "memory");
}
__device__ __forceinline__ void cvt8(const float* src, bf16* dst, size_t i8) {
    const f32x4 a = *(const GAS f32x4*)(src + i8 * 8), b = *(const GAS f32x4*)(src + i8 * 8 + 4);
    v4u o; o.x = pk2(a.x, a.y); o.y = pk2(a.z, a.w); o.z = pk2(b.x, b.y); o.w = pk2(b.z, b.w);
    st16_wt((void*)(dst + i8 * 8), o);
}
__device__ __forceinline__ void p0_prep(Frame& F) {
    {
        LAS float* sc = (LAS float*)F.lds;
        LAS float* red = sc + 4096;
        bool did = false;
        for (int it = blockIdx.x; it < 192; it += F.G) {
            if (!did) { for (int i = F.tid; i < 4096; i += 512) { const float v = F.c[i]; sc[i] = v / (1.f + __expf(-v)); } did = true; }
            __syncthreads();
            const int c4 = F.tid & 7, ks = F.tid >> 3, j0 = it * 32 + 4 * c4;
            f32x4 w[16];
#pragma unroll
            for (int i = 0; i < 16; ++i) w[i] = *(const GAS f32x4*)(F.ada_w + (size_t)(ks * 16 + i) * 6144 + j0);
            f32x4 a0 = {0.f, 0.f, 0.f, 0.f}, a1 = a0, a2 = a0, a3 = a0;
#pragma unroll
            for (int i = 0; i < 16; ++i) { const int r = ks * 16 + i; a0 += w[i] * sc[r]; a1 += w[i] * sc[1024 + r]; a2 += w[i] * sc[2048 + r]; a3 += w[i] * sc[3072 + r]; }
            *(LAS f32x4*)(red + (ks * 4 + 0) * 32 + 4 * c4) = a0; *(LAS f32x4*)(red + (ks * 4 + 1) * 32 + 4 * c4) = a1;
            *(LAS f32x4*)(red + (ks * 4 + 2) * 32 + 4 * c4) = a2; *(LAS f32x4*)(red + (ks * 4 + 3) * 32 + 4 * c4) = a3;
            __syncthreads();
            if (F.tid < 128) { const int b = F.tid >> 5, jj = F.tid & 31; float s = 0.f;
#pragma unroll 16
                for (int k = 0; k < 64; ++k) s += red[(k * 4 + b) * 32 + jj];
                __hip_atomic_store(F.mod + b * 6144 + it * 32 + jj, s + F.ada_b[it * 32 + jj], __ATOMIC_RELAXED, __HIP_MEMORY_SCOPE_AGENT); }
        }
        __syncthreads();
    }
    LAS float* scr = (LAS float*)(F.lds + F.wave * 16384);
    const int gwv = blockIdx.x * NWAVES + F.wave, NGW = F.G * NWAVES;
    constexpr int I_IN = (D / 64) * (NIN / 32), I_O = (D / 64) * (D / 32), I_Q = (D / 64) * (NQ / 32);
    for (int it = gwv; it < I_IN + I_O + I_Q; it += NGW) {
        int r = it;
        if (r < I_IN) { p0_transpose_item<true>(F.w_in, D, NIN, F.WinT, scr, r, F.lane, (unsigned*)(F.ctl + CW_CMAX)); continue; } r -= I_IN;
        if (r < I_O) { p0_transpose_item<true, true>(F.w_out, D, D, F.WoT, scr, r, F.lane, (unsigned*)(F.ctl + CW_CMAX3), F.group_gain); continue; } r -= I_O;
        p0_transpose_item<true>(F.wq, D, NQ, F.WqT, scr, r, F.lane, (unsigned*)(F.ctl + CW_CMAX2));
    }
    const size_t gt = (size_t)blockIdx.x * 512 + F.tid, NT = (size_t)F.G * 512;
    for (size_t i = gt; i < (size_t)16 * 128 * 128 / 8; i += NT) cvt8(F.keys, F.keysb, i);
    for (int row0 = gwv; row0 < 2 * NEXP; row0 += 2 * NGW) {
      f32x4 a2[2][4];
#pragma unroll
      for (int rr = 0; rr < 2; ++rr) { const int row = row0 + rr * NGW; if (row < 2 * NEXP) { const GAS f32x4* src = (const GAS f32x4*)(((row >> 14) ? F.pv : F.pu) + (size_t)(row & (NEXP - 1)) * D + 16 * F.lane);
#pragma unroll
          for (int i = 0; i < 4; ++i) a2[rr][i] = src[i]; } }
#pragma unroll
      for (int rr = 0; rr < 2; ++rr) { const int row = row0 + rr * NGW; if (row >= 2 * NEXP) break;
        const int tabv = row >> 14, e = row & (NEXP - 1);
        f32x4 a[4]; float ssq = 0.f;
#pragma unroll
        for (int i = 0; i < 4; ++i) { a[i] = a2[rr][i]; ssq += (a[i].x * a[i].x + a[i].y * a[i].y) + (a[i].z * a[i].z + a[i].w * a[i].w); }
        ssq = wave_sum(ssq);
        const float rms = sqrtf(ssq * (1.f / D));
        if (tabv == 0) {
            const float stepq = 0.34f * rms, isq = stepq > 0.f ? 1.f / stepq : 0.f;
            unsigned d0 = 0u, d1 = 0u;
#pragma unroll
            for (int i = 0; i < 4; ++i) { const float xs[4] = {a[i].x, a[i].y, a[i].z, a[i].w};
#pragma unroll
                for (int c = 0; c < 4; ++c) { const int q = (int)fminf(fmaxf(__builtin_rintf(xs[c] * isq), -7.f), 7.f); const int el = 4 * i + c;
                    if (el < 8) d0 |= (unsigned)(q & 15) << (4 * el); else d1 |= (unsigned)(q & 15) << (4 * (el - 8)); } }
            st8_wt((void*)(F.U8 + (size_t)e * 512 + 8 * F.lane), (unsigned long long)d0 | ((unsigned long long)d1 << 32));
            if (F.lane == 0) __hip_atomic_store(F.su + e, stepq, __ATOMIC_RELAXED, __HIP_MEMORY_SCOPE_AGENT);
        } else {
            const float unit = 0.5f * rms, iu = unit > 0.f ? 1.f / unit : 0.f;
            unsigned d0 = 0u, d1 = 0u;
            d0 = __builtin_amdgcn_cvt_scalef32_pk_fp4_f32(d0, a[0].x * iu, a[0].y * iu, 1.0f, 0); d0 = __builtin_amdgcn_cvt_scalef32_pk_fp4_f32(d0, a[0].z * iu, a[0].w * iu, 1.0f, 1);
            d0 = __builtin_amdgcn_cvt_scalef32_pk_fp4_f32(d0, a[1].x * iu, a[1].y * iu, 1.0f, 2); d0 = __builtin_amdgcn_cvt_scalef32_pk_fp4_f32(d0, a[1].z * iu, a[1].w * iu, 1.0f, 3);
            d1 = __builtin_amdgcn_cvt_scalef32_pk_fp4_f32(d1, a[2].x * iu, a[2].y * iu, 1.0f, 0); d1 = __builtin_amdgcn_cvt_scalef32_pk_fp4_f32(d1, a[2].z * iu, a[2].w * iu, 1.0f, 1);
            d1 = __builtin_amdgcn_cvt_scalef32_pk_fp4_f32(d1, a[3].x * iu, a[3].y * iu, 1.0f, 2); d1 = __builtin_amdgcn_cvt_scalef32_pk_fp4_f32(d1, a[3].z * iu, a[3].w * iu, 1.0f, 3);
            st8_wt((void*)(F.V8 + (size_t)(F.lane >> 4) * (NEXP * 128) + (size_t)e * 128 + (F.lane & 15) * 8), (unsigned long long)d0 | ((unsigned long long)d1 << 32));
            if (F.lane == 0) __hip_atomic_store(F.sv + e, unit, __ATOMIC_RELAXED, __HIP_MEMORY_SCOPE_AGENT);
        }
      }
    }
}

__device__ __forceinline__ unsigned q8x4(const f32x4 v, float qs) {
    const int a = (int)__builtin_rintf(v.x * qs), b = (int)__builtin_rintf(v.y * qs), c = (int)__builtin_rintf(v.z * qs), d = (int)__builtin_rintf(v.w * qs);
    return ((unsigned)a & 0xffu) | (((unsigned)b & 0xffu) << 8) | (((unsigned)c & 0xffu) << 16) | ((unsigned)d << 24);
}
__device__ __forceinline__ unsigned q8x4c(const f32x4 v, float qs) {
    const int a = (int)fminf(fmaxf(__builtin_rintf(v.x * qs), -127.f), 127.f), b = (int)fminf(fmaxf(__builtin_rintf(v.y * qs), -127.f), 127.f);
    const int c = (int)fminf(fmaxf(__builtin_rintf(v.z * qs), -127.f), 127.f), d = (int)fminf(fmaxf(__builtin_rintf(v.w * qs), -127.f), 127.f);
    return ((unsigned)a & 0xffu) | (((unsigned)b & 0xffu) << 8) | (((unsigned)c & 0xffu) << 16) | ((unsigned)d << 24);
}
__device__ __forceinline__ void p1_hnorm(Frame& F) {
    const int gwv = blockIdx.x * NWAVES + F.wave, NGW = F.G * NWAVES;
    for (int m0 = gwv * 4; m0 < M; m0 += NGW * 4) {
        const int b = m0 >> 12;
        f32x4 v[4][4];
#pragma unroll
        for (int r = 0; r < 4; ++r) { const GAS f32x4* xr = (const GAS f32x4*)(F.x + (size_t)(m0 + r) * D) + F.lane;
#pragma unroll
            for (int j = 0; j < 4; ++j) v[r][j] = xr[64 * j]; }
        f32x4 gs[4], sh[4];
#pragma unroll
        for (int j = 0; j < 4; ++j) { const int col = 4 * F.lane + 256 * j;
            gs[j] = *(const GAS f32x4*)(F.pre_gain + col) * (*(const GAS f32x4*)(F.mod + b * 6144 + 1024 + col) + 1.f); sh[j] = *(const GAS f32x4*)(F.mod + b * 6144 + col); }
#pragma unroll
        for (int r = 0; r < 4; ++r) {
            float ss = 0.f;
#pragma unroll
            for (int j = 0; j < 4; ++j) ss += (v[r][j].x * v[r][j].x + v[r][j].y * v[r][j].y) + (v[r][j].z * v[r][j].z + v[r][j].w * v[r][j].w);
            const float rstd = rsqrtf(wave_sum(ss) * (1.f / D) + EPS);
            f32x4 o[4]; float am = 0.f;
#pragma unroll
            for (int j = 0; j < 4; ++j) { o[j] = v[r][j] * rstd * gs[j] + sh[j]; am = fmaxf(am, fmaxf(fmaxf(fabsf(o[j].x), fabsf(o[j].y)), fmaxf(fabsf(o[j].z), fabsf(o[j].w)))); }
#pragma unroll
            for (int of = 1; of < 64; of <<= 1) am = fmaxf(am, __shfl_xor(am, of));
            const float qs = am > 0.f ? 127.f / am : 0.f;
            v4u w; w.x = q8x4(o[0], qs); w.y = q8x4(o[1], qs); w.z = q8x4(o[2], qs); w.w = q8x4(o[3], qs);
            st16_wt((void*)((unsigned char*)F.H + (size_t)(m0 + r) * D + 16 * F.lane), w);
            if (F.lane == 0) __hip_atomic_store(F.rs + m0 + r, am * (1.f / 127.f), __ATOMIC_RELAXED, __HIP_MEMORY_SCOPE_AGENT);
        }
    }
    for (int n = gwv; n < NIN; n += NGW) {
        const float cm = __uint_as_float(F.ctl[CW_CMAX + n]); const float qs = cm > 0.f ? 127.f / cm : 0.f;
        const GAS unsigned long long* src = (const GAS unsigned long long*)(F.WinT + (size_t)n * D) + F.lane;
        unsigned long long q[4];
#pragma unroll
        for (int j = 0; j < 4; ++j) q[j] = src[64 * j];
        unsigned wd[4];
#pragma unroll
        for (int j = 0; j < 4; ++j) { const unsigned lo = (unsigned)q[j], hi = (unsigned)(q[j] >> 32); wd[j] = q8x4((f32x4){bflo(lo), bfhi(lo), bflo(hi), bfhi(hi)}, qs); }
        v4u w; w.x = wd[0]; w.y = wd[1]; w.z = wd[2]; w.w = wd[3];
        st16_wt((void*)(F.Win8 + (size_t)n * D + 16 * F.lane), w);
    }
    for (int n = gwv; n < NQ; n += NGW) {
        const float cm = __uint_as_float(F.ctl[CW_CMAX2 + n]); const float qs = cm > 0.f ? 127.f / cm : 0.f;
        const GAS v4u* src = (const GAS v4u*)(F.WqT + (size_t)n * D + 16 * F.lane);
        const v4u q0 = src[0], q1 = src[1];
        v4u w; w.x = q8x4((f32x4){bflo(q0.x), bfhi(q0.x), bflo(q0.y), bfhi(q0.y)}, qs); w.y = q8x4((f32x4){bflo(q0.z), bfhi(q0.z), bflo(q0.w), bfhi(q0.w)}, qs);
        w.z = q8x4((f32x4){bflo(q1.x), bfhi(q1.x), bflo(q1.y), bfhi(q1.y)}, qs); w.w = q8x4((f32x4){bflo(q1.z), bfhi(q1.z), bflo(q1.w), bfhi(q1.w)}, qs);
        st16_wt((void*)(F.Wq8 + (size_t)n * D + 16 * F.lane), w);
    }
    for (int n = gwv; n < D; n += NGW) {
        const float cm = __uint_as_float(F.ctl[CW_CMAX3 + n]); const float qs = cm > 0.f ? 127.f / cm : 0.f;
        const GAS v4u* src = (const GAS v4u*)(F.WoT + (size_t)n * D + 16 * F.lane);
        const v4u q0 = src[0], q1 = src[1];
        v4u w; w.x = q8x4((f32x4){bflo(q0.x), bfhi(q0.x), bflo(q0.y), bfhi(q0.y)}, qs); w.y = q8x4((f32x4){bflo(q0.z), bfhi(q0.z), bflo(q0.w), bfhi(q0.w)}, qs);
        w.z = q8x4((f32x4){bflo(q1.x), bfhi(q1.x), bflo(q1.y), bfhi(q1.y)}, qs); w.w = q8x4((f32x4){bflo(q1.z), bfhi(q1.z), bflo(q1.w), bfhi(q1.w)}, qs);
        st16_wt((void*)(F.Wo8 + (size_t)n * D + 16 * F.lane), w);
    }
}

__device__ __forceinline__ void unpack8(const v4u w, float* f) { f[0] = bflo(w.x); f[1] = bfhi(w.x); f[2] = bflo(w.y); f[3] = bfhi(w.y); f[4] = bflo(w.z); f[5] = bfhi(w.z); f[6] = bflo(w.w); f[7] = bfhi(w.w); }
__device__ __forceinline__ void p6_conv(Frame& F) {
    const int gwv = blockIdx.x * NWAVES + F.wave, NGW = F.G * NWAVES;
    const int col = 8 * F.lane;
    float cw[3][8], gg[8];
#pragma unroll
    for (int j = 0; j < 3; ++j)
#pragma unroll
        for (int i = 0; i < 8; ++i) cw[j][i] = F.conv_w[j * 512 + col + i];
#pragma unroll
    for (int i = 0; i < 8; ++i) gg[i] = F.group_gain[col + i];
    for (int t0 = gwv * 4; t0 < M; t0 += NGW * 4) {
        const int s0 = t0 & 4095;
        v4u gbw[4], gcw[6], hxw[6];
#pragma unroll
        for (int r = 0; r < 4; ++r) gbw[r] = *(const GAS v4u*)(F.P + (size_t)(t0 + r) * NIN + col);
#pragma unroll
        for (int k = 0; k < 6; ++k) { const int tt = (s0 == 0 && k < 2) ? t0 : (t0 - 2 + k);
            const bf16* rp = F.P + (size_t)tt * NIN + col; gcw[k] = *(const GAS v4u*)(rp + 512); hxw[k] = *(const GAS v4u*)(rp + 1024); }
        float u[6][8];
#pragma unroll
        for (int k = 0; k < 6; ++k) { float gc[8], hx[8]; unpack8(gcw[k], gc); unpack8(hxw[k], hx); const float keep = (s0 == 0 && k < 2) ? 0.f : 1.f;
#pragma unroll
            for (int i = 0; i < 8; ++i) u[k][i] = keep * gc[i] * hx[i]; }
#pragma unroll
        for (int r = 0; r < 4; ++r) {
            float acc[8], gb[8]; unpack8(gbw[r], gb);
            float ss = 0.f;
#pragma unroll
            for (int i = 0; i < 8; ++i) { acc[i] = gb[i] * (cw[0][i] * u[r][i] + cw[1][i] * u[r + 1][i] + cw[2][i] * u[r + 2][i]); ss += acc[i] * acc[i]; }
            ss += __shfl_xor(ss, 1); ss += __shfl_xor(ss, 2); ss += __shfl_xor(ss, 4);
            const float rstd = rsqrtf(ss * (1.f / 64.f) + EPS);
            const float qn = rstd * YQ;
            const unsigned w0 = q8x4c((f32x4){acc[0], acc[1], acc[2], acc[3]}, qn), w1 = q8x4c((f32x4){acc[4], acc[5], acc[6], acc[7]}, qn);
            st8_wt((void*)((unsigned char*)F.Y + (size_t)(t0 + r) * D + col), (unsigned long long)w0 | ((unsigned long long)w1 << 32));
        }
    }
}
__device__ __forceinline__ void p8_resid(Frame& F) {
    const int gwv = blockIdx.x * NWAVES + F.wave, NGW = F.G * NWAVES;
    for (int m0 = gwv * 2; m0 < M; m0 += NGW * 2) {
        const float* md = F.mod + (m0 >> 12) * 6144;
        unsigned long long ow[2][4]; f32x4 xv[2][4];
#pragma unroll
        for (int r = 0; r < 2; ++r) {
            const GAS unsigned long long* orow = (const GAS unsigned long long*)(F.O + (size_t)(m0 + r) * D) + F.lane; const GAS f32x4* xr = (const GAS f32x4*)(F.x + (size_t)(m0 + r) * D) + F.lane;
#pragma unroll
            for (int j = 0; j < 4; ++j) { ow[r][j] = orow[64 * j]; xv[r][j] = xr[64 * j]; } }
        f32x4 gg[4], gs[4], sh[4];
#pragma unroll
        for (int j = 0; j < 4; ++j) { const int col = 4 * F.lane + 256 * j;
            gg[j] = *(const GAS f32x4*)(F.post_gain + col) * *(const GAS f32x4*)(md + 2048 + col);
            gs[j] = *(const GAS f32x4*)(F.fpre_gain + col) * (*(const GAS f32x4*)(md + 4096 + col) + 1.f); sh[j] = *(const GAS f32x4*)(md + 3072 + col); }
#pragma unroll
        for (int r = 0; r < 2; ++r) { const int m = m0 + r;
            f32x4 ov[4]; float ss = 0.f;
#pragma unroll
            for (int j = 0; j < 4; ++j) { const unsigned lo = (unsigned)ow[r][j], hi = (unsigned)(ow[r][j] >> 32); ov[j] = (f32x4){bflo(lo), bfhi(lo), bflo(hi), bfhi(hi)};
                ss += (ov[j].x * ov[j].x + ov[j].y * ov[j].y) + (ov[j].z * ov[j].z + ov[j].w * ov[j].w); }
            const float rstd = rsqrtf(wave_sum(ss) * (1.f / D) + EPS);
            GAS unsigned long long* x1r = (GAS unsigned long long*)(F.QP + (size_t)m * D) + F.lane;
            f32x4 x1[4]; float s2 = 0.f;
#pragma unroll
            for (int j = 0; j < 4; ++j) { x1[j] = xv[r][j] + gg[j] * (ov[j] * rstd); st8_wt((void*)(x1r + 64 * j), (unsigned long long)pk2(x1[j].x, x1[j].y) | ((unsigned long long)pk2(x1[j].z, x1[j].w) << 32));
                s2 += (x1[j].x * x1[j].x + x1[j].y * x1[j].y) + (x1[j].z * x1[j].z + x1[j].w * x1[j].w); }
            const float rstd2 = rsqrtf(wave_sum(s2) * (1.f / D) + EPS);
            f32x4 o[4]; float am = 0.f;
#pragma unroll
            for (int j = 0; j < 4; ++j) { o[j] = x1[j] * rstd2 * gs[j] + sh[j]; am = fmaxf(am, fmaxf(fmaxf(fabsf(o[j].x), fabsf(o[j].y)), fmaxf(fabsf(o[j].z), fabsf(o[j].w)))); }
#pragma unroll
            for (int of = 1; of < 64; of <<= 1) am = fmaxf(am, __shfl_xor(am, of));
            const float qs = am > 0.f ? 119.f / am : 0.f;
#pragma unroll
            for (int j = 0; j < 4; ++j) st4_wt((void*)((unsigned char*)F.H + (size_t)m * D + 4 * F.lane + 256 * j), q8x4(o[j], qs));
            if (F.lane == 0) __hip_atomic_store(F.rs2 + m, am * (1.f / 119.f), __ATOMIC_RELAXED, __HIP_MEMORY_SCOPE_AGENT);
        }
    }
}
typedef float f32x16 __attribute__((ext_vector_type(16)));
__device__ __forceinline__ float vmaxf(float a, float b) { float r; asm("v_max_f32_e32 %0, %1, %2" : "=v"(r) : "v"(a), "v"(b)); return r; }
__device__ __forceinline__ float vminf(float a, float b) { float r; asm("v_min_f32_e32 %0, %1, %2" : "=v"(r) : "v"(a), "v"(b)); return r; }
#define CE_D(a, b) do { const float hi_ = vmaxf(a, b), lo_ = vminf(a, b); a = hi_; b = lo_; } while (0)
template <int N> __device__ __forceinline__ void bitonic_sort_desc(float (&v)[N]) {
#pragma unroll
    for (int k = 2; k <= N; k <<= 1)
#pragma unroll
        for (int j = k >> 1; j > 0; j >>= 1)
#pragma unroll
            for (int i = 0; i < N; ++i) { const int l = i ^ j; if (l > i) { if ((i & k) == 0) CE_D(v[i], v[l]); else CE_D(v[l], v[i]); } }
}
template <int N> __device__ __forceinline__ void bitonic_merge_desc(float (&v)[N]) {
#pragma unroll
    for (int j = N >> 1; j > 0; j >>= 1)
#pragma unroll
        for (int i = 0; i < N; ++i) { const int l = i ^ j; if (l > i) CE_D(v[i], v[l]); }
}
__device__ __forceinline__ void sort16_desc(float (&v)[16]) {
    CE_D(v[0], v[1]); CE_D(v[2], v[3]); CE_D(v[0], v[2]); CE_D(v[1], v[3]); CE_D(v[1], v[2]); CE_D(v[4], v[5]); CE_D(v[6], v[7]); CE_D(v[4], v[6]); CE_D(v[5], v[7]); CE_D(v[5], v[6]); CE_D(v[0], v[4]); CE_D(v[2], v[6]); CE_D(v[2], v[4]); CE_D(v[1], v[5]); CE_D(v[3], v[7]); CE_D(v[3], v[5]); CE_D(v[1], v[2]); CE_D(v[3], v[4]); CE_D(v[5], v[6]); CE_D(v[8], v[9]); CE_D(v[10], v[11]); CE_D(v[8], v[10]); CE_D(v[9], v[11]); CE_D(v[9], v[10]); CE_D(v[12], v[13]); CE_D(v[14], v[15]); CE_D(v[12], v[14]); CE_D(v[13], v[15]); CE_D(v[13], v[14]); CE_D(v[8], v[12]); CE_D(v[10], v[14]); CE_D(v[10], v[12]); CE_D(v[9], v[13]); CE_D(v[11], v[15]); CE_D(v[11], v[13]); CE_D(v[9], v[10]); CE_D(v[11], v[12]); CE_D(v[13], v[14]); CE_D(v[0], v[8]); CE_D(v[4], v[12]); CE_D(v[4], v[8]); CE_D(v[2], v[10]); CE_D(v[6], v[14]); CE_D(v[6], v[10]); CE_D(v[2], v[4]); CE_D(v[6], v[8]); CE_D(v[10], v[12]); CE_D(v[1], v[9]); CE_D(v[5], v[13]); CE_D(v[5], v[9]); CE_D(v[3], v[11]); CE_D(v[7], v[15]); CE_D(v[7], v[11]); CE_D(v[3], v[5]); CE_D(v[7], v[9]); CE_D(v[11], v[13]); CE_D(v[1], v[2]); CE_D(v[3], v[4]); CE_D(v[5], v[6]); CE_D(v[7], v[8]); CE_D(v[9], v[10]); CE_D(v[11], v[12]); CE_D(v[13], v[14]);
}
__device__ __forceinline__ void top16_merge(float (&a)[16], const float (&b)[16]) {
#pragma unroll
    for (int i = 0; i < 16; ++i) a[i] = vmaxf(a[i], b[15 - i]);
    bitonic_merge_desc<16>(a);
}
__device__ __forceinline__ void top16_of_64(const float (&v)[64], float (&out)[16]) {
    float g1[16], g2[16], g3[16];
#pragma unroll
    for (int i = 0; i < 16; ++i) { out[i] = v[i]; g1[i] = v[16 + i]; g2[i] = v[32 + i]; g3[i] = v[48 + i]; }
    sort16_desc(out); sort16_desc(g1); sort16_desc(g2); sort16_desc(g3);
    top16_merge(out, g1); top16_merge(g2, g3); top16_merge(out, g2);
}
constexpr int KROW = 272, KIMG = 128 * KROW;
__device__ __forceinline__ void route_half(const bf16x8 (&bq)[8], const LAS unsigned char* kimg, int r32, int hh, float (&svp)[16], unsigned (&ivp)[16]) {
    const LAS unsigned char* krow = kimg + r32 * KROW + 16 * hh;
    f32x16 acc[4];
#pragma unroll
    for (int nt = 0; nt < 4; ++nt) {
        acc[nt] = (f32x16){0.f, 0.f, 0.f, 0.f, 0.f, 0.f, 0.f, 0.f, 0.f, 0.f, 0.f, 0.f, 0.f, 0.f, 0.f, 0.f};
#pragma unroll
        for (int ks = 0; ks < 8; ++ks) { const bf16x8 ak = *(const LAS bf16x8*)(krow + nt * 32 * KROW + 32 * ks);
            acc[nt] = __builtin_amdgcn_mfma_f32_32x32x16_bf16(ak, bq[ks], acc[nt], 0, 0, 0); }
    }
    float v[64];
#pragma unroll
    for (int nt = 0; nt < 4; ++nt)
#pragma unroll
        for (int i = 0; i < 16; ++i) { const unsigned code = (unsigned)(32 * nt + 8 * (i >> 2) + (i & 3)); v[nt * 16 + i] = __uint_as_float((__float_as_uint(acc[nt][i]) & ~127u) | code); }
    float L[16], Pn[16];
    top16_of_64(v, L);
#pragma unroll
    for (int i = 0; i < 16; ++i) { L[i] = __uint_as_float(__float_as_uint(L[i]) | (unsigned)(hh << 2)); Pn[i] = __shfl_xor(L[i], 32); }
    top16_merge(L, Pn);
#pragma unroll
    for (int i = 0; i < 16; ++i) { const unsigned bits = __float_as_uint(L[i]); svp[i] = __uint_as_float(bits & ~127u); ivp[i] = bits & 127u; }
}
__device__ __forceinline__ void route_finish(const float (&sv)[2][16], const unsigned (&iv)[2][16], LAS unsigned* tab, int lane, int hh, int* epi, float* gpf, float rst) {
#define CAND(a, b) __uint_as_float((__float_as_uint(sv[0][a] + sv[1][b]) & ~255u) | (unsigned)((a) * 16 + (b)))
    float W[16], g1[16], g2[16];
#pragma unroll
    for (int i = 0; i < 16; ++i) W[i] = CAND(0, i);
#pragma unroll
    for (int i = 0; i < 15; ++i) g1[i] = CAND(i + 1, 0);
    g1[15] = -3e38f;
    g2[0] = CAND(1, 1); g2[1] = CAND(1, 2); g2[2] = CAND(1, 3); g2[3] = CAND(1, 4); g2[4] = CAND(1, 5); g2[5] = CAND(1, 6); g2[6] = CAND(1, 7);
    g2[7] = CAND(2, 1); g2[8] = CAND(2, 2); g2[9] = CAND(2, 3); g2[10] = CAND(2, 4); g2[11] = CAND(3, 1); g2[12] = CAND(3, 2); g2[13] = CAND(3, 3); g2[14] = CAND(4, 1); g2[15] = CAND(4, 2);
    sort16_desc(g2);
    g2[13] = vmaxf(g2[13], CAND(7, 1)); g2[14] = vmaxf(g2[14], CAND(6, 1)); g2[15] = vmaxf(g2[15], CAND(5, 1));
    bitonic_merge_desc<16>(g2);
    top16_merge(W, g1); top16_merge(W, g2);
#undef CAND
#pragma unroll
    for (int j = 0; j < 16; ++j) { tab[j * 64 + lane] = iv[0][j]; tab[(16 + j) * 64 + lane] = iv[1][j]; }
    float e[16], sum = 0.f; unsigned ex[16];
    const float s0 = __uint_as_float(__float_as_uint(W[0]) & ~255u);
#pragma unroll
    for (int j = 0; j < 16; ++j) { const unsigned bits = __float_as_uint(W[j]); const unsigned code = bits & 255u;
        e[j] = __expf((__uint_as_float(bits & ~255u) - s0) * rst); sum += e[j];
        ex[j] = tab[(code >> 4) * 64 + lane] * 128u + tab[(16 + (code & 15u)) * 64 + lane]; }
    const float inv = 1.f / sum;
    v4u eo0, eo1; f32x4 go0, go1;
    eo0.x = hh ? ex[8] : ex[0]; eo0.y = hh ? ex[9] : ex[1]; eo0.z = hh ? ex[10] : ex[2]; eo0.w = hh ? ex[11] : ex[3];
    eo1.x = hh ? ex[12] : ex[4]; eo1.y = hh ? ex[13] : ex[5]; eo1.z = hh ? ex[14] : ex[6]; eo1.w = hh ? ex[15] : ex[7];
    go0.x = (hh ? e[8] : e[0]) * inv; go0.y = (hh ? e[9] : e[1]) * inv; go0.z = (hh ? e[10] : e[2]) * inv; go0.w = (hh ? e[11] : e[3]) * inv;
    go1.x = (hh ? e[12] : e[4]) * inv; go1.y = (hh ? e[13] : e[5]) * inv; go1.z = (hh ? e[14] : e[6]) * inv; go1.w = (hh ? e[15] : e[7]) * inv;
    GAS v4u* ep = (GAS v4u*)epi; GAS f32x4* gp = (GAS f32x4*)gpf;
    st16_wt((void*)ep, eo0); st16_wt((void*)(ep + 1), eo1); st16_wt((void*)gp, __builtin_bit_cast(wt_v4u, go0)); st16_wt((void*)(gp + 1), __builtin_bit_cast(wt_v4u, go1));
}
__device__ __forceinline__ pg8::f32x4 i2f(const pg8::f32x4 a) { const pg8::i32x4 i = __builtin_bit_cast(pg8::i32x4, a); return (pg8::f32x4){(float)i[0], (float)i[1], (float)i[2], (float)i[3]}; }
struct EpiRoute {
    static constexpr bool PERM = true, AFTER_DRAIN = true;
    const bf16* keysb; int* eidx; float* gw; const unsigned* cmax2; const float* rs2;
    __device__ __forceinline__ void fused(pg8::f32x4 (&acc)[2][2][4][2], const pg8::Unit& u, int wr, int wc, int fr, int fq, LAS unsigned char* lds, int wid, int lane) const {
        int tid_ = threadIdx.x; asm volatile("" : "+v"(tid_)); const int h = u.pn, r32 = lane & 31, hh = lane >> 5, tid = tid_;
        LAS unsigned char* Qs = lds; LAS unsigned char* Ks = lds + 256 * KROW;
        v4u q1[2][4];
#pragma unroll
        for (int ai = 0; ai < 2; ++ai)
#pragma unroll
            for (int m = 0; m < 4; ++m) { const pg8::f32x4 a = i2f(acc[ai][1][m][0]), b = i2f(acc[ai][1][m][1]);
                q1[ai][m] = (v4u){pg8::cvt_pk_bf16(a[0], a[1]), pg8::cvt_pk_bf16(a[2], a[3]), pg8::cvt_pk_bf16(b[0], b[1]), pg8::cvt_pk_bf16(b[2], b[3])}; }
        float sv[2][16]; unsigned iv[2][16];
#pragma unroll
        for (int p = 0; p < 2; ++p) {
            if (p == 1) { asm volatile("s_waitcnt lgkmcnt(0)" ::: "memory"); __builtin_amdgcn_s_barrier(); asm volatile("" ::: "memory"); }
#pragma unroll
            for (int ai = 0; ai < 2; ++ai)
#pragma unroll
                for (int m = 0; m < 4; ++m) { v4u w;
                    if (p == 0) { const pg8::f32x4 a = i2f(acc[ai][0][m][0]), b = i2f(acc[ai][0][m][1]);
                        w = (v4u){pg8::cvt_pk_bf16(a[0], a[1]), pg8::cvt_pk_bf16(a[2], a[3]), pg8::cvt_pk_bf16(b[0], b[1]), pg8::cvt_pk_bf16(b[2], b[3])}; }
                    else w = q1[ai][m];
                    *(LAS v4u*)(Qs + (128 * ai + 64 * wr + 16 * m + fr) * KROW + (32 * wc + 8 * fq) * 2) = w; }
            { const int ch = tid & 15; const pg8::u32x4 c0 = *(const pg8::u32x4*)(cmax2 + h * 256 + p * 128 + ch * 8), c1 = *(const pg8::u32x4*)(cmax2 + h * 256 + p * 128 + ch * 8 + 4);
              float cs[8] = {__uint_as_float(c0.x), __uint_as_float(c0.y), __uint_as_float(c0.z), __uint_as_float(c0.w), __uint_as_float(c1.x), __uint_as_float(c1.y), __uint_as_float(c1.z), __uint_as_float(c1.w)};
#pragma unroll
              for (int i = 0; i < 8; ++i) cs[i] *= (1.f / 127.f);
              for (int c = tid; c < 128 * 16; c += NWAVES * 64) { const int row = c >> 4;
                const v4u kq = *(const GAS v4u*)(keysb + (size_t)((h * 2 + p) * 128 + row) * 128 + ch * 8);
                v4u ko; ko.x = pk2(bflo(kq.x) * cs[0], bfhi(kq.x) * cs[1]); ko.y = pk2(bflo(kq.y) * cs[2], bfhi(kq.y) * cs[3]); ko.z = pk2(bflo(kq.z) * cs[4], bfhi(kq.z) * cs[5]); ko.w = pk2(bflo(kq.w) * cs[6], bfhi(kq.w) * cs[7]);
                *(LAS v4u*)(Ks + row * KROW + ch * 16) = ko; } }
            asm volatile("s_waitcnt vmcnt(0) lgkmcnt(0)" ::: "memory"); __builtin_amdgcn_s_barrier(); asm volatile("" ::: "memory");
            bf16x8 bq[8];
#pragma unroll
            for (int ks = 0; ks < 8; ++ks) bq[ks] = *(const LAS bf16x8*)(Qs + (32 * wid + r32) * KROW + 32 * ks + 16 * hh);
            route_half(bq, Ks, r32, hh, sv[p], iv[p]);
        }
        asm volatile("s_waitcnt lgkmcnt(0)" ::: "memory"); __builtin_amdgcn_s_barrier(); asm volatile("" ::: "memory");
        const int t = u.pm * 256 + 32 * wid + r32;
        route_finish(sv, iv, (LAS unsigned*)(lds + wid * 8192), lane, hh, eidx + (size_t)t * 128 + h * 16 + 8 * hh, gw + (size_t)t * 128 + h * 16 + 8 * hh, rs2[t]);
        asm volatile("s_waitcnt lgkmcnt(0)" ::: "memory"); __builtin_amdgcn_s_barrier(); asm volatile("" ::: "memory");
    }
};
struct OneUnit {
    pg8::Unit u;
    __device__ __forceinline__ bool next(int i, pg8::Unit& o) const { if (i != 0) return false; o = u; return true; }
    __device__ __forceinline__ void a_ready(const pg8::Unit&) const {}
    __device__ __forceinline__ void done(const pg8::Unit&) const {}
};
__device__ __forceinline__ float gelu_tanh(float a) {
    const float z = 0.7978845608028654f * (a + 0.044715f * a * a * a);
    const float e = __expf(2.f * z);
    const float th = 1.f - 2.f / (e + 1.f);
    return 0.5f * a * (1.f + th);
}
typedef float f32x2v __attribute__((ext_vector_type(2)));
__device__ __forceinline__ void fp8x16_to_f32(const v4u w, float* f) {
    f32x2v t;
    t = __builtin_amdgcn_cvt_pk_f32_fp8((int)w.x, false); f[0] = t.x; f[1] = t.y; t = __builtin_amdgcn_cvt_pk_f32_fp8((int)w.x, true); f[2] = t.x; f[3] = t.y;
    t = __builtin_amdgcn_cvt_pk_f32_fp8((int)w.y, false); f[4] = t.x; f[5] = t.y; t = __builtin_amdgcn_cvt_pk_f32_fp8((int)w.y, true); f[6] = t.x; f[7] = t.y;
    t = __builtin_amdgcn_cvt_pk_f32_fp8((int)w.z, false); f[8] = t.x; f[9] = t.y; t = __builtin_amdgcn_cvt_pk_f32_fp8((int)w.z, true); f[10] = t.x; f[11] = t.y;
    t = __builtin_amdgcn_cvt_pk_f32_fp8((int)w.w, false); f[12] = t.x; f[13] = t.y; t = __builtin_amdgcn_cvt_pk_f32_fp8((int)w.w, true); f[14] = t.x; f[15] = t.y;
}
#define DPPF(x, ctrl) __uint_as_float((unsigned)__builtin_amdgcn_mov_dpp((int)__float_as_uint(x), ctrl, 0xf, 0xf, true))
__device__ __forceinline__ void swap16_add(float& a, float b) { auto r = __builtin_amdgcn_permlane16_swap(__float_as_uint(a), __float_as_uint(b), false, false); a = __uint_as_float(r[0]) + __uint_as_float(r[1]); }
__device__ __forceinline__ void swap32_add(float& a, float b) { auto r = __builtin_amdgcn_permlane32_swap(__float_as_uint(a), __float_as_uint(b), false, false); a = __uint_as_float(r[0]) + __uint_as_float(r[1]); }
constexpr int PW_BUF0 = 0, PW_SG = 4096, PW_BUF1 = 8192, PW_E = 16384, PW_WH = 17408, PW_WL = 17920, PW_YP = 18432, PW_IK = 18944, PW_BYTES = 18976;
static_assert(PW_BYTES * NWAVES <= LDSCTL_OFF, "PEER per-wave LDS blocks must stay below the control words");
typedef int v8i_t __attribute__((ext_vector_type(8)));
typedef int v2i_t __attribute__((ext_vector_type(2)));
__device__ __forceinline__ void peer_u_issue(v4u (&uw)[8], const unsigned char* U4, LAS unsigned char* wl, int it, int lane) {
    const int grp = it >> 2, j = it & 3, hw = lane >> 5, li = lane & 31;
#pragma unroll
    for (int q = 0; q < 8; ++q) { const unsigned e = *(const LAS unsigned short*)(wl + PW_E + (j * 128 + grp * 16 + 2 * q + hw) * 2);
        uw[q] = *(const GAS v4u*)(U4 + (e * 512u + 16u * (unsigned)li)); }
}
__device__ __forceinline__ void peer_u_compute(const v4u (&uw)[8], LAS unsigned char* wl, int it, int lane) {
    const int grp = it >> 2, j = it & 3, li = lane & 31;
    const v4u hh = *(LAS v4u*)(wl + j * 1024 + 16 * li), hl = *(LAS v4u*)(wl + j * 1024 + 512 + 16 * li);
    float pa[8];
#pragma unroll
    for (int q = 0; q < 8; ++q) {
        int dh = __builtin_amdgcn_sdot8((int)uw[q].x, (int)hh.x, 0, false); dh = __builtin_amdgcn_sdot8((int)uw[q].y, (int)hh.y, dh, false);
        dh = __builtin_amdgcn_sdot8((int)uw[q].z, (int)hh.z, dh, false); dh = __builtin_amdgcn_sdot8((int)uw[q].w, (int)hh.w, dh, false);
        int dl = __builtin_amdgcn_sdot8((int)uw[q].x, (int)hl.x, 0, false); dl = __builtin_amdgcn_sdot8((int)uw[q].y, (int)hl.y, dl, false);
        dl = __builtin_amdgcn_sdot8((int)uw[q].z, (int)hl.z, dl, false); dl = __builtin_amdgcn_sdot8((int)uw[q].w, (int)hl.w, dl, false);
        pa[q] = (float)(16 * dh + dl); }
    swap16_add(pa[0], pa[4]); swap16_add(pa[1], pa[5]); swap16_add(pa[2], pa[6]); swap16_add(pa[3], pa[7]);
#pragma unroll
    for (int i = 0; i < 4; ++i) { pa[i] += DPPF(pa[i], 0xB1); pa[i] += DPPF(pa[i], 0x4E); pa[i] += DPPF(pa[i], 0x141); pa[i] += DPPF(pa[i], 0x140); }
    if ((lane & 12) == 0) {
        const int q = lane & 3, r = lane >> 4;
        const int idx = j * 128 + grp * 16 + 2 * (q + 4 * (r & 1)) + (r >> 1);
        const f32x2v sg = *(const LAS f32x2v*)(wl + PW_SG + idx * 8);
        const float a = (q == 0 ? pa[0] : q == 1 ? pa[1] : q == 2 ? pa[2] : pa[3]) * sg.x;
        *(LAS float*)(wl + PW_BUF1 + idx * 4) = sg.y * gelu_tanh(a);
    }
}
__device__ __forceinline__ void peer_v_issue(const unsigned char* V8, LAS unsigned char* wl, unsigned lbase, int it, int lane, unsigned c16e, unsigned c16o) {
    const int sl = it >> 3, j = (it >> 1) & 3, hf = it & 1;
    const unsigned char* vbase = V8 + (size_t)sl * (NEXP * 128);
    const unsigned dst = lbase + PW_BUF0 + (it & 1) * 8192;
    unsigned go[8];
#pragma unroll
    for (int q = 0; q < 8; ++q) { const unsigned e = *(const LAS unsigned short*)(wl + PW_E + (j * 128 + 64 * hf + 8 * q + (lane >> 3)) * 2); go[q] = e * 128u + ((q & 1) ? c16o : c16e); }
#pragma unroll
    for (int q = 0; q < 8; ++q) attn_body::glds16s(vbase, go[q], (unsigned)__builtin_amdgcn_readfirstlane((int)(dst + q * 1024)));
}
__device__ __forceinline__ void peer_v_compute(LAS unsigned char* wl, f32x4 (&acc)[8], bf16* yrow0, int it, int lane) {
    const int sl = it >> 3, j = (it >> 1) & 3, hf = it & 1;
    const int m = lane & 15, kg = lane >> 4;
    const LAS unsigned char* wsrc = wl + ((m & 1) ? PW_WL : PW_WH) + j * 128 + 64 * hf + 16 * (kg & 1);
    const v4u a0 = *(const LAS v4u*)wsrc, a1 = *(const LAS v4u*)(wsrc + 32);
    const bool valid = (m < 4) && ((m >> 1) == (kg >> 1));
    v8i_t A;
    A[0] = valid ? (int)a0.x : 0; A[1] = valid ? (int)a0.y : 0; A[2] = valid ? (int)a0.z : 0; A[3] = valid ? (int)a0.w : 0;
    A[4] = valid ? (int)a1.x : 0; A[5] = valid ? (int)a1.y : 0; A[6] = valid ? (int)a1.z : 0; A[7] = valid ? (int)a1.w : 0;
    if (hf == 0) {
#pragma unroll
        for (int T = 0; T < 8; ++T) acc[T] = (f32x4){0.f, 0.f, 0.f, 0.f};
    }
    const LAS unsigned char* bb = wl + PW_BUF0 + (it & 1) * 8192 + (32 * (kg >> 1) + m) * 128 + 8 * (kg & 1);
    const unsigned x16 = (unsigned)(m >> 1) * 16u;
#pragma unroll
    for (int T = 0; T < 8; ++T) {
        const LAS unsigned char* p = bb + ((16u * T) ^ x16);
        const v2i_t b0 = __builtin_amdgcn_ds_read_tr4_b64_v2i32((LAS v2i_t*)p), b1 = __builtin_amdgcn_ds_read_tr4_b64_v2i32((LAS v2i_t*)(p + 2048));
        const v8i_t B = {b0.x, b0.y, b1.x, b1.y, 0, 0, 0, 0};
        acc[T] = __builtin_amdgcn_mfma_scale_f32_16x16x128_f8f6f4(A, B, acc[T], 0, 4, 0, 0x7f7f7f7f, 0, 0x7f7f7f7f);
    }
    if (hf == 1) {
        const float ik = *(const LAS float*)(wl + PW_IK + j * 4);
        LAS unsigned char* yp = lane < 16 ? wl + PW_YP + m * 2 : wl + PW_IK + 16;
        const int ystep = lane < 16 ? 1 : 0;
#pragma unroll
        for (int T = 0; T < 8; ++T) {
            *(LAS unsigned short*)(yp + ystep * (64 * T)) = (unsigned short)f2bf((acc[T][0] + acc[T][1]) * ik);
            *(LAS unsigned short*)(yp + ystep * (64 * T + 32)) = (unsigned short)f2bf((acc[T][2] + acc[T][3]) * ik);
        }
        asm volatile("" ::: "memory");
        const unsigned long long pk = *(const LAS unsigned long long*)(wl + PW_YP + 8 * lane);
        *(GAS unsigned long long*)(yrow0 + (size_t)j * D + 256 * sl + 4 * lane) = pk;
    }
}
__device__ __forceinline__ void p11_peer(Frame& F, float* dst) {
    const int gwv = blockIdx.x * NWAVES + F.wave, NGW = F.G * NWAVES, lane = F.lane;
    LAS unsigned char* wl = F.lds + F.wave * PW_BYTES;
    const unsigned lbase = (unsigned)__builtin_amdgcn_readfirstlane((int)(unsigned)(size_t)wl);
    const unsigned c16e = (unsigned)(((lane & 7) ^ (lane >> 4)) * 16), c16o = (unsigned)(((lane & 7) ^ (4 + (lane >> 4))) * 16);
    const unsigned char* U8 = F.U8; const unsigned char* V8 = F.V8;
    for (int t0 = gwv * 4; t0 < M; t0 += NGW * 4) {
        bf16* yrow0 = F.Y + (size_t)t0 * D;
#pragma unroll
        for (int j = 0; j < 4; ++j) {
            const int t = t0 + j;
            const v4u hq = *(const GAS v4u*)((const unsigned char*)F.H + (size_t)t * D + 16 * lane);
            const float hinv = F.rs2[t];
            const unsigned hw[4] = {hq.x, hq.y, hq.z, hq.w};
            unsigned hh0 = 0u, hh1 = 0u, hl0 = 0u, hl1 = 0u;
#pragma unroll
            for (int i = 0; i < 16; ++i) { const int hv_ = (int)(signed char)((hw[i >> 2] >> (8 * (i & 3))) & 0xffu); const int lo = ((hv_ + 8) & 15) - 8; const int hi = (hv_ - lo) >> 4;
                if (i < 8) { hh0 |= (unsigned)(hi & 15) << (4 * i); hl0 |= (unsigned)(lo & 15) << (4 * i); } else { hh1 |= (unsigned)(hi & 15) << (4 * (i - 8)); hl1 |= (unsigned)(lo & 15) << (4 * (i - 8)); } }
            *(LAS unsigned long long*)(wl + j * 1024 + 8 * lane) = (unsigned long long)hh0 | ((unsigned long long)hh1 << 32);
            *(LAS unsigned long long*)(wl + j * 1024 + 512 + 8 * lane) = (unsigned long long)hl0 | ((unsigned long long)hl1 << 32);
            const int e0 = F.eidx[(size_t)t * 128 + lane], e1 = F.eidx[(size_t)t * 128 + 64 + lane];
            const f32x2v sg0 = (f32x2v){F.su[e0] * hinv, F.gw[(size_t)t * 128 + lane] * F.sv[e0]}, sg1 = (f32x2v){F.su[e1] * hinv, F.gw[(size_t)t * 128 + 64 + lane] * F.sv[e1]};
            int base = 0;
#pragma unroll
            for (int sl = 0; sl < 4; ++sl) {
                const bool m0 = (e0 >> 12) == sl, m1 = (e1 >> 12) == sl;
                const unsigned long long b0 = __ballot(m0), b1 = __ballot(m1);
                const int c0 = __popcll(b0), c1 = __popcll(b1);
                const int p0 = j * 128 + base + __builtin_amdgcn_mbcnt_hi((unsigned)(b0 >> 32), __builtin_amdgcn_mbcnt_lo((unsigned)b0, 0));
                const int p1 = j * 128 + base + c0 + __builtin_amdgcn_mbcnt_hi((unsigned)(b1 >> 32), __builtin_amdgcn_mbcnt_lo((unsigned)b1, 0));
                if (m0) { *(LAS unsigned short*)(wl + PW_E + p0 * 2) = (unsigned short)e0; *(LAS f32x2v*)(wl + PW_SG + p0 * 8) = sg0; }
                if (m1) { *(LAS unsigned short*)(wl + PW_E + p1 * 2) = (unsigned short)e1; *(LAS f32x2v*)(wl + PW_SG + p1 * 8) = sg1; }
                base += c0 + c1;
            }
        }
        asm volatile("" ::: "memory");
        {
#ifndef PEER_REPU
#define PEER_REPU 1
#endif
            for (int rep_ = 0; rep_ < PEER_REPU; ++rep_) {
            v4u ua[8], ub[8];
            peer_u_issue(ua, U8, wl, 0, lane);
#pragma unroll 1
            for (int it = 0; it < 32; it += 2) {
                peer_u_issue(ub, U8, wl, it + 1, lane);
                __builtin_amdgcn_sched_barrier(0);
                peer_u_compute(ua, wl, it, lane);
                __builtin_amdgcn_sched_barrier(0);
                if (it + 2 < 32) peer_u_issue(ua, U8, wl, it + 2, lane);
                __builtin_amdgcn_sched_barrier(0);
                peer_u_compute(ub, wl, it + 1, lane);
                __builtin_amdgcn_sched_barrier(0);
            }
            }
        }
#pragma unroll
        for (int j = 0; j < 4; ++j) {
            const float w0 = *(const LAS float*)(wl + PW_BUF1 + (j * 128 + lane) * 4), w1 = *(const LAS float*)(wl + PW_BUF1 + (j * 128 + 64 + lane) * 4);
            float mx = fmaxf(fabsf(w0), fabsf(w1));
#pragma unroll
            for (int o = 1; o < 64; o <<= 1) mx = fmaxf(mx, __shfl_xor(mx, o));
            int ex = (int)((__float_as_uint(mx) >> 23) & 0xffu); ex = ex < 30 ? 127 : ex;
            const float sc = __uint_as_float((unsigned)(127 + 7 + 127 - ex) << 23), isc = __uint_as_float((unsigned)(ex - 7) << 23);
            const float s0 = w0 * sc, s1 = w1 * sc;
            const int ph = __builtin_amdgcn_cvt_pk_fp8_f32(s0, s1, 0, false);
            const f32x2v hb = __builtin_amdgcn_cvt_pk_f32_fp8(ph, false);
            const int pl = __builtin_amdgcn_cvt_pk_fp8_f32(s0 - hb.x, s1 - hb.y, 0, false);
            *(LAS unsigned char*)(wl + PW_WH + j * 128 + lane) = (unsigned char)(ph & 0xff); *(LAS unsigned char*)(wl + PW_WH + j * 128 + 64 + lane) = (unsigned char)((ph >> 8) & 0xff);
            *(LAS unsigned char*)(wl + PW_WL + j * 128 + lane) = (unsigned char)(pl & 0xff); *(LAS unsigned char*)(wl + PW_WL + j * 128 + 64 + lane) = (unsigned char)((pl >> 8) & 0xff);
            if (lane == 0) *(LAS float*)(wl + PW_IK + j * 4) = isc;
        }
        v4u x1w[4][2];
#pragma unroll
        for (int j = 0; j < 4; ++j) { const GAS v4u* op = (const GAS v4u*)(F.QP + (size_t)(t0 + j) * D + 16 * lane); x1w[j][0] = op[0]; x1w[j][1] = op[1]; }
        asm volatile("s_waitcnt lgkmcnt(0)" ::: "memory");
        {
#ifndef PEER_REPV
#define PEER_REPV 1
#endif
            for (int rep_ = 0; rep_ < PEER_REPV; ++rep_) {
            f32x4 acc[8];
            peer_v_issue(V8, wl, lbase, 0, lane, c16e, c16o);
#pragma unroll 1
            for (int it = 0; it < 32; it += 2) {
                peer_v_issue(V8, wl, lbase, it + 1, lane, c16e, c16o);
                asm volatile("s_waitcnt vmcnt(8)" ::: "memory");
                peer_v_compute(wl, acc, yrow0, it, lane);
                asm volatile("s_waitcnt lgkmcnt(0)" ::: "memory");
                if (it + 2 < 32) { peer_v_issue(V8, wl, lbase, it + 2, lane, c16e, c16o); asm volatile("s_waitcnt vmcnt(8)" ::: "memory"); }
                else asm volatile("s_waitcnt vmcnt(0)" ::: "memory");
                peer_v_compute(wl, acc, yrow0, it + 1, lane);
                asm volatile("s_waitcnt lgkmcnt(0)" ::: "memory");
            }
            }
        }
        asm volatile("s_waitcnt vmcnt(0)" ::: "memory");
#pragma unroll
        for (int j = 0; j < 4; ++j) {
            const int t = t0 + j, b = t >> 12;
            float yv[16];
            { const GAS v4u* yp = (const GAS v4u*)(yrow0 + (size_t)j * D + 16 * lane); const v4u y0 = yp[0], y1 = yp[1]; unpack8(y0, yv); unpack8(y1, yv + 8); }
            float ss = 0.f;
#pragma unroll
            for (int i = 0; i < 16; ++i) ss += yv[i] * yv[i];
            const float rstd = rsqrtf(wave_sum(ss) * (1.f / D) + EPS);
            GAS f32x4* dp = (GAS f32x4*)(dst + (size_t)t * D + 16 * lane);
            const GAS f32x4* gp = (const GAS f32x4*)(F.fpost_gain + 16 * lane);
            const GAS f32x4* g2p = (const GAS f32x4*)(F.mod + b * 6144 + 5120 + 16 * lane);
            float x1f[16]; unpack8(x1w[j][0], x1f); unpack8(x1w[j][1], x1f + 8);
#pragma unroll
            for (int i = 0; i < 4; ++i) { const f32x4 x1 = (f32x4){x1f[4 * i], x1f[4 * i + 1], x1f[4 * i + 2], x1f[4 * i + 3]}, g = gp[i], g2 = g2p[i];
                const f32x4 y = (f32x4){yv[4 * i], yv[4 * i + 1], yv[4 * i + 2], yv[4 * i + 3]};
                dp[i] = x1 + g2 * (y * rstd * g); }
        }
    }
}

__device__ __forceinline__ unsigned long long ldp(const Frame& F, int i) {
    volatile LAS unsigned* pt = (volatile LAS unsigned*)(F.lds + LDSCTL_OFF);
    const unsigned lo = pt[2 * i], hi = pt[2 * i + 1];
    return ((unsigned long long)(unsigned)__builtin_amdgcn_readfirstlane((int)hi) << 32) | (unsigned)__builtin_amdgcn_readfirstlane((int)lo);
}
__device__ __forceinline__ void load_frame(Frame& F) {
    F.lane = lane_id_fresh(); F.tid = F.wave * 64 + F.lane;
    F.x = (const float*)ldp(F, 0); F.c = (const float*)ldp(F, 1); F.ada_w = (const float*)ldp(F, 2); F.ada_b = (const float*)ldp(F, 3); F.pre_gain = (const float*)ldp(F, 4); F.post_gain = (const float*)ldp(F, 5);
    F.w_in = (const float*)ldp(F, 6); F.conv_w = (const float*)ldp(F, 7); F.group_gain = (const float*)ldp(F, 8); F.w_out = (const float*)ldp(F, 9); F.fpre_gain = (const float*)ldp(F, 10); F.fpost_gain = (const float*)ldp(F, 11);
    F.wq = (const float*)ldp(F, 12); F.keys = (const float*)ldp(F, 13); F.pu = (const float*)ldp(F, 14); F.pv = (const float*)ldp(F, 15);
    F.out = (float*)ldp(F, 16);
    unsigned char* ws = (unsigned char*)ldp(F, 17);
    F.ctl = (gu32*)(ws + WS_CTL);
    F.mod = (float*)(ws + WS_MOD); F.kmean = (float*)(ws + WS_KMEAN); F.keysb = (bf16*)(ws + WS_KEYS);
    F.WinT = (bf16*)(ws + WS_WIN); F.WoT = (bf16*)(ws + WS_WO); F.WqT = (bf16*)(ws + WS_WQ); F.eidx = (int*)(ws + WS_EIDX); F.gw = (float*)(ws + WS_G);
    F.U8 = ws + WS_U; F.V8 = ws + WS_V; F.su = (float*)(ws + WS_SU); F.sv = (float*)(ws + WS_SV); F.H = (bf16*)(ws + WS_H);
    F.P = (bf16*)(ws + WS_P); F.QP = (bf16*)(ws + WS_QP); F.O = (bf16*)(ws + WS_O); F.Y = (bf16*)(ws + WS_Y); F.scratch = (float*)(ws + WS_O); F.Win8 = ws + WS_WIN8; F.rs = (float*)(ws + WS_RS); F.Wq8 = ws + WS_WQ8; F.rs2 = (float*)(ws + WS_RS2); F.Wo8 = ws + WS_WO8;
}
struct Args { const float* in[16]; float* out; unsigned char* ws; int ph_lo, ph_hi; };
constexpr int NPHASE = 12;
template <unsigned PM> __global__ void __launch_bounds__(NWAVES * 64, 2) fwd_kernel(Args args) {
    extern __shared__ __attribute__((aligned(16))) unsigned char lds[];
    Frame F;
    F.lds = (LAS unsigned char*)lds;
    F.MISC = (volatile LAS unsigned*)(F.lds + MISC_OFF);
    F.tid = threadIdx.x; F.lane = F.tid & 63; F.wave = __builtin_amdgcn_readfirstlane(F.tid >> 6);
    F.G = gridDim.x;
    for (int u = F.tid; u < (LDS_BYTES - LDSCTL_OFF) / 4; u += NWAVES * 64) ((LAS unsigned*)(F.lds + LDSCTL_OFF))[u] = 0u;
    __syncthreads();
    if (F.tid == 0) { LAS unsigned long long* pt = (LAS unsigned long long*)(F.lds + LDSCTL_OFF);
#pragma unroll
        for (int i = 0; i < 16; ++i) pt[i] = (unsigned long long)args.in[i];
        pt[16] = (unsigned long long)args.out; pt[17] = (unsigned long long)args.ws; }
    __syncthreads();
    load_frame(F);
    const int lo = args.ph_lo, hi = args.ph_hi;
    const bool multi = (hi - lo) > 1;
    XcdBarrier bar; bar.bar = (unsigned*)(F.ctl + CW_BAR); bar.x = 0; bar.st = nullptr;
    if (multi) bar = xcd_barrier_post((unsigned*)(F.ctl + CW_BAR), F.MISC + 8);
#define IN(k) ((((PM) >> (k)) & 1u) && lo <= (k) && (k) < hi)
#define BOTH(k) (IN(k) && IN((k) + 1))
#ifndef SEAMREP
#define SEAMREP 1
#endif
#define SEAM(k) do { if (BOTH(k)) { for (int sr_ = 0; sr_ < SEAMREP; ++sr_) xcd_barrier(bar); } } while (0)
#ifndef REPMASK
#define REPMASK 0x000u
#endif
#define REPS(k) (1 + (int)(((REPMASK) >> (k)) & 1u))
#ifndef CHAINREP
#define CHAINREP 1
#endif
#pragma unroll 1
    for (int chain_ = 0; chain_ < CHAINREP; ++chain_) {
    if (CHAINREP > 1 && chain_ > 0) xcd_barrier(bar);
    if (IN(0)) { load_frame(F); for (int r = 0; r < REPS(0); ++r) { p0_prep(F); __syncthreads(); } SEAM(0); }
    if (IN(1)) { load_frame(F); for (int r = 0; r < REPS(1); ++r) p1_hnorm(F); SEAM(1); }
    if (IN(2)) { load_frame(F);
        pg8::Gemm g{F.H, (const bf16*)F.Win8, M, NIN, D / 2}; pg8::StaticOrder So; So.init(M, NIN, F.G, (int)blockIdx.x);
        pg8::EpiBf16S<true> E{F.P, NIN, 6, 8, C2, F.kmean, 8, 10, F.rs, (const unsigned*)(F.ctl + CW_CMAX)};
        for (int r = 0; r < REPS(2); ++r) pg8::gemm_phase<pg8::EpiBf16S<true>, pg8::StaticOrder, true, true, false, true>(F.lds, g, So, E);
        if (IN(2) && IN(5)) { for (int sr_ = 0; sr_ < SEAMREP; ++sr_) xcd_barrier(bar); }
    }
    if (IN(5)) { load_frame(F);
        const attn_body::AttnTensors AT{(const attn_body::bf16*)(F.P + 1536), (const attn_body::bf16*)(F.P + 2048), (const attn_body::bf16*)(F.P + 2560), (attn_body::bf16*)((unsigned char*)F.Y + 512), F.kmean, F.group_gain + 512};
        const attn_body::StaticOrder So((int)F.G, (int)blockIdx.x);
        for (int r = 0; r < REPS(5); ++r) attn_body::attn_phase<attn_body::StaticOrder>((char*)lds, AT, So);
    }
    if (IN(6)) { load_frame(F); for (int r = 0; r < REPS(6); ++r) p6_conv(F); SEAM(6); }
    if (IN(7)) { load_frame(F);
        pg8::Gemm g{F.Y, (const bf16*)F.Wo8, M, D, D / 2}; pg8::StaticOrder So; So.init(M, D, F.G, (int)blockIdx.x);
        pg8::EpiBf16S<true> E{F.O, D, 0, 0, 1.f, nullptr, 0, 0, nullptr, (const unsigned*)(F.ctl + CW_CMAX3)};
        for (int r = 0; r < REPS(7); ++r) pg8::gemm_phase<pg8::EpiBf16S<true>, pg8::StaticOrder, true, true, false, true>(F.lds, g, So, E);
        SEAM(7);
    }
    if (IN(8)) { load_frame(F); for (int r = 0; r < REPS(8); ++r) p8_resid(F); SEAM(8); }
    if (IN(9)) { load_frame(F);
        pg8::Gemm g{F.H, (const bf16*)F.Wq8, M, NQ, D / 2}; pg8::StaticOrder So; So.init(M, NQ, F.G, (int)blockIdx.x);
        EpiRoute E{F.keysb, F.eidx, F.gw, (const unsigned*)(F.ctl + CW_CMAX2), F.rs2};
        for (int r = 0; r < REPS(9); ++r)
            for (int i = 0; ; ++i) { OneUnit S1; if (!So.next(i, S1.u)) break; pg8::gemm_phase<EpiRoute, OneUnit, false, true, false, true>(F.lds, g, S1, E); }
        if (IN(9) && IN(11)) { for (int sr_ = 0; sr_ < SEAMREP; ++sr_) xcd_barrier(bar); }
    }
    if (IN(11)) { load_frame(F); if (REPS(11) > 1) p11_peer(F, F.scratch); p11_peer(F, F.out); }
    }
#undef IN
#undef BOTH
#undef SEAM
}

#ifndef PMASK
#define PMASK 0xfffu
#endif
#ifndef N_LAUNCH_MODE
#define N_LAUNCH_MODE 1
#endif
template <unsigned PM> static bool set_lds() { return hipFuncSetAttribute((const void*)fwd_kernel<PM>, hipFuncAttributeMaxDynamicSharedMemorySize, LDS_BYTES) == hipSuccess; }
template <unsigned PM> static void launch1(int grid, hipStream_t stream, Args a) { hipLaunchKernelGGL(fwd_kernel<PM>, dim3(grid), dim3(NWAVES * 64), LDS_BYTES, stream, a); }
extern "C" void kernel_launch(void* const* d_in, const int* in_sizes, int n_in, void* d_out, int out_size, void* d_ws, size_t ws_size, hipStream_t stream) {
    static int grid = 0;
    if (grid == 0) {
        if (n_in != 16 || out_size != M * D || ws_size < WS_END) { fprintf(stderr, "kernel_launch: unexpected shapes n_in %d out %d ws %zu\n", n_in, out_size, ws_size); grid = -1; return; }
        int dev = 0, cus = 0;
        if (hipGetDevice(&dev) != hipSuccess || hipDeviceGetAttribute(&cus, hipDeviceAttributeMultiprocessorCount, dev) != hipSuccess) { grid = -1; return; }
        bool ok = true;
#if N_LAUNCH_MODE == 1
        ok = set_lds<PMASK>();
#elif N_LAUNCH_MODE == 3
        ok = set_lds<0x3ffu>() && set_lds<0x400u>() && set_lds<0x800u>();
#else
        ok = set_lds<1u>() && set_lds<2u>() && set_lds<4u>() && set_lds<8u>() && set_lds<16u>() && set_lds<32u>() && set_lds<64u>() && set_lds<128u>() && set_lds<256u>() && set_lds<512u>() && set_lds<1024u>() && set_lds<2048u>();
#endif
        if (!ok) { fprintf(stderr, "kernel_launch: hipFuncSetAttribute failed\n"); grid = -1; return; }
        grid = cus;
    }
    if (grid < 0) return;
    (void)hipMemsetAsync((char*)d_ws + WS_CTL, 0, CTL_ZERO_BYTES, stream);
    Args a{};
    for (int i = 0; i < 16; ++i) a.in[i] = (const float*)d_in[i];
    a.out = (float*)d_out; a.ws = (unsigned char*)d_ws;
#if N_LAUNCH_MODE == 1
    a.ph_lo = 0; a.ph_hi = NPHASE; launch1<PMASK>(grid, stream, a);
#elif N_LAUNCH_MODE == 3
    a.ph_lo = 0; a.ph_hi = 10; launch1<0x3ffu>(grid, stream, a);
    a.ph_lo = 10; a.ph_hi = 11; launch1<0x400u>(grid, stream, a);
    a.ph_lo = 11; a.ph_hi = 12; launch1<0x800u>(grid, stream, a);
#else
#define L1(p) do { a.ph_lo = (p); a.ph_hi = (p) + 1; launch1<(1u << (p))>(grid, stream, a); } while (0)
    L1(0); L1(1); L1(2); L1(3); L1(4); L1(5); L1(6); L1(7); L1(8); L1(9); L1(10); L1(11);
#undef L1
#endif
}
```

```cpp
#include <hip/hip_runtime.h>
#include <cstdio>
#include <cstdint>
#ifndef WT_STORES
#define WT_STORES 1
#endif
typedef unsigned wt_v4u __attribute__((ext_vector_type(4)));
__device__ __forceinline__ int lane_id_fresh() { int l; asm volatile("v_mbcnt_lo_u32_b32 %0, -1, 0\n\tv_mbcnt_hi_u32_b32 %0, -1, %0" : "=v"(l)); return l; }
__device__ __forceinline__ void st16_wt(void* p, wt_v4u v) {
#if WT_STORES
    asm volatile("global_store_dwordx4 %0, %1, off sc1\n\ts_nop 1" :: "v"(p), "v"(v) : "memory");
#else
    *(wt_v4u*)p = v;
#endif
}
__device__ __forceinline__ void st4_wt(void* p, unsigned v) {
#if WT_STORES
    asm volatile("global_store_dword %0, %1, off sc1\n\ts_nop 1" :: "v"(p), "v"(v) : "memory");
#else
    *(unsigned*)p = v;
#endif
}
__device__ __forceinline__ void st8_wt(void* p, unsigned long long v) {
#if WT_STORES
    asm volatile("global_store_dwordx2 %0, %1, off sc1\n\ts_nop 1" :: "v"(p), "v"(v) : "memory");
#else
    *(unsigned long long*)p = v;
#endif
}
namespace pg8 {
#define PG8_LAS __attribute__((address_space(3)))
typedef unsigned short bf16_t;
typedef short bf16x8 __attribute__((ext_vector_type(8)));
typedef float f32x4 __attribute__((ext_vector_type(4)));
typedef unsigned u32x4 __attribute__((ext_vector_type(4)));
typedef int i32x4 __attribute__((ext_vector_type(4)));
typedef int i32x8 __attribute__((ext_vector_type(8)));
constexpr int BM = 256, BK = 64, HALF = 128, HTB = HALF * BK * 2  , STAGE_BYTES = 8 * HTB, NXCD = 8, WGM = 8;

__host__ __device__ __forceinline__ int lds_byte(int r, int c) { const int st = (r >> 4) * 2 + (c >> 5), rr = r & 15, cc = c & 31, ob = rr * 64 + cc * 2; return st * 1024 + (ob ^ (((ob >> 9) & 1) << 5)); }
__host__ __device__ __forceinline__ void stage_rc(int b, int& R, int& C) { const int st = b / 1024, sb = b % 1024, swz = sb ^ (((sb >> 9) & 1) << 5); R = (st >> 1) * 16 + swz / 64; C = (st & 1) * 32 + (swz % 64) / 2; }
__host__ __device__ __forceinline__ int perm32(int rho) { const int n = rho >> 4, i = rho & 15; return 8 * (i >> 2) + 4 * n + (i & 3); }

struct Unit { int pm, pn; };
struct Gemm { const bf16_t* A; const bf16_t* Bt; int M, N, K; };

struct StaticOrder {
    int nM, nN, nwg, G, c;
    __host__ __device__ void init(int M, int N, int G_, int c_) { nM = M / BM; nN = N / BM; nwg = nM * nN; G = G_; c = c_; }
    __host__ __device__ bool next(int i, Unit& u) const {
        const long L = (long)i * G + c; if (L >= nwg) return false;
        int wgid = (int)L; { const int q = nwg / NXCD, r = nwg % NXCD, xcd = wgid % NXCD, off = wgid / NXCD; wgid = (xcd < r ? xcd * (q + 1) : r * (q + 1) + (xcd - r) * q) + off; }
        const int nig = WGM * nN, gid = wgid / nig, fm = gid * WGM, gsz = (nM - fm) < WGM ? (nM - fm) : WGM;
        u.pm = fm + ((wgid % nig) % gsz); u.pn = (wgid % nig) / gsz; return true;
    }
    __device__ __forceinline__ void a_ready(const Unit&) const {}
    __device__ __forceinline__ void done(const Unit&) const {}
};


__device__ __forceinline__ unsigned cvt_pk_bf16(float lo, float hi) { unsigned r; asm volatile("v_cvt_pk_bf16_f32 %0, %1, %2" : "=v"(r) : "v"(lo), "v"(hi)); return r; }
template <bool ACC_I32> struct EpiBf16S {
    static constexpr bool PERM = true, AFTER_DRAIN = false;
    bf16_t* O; int ldc; int sc_lo, sc_hi; float scv; float* ksum; int ks_lo, ks_hi; const float* rs; const unsigned* cmax;
    __device__ __forceinline__ void operator()(const f32x4 (&acc)[2][2][4][2], const Unit& u, int wr, int wc, int fr_, int fq_) const {
        (void)fr_; (void)fq_;
        const int lane_ = lane_id_fresh(); const int fr = lane_ & 15, fq = lane_ >> 4;
        const int row0 = u.pm * BM + wr * 64 + fr; const int colt = u.pn * BM;
        const float sc = ((u.pn >= sc_lo && u.pn < sc_hi) ? scv : 1.f) * (ACC_I32 ? (1.f / 127.f) : (1.f / 224.f));
        const int col0 = colt + wc * 32 + 8 * fq;
        float rsv[2][4];
#pragma unroll
        for (int ai = 0; ai < 2; ++ai)
#pragma unroll
            for (int m = 0; m < 4; ++m) rsv[ai][m] = rs != nullptr ? rs[row0 + ai * HALF + m * 16] : 1.f;
        const bool do_ks = ksum != nullptr && u.pn >= ks_lo && u.pn < ks_hi;
#pragma unroll
        for (int bj = 0; bj < 2; ++bj) {
            const u32x4 cb0 = *(const u32x4*)(cmax + col0 + bj * HALF), cb1 = *(const u32x4*)(cmax + col0 + bj * HALF + 4);
            const f32x4 cs0 = (f32x4){__uint_as_float(cb0.x), __uint_as_float(cb0.y), __uint_as_float(cb0.z), __uint_as_float(cb0.w)} * sc;
            const f32x4 cs1 = (f32x4){__uint_as_float(cb1.x), __uint_as_float(cb1.y), __uint_as_float(cb1.z), __uint_as_float(cb1.w)} * sc;
            f32x4 sum0 = {0.f, 0.f, 0.f, 0.f}, sum1 = sum0;
#pragma unroll
            for (int ai = 0; ai < 2; ++ai)
#pragma unroll
                for (int m = 0; m < 4; ++m) { f32x4 a0 = acc[ai][bj][m][0], a1 = acc[ai][bj][m][1];
                    if constexpr (ACC_I32) { const i32x4 i0 = __builtin_bit_cast(i32x4, a0), i1 = __builtin_bit_cast(i32x4, a1);
                        a0 = (f32x4){(float)i0[0], (float)i0[1], (float)i0[2], (float)i0[3]}; a1 = (f32x4){(float)i1[0], (float)i1[1], (float)i1[2], (float)i1[3]}; }
                    const f32x4 v0 = a0 * rsv[ai][m] * cs0, v1 = a1 * rsv[ai][m] * cs1;
                    sum0 += v0; sum1 += v1;
                    u32x4 w; w.x = cvt_pk_bf16(v0[0], v0[1]); w.y = cvt_pk_bf16(v0[2], v0[3]); w.z = cvt_pk_bf16(v1[0], v1[1]); w.w = cvt_pk_bf16(v1[2], v1[3]);
                    st16_wt(O + (size_t)(row0 + ai * HALF + m * 16) * ldc + col0 + bj * HALF, w); }
            if (do_ks) {
                float* kd = ksum + (size_t)u.pm * ((ks_hi - ks_lo) * BM) + (u.pn - ks_lo) * BM + wc * 32 + 8 * fq + bj * HALF;
#pragma unroll
                for (int n = 0; n < 2; ++n)
#pragma unroll
                    for (int i = 0; i < 4; ++i) {
                        float v = n ? sum1[i] : sum0[i];
                        v += __uint_as_float((unsigned)__builtin_amdgcn_mov_dpp((int)__float_as_uint(v), 0xB1, 0xf, 0xf, true));
                        v += __uint_as_float((unsigned)__builtin_amdgcn_mov_dpp((int)__float_as_uint(v), 0x4E, 0xf, 0xf, true));
                        v += __uint_as_float((unsigned)__builtin_amdgcn_mov_dpp((int)__float_as_uint(v), 0x141, 0xf, 0xf, true));
                        v += __uint_as_float((unsigned)__builtin_amdgcn_mov_dpp((int)__float_as_uint(v), 0x140, 0xf, 0xf, true));
                        if (fr == 0) atomicAdd(kd + 4 * n + i, v);
                    }
            }
        }
    }
};
struct EpiBf16 {
    static constexpr bool PERM = true, AFTER_DRAIN = false;
    bf16_t* O; int ldc; int sc_lo, sc_hi; float scv; float* ksum; int ks_lo, ks_hi;
    __device__ __forceinline__ void operator()(const f32x4 (&acc)[2][2][4][2], const Unit& u, int wr, int wc, int fr, int fq) const {
        const int row0 = u.pm * BM + wr * 64 + fr; const int colt = u.pn * BM;
        const float sc = (u.pn >= sc_lo && u.pn < sc_hi) ? scv : 1.f;
        const int col0 = colt + wc * 32 + 8 * fq;
#pragma unroll
        for (int ai = 0; ai < 2; ++ai)
#pragma unroll
            for (int m = 0; m < 4; ++m) { bf16_t* rowp = O + (size_t)(row0 + ai * HALF + m * 16) * ldc + col0;
#pragma unroll
                for (int bj = 0; bj < 2; ++bj) { f32x4 v0 = acc[ai][bj][m][0] * sc, v1 = acc[ai][bj][m][1] * sc;
                    u32x4 w; w.x = cvt_pk_bf16(v0[0], v0[1]); w.y = cvt_pk_bf16(v0[2], v0[3]); w.z = cvt_pk_bf16(v1[0], v1[1]); w.w = cvt_pk_bf16(v1[2], v1[3]);
                    st16_wt(rowp + bj * HALF, w); } }
        if (ksum != nullptr && u.pn >= ks_lo && u.pn < ks_hi) {
            float* kd = ksum + (size_t)u.pm * ((ks_hi - ks_lo) * BM) + (u.pn - ks_lo) * BM + wc * 32 + 8 * fq;
#pragma unroll
            for (int bj = 0; bj < 2; ++bj)
#pragma unroll
                for (int n = 0; n < 2; ++n) {
                    f32x4 cs = acc[0][bj][0][n];
#pragma unroll
                    for (int m = 1; m < 4; ++m) cs += acc[0][bj][m][n];
#pragma unroll
                    for (int m = 0; m < 4; ++m) cs += acc[1][bj][m][n];
#pragma unroll
                    for (int i = 0; i < 4; ++i) {
                        float v = cs[i];
                        v += __uint_as_float((unsigned)__builtin_amdgcn_mov_dpp((int)__float_as_uint(v), 0xB1, 0xf, 0xf, true));
                        v += __uint_as_float((unsigned)__builtin_amdgcn_mov_dpp((int)__float_as_uint(v), 0x4E, 0xf, 0xf, true));
                        v += __uint_as_float((unsigned)__builtin_amdgcn_mov_dpp((int)__float_as_uint(v), 0x141, 0xf, 0xf, true));
                        v += __uint_as_float((unsigned)__builtin_amdgcn_mov_dpp((int)__float_as_uint(v), 0x140, 0xf, 0xf, true));
                        if (fr == 0) atomicAdd(kd + bj * HALF + 4 * n + i, v);
                    }
                }
        }
    }
};

template <int OFF> __device__ __forceinline__ void dma16s(const void* sbase, unsigned voff, unsigned lds_base) { unsigned keep;
    asm volatile("s_mov_b32 %0, m0\n\ts_add_u32 m0, %3, %4\n\ts_nop 0\n\tglobal_load_lds_dwordx4 %1, %2\n\ts_mov_b32 m0, %0" : "=&s"(keep) : "v"(voff), "s"(sbase), "s"(lds_base), "i"(OFF) : "memory", "scc"); }
__device__ __forceinline__ const char* uni_ptr(const char* p) {
    const unsigned long long v = (unsigned long long)p;
    return (const char*)(((unsigned long long)(unsigned)__builtin_amdgcn_readfirstlane((int)(unsigned)(v >> 32)) << 32) | (unsigned)__builtin_amdgcn_readfirstlane((int)(unsigned)v));
}
template <class Epi, class Sched, bool ALIGN_EPI = false, bool SP2 = false, bool FP8 = false, bool I8 = false>
__device__ __forceinline__ void gemm_phase(PG8_LAS unsigned char* lds, const Gemm g, const Sched& S, const Epi& E) {
    int tid_ = threadIdx.x; asm volatile("" : "+v"(tid_));
    const int tid = tid_, wid = __builtin_amdgcn_readfirstlane(tid >> 6), lane = tid & 63, wr = wid >> 2, wc = wid & 3, fr = lane & 15, fq = lane >> 4;
    const int K = g.K, nt = K / BK;
    unsigned voffA[2], voffB[2];
#pragma unroll
    for (int i = 0; i < 2; ++i) { int R, C; stage_rc(tid * 16 + i * 8192, R, C); const int Rb = Epi::PERM ? ((R & ~31) + perm32(R & 31)) : R;
        voffA[i] = (unsigned)(R * K + C) * 2u; voffB[i] = (unsigned)(Rb * K + C) * 2u; }
    const size_t qstep = (size_t)64 * K * 2;
    const size_t kstep = (size_t)(BK * 2);
    const size_t hstep = (size_t)HALF * K * 2;
    const size_t tstep = 2 * hstep;
    const unsigned ldsn = (unsigned)(size_t)lds;
    const unsigned ldsw = (unsigned)wid * 1024u;
    const unsigned ldsb = (unsigned)__builtin_amdgcn_readfirstlane((int)(ldsn + ldsw));
    const int aoff = lds_byte(wr * 64 + fr, fq * 8), boff = lds_byte(wc * 32 + fr, fq * 8);
    unsigned ldsAn = ldsn + (unsigned)aoff, ldsBn = ldsn + (unsigned)(4 * HTB) + (unsigned)boff; asm volatile("" : "+v"(ldsAn), "+v"(ldsBn));
    PG8_LAS unsigned char* const ldsA = (PG8_LAS unsigned char*)(size_t)ldsAn; PG8_LAS unsigned char* const ldsB = (PG8_LAS unsigned char*)(size_t)ldsBn;
#define PG8_SA(b, h) (((b) * 2 + (h)) * HTB)
#define PG8_SB(b, h) ((4 + (b) * 2 + (h)) * HTB)
#define PG8_STAGE(bufoff, gbase, voff) do { if constexpr (FP8 || I8) { const char* gb_ = uni_ptr((const char*)(gbase)); dma16s<(bufoff)>(gb_, (voff)[0], ldsb); dma16s<(bufoff) + 8192>(uni_ptr(gb_ + qstep), (voff)[0], ldsb); }        \
    else { _Pragma("unroll") for (int _i = 0; _i < 2; ++_i) \
        __builtin_amdgcn_global_load_lds((const unsigned*)((const char*)(gbase) + (voff)[_i]), (PG8_LAS unsigned*)(lds + (bufoff) + ldsw + _i * 8192), 16, 0, 0); } } while (0)
#define PG8_LDA(dst, b, h) do { _Pragma("unroll") for (int m = 0; m < 4; ++m) _Pragma("unroll") for (int k = 0; k < 2; ++k) dst[m][k] = *(const PG8_LAS bf16x8*)(lds + PG8_SA(b, h) + aoff + m * 2048 + k * 1024); } while (0)
#define PG8_LDB(dst, b, h) do { _Pragma("unroll") for (int n = 0; n < 2; ++n) _Pragma("unroll") for (int k = 0; k < 2; ++k) dst[n][k] = *(const PG8_LAS bf16x8*)(lds + PG8_SB(b, h) + boff + n * 2048 + k * 1024); } while (0)
#define PG8_LDA8(dst, b, h) do { _Pragma("unroll") for (int m = 0; m < 4; ++m) dst[m] = __builtin_shufflevector(*(const PG8_LAS i32x4*)(ldsA + PG8_SA(b, h) + m * 2048), *(const PG8_LAS i32x4*)(ldsA + PG8_SA(b, h) + m * 2048 + 1024), 0, 1, 2, 3, 4, 5, 6, 7); } while (0)
#define PG8_LDB8(dst, b, h) do { _Pragma("unroll") for (int n = 0; n < 2; ++n) dst[n] = __builtin_shufflevector(*(const PG8_LAS i32x4*)(ldsB + (PG8_SB(b, h) - 4 * HTB) + n * 2048), *(const PG8_LAS i32x4*)(ldsB + (PG8_SB(b, h) - 4 * HTB) + n * 2048 + 1024), 0, 1, 2, 3, 4, 5, 6, 7); } while (0)
#define PG8_MMA8(ai, bj, A8, B8) do { __builtin_amdgcn_s_setprio(1); _Pragma("unroll") for (int m = 0; m < 4; ++m) _Pragma("unroll") for (int n = 0; n < 2; ++n) \
        acc[ai][bj][m][n] = __builtin_amdgcn_mfma_scale_f32_16x16x128_f8f6f4(B8[n], A8[m], acc[ai][bj][m][n], 0, 0, 0, 0, 0, 0); __builtin_amdgcn_s_setprio(0); } while (0)
#define PG8_MMA(ai, bj, At, Bt) do { __builtin_amdgcn_s_setprio(1); _Pragma("unroll") for (int m = 0; m < 4; ++m) _Pragma("unroll") for (int n = 0; n < 2; ++n) _Pragma("unroll") for (int k = 0; k < 2; ++k) { \
        if constexpr (I8) acc[ai][bj][m][n] = __builtin_bit_cast(f32x4, __builtin_amdgcn_mfma_i32_16x16x64_i8(__builtin_bit_cast(i32x4, Bt[n][k]), __builtin_bit_cast(i32x4, At[m][k]), __builtin_bit_cast(i32x4, acc[ai][bj][m][n]), 0, 0, 0)); \
        else acc[ai][bj][m][n] = __builtin_amdgcn_mfma_f32_16x16x32_bf16(Bt[n][k], At[m][k], acc[ai][bj][m][n], 0, 0, 0); } __builtin_amdgcn_s_setprio(0); } while (0)
#define PG8_WAIT_V(n) asm volatile("s_waitcnt vmcnt(" #n ")" ::: "memory")
#define PG8_WAIT_L(n) asm volatile("s_waitcnt lgkmcnt(" #n ")" ::: "memory")
#define PG8_BAR __builtin_amdgcn_s_barrier()
#define PG8_SCHED __builtin_amdgcn_sched_barrier(0)
    Unit cur, nxt; int ui = 0;
    if (!S.next(0, cur)) return;
    f32x4 acc[2][2][4][2];
#pragma unroll
    for (int a = 0; a < 2; ++a)
#pragma unroll
        for (int b = 0; b < 2; ++b)
#pragma unroll
            for (int m = 0; m < 4; ++m)
#pragma unroll
                for (int n = 0; n < 2; ++n) acc[a][b][m][n] = (f32x4){0.f, 0.f, 0.f, 0.f};
    bf16x8 At[4][2], B0[2][2], B1[2][2];
    i32x8 A8[4], B08[2], B18[2];
    const char* cA = (const char*)g.A + (size_t)cur.pm * tstep; const char* cB = (const char*)g.Bt + (size_t)cur.pn * tstep;
    if constexpr (FP8 || I8) { cA = uni_ptr(cA); cB = uni_ptr(cB); }
    S.a_ready(cur);
    if constexpr (SP2) {
        PG8_STAGE(PG8_SB(0, 0), cB, voffB); PG8_STAGE(PG8_SB(0, 1), cB + hstep, voffB); PG8_STAGE(PG8_SA(0, 0), cA, voffA); PG8_STAGE(PG8_SA(0, 1), cA + hstep, voffA);
        if (wr == 1) PG8_BAR;
        PG8_WAIT_V(2); PG8_BAR;
        PG8_STAGE(PG8_SB(1, 0), cB + kstep, voffB); PG8_STAGE(PG8_SA(1, 0), cA + kstep, voffA); PG8_STAGE(PG8_SB(1, 1), cB + hstep + kstep, voffB);
        PG8_WAIT_V(6); PG8_BAR;
    } else {
        PG8_STAGE(PG8_SB(0, 0), cB, voffB); PG8_STAGE(PG8_SA(0, 0), cA, voffA); PG8_STAGE(PG8_SB(0, 1), cB + hstep, voffB); PG8_STAGE(PG8_SA(0, 1), cA + hstep, voffA);
        if (wr == 1) PG8_BAR;
        PG8_WAIT_V(4); PG8_BAR;
        PG8_STAGE(PG8_SB(1, 0), cB + kstep, voffB); PG8_STAGE(PG8_SA(1, 0), cA + kstep, voffA); PG8_STAGE(PG8_SB(1, 1), cB + hstep + kstep, voffB);
        PG8_WAIT_V(6); PG8_BAR;
    }
    for (;;) {
        const bool has_next = S.next(ui + 1, nxt);
        const char* nA = has_next ? (const char*)g.A + (size_t)nxt.pm * tstep : cA; const char* nB = has_next ? (const char*)g.Bt + (size_t)nxt.pn * tstep : cB;
        if constexpr (FP8 || I8) { nA = uni_ptr(nA); nB = uni_ptr(nB); }
        for (int t = 0; t < nt; t += 2) {
            const bool last = (t == nt - 2);
            if constexpr (FP8 || I8) asm volatile("" : "+v"(voffA[0]), "+v"(voffB[0]));
            const char* a1 = cA + (size_t)(t + 1) * kstep;
            const char* a2 = last ? nA : cA + (size_t)(t + 2) * kstep; const char* b2 = last ? nB : cB + (size_t)(t + 2) * kstep;
            const char* a3 = a2 + kstep; const char* b3 = b2 + kstep;
            if (last && has_next) S.a_ready(nxt);
            if constexpr (SP2 && FP8) {
            PG8_LDB8(B08, 0, 0); PG8_LDB8(B18, 0, 1); PG8_SCHED; PG8_LDA8(A8, 0, 0); PG8_STAGE(PG8_SA(1, 1), a1 + hstep, voffA);
            PG8_WAIT_V(8); PG8_WAIT_L(0); PG8_BAR; PG8_MMA8(0, 0, A8, B08); PG8_MMA8(0, 1, A8, B18); PG8_BAR; PG8_SCHED;
            PG8_LDA8(A8, 0, 1); PG8_STAGE(PG8_SB(0, 0), b2, voffB); PG8_STAGE(PG8_SB(0, 1), b2 + hstep, voffB); PG8_STAGE(PG8_SA(0, 0), a2, voffA);
            PG8_WAIT_V(8); PG8_WAIT_L(0); PG8_BAR; PG8_MMA8(1, 0, A8, B08); PG8_MMA8(1, 1, A8, B18); PG8_BAR; PG8_SCHED;
            PG8_LDB8(B08, 1, 0); PG8_LDB8(B18, 1, 1); PG8_SCHED; PG8_LDA8(A8, 1, 0); PG8_STAGE(PG8_SA(0, 1), a2 + hstep, voffA);
            PG8_WAIT_V(8); PG8_WAIT_L(0); PG8_BAR; PG8_MMA8(0, 0, A8, B08); PG8_MMA8(0, 1, A8, B18); PG8_BAR; PG8_SCHED;
            PG8_LDA8(A8, 1, 1); PG8_STAGE(PG8_SB(1, 0), b3, voffB); PG8_STAGE(PG8_SB(1, 1), b3 + hstep, voffB); PG8_STAGE(PG8_SA(1, 0), a3, voffA);
            PG8_WAIT_V(8); PG8_WAIT_L(0); PG8_BAR; PG8_MMA8(1, 0, A8, B08); PG8_MMA8(1, 1, A8, B18); PG8_BAR; PG8_SCHED;
            } else if constexpr (SP2) {
            PG8_LDB(B0, 0, 0); PG8_LDB(B1, 0, 1); PG8_SCHED; PG8_LDA(At, 0, 0); PG8_STAGE(PG8_SA(1, 1), a1 + hstep, voffA);
            PG8_WAIT_V(8); PG8_WAIT_L(0); PG8_BAR; PG8_MMA(0, 0, At, B0); PG8_MMA(0, 1, At, B1); PG8_BAR; PG8_SCHED;
            PG8_LDA(At, 0, 1); PG8_STAGE(PG8_SB(0, 0), b2, voffB); PG8_STAGE(PG8_SB(0, 1), b2 + hstep, voffB); PG8_STAGE(PG8_SA(0, 0), a2, voffA);
            PG8_WAIT_V(8); PG8_WAIT_L(0); PG8_BAR; PG8_MMA(1, 0, At, B0); PG8_MMA(1, 1, At, B1); PG8_BAR; PG8_SCHED;
            PG8_LDB(B0, 1, 0); PG8_LDB(B1, 1, 1); PG8_SCHED; PG8_LDA(At, 1, 0); PG8_STAGE(PG8_SA(0, 1), a2 + hstep, voffA);
            PG8_WAIT_V(8); PG8_WAIT_L(0); PG8_BAR; PG8_MMA(0, 0, At, B0); PG8_MMA(0, 1, At, B1); PG8_BAR; PG8_SCHED;
            PG8_LDA(At, 1, 1); PG8_STAGE(PG8_SB(1, 0), b3, voffB); PG8_STAGE(PG8_SB(1, 1), b3 + hstep, voffB); PG8_STAGE(PG8_SA(1, 0), a3, voffA);
            PG8_WAIT_V(8); PG8_WAIT_L(0); PG8_BAR; PG8_MMA(1, 0, At, B0); PG8_MMA(1, 1, At, B1); PG8_BAR; PG8_SCHED;
            } else {
            PG8_LDB(B0, 0, 0); PG8_SCHED; PG8_LDA(At, 0, 0); PG8_STAGE(PG8_SA(1, 1), a1 + hstep, voffA);
            PG8_WAIT_L(8); PG8_BAR; PG8_WAIT_L(0); PG8_MMA(0, 0, At, B0); PG8_BAR; PG8_SCHED;
            PG8_LDB(B1, 0, 1); PG8_STAGE(PG8_SB(0, 0), b2, voffB);
            PG8_BAR; PG8_WAIT_L(0); PG8_MMA(0, 1, At, B1); PG8_BAR;
            PG8_LDA(At, 0, 1); PG8_STAGE(PG8_SA(0, 0), a2, voffA);
            PG8_BAR; PG8_WAIT_L(0); PG8_MMA(1, 0, At, B0); PG8_BAR; PG8_SCHED;
            PG8_STAGE(PG8_SB(0, 1), b2 + hstep, voffB);
            PG8_WAIT_V(6); PG8_BAR; PG8_MMA(1, 1, At, B1); PG8_BAR;
            PG8_LDB(B0, 1, 0); PG8_SCHED; PG8_LDA(At, 1, 0); PG8_STAGE(PG8_SA(0, 1), a2 + hstep, voffA);
            PG8_WAIT_L(8); PG8_BAR; PG8_WAIT_L(0); PG8_MMA(0, 0, At, B0); PG8_BAR; PG8_SCHED;
            PG8_LDB(B1, 1, 1); PG8_STAGE(PG8_SB(1, 0), b3, voffB);
            PG8_BAR; PG8_WAIT_L(0); PG8_MMA(0, 1, At, B1); PG8_BAR;
            PG8_LDA(At, 1, 1); PG8_STAGE(PG8_SA(1, 0), a3, voffA);
            PG8_BAR; PG8_WAIT_L(0); PG8_MMA(1, 0, At, B0); PG8_BAR; PG8_SCHED;
            PG8_STAGE(PG8_SB(1, 1), b3 + hstep, voffB);
            PG8_WAIT_V(6); PG8_BAR; PG8_MMA(1, 1, At, B1); PG8_BAR;
            }
        }
        if constexpr (ALIGN_EPI) { if (wr == 0) PG8_BAR; }
        if constexpr (!Epi::AFTER_DRAIN) { E(acc, cur, wr, wc, fr, fq); S.done(cur); }
        if (!has_next) break;
#pragma unroll
        for (int a = 0; a < 2; ++a)
#pragma unroll
            for (int b = 0; b < 2; ++b)
#pragma unroll
                for (int m = 0; m < 4; ++m)
#pragma unroll
                    for (int n = 0; n < 2; ++n) acc[a][b][m][n] = (f32x4){0.f, 0.f, 0.f, 0.f};
        cur = nxt; cA = nA; cB = nB; ++ui;
        if constexpr (ALIGN_EPI) { if (wr == 1) PG8_BAR; }
    }
    PG8_WAIT_V(0);
    if constexpr (!ALIGN_EPI) { if (wr == 0) PG8_BAR; }
    PG8_BAR;
    if constexpr (Epi::AFTER_DRAIN) { E.fused(acc, cur, wr, wc, fr, fq, lds, wid, lane); S.done(cur); }
#undef PG8_SA
#undef PG8_SB
#undef PG8_STAGE
#undef PG8_LDA
#undef PG8_LDB
#undef PG8_LDA8
#undef PG8_LDB8
#undef PG8_MMA8
#undef PG8_MMA
#undef PG8_WAIT_V
#undef PG8_WAIT_L
#undef PG8_BAR
#undef PG8_SCHED
}
}
#include <hip/hip_bf16.h>
#include <cmath>
namespace attn_body {
using bf16=__hip_bfloat16;
using bf16x8=__attribute__((ext_vector_type(8)))short;
using s16x4=__attribute__((ext_vector_type(4)))short;
using f32x16=__attribute__((ext_vector_type(16)))float;
using u32x4=__attribute__((ext_vector_type(4)))unsigned;
constexpr int BATCH=4,NHEAD=8,SEQ=4096,D=64,DM=3072,OPITCH=1024;
constexpr int NW=8,QBLK=32,QB=QBLK*NW,KVBLK=64,NQB=SEQ/QB;
constexpr int ATTN_UNIT_ROWS=QB;
__device__ __forceinline__ int crow(int r,int hi){return (r&3)+8*(r>>2)+4*hi;}
#define SBAR() __builtin_amdgcn_sched_barrier(0)
__device__ __forceinline__ void cmask(f32x16&p0,f32x16&p1,int jb,int qrel,int hi){
  const float NEG=-INFINITY; int kb=64*jb+4*hi;
  #pragma unroll
  for(int r=0;r<16;++r){int kv=kb+(r&3)+8*(r>>2); if(kv>qrel)p0[r]=NEG; if(kv+32>qrel)p1[r]=NEG;}
}

constexpr int NSLOT=3, SLOTB=8192;
constexpr int LDS_K=0, LDS_V=NSLOT*SLOTB, LDS_WS=2*NSLOT*SLOTB, LDS_OST=LDS_WS+NW*64*4, LDS_BYTES=LDS_OST+NW*4096;
constexpr float C2=0.125f*1.4426950408889634f;
__device__ __forceinline__ void glds16(const void*gsrc,unsigned lds_dst){unsigned keep;
  asm volatile("s_mov_b32 %0, m0\n\ts_mov_b32 m0, %2\n\ts_nop 0\n\tglobal_load_lds_dwordx4 %1, off\n\ts_mov_b32 m0, %0":"=&s"(keep):"v"(gsrc),"s"(lds_dst):"memory");}
__device__ __forceinline__ void glds16s(const void*sbase,unsigned voff,unsigned lds_dst){unsigned keep;
  asm volatile("s_mov_b32 %0, m0\n\ts_mov_b32 m0, %3\n\ts_nop 0\n\tglobal_load_lds_dwordx4 %1, %2\n\ts_mov_b32 m0, %0":"=&s"(keep):"v"(voff),"s"(sbase),"s"(lds_dst):"memory");}
__device__ __forceinline__ float max3f(float a,float b,float c){float r;asm("v_max3_f32 %0, %1, %2, %3":"=v"(r):"v"(a),"v"(b),"v"(c));return r;}
__device__ __forceinline__ float max2f(float a,float b){float r;asm("v_max_f32_e32 %0, %1, %2":"=v"(r):"v"(a),"v"(b));return r;}
__device__ __forceinline__ float fadd_s(float a,float b){float r;asm("v_add_f32_e32 %0, %1, %2":"=v"(r):"v"(a),"v"(b));return r;}
__device__ __forceinline__ float fsub_s(float a,float b){float r;asm("v_sub_f32_e32 %0, %1, %2":"=v"(r):"v"(a),"v"(b));return r;}
typedef float f32x2_t __attribute__((ext_vector_type(2))); typedef __bf16 bf16x2_t __attribute__((ext_vector_type(2)));
__device__ __forceinline__ unsigned cvtpk_s(float lo,float hi){f32x2_t v={lo,hi};bf16x2_t b=__builtin_convertvector(v,bf16x2_t);return __builtin_bit_cast(unsigned,b);}
#define WAIT_BAR(N) asm volatile("s_waitcnt vmcnt(" #N ") lgkmcnt(0)\n\ts_barrier":::"memory")

__device__ __forceinline__ void qkt(f32x16&p0,f32x16&p1,const char*Kslot,const bf16x8*qr,int r32,int hi){
  const f32x16 negm=f32x16{};
  const char*kb=Kslot+hi*1024+r32*16;
  #pragma unroll
  for(int d0=0;d0<4;++d0){
    const bf16x8 b0=*reinterpret_cast<const bf16x8*>(kb+d0*2048);
    const bf16x8 b1=*reinterpret_cast<const bf16x8*>(kb+d0*2048+512);
    if(d0==0){p0=__builtin_amdgcn_mfma_f32_32x32x16_bf16(b0,qr[0],negm,0,0,0);p1=__builtin_amdgcn_mfma_f32_32x32x16_bf16(b1,qr[0],negm,0,0,0);}
    else{p0=__builtin_amdgcn_mfma_f32_32x32x16_bf16(b0,qr[d0],p0,0,0,0);p1=__builtin_amdgcn_mfma_f32_32x32x16_bf16(b1,qr[d0],p1,0,0,0);}}
}
typedef __attribute__((address_space(3))) const char* lds_cptr;
typedef short v4i16_t __attribute__((ext_vector_type(4)));
__device__ __forceinline__ void kload8(bf16x8*kf,lds_cptr kp){
  kf[0]=*(const __attribute__((address_space(3))) bf16x8*)(kp);      kf[1]=*(const __attribute__((address_space(3))) bf16x8*)(kp+512);
  kf[2]=*(const __attribute__((address_space(3))) bf16x8*)(kp+2048); kf[3]=*(const __attribute__((address_space(3))) bf16x8*)(kp+2560);
  kf[4]=*(const __attribute__((address_space(3))) bf16x8*)(kp+4096); kf[5]=*(const __attribute__((address_space(3))) bf16x8*)(kp+4608);
  kf[6]=*(const __attribute__((address_space(3))) bf16x8*)(kp+6144); kf[7]=*(const __attribute__((address_space(3))) bf16x8*)(kp+6656);
}
__device__ __forceinline__ void kload2(bf16x8*kf,lds_cptr kp,int j){ kf[2*j]=*(const __attribute__((address_space(3))) bf16x8*)(kp+j*2048); kf[2*j+1]=*(const __attribute__((address_space(3))) bf16x8*)(kp+j*2048+512); }
__device__ __forceinline__ s16x4 vtr(lds_cptr p){ return __builtin_bit_cast(s16x4,__builtin_amdgcn_ds_read_tr16_b64_v4i16((__attribute__((address_space(3))) v4i16_t*)p)); }
__device__ __forceinline__ float rowmax(const f32x16&p0,const f32x16&p1){
  float a=max3f(p0[0],p0[1],p1[0]),b=max3f(p0[2],p0[3],p1[1]);a=max3f(a,p1[2],p1[3]);
  #pragma unroll
  for(int r=4;r<16;r+=4){a=max3f(a,p0[r],p0[r+1]);b=max3f(b,p0[r+2],p0[r+3]);a=max3f(a,p1[r],p1[r+1]);b=max3f(b,p1[r+2],p1[r+3]);}
  const float m=max2f(a,b);
  auto rr=__builtin_amdgcn_permlane32_swap(__float_as_uint(m),__float_as_uint(m),false,false);
  return max2f(__uint_as_float(rr[0]),__uint_as_float(rr[1]));
}
__device__ __forceinline__ void pv(f32x16*o,int vb,bf16x8 pa0,bf16x8 pa1,bf16x8 pa2,bf16x8 pa3){
  #pragma unroll
  for(int d0=0;d0<2;++d0){s16x4 lo[4],hi[4];
    #pragma unroll
    for(int ks=0;ks<4;++ks){
      asm volatile("ds_read_b64_tr_b16 %0,%1 offset:%c2":"=&v"(lo[ks]):"v"(vb),"i"(d0*4096+ks*1024):"memory");
      asm volatile("ds_read_b64_tr_b16 %0,%1 offset:%c2":"=&v"(hi[ks]):"v"(vb),"i"(d0*4096+ks*1024+512):"memory");}
    asm volatile("s_waitcnt lgkmcnt(0)":::"memory");SBAR();
    #define PK(k) (bf16x8){lo[k][0],lo[k][1],lo[k][2],lo[k][3],hi[k][0],hi[k][1],hi[k][2],hi[k][3]}
    o[d0]=__builtin_amdgcn_mfma_f32_32x32x16_bf16(pa0,PK(0),o[d0],0,0,0);
    o[d0]=__builtin_amdgcn_mfma_f32_32x32x16_bf16(pa1,PK(1),o[d0],0,0,0);
    o[d0]=__builtin_amdgcn_mfma_f32_32x32x16_bf16(pa2,PK(2),o[d0],0,0,0);
    o[d0]=__builtin_amdgcn_mfma_f32_32x32x16_bf16(pa3,PK(3),o[d0],0,0,0);
    #undef PK
  }
}

#define ATTN_YQ (127.f/6.f)
#ifndef ATTN_STORE16
#define ATTN_STORE16(p,v) st16_wt((p),(v))
#endif
template<int THRL> __device__ __forceinline__ void attn_unit(int b,int h,int qb,const bf16*Q,const bf16*__restrict__ K,const bf16*__restrict__ V,bf16*O,const float*KSUM,const float*GG,char*shm){
  int tid_=threadIdx.x; asm volatile("":"+v"(tid_)); const int tid=tid_,lane=tid&63,r32=lane&31,hi=lane>>5; const int wid=__builtin_amdgcn_readfirstlane(tid>>6);
  const long rowbase=(long)b*SEQ; const int q0=qb*QB;
  const bf16*Qw=Q+(rowbase+q0+wid*QBLK)*DM+h*D;
  const bf16*Kh=K+rowbase*DM+h*D,*Vh=V+rowbase*DM+h*D;
  const unsigned lds0=(unsigned)(uintptr_t)shm;
  float*wsf=(float*)(shm+LDS_WS)+wid*64;
  const unsigned koff=(unsigned)((lane*DM+wid*8)*2);
  const unsigned voffs=(unsigned)(((16*(wid&3)+(lane>>2))*DM+(wid>>2)*32+(lane&3)*8)*2);
  const unsigned kdst=lds0+LDS_K+wid*1024, vdst=lds0+LDS_V+wid*1024;
  #define PT(t) (((t)<4)?(NT-4+(t)):((t)-4))
  #define DMA_K(t,slot) glds16s((const char*)Kh+(long)PT(t)*(KVBLK*DM*2),koff,(unsigned)__builtin_amdgcn_readfirstlane(kdst+(slot)))
  #define DMA_V(t,slot) glds16s((const char*)Vh+(long)PT(t)*(KVBLK*DM*2),voffs,(unsigned)__builtin_amdgcn_readfirstlane(vdst+(slot)))
  const int vb0=(int)(lds0+LDS_V)+((lane>>4)&1)*32+(lane&3)*8+(4*hi+((lane&15)>>2))*64;
  const char*Kbase=shm+LDS_K; bf16x8 kf[8];
  const lds_cptr shm3=(lds_cptr)shm; const lds_cptr kp0=shm3+LDS_K+hi*1024+r32*16; const lds_cptr vp0=shm3+LDS_V+((lane>>4)&1)*32+(lane&3)*8+(4*hi+((lane&15)>>2))*64;
  const int NT=(q0+QB)/KVBLK;
  DMA_K(0,0);DMA_V(0,0);DMA_K(1,SLOTB);
  bf16x8 qr[4];
  #pragma unroll
  for(int d0=0;d0<4;++d0)qr[d0]=*reinterpret_cast<const bf16x8*>(&Qw[(long)r32*DM+d0*16+hi*8]);
  float mhat=0.f,l_reg=0.f;f32x16 o[2];o[0]=f32x16{};o[1]=f32x16{};const f32x16 z16=f32x16{};
  unsigned selm=(1u<<qb)-1u;
  if(qb>3){
    f32x16 gt=f32x16{};
    #pragma unroll
    for(int d0=0;d0<4;++d0){ const float*kp=KSUM+((long)(b*16+(r32&15)))*512+h*D+d0*16+hi*8;
      const float4 k0=*reinterpret_cast<const float4*>(kp),k1=*reinterpret_cast<const float4*>(kp+4);
      u32x4 kw; kw.x=cvtpk_s(k0.x,k0.y);kw.y=cvtpk_s(k0.z,k0.w);kw.z=cvtpk_s(k1.x,k1.y);kw.w=cvtpk_s(k1.z,k1.w);
      gt=__builtin_amdgcn_mfma_f32_32x32x16_bf16(__builtin_bit_cast(bf16x8,kw),qr[d0],gt,0,0,0); }
    float v0=-INFINITY,v1=-INFINITY,v2=-INFINITY; int i0=0,i1=0,i2=0;
    #define INS3(vv,ii) do{ const float x_=(vv); const int j_=(ii); \
      if(x_>v0){v2=v1;i2=i1;v1=v0;i1=i0;v0=x_;i0=j_;} else if(x_>v1){v2=v1;i2=i1;v1=x_;i1=j_;} else if(x_>v2){v2=x_;i2=j_;} }while(0)
    #pragma unroll
    for(int r=0;r<8;++r){ const int j=crow(r,hi); INS3(j<qb?gt[r]:-INFINITY,j); }
    const float p0=__shfl_xor(v0,32),p1=__shfl_xor(v1,32),p2=__shfl_xor(v2,32); const int q0i=__shfl_xor(i0,32),q1i=__shfl_xor(i1,32),q2i=__shfl_xor(i2,32);
    INS3(p0,q0i); INS3(p1,q1i); INS3(p2,q2i);
    #undef INS3
    selm=(1u<<i0)|(1u<<i1)|(1u<<i2);
  }
  const int qrel=wid*QBLK+r32;
  #define CMASK(P0,P1,t) do{ if((t)<4)cmask(P0,P1,(t),qrel,hi); }while(0)
  bool resc=false;
  #define START(P0,P1) do{ const float rm=rowmax(P0,P1); resc=false; \
    { const float dl=rm; mhat=fadd_s(mhat,dl); \
      _Pragma("unroll") for(int r=0;r<16;++r){P0[r]=fsub_s(P0[r],dl);P1[r]=fsub_s(P1[r],dl);} \
      } \
    _Pragma("unroll") for(int r=0;r<16;++r)P0[r]=__builtin_amdgcn_exp2f(P0[r]); }while(0)
  #define RESC() do{ if(resc){ asm volatile("s_waitcnt lgkmcnt(0)":::"memory"); \
      _Pragma("unroll") for(int d_=0;d_<2;++d_) _Pragma("unroll") for(int r=0;r<16;++r)o[d_][r]*=wsf[crow(r,hi)]; } }while(0)
  f32x16 pA0,pA1,pB0,pB1;
  int sl_prev=0,sl_cur=0,sl_next=SLOTB;
  #define ROT() do{sl_prev=sl_cur;sl_cur=sl_next;sl_next=(sl_next==(NSLOT-1)*SLOTB)?0:sl_next+SLOTB;}while(0)
  DMA_K(2,2*SLOTB);
  WAIT_BAR(3);
  qkt(pA0,pA1,Kbase,qr,r32,hi);asm volatile("s_nop 15\n\ts_nop 7":"+v"(pA0),"+v"(pA1));CMASK(pA0,pA1,0);
  START(pA0,pA1);
  _Pragma("unroll") for(int r=0;r<16;++r)pA1[r]=__builtin_amdgcn_exp2f(pA1[r]);
  WAIT_BAR(0);
  DMA_K(3,0);DMA_V(1,SLOTB);
  ROT();
  kload8(kf,kp0+sl_cur);
  WAIT_BAR(2);
  s16x4 vlo[8],vhi[8]; u32x4 pw0,pw1,pw2,pw3;
  #define PKW(P,B) cvtpk_s(P[B],P[B+1])
  #define PAF(k) __builtin_bit_cast(bf16x8,pw##k)
  #define VFR(i) (bf16x8){vlo[i][0],vlo[i][1],vlo[i][2],vlo[i][3],vhi[i][0],vhi[i][1],vhi[i][2],vhi[i][3]}
  #define PIN(x) asm volatile("":"+v"(x))
  #define MX3(a,b,c) __builtin_fmaxf(__builtin_fmaxf((a),(b)),(c))
  #define GAPA(MF,A0,A1,A2,A3,W0,W1,PW) do{ MF; sacc+=A0; sacc+=A1; sacc+=A2; sacc+=A3; PIN(sacc); W0; W1; PIN(PW); SBAR(); }while(0)
  #define EX(v) __builtin_amdgcn_exp2f(v)
  #define GAPB(MF,X,B) do{ MF; X[B]=EX(X[B]); X[B+1]=EX(X[B+1]); X[B+2]=EX(X[B+2]); X[B+3]=EX(X[B+3]); PIN(X); SBAR(); }while(0)
  #define VRD(i) do{ vlo[i]=vtr(vp_+(((i)>>2)*4096+((i)&3)*1024)); vhi[i]=vtr(vp_+(((i)>>2)*4096+((i)&3)*1024+512)); }while(0)
  #define KRD(G,j) do{ if(G){ kload2(kf,kp0+sl_next,j); SBAR(); } }while(0)
  #define STEP(C0,C1,P0,P1,t,GK,GV,GL) do{ SBAR(); \
    const lds_cptr vp_=vp0+sl_prev; \
    VRD(0); SBAR(); float sacc=(P0[0]+P0[1]); \
    GAPA(C0=__builtin_amdgcn_mfma_f32_32x32x16_bf16(kf[0],qr[0],z16,0,0,0), P0[2],P0[3],P0[4],P0[5],     pw0[0]=PKW(P0,0), pw0[1]=PKW(P0,2), pw0); \
    VRD(4); SBAR(); GAPA(C1=__builtin_amdgcn_mfma_f32_32x32x16_bf16(kf[1],qr[0],z16,0,0,0), P0[6],P0[7],P0[8],P0[9],     pw0[2]=PKW(P0,4), pw0[3]=PKW(P0,6), pw0); \
    VRD(1); SBAR(); GAPA(C0=__builtin_amdgcn_mfma_f32_32x32x16_bf16(kf[2],qr[1],C0,0,0,0),   P0[10],P0[11],P0[12],P0[13], pw1[0]=PKW(P0,8), pw1[1]=PKW(P0,10), pw1); \
    VRD(5); SBAR(); GAPA(C1=__builtin_amdgcn_mfma_f32_32x32x16_bf16(kf[3],qr[1],C1,0,0,0),   P0[14],P0[15],P1[0],P1[1],   pw1[2]=PKW(P0,12),pw1[3]=PKW(P0,14), pw1); \
    VRD(2); SBAR(); GAPA(C0=__builtin_amdgcn_mfma_f32_32x32x16_bf16(kf[4],qr[2],C0,0,0,0),   P1[2],P1[3],P1[4],P1[5],     pw2[0]=PKW(P1,0), pw2[1]=PKW(P1,2), pw2); \
    VRD(6); SBAR(); GAPA(C1=__builtin_amdgcn_mfma_f32_32x32x16_bf16(kf[5],qr[2],C1,0,0,0),   P1[6],P1[7],P1[8],P1[9],     pw2[2]=PKW(P1,4), pw2[3]=PKW(P1,6), pw2); \
    VRD(3); SBAR(); GAPA(C0=__builtin_amdgcn_mfma_f32_32x32x16_bf16(kf[6],qr[3],C0,0,0,0),   P1[10],P1[11],P1[12],P1[13], pw3[0]=PKW(P1,8), pw3[1]=PKW(P1,10), pw3); \
    VRD(7); SBAR(); GAPA(C1=__builtin_amdgcn_mfma_f32_32x32x16_bf16(kf[7],qr[3],C1,0,0,0),   P1[14],P1[15],0.f,0.f,       pw3[2]=PKW(P1,12),pw3[3]=PKW(P1,14), pw3); \
    l_reg+=sacc; \
    if(GK){DMA_K((t)+3,sl_cur);} if(GV){DMA_V((t)+1,sl_next);} \
    { const bool v_=((t)<4)||((selm>>(((t)-4)>>2))&1u); const float nm_=v_?-mhat:-INFINITY; \
      _Pragma("unroll") for(int r=0;r<16;++r){C0[r]+=nm_;C1[r]+=nm_;} } \
    CMASK(C0,C1,t); \
    { float a=MX3(C0[0],C0[1],C1[0]),b=MX3(C0[2],C0[3],C1[1]); a=MX3(a,C1[2],C1[3]); \
      _Pragma("unroll") for(int r=4;r<16;r+=4){a=MX3(a,C0[r],C0[r+1]);b=MX3(b,C0[r+2],C0[r+3]);a=MX3(a,C1[r],C1[r+1]);b=MX3(b,C1[r+2],C1[r+3]);} \
      float rm=__builtin_fmaxf(a,b); { auto rr=__builtin_amdgcn_permlane32_swap(__float_as_uint(rm),__float_as_uint(rm),false,false); rm=__builtin_fmaxf(__uint_as_float(rr[0]),__uint_as_float(rr[1])); } \
      resc=false; \
      if(__builtin_expect(__any(rm>(float)THRL),0)){ const float dl=__builtin_fmaxf(rm,0.f); mhat+=dl; \
        _Pragma("unroll") for(int r=0;r<16;++r){C0[r]-=dl;C1[r]-=dl;} \
        const float f=__builtin_amdgcn_exp2f(-dl); l_reg*=f; if(hi==0)wsf[r32]=f; resc=true; } } \
    SBAR(); \
    GAPB(o[0]=__builtin_amdgcn_mfma_f32_32x32x16_bf16(PAF(0),VFR(0),o[0],0,0,0), C0,0); \
    GAPB(o[1]=__builtin_amdgcn_mfma_f32_32x32x16_bf16(PAF(0),VFR(4),o[1],0,0,0), C0,4); \
    KRD(GL,0); GAPB(o[0]=__builtin_amdgcn_mfma_f32_32x32x16_bf16(PAF(1),VFR(1),o[0],0,0,0), C0,8); \
    KRD(GL,1); GAPB(o[1]=__builtin_amdgcn_mfma_f32_32x32x16_bf16(PAF(1),VFR(5),o[1],0,0,0), C0,12); \
    KRD(GL,2); GAPB(o[0]=__builtin_amdgcn_mfma_f32_32x32x16_bf16(PAF(2),VFR(2),o[0],0,0,0), C1,0); \
    KRD(GL,3); GAPB(o[1]=__builtin_amdgcn_mfma_f32_32x32x16_bf16(PAF(2),VFR(6),o[1],0,0,0), C1,4); \
    GAPB(o[0]=__builtin_amdgcn_mfma_f32_32x32x16_bf16(PAF(3),VFR(3),o[0],0,0,0), C1,8); \
    GAPB(o[1]=__builtin_amdgcn_mfma_f32_32x32x16_bf16(PAF(3),VFR(7),o[1],0,0,0), C1,12); \
    }while(0)
  int t=1;
  #define ENDW(tt) do{ if((tt)+3<NT){WAIT_BAR(2);} else if((tt)+2<NT){WAIT_BAR(1);} else {WAIT_BAR(0);} }while(0)
  for(;t<5&&t+1<NT;t+=2){
    STEP(pB0,pB1,pA0,pA1,t,(t+3<NT),(t+1<NT),(t+1<NT));       ENDW(t);   RESC(); ROT();
    STEP(pA0,pA1,pB0,pB1,t+1,(t+4<NT),(t+2<NT),(t+2<NT));     ENDW(t+1); RESC(); ROT();
  }
  #undef CMASK
  #define CMASK(P0,P1,t) do{}while(0)
  for(;t+5<NT;t+=2){
    STEP(pB0,pB1,pA0,pA1,t,true,true,true);     WAIT_BAR(2); RESC(); ROT();
    STEP(pA0,pA1,pB0,pB1,t+1,true,true,true);   WAIT_BAR(2); RESC(); ROT();
  }
  #undef CMASK
  #define CMASK(P0,P1,t) do{ if((t)<4)cmask(P0,P1,(t),qrel,hi); }while(0)
  for(;t+1<NT;t+=2){
    STEP(pB0,pB1,pA0,pA1,t,(t+3<NT),(t+1<NT),(t+1<NT));       ENDW(t);   RESC(); ROT();
    STEP(pA0,pA1,pB0,pB1,t+1,(t+4<NT),(t+2<NT),(t+2<NT));     ENDW(t+1); RESC(); ROT();
  }
  STEP(pB0,pB1,pA0,pA1,NT-1,false,false,false); RESC();
  { float sacc=pB0[0]+pB0[1]; _Pragma("unroll") for(int r=2;r<16;++r)sacc+=pB0[r]; _Pragma("unroll") for(int r=0;r<16;++r)sacc+=pB1[r]; l_reg+=sacc;
    pw0=(u32x4){PKW(pB0,0),PKW(pB0,2),PKW(pB0,4),PKW(pB0,6)};pw1=(u32x4){PKW(pB0,8),PKW(pB0,10),PKW(pB0,12),PKW(pB0,14)};pw2=(u32x4){PKW(pB1,0),PKW(pB1,2),PKW(pB1,4),PKW(pB1,6)};pw3=(u32x4){PKW(pB1,8),PKW(pB1,10),PKW(pB1,12),PKW(pB1,14)};
    SBAR(); pv(o,vb0+sl_cur,PAF(0),PAF(1),PAF(2),PAF(3)); }
  #undef PKW
  #undef PAF
  #undef VFR
  #undef PIN
  #undef MX3
  #undef GAPA
  #undef GAPB
  #undef EX
  #undef VRD
  #undef KRD
  #undef STEP
  #undef ENDW
  {auto rr=__builtin_amdgcn_permlane32_swap(__float_as_uint(l_reg),__float_as_uint(l_reg),false,false);l_reg=__uint_as_float(rr[0])+__uint_as_float(rr[1]);}
  if(hi==0)wsf[32+r32]=l_reg;asm volatile("s_waitcnt lgkmcnt(0)":::"memory");
  float rli[16];
  #pragma unroll
  for(int r=0;r<16;++r)rli[r]=__builtin_amdgcn_rcpf(wsf[32+crow(r,hi)]);
  bf16*Ow=O+(rowbase+q0+wid*QBLK)*OPITCH+h*D;
  { bf16*stg=(bf16*)(shm+LDS_OST)+wid*2048;
    #pragma unroll
    for(int r=0;r<16;++r){const int orow=crow(r,hi);
      #pragma unroll
      for(int d0=0;d0<2;++d0)stg[orow*64+d0*32+r32]=__float2bfloat16(o[d0][r]*rli[r]);}
    asm volatile("s_waitcnt lgkmcnt(0)":::"memory");
    const int ch=lane&7; float gg[8];
    #pragma unroll
    for(int i=0;i<8;++i)gg[i]=GG[h*D+ch*8+i];
    #pragma unroll
    for(int i=0;i<4;++i){const int row=i*8+(lane>>3); const u32x4 v=*(const u32x4*)(stg+row*64+ch*8);
      float x[8]; x[0]=__uint_as_float(v.x<<16);x[1]=__uint_as_float(v.x&0xffff0000u);x[2]=__uint_as_float(v.y<<16);x[3]=__uint_as_float(v.y&0xffff0000u);
      x[4]=__uint_as_float(v.z<<16);x[5]=__uint_as_float(v.z&0xffff0000u);x[6]=__uint_as_float(v.w<<16);x[7]=__uint_as_float(v.w&0xffff0000u);
      float ss=0.f;
      #pragma unroll
      for(int k=0;k<8;++k)ss+=x[k]*x[k];
      ss+=__shfl_xor(ss,1);ss+=__shfl_xor(ss,2);ss+=__shfl_xor(ss,4);
      const float rs=rsqrtf(ss*(1.f/64.f)+1e-6f);
      const float qn=rs*ATTN_YQ; unsigned w0=0u,w1=0u;
      #pragma unroll
      for(int k=0;k<4;++k){const int a=(int)fminf(fmaxf(__builtin_rintf(x[k]*qn),-127.f),127.f),b=(int)fminf(fmaxf(__builtin_rintf(x[4+k]*qn),-127.f),127.f); w0|=((unsigned)a&0xffu)<<(8*k); w1|=((unsigned)b&0xffu)<<(8*k);}
      st8_wt((void*)((unsigned char*)O+((rowbase+q0+wid*QBLK+row)*(long)OPITCH+h*D+ch*8)),(unsigned long long)w0|((unsigned long long)w1<<32));} }
  asm volatile("s_waitcnt lgkmcnt(0)\n\ts_barrier":::"memory");
  #undef DMA_K
  #undef PT
  #undef DMA_V
  #undef CMASK
  #undef START
  #undef RESC
  #undef ROT
}
constexpr int ATTN_LDS_BYTES=LDS_BYTES;
struct AttnTensors { const bf16* Q; const bf16* K; const bf16* V; bf16* O; const float* KSUM; const float* GG; };
struct AttnUnit { int bh; int qb; };
struct StaticOrder {
  int vcu,G;
  __device__ __forceinline__ explicit StaticOrder(int grid,int block):vcu((grid%8==0)?(block%8)*(grid/8)+block/8:block),G(grid){}
  __device__ __forceinline__ bool next(int i,AttnUnit&u)const{ const int pr=vcu+(i>>1)*G; if(pr>=256)return false; const int s=pr&7; u.bh=pr>>3; u.qb=(i&1)?s:15-s; return true; }
  __device__ __forceinline__ void a_ready(const AttnUnit&)const{}
  __device__ __forceinline__ void done(const AttnUnit&)const{}
};
template<class Sched,int THRL=8> __device__ __forceinline__ void attn_phase(char*lds,const AttnTensors&T,const Sched&S){
  AttnUnit u;
  for(int i=0;S.next(i,u);++i){ S.a_ready(u); attn_unit<THRL>(u.bh/NHEAD,u.bh%NHEAD,u.qb,T.Q,T.K,T.V,T.O,T.KSUM,T.GG,lds); S.done(u); }
}
#undef SBAR
#undef WAIT_BAR
}

#define GAS __attribute__((address_space(1)))
#define LAS __attribute__((address_space(3)))
typedef unsigned short bf16;
typedef unsigned v4u __attribute__((ext_vector_type(4)));
typedef float f32x4 __attribute__((ext_vector_type(4)));
typedef short bf16x8 __attribute__((ext_vector_type(8)));
typedef GAS unsigned gu32;
typedef GAS unsigned long long gu64;
#define RLX_AGENT __ATOMIC_RELAXED, __HIP_MEMORY_SCOPE_AGENT
#define LDS_WAIT() asm volatile("s_waitcnt lgkmcnt(0)" ::: "memory")
#define VM_WAIT() asm volatile("s_waitcnt vmcnt(0)" ::: "memory")
__device__ __forceinline__ unsigned long long rt() { return __builtin_amdgcn_s_memrealtime(); }
__device__ __forceinline__ unsigned f2bf(float f) { unsigned u = __builtin_bit_cast(unsigned, f); return (u + 0x7fffu + ((u >> 16) & 1u)) >> 16; }
__device__ __forceinline__ unsigned pk2(float lo, float hi) { return f2bf(lo) | (f2bf(hi) << 16); }

#define XB_TMO      128
#define XB_XCNT(j)  (256  + 64 * (j))
#define XB_XSUB(j)  (1280 + 64 * (j))
#define XB_XGEN(j)  (2304 + 64 * (j))
#define XB_TOP      3328
#define XB_TOPGEN   3392
#define XCD_BAR_WORDS 3456
#define XB_SPIN_CAP (1u << 18)

__device__ __forceinline__ unsigned xb_ld(unsigned* p)              { return __hip_atomic_load(p, __ATOMIC_RELAXED, __HIP_MEMORY_SCOPE_AGENT); }
__device__ __forceinline__ unsigned xb_add(unsigned* p, unsigned v) { return __hip_atomic_fetch_add(p, v, __ATOMIC_RELAXED, __HIP_MEMORY_SCOPE_AGENT); }
__device__ __forceinline__ unsigned xb_xcc_id() { return (unsigned)__builtin_amdgcn_s_getreg((3 << 11) | 20) & 0xFu; }
#define XB_SPIN(cond, bar) do { unsigned _sp = 0; while (cond) { __builtin_amdgcn_s_sleep(1); \
    if ((++_sp & 255u) == 0u) { if (xb_ld(&(bar)[XB_TMO])) break; if (_sp > XB_SPIN_CAP) { atomicAdd(&(bar)[XB_TMO], 1u); break; } } } } while (0)

struct XcdBarrier {
    unsigned* bar; unsigned x;
    volatile LAS unsigned* st;
};

__device__ __forceinline__ XcdBarrier xcd_barrier_post(unsigned* bar, volatile LAS unsigned* st) {
    XcdBarrier b; b.bar = bar; b.x = xb_xcc_id(); b.st = st;
    if (threadIdx.x == 0) (void)xb_add(&bar[XB_XCNT(b.x)], 1u);
    return b;
}
__device__ __forceinline__ void xcd_barrier_complete(unsigned* bar, unsigned x, unsigned& nloc, unsigned& nx) {
    const unsigned G = gridDim.x * gridDim.y * gridDim.z;
    unsigned sum, cnt, mine, sp = 0u;
    for (;;) {
        sum = 0u; cnt = 0u; mine = 0u;
#pragma unroll
        for (unsigned j = 0; j < 16; ++j) { const unsigned c = xb_ld(&bar[XB_XCNT(j)]); sum += c; cnt += (c > 0u) ? 1u : 0u; mine = (j == x) ? c : mine; }
        if (sum == G) break;
        __builtin_amdgcn_s_sleep(1);
        if ((++sp & 255u) == 0u) { if (xb_ld(&bar[XB_TMO])) break; if (sp > XB_SPIN_CAP) { atomicAdd(&bar[XB_TMO], 1u); break; } }
    }
    nloc = mine > 0u ? mine : 1u; nx = cnt > 0u ? cnt : 1u;
}

__device__ __forceinline__ void xcd_barrier(const XcdBarrier& b) {
    asm volatile("s_waitcnt vmcnt(0)" ::: "memory");
    __syncthreads();
    if (threadIdx.x == 0) {
        unsigned* bar = b.bar;
        __builtin_amdgcn_s_waitcnt(0);
        unsigned nloc = b.st[0], nx = b.st[1];
        if (nloc == 0u) { xcd_barrier_complete(bar, b.x, nloc, nx); b.st[0] = nloc; b.st[1] = nx; }
        const unsigned old = xb_add(&bar[XB_XSUB(b.x)], 1u);
        const unsigned gen = old / nloc;
        if (old + 1u == (gen + 1u) * nloc) {
            asm volatile("s_waitcnt vmcnt(0)" ::: "memory");
            const unsigned og = xb_add(&bar[XB_TOP], 1u);
            const unsigned tg = og / nx;
            if (og + 1u == (tg + 1u) * nx) xb_add(&bar[XB_TOPGEN], 1u);
            else XB_SPIN(xb_ld(&bar[XB_TOPGEN]) == tg, bar);
            __builtin_amdgcn_fence(__ATOMIC_ACQUIRE, "agent");
            xb_add(&bar[XB_XGEN(b.x)], 1u);
            asm volatile("s_waitcnt vmcnt(0)" ::: "memory");
        } else {
            XB_SPIN(xb_ld(&bar[XB_XGEN(b.x)]) == gen, bar);
            __builtin_amdgcn_fence(__ATOMIC_ACQUIRE, "agent");
            asm volatile("s_waitcnt vmcnt(0)" ::: "memory");
        }
    }
    __syncthreads();
}

constexpr int NWAVES = 8;
constexpr int NB = 4, S = 4096, D = 1024, M = NB * S;
constexpr int NIN = 3072, NQ = 2048, NEXP = 16384;
constexpr float EPS = 1e-6f;
constexpr float C2 = 0.125f * 1.4426950408889634f;

constexpr size_t MiB = 1u << 20;
constexpr size_t WS_CTL = 0, CTL_ZERO_BYTES = 256 * 1024;
constexpr size_t WS_MOD = 1 * MiB;
constexpr size_t WS_KMEAN = 128 * 1024;
constexpr size_t WS_KEYS = 1 * MiB + 512 * 1024;
constexpr size_t WS_WIN = 2 * MiB, WS_WO = 8 * MiB, WS_WQ = 10 * MiB;
constexpr size_t WS_EIDX = 14 * MiB, WS_G = 22 * MiB;
constexpr size_t WS_U = 32 * MiB, WS_V = 64 * MiB;
constexpr size_t WS_SU = 48 * MiB, WS_SV = 48 * MiB + 64 * 1024;
constexpr size_t WS_H = 96 * MiB;
constexpr size_t WS_P = 128 * MiB;
constexpr size_t WS_QP = 128 * MiB, WS_O = 192 * MiB;
constexpr size_t WS_Y = 224 * MiB, WS_END = 256 * MiB;
constexpr int CW_BAR = 1024;
constexpr int CW_CMAX = 8192;
constexpr int CW_CMAX3 = CW_CMAX + 3072 + 2048;
constexpr float YQ = 127.f / 6.f;
constexpr int CW_CMAX2 = CW_CMAX + 3072;
constexpr size_t WS_WO8 = 47 * MiB;
constexpr size_t WS_WQ8 = 45 * MiB, WS_RS2 = 44 * MiB + 65536;
constexpr size_t WS_WIN8 = 40 * MiB, WS_RS = 44 * MiB;

constexpr int LDS_BYTES = 153600;
constexpr int LDSCTL_OFF = LDS_BYTES - 512, MISC_OFF = LDSCTL_OFF + 320;
constexpr int RING_BYTES = 131072;

struct Frame {
    LAS unsigned char* lds;
    volatile LAS unsigned* MISC;
    gu32* ctl;
    int tid, lane, wave, G;
    const float *x, *c, *ada_w, *ada_b, *pre_gain, *post_gain, *w_in, *conv_w, *group_gain, *w_out, *fpre_gain, *fpost_gain, *wq, *keys, *pu, *pv;
    float* out;
    float* mod; float* kmean; bf16* keysb; bf16 *WinT, *WoT, *WqT; int* eidx; float* gw; unsigned char *U8, *V8; float *su, *sv; bf16 *H, *P, *QP, *O, *Y; float* scratch; unsigned char* Win8; float* rs; unsigned char* Wq8; float* rs2; unsigned char* Wo8;
};

__device__ __forceinline__ float wave_sum(float v) {
#pragma unroll
    for (int o = 1; o < 64; o <<= 1) v += __shfl_xor(v, o);
    return v;
}
__device__ __forceinline__ float bflo(unsigned u) { return __uint_as_float(u << 16); }
__device__ __forceinline__ float bfhi(unsigned u) { return __uint_as_float(u & 0xffff0000u); }

template <bool CMAX = false, bool KSC = false> __device__ __forceinline__ void p0_transpose_item(const float* W, int K, int N, bf16* WT, LAS float* scr, int item, int lane, unsigned* cmax = nullptr, const float* ksc = nullptr) {
    const int nblk = N / 32, kb = item / nblk, nb = item % nblk, k0 = 64 * kb, n0 = 32 * nb;
#pragma unroll 8
    for (int i = 0; i < 32; ++i) { const int kk = 2 * i + (lane >> 5); float wv = W[(size_t)(k0 + kk) * N + n0 + (lane & 31)]; if (KSC) wv *= ksc[k0 + kk] * (1.f / YQ); scr[kk * 33 + (lane & 31)] = wv; }
    LDS_WAIT(); asm volatile("" ::: "memory");
    const int c = lane & 7;
#pragma unroll
    for (int j = 0; j < 4; ++j) { const int n = (lane >> 3) + 8 * j; const LAS float* s = scr + (8 * c) * 33 + n;
        v4u o; o.x = pk2(s[0 * 33], s[1 * 33]); o.y = pk2(s[2 * 33], s[3 * 33]); o.z = pk2(s[4 * 33], s[5 * 33]); o.w = pk2(s[6 * 33], s[7 * 33]);
        st16_wt((void*)(WT + (size_t)(n0 + n) * K + k0 + 8 * c), o);
        if (CMAX) {
            float am = fmaxf(fmaxf(fmaxf(fabsf(s[0 * 33]), fabsf(s[1 * 33])), fmaxf(fabsf(s[2 * 33]), fabsf(s[3 * 33]))), fmaxf(fmaxf(fabsf(s[4 * 33]), fabsf(s[5 * 33])), fmaxf(fabsf(s[6 * 33]), fabsf(s[7 * 33]))));
            am = fmaxf(am, __shfl_xor(am, 1)); am = fmaxf(am, __shfl_xor(am, 2)); am = fmaxf(am, __shfl_xor(am, 4));
            if (c == 0) atomicMax(cmax + n0 + n, __float_as_uint(am));
        } }
    LDS_WAIT(); asm volatile("" ::: "memory");
}
__device__ __forceinline__ void cvt8(const float* src, bf16* dst, size_t i8) {
    const f32x4 a = *(const GAS f32x4*)(src + i8 * 8), b = *(const GAS f32x4*)(src + i8 * 8 + 4);
    v4u o; o.x = pk2(a.x, a.y); o.y = pk2(a.z, a.w); o.z = pk2(b.x, b.y); o.w = pk2(b.z, b.w);
    st16_wt((void*)(dst + i8 * 8), o);
}
__device__ __forceinline__ void p0_prep(Frame& F) {
    {
        LAS float* sc = (LAS float*)F.lds;
        LAS float* red = sc + 4096;
        bool did = false;
        for (int it = blockIdx.x; it < 192; it += F.G) {
            if (!did) { for (int i = F.tid; i < 4096; i += 512) { const float v = F.c[i]; sc[i] = v / (1.f + __expf(-v)); } did = true; }
            __syncthreads();
            const int c4 = F.tid & 7, ks = F.tid >> 3, j0 = it * 32 + 4 * c4;
            f32x4 w[16];
#pragma unroll
            for (int i = 0; i < 16; ++i) w[i] = *(const GAS f32x4*)(F.ada_w + (size_t)(ks * 16 + i) * 6144 + j0);
            f32x4 a0 = {0.f, 0.f, 0.f, 0.f}, a1 = a0, a2 = a0, a3 = a0;
#pragma unroll
            for (int i = 0; i < 16; ++i) { const int r = ks * 16 + i; a0 += w[i] * sc[r]; a1 += w[i] * sc[1024 + r]; a2 += w[i] * sc[2048 + r]; a3 += w[i] * sc[3072 + r]; }
            *(LAS f32x4*)(red + (ks * 4 + 0) * 32 + 4 * c4) = a0; *(LAS f32x4*)(red + (ks * 4 + 1) * 32 + 4 * c4) = a1;
            *(LAS f32x4*)(red + (ks * 4 + 2) * 32 + 4 * c4) = a2; *(LAS f32x4*)(red + (ks * 4 + 3) * 32 + 4 * c4) = a3;
            __syncthreads();
            if (F.tid < 128) { const int b = F.tid >> 5, jj = F.tid & 31; float s = 0.f;
#pragma unroll 16
                for (int k = 0; k < 64; ++k) s += red[(k * 4 + b) * 32 + jj];
                __hip_atomic_store(F.mod + b * 6144 + it * 32 + jj, s + F.ada_b[it * 32 + jj], __ATOMIC_RELAXED, __HIP_MEMORY_SCOPE_AGENT); }
        }
        __syncthreads();
    }
    LAS float* scr = (LAS float*)(F.lds + F.wave * 16384);
    const int gwv = blockIdx.x * NWAVES + F.wave, NGW = F.G * NWAVES;
    constexpr int I_IN = (D / 64) * (NIN / 32), I_O = (D / 64) * (D / 32), I_Q = (D / 64) * (NQ / 32);
    for (int it = gwv; it < I_IN + I_O + I_Q; it += NGW) {
        int r = it;
        if (r < I_IN) { p0_transpose_item<true>(F.w_in, D, NIN, F.WinT, scr, r, F.lane, (unsigned*)(F.ctl + CW_CMAX)); continue; } r -= I_IN;
        if (r < I_O) { p0_transpose_item<true, true>(F.w_out, D, D, F.WoT, scr, r, F.lane, (unsigned*)(F.ctl + CW_CMAX3), F.group_gain); continue; } r -= I_O;
        p0_transpose_item<true>(F.wq, D, NQ, F.WqT, scr, r, F.lane, (unsigned*)(F.ctl + CW_CMAX2));
    }
    const size_t gt = (size_t)blockIdx.x * 512 + F.tid, NT = (size_t)F.G * 512;
    for (size_t i = gt; i < (size_t)16 * 128 * 128 / 8; i += NT) cvt8(F.keys, F.keysb, i);
    for (int row0 = gwv; row0 < 2 * NEXP; row0 += 2 * NGW) {
      f32x4 a2[2][4];
#pragma unroll
      for (int rr = 0; rr < 2; ++rr) { const int row = row0 + rr * NGW; if (row < 2 * NEXP) { const GAS f32x4* src = (const GAS f32x4*)(((row >> 14) ? F.pv : F.pu) + (size_t)(row & (NEXP - 1)) * D + 16 * F.lane);
#pragma unroll
          for (int i = 0; i < 4; ++i) a2[rr][i] = src[i]; } }
#pragma unroll
      for (int rr = 0; rr < 2; ++rr) { const int row = row0 + rr * NGW; if (row >= 2 * NEXP) break;
        const int tabv = row >> 14, e = row & (NEXP - 1);
        f32x4 a[4]; float ssq = 0.f;
#pragma unroll
        for (int i = 0; i < 4; ++i) { a[i] = a2[rr][i]; ssq += (a[i].x * a[i].x + a[i].y * a[i].y) + (a[i].z * a[i].z + a[i].w * a[i].w); }
        ssq = wave_sum(ssq);
        const float rms = sqrtf(ssq * (1.f / D));
        if (tabv == 0) {
            const float stepq = 0.34f * rms, isq = stepq > 0.f ? 1.f / stepq : 0.f;
            unsigned d0 = 0u, d1 = 0u;
#pragma unroll
            for (int i = 0; i < 4; ++i) { const float xs[4] = {a[i].x, a[i].y, a[i].z, a[i].w};
#pragma unroll
                for (int c = 0; c < 4; ++c) { const int q = (int)fminf(fmaxf(__builtin_rintf(xs[c] * isq), -7.f), 7.f); const int el = 4 * i + c;
                    if (el < 8) d0 |= (unsigned)(q & 15) << (4 * el); else d1 |= (unsigned)(q & 15) << (4 * (el - 8)); } }
            st8_wt((void*)(F.U8 + (size_t)e * 512 + 8 * F.lane), (unsigned long long)d0 | ((unsigned long long)d1 << 32));
            if (F.lane == 0) __hip_atomic_store(F.su + e, stepq, __ATOMIC_RELAXED, __HIP_MEMORY_SCOPE_AGENT);
        } else {
            const float unit = 0.5f * rms, iu = unit > 0.f ? 1.f / unit : 0.f;
            unsigned d0 = 0u, d1 = 0u;
            d0 = __builtin_amdgcn_cvt_scalef32_pk_fp4_f32(d0, a[0].x * iu, a[0].y * iu, 1.0f, 0); d0 = __builtin_amdgcn_cvt_scalef32_pk_fp4_f32(d0, a[0].z * iu, a[0].w * iu, 1.0f, 1);
            d0 = __builtin_amdgcn_cvt_scalef32_pk_fp4_f32(d0, a[1].x * iu, a[1].y * iu, 1.0f, 2); d0 = __builtin_amdgcn_cvt_scalef32_pk_fp4_f32(d0, a[1].z * iu, a[1].w * iu, 1.0f, 3);
            d1 = __builtin_amdgcn_cvt_scalef32_pk_fp4_f32(d1, a[2].x * iu, a[2].y * iu, 1.0f, 0); d1 = __builtin_amdgcn_cvt_scalef32_pk_fp4_f32(d1, a[2].z * iu, a[2].w * iu, 1.0f, 1);
            d1 = __builtin_amdgcn_cvt_scalef32_pk_fp4_f32(d1, a[3].x * iu, a[3].y * iu, 1.0f, 2); d1 = __builtin_amdgcn_cvt_scalef32_pk_fp4_f32(d1, a[3].z * iu, a[3].w * iu, 1.0f, 3);
            st8_wt((void*)(F.V8 + (size_t)(F.lane >> 4) * (NEXP * 128) + (size_t)e * 128 + (F.lane & 15) * 8), (unsigned long long)d0 | ((unsigned long long)d1 << 32));
            if (F.lane == 0) __hip_atomic_store(F.sv + e, unit, __ATOMIC_RELAXED, __HIP_MEMORY_SCOPE_AGENT);
        }
      }
    }
}

__device__ __forceinline__ unsigned q8x4(const f32x4 v, float qs) {
    const int a = (int)__builtin_rintf(v.x * qs), b = (int)__builtin_rintf(v.y * qs), c = (int)__builtin_rintf(v.z * qs), d = (int)__builtin_rintf(v.w * qs);
    return ((unsigned)a & 0xffu) | (((unsigned)b & 0xffu) << 8) | (((unsigned)c & 0xffu) << 16) | ((unsigned)d << 24);
}
__device__ __forceinline__ unsigned q8x4c(const f32x4 v, float qs) {
    const int a = (int)fminf(fmaxf(__builtin_rintf(v.x * qs), -127.f), 127.f), b = (int)fminf(fmaxf(__builtin_rintf(v.y * qs), -127.f), 127.f);
    const int c = (int)fminf(fmaxf(__builtin_rintf(v.z * qs), -127.f), 127.f), d = (int)fminf(fmaxf(__builtin_rintf(v.w * qs), -127.f), 127.f);
    return ((unsigned)a & 0xffu) | (((unsigned)b & 0xffu) << 8) | (((unsigned)c & 0xffu) << 16) | ((unsigned)d << 24);
}
__device__ __forceinline__ void p1_hnorm(Frame& F) {
    const int gwv = blockIdx.x * NWAVES + F.wave, NGW = F.G * NWAVES;
    for (int m0 = gwv * 4; m0 < M; m0 += NGW * 4) {
        const int b = m0 >> 12;
        f32x4 v[4][4];
#pragma unroll
        for (int r = 0; r < 4; ++r) { const GAS f32x4* xr = (const GAS f32x4*)(F.x + (size_t)(m0 + r) * D) + F.lane;
#pragma unroll
            for (int j = 0; j < 4; ++j) v[r][j] = xr[64 * j]; }
        f32x4 gs[4], sh[4];
#pragma unroll
        for (int j = 0; j < 4; ++j) { const int col = 4 * F.lane + 256 * j;
            gs[j] = *(const GAS f32x4*)(F.pre_gain + col) * (*(const GAS f32x4*)(F.mod + b * 6144 + 1024 + col) + 1.f); sh[j] = *(const GAS f32x4*)(F.mod + b * 6144 + col); }
#pragma unroll
        for (int r = 0; r < 4; ++r) {
            float ss = 0.f;
#pragma unroll
            for (int j = 0; j < 4; ++j) ss += (v[r][j].x * v[r][j].x + v[r][j].y * v[r][j].y) + (v[r][j].z * v[r][j].z + v[r][j].w * v[r][j].w);
            const float rstd = rsqrtf(wave_sum(ss) * (1.f / D) + EPS);
            f32x4 o[4]; float am = 0.f;
#pragma unroll
            for (int j = 0; j < 4; ++j) { o[j] = v[r][j] * rstd * gs[j] + sh[j]; am = fmaxf(am, fmaxf(fmaxf(fabsf(o[j].x), fabsf(o[j].y)), fmaxf(fabsf(o[j].z), fabsf(o[j].w)))); }
#pragma unroll
            for (int of = 1; of < 64; of <<= 1) am = fmaxf(am, __shfl_xor(am, of));
            const float qs = am > 0.f ? 127.f / am : 0.f;
            v4u w; w.x = q8x4(o[0], qs); w.y = q8x4(o[1], qs); w.z = q8x4(o[2], qs); w.w = q8x4(o[3], qs);
            st16_wt((void*)((unsigned char*)F.H + (size_t)(m0 + r) * D + 16 * F.lane), w);
            if (F.lane == 0) __hip_atomic_store(F.rs + m0 + r, am * (1.f / 127.f), __ATOMIC_RELAXED, __HIP_MEMORY_SCOPE_AGENT);
        }
    }
    for (int n = gwv; n < NIN; n += NGW) {
        const float cm = __uint_as_float(F.ctl[CW_CMAX + n]); const float qs = cm > 0.f ? 127.f / cm : 0.f;
        const GAS unsigned long long* src = (const GAS unsigned long long*)(F.WinT + (size_t)n * D) + F.lane;
        unsigned long long q[4];
#pragma unroll
        for (int j = 0; j < 4; ++j) q[j] = src[64 * j];
        unsigned wd[4];
#pragma unroll
        for (int j = 0; j < 4; ++j) { const unsigned lo = (unsigned)q[j], hi = (unsigned)(q[j] >> 32); wd[j] = q8x4((f32x4){bflo(lo), bfhi(lo), bflo(hi), bfhi(hi)}, qs); }
        v4u w; w.x = wd[0]; w.y = wd[1]; w.z = wd[2]; w.w = wd[3];
        st16_wt((void*)(F.Win8 + (size_t)n * D + 16 * F.lane), w);
    }
    for (int n = gwv; n < NQ; n += NGW) {
        const float cm = __uint_as_float(F.ctl[CW_CMAX2 + n]); const float qs = cm > 0.f ? 127.f / cm : 0.f;
        const GAS v4u* src = (const GAS v4u*)(F.WqT + (size_t)n * D + 16 * F.lane);
        const v4u q0 = src[0], q1 = src[1];
        v4u w; w.x = q8x4((f32x4){bflo(q0.x), bfhi(q0.x), bflo(q0.y), bfhi(q0.y)}, qs); w.y = q8x4((f32x4){bflo(q0.z), bfhi(q0.z), bflo(q0.w), bfhi(q0.w)}, qs);
        w.z = q8x4((f32x4){bflo(q1.x), bfhi(q1.x), bflo(q1.y), bfhi(q1.y)}, qs); w.w = q8x4((f32x4){bflo(q1.z), bfhi(q1.z), bflo(q1.w), bfhi(q1.w)}, qs);
        st16_wt((void*)(F.Wq8 + (size_t)n * D + 16 * F.lane), w);
    }
    for (int n = gwv; n < D; n += NGW) {
        const float cm = __uint_as_float(F.ctl[CW_CMAX3 + n]); const float qs = cm > 0.f ? 127.f / cm : 0.f;
        const GAS v4u* src = (const GAS v4u*)(F.WoT + (size_t)n * D + 16 * F.lane);
        const v4u q0 = src[0], q1 = src[1];
        v4u w; w.x = q8x4((f32x4){bflo(q0.x), bfhi(q0.x), bflo(q0.y), bfhi(q0.y)}, qs); w.y = q8x4((f32x4){bflo(q0.z), bfhi(q0.z), bflo(q0.w), bfhi(q0.w)}, qs);
        w.z = q8x4((f32x4){bflo(q1.x), bfhi(q1.x), bflo(q1.y), bfhi(q1.y)}, qs); w.w = q8x4((f32x4){bflo(q1.z), bfhi(q1.z), bflo(q1.w), bfhi(q1.w)}, qs);
        st16_wt((void*)(F.Wo8 + (size_t)n * D + 16 * F.lane), w);
    }
}

__device__ __forceinline__ void unpack8(const v4u w, float* f) { f[0] = bflo(w.x); f[1] = bfhi(w.x); f[2] = bflo(w.y); f[3] = bfhi(w.y); f[4] = bflo(w.z); f[5] = bfhi(w.z); f[6] = bflo(w.w); f[7] = bfhi(w.w); }
__device__ __forceinline__ void p6_conv(Frame& F) {
    const int gwv = blockIdx.x * NWAVES + F.wave, NGW = F.G * NWAVES;
    const int col = 8 * F.lane;
    float cw[3][8], gg[8];
#pragma unroll
    for (int j = 0; j < 3; ++j)
#pragma unroll
        for (int i = 0; i < 8; ++i) cw[j][i] = F.conv_w[j * 512 + col + i];
#pragma unroll
    for (int i = 0; i < 8; ++i) gg[i] = F.group_gain[col + i];
    for (int t0 = gwv * 4; t0 < M; t0 += NGW * 4) {
        const int s0 = t0 & 4095;
        v4u gbw[4], gcw[6], hxw[6];
#pragma unroll
        for (int r = 0; r < 4; ++r) gbw[r] = *(const GAS v4u*)(F.P + (size_t)(t0 + r) * NIN + col);
#pragma unroll
        for (int k = 0; k < 6; ++k) { const int tt = (s0 == 0 && k < 2) ? t0 : (t0 - 2 + k);
            const bf16* rp = F.P + (size_t)tt * NIN + col; gcw[k] = *(const GAS v4u*)(rp + 512); hxw[k] = *(const GAS v4u*)(rp + 1024); }
        float u[6][8];
#pragma unroll
        for (int k = 0; k < 6; ++k) { float gc[8], hx[8]; unpack8(gcw[k], gc); unpack8(hxw[k], hx); const float keep = (s0 == 0 && k < 2) ? 0.f : 1.f;
#pragma unroll
            for (int i = 0; i < 8; ++i) u[k][i] = keep * gc[i] * hx[i]; }
#pragma unroll
        for (int r = 0; r < 4; ++r) {
            float acc[8], gb[8]; unpack8(gbw[r], gb);
            float ss = 0.f;
#pragma unroll
            for (int i = 0; i < 8; ++i) { acc[i] = gb[i] * (cw[0][i] * u[r][i] + cw[1][i] * u[r + 1][i] + cw[2][i] * u[r + 2][i]); ss += acc[i] * acc[i]; }
            ss += __shfl_xor(ss, 1); ss += __shfl_xor(ss, 2); ss += __shfl_xor(ss, 4);
            const float rstd = rsqrtf(ss * (1.f / 64.f) + EPS);
            const float qn = rstd * YQ;
            const unsigned w0 = q8x4c((f32x4){acc[0], acc[1], acc[2], acc[3]}, qn), w1 = q8x4c((f32x4){acc[4], acc[5], acc[6], acc[7]}, qn);
            st8_wt((void*)((unsigned char*)F.Y + (size_t)(t0 + r) * D + col), (unsigned long long)w0 | ((unsigned long long)w1 << 32));
        }
    }
}
__device__ __forceinline__ void p8_resid(Frame& F) {
    const int gwv = blockIdx.x * NWAVES + F.wave, NGW = F.G * NWAVES;
    for (int m0 = gwv * 2; m0 < M; m0 += NGW * 2) {
        const float* md = F.mod + (m0 >> 12) * 6144;
        unsigned long long ow[2][4]; f32x4 xv[2][4];
#pragma unroll
        for (int r = 0; r < 2; ++r) {
            const GAS unsigned long long* orow = (const GAS unsigned long long*)(F.O + (size_t)(m0 + r) * D) + F.lane; const GAS f32x4* xr = (const GAS f32x4*)(F.x + (size_t)(m0 + r) * D) + F.lane;
#pragma unroll
            for (int j = 0; j < 4; ++j) { ow[r][j] = orow[64 * j]; xv[r][j] = xr[64 * j]; } }
        f32x4 gg[4], gs[4], sh[4];
#pragma unroll
        for (int j = 0; j < 4; ++j) { const int col = 4 * F.lane + 256 * j;
            gg[j] = *(const GAS f32x4*)(F.post_gain + col) * *(const GAS f32x4*)(md + 2048 + col);
            gs[j] = *(const GAS f32x4*)(F.fpre_gain + col) * (*(const GAS f32x4*)(md + 4096 + col) + 1.f); sh[j] = *(const GAS f32x4*)(md + 3072 + col); }
#pragma unroll
        for (int r = 0; r < 2; ++r) { const int m = m0 + r;
            f32x4 ov[4]; float ss = 0.f;
#pragma unroll
            for (int j = 0; j < 4; ++j) { const unsigned lo = (unsigned)ow[r][j], hi = (unsigned)(ow[r][j] >> 32); ov[j] = (f32x4){bflo(lo), bfhi(lo), bflo(hi), bfhi(hi)};
                ss += (ov[j].x * ov[j].x + ov[j].y * ov[j].y) + (ov[j].z * ov[j].z + ov[j].w * ov[j].w); }
            const float rstd = rsqrtf(wave_sum(ss) * (1.f / D) + EPS);
            GAS unsigned long long* x1r = (GAS unsigned long long*)(F.QP + (size_t)m * D) + F.lane;
            f32x4 x1[4]; float s2 = 0.f;
#pragma unroll
            for (int j = 0; j < 4; ++j) { x1[j] = xv[r][j] + gg[j] * (ov[j] * rstd); st8_wt((void*)(x1r + 64 * j), (unsigned long long)pk2(x1[j].x, x1[j].y) | ((unsigned long long)pk2(x1[j].z, x1[j].w) << 32));
                s2 += (x1[j].x * x1[j].x + x1[j].y * x1[j].y) + (x1[j].z * x1[j].z + x1[j].w * x1[j].w); }
            const float rstd2 = rsqrtf(wave_sum(s2) * (1.f / D) + EPS);
            f32x4 o[4]; float am = 0.f;
#pragma unroll
            for (int j = 0; j < 4; ++j) { o[j] = x1[j] * rstd2 * gs[j] + sh[j]; am = fmaxf(am, fmaxf(fmaxf(fabsf(o[j].x), fabsf(o[j].y)), fmaxf(fabsf(o[j].z), fabsf(o[j].w)))); }
#pragma unroll
            for (int of = 1; of < 64; of <<= 1) am = fmaxf(am, __shfl_xor(am, of));
            const float qs = am > 0.f ? 119.f / am : 0.f;
#pragma unroll
            for (int j = 0; j < 4; ++j) st4_wt((void*)((unsigned char*)F.H + (size_t)m * D + 4 * F.lane + 256 * j), q8x4(o[j], qs));
            if (F.lane == 0) __hip_atomic_store(F.rs2 + m, am * (1.f / 119.f), __ATOMIC_RELAXED, __HIP_MEMORY_SCOPE_AGENT);
        }
    }
}
typedef float f32x16 __attribute__((ext_vector_type(16)));
__device__ __forceinline__ float vmaxf(float a, float b) { float r; asm("v_max_f32_e32 %0, %1, %2" : "=v"(r) : "v"(a), "v"(b)); return r; }
__device__ __forceinline__ float vminf(float a, float b) { float r; asm("v_min_f32_e32 %0, %1, %2" : "=v"(r) : "v"(a), "v"(b)); return r; }
#define CE_D(a, b) do { const float hi_ = vmaxf(a, b), lo_ = vminf(a, b); a = hi_; b = lo_; } while (0)
template <int N> __device__ __forceinline__ void bitonic_sort_desc(float (&v)[N]) {
#pragma unroll
    for (int k = 2; k <= N; k <<= 1)
#pragma unroll
        for (int j = k >> 1; j > 0; j >>= 1)
#pragma unroll
            for (int i = 0; i < N; ++i) { const int l = i ^ j; if (l > i) { if ((i & k) == 0) CE_D(v[i], v[l]); else CE_D(v[l], v[i]); } }
}
template <int N> __device__ __forceinline__ void bitonic_merge_desc(float (&v)[N]) {
#pragma unroll
    for (int j = N >> 1; j > 0; j >>= 1)
#pragma unroll
        for (int i = 0; i < N; ++i) { const int l = i ^ j; if (l > i) CE_D(v[i], v[l]); }
}
__device__ __forceinline__ void sort16_desc(float (&v)[16]) {
    CE_D(v[0], v[1]); CE_D(v[2], v[3]); CE_D(v[0], v[2]); CE_D(v[1], v[3]); CE_D(v[1], v[2]); CE_D(v[4], v[5]); CE_D(v[6], v[7]); CE_D(v[4], v[6]); CE_D(v[5], v[7]); CE_D(v[5], v[6]); CE_D(v[0], v[4]); CE_D(v[2], v[6]); CE_D(v[2], v[4]); CE_D(v[1], v[5]); CE_D(v[3], v[7]); CE_D(v[3], v[5]); CE_D(v[1], v[2]); CE_D(v[3], v[4]); CE_D(v[5], v[6]); CE_D(v[8], v[9]); CE_D(v[10], v[11]); CE_D(v[8], v[10]); CE_D(v[9], v[11]); CE_D(v[9], v[10]); CE_D(v[12], v[13]); CE_D(v[14], v[15]); CE_D(v[12], v[14]); CE_D(v[13], v[15]); CE_D(v[13], v[14]); CE_D(v[8], v[12]); CE_D(v[10], v[14]); CE_D(v[10], v[12]); CE_D(v[9], v[13]); CE_D(v[11], v[15]); CE_D(v[11], v[13]); CE_D(v[9], v[10]); CE_D(v[11], v[12]); CE_D(v[13], v[14]); CE_D(v[0], v[8]); CE_D(v[4], v[12]); CE_D(v[4], v[8]); CE_D(v[2], v[10]); CE_D(v[6], v[14]); CE_D(v[6], v[10]); CE_D(v[2], v[4]); CE_D(v[6], v[8]); CE_D(v[10], v[12]); CE_D(v[1], v[9]); CE_D(v[5], v[13]); CE_D(v[5], v[9]); CE_D(v[3], v[11]); CE_D(v[7], v[15]); CE_D(v[7], v[11]); CE_D(v[3], v[5]); CE_D(v[7], v[9]); CE_D(v[11], v[13]); CE_D(v[1], v[2]); CE_D(v[3], v[4]); CE_D(v[5], v[6]); CE_D(v[7], v[8]); CE_D(v[9], v[10]); CE_D(v[11], v[12]); CE_D(v[13], v[14]);
}
__device__ __forceinline__ void top16_merge(float (&a)[16], const float (&b)[16]) {
#pragma unroll
    for (int i = 0; i < 16; ++i) a[i] = vmaxf(a[i], b[15 - i]);
    bitonic_merge_desc<16>(a);
}
__device__ __forceinline__ void top16_of_64(const float (&v)[64], float (&out)[16]) {
    float g1[16], g2[16], g3[16];
#pragma unroll
    for (int i = 0; i < 16; ++i) { out[i] = v[i]; g1[i] = v[16 + i]; g2[i] = v[32 + i]; g3[i] = v[48 + i]; }
    sort16_desc(out); sort16_desc(g1); sort16_desc(g2); sort16_desc(g3);
    top16_merge(out, g1); top16_merge(g2, g3); top16_merge(out, g2);
}
constexpr int KROW = 272, KIMG = 128 * KROW;
__device__ __forceinline__ void route_half(const bf16x8 (&bq)[8], const LAS unsigned char* kimg, int r32, int hh, float (&svp)[16], unsigned (&ivp)[16]) {
    const LAS unsigned char* krow = kimg + r32 * KROW + 16 * hh;
    f32x16 acc[4];
#pragma unroll
    for (int nt = 0; nt < 4; ++nt) {
        acc[nt] = (f32x16){0.f, 0.f, 0.f, 0.f, 0.f, 0.f, 0.f, 0.f, 0.f, 0.f, 0.f, 0.f, 0.f, 0.f, 0.f, 0.f};
#pragma unroll
        for (int ks = 0; ks < 8; ++ks) { const bf16x8 ak = *(const LAS bf16x8*)(krow + nt * 32 * KROW + 32 * ks);
            acc[nt] = __builtin_amdgcn_mfma_f32_32x32x16_bf16(ak, bq[ks], acc[nt], 0, 0, 0); }
    }
    float v[64];
#pragma unroll
    for (int nt = 0; nt < 4; ++nt)
#pragma unroll
        for (int i = 0; i < 16; ++i) { const unsigned code = (unsigned)(32 * nt + 8 * (i >> 2) + (i & 3)); v[nt * 16 + i] = __uint_as_float((__float_as_uint(acc[nt][i]) & ~127u) | code); }
    float L[16], Pn[16];
    top16_of_64(v, L);
#pragma unroll
    for (int i = 0; i < 16; ++i) { L[i] = __uint_as_float(__float_as_uint(L[i]) | (unsigned)(hh << 2)); Pn[i] = __shfl_xor(L[i], 32); }
    top16_merge(L, Pn);
#pragma unroll
    for (int i = 0; i < 16; ++i) { const unsigned bits = __float_as_uint(L[i]); svp[i] = __uint_as_float(bits & ~127u); ivp[i] = bits & 127u; }
}
__device__ __forceinline__ void route_finish(const float (&sv)[2][16], const unsigned (&iv)[2][16], LAS unsigned* tab, int lane, int hh, int* epi, float* gpf, float rst) {
#define CAND(a, b) __uint_as_float((__float_as_uint(sv[0][a] + sv[1][b]) & ~255u) | (unsigned)((a) * 16 + (b)))
    float W[16], g1[16], g2[16];
#pragma unroll
    for (int i = 0; i < 16; ++i) W[i] = CAND(0, i);
#pragma unroll
    for (int i = 0; i < 15; ++i) g1[i] = CAND(i + 1, 0);
    g1[15] = -3e38f;
    g2[0] = CAND(1, 1); g2[1] = CAND(1, 2); g2[2] = CAND(1, 3); g2[3] = CAND(1, 4); g2[4] = CAND(1, 5); g2[5] = CAND(1, 6); g2[6] = CAND(1, 7);
    g2[7] = CAND(2, 1); g2[8] = CAND(2, 2); g2[9] = CAND(2, 3); g2[10] = CAND(2, 4); g2[11] = CAND(3, 1); g2[12] = CAND(3, 2); g2[13] = CAND(3, 3); g2[14] = CAND(4, 1); g2[15] = CAND(4, 2);
    sort16_desc(g2);
    g2[13] = vmaxf(g2[13], CAND(7, 1)); g2[14] = vmaxf(g2[14], CAND(6, 1)); g2[15] = vmaxf(g2[15], CAND(5, 1));
    bitonic_merge_desc<16>(g2);
    top16_merge(W, g1); top16_merge(W, g2);
#undef CAND
#pragma unroll
    for (int j = 0; j < 16; ++j) { tab[j * 64 + lane] = iv[0][j]; tab[(16 + j) * 64 + lane] = iv[1][j]; }
    float e[16], sum = 0.f; unsigned ex[16];
    const float s0 = __uint_as_float(__float_as_uint(W[0]) & ~255u);
#pragma unroll
    for (int j = 0; j < 16; ++j) { const unsigned bits = __float_as_uint(W[j]); const unsigned code = bits & 255u;
        e[j] = __expf((__uint_as_float(bits & ~255u) - s0) * rst); sum += e[j];
        ex[j] = tab[(code >> 4) * 64 + lane] * 128u + tab[(16 + (code & 15u)) * 64 + lane]; }
    const float inv = 1.f / sum;
    v4u eo0, eo1; f32x4 go0, go1;
    eo0.x = hh ? ex[8] : ex[0]; eo0.y = hh ? ex[9] : ex[1]; eo0.z = hh ? ex[10] : ex[2]; eo0.w = hh ? ex[11] : ex[3];
    eo1.x = hh ? ex[12] : ex[4]; eo1.y = hh ? ex[13] : ex[5]; eo1.z = hh ? ex[14] : ex[6]; eo1.w = hh ? ex[15] : ex[7];
    go0.x = (hh ? e[8] : e[0]) * inv; go0.y = (hh ? e[9] : e[1]) * inv; go0.z = (hh ? e[10] : e[2]) * inv; go0.w = (hh ? e[11] : e[3]) * inv;
    go1.x = (hh ? e[12] : e[4]) * inv; go1.y = (hh ? e[13] : e[5]) * inv; go1.z = (hh ? e[14] : e[6]) * inv; go1.w = (hh ? e[15] : e[7]) * inv;
    GAS v4u* ep = (GAS v4u*)epi; GAS f32x4* gp = (GAS f32x4*)gpf;
    st16_wt((void*)ep, eo0); st16_wt((void*)(ep + 1), eo1); st16_wt((void*)gp, __builtin_bit_cast(wt_v4u, go0)); st16_wt((void*)(gp + 1), __builtin_bit_cast(wt_v4u, go1));
}
__device__ __forceinline__ pg8::f32x4 i2f(const pg8::f32x4 a) { const pg8::i32x4 i = __builtin_bit_cast(pg8::i32x4, a); return (pg8::f32x4){(float)i[0], (float)i[1], (float)i[2], (float)i[3]}; }
struct EpiRoute {
    static constexpr bool PERM = true, AFTER_DRAIN = true;
    const bf16* keysb; int* eidx; float* gw; const unsigned* cmax2; const float* rs2;
    __device__ __forceinline__ void fused(pg8::f32x4 (&acc)[2][2][4][2], const pg8::Unit& u, int wr, int wc, int fr, int fq, LAS unsigned char* lds, int wid, int lane) const {
        int tid_ = threadIdx.x; asm volatile("" : "+v"(tid_)); const int h = u.pn, r32 = lane & 31, hh = lane >> 5, tid = tid_;
        LAS unsigned char* Qs = lds; LAS unsigned char* Ks = lds + 256 * KROW;
        v4u q1[2][4];
#pragma unroll
        for (int ai = 0; ai < 2; ++ai)
#pragma unroll
            for (int m = 0; m < 4; ++m) { const pg8::f32x4 a = i2f(acc[ai][1][m][0]), b = i2f(acc[ai][1][m][1]);
                q1[ai][m] = (v4u){pg8::cvt_pk_bf16(a[0], a[1]), pg8::cvt_pk_bf16(a[2], a[3]), pg8::cvt_pk_bf16(b[0], b[1]), pg8::cvt_pk_bf16(b[2], b[3])}; }
        float sv[2][16]; unsigned iv[2][16];
#pragma unroll
        for (int p = 0; p < 2; ++p) {
            if (p == 1) { asm volatile("s_waitcnt lgkmcnt(0)" ::: "memory"); __builtin_amdgcn_s_barrier(); asm volatile("" ::: "memory"); }
#pragma unroll
            for (int ai = 0; ai < 2; ++ai)
#pragma unroll
                for (int m = 0; m < 4; ++m) { v4u w;
                    if (p == 0) { const pg8::f32x4 a = i2f(acc[ai][0][m][0]), b = i2f(acc[ai][0][m][1]);
                        w = (v4u){pg8::cvt_pk_bf16(a[0], a[1]), pg8::cvt_pk_bf16(a[2], a[3]), pg8::cvt_pk_bf16(b[0], b[1]), pg8::cvt_pk_bf16(b[2], b[3])}; }
                    else w = q1[ai][m];
                    *(LAS v4u*)(Qs + (128 * ai + 64 * wr + 16 * m + fr) * KROW + (32 * wc + 8 * fq) * 2) = w; }
            { const int ch = tid & 15; const pg8::u32x4 c0 = *(const pg8::u32x4*)(cmax2 + h * 256 + p * 128 + ch * 8), c1 = *(const pg8::u32x4*)(cmax2 + h * 256 + p * 128 + ch * 8 + 4);
              float cs[8] = {__uint_as_float(c0.x), __uint_as_float(c0.y), __uint_as_float(c0.z), __uint_as_float(c0.w), __uint_as_float(c1.x), __uint_as_float(c1.y), __uint_as_float(c1.z), __uint_as_float(c1.w)};
#pragma unroll
              for (int i = 0; i < 8; ++i) cs[i] *= (1.f / 127.f);
              for (int c = tid; c < 128 * 16; c += NWAVES * 64) { const int row = c >> 4;
                const v4u kq = *(const GAS v4u*)(keysb + (size_t)((h * 2 + p) * 128 + row) * 128 + ch * 8);
                v4u ko; ko.x = pk2(bflo(kq.x) * cs[0], bfhi(kq.x) * cs[1]); ko.y = pk2(bflo(kq.y) * cs[2], bfhi(kq.y) * cs[3]); ko.z = pk2(bflo(kq.z) * cs[4], bfhi(kq.z) * cs[5]); ko.w = pk2(bflo(kq.w) * cs[6], bfhi(kq.w) * cs[7]);
                *(LAS v4u*)(Ks + row * KROW + ch * 16) = ko; } }
            asm volatile("s_waitcnt vmcnt(0) lgkmcnt(0)" ::: "memory"); __builtin_amdgcn_s_barrier(); asm volatile("" ::: "memory");
            bf16x8 bq[8];
#pragma unroll
            for (int ks = 0; ks < 8; ++ks) bq[ks] = *(const LAS bf16x8*)(Qs + (32 * wid + r32) * KROW + 32 * ks + 16 * hh);
            route_half(bq, Ks, r32, hh, sv[p], iv[p]);
        }
        asm volatile("s_waitcnt lgkmcnt(0)" ::: "memory"); __builtin_amdgcn_s_barrier(); asm volatile("" ::: "memory");
        const int t = u.pm * 256 + 32 * wid + r32;
        route_finish(sv, iv, (LAS unsigned*)(lds + wid * 8192), lane, hh, eidx + (size_t)t * 128 + h * 16 + 8 * hh, gw + (size_t)t * 128 + h * 16 + 8 * hh, rs2[t]);
        asm volatile("s_waitcnt lgkmcnt(0)" ::: "memory"); __builtin_amdgcn_s_barrier(); asm volatile("" ::: "memory");
    }
};
struct OneUnit {
    pg8::Unit u;
    __device__ __forceinline__ bool next(int i, pg8::Unit& o) const { if (i != 0) return false; o = u; return true; }
    __device__ __forceinline__ void a_ready(const pg8::Unit&) const {}
    __device__ __forceinline__ void done(const pg8::Unit&) const {}
};
__device__ __forceinline__ float gelu_tanh(float a) {
    const float z = 0.7978845608028654f * (a + 0.044715f * a * a * a);
    const float e = __expf(2.f * z);
    const float th = 1.f - 2.f / (e + 1.f);
    return 0.5f * a * (1.f + th);
}
typedef float f32x2v __attribute__((ext_vector_type(2)));
__device__ __forceinline__ void fp8x16_to_f32(const v4u w, float* f) {
    f32x2v t;
    t = __builtin_amdgcn_cvt_pk_f32_fp8((int)w.x, false); f[0] = t.x; f[1] = t.y; t = __builtin_amdgcn_cvt_pk_f32_fp8((int)w.x, true); f[2] = t.x; f[3] = t.y;
    t = __builtin_amdgcn_cvt_pk_f32_fp8((int)w.y, false); f[4] = t.x; f[5] = t.y; t = __builtin_amdgcn_cvt_pk_f32_fp8((int)w.y, true); f[6] = t.x; f[7] = t.y;
    t = __builtin_amdgcn_cvt_pk_f32_fp8((int)w.z, false); f[8] = t.x; f[9] = t.y; t = __builtin_amdgcn_cvt_pk_f32_fp8((int)w.z, true); f[10] = t.x; f[11] = t.y;
    t = __builtin_amdgcn_cvt_pk_f32_fp8((int)w.w, false); f[12] = t.x; f[13] = t.y; t = __builtin_amdgcn_cvt_pk_f32_fp8((int)w.w, true); f[14] = t.x; f[15] = t.y;
}
#define DPPF(x, ctrl) __uint_as_float((unsigned)__builtin_amdgcn_mov_dpp((int)__float_as_uint(x), ctrl, 0xf, 0xf, true))
__device__ __forceinline__ void swap16_add(float& a, float b) { auto r = __builtin_amdgcn_permlane16_swap(__float_as_uint(a), __float_as_uint(b), false, false); a = __uint_as_float(r[0]) + __uint_as_float(r[1]); }
__device__ __forceinline__ void swap32_add(float& a, float b) { auto r = __builtin_amdgcn_permlane32_swap(__float_as_uint(a), __float_as_uint(b), false, false); a = __uint_as_float(r[0]) + __uint_as_float(r[1]); }
constexpr int PW_BUF0 = 0, PW_SG = 4096, PW_BUF1 = 8192, PW_E = 16384, PW_WH = 17408, PW_WL = 17920, PW_YP = 18432, PW_IK = 18944, PW_BYTES = 18976;
static_assert(PW_BYTES * NWAVES <= LDSCTL_OFF, "PEER per-wave LDS blocks must stay below the control words");
typedef int v8i_t __attribute__((ext_vector_type(8)));
typedef int v2i_t __attribute__((ext_vector_type(2)));
__device__ __forceinline__ void peer_u_issue(v4u (&uw)[8], const unsigned char* U4, LAS unsigned char* wl, int it, int lane) {
    const int grp = it >> 2, j = it & 3, hw = lane >> 5, li = lane & 31;
#pragma unroll
    for (int q = 0; q < 8; ++q) { const unsigned e = *(const LAS unsigned short*)(wl + PW_E + (j * 128 + grp * 16 + 2 * q + hw) * 2);
        uw[q] = *(const GAS v4u*)(U4 + (e * 512u + 16u * (unsigned)li)); }
}
__device__ __forceinline__ void peer_u_compute(const v4u (&uw)[8], LAS unsigned char* wl, int it, int lane) {
    const int grp = it >> 2, j = it & 3, li = lane & 31;
    const v4u hh = *(LAS v4u*)(wl + j * 1024 + 16 * li), hl = *(LAS v4u*)(wl + j * 1024 + 512 + 16 * li);
    float pa[8];
#pragma unroll
    for (int q = 0; q < 8; ++q) {
        int dh = __builtin_amdgcn_sdot8((int)uw[q].x, (int)hh.x, 0, false); dh = __builtin_amdgcn_sdot8((int)uw[q].y, (int)hh.y, dh, false);
        dh = __builtin_amdgcn_sdot8((int)uw[q].z, (int)hh.z, dh, false); dh = __builtin_amdgcn_sdot8((int)uw[q].w, (int)hh.w, dh, false);
        int dl = __builtin_amdgcn_sdot8((int)uw[q].x, (int)hl.x, 0, false); dl = __builtin_amdgcn_sdot8((int)uw[q].y, (int)hl.y, dl, false);
        dl = __builtin_amdgcn_sdot8((int)uw[q].z, (int)hl.z, dl, false); dl = __builtin_amdgcn_sdot8((int)uw[q].w, (int)hl.w, dl, false);
        pa[q] = (float)(16 * dh + dl); }
    swap16_add(pa[0], pa[4]); swap16_add(pa[1], pa[5]); swap16_add(pa[2], pa[6]); swap16_add(pa[3], pa[7]);
#pragma unroll
    for (int i = 0; i < 4; ++i) { pa[i] += DPPF(pa[i], 0xB1); pa[i] += DPPF(pa[i], 0x4E); pa[i] += DPPF(pa[i], 0x141); pa[i] += DPPF(pa[i], 0x140); }
    if ((lane & 12) == 0) {
        const int q = lane & 3, r = lane >> 4;
        const int idx = j * 128 + grp * 16 + 2 * (q + 4 * (r & 1)) + (r >> 1);
        const f32x2v sg = *(const LAS f32x2v*)(wl + PW_SG + idx * 8);
        const float a = (q == 0 ? pa[0] : q == 1 ? pa[1] : q == 2 ? pa[2] : pa[3]) * sg.x;
        *(LAS float*)(wl + PW_BUF1 + idx * 4) = sg.y * gelu_tanh(a);
    }
}
__device__ __forceinline__ void peer_v_issue(const unsigned char* V8, LAS unsigned char* wl, unsigned lbase, int it, int lane, unsigned c16e, unsigned c16o) {
    const int sl = it >> 3, j = (it >> 1) & 3, hf = it & 1;
    const unsigned char* vbase = V8 + (size_t)sl * (NEXP * 128);
    const unsigned dst = lbase + PW_BUF0 + (it & 1) * 8192;
    unsigned go[8];
#pragma unroll
    for (int q = 0; q < 8; ++q) { const unsigned e = *(const LAS unsigned short*)(wl + PW_E + (j * 128 + 64 * hf + 8 * q + (lane >> 3)) * 2); go[q] = e * 128u + ((q & 1) ? c16o : c16e); }
#pragma unroll
    for (int q = 0; q < 8; ++q) attn_body::glds16s(vbase, go[q], (unsigned)__builtin_amdgcn_readfirstlane((int)(dst + q * 1024)));
}
__device__ __forceinline__ void peer_v_compute(LAS unsigned char* wl, f32x4 (&acc)[8], bf16* yrow0, int it, int lane) {
    const int sl = it >> 3, j = (it >> 1) & 3, hf = it & 1;
    const int m = lane & 15, kg = lane >> 4;
    const LAS unsigned char* wsrc = wl + ((m & 1) ? PW_WL : PW_WH) + j * 128 + 64 * hf + 16 * (kg & 1);
    const v4u a0 = *(const LAS v4u*)wsrc, a1 = *(const LAS v4u*)(wsrc + 32);
    const bool valid = (m < 4) && ((m >> 1) == (kg >> 1));
    v8i_t A;
    A[0] = valid ? (int)a0.x : 0; A[1] = valid ? (int)a0.y : 0; A[2] = valid ? (int)a0.z : 0; A[3] = valid ? (int)a0.w : 0;
    A[4] = valid ? (int)a1.x : 0; A[5] = valid ? (int)a1.y : 0; A[6] = valid ? (int)a1.z : 0; A[7] = valid ? (int)a1.w : 0;
    if (hf == 0) {
#pragma unroll
        for (int T = 0; T < 8; ++T) acc[T] = (f32x4){0.f, 0.f, 0.f, 0.f};
    }
    const LAS unsigned char* bb = wl + PW_BUF0 + (it & 1) * 8192 + (32 * (kg >> 1) + m) * 128 + 8 * (kg & 1);
    const unsigned x16 = (unsigned)(m >> 1) * 16u;
#pragma unroll
    for (int T = 0; T < 8; ++T) {
        const LAS unsigned char* p = bb + ((16u * T) ^ x16);
        const v2i_t b0 = __builtin_amdgcn_ds_read_tr4_b64_v2i32((LAS v2i_t*)p), b1 = __builtin_amdgcn_ds_read_tr4_b64_v2i32((LAS v2i_t*)(p + 2048));
        const v8i_t B = {b0.x, b0.y, b1.x, b1.y, 0, 0, 0, 0};
        acc[T] = __builtin_amdgcn_mfma_scale_f32_16x16x128_f8f6f4(A, B, acc[T], 0, 4, 0, 0x7f7f7f7f, 0, 0x7f7f7f7f);
    }
    if (hf == 1) {
        const float ik = *(const LAS float*)(wl + PW_IK + j * 4);
        LAS unsigned char* yp = lane < 16 ? wl + PW_YP + m * 2 : wl + PW_IK + 16;
        const int ystep = lane < 16 ? 1 : 0;
#pragma unroll
        for (int T = 0; T < 8; ++T) {
            *(LAS unsigned short*)(yp + ystep * (64 * T)) = (unsigned short)f2bf((acc[T][0] + acc[T][1]) * ik);
            *(LAS unsigned short*)(yp + ystep * (64 * T + 32)) = (unsigned short)f2bf((acc[T][2] + acc[T][3]) * ik);
        }
        asm volatile("" ::: "memory");
        const unsigned long long pk = *(const LAS unsigned long long*)(wl + PW_YP + 8 * lane);
        *(GAS unsigned long long*)(yrow0 + (size_t)j * D + 256 * sl + 4 * lane) = pk;
    }
}
__device__ __forceinline__ void p11_peer(Frame& F, float* dst) {
    const int gwv = blockIdx.x * NWAVES + F.wave, NGW = F.G * NWAVES, lane = F.lane;
    LAS unsigned char* wl = F.lds + F.wave * PW_BYTES;
    const unsigned lbase = (unsigned)__builtin_amdgcn_readfirstlane((int)(unsigned)(size_t)wl);
    const unsigned c16e = (unsigned)(((lane & 7) ^ (lane >> 4)) * 16), c16o = (unsigned)(((lane & 7) ^ (4 + (lane >> 4))) * 16);
    const unsigned char* U8 = F.U8; const unsigned char* V8 = F.V8;
    for (int t0 = gwv * 4; t0 < M; t0 += NGW * 4) {
        bf16* yrow0 = F.Y + (size_t)t0 * D;
#pragma unroll
        for (int j = 0; j < 4; ++j) {
            const int t = t0 + j;
            const v4u hq = *(const GAS v4u*)((const unsigned char*)F.H + (size_t)t * D + 16 * lane);
            const float hinv = F.rs2[t];
            const unsigned hw[4] = {hq.x, hq.y, hq.z, hq.w};
            unsigned hh0 = 0u, hh1 = 0u, hl0 = 0u, hl1 = 0u;
#pragma unroll
            for (int i = 0; i < 16; ++i) { const int hv_ = (int)(signed char)((hw[i >> 2] >> (8 * (i & 3))) & 0xffu); const int lo = ((hv_ + 8) & 15) - 8; const int hi = (hv_ - lo) >> 4;
                if (i < 8) { hh0 |= (unsigned)(hi & 15) << (4 * i); hl0 |= (unsigned)(lo & 15) << (4 * i); } else { hh1 |= (unsigned)(hi & 15) << (4 * (i - 8)); hl1 |= (unsigned)(lo & 15) << (4 * (i - 8)); } }
            *(LAS unsigned long long*)(wl + j * 1024 + 8 * lane) = (unsigned long long)hh0 | ((unsigned long long)hh1 << 32);
            *(LAS unsigned long long*)(wl + j * 1024 + 512 + 8 * lane) = (unsigned long long)hl0 | ((unsigned long long)hl1 << 32);
            const int e0 = F.eidx[(size_t)t * 128 + lane], e1 = F.eidx[(size_t)t * 128 + 64 + lane];
            const f32x2v sg0 = (f32x2v){F.su[e0] * hinv, F.gw[(size_t)t * 128 + lane] * F.sv[e0]}, sg1 = (f32x2v){F.su[e1] * hinv, F.gw[(size_t)t * 128 + 64 + lane] * F.sv[e1]};
            int base = 0;
#pragma unroll
            for (int sl = 0; sl < 4; ++sl) {
                const bool m0 = (e0 >> 12) == sl, m1 = (e1 >> 12) == sl;
                const unsigned long long b0 = __ballot(m0), b1 = __ballot(m1);
                const int c0 = __popcll(b0), c1 = __popcll(b1);
                const int p0 = j * 128 + base + __builtin_amdgcn_mbcnt_hi((unsigned)(b0 >> 32), __builtin_amdgcn_mbcnt_lo((unsigned)b0, 0));
                const int p1 = j * 128 + base + c0 + __builtin_amdgcn_mbcnt_hi((unsigned)(b1 >> 32), __builtin_amdgcn_mbcnt_lo((unsigned)b1, 0));
                if (m0) { *(LAS unsigned short*)(wl + PW_E + p0 * 2) = (unsigned short)e0; *(LAS f32x2v*)(wl + PW_SG + p0 * 8) = sg0; }
                if (m1) { *(LAS unsigned short*)(wl + PW_E + p1 * 2) = (unsigned short)e1; *(LAS f32x2v*)(wl + PW_SG + p1 * 8) = sg1; }
                base += c0 + c1;
            }
        }
        asm volatile("" ::: "memory");
        {
            v4u ua[8], ub[8];
            peer_u_issue(ua, U8, wl, 0, lane);
#pragma unroll 1
            for (int it = 0; it < 32; it += 2) {
                peer_u_issue(ub, U8, wl, it + 1, lane);
                __builtin_amdgcn_sched_barrier(0);
                peer_u_compute(ua, wl, it, lane);
                __builtin_amdgcn_sched_barrier(0);
                if (it + 2 < 32) peer_u_issue(ua, U8, wl, it + 2, lane);
                __builtin_amdgcn_sched_barrier(0);
                peer_u_compute(ub, wl, it + 1, lane);
                __builtin_amdgcn_sched_barrier(0);
            }
        }
#pragma unroll
        for (int j = 0; j < 4; ++j) {
            const float w0 = *(const LAS float*)(wl + PW_BUF1 + (j * 128 + lane) * 4), w1 = *(const LAS float*)(wl + PW_BUF1 + (j * 128 + 64 + lane) * 4);
            float mx = fmaxf(fabsf(w0), fabsf(w1));
#pragma unroll
            for (int o = 1; o < 64; o <<= 1) mx = fmaxf(mx, __shfl_xor(mx, o));
            int ex = (int)((__float_as_uint(mx) >> 23) & 0xffu); ex = ex < 30 ? 127 : ex;
            const float sc = __uint_as_float((unsigned)(127 + 7 + 127 - ex) << 23), isc = __uint_as_float((unsigned)(ex - 7) << 23);
            const float s0 = w0 * sc, s1 = w1 * sc;
            const int ph = __builtin_amdgcn_cvt_pk_fp8_f32(s0, s1, 0, false);
            const f32x2v hb = __builtin_amdgcn_cvt_pk_f32_fp8(ph, false);
            const int pl = __builtin_amdgcn_cvt_pk_fp8_f32(s0 - hb.x, s1 - hb.y, 0, false);
            *(LAS unsigned char*)(wl + PW_WH + j * 128 + lane) = (unsigned char)(ph & 0xff); *(LAS unsigned char*)(wl + PW_WH + j * 128 + 64 + lane) = (unsigned char)((ph >> 8) & 0xff);
            *(LAS unsigned char*)(wl + PW_WL + j * 128 + lane) = (unsigned char)(pl & 0xff); *(LAS unsigned char*)(wl + PW_WL + j * 128 + 64 + lane) = (unsigned char)((pl >> 8) & 0xff);
            if (lane == 0) *(LAS float*)(wl + PW_IK + j * 4) = isc;
        }
        v4u x1w[4][2];
#pragma unroll
        for (int j = 0; j < 4; ++j) { const GAS v4u* op = (const GAS v4u*)(F.QP + (size_t)(t0 + j) * D + 16 * lane); x1w[j][0] = op[0]; x1w[j][1] = op[1]; }
        asm volatile("s_waitcnt lgkmcnt(0)" ::: "memory");
        {
            f32x4 acc[8];
            peer_v_issue(V8, wl, lbase, 0, lane, c16e, c16o);
#pragma unroll 1
            for (int it = 0; it < 32; it += 2) {
                peer_v_issue(V8, wl, lbase, it + 1, lane, c16e, c16o);
                asm volatile("s_waitcnt vmcnt(8)" ::: "memory");
                peer_v_compute(wl, acc, yrow0, it, lane);
                asm volatile("s_waitcnt lgkmcnt(0)" ::: "memory");
                if (it + 2 < 32) { peer_v_issue(V8, wl, lbase, it + 2, lane, c16e, c16o); asm volatile("s_waitcnt vmcnt(8)" ::: "memory"); }
                else asm volatile("s_waitcnt vmcnt(0)" ::: "memory");
                peer_v_compute(wl, acc, yrow0, it + 1, lane);
                asm volatile("s_waitcnt lgkmcnt(0)" ::: "memory");
            }
        }
        asm volatile("s_waitcnt vmcnt(0)" ::: "memory");
#pragma unroll
        for (int j = 0; j < 4; ++j) {
            const int t = t0 + j, b = t >> 12;
            float yv[16];
            { const GAS v4u* yp = (const GAS v4u*)(yrow0 + (size_t)j * D + 16 * lane); const v4u y0 = yp[0], y1 = yp[1]; unpack8(y0, yv); unpack8(y1, yv + 8); }
            float ss = 0.f;
#pragma unroll
            for (int i = 0; i < 16; ++i) ss += yv[i] * yv[i];
            const float rstd = rsqrtf(wave_sum(ss) * (1.f / D) + EPS);
            GAS f32x4* dp = (GAS f32x4*)(dst + (size_t)t * D + 16 * lane);
            const GAS f32x4* gp = (const GAS f32x4*)(F.fpost_gain + 16 * lane);
            const GAS f32x4* g2p = (const GAS f32x4*)(F.mod + b * 6144 + 5120 + 16 * lane);
            float x1f[16]; unpack8(x1w[j][0], x1f); unpack8(x1w[j][1], x1f + 8);
#pragma unroll
            for (int i = 0; i < 4; ++i) { const f32x4 x1 = (f32x4){x1f[4 * i], x1f[4 * i + 1], x1f[4 * i + 2], x1f[4 * i + 3]}, g = gp[i], g2 = g2p[i];
                const f32x4 y = (f32x4){yv[4 * i], yv[4 * i + 1], yv[4 * i + 2], yv[4 * i + 3]};
                dp[i] = x1 + g2 * (y * rstd * g); }
        }
    }
}

__device__ __forceinline__ unsigned long long ldp(const Frame& F, int i) {
    volatile LAS unsigned* pt = (volatile LAS unsigned*)(F.lds + LDSCTL_OFF);
    const unsigned lo = pt[2 * i], hi = pt[2 * i + 1];
    return ((unsigned long long)(unsigned)__builtin_amdgcn_readfirstlane((int)hi) << 32) | (unsigned)__builtin_amdgcn_readfirstlane((int)lo);
}
__device__ __forceinline__ void load_frame(Frame& F) {
    F.lane = lane_id_fresh(); F.tid = F.wave * 64 + F.lane;
    F.x = (const float*)ldp(F, 0); F.c = (const float*)ldp(F, 1); F.ada_w = (const float*)ldp(F, 2); F.ada_b = (const float*)ldp(F, 3); F.pre_gain = (const float*)ldp(F, 4); F.post_gain = (const float*)ldp(F, 5);
    F.w_in = (const float*)ldp(F, 6); F.conv_w = (const float*)ldp(F, 7); F.group_gain = (const float*)ldp(F, 8); F.w_out = (const float*)ldp(F, 9); F.fpre_gain = (const float*)ldp(F, 10); F.fpost_gain = (const float*)ldp(F, 11);
    F.wq = (const float*)ldp(F, 12); F.keys = (const float*)ldp(F, 13); F.pu = (const float*)ldp(F, 14); F.pv = (const float*)ldp(F, 15);
    F.out = (float*)ldp(F, 16);
    unsigned char* ws = (unsigned char*)ldp(F, 17);
    F.ctl = (gu32*)(ws + WS_CTL);
    F.mod = (float*)(ws + WS_MOD); F.kmean = (float*)(ws + WS_KMEAN); F.keysb = (bf16*)(ws + WS_KEYS);
    F.WinT = (bf16*)(ws + WS_WIN); F.WoT = (bf16*)(ws + WS_WO); F.WqT = (bf16*)(ws + WS_WQ); F.eidx = (int*)(ws + WS_EIDX); F.gw = (float*)(ws + WS_G);
    F.U8 = ws + WS_U; F.V8 = ws + WS_V; F.su = (float*)(ws + WS_SU); F.sv = (float*)(ws + WS_SV); F.H = (bf16*)(ws + WS_H);
    F.P = (bf16*)(ws + WS_P); F.QP = (bf16*)(ws + WS_QP); F.O = (bf16*)(ws + WS_O); F.Y = (bf16*)(ws + WS_Y); F.scratch = (float*)(ws + WS_O); F.Win8 = ws + WS_WIN8; F.rs = (float*)(ws + WS_RS); F.Wq8 = ws + WS_WQ8; F.rs2 = (float*)(ws + WS_RS2); F.Wo8 = ws + WS_WO8;
}
struct Args { const float* in[16]; float* out; unsigned char* ws; int ph_lo, ph_hi; };
constexpr int NPHASE = 12;
template <unsigned PM> __global__ void __launch_bounds__(NWAVES * 64, 2) fwd_kernel(Args args) {
    extern __shared__ __attribute__((aligned(16))) unsigned char lds[];
    Frame F;
    F.lds = (LAS unsigned char*)lds;
    F.MISC = (volatile LAS unsigned*)(F.lds + MISC_OFF);
    F.tid = threadIdx.x; F.lane = F.tid & 63; F.wave = __builtin_amdgcn_readfirstlane(F.tid >> 6);
    F.G = gridDim.x;
    for (int u = F.tid; u < (LDS_BYTES - LDSCTL_OFF) / 4; u += NWAVES * 64) ((LAS unsigned*)(F.lds + LDSCTL_OFF))[u] = 0u;
    __syncthreads();
    if (F.tid == 0) { LAS unsigned long long* pt = (LAS unsigned long long*)(F.lds + LDSCTL_OFF);
#pragma unroll
        for (int i = 0; i < 16; ++i) pt[i] = (unsigned long long)args.in[i];
        pt[16] = (unsigned long long)args.out; pt[17] = (unsigned long long)args.ws; }
    __syncthreads();
    load_frame(F);
    const int lo = args.ph_lo, hi = args.ph_hi;
    const bool multi = (hi - lo) > 1;
    XcdBarrier bar; bar.bar = (unsigned*)(F.ctl + CW_BAR); bar.x = 0; bar.st = nullptr;
    if (multi) bar = xcd_barrier_post((unsigned*)(F.ctl + CW_BAR), F.MISC + 8);
#define IN(k) ((((PM) >> (k)) & 1u) && lo <= (k) && (k) < hi)
#define BOTH(k) (IN(k) && IN((k) + 1))
#ifndef SEAMREP
#define SEAMREP 1
#endif
#define SEAM(k) do { if (BOTH(k)) { for (int sr_ = 0; sr_ < SEAMREP; ++sr_) xcd_barrier(bar); } } while (0)
#ifndef REPMASK
#define REPMASK 0x000u
#endif
#define REPS(k) (1 + (int)(((REPMASK) >> (k)) & 1u))
    if (IN(0)) { load_frame(F); for (int r = 0; r < REPS(0); ++r) { p0_prep(F); __syncthreads(); } SEAM(0); }
    if (IN(1)) { load_frame(F); for (int r = 0; r < REPS(1); ++r) p1_hnorm(F); SEAM(1); }
    if (IN(2)) { load_frame(F);
        pg8::Gemm g{F.H, (const bf16*)F.Win8, M, NIN, D / 2}; pg8::StaticOrder So; So.init(M, NIN, F.G, (int)blockIdx.x);
        pg8::EpiBf16S<true> E{F.P, NIN, 6, 8, C2, F.kmean, 8, 10, F.rs, (const unsigned*)(F.ctl + CW_CMAX)};
        for (int r = 0; r < REPS(2); ++r) pg8::gemm_phase<pg8::EpiBf16S<true>, pg8::StaticOrder, true, true, false, true>(F.lds, g, So, E);
        if (IN(2) && IN(5)) { for (int sr_ = 0; sr_ < SEAMREP; ++sr_) xcd_barrier(bar); }
    }
    if (IN(5)) { load_frame(F);
        const attn_body::AttnTensors AT{(const attn_body::bf16*)(F.P + 1536), (const attn_body::bf16*)(F.P + 2048), (const attn_body::bf16*)(F.P + 2560), (attn_body::bf16*)((unsigned char*)F.Y + 512), F.kmean, F.group_gain + 512};
        const attn_body::StaticOrder So((int)F.G, (int)blockIdx.x);
        for (int r = 0; r < REPS(5); ++r) attn_body::attn_phase<attn_body::StaticOrder>((char*)lds, AT, So);
    }
    if (IN(6)) { load_frame(F); for (int r = 0; r < REPS(6); ++r) p6_conv(F); SEAM(6); }
    if (IN(7)) { load_frame(F);
        pg8::Gemm g{F.Y, (const bf16*)F.Wo8, M, D, D / 2}; pg8::StaticOrder So; So.init(M, D, F.G, (int)blockIdx.x);
        pg8::EpiBf16S<true> E{F.O, D, 0, 0, 1.f, nullptr, 0, 0, nullptr, (const unsigned*)(F.ctl + CW_CMAX3)};
        for (int r = 0; r < REPS(7); ++r) pg8::gemm_phase<pg8::EpiBf16S<true>, pg8::StaticOrder, true, true, false, true>(F.lds, g, So, E);
        SEAM(7);
    }
    if (IN(8)) { load_frame(F); for (int r = 0; r < REPS(8); ++r) p8_resid(F); SEAM(8); }
    if (IN(9)) { load_frame(F);
        pg8::Gemm g{F.H, (const bf16*)F.Wq8, M, NQ, D / 2}; pg8::StaticOrder So; So.init(M, NQ, F.G, (int)blockIdx.x);
        EpiRoute E{F.keysb, F.eidx, F.gw, (const unsigned*)(F.ctl + CW_CMAX2), F.rs2};
        for (int r = 0; r < REPS(9); ++r)
            for (int i = 0; ; ++i) { OneUnit S1; if (!So.next(i, S1.u)) break; pg8::gemm_phase<EpiRoute, OneUnit, false, true, false, true>(F.lds, g, S1, E); }
        if (IN(9) && IN(11)) { for (int sr_ = 0; sr_ < SEAMREP; ++sr_) xcd_barrier(bar); }
    }
    if (IN(11)) { load_frame(F); if (REPS(11) > 1) p11_peer(F, F.scratch); p11_peer(F, F.out); }
#undef IN
#undef BOTH
#undef SEAM
}

#ifndef PMASK
#define PMASK 0xfffu
#endif
#ifndef N_LAUNCH_MODE
#define N_LAUNCH_MODE 1
#endif
template <unsigned PM> static bool set_lds() { return hipFuncSetAttribute((const void*)fwd_kernel<PM>, hipFuncAttributeMaxDynamicSharedMemorySize, LDS_BYTES) == hipSuccess; }
template <unsigned PM> static void launch1(int grid, hipStream_t stream, Args a) { hipLaunchKernelGGL(fwd_kernel<PM>, dim3(grid), dim3(NWAVES * 64), LDS_BYTES, stream, a); }
extern "C" void kernel_launch(void* const* d_in, const int* in_sizes, int n_in, void* d_out, int out_size, void* d_ws, size_t ws_size, hipStream_t stream) {
    static int grid = 0;
    if (grid == 0) {
        if (n_in != 16 || out_size != M * D || ws_size < WS_END) { fprintf(stderr, "kernel_launch: unexpected shapes n_in %d out %d ws %zu\n", n_in, out_size, ws_size); grid = -1; return; }
        int dev = 0, cus = 0;
        if (hipGetDevice(&dev) != hipSuccess || hipDeviceGetAttribute(&cus, hipDeviceAttributeMultiprocessorCount, dev) != hipSuccess) { grid = -1; return; }
        bool ok = true;
#if N_LAUNCH_MODE == 1
        ok = set_lds<PMASK>();
#elif N_LAUNCH_MODE == 3
        ok = set_lds<0x3ffu>() && set_lds<0x400u>() && set_lds<0x800u>();
#else
        ok = set_lds<1u>() && set_lds<2u>() && set_lds<4u>() && set_lds<8u>() && set_lds<16u>() && set_lds<32u>() && set_lds<64u>() && set_lds<128u>() && set_lds<256u>() && set_lds<512u>() && set_lds<1024u>() && set_lds<2048u>();
#endif
        if (!ok) { fprintf(stderr, "kernel_launch: hipFuncSetAttribute failed\n"); grid = -1; return; }
        grid = cus;
    }
    if (grid < 0) return;
    (void)hipMemsetAsync((char*)d_ws + WS_CTL, 0, CTL_ZERO_BYTES, stream);
    Args a{};
    for (int i = 0; i < 16; ++i) a.in[i] = (const float*)d_in[i];
    a.out = (float*)d_out; a.ws = (unsigned char*)d_ws;
#if N_LAUNCH_MODE == 1
    a.ph_lo = 0; a.ph_hi = NPHASE; launch1<PMASK>(grid, stream, a);
#elif N_LAUNCH_MODE == 3
    a.ph_lo = 0; a.ph_hi = 10; launch1<0x3ffu>(grid, stream, a);
    a.ph_lo = 10; a.ph_hi = 11; launch1<0x400u>(grid, stream, a);
    a.ph_lo = 11; a.ph_hi = 12; launch1<0x800u>(grid, stream, a);
#else
#define L1(p) do { a.ph_lo = (p); a.ph_hi = (p) + 1; launch1<(1u << (p))>(grid, stream, a); } while (0)
    L1(0); L1(1); L1(2); L1(3); L1(4); L1(5); L1(6); L1(7); L1(8); L1(9); L1(10); L1(11);
#undef L1
#endif
}
```

```cpp
#include <hip/hip_runtime.h>
#include <cstdio>
#include <cstdint>
#ifndef WT_STORES
#define WT_STORES 1
#endif
typedef unsigned wt_v4u __attribute__((ext_vector_type(4)));
__device__ __forceinline__ int lane_id_fresh() { int l; asm volatile("v_mbcnt_lo_u32_b32 %0, -1, 0\n\tv_mbcnt_hi_u32_b32 %0, -1, %0" : "=v"(l)); return l; }
__device__ __forceinline__ void st16_wt(void* p, wt_v4u v) {
#if WT_STORES
    asm volatile("global_store_dwordx4 %0, %1, off sc1\n\ts_nop 1" :: "v"(p), "v"(v) : "memory");
#else
    *(wt_v4u*)p = v;
#endif
}
__device__ __forceinline__ void st4_wt(void* p, unsigned v) {
#if WT_STORES
    asm volatile("global_store_dword %0, %1, off sc1\n\ts_nop 1" :: "v"(p), "v"(v) : "memory");
#else
    *(unsigned*)p = v;
#endif
}
__device__ __forceinline__ void st8_wt(void* p, unsigned long long v) {
#if WT_STORES
    asm volatile("global_store_dwordx2 %0, %1, off sc1\n\ts_nop 1" :: "v"(p), "v"(v) : "memory");
#else
    *(unsigned long long*)p = v;
#endif
}
namespace pg8 {
#define PG8_LAS __attribute__((address_space(3)))
typedef unsigned short bf16_t;
typedef short bf16x8 __attribute__((ext_vector_type(8)));
typedef float f32x4 __attribute__((ext_vector_type(4)));
typedef unsigned u32x4 __attribute__((ext_vector_type(4)));
typedef int i32x4 __attribute__((ext_vector_type(4)));
typedef int i32x8 __attribute__((ext_vector_type(8)));
constexpr int BM = 256, BK = 64, HALF = 128, HTB = HALF * BK * 2  , STAGE_BYTES = 8 * HTB, NXCD = 8, WGM = 8;

__host__ __device__ __forceinline__ int lds_byte(int r, int c) { const int st = (r >> 4) * 2 + (c >> 5), rr = r & 15, cc = c & 31, ob = rr * 64 + cc * 2; return st * 1024 + (ob ^ (((ob >> 9) & 1) << 5)); }
__host__ __device__ __forceinline__ void stage_rc(int b, int& R, int& C) { const int st = b / 1024, sb = b % 1024, swz = sb ^ (((sb >> 9) & 1) << 5); R = (st >> 1) * 16 + swz / 64; C = (st & 1) * 32 + (swz % 64) / 2; }
__host__ __device__ __forceinline__ int perm32(int rho) { const int n = rho >> 4, i = rho & 15; return 8 * (i >> 2) + 4 * n + (i & 3); }

struct Unit { int pm, pn; };
struct Gemm { const bf16_t* A; const bf16_t* Bt; int M, N, K; };

struct StaticOrder {
    int nM, nN, nwg, G, c;
    __host__ __device__ void init(int M, int N, int G_, int c_) { nM = M / BM; nN = N / BM; nwg = nM * nN; G = G_; c = c_; }
    __host__ __device__ bool next(int i, Unit& u) const {
        const long L = (long)i * G + c; if (L >= nwg) return false;
        int wgid = (int)L; { const int q = nwg / NXCD, r = nwg % NXCD, xcd = wgid % NXCD, off = wgid / NXCD; wgid = (xcd < r ? xcd * (q + 1) : r * (q + 1) + (xcd - r) * q) + off; }
        const int nig = WGM * nN, gid = wgid / nig, fm = gid * WGM, gsz = (nM - fm) < WGM ? (nM - fm) : WGM;
        u.pm = fm + ((wgid % nig) % gsz); u.pn = (wgid % nig) / gsz; return true;
    }
    __device__ __forceinline__ void a_ready(const Unit&) const {}
    __device__ __forceinline__ void done(const Unit&) const {}
};


__device__ __forceinline__ unsigned cvt_pk_bf16(float lo, float hi) { unsigned r; asm volatile("v_cvt_pk_bf16_f32 %0, %1, %2" : "=v"(r) : "v"(lo), "v"(hi)); return r; }
template <bool ACC_I32> struct EpiBf16S {
    static constexpr bool PERM = true, AFTER_DRAIN = false;
    bf16_t* O; int ldc; int sc_lo, sc_hi; float scv; float* ksum; int ks_lo, ks_hi; const float* rs; const unsigned* cmax;
    __device__ __forceinline__ void operator()(const f32x4 (&acc)[2][2][4][2], const Unit& u, int wr, int wc, int fr_, int fq_) const {
        (void)fr_; (void)fq_;
        const int lane_ = lane_id_fresh(); const int fr = lane_ & 15, fq = lane_ >> 4;
        const int row0 = u.pm * BM + wr * 64 + fr; const int colt = u.pn * BM;
        const float sc = ((u.pn >= sc_lo && u.pn < sc_hi) ? scv : 1.f) * (ACC_I32 ? (1.f / 127.f) : (1.f / 224.f));
        const int col0 = colt + wc * 32 + 8 * fq;
        float rsv[2][4];
#pragma unroll
        for (int ai = 0; ai < 2; ++ai)
#pragma unroll
            for (int m = 0; m < 4; ++m) rsv[ai][m] = rs != nullptr ? rs[row0 + ai * HALF + m * 16] : 1.f;
        const bool do_ks = ksum != nullptr && u.pn >= ks_lo && u.pn < ks_hi;
#pragma unroll
        for (int bj = 0; bj < 2; ++bj) {
            const u32x4 cb0 = *(const u32x4*)(cmax + col0 + bj * HALF), cb1 = *(const u32x4*)(cmax + col0 + bj * HALF + 4);
            const f32x4 cs0 = (f32x4){__uint_as_float(cb0.x), __uint_as_float(cb0.y), __uint_as_float(cb0.z), __uint_as_float(cb0.w)} * sc;
            const f32x4 cs1 = (f32x4){__uint_as_float(cb1.x), __uint_as_float(cb1.y), __uint_as_float(cb1.z), __uint_as_float(cb1.w)} * sc;
            f32x4 sum0 = {0.f, 0.f, 0.f, 0.f}, sum1 = sum0;
#pragma unroll
            for (int ai = 0; ai < 2; ++ai)
#pragma unroll
                for (int m = 0; m < 4; ++m) { f32x4 a0 = acc[ai][bj][m][0], a1 = acc[ai][bj][m][1];
                    if constexpr (ACC_I32) { const i32x4 i0 = __builtin_bit_cast(i32x4, a0), i1 = __builtin_bit_cast(i32x4, a1);
                        a0 = (f32x4){(float)i0[0], (float)i0[1], (float)i0[2], (float)i0[3]}; a1 = (f32x4){(float)i1[0], (float)i1[1], (float)i1[2], (float)i1[3]}; }
                    const f32x4 v0 = a0 * rsv[ai][m] * cs0, v1 = a1 * rsv[ai][m] * cs1;
                    sum0 += v0; sum1 += v1;
                    u32x4 w; w.x = cvt_pk_bf16(v0[0], v0[1]); w.y = cvt_pk_bf16(v0[2], v0[3]); w.z = cvt_pk_bf16(v1[0], v1[1]); w.w = cvt_pk_bf16(v1[2], v1[3]);
                    st16_wt(O + (size_t)(row0 + ai * HALF + m * 16) * ldc + col0 + bj * HALF, w); }
            if (do_ks) {
                float* kd = ksum + (size_t)u.pm * ((ks_hi - ks_lo) * BM) + (u.pn - ks_lo) * BM + wc * 32 + 8 * fq + bj * HALF;
#pragma unroll
                for (int n = 0; n < 2; ++n)
#pragma unroll
                    for (int i = 0; i < 4; ++i) {
                        float v = n ? sum1[i] : sum0[i];
                        v += __uint_as_float((unsigned)__builtin_amdgcn_mov_dpp((int)__float_as_uint(v), 0xB1, 0xf, 0xf, true));
                        v += __uint_as_float((unsigned)__builtin_amdgcn_mov_dpp((int)__float_as_uint(v), 0x4E, 0xf, 0xf, true));
                        v += __uint_as_float((unsigned)__builtin_amdgcn_mov_dpp((int)__float_as_uint(v), 0x141, 0xf, 0xf, true));
                        v += __uint_as_float((unsigned)__builtin_amdgcn_mov_dpp((int)__float_as_uint(v), 0x140, 0xf, 0xf, true));
                        if (fr == 0) atomicAdd(kd + 4 * n + i, v);
                    }
            }
        }
    }
};
struct EpiBf16 {
    static constexpr bool PERM = true, AFTER_DRAIN = false;
    bf16_t* O; int ldc; int sc_lo, sc_hi; float scv; float* ksum; int ks_lo, ks_hi;
    __device__ __forceinline__ void operator()(const f32x4 (&acc)[2][2][4][2], const Unit& u, int wr, int wc, int fr, int fq) const {
        const int row0 = u.pm * BM + wr * 64 + fr; const int colt = u.pn * BM;
        const float sc = (u.pn >= sc_lo && u.pn < sc_hi) ? scv : 1.f;
        const int col0 = colt + wc * 32 + 8 * fq;
#pragma unroll
        for (int ai = 0; ai < 2; ++ai)
#pragma unroll
            for (int m = 0; m < 4; ++m) { bf16_t* rowp = O + (size_t)(row0 + ai * HALF + m * 16) * ldc + col0;
#pragma unroll
                for (int bj = 0; bj < 2; ++bj) { f32x4 v0 = acc[ai][bj][m][0] * sc, v1 = acc[ai][bj][m][1] * sc;
                    u32x4 w; w.x = cvt_pk_bf16(v0[0], v0[1]); w.y = cvt_pk_bf16(v0[2], v0[3]); w.z = cvt_pk_bf16(v1[0], v1[1]); w.w = cvt_pk_bf16(v1[2], v1[3]);
                    st16_wt(rowp + bj * HALF, w); } }
        if (ksum != nullptr && u.pn >= ks_lo && u.pn < ks_hi) {
            float* kd = ksum + (size_t)u.pm * ((ks_hi - ks_lo) * BM) + (u.pn - ks_lo) * BM + wc * 32 + 8 * fq;
#pragma unroll
            for (int bj = 0; bj < 2; ++bj)
#pragma unroll
                for (int n = 0; n < 2; ++n) {
                    f32x4 cs = acc[0][bj][0][n];
#pragma unroll
                    for (int m = 1; m < 4; ++m) cs += acc[0][bj][m][n];
#pragma unroll
                    for (int m = 0; m < 4; ++m) cs += acc[1][bj][m][n];
#pragma unroll
                    for (int i = 0; i < 4; ++i) {
                        float v = cs[i];
                        v += __uint_as_float((unsigned)__builtin_amdgcn_mov_dpp((int)__float_as_uint(v), 0xB1, 0xf, 0xf, true));
                        v += __uint_as_float((unsigned)__builtin_amdgcn_mov_dpp((int)__float_as_uint(v), 0x4E, 0xf, 0xf, true));
                        v += __uint_as_float((unsigned)__builtin_amdgcn_mov_dpp((int)__float_as_uint(v), 0x141, 0xf, 0xf, true));
                        v += __uint_as_float((unsigned)__builtin_amdgcn_mov_dpp((int)__float_as_uint(v), 0x140, 0xf, 0xf, true));
                        if (fr == 0) atomicAdd(kd + bj * HALF + 4 * n + i, v);
                    }
                }
        }
    }
};

template <int OFF> __device__ __forceinline__ void dma16s(const void* sbase, unsigned voff, unsigned lds_base) { unsigned keep;
    asm volatile("s_mov_b32 %0, m0\n\ts_add_u32 m0, %3, %4\n\ts_nop 0\n\tglobal_load_lds_dwordx4 %1, %2\n\ts_mov_b32 m0, %0" : "=&s"(keep) : "v"(voff), "s"(sbase), "s"(lds_base), "i"(OFF) : "memory", "scc"); }
__device__ __forceinline__ const char* uni_ptr(const char* p) {
    const unsigned long long v = (unsigned long long)p;
    return (const char*)(((unsigned long long)(unsigned)__builtin_amdgcn_readfirstlane((int)(unsigned)(v >> 32)) << 32) | (unsigned)__builtin_amdgcn_readfirstlane((int)(unsigned)v));
}
template <class Epi, class Sched, bool ALIGN_EPI = false, bool SP2 = false, bool FP8 = false, bool I8 = false>
__device__ __forceinline__ void gemm_phase(PG8_LAS unsigned char* lds, const Gemm g, const Sched& S, const Epi& E) {
    int tid_ = threadIdx.x; asm volatile("" : "+v"(tid_));
    const int tid = tid_, wid = __builtin_amdgcn_readfirstlane(tid >> 6), lane = tid & 63, wr = wid >> 2, wc = wid & 3, fr = lane & 15, fq = lane >> 4;
    const int K = g.K, nt = K / BK;
    unsigned voffA[2], voffB[2];
#pragma unroll
    for (int i = 0; i < 2; ++i) { int R, C; stage_rc(tid * 16 + i * 8192, R, C); const int Rb = Epi::PERM ? ((R & ~31) + perm32(R & 31)) : R;
        voffA[i] = (unsigned)(R * K + C) * 2u; voffB[i] = (unsigned)(Rb * K + C) * 2u; }
    const size_t qstep = (size_t)64 * K * 2;
    const size_t kstep = (size_t)(BK * 2);
    const size_t hstep = (size_t)HALF * K * 2;
    const size_t tstep = 2 * hstep;
    const unsigned ldsn = (unsigned)(size_t)lds;
    const unsigned ldsw = (unsigned)wid * 1024u;
    const unsigned ldsb = (unsigned)__builtin_amdgcn_readfirstlane((int)(ldsn + ldsw));
    const int aoff = lds_byte(wr * 64 + fr, fq * 8), boff = lds_byte(wc * 32 + fr, fq * 8);
    unsigned ldsAn = ldsn + (unsigned)aoff, ldsBn = ldsn + (unsigned)(4 * HTB) + (unsigned)boff; asm volatile("" : "+v"(ldsAn), "+v"(ldsBn));
    PG8_LAS unsigned char* const ldsA = (PG8_LAS unsigned char*)(size_t)ldsAn; PG8_LAS unsigned char* const ldsB = (PG8_LAS unsigned char*)(size_t)ldsBn;
#define PG8_SA(b, h) (((b) * 2 + (h)) * HTB)
#define PG8_SB(b, h) ((4 + (b) * 2 + (h)) * HTB)
#define PG8_STAGE(bufoff, gbase, voff) do { if constexpr (FP8 || I8) { const char* gb_ = uni_ptr((const char*)(gbase)); dma16s<(bufoff)>(gb_, (voff)[0], ldsb); dma16s<(bufoff) + 8192>(uni_ptr(gb_ + qstep), (voff)[0], ldsb); }        \
    else { _Pragma("unroll") for (int _i = 0; _i < 2; ++_i) \
        __builtin_amdgcn_global_load_lds((const unsigned*)((const char*)(gbase) + (voff)[_i]), (PG8_LAS unsigned*)(lds + (bufoff) + ldsw + _i * 8192), 16, 0, 0); } } while (0)
#define PG8_LDA(dst, b, h) do { _Pragma("unroll") for (int m = 0; m < 4; ++m) _Pragma("unroll") for (int k = 0; k < 2; ++k) dst[m][k] = *(const PG8_LAS bf16x8*)(lds + PG8_SA(b, h) + aoff + m * 2048 + k * 1024); } while (0)
#define PG8_LDB(dst, b, h) do { _Pragma("unroll") for (int n = 0; n < 2; ++n) _Pragma("unroll") for (int k = 0; k < 2; ++k) dst[n][k] = *(const PG8_LAS bf16x8*)(lds + PG8_SB(b, h) + boff + n * 2048 + k * 1024); } while (0)
#define PG8_LDA8(dst, b, h) do { _Pragma("unroll") for (int m = 0; m < 4; ++m) dst[m] = __builtin_shufflevector(*(const PG8_LAS i32x4*)(ldsA + PG8_SA(b, h) + m * 2048), *(const PG8_LAS i32x4*)(ldsA + PG8_SA(b, h) + m * 2048 + 1024), 0, 1, 2, 3, 4, 5, 6, 7); } while (0)
#define PG8_LDB8(dst, b, h) do { _Pragma("unroll") for (int n = 0; n < 2; ++n) dst[n] = __builtin_shufflevector(*(const PG8_LAS i32x4*)(ldsB + (PG8_SB(b, h) - 4 * HTB) + n * 2048), *(const PG8_LAS i32x4*)(ldsB + (PG8_SB(b, h) - 4 * HTB) + n * 2048 + 1024), 0, 1, 2, 3, 4, 5, 6, 7); } while (0)
#define PG8_MMA8(ai, bj, A8, B8) do { __builtin_amdgcn_s_setprio(1); _Pragma("unroll") for (int m = 0; m < 4; ++m) _Pragma("unroll") for (int n = 0; n < 2; ++n) \
        acc[ai][bj][m][n] = __builtin_amdgcn_mfma_scale_f32_16x16x128_f8f6f4(B8[n], A8[m], acc[ai][bj][m][n], 0, 0, 0, 0, 0, 0); __builtin_amdgcn_s_setprio(0); } while (0)
#define PG8_MMA(ai, bj, At, Bt) do { __builtin_amdgcn_s_setprio(1); _Pragma("unroll") for (int m = 0; m < 4; ++m) _Pragma("unroll") for (int n = 0; n < 2; ++n) _Pragma("unroll") for (int k = 0; k < 2; ++k) { \
        if constexpr (I8) acc[ai][bj][m][n] = __builtin_bit_cast(f32x4, __builtin_amdgcn_mfma_i32_16x16x64_i8(__builtin_bit_cast(i32x4, Bt[n][k]), __builtin_bit_cast(i32x4, At[m][k]), __builtin_bit_cast(i32x4, acc[ai][bj][m][n]), 0, 0, 0)); \
        else acc[ai][bj][m][n] = __builtin_amdgcn_mfma_f32_16x16x32_bf16(Bt[n][k], At[m][k], acc[ai][bj][m][n], 0, 0, 0); } __builtin_amdgcn_s_setprio(0); } while (0)
#define PG8_WAIT_V(n) asm volatile("s_waitcnt vmcnt(" #n ")" ::: "memory")
#define PG8_WAIT_L(n) asm volatile("s_waitcnt lgkmcnt(" #n ")" ::: "memory")
#define PG8_BAR __builtin_amdgcn_s_barrier()
#define PG8_SCHED __builtin_amdgcn_sched_barrier(0)
    Unit cur, nxt; int ui = 0;
    if (!S.next(0, cur)) return;
    f32x4 acc[2][2][4][2];
#pragma unroll
    for (int a = 0; a < 2; ++a)
#pragma unroll
        for (int b = 0; b < 2; ++b)
#pragma unroll
            for (int m = 0; m < 4; ++m)
#pragma unroll
                for (int n = 0; n < 2; ++n) acc[a][b][m][n] = (f32x4){0.f, 0.f, 0.f, 0.f};
    bf16x8 At[4][2], B0[2][2], B1[2][2];
    i32x8 A8[4], B08[2], B18[2];
    const char* cA = (const char*)g.A + (size_t)cur.pm * tstep; const char* cB = (const char*)g.Bt + (size_t)cur.pn * tstep;
    if constexpr (FP8 || I8) { cA = uni_ptr(cA); cB = uni_ptr(cB); }
    S.a_ready(cur);
    if constexpr (SP2) {
        PG8_STAGE(PG8_SB(0, 0), cB, voffB); PG8_STAGE(PG8_SB(0, 1), cB + hstep, voffB); PG8_STAGE(PG8_SA(0, 0), cA, voffA); PG8_STAGE(PG8_SA(0, 1), cA + hstep, voffA);
        if (wr == 1) PG8_BAR;
        PG8_WAIT_V(2); PG8_BAR;
        PG8_STAGE(PG8_SB(1, 0), cB + kstep, voffB); PG8_STAGE(PG8_SA(1, 0), cA + kstep, voffA); PG8_STAGE(PG8_SB(1, 1), cB + hstep + kstep, voffB);
        PG8_WAIT_V(6); PG8_BAR;
    } else {
        PG8_STAGE(PG8_SB(0, 0), cB, voffB); PG8_STAGE(PG8_SA(0, 0), cA, voffA); PG8_STAGE(PG8_SB(0, 1), cB + hstep, voffB); PG8_STAGE(PG8_SA(0, 1), cA + hstep, voffA);
        if (wr == 1) PG8_BAR;
        PG8_WAIT_V(4); PG8_BAR;
        PG8_STAGE(PG8_SB(1, 0), cB + kstep, voffB); PG8_STAGE(PG8_SA(1, 0), cA + kstep, voffA); PG8_STAGE(PG8_SB(1, 1), cB + hstep + kstep, voffB);
        PG8_WAIT_V(6); PG8_BAR;
    }
    for (;;) {
        const bool has_next = S.next(ui + 1, nxt);
        const char* nA = has_next ? (const char*)g.A + (size_t)nxt.pm * tstep : cA; const char* nB = has_next ? (const char*)g.Bt + (size_t)nxt.pn * tstep : cB;
        if constexpr (FP8 || I8) { nA = uni_ptr(nA); nB = uni_ptr(nB); }
        for (int t = 0; t < nt; t += 2) {
            const bool last = (t == nt - 2);
            if constexpr (FP8 || I8) asm volatile("" : "+v"(voffA[0]), "+v"(voffB[0]));
            const char* a1 = cA + (size_t)(t + 1) * kstep;
            const char* a2 = last ? nA : cA + (size_t)(t + 2) * kstep; const char* b2 = last ? nB : cB + (size_t)(t + 2) * kstep;
            const char* a3 = a2 + kstep; const char* b3 = b2 + kstep;
            if (last && has_next) S.a_ready(nxt);
            if constexpr (SP2 && FP8) {
            PG8_LDB8(B08, 0, 0); PG8_LDB8(B18, 0, 1); PG8_SCHED; PG8_LDA8(A8, 0, 0); PG8_STAGE(PG8_SA(1, 1), a1 + hstep, voffA);
            PG8_WAIT_V(8); PG8_WAIT_L(0); PG8_BAR; PG8_MMA8(0, 0, A8, B08); PG8_MMA8(0, 1, A8, B18); PG8_BAR; PG8_SCHED;
            PG8_LDA8(A8, 0, 1); PG8_STAGE(PG8_SB(0, 0), b2, voffB); PG8_STAGE(PG8_SB(0, 1), b2 + hstep, voffB); PG8_STAGE(PG8_SA(0, 0), a2, voffA);
            PG8_WAIT_V(8); PG8_WAIT_L(0); PG8_BAR; PG8_MMA8(1, 0, A8, B08); PG8_MMA8(1, 1, A8, B18); PG8_BAR; PG8_SCHED;
            PG8_LDB8(B08, 1, 0); PG8_LDB8(B18, 1, 1); PG8_SCHED; PG8_LDA8(A8, 1, 0); PG8_STAGE(PG8_SA(0, 1), a2 + hstep, voffA);
            PG8_WAIT_V(8); PG8_WAIT_L(0); PG8_BAR; PG8_MMA8(0, 0, A8, B08); PG8_MMA8(0, 1, A8, B18); PG8_BAR; PG8_SCHED;
            PG8_LDA8(A8, 1, 1); PG8_STAGE(PG8_SB(1, 0), b3, voffB); PG8_STAGE(PG8_SB(1, 1), b3 + hstep, voffB); PG8_STAGE(PG8_SA(1, 0), a3, voffA);
            PG8_WAIT_V(8); PG8_WAIT_L(0); PG8_BAR; PG8_MMA8(1, 0, A8, B08); PG8_MMA8(1, 1, A8, B18); PG8_BAR; PG8_SCHED;
            } else if constexpr (SP2) {
            PG8_LDB(B0, 0, 0); PG8_LDB(B1, 0, 1); PG8_SCHED; PG8_LDA(At, 0, 0); PG8_STAGE(PG8_SA(1, 1), a1 + hstep, voffA);
            PG8_WAIT_V(8); PG8_WAIT_L(0); PG8_BAR; PG8_MMA(0, 0, At, B0); PG8_MMA(0, 1, At, B1); PG8_BAR; PG8_SCHED;
            PG8_LDA(At, 0, 1); PG8_STAGE(PG8_SB(0, 0), b2, voffB); PG8_STAGE(PG8_SB(0, 1), b2 + hstep, voffB); PG8_STAGE(PG8_SA(0, 0), a2, voffA);
            PG8_WAIT_V(8); PG8_WAIT_L(0); PG8_BAR; PG8_MMA(1, 0, At, B0); PG8_MMA(1, 1, At, B1); PG8_BAR; PG8_SCHED;
            PG8_LDB(B0, 1, 0); PG8_LDB(B1, 1, 1); PG8_SCHED; PG8_LDA(At, 1, 0); PG8_STAGE(PG8_SA(0, 1), a2 + hstep, voffA);
            PG8_WAIT_V(8); PG8_WAIT_L(0); PG8_BAR; PG8_MMA(0, 0, At, B0); PG8_MMA(0, 1, At, B1); PG8_BAR; PG8_SCHED;
            PG8_LDA(At, 1, 1); PG8_STAGE(PG8_SB(1, 0), b3, voffB); PG8_STAGE(PG8_SB(1, 1), b3 + hstep, voffB); PG8_STAGE(PG8_SA(1, 0), a3, voffA);
            PG8_WAIT_V(8); PG8_WAIT_L(0); PG8_BAR; PG8_MMA(1, 0, At, B0); PG8_MMA(1, 1, At, B1); PG8_BAR; PG8_SCHED;
            } else {
            PG8_LDB(B0, 0, 0); PG8_SCHED; PG8_LDA(At, 0, 0); PG8_STAGE(PG8_SA(1, 1), a1 + hstep, voffA);
            PG8_WAIT_L(8); PG8_BAR; PG8_WAIT_L(0); PG8_MMA(0, 0, At, B0); PG8_BAR; PG8_SCHED;
            PG8_LDB(B1, 0, 1); PG8_STAGE(PG8_SB(0, 0), b2, voffB);
            PG8_BAR; PG8_WAIT_L(0); PG8_MMA(0, 1, At, B1); PG8_BAR;
            PG8_LDA(At, 0, 1); PG8_STAGE(PG8_SA(0, 0), a2, voffA);
            PG8_BAR; PG8_WAIT_L(0); PG8_MMA(1, 0, At, B0); PG8_BAR; PG8_SCHED;
            PG8_STAGE(PG8_SB(0, 1), b2 + hstep, voffB);
            PG8_WAIT_V(6); PG8_BAR; PG8_MMA(1, 1, At, B1); PG8_BAR;
            PG8_LDB(B0, 1, 0); PG8_SCHED; PG8_LDA(At, 1, 0); PG8_STAGE(PG8_SA(0, 1), a2 + hstep, voffA);
            PG8_WAIT_L(8); PG8_BAR; PG8_WAIT_L(0); PG8_MMA(0, 0, At, B0); PG8_BAR; PG8_SCHED;
            PG8_LDB(B1, 1, 1); PG8_STAGE(PG8_SB(1, 0), b3, voffB);
            PG8_BAR; PG8_WAIT_L(0); PG8_MMA(0, 1, At, B1); PG8_BAR;
            PG8_LDA(At, 1, 1); PG8_STAGE(PG8_SA(1, 0), a3, voffA);
            PG8_BAR; PG8_WAIT_L(0); PG8_MMA(1, 0, At, B0); PG8_BAR; PG8_SCHED;
            PG8_STAGE(PG8_SB(1, 1), b3 + hstep, voffB);
            PG8_WAIT_V(6); PG8_BAR; PG8_MMA(1, 1, At, B1); PG8_BAR;
            }
        }
        if constexpr (ALIGN_EPI) { if (wr == 0) PG8_BAR; }
        if constexpr (!Epi::AFTER_DRAIN) { E(acc, cur, wr, wc, fr, fq); S.done(cur); }
        if (!has_next) break;
#pragma unroll
        for (int a = 0; a < 2; ++a)
#pragma unroll
            for (int b = 0; b < 2; ++b)
#pragma unroll
                for (int m = 0; m < 4; ++m)
#pragma unroll
                    for (int n = 0; n < 2; ++n) acc[a][b][m][n] = (f32x4){0.f, 0.f, 0.f, 0.f};
        cur = nxt; cA = nA; cB = nB; ++ui;
        if constexpr (ALIGN_EPI) { if (wr == 1) PG8_BAR; }
    }
    PG8_WAIT_V(0);
    if constexpr (!ALIGN_EPI) { if (wr == 0) PG8_BAR; }
    PG8_BAR;
    if constexpr (Epi::AFTER_DRAIN) { E.fused(acc, cur, wr, wc, fr, fq, lds, wid, lane); S.done(cur); }
#undef PG8_SA
#undef PG8_SB
#undef PG8_STAGE
#undef PG8_LDA
#undef PG8_LDB
#undef PG8_LDA8
#undef PG8_LDB8
#undef PG8_MMA8
#undef PG8_MMA
#undef PG8_WAIT_V
#undef PG8_WAIT_L
#undef PG8_BAR
#undef PG8_SCHED
}
}
#include <hip/hip_bf16.h>
#include <cmath>
namespace attn_body {
using bf16=__hip_bfloat16;
using bf16x8=__attribute__((ext_vector_type(8)))short;
using s16x4=__attribute__((ext_vector_type(4)))short;
using f32x16=__attribute__((ext_vector_type(16)))float;
using u32x4=__attribute__((ext_vector_type(4)))unsigned;
constexpr int BATCH=4,NHEAD=8,SEQ=4096,D=64,DM=3072,OPITCH=1024;
constexpr int NW=8,QBLK=32,QB=QBLK*NW,KVBLK=64,NQB=SEQ/QB;
constexpr int ATTN_UNIT_ROWS=QB;
__device__ __forceinline__ int crow(int r,int hi){return (r&3)+8*(r>>2)+4*hi;}
#define SBAR() __builtin_amdgcn_sched_barrier(0)
__device__ __forceinline__ void cmask(f32x16&p0,f32x16&p1,int jb,int qrel,int hi){
  const float NEG=-INFINITY; int kb=64*jb+4*hi;
  #pragma unroll
  for(int r=0;r<16;++r){int kv=kb+(r&3)+8*(r>>2); if(kv>qrel)p0[r]=NEG; if(kv+32>qrel)p1[r]=NEG;}
}

constexpr int NSLOT=3, SLOTB=8192;
constexpr int LDS_K=0, LDS_V=NSLOT*SLOTB, LDS_WS=2*NSLOT*SLOTB, LDS_OST=LDS_WS+NW*64*4, LDS_BYTES=LDS_OST+NW*4096;
constexpr float C2=0.125f*1.4426950408889634f;
__device__ __forceinline__ void glds16(const void*gsrc,unsigned lds_dst){unsigned keep;
  asm volatile("s_mov_b32 %0, m0\n\ts_mov_b32 m0, %2\n\ts_nop 0\n\tglobal_load_lds_dwordx4 %1, off\n\ts_mov_b32 m0, %0":"=&s"(keep):"v"(gsrc),"s"(lds_dst):"memory");}
__device__ __forceinline__ void glds16s(const void*sbase,unsigned voff,unsigned lds_dst){unsigned keep;
  asm volatile("s_mov_b32 %0, m0\n\ts_mov_b32 m0, %3\n\ts_nop 0\n\tglobal_load_lds_dwordx4 %1, %2\n\ts_mov_b32 m0, %0":"=&s"(keep):"v"(voff),"s"(sbase),"s"(lds_dst):"memory");}
__device__ __forceinline__ float max3f(float a,float b,float c){float r;asm("v_max3_f32 %0, %1, %2, %3":"=v"(r):"v"(a),"v"(b),"v"(c));return r;}
__device__ __forceinline__ float max2f(float a,float b){float r;asm("v_max_f32_e32 %0, %1, %2":"=v"(r):"v"(a),"v"(b));return r;}
__device__ __forceinline__ float fadd_s(float a,float b){float r;asm("v_add_f32_e32 %0, %1, %2":"=v"(r):"v"(a),"v"(b));return r;}
__device__ __forceinline__ float fsub_s(float a,float b){float r;asm("v_sub_f32_e32 %0, %1, %2":"=v"(r):"v"(a),"v"(b));return r;}
typedef float f32x2_t __attribute__((ext_vector_type(2))); typedef __bf16 bf16x2_t __attribute__((ext_vector_type(2)));
__device__ __forceinline__ unsigned cvtpk_s(float lo,float hi){f32x2_t v={lo,hi};bf16x2_t b=__builtin_convertvector(v,bf16x2_t);return __builtin_bit_cast(unsigned,b);}
#define WAIT_BAR(N) asm volatile("s_waitcnt vmcnt(" #N ") lgkmcnt(0)\n\ts_barrier":::"memory")

__device__ __forceinline__ void qkt(f32x16&p0,f32x16&p1,const char*Kslot,const bf16x8*qr,int r32,int hi){
  const f32x16 negm=f32x16{};
  const char*kb=Kslot+hi*1024+r32*16;
  #pragma unroll
  for(int d0=0;d0<4;++d0){
    const bf16x8 b0=*reinterpret_cast<const bf16x8*>(kb+d0*2048);
    const bf16x8 b1=*reinterpret_cast<const bf16x8*>(kb+d0*2048+512);
    if(d0==0){p0=__builtin_amdgcn_mfma_f32_32x32x16_bf16(b0,qr[0],negm,0,0,0);p1=__builtin_amdgcn_mfma_f32_32x32x16_bf16(b1,qr[0],negm,0,0,0);}
    else{p0=__builtin_amdgcn_mfma_f32_32x32x16_bf16(b0,qr[d0],p0,0,0,0);p1=__builtin_amdgcn_mfma_f32_32x32x16_bf16(b1,qr[d0],p1,0,0,0);}}
}
typedef __attribute__((address_space(3))) const char* lds_cptr;
typedef short v4i16_t __attribute__((ext_vector_type(4)));
__device__ __forceinline__ void kload8(bf16x8*kf,lds_cptr kp){
  kf[0]=*(const __attribute__((address_space(3))) bf16x8*)(kp);      kf[1]=*(const __attribute__((address_space(3))) bf16x8*)(kp+512);
  kf[2]=*(const __attribute__((address_space(3))) bf16x8*)(kp+2048); kf[3]=*(const __attribute__((address_space(3))) bf16x8*)(kp+2560);
  kf[4]=*(const __attribute__((address_space(3))) bf16x8*)(kp+4096); kf[5]=*(const __attribute__((address_space(3))) bf16x8*)(kp+4608);
  kf[6]=*(const __attribute__((address_space(3))) bf16x8*)(kp+6144); kf[7]=*(const __attribute__((address_space(3))) bf16x8*)(kp+6656);
}
__device__ __forceinline__ void kload2(bf16x8*kf,lds_cptr kp,int j){ kf[2*j]=*(const __attribute__((address_space(3))) bf16x8*)(kp+j*2048); kf[2*j+1]=*(const __attribute__((address_space(3))) bf16x8*)(kp+j*2048+512); }
__device__ __forceinline__ s16x4 vtr(lds_cptr p){ return __builtin_bit_cast(s16x4,__builtin_amdgcn_ds_read_tr16_b64_v4i16((__attribute__((address_space(3))) v4i16_t*)p)); }
__device__ __forceinline__ float rowmax(const f32x16&p0,const f32x16&p1){
  float a=max3f(p0[0],p0[1],p1[0]),b=max3f(p0[2],p0[3],p1[1]);a=max3f(a,p1[2],p1[3]);
  #pragma unroll
  for(int r=4;r<16;r+=4){a=max3f(a,p0[r],p0[r+1]);b=max3f(b,p0[r+2],p0[r+3]);a=max3f(a,p1[r],p1[r+1]);b=max3f(b,p1[r+2],p1[r+3]);}
  const float m=max2f(a,b);
  auto rr=__builtin_amdgcn_permlane32_swap(__float_as_uint(m),__float_as_uint(m),false,false);
  return max2f(__uint_as_float(rr[0]),__uint_as_float(rr[1]));
}
__device__ __forceinline__ void pv(f32x16*o,int vb,bf16x8 pa0,bf16x8 pa1,bf16x8 pa2,bf16x8 pa3){
  #pragma unroll
  for(int d0=0;d0<2;++d0){s16x4 lo[4],hi[4];
    #pragma unroll
    for(int ks=0;ks<4;++ks){
      asm volatile("ds_read_b64_tr_b16 %0,%1 offset:%c2":"=&v"(lo[ks]):"v"(vb),"i"(d0*4096+ks*1024):"memory");
      asm volatile("ds_read_b64_tr_b16 %0,%1 offset:%c2":"=&v"(hi[ks]):"v"(vb),"i"(d0*4096+ks*1024+512):"memory");}
    asm volatile("s_waitcnt lgkmcnt(0)":::"memory");SBAR();
    #define PK(k) (bf16x8){lo[k][0],lo[k][1],lo[k][2],lo[k][3],hi[k][0],hi[k][1],hi[k][2],hi[k][3]}
    o[d0]=__builtin_amdgcn_mfma_f32_32x32x16_bf16(pa0,PK(0),o[d0],0,0,0);
    o[d0]=__builtin_amdgcn_mfma_f32_32x32x16_bf16(pa1,PK(1),o[d0],0,0,0);
    o[d0]=__builtin_amdgcn_mfma_f32_32x32x16_bf16(pa2,PK(2),o[d0],0,0,0);
    o[d0]=__builtin_amdgcn_mfma_f32_32x32x16_bf16(pa3,PK(3),o[d0],0,0,0);
    #undef PK
  }
}

#define ATTN_YQ (127.f/6.f)
#ifndef ATTN_STORE16
#define ATTN_STORE16(p,v) st16_wt((p),(v))
#endif
template<int THRL> __device__ __forceinline__ void attn_unit(int b,int h,int qb,const bf16*Q,const bf16*__restrict__ K,const bf16*__restrict__ V,bf16*O,const float*KSUM,const float*GG,char*shm){
  int tid_=threadIdx.x; asm volatile("":"+v"(tid_)); const int tid=tid_,lane=tid&63,r32=lane&31,hi=lane>>5; const int wid=__builtin_amdgcn_readfirstlane(tid>>6);
  const long rowbase=(long)b*SEQ; const int q0=qb*QB;
  const bf16*Qw=Q+(rowbase+q0+wid*QBLK)*DM+h*D;
  const bf16*Kh=K+rowbase*DM+h*D,*Vh=V+rowbase*DM+h*D;
  const unsigned lds0=(unsigned)(uintptr_t)shm;
  float*wsf=(float*)(shm+LDS_WS)+wid*64;
  const unsigned koff=(unsigned)((lane*DM+wid*8)*2);
  const unsigned voffs=(unsigned)(((16*(wid&3)+(lane>>2))*DM+(wid>>2)*32+(lane&3)*8)*2);
  const unsigned kdst=lds0+LDS_K+wid*1024, vdst=lds0+LDS_V+wid*1024;
  #define PT(t) (((t)<4)?(NT-4+(t)):((t)-4))
  #define DMA_K(t,slot) glds16s((const char*)Kh+(long)PT(t)*(KVBLK*DM*2),koff,(unsigned)__builtin_amdgcn_readfirstlane(kdst+(slot)))
  #define DMA_V(t,slot) glds16s((const char*)Vh+(long)PT(t)*(KVBLK*DM*2),voffs,(unsigned)__builtin_amdgcn_readfirstlane(vdst+(slot)))
  const int vb0=(int)(lds0+LDS_V)+((lane>>4)&1)*32+(lane&3)*8+(4*hi+((lane&15)>>2))*64;
  const char*Kbase=shm+LDS_K; bf16x8 kf[8];
  const lds_cptr shm3=(lds_cptr)shm; const lds_cptr kp0=shm3+LDS_K+hi*1024+r32*16; const lds_cptr vp0=shm3+LDS_V+((lane>>4)&1)*32+(lane&3)*8+(4*hi+((lane&15)>>2))*64;
  const int NT=(q0+QB)/KVBLK;
  DMA_K(0,0);DMA_V(0,0);DMA_K(1,SLOTB);
  bf16x8 qr[4];
  #pragma unroll
  for(int d0=0;d0<4;++d0)qr[d0]=*reinterpret_cast<const bf16x8*>(&Qw[(long)r32*DM+d0*16+hi*8]);
  float mhat=0.f,l_reg=0.f;f32x16 o[2];o[0]=f32x16{};o[1]=f32x16{};const f32x16 z16=f32x16{};
  unsigned selm=(1u<<qb)-1u;
  if(qb>3){
    f32x16 gt=f32x16{};
    #pragma unroll
    for(int d0=0;d0<4;++d0){ const float*kp=KSUM+((long)(b*16+(r32&15)))*512+h*D+d0*16+hi*8;
      const float4 k0=*reinterpret_cast<const float4*>(kp),k1=*reinterpret_cast<const float4*>(kp+4);
      u32x4 kw; kw.x=cvtpk_s(k0.x,k0.y);kw.y=cvtpk_s(k0.z,k0.w);kw.z=cvtpk_s(k1.x,k1.y);kw.w=cvtpk_s(k1.z,k1.w);
      gt=__builtin_amdgcn_mfma_f32_32x32x16_bf16(__builtin_bit_cast(bf16x8,kw),qr[d0],gt,0,0,0); }
    float v0=-INFINITY,v1=-INFINITY,v2=-INFINITY; int i0=0,i1=0,i2=0;
    #define INS3(vv,ii) do{ const float x_=(vv); const int j_=(ii); \
      if(x_>v0){v2=v1;i2=i1;v1=v0;i1=i0;v0=x_;i0=j_;} else if(x_>v1){v2=v1;i2=i1;v1=x_;i1=j_;} else if(x_>v2){v2=x_;i2=j_;} }while(0)
    #pragma unroll
    for(int r=0;r<8;++r){ const int j=crow(r,hi); INS3(j<qb?gt[r]:-INFINITY,j); }
    const float p0=__shfl_xor(v0,32),p1=__shfl_xor(v1,32),p2=__shfl_xor(v2,32); const int q0i=__shfl_xor(i0,32),q1i=__shfl_xor(i1,32),q2i=__shfl_xor(i2,32);
    INS3(p0,q0i); INS3(p1,q1i); INS3(p2,q2i);
    #undef INS3
    selm=(1u<<i0)|(1u<<i1)|(1u<<i2);
  }
  const int qrel=wid*QBLK+r32;
  #define CMASK(P0,P1,t) do{ if((t)<4)cmask(P0,P1,(t),qrel,hi); }while(0)
  bool resc=false;
  #define START(P0,P1) do{ const float rm=rowmax(P0,P1); resc=false; \
    { const float dl=rm; mhat=fadd_s(mhat,dl); \
      _Pragma("unroll") for(int r=0;r<16;++r){P0[r]=fsub_s(P0[r],dl);P1[r]=fsub_s(P1[r],dl);} \
      } \
    _Pragma("unroll") for(int r=0;r<16;++r)P0[r]=__builtin_amdgcn_exp2f(P0[r]); }while(0)
  #define RESC() do{ if(resc){ asm volatile("s_waitcnt lgkmcnt(0)":::"memory"); \
      _Pragma("unroll") for(int d_=0;d_<2;++d_) _Pragma("unroll") for(int r=0;r<16;++r)o[d_][r]*=wsf[crow(r,hi)]; } }while(0)
  f32x16 pA0,pA1,pB0,pB1;
  int sl_prev=0,sl_cur=0,sl_next=SLOTB;
  #define ROT() do{sl_prev=sl_cur;sl_cur=sl_next;sl_next=(sl_next==(NSLOT-1)*SLOTB)?0:sl_next+SLOTB;}while(0)
  DMA_K(2,2*SLOTB);
  WAIT_BAR(3);
  qkt(pA0,pA1,Kbase,qr,r32,hi);asm volatile("s_nop 15\n\ts_nop 7":"+v"(pA0),"+v"(pA1));CMASK(pA0,pA1,0);
  START(pA0,pA1);
  _Pragma("unroll") for(int r=0;r<16;++r)pA1[r]=__builtin_amdgcn_exp2f(pA1[r]);
  WAIT_BAR(0);
  DMA_K(3,0);DMA_V(1,SLOTB);
  ROT();
  kload8(kf,kp0+sl_cur);
  WAIT_BAR(2);
  s16x4 vlo[8],vhi[8]; u32x4 pw0,pw1,pw2,pw3;
  #define PKW(P,B) cvtpk_s(P[B],P[B+1])
  #define PAF(k) __builtin_bit_cast(bf16x8,pw##k)
  #define VFR(i) (bf16x8){vlo[i][0],vlo[i][1],vlo[i][2],vlo[i][3],vhi[i][0],vhi[i][1],vhi[i][2],vhi[i][3]}
  #define PIN(x) asm volatile("":"+v"(x))
  #define MX3(a,b,c) __builtin_fmaxf(__builtin_fmaxf((a),(b)),(c))
  #define GAPA(MF,A0,A1,A2,A3,W0,W1,PW) do{ MF; sacc+=A0; sacc+=A1; sacc+=A2; sacc+=A3; PIN(sacc); W0; W1; PIN(PW); SBAR(); }while(0)
  #define EX(v) __builtin_amdgcn_exp2f(v)
  #define GAPB(MF,X,B) do{ MF; X[B]=EX(X[B]); X[B+1]=EX(X[B+1]); X[B+2]=EX(X[B+2]); X[B+3]=EX(X[B+3]); PIN(X); SBAR(); }while(0)
  #define VRD(i) do{ vlo[i]=vtr(vp_+(((i)>>2)*4096+((i)&3)*1024)); vhi[i]=vtr(vp_+(((i)>>2)*4096+((i)&3)*1024+512)); }while(0)
  #define KRD(G,j) do{ if(G){ kload2(kf,kp0+sl_next,j); SBAR(); } }while(0)
  #define STEP(C0,C1,P0,P1,t,GK,GV,GL) do{ SBAR(); \
    const lds_cptr vp_=vp0+sl_prev; \
    VRD(0); SBAR(); float sacc=(P0[0]+P0[1]); \
    GAPA(C0=__builtin_amdgcn_mfma_f32_32x32x16_bf16(kf[0],qr[0],z16,0,0,0), P0[2],P0[3],P0[4],P0[5],     pw0[0]=PKW(P0,0), pw0[1]=PKW(P0,2), pw0); \
    VRD(4); SBAR(); GAPA(C1=__builtin_amdgcn_mfma_f32_32x32x16_bf16(kf[1],qr[0],z16,0,0,0), P0[6],P0[7],P0[8],P0[9],     pw0[2]=PKW(P0,4), pw0[3]=PKW(P0,6), pw0); \
    VRD(1); SBAR(); GAPA(C0=__builtin_amdgcn_mfma_f32_32x32x16_bf16(kf[2],qr[1],C0,0,0,0),   P0[10],P0[11],P0[12],P0[13], pw1[0]=PKW(P0,8), pw1[1]=PKW(P0,10), pw1); \
    VRD(5); SBAR(); GAPA(C1=__builtin_amdgcn_mfma_f32_32x32x16_bf16(kf[3],qr[1],C1,0,0,0),   P0[14],P0[15],P1[0],P1[1],   pw1[2]=PKW(P0,12),pw1[3]=PKW(P0,14), pw1); \
    VRD(2); SBAR(); GAPA(C0=__builtin_amdgcn_mfma_f32_32x32x16_bf16(kf[4],qr[2],C0,0,0,0),   P1[2],P1[3],P1[4],P1[5],     pw2[0]=PKW(P1,0), pw2[1]=PKW(P1,2), pw2); \
    VRD(6); SBAR(); GAPA(C1=__builtin_amdgcn_mfma_f32_32x32x16_bf16(kf[5],qr[2],C1,0,0,0),   P1[6],P1[7],P1[8],P1[9],     pw2[2]=PKW(P1,4), pw2[3]=PKW(P1,6), pw2); \
    VRD(3); SBAR(); GAPA(C0=__builtin_amdgcn_mfma_f32_32x32x16_bf16(kf[6],qr[3],C0,0,0,0),   P1[10],P1[11],P1[12],P1[13], pw3[0]=PKW(P1,8), pw3[1]=PKW(P1,10), pw3); \
    VRD(7); SBAR(); GAPA(C1=__builtin_amdgcn_mfma_f32_32x32x16_bf16(kf[7],qr[3],C1,0,0,0),   P1[14],P1[15],0.f,0.f,       pw3[2]=PKW(P1,12),pw3[3]=PKW(P1,14), pw3); \
    l_reg+=sacc; \
    if(GK){DMA_K((t)+3,sl_cur);} if(GV){DMA_V((t)+1,sl_next);} \
    { const bool v_=((t)<4)||((selm>>(((t)-4)>>2))&1u); const float nm_=v_?-mhat:-INFINITY; \
      _Pragma("unroll") for(int r=0;r<16;++r){C0[r]+=nm_;C1[r]+=nm_;} } \
    CMASK(C0,C1,t); \
    { float a=MX3(C0[0],C0[1],C1[0]),b=MX3(C0[2],C0[3],C1[1]); a=MX3(a,C1[2],C1[3]); \
      _Pragma("unroll") for(int r=4;r<16;r+=4){a=MX3(a,C0[r],C0[r+1]);b=MX3(b,C0[r+2],C0[r+3]);a=MX3(a,C1[r],C1[r+1]);b=MX3(b,C1[r+2],C1[r+3]);} \
      float rm=__builtin_fmaxf(a,b); { auto rr=__builtin_amdgcn_permlane32_swap(__float_as_uint(rm),__float_as_uint(rm),false,false); rm=__builtin_fmaxf(__uint_as_float(rr[0]),__uint_as_float(rr[1])); } \
      resc=false; \
      if(__builtin_expect(__any(rm>(float)THRL),0)){ const float dl=__builtin_fmaxf(rm,0.f); mhat+=dl; \
        _Pragma("unroll") for(int r=0;r<16;++r){C0[r]-=dl;C1[r]-=dl;} \
        const float f=__builtin_amdgcn_exp2f(-dl); l_reg*=f; if(hi==0)wsf[r32]=f; resc=true; } } \
    SBAR(); \
    GAPB(o[0]=__builtin_amdgcn_mfma_f32_32x32x16_bf16(PAF(0),VFR(0),o[0],0,0,0), C0,0); \
    GAPB(o[1]=__builtin_amdgcn_mfma_f32_32x32x16_bf16(PAF(0),VFR(4),o[1],0,0,0), C0,4); \
    KRD(GL,0); GAPB(o[0]=__builtin_amdgcn_mfma_f32_32x32x16_bf16(PAF(1),VFR(1),o[0],0,0,0), C0,8); \
    KRD(GL,1); GAPB(o[1]=__builtin_amdgcn_mfma_f32_32x32x16_bf16(PAF(1),VFR(5),o[1],0,0,0), C0,12); \
    KRD(GL,2); GAPB(o[0]=__builtin_amdgcn_mfma_f32_32x32x16_bf16(PAF(2),VFR(2),o[0],0,0,0), C1,0); \
    KRD(GL,3); GAPB(o[1]=__builtin_amdgcn_mfma_f32_32x32x16_bf16(PAF(2),VFR(6),o[1],0,0,0), C1,4); \
    GAPB(o[0]=__builtin_amdgcn_mfma_f32_32x32x16_bf16(PAF(3),VFR(3),o[0],0,0,0), C1,8); \
    GAPB(o[1]=__builtin_amdgcn_mfma_f32_32x32x16_bf16(PAF(3),VFR(7),o[1],0,0,0), C1,12); \
    }while(0)
  int t=1;
  #define ENDW(tt) do{ if((tt)+3<NT){WAIT_BAR(2);} else if((tt)+2<NT){WAIT_BAR(1);} else {WAIT_BAR(0);} }while(0)
  for(;t<5&&t+1<NT;t+=2){
    STEP(pB0,pB1,pA0,pA1,t,(t+3<NT),(t+1<NT),(t+1<NT));       ENDW(t);   RESC(); ROT();
    STEP(pA0,pA1,pB0,pB1,t+1,(t+4<NT),(t+2<NT),(t+2<NT));     ENDW(t+1); RESC(); ROT();
  }
  #undef CMASK
  #define CMASK(P0,P1,t) do{}while(0)
  for(;t+5<NT;t+=2){
    STEP(pB0,pB1,pA0,pA1,t,true,true,true);     WAIT_BAR(2); RESC(); ROT();
    STEP(pA0,pA1,pB0,pB1,t+1,true,true,true);   WAIT_BAR(2); RESC(); ROT();
  }
  #undef CMASK
  #define CMASK(P0,P1,t) do{ if((t)<4)cmask(P0,P1,(t),qrel,hi); }while(0)
  for(;t+1<NT;t+=2){
    STEP(pB0,pB1,pA0,pA1,t,(t+3<NT),(t+1<NT),(t+1<NT));       ENDW(t);   RESC(); ROT();
    STEP(pA0,pA1,pB0,pB1,t+1,(t+4<NT),(t+2<NT),(t+2<NT));     ENDW(t+1); RESC(); ROT();
  }
  STEP(pB0,pB1,pA0,pA1,NT-1,false,false,false); RESC();
  { float sacc=pB0[0]+pB0[1]; _Pragma("unroll") for(int r=2;r<16;++r)sacc+=pB0[r]; _Pragma("unroll") for(int r=0;r<16;++r)sacc+=pB1[r]; l_reg+=sacc;
    pw0=(u32x4){PKW(pB0,0),PKW(pB0,2),PKW(pB0,4),PKW(pB0,6)};pw1=(u32x4){PKW(pB0,8),PKW(pB0,10),PKW(pB0,12),PKW(pB0,14)};pw2=(u32x4){PKW(pB1,0),PKW(pB1,2),PKW(pB1,4),PKW(pB1,6)};pw3=(u32x4){PKW(pB1,8),PKW(pB1,10),PKW(pB1,12),PKW(pB1,14)};
    SBAR(); pv(o,vb0+sl_cur,PAF(0),PAF(1),PAF(2),PAF(3)); }
  #undef PKW
  #undef PAF
  #undef VFR
  #undef PIN
  #undef MX3
  #undef GAPA
  #undef GAPB
  #undef EX
  #undef VRD
  #undef KRD
  #undef STEP
  #undef ENDW
  {auto rr=__builtin_amdgcn_permlane32_swap(__float_as_uint(l_reg),__float_as_uint(l_reg),false,false);l_reg=__uint_as_float(rr[0])+__uint_as_float(rr[1]);}
  if(hi==0)wsf[32+r32]=l_reg;asm volatile("s_waitcnt lgkmcnt(0)":::"memory");
  float rli[16];
  #pragma unroll
  for(int r=0;r<16;++r)rli[r]=__builtin_amdgcn_rcpf(wsf[32+crow(r,hi)]);
  bf16*Ow=O+(rowbase+q0+wid*QBLK)*OPITCH+h*D;
  { bf16*stg=(bf16*)(shm+LDS_OST)+wid*2048;
    #pragma unroll
    for(int r=0;r<16;++r){const int orow=crow(r,hi);
      #pragma unroll
      for(int d0=0;d0<2;++d0)stg[orow*64+d0*32+r32]=__float2bfloat16(o[d0][r]*rli[r]);}
    asm volatile("s_waitcnt lgkmcnt(0)":::"memory");
    const int ch=lane&7; float gg[8];
    #pragma unroll
    for(int i=0;i<8;++i)gg[i]=GG[h*D+ch*8+i];
    #pragma unroll
    for(int i=0;i<4;++i){const int row=i*8+(lane>>3); const u32x4 v=*(const u32x4*)(stg+row*64+ch*8);
      float x[8]; x[0]=__uint_as_float(v.x<<16);x[1]=__uint_as_float(v.x&0xffff0000u);x[2]=__uint_as_float(v.y<<16);x[3]=__uint_as_float(v.y&0xffff0000u);
      x[4]=__uint_as_float(v.z<<16);x[5]=__uint_as_float(v.z&0xffff0000u);x[6]=__uint_as_float(v.w<<16);x[7]=__uint_as_float(v.w&0xffff0000u);
      float ss=0.f;
      #pragma unroll
      for(int k=0;k<8;++k)ss+=x[k]*x[k];
      ss+=__shfl_xor(ss,1);ss+=__shfl_xor(ss,2);ss+=__shfl_xor(ss,4);
      const float rs=rsqrtf(ss*(1.f/64.f)+1e-6f);
      const float qn=rs*ATTN_YQ; unsigned w0=0u,w1=0u;
      #pragma unroll
      for(int k=0;k<4;++k){const int a=(int)fminf(fmaxf(__builtin_rintf(x[k]*qn),-127.f),127.f),b=(int)fminf(fmaxf(__builtin_rintf(x[4+k]*qn),-127.f),127.f); w0|=((unsigned)a&0xffu)<<(8*k); w1|=((unsigned)b&0xffu)<<(8*k);}
      st8_wt((void*)((unsigned char*)O+((rowbase+q0+wid*QBLK+row)*(long)OPITCH+h*D+ch*8)),(unsigned long long)w0|((unsigned long long)w1<<32));} }
  asm volatile("s_waitcnt lgkmcnt(0)\n\ts_barrier":::"memory");
  #undef DMA_K
  #undef PT
  #undef DMA_V
  #undef CMASK
  #undef START
  #undef RESC
  #undef ROT
}
constexpr int ATTN_LDS_BYTES=LDS_BYTES;
struct AttnTensors { const bf16* Q; const bf16* K; const bf16* V; bf16* O; const float* KSUM; const float* GG; };
struct AttnUnit { int bh; int qb; };
struct StaticOrder {
  int vcu,G;
  __device__ __forceinline__ explicit StaticOrder(int grid,int block):vcu((grid%8==0)?(block%8)*(grid/8)+block/8:block),G(grid){}
  __device__ __forceinline__ bool next(int i,AttnUnit&u)const{ const int pr=vcu+(i>>1)*G; if(pr>=256)return false; const int s=pr&7; u.bh=pr>>3; u.qb=(i&1)?s:15-s; return true; }
  __device__ __forceinline__ void a_ready(const AttnUnit&)const{}
  __device__ __forceinline__ void done(const AttnUnit&)const{}
};
template<class Sched,int THRL=8> __device__ __forceinline__ void attn_phase(char*lds,const AttnTensors&T,const Sched&S){
  AttnUnit u;
  for(int i=0;S.next(i,u);++i){ S.a_ready(u); attn_unit<THRL>(u.bh/NHEAD,u.bh%NHEAD,u.qb,T.Q,T.K,T.V,T.O,T.KSUM,T.GG,lds); S.done(u); }
}
#undef SBAR
#undef WAIT_BAR
}

#define GAS __attribute__((address_space(1)))
#define LAS __attribute__((address_space(3)))
typedef unsigned short bf16;
typedef unsigned v4u __attribute__((ext_vector_type(4)));
typedef float f32x4 __attribute__((ext_vector_type(4)));
typedef short bf16x8 __attribute__((ext_vector_type(8)));
typedef GAS unsigned gu32;
typedef GAS unsigned long long gu64;
#define RLX_AGENT __ATOMIC_RELAXED, __HIP_MEMORY_SCOPE_AGENT
#define LDS_WAIT() asm volatile("s_waitcnt lgkmcnt(0)" ::: "memory")
#define VM_WAIT() asm volatile("s_waitcnt vmcnt(0)" ::: "memory")
__device__ __forceinline__ unsigned long long rt() { return __builtin_amdgcn_s_memrealtime(); }
__device__ __forceinline__ unsigned f2bf(float f) { unsigned u = __builtin_bit_cast(unsigned, f); return (u + 0x7fffu + ((u >> 16) & 1u)) >> 16; }
__device__ __forceinline__ unsigned pk2(float lo, float hi) { return f2bf(lo) | (f2bf(hi) << 16); }

#define XB_TMO      128
#define XB_XCNT(j)  (256  + 64 * (j))
#define XB_XSUB(j)  (1280 + 64 * (j))
#define XB_XGEN(j)  (2304 + 64 * (j))
#define XB_TOP      3328
#define XB_TOPGEN   3392
#define XCD_BAR_WORDS 3456
#define XB_SPIN_CAP (1u << 18)

__device__ __forceinline__ unsigned xb_ld(unsigned* p)              { return __hip_atomic_load(p, __ATOMIC_RELAXED, __HIP_MEMORY_SCOPE_AGENT); }
__device__ __forceinline__ unsigned xb_add(unsigned* p, unsigned v) { return __hip_atomic_fetch_add(p, v, __ATOMIC_RELAXED, __HIP_MEMORY_SCOPE_AGENT); }
__device__ __forceinline__ unsigned xb_xcc_id() { return (unsigned)__builtin_amdgcn_s_getreg((3 << 11) | 20) & 0xFu; }
#define XB_SPIN(cond, bar) do { unsigned _sp = 0; while (cond) { __builtin_amdgcn_s_sleep(1); \
    if ((++_sp & 255u) == 0u) { if (xb_ld(&(bar)[XB_TMO])) break; if (_sp > XB_SPIN_CAP) { atomicAdd(&(bar)[XB_TMO], 1u); break; } } } } while (0)

struct XcdBarrier {
    unsigned* bar; unsigned x;
    volatile LAS unsigned* st;
};

__device__ __forceinline__ XcdBarrier xcd_barrier_post(unsigned* bar, volatile LAS unsigned* st) {
    XcdBarrier b; b.bar = bar; b.x = xb_xcc_id(); b.st = st;
    if (threadIdx.x == 0) (void)xb_add(&bar[XB_XCNT(b.x)], 1u);
    return b;
}
__device__ __forceinline__ void xcd_barrier_complete(unsigned* bar, unsigned x, unsigned& nloc, unsigned& nx) {
    const unsigned G = gridDim.x * gridDim.y * gridDim.z;
    unsigned sum, cnt, mine, sp = 0u;
    for (;;) {
        sum = 0u; cnt = 0u; mine = 0u;
#pragma unroll
        for (unsigned j = 0; j < 16; ++j) { const unsigned c = xb_ld(&bar[XB_XCNT(j)]); sum += c; cnt += (c > 0u) ? 1u : 0u; mine = (j == x) ? c : mine; }
        if (sum == G) break;
        __builtin_amdgcn_s_sleep(1);
        if ((++sp & 255u) == 0u) { if (xb_ld(&bar[XB_TMO])) break; if (sp > XB_SPIN_CAP) { atomicAdd(&bar[XB_TMO], 1u); break; } }
    }
    nloc = mine > 0u ? mine : 1u; nx = cnt > 0u ? cnt : 1u;
}

__device__ __forceinline__ void xcd_barrier(const XcdBarrier& b) {
    asm volatile("s_waitcnt vmcnt(0)" ::: "memory");
    __syncthreads();
    if (threadIdx.x == 0) {
        unsigned* bar = b.bar;
        __builtin_amdgcn_s_waitcnt(0);
        unsigned nloc = b.st[0], nx = b.st[1];
        if (nloc == 0u) { xcd_barrier_complete(bar, b.x, nloc, nx); b.st[0] = nloc; b.st[1] = nx; }
        const unsigned old = xb_add(&bar[XB_XSUB(b.x)], 1u);
        const unsigned gen = old / nloc;
        if (old + 1u == (gen + 1u) * nloc) {
            asm volatile("s_waitcnt vmcnt(0)" ::: "memory");
            const unsigned og = xb_add(&bar[XB_TOP], 1u);
            const unsigned tg = og / nx;
            if (og + 1u == (tg + 1u) * nx) xb_add(&bar[XB_TOPGEN], 1u);
            else XB_SPIN(xb_ld(&bar[XB_TOPGEN]) == tg, bar);
            __builtin_amdgcn_fence(__ATOMIC_ACQUIRE, "agent");
            xb_add(&bar[XB_XGEN(b.x)], 1u);
            asm volatile("s_waitcnt vmcnt(0)" ::: "memory");
        } else {
            XB_SPIN(xb_ld(&bar[XB_XGEN(b.x)]) == gen, bar);
            __builtin_amdgcn_fence(__ATOMIC_ACQUIRE, "agent");
            asm volatile("s_waitcnt vmcnt(0)" ::: "memory");
        }
    }
    __syncthreads();
}

constexpr int NWAVES = 8;
constexpr int NB = 4, S = 4096, D = 1024, M = NB * S;
constexpr int NIN = 3072, NQ = 2048, NEXP = 16384;
constexpr float EPS = 1e-6f;
constexpr float C2 = 0.125f * 1.4426950408889634f;

constexpr size_t MiB = 1u << 20;
constexpr size_t WS_CTL = 0, CTL_ZERO_BYTES = 256 * 1024;
constexpr size_t WS_MOD = 1 * MiB;
constexpr size_t WS_KMEAN = 128 * 1024;
constexpr size_t WS_KEYS = 1 * MiB + 512 * 1024;
constexpr size_t WS_WIN = 2 * MiB, WS_WO = 8 * MiB, WS_WQ = 10 * MiB;
constexpr size_t WS_EIDX = 14 * MiB, WS_G = 22 * MiB;
constexpr size_t WS_U = 32 * MiB, WS_V = 64 * MiB;
constexpr size_t WS_SU = 48 * MiB, WS_SV = 48 * MiB + 64 * 1024;
constexpr size_t WS_H = 96 * MiB;
constexpr size_t WS_P = 128 * MiB;
constexpr size_t WS_QP = 128 * MiB, WS_O = 192 * MiB;
constexpr size_t WS_Y = 224 * MiB, WS_END = 256 * MiB;
constexpr int CW_BAR = 1024;
constexpr int CW_CMAX = 8192;
constexpr int CW_CMAX3 = CW_CMAX + 3072 + 2048;
constexpr float YQ = 127.f / 6.f;
constexpr int CW_CMAX2 = CW_CMAX + 3072;
constexpr size_t WS_WO8 = 47 * MiB;
constexpr size_t WS_WQ8 = 45 * MiB, WS_RS2 = 44 * MiB + 65536;
constexpr size_t WS_WIN8 = 40 * MiB, WS_RS = 44 * MiB;

constexpr int LDS_BYTES = 153600;
constexpr int LDSCTL_OFF = LDS_BYTES - 512, MISC_OFF = LDSCTL_OFF + 320;
constexpr int RING_BYTES = 131072;

struct Frame {
    LAS unsigned char* lds;
    volatile LAS unsigned* MISC;
    gu32* ctl;
    int tid, lane, wave, G;
    const float *x, *c, *ada_w, *ada_b, *pre_gain, *post_gain, *w_in, *conv_w, *group_gain, *w_out, *fpre_gain, *fpost_gain, *wq, *keys, *pu, *pv;
    float* out;
    float* mod; float* kmean; bf16* keysb; bf16 *WinT, *WoT, *WqT; int* eidx; float* gw; unsigned char *U8, *V8; float *su, *sv; bf16 *H, *P, *QP, *O, *Y; float* scratch; unsigned char* Win8; float* rs; unsigned char* Wq8; float* rs2; unsigned char* Wo8;
};

__device__ __forceinline__ float wave_sum(float v) {
#pragma unroll
    for (int o = 1; o < 64; o <<= 1) v += __shfl_xor(v, o);
    return v;
}
__device__ __forceinline__ float bflo(unsigned u) { return __uint_as_float(u << 16); }
__device__ __forceinline__ float bfhi(unsigned u) { return __uint_as_float(u & 0xffff0000u); }

template <bool CMAX = false, bool KSC = false> __device__ __forceinline__ void p0_transpose_item(const float* W, int K, int N, bf16* WT, LAS float* scr, int item, int lane, unsigned* cmax = nullptr, const float* ksc = nullptr) {
    const int nblk = N / 32, kb = item / nblk, nb = item % nblk, k0 = 64 * kb, n0 = 32 * nb;
#pragma unroll 8
    for (int i = 0; i < 32; ++i) { const int kk = 2 * i + (lane >> 5); float wv = W[(size_t)(k0 + kk) * N + n0 + (lane & 31)]; if (KSC) wv *= ksc[k0 + kk] * (1.f / YQ); scr[kk * 33 + (lane & 31)] = wv; }
    LDS_WAIT(); asm volatile("" ::: "memory");
    const int c = lane & 7;
#pragma unroll
    for (int j = 0; j < 4; ++j) { const int n = (lane >> 3) + 8 * j; const LAS float* s = scr + (8 * c) * 33 + n;
        v4u o; o.x = pk2(s[0 * 33], s[1 * 33]); o.y = pk2(s[2 * 33], s[3 * 33]); o.z = pk2(s[4 * 33], s[5 * 33]); o.w = pk2(s[6 * 33], s[7 * 33]);
        st16_wt((void*)(WT + (size_t)(n0 + n) * K + k0 + 8 * c), o);
        if (CMAX) {
            float am = fmaxf(fmaxf(fmaxf(fabsf(s[0 * 33]), fabsf(s[1 * 33])), fmaxf(fabsf(s[2 * 33]), fabsf(s[3 * 33]))), fmaxf(fmaxf(fabsf(s[4 * 33]), fabsf(s[5 * 33])), fmaxf(fabsf(s[6 * 33]), fabsf(s[7 * 33]))));
            am = fmaxf(am, __shfl_xor(am, 1)); am = fmaxf(am, __shfl_xor(am, 2)); am = fmaxf(am, __shfl_xor(am, 4));
            if (c == 0) atomicMax(cmax + n0 + n, __float_as_uint(am));
        } }
    LDS_WAIT(); asm volatile("" ::: "memory");
}
__device__ __forceinline__ void cvt8(const float* src, bf16* dst, size_t i8) {
    const f32x4 a = *(const GAS f32x4*)(src + i8 * 8), b = *(const GAS f32x4*)(src + i8 * 8 + 4);
    v4u o; o.x = pk2(a.x, a.y); o.y = pk2(a.z, a.w); o.z = pk2(b.x, b.y); o.w = pk2(b.z, b.w);
    st16_wt((void*)(dst + i8 * 8), o);
}
__device__ __forceinline__ void p0_prep(Frame& F) {
    {
        LAS float* sc = (LAS float*)F.lds;
        LAS float* red = sc + 4096;
        bool did = false;
        for (int it = blockIdx.x; it < 192; it += F.G) {
            if (!did) { for (int i = F.tid; i < 4096; i += 512) { const float v = F.c[i]; sc[i] = v / (1.f + __expf(-v)); } did = true; }
            __syncthreads();
            const int c4 = F.tid & 7, ks = F.tid >> 3, j0 = it * 32 + 4 * c4;
            f32x4 w[16];
#pragma unroll
            for (int i = 0; i < 16; ++i) w[i] = *(const GAS f32x4*)(F.ada_w + (size_t)(ks * 16 + i) * 6144 + j0);
            f32x4 a0 = {0.f, 0.f, 0.f, 0.f}, a1 = a0, a2 = a0, a3 = a0;
#pragma unroll
            for (int i = 0; i < 16; ++i) { const int r = ks * 16 + i; a0 += w[i] * sc[r]; a1 += w[i] * sc[1024 + r]; a2 += w[i] * sc[2048 + r]; a3 += w[i] * sc[3072 + r]; }
            *(LAS f32x4*)(red + (ks * 4 + 0) * 32 + 4 * c4) = a0; *(LAS f32x4*)(red + (ks * 4 + 1) * 32 + 4 * c4) = a1;
            *(LAS f32x4*)(red + (ks * 4 + 2) * 32 + 4 * c4) = a2; *(LAS f32x4*)(red + (ks * 4 + 3) * 32 + 4 * c4) = a3;
            __syncthreads();
            if (F.tid < 128) { const int b = F.tid >> 5, jj = F.tid & 31; float s = 0.f;
#pragma unroll 16
                for (int k = 0; k < 64; ++k) s += red[(k * 4 + b) * 32 + jj];
                __hip_atomic_store(F.mod + b * 6144 + it * 32 + jj, s + F.ada_b[it * 32 + jj], __ATOMIC_RELAXED, __HIP_MEMORY_SCOPE_AGENT); }
        }
        __syncthreads();
    }
    LAS float* scr = (LAS float*)(F.lds + F.wave * 16384);
    const int gwv = blockIdx.x * NWAVES + F.wave, NGW = F.G * NWAVES;
    constexpr int I_IN = (D / 64) * (NIN / 32), I_O = (D / 64) * (D / 32), I_Q = (D / 64) * (NQ / 32);
    for (int it = gwv; it < I_IN + I_O + I_Q; it += NGW) {
        int r = it;
        if (r < I_IN) { p0_transpose_item<true>(F.w_in, D, NIN, F.WinT, scr, r, F.lane, (unsigned*)(F.ctl + CW_CMAX)); continue; } r -= I_IN;
        if (r < I_O) { p0_transpose_item<true, true>(F.w_out, D, D, F.WoT, scr, r, F.lane, (unsigned*)(F.ctl + CW_CMAX3), F.group_gain); continue; } r -= I_O;
        p0_transpose_item<true>(F.wq, D, NQ, F.WqT, scr, r, F.lane, (unsigned*)(F.ctl + CW_CMAX2));
    }
    const size_t gt = (size_t)blockIdx.x * 512 + F.tid, NT = (size_t)F.G * 512;
    for (size_t i = gt; i < (size_t)16 * 128 * 128 / 8; i += NT) cvt8(F.keys, F.keysb, i);
}
__device__ __forceinline__ void p0_tables(Frame& F) {
    const int gwv = blockIdx.x * NWAVES + F.wave, NGW = F.G * NWAVES;
    for (int row0 = gwv; row0 < 2 * NEXP; row0 += 2 * NGW) {
      f32x4 a2[2][4];
#pragma unroll
      for (int rr = 0; rr < 2; ++rr) { const int row = row0 + rr * NGW; if (row < 2 * NEXP) { const GAS f32x4* src = (const GAS f32x4*)(((row >> 14) ? F.pv : F.pu) + (size_t)(row & (NEXP - 1)) * D + 16 * F.lane);
#pragma unroll
          for (int i = 0; i < 4; ++i) a2[rr][i] = src[i]; } }
#pragma unroll
      for (int rr = 0; rr < 2; ++rr) { const int row = row0 + rr * NGW; if (row >= 2 * NEXP) break;
        const int tabv = row >> 14, e = row & (NEXP - 1);
        f32x4 a[4]; float ssq = 0.f;
#pragma unroll
        for (int i = 0; i < 4; ++i) { a[i] = a2[rr][i]; ssq += (a[i].x * a[i].x + a[i].y * a[i].y) + (a[i].z * a[i].z + a[i].w * a[i].w); }
        ssq = wave_sum(ssq);
        const float rms = sqrtf(ssq * (1.f / D));
        if (tabv == 0) {
            const float stepq = 0.34f * rms, isq = stepq > 0.f ? 1.f / stepq : 0.f;
            unsigned d0 = 0u, d1 = 0u;
#pragma unroll
            for (int i = 0; i < 4; ++i) { const float xs[4] = {a[i].x, a[i].y, a[i].z, a[i].w};
#pragma unroll
                for (int c = 0; c < 4; ++c) { const int q = (int)fminf(fmaxf(__builtin_rintf(xs[c] * isq), -7.f), 7.f); const int el = 4 * i + c;
                    if (el < 8) d0 |= (unsigned)(q & 15) << (4 * el); else d1 |= (unsigned)(q & 15) << (4 * (el - 8)); } }
            st8_wt((void*)(F.U8 + (size_t)e * 512 + 8 * F.lane), (unsigned long long)d0 | ((unsigned long long)d1 << 32));
            if (F.lane == 0) __hip_atomic_store(F.su + e, stepq, __ATOMIC_RELAXED, __HIP_MEMORY_SCOPE_AGENT);
        } else {
            const float unit = 0.5f * rms, iu = unit > 0.f ? 1.f / unit : 0.f;
            unsigned d0 = 0u, d1 = 0u;
            d0 = __builtin_amdgcn_cvt_scalef32_pk_fp4_f32(d0, a[0].x * iu, a[0].y * iu, 1.0f, 0); d0 = __builtin_amdgcn_cvt_scalef32_pk_fp4_f32(d0, a[0].z * iu, a[0].w * iu, 1.0f, 1);
            d0 = __builtin_amdgcn_cvt_scalef32_pk_fp4_f32(d0, a[1].x * iu, a[1].y * iu, 1.0f, 2); d0 = __builtin_amdgcn_cvt_scalef32_pk_fp4_f32(d0, a[1].z * iu, a[1].w * iu, 1.0f, 3);
            d1 = __builtin_amdgcn_cvt_scalef32_pk_fp4_f32(d1, a[2].x * iu, a[2].y * iu, 1.0f, 0); d1 = __builtin_amdgcn_cvt_scalef32_pk_fp4_f32(d1, a[2].z * iu, a[2].w * iu, 1.0f, 1);
            d1 = __builtin_amdgcn_cvt_scalef32_pk_fp4_f32(d1, a[3].x * iu, a[3].y * iu, 1.0f, 2); d1 = __builtin_amdgcn_cvt_scalef32_pk_fp4_f32(d1, a[3].z * iu, a[3].w * iu, 1.0f, 3);
            st8_wt((void*)(F.V8 + (size_t)(F.lane >> 4) * (NEXP * 128) + (size_t)e * 128 + (F.lane & 15) * 8), (unsigned long long)d0 | ((unsigned long long)d1 << 32));
            if (F.lane == 0) __hip_atomic_store(F.sv + e, unit, __ATOMIC_RELAXED, __HIP_MEMORY_SCOPE_AGENT);
        }
      }
    }
}

__device__ __forceinline__ unsigned q8x4(const f32x4 v, float qs) {
    const int a = (int)__builtin_rintf(v.x * qs), b = (int)__builtin_rintf(v.y * qs), c = (int)__builtin_rintf(v.z * qs), d = (int)__builtin_rintf(v.w * qs);
    return ((unsigned)a & 0xffu) | (((unsigned)b & 0xffu) << 8) | (((unsigned)c & 0xffu) << 16) | ((unsigned)d << 24);
}
__device__ __forceinline__ unsigned q8x4c(const f32x4 v, float qs) {
    const int a = (int)fminf(fmaxf(__builtin_rintf(v.x * qs), -127.f), 127.f), b = (int)fminf(fmaxf(__builtin_rintf(v.y * qs), -127.f), 127.f);
    const int c = (int)fminf(fmaxf(__builtin_rintf(v.z * qs), -127.f), 127.f), d = (int)fminf(fmaxf(__builtin_rintf(v.w * qs), -127.f), 127.f);
    return ((unsigned)a & 0xffu) | (((unsigned)b & 0xffu) << 8) | (((unsigned)c & 0xffu) << 16) | ((unsigned)d << 24);
}
__device__ __forceinline__ void p1_hnorm(Frame& F) {
    const int gwv = blockIdx.x * NWAVES + F.wave, NGW = F.G * NWAVES;
    for (int m0 = gwv * 4; m0 < M; m0 += NGW * 4) {
        const int b = m0 >> 12;
        f32x4 v[4][4];
#pragma unroll
        for (int r = 0; r < 4; ++r) { const GAS f32x4* xr = (const GAS f32x4*)(F.x + (size_t)(m0 + r) * D) + F.lane;
#pragma unroll
            for (int j = 0; j < 4; ++j) v[r][j] = xr[64 * j]; }
        f32x4 gs[4], sh[4];
#pragma unroll
        for (int j = 0; j < 4; ++j) { const int col = 4 * F.lane + 256 * j;
            gs[j] = *(const GAS f32x4*)(F.pre_gain + col) * (*(const GAS f32x4*)(F.mod + b * 6144 + 1024 + col) + 1.f); sh[j] = *(const GAS f32x4*)(F.mod + b * 6144 + col); }
#pragma unroll
        for (int r = 0; r < 4; ++r) {
            float ss = 0.f;
#pragma unroll
            for (int j = 0; j < 4; ++j) ss += (v[r][j].x * v[r][j].x + v[r][j].y * v[r][j].y) + (v[r][j].z * v[r][j].z + v[r][j].w * v[r][j].w);
            const float rstd = rsqrtf(wave_sum(ss) * (1.f / D) + EPS);
            f32x4 o[4]; float am = 0.f;
#pragma unroll
            for (int j = 0; j < 4; ++j) { o[j] = v[r][j] * rstd * gs[j] + sh[j]; am = fmaxf(am, fmaxf(fmaxf(fabsf(o[j].x), fabsf(o[j].y)), fmaxf(fabsf(o[j].z), fabsf(o[j].w)))); }
#pragma unroll
            for (int of = 1; of < 64; of <<= 1) am = fmaxf(am, __shfl_xor(am, of));
            const float qs = am > 0.f ? 127.f / am : 0.f;
            v4u w; w.x = q8x4(o[0], qs); w.y = q8x4(o[1], qs); w.z = q8x4(o[2], qs); w.w = q8x4(o[3], qs);
            st16_wt((void*)((unsigned char*)F.H + (size_t)(m0 + r) * D + 16 * F.lane), w);
            if (F.lane == 0) __hip_atomic_store(F.rs + m0 + r, am * (1.f / 127.f), __ATOMIC_RELAXED, __HIP_MEMORY_SCOPE_AGENT);
        }
    }
    for (int n = gwv; n < NIN; n += NGW) {
        const float cm = __uint_as_float(F.ctl[CW_CMAX + n]); const float qs = cm > 0.f ? 127.f / cm : 0.f;
        const GAS unsigned long long* src = (const GAS unsigned long long*)(F.WinT + (size_t)n * D) + F.lane;
        unsigned long long q[4];
#pragma unroll
        for (int j = 0; j < 4; ++j) q[j] = src[64 * j];
        unsigned wd[4];
#pragma unroll
        for (int j = 0; j < 4; ++j) { const unsigned lo = (unsigned)q[j], hi = (unsigned)(q[j] >> 32); wd[j] = q8x4((f32x4){bflo(lo), bfhi(lo), bflo(hi), bfhi(hi)}, qs); }
        v4u w; w.x = wd[0]; w.y = wd[1]; w.z = wd[2]; w.w = wd[3];
        st16_wt((void*)(F.Win8 + (size_t)n * D + 16 * F.lane), w);
    }
    for (int n = gwv; n < NQ; n += NGW) {
        const float cm = __uint_as_float(F.ctl[CW_CMAX2 + n]); const float qs = cm > 0.f ? 127.f / cm : 0.f;
        const GAS v4u* src = (const GAS v4u*)(F.WqT + (size_t)n * D + 16 * F.lane);
        const v4u q0 = src[0], q1 = src[1];
        v4u w; w.x = q8x4((f32x4){bflo(q0.x), bfhi(q0.x), bflo(q0.y), bfhi(q0.y)}, qs); w.y = q8x4((f32x4){bflo(q0.z), bfhi(q0.z), bflo(q0.w), bfhi(q0.w)}, qs);
        w.z = q8x4((f32x4){bflo(q1.x), bfhi(q1.x), bflo(q1.y), bfhi(q1.y)}, qs); w.w = q8x4((f32x4){bflo(q1.z), bfhi(q1.z), bflo(q1.w), bfhi(q1.w)}, qs);
        st16_wt((void*)(F.Wq8 + (size_t)n * D + 16 * F.lane), w);
    }
    for (int n = gwv; n < D; n += NGW) {
        const float cm = __uint_as_float(F.ctl[CW_CMAX3 + n]); const float qs = cm > 0.f ? 127.f / cm : 0.f;
        const GAS v4u* src = (const GAS v4u*)(F.WoT + (size_t)n * D + 16 * F.lane);
        const v4u q0 = src[0], q1 = src[1];
        v4u w; w.x = q8x4((f32x4){bflo(q0.x), bfhi(q0.x), bflo(q0.y), bfhi(q0.y)}, qs); w.y = q8x4((f32x4){bflo(q0.z), bfhi(q0.z), bflo(q0.w), bfhi(q0.w)}, qs);
        w.z = q8x4((f32x4){bflo(q1.x), bfhi(q1.x), bflo(q1.y), bfhi(q1.y)}, qs); w.w = q8x4((f32x4){bflo(q1.z), bfhi(q1.z), bflo(q1.w), bfhi(q1.w)}, qs);
        st16_wt((void*)(F.Wo8 + (size_t)n * D + 16 * F.lane), w);
    }
}

__device__ __forceinline__ void unpack8(const v4u w, float* f) { f[0] = bflo(w.x); f[1] = bfhi(w.x); f[2] = bflo(w.y); f[3] = bfhi(w.y); f[4] = bflo(w.z); f[5] = bfhi(w.z); f[6] = bflo(w.w); f[7] = bfhi(w.w); }
__device__ __forceinline__ void p6_conv(Frame& F) {
    const int gwv = blockIdx.x * NWAVES + F.wave, NGW = F.G * NWAVES;
    const int col = 8 * F.lane;
    float cw[3][8], gg[8];
#pragma unroll
    for (int j = 0; j < 3; ++j)
#pragma unroll
        for (int i = 0; i < 8; ++i) cw[j][i] = F.conv_w[j * 512 + col + i];
#pragma unroll
    for (int i = 0; i < 8; ++i) gg[i] = F.group_gain[col + i];
    for (int t0 = gwv * 4; t0 < M; t0 += NGW * 4) {
        const int s0 = t0 & 4095;
        v4u gbw[4], gcw[6], hxw[6];
#pragma unroll
        for (int r = 0; r < 4; ++r) gbw[r] = *(const GAS v4u*)(F.P + (size_t)(t0 + r) * NIN + col);
#pragma unroll
        for (int k = 0; k < 6; ++k) { const int tt = (s0 == 0 && k < 2) ? t0 : (t0 - 2 + k);
            const bf16* rp = F.P + (size_t)tt * NIN + col; gcw[k] = *(const GAS v4u*)(rp + 512); hxw[k] = *(const GAS v4u*)(rp + 1024); }
        float u[6][8];
#pragma unroll
        for (int k = 0; k < 6; ++k) { float gc[8], hx[8]; unpack8(gcw[k], gc); unpack8(hxw[k], hx); const float keep = (s0 == 0 && k < 2) ? 0.f : 1.f;
#pragma unroll
            for (int i = 0; i < 8; ++i) u[k][i] = keep * gc[i] * hx[i]; }
#pragma unroll
        for (int r = 0; r < 4; ++r) {
            float acc[8], gb[8]; unpack8(gbw[r], gb);
            float ss = 0.f;
#pragma unroll
            for (int i = 0; i < 8; ++i) { acc[i] = gb[i] * (cw[0][i] * u[r][i] + cw[1][i] * u[r + 1][i] + cw[2][i] * u[r + 2][i]); ss += acc[i] * acc[i]; }
            ss += __shfl_xor(ss, 1); ss += __shfl_xor(ss, 2); ss += __shfl_xor(ss, 4);
            const float rstd = rsqrtf(ss * (1.f / 64.f) + EPS);
            const float qn = rstd * YQ;
            const unsigned w0 = q8x4c((f32x4){acc[0], acc[1], acc[2], acc[3]}, qn), w1 = q8x4c((f32x4){acc[4], acc[5], acc[6], acc[7]}, qn);
            st8_wt((void*)((unsigned char*)F.Y + (size_t)(t0 + r) * D + col), (unsigned long long)w0 | ((unsigned long long)w1 << 32));
        }
    }
}
__device__ __forceinline__ void p8_resid(Frame& F) {
    const int gwv = blockIdx.x * NWAVES + F.wave, NGW = F.G * NWAVES;
    for (int m0 = gwv * 2; m0 < M; m0 += NGW * 2) {
        const float* md = F.mod + (m0 >> 12) * 6144;
        unsigned long long ow[2][4]; f32x4 xv[2][4];
#pragma unroll
        for (int r = 0; r < 2; ++r) {
            const GAS unsigned long long* orow = (const GAS unsigned long long*)(F.O + (size_t)(m0 + r) * D) + F.lane; const GAS f32x4* xr = (const GAS f32x4*)(F.x + (size_t)(m0 + r) * D) + F.lane;
#pragma unroll
            for (int j = 0; j < 4; ++j) { ow[r][j] = orow[64 * j]; xv[r][j] = xr[64 * j]; } }
        f32x4 gg[4], gs[4], sh[4];
#pragma unroll
        for (int j = 0; j < 4; ++j) { const int col = 4 * F.lane + 256 * j;
            gg[j] = *(const GAS f32x4*)(F.post_gain + col) * *(const GAS f32x4*)(md + 2048 + col);
            gs[j] = *(const GAS f32x4*)(F.fpre_gain + col) * (*(const GAS f32x4*)(md + 4096 + col) + 1.f); sh[j] = *(const GAS f32x4*)(md + 3072 + col); }
#pragma unroll
        for (int r = 0; r < 2; ++r) { const int m = m0 + r;
            f32x4 ov[4]; float ss = 0.f;
#pragma unroll
            for (int j = 0; j < 4; ++j) { const unsigned lo = (unsigned)ow[r][j], hi = (unsigned)(ow[r][j] >> 32); ov[j] = (f32x4){bflo(lo), bfhi(lo), bflo(hi), bfhi(hi)};
                ss += (ov[j].x * ov[j].x + ov[j].y * ov[j].y) + (ov[j].z * ov[j].z + ov[j].w * ov[j].w); }
            const float rstd = rsqrtf(wave_sum(ss) * (1.f / D) + EPS);
            GAS unsigned long long* x1r = (GAS unsigned long long*)(F.QP + (size_t)m * D) + F.lane;
            f32x4 x1[4]; float s2 = 0.f;
#pragma unroll
            for (int j = 0; j < 4; ++j) { x1[j] = xv[r][j] + gg[j] * (ov[j] * rstd); st8_wt((void*)(x1r + 64 * j), (unsigned long long)pk2(x1[j].x, x1[j].y) | ((unsigned long long)pk2(x1[j].z, x1[j].w) << 32));
                s2 += (x1[j].x * x1[j].x + x1[j].y * x1[j].y) + (x1[j].z * x1[j].z + x1[j].w * x1[j].w); }
            const float rstd2 = rsqrtf(wave_sum(s2) * (1.f / D) + EPS);
            f32x4 o[4]; float am = 0.f;
#pragma unroll
            for (int j = 0; j < 4; ++j) { o[j] = x1[j] * rstd2 * gs[j] + sh[j]; am = fmaxf(am, fmaxf(fmaxf(fabsf(o[j].x), fabsf(o[j].y)), fmaxf(fabsf(o[j].z), fabsf(o[j].w)))); }
#pragma unroll
            for (int of = 1; of < 64; of <<= 1) am = fmaxf(am, __shfl_xor(am, of));
            const float qs = am > 0.f ? 119.f / am : 0.f;
#pragma unroll
            for (int j = 0; j < 4; ++j) st4_wt((void*)((unsigned char*)F.H + (size_t)m * D + 4 * F.lane + 256 * j), q8x4(o[j], qs));
            if (F.lane == 0) __hip_atomic_store(F.rs2 + m, am * (1.f / 119.f), __ATOMIC_RELAXED, __HIP_MEMORY_SCOPE_AGENT);
        }
    }
}
typedef float f32x16 __attribute__((ext_vector_type(16)));
__device__ __forceinline__ float vmaxf(float a, float b) { float r; asm("v_max_f32_e32 %0, %1, %2" : "=v"(r) : "v"(a), "v"(b)); return r; }
__device__ __forceinline__ float vminf(float a, float b) { float r; asm("v_min_f32_e32 %0, %1, %2" : "=v"(r) : "v"(a), "v"(b)); return r; }
#define CE_D(a, b) do { const float hi_ = vmaxf(a, b), lo_ = vminf(a, b); a = hi_; b = lo_; } while (0)
template <int N> __device__ __forceinline__ void bitonic_sort_desc(float (&v)[N]) {
#pragma unroll
    for (int k = 2; k <= N; k <<= 1)
#pragma unroll
        for (int j = k >> 1; j > 0; j >>= 1)
#pragma unroll
            for (int i = 0; i < N; ++i) { const int l = i ^ j; if (l > i) { if ((i & k) == 0) CE_D(v[i], v[l]); else CE_D(v[l], v[i]); } }
}
template <int N> __device__ __forceinline__ void bitonic_merge_desc(float (&v)[N]) {
#pragma unroll
    for (int j = N >> 1; j > 0; j >>= 1)
#pragma unroll
        for (int i = 0; i < N; ++i) { const int l = i ^ j; if (l > i) CE_D(v[i], v[l]); }
}
__device__ __forceinline__ void sort16_desc(float (&v)[16]) {
    CE_D(v[0], v[1]); CE_D(v[2], v[3]); CE_D(v[0], v[2]); CE_D(v[1], v[3]); CE_D(v[1], v[2]); CE_D(v[4], v[5]); CE_D(v[6], v[7]); CE_D(v[4], v[6]); CE_D(v[5], v[7]); CE_D(v[5], v[6]); CE_D(v[0], v[4]); CE_D(v[2], v[6]); CE_D(v[2], v[4]); CE_D(v[1], v[5]); CE_D(v[3], v[7]); CE_D(v[3], v[5]); CE_D(v[1], v[2]); CE_D(v[3], v[4]); CE_D(v[5], v[6]); CE_D(v[8], v[9]); CE_D(v[10], v[11]); CE_D(v[8], v[10]); CE_D(v[9], v[11]); CE_D(v[9], v[10]); CE_D(v[12], v[13]); CE_D(v[14], v[15]); CE_D(v[12], v[14]); CE_D(v[13], v[15]); CE_D(v[13], v[14]); CE_D(v[8], v[12]); CE_D(v[10], v[14]); CE_D(v[10], v[12]); CE_D(v[9], v[13]); CE_D(v[11], v[15]); CE_D(v[11], v[13]); CE_D(v[9], v[10]); CE_D(v[11], v[12]); CE_D(v[13], v[14]); CE_D(v[0], v[8]); CE_D(v[4], v[12]); CE_D(v[4], v[8]); CE_D(v[2], v[10]); CE_D(v[6], v[14]); CE_D(v[6], v[10]); CE_D(v[2], v[4]); CE_D(v[6], v[8]); CE_D(v[10], v[12]); CE_D(v[1], v[9]); CE_D(v[5], v[13]); CE_D(v[5], v[9]); CE_D(v[3], v[11]); CE_D(v[7], v[15]); CE_D(v[7], v[11]); CE_D(v[3], v[5]); CE_D(v[7], v[9]); CE_D(v[11], v[13]); CE_D(v[1], v[2]); CE_D(v[3], v[4]); CE_D(v[5], v[6]); CE_D(v[7], v[8]); CE_D(v[9], v[10]); CE_D(v[11], v[12]); CE_D(v[13], v[14]);
}
__device__ __forceinline__ void top16_merge(float (&a)[16], const float (&b)[16]) {
#pragma unroll
    for (int i = 0; i < 16; ++i) a[i] = vmaxf(a[i], b[15 - i]);
    bitonic_merge_desc<16>(a);
}
__device__ __forceinline__ void top16_of_64(const float (&v)[64], float (&out)[16]) {
    float g1[16], g2[16], g3[16];
#pragma unroll
    for (int i = 0; i < 16; ++i) { out[i] = v[i]; g1[i] = v[16 + i]; g2[i] = v[32 + i]; g3[i] = v[48 + i]; }
    sort16_desc(out); sort16_desc(g1); sort16_desc(g2); sort16_desc(g3);
    top16_merge(out, g1); top16_merge(g2, g3); top16_merge(out, g2);
}
constexpr int KROW = 272, KIMG = 128 * KROW;
__device__ __forceinline__ void route_half(const bf16x8 (&bq)[8], const LAS unsigned char* kimg, int r32, int hh, float (&svp)[16], unsigned (&ivp)[16]) {
    const LAS unsigned char* krow = kimg + r32 * KROW + 16 * hh;
    f32x16 acc[4];
#pragma unroll
    for (int nt = 0; nt < 4; ++nt) {
        acc[nt] = (f32x16){0.f, 0.f, 0.f, 0.f, 0.f, 0.f, 0.f, 0.f, 0.f, 0.f, 0.f, 0.f, 0.f, 0.f, 0.f, 0.f};
#pragma unroll
        for (int ks = 0; ks < 8; ++ks) { const bf16x8 ak = *(const LAS bf16x8*)(krow + nt * 32 * KROW + 32 * ks);
            acc[nt] = __builtin_amdgcn_mfma_f32_32x32x16_bf16(ak, bq[ks], acc[nt], 0, 0, 0); }
    }
    float v[64];
#pragma unroll
    for (int nt = 0; nt < 4; ++nt)
#pragma unroll
        for (int i = 0; i < 16; ++i) { const unsigned code = (unsigned)(32 * nt + 8 * (i >> 2) + (i & 3)); v[nt * 16 + i] = __uint_as_float((__float_as_uint(acc[nt][i]) & ~127u) | code); }
    float L[16], Pn[16];
    top16_of_64(v, L);
#pragma unroll
    for (int i = 0; i < 16; ++i) { L[i] = __uint_as_float(__float_as_uint(L[i]) | (unsigned)(hh << 2)); Pn[i] = __shfl_xor(L[i], 32); }
    top16_merge(L, Pn);
#pragma unroll
    for (int i = 0; i < 16; ++i) { const unsigned bits = __float_as_uint(L[i]); svp[i] = __uint_as_float(bits & ~127u); ivp[i] = bits & 127u; }
}
__device__ __forceinline__ void route_finish(const float (&sv)[2][16], const unsigned (&iv)[2][16], LAS unsigned* tab, int lane, int hh, int* epi, float* gpf, float rst) {
#define CAND(a, b) __uint_as_float((__float_as_uint(sv[0][a] + sv[1][b]) & ~255u) | (unsigned)((a) * 16 + (b)))
    float W[16], g1[16], g2[16];
#pragma unroll
    for (int i = 0; i < 16; ++i) W[i] = CAND(0, i);
#pragma unroll
    for (int i = 0; i < 15; ++i) g1[i] = CAND(i + 1, 0);
    g1[15] = -3e38f;
    g2[0] = CAND(1, 1); g2[1] = CAND(1, 2); g2[2] = CAND(1, 3); g2[3] = CAND(1, 4); g2[4] = CAND(1, 5); g2[5] = CAND(1, 6); g2[6] = CAND(1, 7);
    g2[7] = CAND(2, 1); g2[8] = CAND(2, 2); g2[9] = CAND(2, 3); g2[10] = CAND(2, 4); g2[11] = CAND(3, 1); g2[12] = CAND(3, 2); g2[13] = CAND(3, 3); g2[14] = CAND(4, 1); g2[15] = CAND(4, 2);
    sort16_desc(g2);
    g2[13] = vmaxf(g2[13], CAND(7, 1)); g2[14] = vmaxf(g2[14], CAND(6, 1)); g2[15] = vmaxf(g2[15], CAND(5, 1));
    bitonic_merge_desc<16>(g2);
    top16_merge(W, g1); top16_merge(W, g2);
#undef CAND
#pragma unroll
    for (int j = 0; j < 16; ++j) { tab[j * 64 + lane] = iv[0][j]; tab[(16 + j) * 64 + lane] = iv[1][j]; }
    float e[16], sum = 0.f; unsigned ex[16];
    const float s0 = __uint_as_float(__float_as_uint(W[0]) & ~255u);
#pragma unroll
    for (int j = 0; j < 16; ++j) { const unsigned bits = __float_as_uint(W[j]); const unsigned code = bits & 255u;
        e[j] = __expf((__uint_as_float(bits & ~255u) - s0) * rst); sum += e[j];
        ex[j] = tab[(code >> 4) * 64 + lane] * 128u + tab[(16 + (code & 15u)) * 64 + lane]; }
    const float inv = 1.f / sum;
    v4u eo0, eo1; f32x4 go0, go1;
    eo0.x = hh ? ex[8] : ex[0]; eo0.y = hh ? ex[9] : ex[1]; eo0.z = hh ? ex[10] : ex[2]; eo0.w = hh ? ex[11] : ex[3];
    eo1.x = hh ? ex[12] : ex[4]; eo1.y = hh ? ex[13] : ex[5]; eo1.z = hh ? ex[14] : ex[6]; eo1.w = hh ? ex[15] : ex[7];
    go0.x = (hh ? e[8] : e[0]) * inv; go0.y = (hh ? e[9] : e[1]) * inv; go0.z = (hh ? e[10] : e[2]) * inv; go0.w = (hh ? e[11] : e[3]) * inv;
    go1.x = (hh ? e[12] : e[4]) * inv; go1.y = (hh ? e[13] : e[5]) * inv; go1.z = (hh ? e[14] : e[6]) * inv; go1.w = (hh ? e[15] : e[7]) * inv;
    GAS v4u* ep = (GAS v4u*)epi; GAS f32x4* gp = (GAS f32x4*)gpf;
    st16_wt((void*)ep, eo0); st16_wt((void*)(ep + 1), eo1); st16_wt((void*)gp, __builtin_bit_cast(wt_v4u, go0)); st16_wt((void*)(gp + 1), __builtin_bit_cast(wt_v4u, go1));
}
__device__ __forceinline__ pg8::f32x4 i2f(const pg8::f32x4 a) { const pg8::i32x4 i = __builtin_bit_cast(pg8::i32x4, a); return (pg8::f32x4){(float)i[0], (float)i[1], (float)i[2], (float)i[3]}; }
struct EpiRoute {
    static constexpr bool PERM = true, AFTER_DRAIN = true;
    const bf16* keysb; int* eidx; float* gw; const unsigned* cmax2; const float* rs2;
    __device__ __forceinline__ void fused(pg8::f32x4 (&acc)[2][2][4][2], const pg8::Unit& u, int wr, int wc, int fr, int fq, LAS unsigned char* lds, int wid, int lane) const {
        int tid_ = threadIdx.x; asm volatile("" : "+v"(tid_)); const int h = u.pn, r32 = lane & 31, hh = lane >> 5, tid = tid_;
        LAS unsigned char* Qs = lds; LAS unsigned char* Ks = lds + 256 * KROW;
        v4u q1[2][4];
#pragma unroll
        for (int ai = 0; ai < 2; ++ai)
#pragma unroll
            for (int m = 0; m < 4; ++m) { const pg8::f32x4 a = i2f(acc[ai][1][m][0]), b = i2f(acc[ai][1][m][1]);
                q1[ai][m] = (v4u){pg8::cvt_pk_bf16(a[0], a[1]), pg8::cvt_pk_bf16(a[2], a[3]), pg8::cvt_pk_bf16(b[0], b[1]), pg8::cvt_pk_bf16(b[2], b[3])}; }
        float sv[2][16]; unsigned iv[2][16];
#pragma unroll
        for (int p = 0; p < 2; ++p) {
            if (p == 1) { asm volatile("s_waitcnt lgkmcnt(0)" ::: "memory"); __builtin_amdgcn_s_barrier(); asm volatile("" ::: "memory"); }
#pragma unroll
            for (int ai = 0; ai < 2; ++ai)
#pragma unroll
                for (int m = 0; m < 4; ++m) { v4u w;
                    if (p == 0) { const pg8::f32x4 a = i2f(acc[ai][0][m][0]), b = i2f(acc[ai][0][m][1]);
                        w = (v4u){pg8::cvt_pk_bf16(a[0], a[1]), pg8::cvt_pk_bf16(a[2], a[3]), pg8::cvt_pk_bf16(b[0], b[1]), pg8::cvt_pk_bf16(b[2], b[3])}; }
                    else w = q1[ai][m];
                    *(LAS v4u*)(Qs + (128 * ai + 64 * wr + 16 * m + fr) * KROW + (32 * wc + 8 * fq) * 2) = w; }
            { const int ch = tid & 15; const pg8::u32x4 c0 = *(const pg8::u32x4*)(cmax2 + h * 256 + p * 128 + ch * 8), c1 = *(const pg8::u32x4*)(cmax2 + h * 256 + p * 128 + ch * 8 + 4);
              float cs[8] = {__uint_as_float(c0.x), __uint_as_float(c0.y), __uint_as_float(c0.z), __uint_as_float(c0.w), __uint_as_float(c1.x), __uint_as_float(c1.y), __uint_as_float(c1.z), __uint_as_float(c1.w)};
#pragma unroll
              for (int i = 0; i < 8; ++i) cs[i] *= (1.f / 127.f);
              for (int c = tid; c < 128 * 16; c += NWAVES * 64) { const int row = c >> 4;
                const v4u kq = *(const GAS v4u*)(keysb + (size_t)((h * 2 + p) * 128 + row) * 128 + ch * 8);
                v4u ko; ko.x = pk2(bflo(kq.x) * cs[0], bfhi(kq.x) * cs[1]); ko.y = pk2(bflo(kq.y) * cs[2], bfhi(kq.y) * cs[3]); ko.z = pk2(bflo(kq.z) * cs[4], bfhi(kq.z) * cs[5]); ko.w = pk2(bflo(kq.w) * cs[6], bfhi(kq.w) * cs[7]);
                *(LAS v4u*)(Ks + row * KROW + ch * 16) = ko; } }
            asm volatile("s_waitcnt vmcnt(0) lgkmcnt(0)" ::: "memory"); __builtin_amdgcn_s_barrier(); asm volatile("" ::: "memory");
            bf16x8 bq[8];
#pragma unroll
            for (int ks = 0; ks < 8; ++ks) bq[ks] = *(const LAS bf16x8*)(Qs + (32 * wid + r32) * KROW + 32 * ks + 16 * hh);
            route_half(bq, Ks, r32, hh, sv[p], iv[p]);
        }
        asm volatile("s_waitcnt lgkmcnt(0)" ::: "memory"); __builtin_amdgcn_s_barrier(); asm volatile("" ::: "memory");
        const int t = u.pm * 256 + 32 * wid + r32;
        route_finish(sv, iv, (LAS unsigned*)(lds + wid * 8192), lane, hh, eidx + (size_t)t * 128 + h * 16 + 8 * hh, gw + (size_t)t * 128 + h * 16 + 8 * hh, rs2[t]);
        asm volatile("s_waitcnt lgkmcnt(0)" ::: "memory"); __builtin_amdgcn_s_barrier(); asm volatile("" ::: "memory");
    }
};
struct OneUnit {
    pg8::Unit u;
    __device__ __forceinline__ bool next(int i, pg8::Unit& o) const { if (i != 0) return false; o = u; return true; }
    __device__ __forceinline__ void a_ready(const pg8::Unit&) const {}
    __device__ __forceinline__ void done(const pg8::Unit&) const {}
};
__device__ __forceinline__ float gelu_tanh(float a) {
    const float z = 0.7978845608028654f * (a + 0.044715f * a * a * a);
    const float e = __expf(2.f * z);
    const float th = 1.f - 2.f / (e + 1.f);
    return 0.5f * a * (1.f + th);
}
typedef float f32x2v __attribute__((ext_vector_type(2)));
__device__ __forceinline__ void fp8x16_to_f32(const v4u w, float* f) {
    f32x2v t;
    t = __builtin_amdgcn_cvt_pk_f32_fp8((int)w.x, false); f[0] = t.x; f[1] = t.y; t = __builtin_amdgcn_cvt_pk_f32_fp8((int)w.x, true); f[2] = t.x; f[3] = t.y;
    t = __builtin_amdgcn_cvt_pk_f32_fp8((int)w.y, false); f[4] = t.x; f[5] = t.y; t = __builtin_amdgcn_cvt_pk_f32_fp8((int)w.y, true); f[6] = t.x; f[7] = t.y;
    t = __builtin_amdgcn_cvt_pk_f32_fp8((int)w.z, false); f[8] = t.x; f[9] = t.y; t = __builtin_amdgcn_cvt_pk_f32_fp8((int)w.z, true); f[10] = t.x; f[11] = t.y;
    t = __builtin_amdgcn_cvt_pk_f32_fp8((int)w.w, false); f[12] = t.x; f[13] = t.y; t = __builtin_amdgcn_cvt_pk_f32_fp8((int)w.w, true); f[14] = t.x; f[15] = t.y;
}
#define DPPF(x, ctrl) __uint_as_float((unsigned)__builtin_amdgcn_mov_dpp((int)__float_as_uint(x), ctrl, 0xf, 0xf, true))
__device__ __forceinline__ void swap16_add(float& a, float b) { auto r = __builtin_amdgcn_permlane16_swap(__float_as_uint(a), __float_as_uint(b), false, false); a = __uint_as_float(r[0]) + __uint_as_float(r[1]); }
__device__ __forceinline__ void swap32_add(float& a, float b) { auto r = __builtin_amdgcn_permlane32_swap(__float_as_uint(a), __float_as_uint(b), false, false); a = __uint_as_float(r[0]) + __uint_as_float(r[1]); }
constexpr int PW_BUF0 = 0, PW_SG = 4096, PW_BUF1 = 8192, PW_E = 16384, PW_WH = 17408, PW_WL = 17920, PW_YP = 18432, PW_IK = 18944, PW_BYTES = 18976;
static_assert(PW_BYTES * NWAVES <= LDSCTL_OFF, "PEER per-wave LDS blocks must stay below the control words");
typedef int v8i_t __attribute__((ext_vector_type(8)));
typedef int v2i_t __attribute__((ext_vector_type(2)));
__device__ __forceinline__ void peer_u_issue(v4u (&uw)[8], const unsigned char* U4, LAS unsigned char* wl, int it, int lane) {
    const int grp = it >> 2, j = it & 3, hw = lane >> 5, li = lane & 31;
#pragma unroll
    for (int q = 0; q < 8; ++q) { const unsigned e = *(const LAS unsigned short*)(wl + PW_E + (j * 128 + grp * 16 + 2 * q + hw) * 2);
        uw[q] = *(const GAS v4u*)(U4 + (e * 512u + 16u * (unsigned)li)); }
}
__device__ __forceinline__ void peer_u_compute(const v4u (&uw)[8], LAS unsigned char* wl, int it, int lane) {
    const int grp = it >> 2, j = it & 3, li = lane & 31;
    const v4u hh = *(LAS v4u*)(wl + j * 1024 + 16 * li), hl = *(LAS v4u*)(wl + j * 1024 + 512 + 16 * li);
    float pa[8];
#pragma unroll
    for (int q = 0; q < 8; ++q) {
        int dh = __builtin_amdgcn_sdot8((int)uw[q].x, (int)hh.x, 0, false); dh = __builtin_amdgcn_sdot8((int)uw[q].y, (int)hh.y, dh, false);
        dh = __builtin_amdgcn_sdot8((int)uw[q].z, (int)hh.z, dh, false); dh = __builtin_amdgcn_sdot8((int)uw[q].w, (int)hh.w, dh, false);
        int dl = __builtin_amdgcn_sdot8((int)uw[q].x, (int)hl.x, 0, false); dl = __builtin_amdgcn_sdot8((int)uw[q].y, (int)hl.y, dl, false);
        dl = __builtin_amdgcn_sdot8((int)uw[q].z, (int)hl.z, dl, false); dl = __builtin_amdgcn_sdot8((int)uw[q].w, (int)hl.w, dl, false);
        pa[q] = (float)(16 * dh + dl); }
    swap16_add(pa[0], pa[4]); swap16_add(pa[1], pa[5]); swap16_add(pa[2], pa[6]); swap16_add(pa[3], pa[7]);
#pragma unroll
    for (int i = 0; i < 4; ++i) { pa[i] += DPPF(pa[i], 0xB1); pa[i] += DPPF(pa[i], 0x4E); pa[i] += DPPF(pa[i], 0x141); pa[i] += DPPF(pa[i], 0x140); }
    if ((lane & 12) == 0) {
        const int q = lane & 3, r = lane >> 4;
        const int idx = j * 128 + grp * 16 + 2 * (q + 4 * (r & 1)) + (r >> 1);
        const f32x2v sg = *(const LAS f32x2v*)(wl + PW_SG + idx * 8);
        const float a = (q == 0 ? pa[0] : q == 1 ? pa[1] : q == 2 ? pa[2] : pa[3]) * sg.x;
        *(LAS float*)(wl + PW_BUF1 + idx * 4) = sg.y * gelu_tanh(a);
    }
}
__device__ __forceinline__ void peer_v_issue(const unsigned char* V8, LAS unsigned char* wl, unsigned lbase, int it, int lane, unsigned c16e, unsigned c16o) {
    const int sl = it >> 3, j = (it >> 1) & 3, hf = it & 1;
    const unsigned char* vbase = V8 + (size_t)sl * (NEXP * 128);
    const unsigned dst = lbase + PW_BUF0 + (it & 1) * 8192;
    unsigned go[8];
#pragma unroll
    for (int q = 0; q < 8; ++q) { const unsigned e = *(const LAS unsigned short*)(wl + PW_E + (j * 128 + 64 * hf + 8 * q + (lane >> 3)) * 2); go[q] = e * 128u + ((q & 1) ? c16o : c16e); }
#pragma unroll
    for (int q = 0; q < 8; ++q) attn_body::glds16s(vbase, go[q], (unsigned)__builtin_amdgcn_readfirstlane((int)(dst + q * 1024)));
}
__device__ __forceinline__ void peer_v_compute(LAS unsigned char* wl, f32x4 (&acc)[8], bf16* yrow0, int it, int lane) {
    const int sl = it >> 3, j = (it >> 1) & 3, hf = it & 1;
    const int m = lane & 15, kg = lane >> 4;
    const LAS unsigned char* wsrc = wl + ((m & 1) ? PW_WL : PW_WH) + j * 128 + 64 * hf + 16 * (kg & 1);
    const v4u a0 = *(const LAS v4u*)wsrc, a1 = *(const LAS v4u*)(wsrc + 32);
    const bool valid = (m < 4) && ((m >> 1) == (kg >> 1));
    v8i_t A;
    A[0] = valid ? (int)a0.x : 0; A[1] = valid ? (int)a0.y : 0; A[2] = valid ? (int)a0.z : 0; A[3] = valid ? (int)a0.w : 0;
    A[4] = valid ? (int)a1.x : 0; A[5] = valid ? (int)a1.y : 0; A[6] = valid ? (int)a1.z : 0; A[7] = valid ? (int)a1.w : 0;
    if (hf == 0) {
#pragma unroll
        for (int T = 0; T < 8; ++T) acc[T] = (f32x4){0.f, 0.f, 0.f, 0.f};
    }
    const LAS unsigned char* bb = wl + PW_BUF0 + (it & 1) * 8192 + (32 * (kg >> 1) + m) * 128 + 8 * (kg & 1);
    const unsigned x16 = (unsigned)(m >> 1) * 16u;
#pragma unroll
    for (int T = 0; T < 8; ++T) {
        const LAS unsigned char* p = bb + ((16u * T) ^ x16);
        const v2i_t b0 = __builtin_amdgcn_ds_read_tr4_b64_v2i32((LAS v2i_t*)p), b1 = __builtin_amdgcn_ds_read_tr4_b64_v2i32((LAS v2i_t*)(p + 2048));
        const v8i_t B = {b0.x, b0.y, b1.x, b1.y, 0, 0, 0, 0};
        acc[T] = __builtin_amdgcn_mfma_scale_f32_16x16x128_f8f6f4(A, B, acc[T], 0, 4, 0, 0x7f7f7f7f, 0, 0x7f7f7f7f);
    }
    if (hf == 1) {
        const float ik = *(const LAS float*)(wl + PW_IK + j * 4);
        LAS unsigned char* yp = lane < 16 ? wl + PW_YP + m * 2 : wl + PW_IK + 16;
        const int ystep = lane < 16 ? 1 : 0;
#pragma unroll
        for (int T = 0; T < 8; ++T) {
            *(LAS unsigned short*)(yp + ystep * (64 * T)) = (unsigned short)f2bf((acc[T][0] + acc[T][1]) * ik);
            *(LAS unsigned short*)(yp + ystep * (64 * T + 32)) = (unsigned short)f2bf((acc[T][2] + acc[T][3]) * ik);
        }
        asm volatile("" ::: "memory");
        const unsigned long long pk = *(const LAS unsigned long long*)(wl + PW_YP + 8 * lane);
        *(GAS unsigned long long*)(yrow0 + (size_t)j * D + 256 * sl + 4 * lane) = pk;
    }
}
__device__ __forceinline__ void p11_peer(Frame& F, float* dst) {
    const int gwv = blockIdx.x * NWAVES + F.wave, NGW = F.G * NWAVES, lane = F.lane;
    LAS unsigned char* wl = F.lds + F.wave * PW_BYTES;
    const unsigned lbase = (unsigned)__builtin_amdgcn_readfirstlane((int)(unsigned)(size_t)wl);
    const unsigned c16e = (unsigned)(((lane & 7) ^ (lane >> 4)) * 16), c16o = (unsigned)(((lane & 7) ^ (4 + (lane >> 4))) * 16);
    const unsigned char* U8 = F.U8; const unsigned char* V8 = F.V8;
    for (int t0 = gwv * 4; t0 < M; t0 += NGW * 4) {
        bf16* yrow0 = F.Y + (size_t)t0 * D;
#pragma unroll
        for (int j = 0; j < 4; ++j) {
            const int t = t0 + j;
            const v4u hq = *(const GAS v4u*)((const unsigned char*)F.H + (size_t)t * D + 16 * lane);
            const float hinv = F.rs2[t];
            const unsigned hw[4] = {hq.x, hq.y, hq.z, hq.w};
            unsigned hh0 = 0u, hh1 = 0u, hl0 = 0u, hl1 = 0u;
#pragma unroll
            for (int i = 0; i < 16; ++i) { const int hv_ = (int)(signed char)((hw[i >> 2] >> (8 * (i & 3))) & 0xffu); const int lo = ((hv_ + 8) & 15) - 8; const int hi = (hv_ - lo) >> 4;
                if (i < 8) { hh0 |= (unsigned)(hi & 15) << (4 * i); hl0 |= (unsigned)(lo & 15) << (4 * i); } else { hh1 |= (unsigned)(hi & 15) << (4 * (i - 8)); hl1 |= (unsigned)(lo & 15) << (4 * (i - 8)); } }
            *(LAS unsigned long long*)(wl + j * 1024 + 8 * lane) = (unsigned long long)hh0 | ((unsigned long long)hh1 << 32);
            *(LAS unsigned long long*)(wl + j * 1024 + 512 + 8 * lane) = (unsigned long long)hl0 | ((unsigned long long)hl1 << 32);
            const int e0 = F.eidx[(size_t)t * 128 + lane], e1 = F.eidx[(size_t)t * 128 + 64 + lane];
            const f32x2v sg0 = (f32x2v){F.su[e0] * hinv, F.gw[(size_t)t * 128 + lane] * F.sv[e0]}, sg1 = (f32x2v){F.su[e1] * hinv, F.gw[(size_t)t * 128 + 64 + lane] * F.sv[e1]};
            int base = 0;
#pragma unroll
            for (int sl = 0; sl < 4; ++sl) {
                const bool m0 = (e0 >> 12) == sl, m1 = (e1 >> 12) == sl;
                const unsigned long long b0 = __ballot(m0), b1 = __ballot(m1);
                const int c0 = __popcll(b0), c1 = __popcll(b1);
                const int p0 = j * 128 + base + __builtin_amdgcn_mbcnt_hi((unsigned)(b0 >> 32), __builtin_amdgcn_mbcnt_lo((unsigned)b0, 0));
                const int p1 = j * 128 + base + c0 + __builtin_amdgcn_mbcnt_hi((unsigned)(b1 >> 32), __builtin_amdgcn_mbcnt_lo((unsigned)b1, 0));
                if (m0) { *(LAS unsigned short*)(wl + PW_E + p0 * 2) = (unsigned short)e0; *(LAS f32x2v*)(wl + PW_SG + p0 * 8) = sg0; }
                if (m1) { *(LAS unsigned short*)(wl + PW_E + p1 * 2) = (unsigned short)e1; *(LAS f32x2v*)(wl + PW_SG + p1 * 8) = sg1; }
                base += c0 + c1;
            }
        }
        asm volatile("" ::: "memory");
        {
            v4u ua[8], ub[8];
            peer_u_issue(ua, U8, wl, 0, lane);
#pragma unroll 1
            for (int it = 0; it < 32; it += 2) {
                peer_u_issue(ub, U8, wl, it + 1, lane);
                __builtin_amdgcn_sched_barrier(0);
                peer_u_compute(ua, wl, it, lane);
                __builtin_amdgcn_sched_barrier(0);
                if (it + 2 < 32) peer_u_issue(ua, U8, wl, it + 2, lane);
                __builtin_amdgcn_sched_barrier(0);
                peer_u_compute(ub, wl, it + 1, lane);
                __builtin_amdgcn_sched_barrier(0);
            }
        }
#pragma unroll
        for (int j = 0; j < 4; ++j) {
            const float w0 = *(const LAS float*)(wl + PW_BUF1 + (j * 128 + lane) * 4), w1 = *(const LAS float*)(wl + PW_BUF1 + (j * 128 + 64 + lane) * 4);
            float mx = fmaxf(fabsf(w0), fabsf(w1));
#pragma unroll
            for (int o = 1; o < 64; o <<= 1) mx = fmaxf(mx, __shfl_xor(mx, o));
            int ex = (int)((__float_as_uint(mx) >> 23) & 0xffu); ex = ex < 30 ? 127 : ex;
            const float sc = __uint_as_float((unsigned)(127 + 7 + 127 - ex) << 23), isc = __uint_as_float((unsigned)(ex - 7) << 23);
            const float s0 = w0 * sc, s1 = w1 * sc;
            const int ph = __builtin_amdgcn_cvt_pk_fp8_f32(s0, s1, 0, false);
            const f32x2v hb = __builtin_amdgcn_cvt_pk_f32_fp8(ph, false);
            const int pl = __builtin_amdgcn_cvt_pk_fp8_f32(s0 - hb.x, s1 - hb.y, 0, false);
            *(LAS unsigned char*)(wl + PW_WH + j * 128 + lane) = (unsigned char)(ph & 0xff); *(LAS unsigned char*)(wl + PW_WH + j * 128 + 64 + lane) = (unsigned char)((ph >> 8) & 0xff);
            *(LAS unsigned char*)(wl + PW_WL + j * 128 + lane) = (unsigned char)(pl & 0xff); *(LAS unsigned char*)(wl + PW_WL + j * 128 + 64 + lane) = (unsigned char)((pl >> 8) & 0xff);
            if (lane == 0) *(LAS float*)(wl + PW_IK + j * 4) = isc;
        }
        v4u x1w[4][2];
#pragma unroll
        for (int j = 0; j < 4; ++j) { const GAS v4u* op = (const GAS v4u*)(F.QP + (size_t)(t0 + j) * D + 16 * lane); x1w[j][0] = op[0]; x1w[j][1] = op[1]; }
        asm volatile("s_waitcnt lgkmcnt(0)" ::: "memory");
        {
            f32x4 acc[8];
            peer_v_issue(V8, wl, lbase, 0, lane, c16e, c16o);
#pragma unroll 1
            for (int it = 0; it < 32; it += 2) {
                peer_v_issue(V8, wl, lbase, it + 1, lane, c16e, c16o);
                asm volatile("s_waitcnt vmcnt(8)" ::: "memory");
                peer_v_compute(wl, acc, yrow0, it, lane);
                asm volatile("s_waitcnt lgkmcnt(0)" ::: "memory");
                if (it + 2 < 32) { peer_v_issue(V8, wl, lbase, it + 2, lane, c16e, c16o); asm volatile("s_waitcnt vmcnt(8)" ::: "memory"); }
                else asm volatile("s_waitcnt vmcnt(0)" ::: "memory");
                peer_v_compute(wl, acc, yrow0, it + 1, lane);
                asm volatile("s_waitcnt lgkmcnt(0)" ::: "memory");
            }
        }
        asm volatile("s_waitcnt vmcnt(0)" ::: "memory");
#pragma unroll
        for (int j = 0; j < 4; ++j) {
            const int t = t0 + j, b = t >> 12;
            float yv[16];
            { const GAS v4u* yp = (const GAS v4u*)(yrow0 + (size_t)j * D + 16 * lane); const v4u y0 = yp[0], y1 = yp[1]; unpack8(y0, yv); unpack8(y1, yv + 8); }
            float ss = 0.f;
#pragma unroll
            for (int i = 0; i < 16; ++i) ss += yv[i] * yv[i];
            const float rstd = rsqrtf(wave_sum(ss) * (1.f / D) + EPS);
            GAS f32x4* dp = (GAS f32x4*)(dst + (size_t)t * D + 16 * lane);
            const GAS f32x4* gp = (const GAS f32x4*)(F.fpost_gain + 16 * lane);
            const GAS f32x4* g2p = (const GAS f32x4*)(F.mod + b * 6144 + 5120 + 16 * lane);
            float x1f[16]; unpack8(x1w[j][0], x1f); unpack8(x1w[j][1], x1f + 8);
#pragma unroll
            for (int i = 0; i < 4; ++i) { const f32x4 x1 = (f32x4){x1f[4 * i], x1f[4 * i + 1], x1f[4 * i + 2], x1f[4 * i + 3]}, g = gp[i], g2 = g2p[i];
                const f32x4 y = (f32x4){yv[4 * i], yv[4 * i + 1], yv[4 * i + 2], yv[4 * i + 3]};
                dp[i] = x1 + g2 * (y * rstd * g); }
        }
    }
}

__device__ __forceinline__ unsigned long long ldp(const Frame& F, int i) {
    volatile LAS unsigned* pt = (volatile LAS unsigned*)(F.lds + LDSCTL_OFF);
    const unsigned lo = pt[2 * i], hi = pt[2 * i + 1];
    return ((unsigned long long)(unsigned)__builtin_amdgcn_readfirstlane((int)hi) << 32) | (unsigned)__builtin_amdgcn_readfirstlane((int)lo);
}
__device__ __forceinline__ void load_frame(Frame& F) {
    F.lane = lane_id_fresh(); F.tid = F.wave * 64 + F.lane;
    F.x = (const float*)ldp(F, 0); F.c = (const float*)ldp(F, 1); F.ada_w = (const float*)ldp(F, 2); F.ada_b = (const float*)ldp(F, 3); F.pre_gain = (const float*)ldp(F, 4); F.post_gain = (const float*)ldp(F, 5);
    F.w_in = (const float*)ldp(F, 6); F.conv_w = (const float*)ldp(F, 7); F.group_gain = (const float*)ldp(F, 8); F.w_out = (const float*)ldp(F, 9); F.fpre_gain = (const float*)ldp(F, 10); F.fpost_gain = (const float*)ldp(F, 11);
    F.wq = (const float*)ldp(F, 12); F.keys = (const float*)ldp(F, 13); F.pu = (const float*)ldp(F, 14); F.pv = (const float*)ldp(F, 15);
    F.out = (float*)ldp(F, 16);
    unsigned char* ws = (unsigned char*)ldp(F, 17);
    F.ctl = (gu32*)(ws + WS_CTL);
    F.mod = (float*)(ws + WS_MOD); F.kmean = (float*)(ws + WS_KMEAN); F.keysb = (bf16*)(ws + WS_KEYS);
    F.WinT = (bf16*)(ws + WS_WIN); F.WoT = (bf16*)(ws + WS_WO); F.WqT = (bf16*)(ws + WS_WQ); F.eidx = (int*)(ws + WS_EIDX); F.gw = (float*)(ws + WS_G);
    F.U8 = ws + WS_U; F.V8 = ws + WS_V; F.su = (float*)(ws + WS_SU); F.sv = (float*)(ws + WS_SV); F.H = (bf16*)(ws + WS_H);
    F.P = (bf16*)(ws + WS_P); F.QP = (bf16*)(ws + WS_QP); F.O = (bf16*)(ws + WS_O); F.Y = (bf16*)(ws + WS_Y); F.scratch = (float*)(ws + WS_O); F.Win8 = ws + WS_WIN8; F.rs = (float*)(ws + WS_RS); F.Wq8 = ws + WS_WQ8; F.rs2 = (float*)(ws + WS_RS2); F.Wo8 = ws + WS_WO8;
}
struct Args { const float* in[16]; float* out; unsigned char* ws; int ph_lo, ph_hi; };
constexpr int NPHASE = 12;
template <unsigned PM> __global__ void __launch_bounds__(NWAVES * 64, 2) fwd_kernel(Args args) {
    extern __shared__ __attribute__((aligned(16))) unsigned char lds[];
    Frame F;
    F.lds = (LAS unsigned char*)lds;
    F.MISC = (volatile LAS unsigned*)(F.lds + MISC_OFF);
    F.tid = threadIdx.x; F.lane = F.tid & 63; F.wave = __builtin_amdgcn_readfirstlane(F.tid >> 6);
    F.G = gridDim.x;
    for (int u = F.tid; u < (LDS_BYTES - LDSCTL_OFF) / 4; u += NWAVES * 64) ((LAS unsigned*)(F.lds + LDSCTL_OFF))[u] = 0u;
    __syncthreads();
    if (F.tid == 0) { LAS unsigned long long* pt = (LAS unsigned long long*)(F.lds + LDSCTL_OFF);
#pragma unroll
        for (int i = 0; i < 16; ++i) pt[i] = (unsigned long long)args.in[i];
        pt[16] = (unsigned long long)args.out; pt[17] = (unsigned long long)args.ws; }
    __syncthreads();
    load_frame(F);
    const int lo = args.ph_lo, hi = args.ph_hi;
    const bool multi = (hi - lo) > 1;
    XcdBarrier bar; bar.bar = (unsigned*)(F.ctl + CW_BAR); bar.x = 0; bar.st = nullptr;
    if (multi) bar = xcd_barrier_post((unsigned*)(F.ctl + CW_BAR), F.MISC + 8);
#define IN(k) ((((PM) >> (k)) & 1u) && lo <= (k) && (k) < hi)
#define BOTH(k) (IN(k) && IN((k) + 1))
#ifndef SEAMREP
#define SEAMREP 1
#endif
#define SEAM(k) do { if (BOTH(k)) { for (int sr_ = 0; sr_ < SEAMREP; ++sr_) xcd_barrier(bar); } } while (0)
#ifndef REPMASK
#define REPMASK 0x000u
#endif
#define REPS(k) (1 + (int)(((REPMASK) >> (k)) & 1u))
    if (IN(0)) { load_frame(F); for (int r = 0; r < REPS(0); ++r) { p0_prep(F); __syncthreads(); } SEAM(0); }
    if (IN(1)) { load_frame(F); for (int r = 0; r < REPS(1); ++r) p1_hnorm(F); SEAM(1); }
    if (IN(2)) { load_frame(F);
        pg8::Gemm g{F.H, (const bf16*)F.Win8, M, NIN, D / 2}; pg8::StaticOrder So; So.init(M, NIN, F.G, (int)blockIdx.x);
        pg8::EpiBf16S<true> E{F.P, NIN, 6, 8, C2, F.kmean, 8, 10, F.rs, (const unsigned*)(F.ctl + CW_CMAX)};
        for (int r = 0; r < REPS(2); ++r) pg8::gemm_phase<pg8::EpiBf16S<true>, pg8::StaticOrder, true, true, false, true>(F.lds, g, So, E);
        if (IN(2) && IN(5)) { for (int sr_ = 0; sr_ < SEAMREP; ++sr_) xcd_barrier(bar); }
    }
    const bool stream_first = (((int)blockIdx.x >> 3) & 1) == 0;
    if (IN(5) && stream_first) { load_frame(F); p0_tables(F); }
    if (IN(6) && stream_first) { load_frame(F); p6_conv(F); }
    if (IN(5)) { load_frame(F);
        const attn_body::AttnTensors AT{(const attn_body::bf16*)(F.P + 1536), (const attn_body::bf16*)(F.P + 2048), (const attn_body::bf16*)(F.P + 2560), (attn_body::bf16*)((unsigned char*)F.Y + 512), F.kmean, F.group_gain + 512};
        const attn_body::StaticOrder So((int)F.G, (int)blockIdx.x);
        for (int r = 0; r < REPS(5); ++r) attn_body::attn_phase<attn_body::StaticOrder>((char*)lds, AT, So);
    }
    if (IN(6) && !stream_first) { load_frame(F); p6_conv(F); }
    if (IN(5) && !stream_first) { load_frame(F); p0_tables(F); }
    if (IN(6)) { SEAM(6); }
    if (IN(7)) { load_frame(F);
        pg8::Gemm g{F.Y, (const bf16*)F.Wo8, M, D, D / 2}; pg8::StaticOrder So; So.init(M, D, F.G, (int)blockIdx.x);
        pg8::EpiBf16S<true> E{F.O, D, 0, 0, 1.f, nullptr, 0, 0, nullptr, (const unsigned*)(F.ctl + CW_CMAX3)};
        for (int r = 0; r < REPS(7); ++r) pg8::gemm_phase<pg8::EpiBf16S<true>, pg8::StaticOrder, true, true, false, true>(F.lds, g, So, E);
        SEAM(7);
    }
    if (IN(8)) { load_frame(F); for (int r = 0; r < REPS(8); ++r) p8_resid(F); SEAM(8); }
    if (IN(9)) { load_frame(F);
        pg8::Gemm g{F.H, (const bf16*)F.Wq8, M, NQ, D / 2}; pg8::StaticOrder So; So.init(M, NQ, F.G, (int)blockIdx.x);
        EpiRoute E{F.keysb, F.eidx, F.gw, (const unsigned*)(F.ctl + CW_CMAX2), F.rs2};
        for (int r = 0; r < REPS(9); ++r)
            for (int i = 0; ; ++i) { OneUnit S1; if (!So.next(i, S1.u)) break; pg8::gemm_phase<EpiRoute, OneUnit, false, true, false, true>(F.lds, g, S1, E); }
        if (IN(9) && IN(11)) { for (int sr_ = 0; sr_ < SEAMREP; ++sr_) xcd_barrier(bar); }
    }
    if (IN(11)) { load_frame(F); if (REPS(11) > 1) p11_peer(F, F.scratch); p11_peer(F, F.out); }
#undef IN
#undef BOTH
#undef SEAM
}

#ifndef PMASK
#define PMASK 0xfffu
#endif
#ifndef N_LAUNCH_MODE
#define N_LAUNCH_MODE 1
#endif
template <unsigned PM> static bool set_lds() { return hipFuncSetAttribute((const void*)fwd_kernel<PM>, hipFuncAttributeMaxDynamicSharedMemorySize, LDS_BYTES) == hipSuccess; }
template <unsigned PM> static void launch1(int grid, hipStream_t stream, Args a) { hipLaunchKernelGGL(fwd_kernel<PM>, dim3(grid), dim3(NWAVES * 64), LDS_BYTES, stream, a); }
extern "C" void kernel_launch(void* const* d_in, const int* in_sizes, int n_in, void* d_out, int out_size, void* d_ws, size_t ws_size, hipStream_t stream) {
    static int grid = 0;
    if (grid == 0) {
        if (n_in != 16 || out_size != M * D || ws_size < WS_END) { fprintf(stderr, "kernel_launch: unexpected shapes n_in %d out %d ws %zu\n", n_in, out_size, ws_size); grid = -1; return; }
        int dev = 0, cus = 0;
        if (hipGetDevice(&dev) != hipSuccess || hipDeviceGetAttribute(&cus, hipDeviceAttributeMultiprocessorCount, dev) != hipSuccess) { grid = -1; return; }
        bool ok = true;
#if N_LAUNCH_MODE == 1
        ok = set_lds<PMASK>();
#elif N_LAUNCH_MODE == 3
        ok = set_lds<0x3ffu>() && set_lds<0x400u>() && set_lds<0x800u>();
#else
        ok = set_lds<1u>() && set_lds<2u>() && set_lds<4u>() && set_lds<8u>() && set_lds<16u>() && set_lds<32u>() && set_lds<64u>() && set_lds<128u>() && set_lds<256u>() && set_lds<512u>() && set_lds<1024u>() && set_lds<2048u>();
#endif
        if (!ok) { fprintf(stderr, "kernel_launch: hipFuncSetAttribute failed\n"); grid = -1; return; }
        grid = cus;
    }
    if (grid < 0) return;
    (void)hipMemsetAsync((char*)d_ws + WS_CTL, 0, CTL_ZERO_BYTES, stream);
    Args a{};
    for (int i = 0; i < 16; ++i) a.in[i] = (const float*)d_in[i];
    a.out = (float*)d_out; a.ws = (unsigned char*)d_ws;
#if N_LAUNCH_MODE == 1
    a.ph_lo = 0; a.ph_hi = NPHASE; launch1<PMASK>(grid, stream, a);
#elif N_LAUNCH_MODE == 3
    a.ph_lo = 0; a.ph_hi = 10; launch1<0x3ffu>(grid, stream, a);
    a.ph_lo = 10; a.ph_hi = 11; launch1<0x400u>(grid, stream, a);
    a.ph_lo = 11; a.ph_hi = 12; launch1<0x800u>(grid, stream, a);
#else
#define L1(p) do { a.ph_lo = (p); a.ph_hi = (p) + 1; launch1<(1u << (p))>(grid, stream, a); } while (0)
    L1(0); L1(1); L1(2); L1(3); L1(4); L1(5); L1(6); L1(7); L1(8); L1(9); L1(10); L1(11);
#undef L1
#endif
}
```

```cpp
#include <hip/hip_runtime.h>
#include <cstdio>
#include <cstdint>
#ifndef WT_STORES
#define WT_STORES 1
#endif
typedef unsigned wt_v4u __attribute__((ext_vector_type(4)));
__device__ __forceinline__ int lane_id_fresh() { int l; asm volatile("v_mbcnt_lo_u32_b32 %0, -1, 0\n\tv_mbcnt_hi_u32_b32 %0, -1, %0" : "=v"(l)); return l; }
__device__ __forceinline__ void st16_wt(void* p, wt_v4u v) {
#if WT_STORES
    asm volatile("global_store_dwordx4 %0, %1, off sc1\n\ts_nop 1" :: "v"(p), "v"(v) : "memory");
#else
    *(wt_v4u*)p = v;
#endif
}
__device__ __forceinline__ void st4_wt(void* p, unsigned v) {
#if WT_STORES
    asm volatile("global_store_dword %0, %1, off sc1\n\ts_nop 1" :: "v"(p), "v"(v) : "memory");
#else
    *(unsigned*)p = v;
#endif
}
__device__ __forceinline__ void st8_wt(void* p, unsigned long long v) {
#if WT_STORES
    asm volatile("global_store_dwordx2 %0, %1, off sc1\n\ts_nop 1" :: "v"(p), "v"(v) : "memory");
#else
    *(unsigned long long*)p = v;
#endif
}
namespace pg8 {
#define PG8_LAS __attribute__((address_space(3)))
typedef unsigned short bf16_t;
typedef short bf16x8 __attribute__((ext_vector_type(8)));
typedef float f32x4 __attribute__((ext_vector_type(4)));
typedef unsigned u32x4 __attribute__((ext_vector_type(4)));
typedef int i32x4 __attribute__((ext_vector_type(4)));
typedef int i32x8 __attribute__((ext_vector_type(8)));
constexpr int BM = 256, BK = 64, HALF = 128, HTB = HALF * BK * 2  , STAGE_BYTES = 8 * HTB, NXCD = 8, WGM = 8;

__host__ __device__ __forceinline__ int lds_byte(int r, int c) { const int st = (r >> 4) * 2 + (c >> 5), rr = r & 15, cc = c & 31, ob = rr * 64 + cc * 2; return st * 1024 + (ob ^ (((ob >> 9) & 1) << 5)); }
__host__ __device__ __forceinline__ void stage_rc(int b, int& R, int& C) { const int st = b / 1024, sb = b % 1024, swz = sb ^ (((sb >> 9) & 1) << 5); R = (st >> 1) * 16 + swz / 64; C = (st & 1) * 32 + (swz % 64) / 2; }
__host__ __device__ __forceinline__ int perm32(int rho) { const int n = rho >> 4, i = rho & 15; return 8 * (i >> 2) + 4 * n + (i & 3); }

struct Unit { int pm, pn; };
struct Gemm { const bf16_t* A; const bf16_t* Bt; int M, N, K; };

struct StaticOrder {
    int nM, nN, nwg, G, c;
    __host__ __device__ void init(int M, int N, int G_, int c_) { nM = M / BM; nN = N / BM; nwg = nM * nN; G = G_; c = c_; }
    __host__ __device__ bool next(int i, Unit& u) const {
        const long L = (long)i * G + c; if (L >= nwg) return false;
        int wgid = (int)L; { const int q = nwg / NXCD, r = nwg % NXCD, xcd = wgid % NXCD, off = wgid / NXCD; wgid = (xcd < r ? xcd * (q + 1) : r * (q + 1) + (xcd - r) * q) + off; }
        const int nig = WGM * nN, gid = wgid / nig, fm = gid * WGM, gsz = (nM - fm) < WGM ? (nM - fm) : WGM;
        u.pm = fm + ((wgid % nig) % gsz); u.pn = (wgid % nig) / gsz; return true;
    }
    __device__ __forceinline__ void a_ready(const Unit&) const {}
    __device__ __forceinline__ void done(const Unit&) const {}
};


__device__ __forceinline__ unsigned cvt_pk_bf16(float lo, float hi) { unsigned r; asm volatile("v_cvt_pk_bf16_f32 %0, %1, %2" : "=v"(r) : "v"(lo), "v"(hi)); return r; }
template <bool ACC_I32> struct EpiBf16S {
    static constexpr bool PERM = true, AFTER_DRAIN = false;
    bf16_t* O; int ldc; int sc_lo, sc_hi; float scv; float* ksum; int ks_lo, ks_hi; const float* rs; const unsigned* cmax;
    __device__ __forceinline__ void operator()(const f32x4 (&acc)[2][2][4][2], const Unit& u, int wr, int wc, int fr_, int fq_) const {
        (void)fr_; (void)fq_;
        const int lane_ = lane_id_fresh(); const int fr = lane_ & 15, fq = lane_ >> 4;
        const int row0 = u.pm * BM + wr * 64 + fr; const int colt = u.pn * BM;
        const float sc = ((u.pn >= sc_lo && u.pn < sc_hi) ? scv : 1.f) * (ACC_I32 ? (1.f / 127.f) : (1.f / 224.f));
        const int col0 = colt + wc * 32 + 8 * fq;
        float rsv[2][4];
#pragma unroll
        for (int ai = 0; ai < 2; ++ai)
#pragma unroll
            for (int m = 0; m < 4; ++m) rsv[ai][m] = rs != nullptr ? rs[row0 + ai * HALF + m * 16] : 1.f;
        const bool do_ks = ksum != nullptr && u.pn >= ks_lo && u.pn < ks_hi;
#pragma unroll
        for (int bj = 0; bj < 2; ++bj) {
            const u32x4 cb0 = *(const u32x4*)(cmax + col0 + bj * HALF), cb1 = *(const u32x4*)(cmax + col0 + bj * HALF + 4);
            const f32x4 cs0 = (f32x4){__uint_as_float(cb0.x), __uint_as_float(cb0.y), __uint_as_float(cb0.z), __uint_as_float(cb0.w)} * sc;
            const f32x4 cs1 = (f32x4){__uint_as_float(cb1.x), __uint_as_float(cb1.y), __uint_as_float(cb1.z), __uint_as_float(cb1.w)} * sc;
            f32x4 sum0 = {0.f, 0.f, 0.f, 0.f}, sum1 = sum0;
#pragma unroll
            for (int ai = 0; ai < 2; ++ai)
#pragma unroll
                for (int m = 0; m < 4; ++m) { f32x4 a0 = acc[ai][bj][m][0], a1 = acc[ai][bj][m][1];
                    if constexpr (ACC_I32) { const i32x4 i0 = __builtin_bit_cast(i32x4, a0), i1 = __builtin_bit_cast(i32x4, a1);
                        a0 = (f32x4){(float)i0[0], (float)i0[1], (float)i0[2], (float)i0[3]}; a1 = (f32x4){(float)i1[0], (float)i1[1], (float)i1[2], (float)i1[3]}; }
                    const f32x4 v0 = a0 * rsv[ai][m] * cs0, v1 = a1 * rsv[ai][m] * cs1;
                    sum0 += v0; sum1 += v1;
                    u32x4 w; w.x = cvt_pk_bf16(v0[0], v0[1]); w.y = cvt_pk_bf16(v0[2], v0[3]); w.z = cvt_pk_bf16(v1[0], v1[1]); w.w = cvt_pk_bf16(v1[2], v1[3]);
                    st16_wt(O + (size_t)(row0 + ai * HALF + m * 16) * ldc + col0 + bj * HALF, w); }
            if (do_ks) {
                float* kd = ksum + (size_t)u.pm * ((ks_hi - ks_lo) * BM) + (u.pn - ks_lo) * BM + wc * 32 + 8 * fq + bj * HALF;
#pragma unroll
                for (int n = 0; n < 2; ++n)
#pragma unroll
                    for (int i = 0; i < 4; ++i) {
                        float v = n ? sum1[i] : sum0[i];
                        v += __uint_as_float((unsigned)__builtin_amdgcn_mov_dpp((int)__float_as_uint(v), 0xB1, 0xf, 0xf, true));
                        v += __uint_as_float((unsigned)__builtin_amdgcn_mov_dpp((int)__float_as_uint(v), 0x4E, 0xf, 0xf, true));
                        v += __uint_as_float((unsigned)__builtin_amdgcn_mov_dpp((int)__float_as_uint(v), 0x141, 0xf, 0xf, true));
                        v += __uint_as_float((unsigned)__builtin_amdgcn_mov_dpp((int)__float_as_uint(v), 0x140, 0xf, 0xf, true));
                        if (fr == 0) atomicAdd(kd + 4 * n + i, v);
                    }
            }
        }
    }
};
struct EpiBf16 {
    static constexpr bool PERM = true, AFTER_DRAIN = false;
    bf16_t* O; int ldc; int sc_lo, sc_hi; float scv; float* ksum; int ks_lo, ks_hi;
    __device__ __forceinline__ void operator()(const f32x4 (&acc)[2][2][4][2], const Unit& u, int wr, int wc, int fr, int fq) const {
        const int row0 = u.pm * BM + wr * 64 + fr; const int colt = u.pn * BM;
        const float sc = (u.pn >= sc_lo && u.pn < sc_hi) ? scv : 1.f;
        const int col0 = colt + wc * 32 + 8 * fq;
#pragma unroll
        for (int ai = 0; ai < 2; ++ai)
#pragma unroll
            for (int m = 0; m < 4; ++m) { bf16_t* rowp = O + (size_t)(row0 + ai * HALF + m * 16) * ldc + col0;
#pragma unroll
                for (int bj = 0; bj < 2; ++bj) { f32x4 v0 = acc[ai][bj][m][0] * sc, v1 = acc[ai][bj][m][1] * sc;
                    u32x4 w; w.x = cvt_pk_bf16(v0[0], v0[1]); w.y = cvt_pk_bf16(v0[2], v0[3]); w.z = cvt_pk_bf16(v1[0], v1[1]); w.w = cvt_pk_bf16(v1[2], v1[3]);
                    st16_wt(rowp + bj * HALF, w); } }
        if (ksum != nullptr && u.pn >= ks_lo && u.pn < ks_hi) {
            float* kd = ksum + (size_t)u.pm * ((ks_hi - ks_lo) * BM) + (u.pn - ks_lo) * BM + wc * 32 + 8 * fq;
#pragma unroll
            for (int bj = 0; bj < 2; ++bj)
#pragma unroll
                for (int n = 0; n < 2; ++n) {
                    f32x4 cs = acc[0][bj][0][n];
#pragma unroll
                    for (int m = 1; m < 4; ++m) cs += acc[0][bj][m][n];
#pragma unroll
                    for (int m = 0; m < 4; ++m) cs += acc[1][bj][m][n];
#pragma unroll
                    for (int i = 0; i < 4; ++i) {
                        float v = cs[i];
                        v += __uint_as_float((unsigned)__builtin_amdgcn_mov_dpp((int)__float_as_uint(v), 0xB1, 0xf, 0xf, true));
                        v += __uint_as_float((unsigned)__builtin_amdgcn_mov_dpp((int)__float_as_uint(v), 0x4E, 0xf, 0xf, true));
                        v += __uint_as_float((unsigned)__builtin_amdgcn_mov_dpp((int)__float_as_uint(v), 0x141, 0xf, 0xf, true));
                        v += __uint_as_float((unsigned)__builtin_amdgcn_mov_dpp((int)__float_as_uint(v), 0x140, 0xf, 0xf, true));
                        if (fr == 0) atomicAdd(kd + bj * HALF + 4 * n + i, v);
                    }
                }
        }
    }
};

template <int OFF> __device__ __forceinline__ void dma16s(const void* sbase, unsigned voff, unsigned lds_base) { unsigned keep;
    asm volatile("s_mov_b32 %0, m0\n\ts_add_u32 m0, %3, %4\n\ts_nop 0\n\tglobal_load_lds_dwordx4 %1, %2\n\ts_mov_b32 m0, %0" : "=&s"(keep) : "v"(voff), "s"(sbase), "s"(lds_base), "i"(OFF) : "memory", "scc"); }
__device__ __forceinline__ const char* uni_ptr(const char* p) {
    const unsigned long long v = (unsigned long long)p;
    return (const char*)(((unsigned long long)(unsigned)__builtin_amdgcn_readfirstlane((int)(unsigned)(v >> 32)) << 32) | (unsigned)__builtin_amdgcn_readfirstlane((int)(unsigned)v));
}
template <class Epi, class Sched, bool ALIGN_EPI = false, bool SP2 = false, bool FP8 = false, bool I8 = false>
__device__ __forceinline__ void gemm_phase(PG8_LAS unsigned char* lds, const Gemm g, const Sched& S, const Epi& E) {
    int tid_ = threadIdx.x; asm volatile("" : "+v"(tid_));
    const int tid = tid_, wid = __builtin_amdgcn_readfirstlane(tid >> 6), lane = tid & 63, wr = wid >> 2, wc = wid & 3, fr = lane & 15, fq = lane >> 4;
    const int K = g.K, nt = K / BK;
    unsigned voffA[2], voffB[2];
#pragma unroll
    for (int i = 0; i < 2; ++i) { int R, C; stage_rc(tid * 16 + i * 8192, R, C); const int Rb = Epi::PERM ? ((R & ~31) + perm32(R & 31)) : R;
        voffA[i] = (unsigned)(R * K + C) * 2u; voffB[i] = (unsigned)(Rb * K + C) * 2u; }
    const size_t qstep = (size_t)64 * K * 2;
    const size_t kstep = (size_t)(BK * 2);
    const size_t hstep = (size_t)HALF * K * 2;
    const size_t tstep = 2 * hstep;
    const unsigned ldsn = (unsigned)(size_t)lds;
    const unsigned ldsw = (unsigned)wid * 1024u;
    const unsigned ldsb = (unsigned)__builtin_amdgcn_readfirstlane((int)(ldsn + ldsw));
    const int aoff = lds_byte(wr * 64 + fr, fq * 8), boff = lds_byte(wc * 32 + fr, fq * 8);
    unsigned ldsAn = ldsn + (unsigned)aoff, ldsBn = ldsn + (unsigned)(4 * HTB) + (unsigned)boff; asm volatile("" : "+v"(ldsAn), "+v"(ldsBn));
    PG8_LAS unsigned char* const ldsA = (PG8_LAS unsigned char*)(size_t)ldsAn; PG8_LAS unsigned char* const ldsB = (PG8_LAS unsigned char*)(size_t)ldsBn;
#define PG8_SA(b, h) (((b) * 2 + (h)) * HTB)
#define PG8_SB(b, h) ((4 + (b) * 2 + (h)) * HTB)
#define PG8_STAGE(bufoff, gbase, voff) do { if constexpr (FP8 || I8) { const char* gb_ = uni_ptr((const char*)(gbase)); dma16s<(bufoff)>(gb_, (voff)[0], ldsb); dma16s<(bufoff) + 8192>(uni_ptr(gb_ + qstep), (voff)[0], ldsb); }        \
    else { _Pragma("unroll") for (int _i = 0; _i < 2; ++_i) \
        __builtin_amdgcn_global_load_lds((const unsigned*)((const char*)(gbase) + (voff)[_i]), (PG8_LAS unsigned*)(lds + (bufoff) + ldsw + _i * 8192), 16, 0, 0); } } while (0)
#define PG8_LDA(dst, b, h) do { _Pragma("unroll") for (int m = 0; m < 4; ++m) _Pragma("unroll") for (int k = 0; k < 2; ++k) dst[m][k] = *(const PG8_LAS bf16x8*)(lds + PG8_SA(b, h) + aoff + m * 2048 + k * 1024); } while (0)
#define PG8_LDB(dst, b, h) do { _Pragma("unroll") for (int n = 0; n < 2; ++n) _Pragma("unroll") for (int k = 0; k < 2; ++k) dst[n][k] = *(const PG8_LAS bf16x8*)(lds + PG8_SB(b, h) + boff + n * 2048 + k * 1024); } while (0)
#define PG8_LDA8(dst, b, h) do { _Pragma("unroll") for (int m = 0; m < 4; ++m) dst[m] = __builtin_shufflevector(*(const PG8_LAS i32x4*)(ldsA + PG8_SA(b, h) + m * 2048), *(const PG8_LAS i32x4*)(ldsA + PG8_SA(b, h) + m * 2048 + 1024), 0, 1, 2, 3, 4, 5, 6, 7); } while (0)
#define PG8_LDB8(dst, b, h) do { _Pragma("unroll") for (int n = 0; n < 2; ++n) dst[n] = __builtin_shufflevector(*(const PG8_LAS i32x4*)(ldsB + (PG8_SB(b, h) - 4 * HTB) + n * 2048), *(const PG8_LAS i32x4*)(ldsB + (PG8_SB(b, h) - 4 * HTB) + n * 2048 + 1024), 0, 1, 2, 3, 4, 5, 6, 7); } while (0)
#define PG8_MMA8(ai, bj, A8, B8) do { __builtin_amdgcn_s_setprio(1); _Pragma("unroll") for (int m = 0; m < 4; ++m) _Pragma("unroll") for (int n = 0; n < 2; ++n) \
        acc[ai][bj][m][n] = __builtin_amdgcn_mfma_scale_f32_16x16x128_f8f6f4(B8[n], A8[m], acc[ai][bj][m][n], 0, 0, 0, 0, 0, 0); __builtin_amdgcn_s_setprio(0); } while (0)
#define PG8_MMA(ai, bj, At, Bt) do { __builtin_amdgcn_s_setprio(1); _Pragma("unroll") for (int m = 0; m < 4; ++m) _Pragma("unroll") for (int n = 0; n < 2; ++n) _Pragma("unroll") for (int k = 0; k < 2; ++k) { \
        if constexpr (I8) acc[ai][bj][m][n] = __builtin_bit_cast(f32x4, __builtin_amdgcn_mfma_i32_16x16x64_i8(__builtin_bit_cast(i32x4, Bt[n][k]), __builtin_bit_cast(i32x4, At[m][k]), __builtin_bit_cast(i32x4, acc[ai][bj][m][n]), 0, 0, 0)); \
        else acc[ai][bj][m][n] = __builtin_amdgcn_mfma_f32_16x16x32_bf16(Bt[n][k], At[m][k], acc[ai][bj][m][n], 0, 0, 0); } __builtin_amdgcn_s_setprio(0); } while (0)
#define PG8_WAIT_V(n) asm volatile("s_waitcnt vmcnt(" #n ")" ::: "memory")
#define PG8_WAIT_L(n) asm volatile("s_waitcnt lgkmcnt(" #n ")" ::: "memory")
#define PG8_BAR __builtin_amdgcn_s_barrier()
#define PG8_SCHED __builtin_amdgcn_sched_barrier(0)
    Unit cur, nxt; int ui = 0;
    if (!S.next(0, cur)) return;
    f32x4 acc[2][2][4][2];
#pragma unroll
    for (int a = 0; a < 2; ++a)
#pragma unroll
        for (int b = 0; b < 2; ++b)
#pragma unroll
            for (int m = 0; m < 4; ++m)
#pragma unroll
                for (int n = 0; n < 2; ++n) acc[a][b][m][n] = (f32x4){0.f, 0.f, 0.f, 0.f};
    bf16x8 At[4][2], B0[2][2], B1[2][2];
    i32x8 A8[4], B08[2], B18[2];
    const char* cA = (const char*)g.A + (size_t)cur.pm * tstep; const char* cB = (const char*)g.Bt + (size_t)cur.pn * tstep;
    if constexpr (FP8 || I8) { cA = uni_ptr(cA); cB = uni_ptr(cB); }
    S.a_ready(cur);
    if constexpr (SP2) {
        PG8_STAGE(PG8_SB(0, 0), cB, voffB); PG8_STAGE(PG8_SB(0, 1), cB + hstep, voffB); PG8_STAGE(PG8_SA(0, 0), cA, voffA); PG8_STAGE(PG8_SA(0, 1), cA + hstep, voffA);
        if (wr == 1) PG8_BAR;
        PG8_WAIT_V(2); PG8_BAR;
        PG8_STAGE(PG8_SB(1, 0), cB + kstep, voffB); PG8_STAGE(PG8_SA(1, 0), cA + kstep, voffA); PG8_STAGE(PG8_SB(1, 1), cB + hstep + kstep, voffB);
        PG8_WAIT_V(6); PG8_BAR;
    } else {
        PG8_STAGE(PG8_SB(0, 0), cB, voffB); PG8_STAGE(PG8_SA(0, 0), cA, voffA); PG8_STAGE(PG8_SB(0, 1), cB + hstep, voffB); PG8_STAGE(PG8_SA(0, 1), cA + hstep, voffA);
        if (wr == 1) PG8_BAR;
        PG8_WAIT_V(4); PG8_BAR;
        PG8_STAGE(PG8_SB(1, 0), cB + kstep, voffB); PG8_STAGE(PG8_SA(1, 0), cA + kstep, voffA); PG8_STAGE(PG8_SB(1, 1), cB + hstep + kstep, voffB);
        PG8_WAIT_V(6); PG8_BAR;
    }
    for (;;) {
        const bool has_next = S.next(ui + 1, nxt);
        const char* nA = has_next ? (const char*)g.A + (size_t)nxt.pm * tstep : cA; const char* nB = has_next ? (const char*)g.Bt + (size_t)nxt.pn * tstep : cB;
        if constexpr (FP8 || I8) { nA = uni_ptr(nA); nB = uni_ptr(nB); }
        for (int t = 0; t < nt; t += 2) {
            const bool last = (t == nt - 2);
            if constexpr (FP8 || I8) asm volatile("" : "+v"(voffA[0]), "+v"(voffB[0]));
            const char* a1 = cA + (size_t)(t + 1) * kstep;
            const char* a2 = last ? nA : cA + (size_t)(t + 2) * kstep; const char* b2 = last ? nB : cB + (size_t)(t + 2) * kstep;
            const char* a3 = a2 + kstep; const char* b3 = b2 + kstep;
            if (last && has_next) S.a_ready(nxt);
            if constexpr (SP2 && FP8) {
            PG8_LDB8(B08, 0, 0); PG8_LDB8(B18, 0, 1); PG8_SCHED; PG8_LDA8(A8, 0, 0); PG8_STAGE(PG8_SA(1, 1), a1 + hstep, voffA);
            PG8_WAIT_V(8); PG8_WAIT_L(0); PG8_BAR; PG8_MMA8(0, 0, A8, B08); PG8_MMA8(0, 1, A8, B18); PG8_BAR; PG8_SCHED;
            PG8_LDA8(A8, 0, 1); PG8_STAGE(PG8_SB(0, 0), b2, voffB); PG8_STAGE(PG8_SB(0, 1), b2 + hstep, voffB); PG8_STAGE(PG8_SA(0, 0), a2, voffA);
            PG8_WAIT_V(8); PG8_WAIT_L(0); PG8_BAR; PG8_MMA8(1, 0, A8, B08); PG8_MMA8(1, 1, A8, B18); PG8_BAR; PG8_SCHED;
            PG8_LDB8(B08, 1, 0); PG8_LDB8(B18, 1, 1); PG8_SCHED; PG8_LDA8(A8, 1, 0); PG8_STAGE(PG8_SA(0, 1), a2 + hstep, voffA);
            PG8_WAIT_V(8); PG8_WAIT_L(0); PG8_BAR; PG8_MMA8(0, 0, A8, B08); PG8_MMA8(0, 1, A8, B18); PG8_BAR; PG8_SCHED;
            PG8_LDA8(A8, 1, 1); PG8_STAGE(PG8_SB(1, 0), b3, voffB); PG8_STAGE(PG8_SB(1, 1), b3 + hstep, voffB); PG8_STAGE(PG8_SA(1, 0), a3, voffA);
            PG8_WAIT_V(8); PG8_WAIT_L(0); PG8_BAR; PG8_MMA8(1, 0, A8, B08); PG8_MMA8(1, 1, A8, B18); PG8_BAR; PG8_SCHED;
            } else if constexpr (SP2) {
            PG8_LDB(B0, 0, 0); PG8_LDB(B1, 0, 1); PG8_SCHED; PG8_LDA(At, 0, 0); PG8_STAGE(PG8_SA(1, 1), a1 + hstep, voffA);
            PG8_WAIT_V(8); PG8_WAIT_L(0); PG8_BAR; PG8_MMA(0, 0, At, B0); PG8_MMA(0, 1, At, B1); PG8_BAR; PG8_SCHED;
            PG8_LDA(At, 0, 1); PG8_STAGE(PG8_SB(0, 0), b2, voffB); PG8_STAGE(PG8_SB(0, 1), b2 + hstep, voffB); PG8_STAGE(PG8_SA(0, 0), a2, voffA);
            PG8_WAIT_V(8); PG8_WAIT_L(0); PG8_BAR; PG8_MMA(1, 0, At, B0); PG8_MMA(1, 1, At, B1); PG8_BAR; PG8_SCHED;
            PG8_LDB(B0, 1, 0); PG8_LDB(B1, 1, 1); PG8_SCHED; PG8_LDA(At, 1, 0); PG8_STAGE(PG8_SA(0, 1), a2 + hstep, voffA);
            PG8_WAIT_V(8); PG8_WAIT_L(0); PG8_BAR; PG8_MMA(0, 0, At, B0); PG8_MMA(0, 1, At, B1); PG8_BAR; PG8_SCHED;
            PG8_LDA(At, 1, 1); PG8_STAGE(PG8_SB(1, 0), b3, voffB); PG8_STAGE(PG8_SB(1, 1), b3 + hstep, voffB); PG8_STAGE(PG8_SA(1, 0), a3, voffA);
            PG8_WAIT_V(8); PG8_WAIT_L(0); PG8_BAR; PG8_MMA(1, 0, At, B0); PG8_MMA(1, 1, At, B1); PG8_BAR; PG8_SCHED;
            } else {
            PG8_LDB(B0, 0, 0); PG8_SCHED; PG8_LDA(At, 0, 0); PG8_STAGE(PG8_SA(1, 1), a1 + hstep, voffA);
            PG8_WAIT_L(8); PG8_BAR; PG8_WAIT_L(0); PG8_MMA(0, 0, At, B0); PG8_BAR; PG8_SCHED;
            PG8_LDB(B1, 0, 1); PG8_STAGE(PG8_SB(0, 0), b2, voffB);
            PG8_BAR; PG8_WAIT_L(0); PG8_MMA(0, 1, At, B1); PG8_BAR;
            PG8_LDA(At, 0, 1); PG8_STAGE(PG8_SA(0, 0), a2, voffA);
            PG8_BAR; PG8_WAIT_L(0); PG8_MMA(1, 0, At, B0); PG8_BAR; PG8_SCHED;
            PG8_STAGE(PG8_SB(0, 1), b2 + hstep, voffB);
            PG8_WAIT_V(6); PG8_BAR; PG8_MMA(1, 1, At, B1); PG8_BAR;
            PG8_LDB(B0, 1, 0); PG8_SCHED; PG8_LDA(At, 1, 0); PG8_STAGE(PG8_SA(0, 1), a2 + hstep, voffA);
            PG8_WAIT_L(8); PG8_BAR; PG8_WAIT_L(0); PG8_MMA(0, 0, At, B0); PG8_BAR; PG8_SCHED;
            PG8_LDB(B1, 1, 1); PG8_STAGE(PG8_SB(1, 0), b3, voffB);
            PG8_BAR; PG8_WAIT_L(0); PG8_MMA(0, 1, At, B1); PG8_BAR;
            PG8_LDA(At, 1, 1); PG8_STAGE(PG8_SA(1, 0), a3, voffA);
            PG8_BAR; PG8_WAIT_L(0); PG8_MMA(1, 0, At, B0); PG8_BAR; PG8_SCHED;
            PG8_STAGE(PG8_SB(1, 1), b3 + hstep, voffB);
            PG8_WAIT_V(6); PG8_BAR; PG8_MMA(1, 1, At, B1); PG8_BAR;
            }
        }
        if constexpr (ALIGN_EPI) { if (wr == 0) PG8_BAR; }
        if constexpr (!Epi::AFTER_DRAIN) { E(acc, cur, wr, wc, fr, fq); S.done(cur); }
        if (!has_next) break;
#pragma unroll
        for (int a = 0; a < 2; ++a)
#pragma unroll
            for (int b = 0; b < 2; ++b)
#pragma unroll
                for (int m = 0; m < 4; ++m)
#pragma unroll
                    for (int n = 0; n < 2; ++n) acc[a][b][m][n] = (f32x4){0.f, 0.f, 0.f, 0.f};
        cur = nxt; cA = nA; cB = nB; ++ui;
        if constexpr (ALIGN_EPI) { if (wr == 1) PG8_BAR; }
    }
    PG8_WAIT_V(0);
    if constexpr (!ALIGN_EPI) { if (wr == 0) PG8_BAR; }
    PG8_BAR;
    if constexpr (Epi::AFTER_DRAIN) { E.fused(acc, cur, wr, wc, fr, fq, lds, wid, lane); S.done(cur); }
#undef PG8_SA
#undef PG8_SB
#undef PG8_STAGE
#undef PG8_LDA
#undef PG8_LDB
#undef PG8_LDA8
#undef PG8_LDB8
#undef PG8_MMA8
#undef PG8_MMA
#undef PG8_WAIT_V
#undef PG8_WAIT_L
#undef PG8_BAR
#undef PG8_SCHED
}
}
#include <hip/hip_bf16.h>
#include <cmath>
namespace attn_body {
using bf16=__hip_bfloat16;
using bf16x8=__attribute__((ext_vector_type(8)))short;
using s16x4=__attribute__((ext_vector_type(4)))short;
using f32x16=__attribute__((ext_vector_type(16)))float;
using u32x4=__attribute__((ext_vector_type(4)))unsigned;
constexpr int BATCH=4,NHEAD=8,SEQ=4096,D=64,DM=3072,OPITCH=1024;
constexpr int NW=8,QBLK=32,QB=QBLK*NW,KVBLK=64,NQB=SEQ/QB;
constexpr int ATTN_UNIT_ROWS=QB;
__device__ __forceinline__ int crow(int r,int hi){return (r&3)+8*(r>>2)+4*hi;}
#define SBAR() __builtin_amdgcn_sched_barrier(0)
__device__ __forceinline__ void cmask(f32x16&p0,f32x16&p1,int jb,int qrel,int hi){
  const float NEG=-INFINITY; int kb=64*jb+4*hi;
  #pragma unroll
  for(int r=0;r<16;++r){int kv=kb+(r&3)+8*(r>>2); if(kv>qrel)p0[r]=NEG; if(kv+32>qrel)p1[r]=NEG;}
}

constexpr int NSLOT=3, SLOTB=8192;
constexpr int LDS_K=0, LDS_V=NSLOT*SLOTB, LDS_WS=2*NSLOT*SLOTB, LDS_OST=LDS_WS+NW*64*4, LDS_BYTES=LDS_OST+NW*4096;
constexpr float C2=0.125f*1.4426950408889634f;
__device__ __forceinline__ void glds16(const void*gsrc,unsigned lds_dst){unsigned keep;
  asm volatile("s_mov_b32 %0, m0\n\ts_mov_b32 m0, %2\n\ts_nop 0\n\tglobal_load_lds_dwordx4 %1, off\n\ts_mov_b32 m0, %0":"=&s"(keep):"v"(gsrc),"s"(lds_dst):"memory");}
__device__ __forceinline__ void glds16s(const void*sbase,unsigned voff,unsigned lds_dst){unsigned keep;
  asm volatile("s_mov_b32 %0, m0\n\ts_mov_b32 m0, %3\n\ts_nop 0\n\tglobal_load_lds_dwordx4 %1, %2\n\ts_mov_b32 m0, %0":"=&s"(keep):"v"(voff),"s"(sbase),"s"(lds_dst):"memory");}
__device__ __forceinline__ float max3f(float a,float b,float c){float r;asm("v_max3_f32 %0, %1, %2, %3":"=v"(r):"v"(a),"v"(b),"v"(c));return r;}
__device__ __forceinline__ float max2f(float a,float b){float r;asm("v_max_f32_e32 %0, %1, %2":"=v"(r):"v"(a),"v"(b));return r;}
__device__ __forceinline__ float fadd_s(float a,float b){float r;asm("v_add_f32_e32 %0, %1, %2":"=v"(r):"v"(a),"v"(b));return r;}
__device__ __forceinline__ float fsub_s(float a,float b){float r;asm("v_sub_f32_e32 %0, %1, %2":"=v"(r):"v"(a),"v"(b));return r;}
typedef float f32x2_t __attribute__((ext_vector_type(2))); typedef __bf16 bf16x2_t __attribute__((ext_vector_type(2)));
__device__ __forceinline__ unsigned cvtpk_s(float lo,float hi){f32x2_t v={lo,hi};bf16x2_t b=__builtin_convertvector(v,bf16x2_t);return __builtin_bit_cast(unsigned,b);}
#define WAIT_BAR(N) asm volatile("s_waitcnt vmcnt(" #N ") lgkmcnt(0)\n\ts_barrier":::"memory")

__device__ __forceinline__ void qkt(f32x16&p0,f32x16&p1,const char*Kslot,const bf16x8*qr,int r32,int hi){
  const f32x16 negm=f32x16{};
  const char*kb=Kslot+hi*1024+r32*16;
  #pragma unroll
  for(int d0=0;d0<4;++d0){
    const bf16x8 b0=*reinterpret_cast<const bf16x8*>(kb+d0*2048);
    const bf16x8 b1=*reinterpret_cast<const bf16x8*>(kb+d0*2048+512);
    if(d0==0){p0=__builtin_amdgcn_mfma_f32_32x32x16_bf16(b0,qr[0],negm,0,0,0);p1=__builtin_amdgcn_mfma_f32_32x32x16_bf16(b1,qr[0],negm,0,0,0);}
    else{p0=__builtin_amdgcn_mfma_f32_32x32x16_bf16(b0,qr[d0],p0,0,0,0);p1=__builtin_amdgcn_mfma_f32_32x32x16_bf16(b1,qr[d0],p1,0,0,0);}}
}
typedef __attribute__((address_space(3))) const char* lds_cptr;
typedef short v4i16_t __attribute__((ext_vector_type(4)));
__device__ __forceinline__ void kload8(bf16x8*kf,lds_cptr kp){
  kf[0]=*(const __attribute__((address_space(3))) bf16x8*)(kp);      kf[1]=*(const __attribute__((address_space(3))) bf16x8*)(kp+512);
  kf[2]=*(const __attribute__((address_space(3))) bf16x8*)(kp+2048); kf[3]=*(const __attribute__((address_space(3))) bf16x8*)(kp+2560);
  kf[4]=*(const __attribute__((address_space(3))) bf16x8*)(kp+4096); kf[5]=*(const __attribute__((address_space(3))) bf16x8*)(kp+4608);
  kf[6]=*(const __attribute__((address_space(3))) bf16x8*)(kp+6144); kf[7]=*(const __attribute__((address_space(3))) bf16x8*)(kp+6656);
}
__device__ __forceinline__ void kload2(bf16x8*kf,lds_cptr kp,int j){ kf[2*j]=*(const __attribute__((address_space(3))) bf16x8*)(kp+j*2048); kf[2*j+1]=*(const __attribute__((address_space(3))) bf16x8*)(kp+j*2048+512); }
__device__ __forceinline__ s16x4 vtr(lds_cptr p){ return __builtin_bit_cast(s16x4,__builtin_amdgcn_ds_read_tr16_b64_v4i16((__attribute__((address_space(3))) v4i16_t*)p)); }
__device__ __forceinline__ float rowmax(const f32x16&p0,const f32x16&p1){
  float a=max3f(p0[0],p0[1],p1[0]),b=max3f(p0[2],p0[3],p1[1]);a=max3f(a,p1[2],p1[3]);
  #pragma unroll
  for(int r=4;r<16;r+=4){a=max3f(a,p0[r],p0[r+1]);b=max3f(b,p0[r+2],p0[r+3]);a=max3f(a,p1[r],p1[r+1]);b=max3f(b,p1[r+2],p1[r+3]);}
  const float m=max2f(a,b);
  auto rr=__builtin_amdgcn_permlane32_swap(__float_as_uint(m),__float_as_uint(m),false,false);
  return max2f(__uint_as_float(rr[0]),__uint_as_float(rr[1]));
}
__device__ __forceinline__ void pv(f32x16*o,int vb,bf16x8 pa0,bf16x8 pa1,bf16x8 pa2,bf16x8 pa3){
  #pragma unroll
  for(int d0=0;d0<2;++d0){s16x4 lo[4],hi[4];
    #pragma unroll
    for(int ks=0;ks<4;++ks){
      asm volatile("ds_read_b64_tr_b16 %0,%1 offset:%c2":"=&v"(lo[ks]):"v"(vb),"i"(d0*4096+ks*1024):"memory");
      asm volatile("ds_read_b64_tr_b16 %0,%1 offset:%c2":"=&v"(hi[ks]):"v"(vb),"i"(d0*4096+ks*1024+512):"memory");}
    asm volatile("s_waitcnt lgkmcnt(0)":::"memory");SBAR();
    #define PK(k) (bf16x8){lo[k][0],lo[k][1],lo[k][2],lo[k][3],hi[k][0],hi[k][1],hi[k][2],hi[k][3]}
    o[d0]=__builtin_amdgcn_mfma_f32_32x32x16_bf16(pa0,PK(0),o[d0],0,0,0);
    o[d0]=__builtin_amdgcn_mfma_f32_32x32x16_bf16(pa1,PK(1),o[d0],0,0,0);
    o[d0]=__builtin_amdgcn_mfma_f32_32x32x16_bf16(pa2,PK(2),o[d0],0,0,0);
    o[d0]=__builtin_amdgcn_mfma_f32_32x32x16_bf16(pa3,PK(3),o[d0],0,0,0);
    #undef PK
  }
}

#define ATTN_YQ (127.f/6.f)
#ifndef ATTN_STORE16
#define ATTN_STORE16(p,v) st16_wt((p),(v))
#endif
template<int THRL> __device__ __forceinline__ void attn_unit(int b,int h,int qb,const bf16*Q,const bf16*__restrict__ K,const bf16*__restrict__ V,bf16*O,const float*KSUM,const float*GG,char*shm){
  int tid_=threadIdx.x; asm volatile("":"+v"(tid_)); const int tid=tid_,lane=tid&63,r32=lane&31,hi=lane>>5; const int wid=__builtin_amdgcn_readfirstlane(tid>>6);
  const long rowbase=(long)b*SEQ; const int q0=qb*QB;
  const bf16*Qw=Q+(rowbase+q0+wid*QBLK)*DM+h*D;
  const bf16*Kh=K+rowbase*DM+h*D,*Vh=V+rowbase*DM+h*D;
  const unsigned lds0=(unsigned)(uintptr_t)shm;
  float*wsf=(float*)(shm+LDS_WS)+wid*64;
  const unsigned koff=(unsigned)((lane*DM+wid*8)*2);
  const unsigned voffs=(unsigned)(((16*(wid&3)+(lane>>2))*DM+(wid>>2)*32+(lane&3)*8)*2);
  const unsigned kdst=lds0+LDS_K+wid*1024, vdst=lds0+LDS_V+wid*1024;
  #define PT(t) (((t)<4)?(NT-4+(t)):((t)-4))
  #define DMA_K(t,slot) glds16s((const char*)Kh+(long)PT(t)*(KVBLK*DM*2),koff,(unsigned)__builtin_amdgcn_readfirstlane(kdst+(slot)))
  #define DMA_V(t,slot) glds16s((const char*)Vh+(long)PT(t)*(KVBLK*DM*2),voffs,(unsigned)__builtin_amdgcn_readfirstlane(vdst+(slot)))
  const int vb0=(int)(lds0+LDS_V)+((lane>>4)&1)*32+(lane&3)*8+(4*hi+((lane&15)>>2))*64;
  const char*Kbase=shm+LDS_K; bf16x8 kf[8];
  const lds_cptr shm3=(lds_cptr)shm; const lds_cptr kp0=shm3+LDS_K+hi*1024+r32*16; const lds_cptr vp0=shm3+LDS_V+((lane>>4)&1)*32+(lane&3)*8+(4*hi+((lane&15)>>2))*64;
  const int NT=(q0+QB)/KVBLK;
  DMA_K(0,0);DMA_V(0,0);DMA_K(1,SLOTB);
  bf16x8 qr[4];
  #pragma unroll
  for(int d0=0;d0<4;++d0)qr[d0]=*reinterpret_cast<const bf16x8*>(&Qw[(long)r32*DM+d0*16+hi*8]);
  float mhat=0.f,l_reg=0.f;f32x16 o[2];o[0]=f32x16{};o[1]=f32x16{};const f32x16 z16=f32x16{};
  unsigned selm=(1u<<qb)-1u;
  if(qb>3){
    f32x16 gt=f32x16{};
    #pragma unroll
    for(int d0=0;d0<4;++d0){ const float*kp=KSUM+((long)(b*16+(r32&15)))*512+h*D+d0*16+hi*8;
      const float4 k0=*reinterpret_cast<const float4*>(kp),k1=*reinterpret_cast<const float4*>(kp+4);
      u32x4 kw; kw.x=cvtpk_s(k0.x,k0.y);kw.y=cvtpk_s(k0.z,k0.w);kw.z=cvtpk_s(k1.x,k1.y);kw.w=cvtpk_s(k1.z,k1.w);
      gt=__builtin_amdgcn_mfma_f32_32x32x16_bf16(__builtin_bit_cast(bf16x8,kw),qr[d0],gt,0,0,0); }
    float v0=-INFINITY,v1=-INFINITY,v2=-INFINITY; int i0=0,i1=0,i2=0;
    #define INS3(vv,ii) do{ const float x_=(vv); const int j_=(ii); \
      if(x_>v0){v2=v1;i2=i1;v1=v0;i1=i0;v0=x_;i0=j_;} else if(x_>v1){v2=v1;i2=i1;v1=x_;i1=j_;} else if(x_>v2){v2=x_;i2=j_;} }while(0)
    #pragma unroll
    for(int r=0;r<8;++r){ const int j=crow(r,hi); INS3(j<qb?gt[r]:-INFINITY,j); }
    const float p0=__shfl_xor(v0,32),p1=__shfl_xor(v1,32),p2=__shfl_xor(v2,32); const int q0i=__shfl_xor(i0,32),q1i=__shfl_xor(i1,32),q2i=__shfl_xor(i2,32);
    INS3(p0,q0i); INS3(p1,q1i); INS3(p2,q2i);
    #undef INS3
    selm=(1u<<i0)|(1u<<i1)|(1u<<i2);
  }
  const int qrel=wid*QBLK+r32;
  #define CMASK(P0,P1,t) do{ if((t)<4)cmask(P0,P1,(t),qrel,hi); }while(0)
  bool resc=false;
  #define START(P0,P1) do{ const float rm=rowmax(P0,P1); resc=false; \
    { const float dl=rm; mhat=fadd_s(mhat,dl); \
      _Pragma("unroll") for(int r=0;r<16;++r){P0[r]=fsub_s(P0[r],dl);P1[r]=fsub_s(P1[r],dl);} \
      } \
    _Pragma("unroll") for(int r=0;r<16;++r)P0[r]=__builtin_amdgcn_exp2f(P0[r]); }while(0)
  #define RESC() do{ if(resc){ asm volatile("s_waitcnt lgkmcnt(0)":::"memory"); \
      _Pragma("unroll") for(int d_=0;d_<2;++d_) _Pragma("unroll") for(int r=0;r<16;++r)o[d_][r]*=wsf[crow(r,hi)]; } }while(0)
  f32x16 pA0,pA1,pB0,pB1;
  int sl_prev=0,sl_cur=0,sl_next=SLOTB;
  #define ROT() do{sl_prev=sl_cur;sl_cur=sl_next;sl_next=(sl_next==(NSLOT-1)*SLOTB)?0:sl_next+SLOTB;}while(0)
  DMA_K(2,2*SLOTB);
  WAIT_BAR(3);
  qkt(pA0,pA1,Kbase,qr,r32,hi);asm volatile("s_nop 15\n\ts_nop 7":"+v"(pA0),"+v"(pA1));CMASK(pA0,pA1,0);
  START(pA0,pA1);
  _Pragma("unroll") for(int r=0;r<16;++r)pA1[r]=__builtin_amdgcn_exp2f(pA1[r]);
  WAIT_BAR(0);
  DMA_K(3,0);DMA_V(1,SLOTB);
  ROT();
  kload8(kf,kp0+sl_cur);
  WAIT_BAR(2);
  s16x4 vlo[8],vhi[8]; u32x4 pw0,pw1,pw2,pw3;
  #define PKW(P,B) cvtpk_s(P[B],P[B+1])
  #define PAF(k) __builtin_bit_cast(bf16x8,pw##k)
  #define VFR(i) (bf16x8){vlo[i][0],vlo[i][1],vlo[i][2],vlo[i][3],vhi[i][0],vhi[i][1],vhi[i][2],vhi[i][3]}
  #define PIN(x) asm volatile("":"+v"(x))
  #define MX3(a,b,c) __builtin_fmaxf(__builtin_fmaxf((a),(b)),(c))
  #define GAPA(MF,A0,A1,A2,A3,W0,W1,PW) do{ MF; sacc+=A0; sacc+=A1; sacc+=A2; sacc+=A3; PIN(sacc); W0; W1; PIN(PW); SBAR(); }while(0)
  #define EX(v) __builtin_amdgcn_exp2f(v)
  #define GAPB(MF,X,B) do{ MF; X[B]=EX(X[B]); X[B+1]=EX(X[B+1]); X[B+2]=EX(X[B+2]); X[B+3]=EX(X[B+3]); PIN(X); SBAR(); }while(0)
  #define VRD(i) do{ vlo[i]=vtr(vp_+(((i)>>2)*4096+((i)&3)*1024)); vhi[i]=vtr(vp_+(((i)>>2)*4096+((i)&3)*1024+512)); }while(0)
  #define KRD(G,j) do{ if(G){ kload2(kf,kp0+sl_next,j); SBAR(); } }while(0)
  #define STEP(C0,C1,P0,P1,t,GK,GV,GL) do{ SBAR(); \
    const lds_cptr vp_=vp0+sl_prev; \
    VRD(0); SBAR(); float sacc=(P0[0]+P0[1]); \
    GAPA(C0=__builtin_amdgcn_mfma_f32_32x32x16_bf16(kf[0],qr[0],z16,0,0,0), P0[2],P0[3],P0[4],P0[5],     pw0[0]=PKW(P0,0), pw0[1]=PKW(P0,2), pw0); \
    VRD(4); SBAR(); GAPA(C1=__builtin_amdgcn_mfma_f32_32x32x16_bf16(kf[1],qr[0],z16,0,0,0), P0[6],P0[7],P0[8],P0[9],     pw0[2]=PKW(P0,4), pw0[3]=PKW(P0,6), pw0); \
    VRD(1); SBAR(); GAPA(C0=__builtin_amdgcn_mfma_f32_32x32x16_bf16(kf[2],qr[1],C0,0,0,0),   P0[10],P0[11],P0[12],P0[13], pw1[0]=PKW(P0,8), pw1[1]=PKW(P0,10), pw1); \
    VRD(5); SBAR(); GAPA(C1=__builtin_amdgcn_mfma_f32_32x32x16_bf16(kf[3],qr[1],C1,0,0,0),   P0[14],P0[15],P1[0],P1[1],   pw1[2]=PKW(P0,12),pw1[3]=PKW(P0,14), pw1); \
    VRD(2); SBAR(); GAPA(C0=__builtin_amdgcn_mfma_f32_32x32x16_bf16(kf[4],qr[2],C0,0,0,0),   P1[2],P1[3],P1[4],P1[5],     pw2[0]=PKW(P1,0), pw2[1]=PKW(P1,2), pw2); \
    VRD(6); SBAR(); GAPA(C1=__builtin_amdgcn_mfma_f32_32x32x16_bf16(kf[5],qr[2],C1,0,0,0),   P1[6],P1[7],P1[8],P1[9],     pw2[2]=PKW(P1,4), pw2[3]=PKW(P1,6), pw2); \
    VRD(3); SBAR(); GAPA(C0=__builtin_amdgcn_mfma_f32_32x32x16_bf16(kf[6],qr[3],C0,0,0,0),   P1[10],P1[11],P1[12],P1[13], pw3[0]=PKW(P1,8), pw3[1]=PKW(P1,10), pw3); \
    VRD(7); SBAR(); GAPA(C1=__builtin_amdgcn_mfma_f32_32x32x16_bf16(kf[7],qr[3],C1,0,0,0),   P1[14],P1[15],0.f,0.f,       pw3[2]=PKW(P1,12),pw3[3]=PKW(P1,14), pw3); \
    l_reg+=sacc; \
    if(GK){DMA_K((t)+3,sl_cur);} if(GV){DMA_V((t)+1,sl_next);} \
    { const bool v_=((t)<4)||((selm>>(((t)-4)>>2))&1u); const float nm_=v_?-mhat:-INFINITY; \
      _Pragma("unroll") for(int r=0;r<16;++r){C0[r]+=nm_;C1[r]+=nm_;} } \
    CMASK(C0,C1,t); \
    { float a=MX3(C0[0],C0[1],C1[0]),b=MX3(C0[2],C0[3],C1[1]); a=MX3(a,C1[2],C1[3]); \
      _Pragma("unroll") for(int r=4;r<16;r+=4){a=MX3(a,C0[r],C0[r+1]);b=MX3(b,C0[r+2],C0[r+3]);a=MX3(a,C1[r],C1[r+1]);b=MX3(b,C1[r+2],C1[r+3]);} \
      float rm=__builtin_fmaxf(a,b); { auto rr=__builtin_amdgcn_permlane32_swap(__float_as_uint(rm),__float_as_uint(rm),false,false); rm=__builtin_fmaxf(__uint_as_float(rr[0]),__uint_as_float(rr[1])); } \
      resc=false; \
      if(__builtin_expect(__any(rm>(float)THRL),0)){ const float dl=__builtin_fmaxf(rm,0.f); mhat+=dl; \
        _Pragma("unroll") for(int r=0;r<16;++r){C0[r]-=dl;C1[r]-=dl;} \
        const float f=__builtin_amdgcn_exp2f(-dl); l_reg*=f; if(hi==0)wsf[r32]=f; resc=true; } } \
    SBAR(); \
    GAPB(o[0]=__builtin_amdgcn_mfma_f32_32x32x16_bf16(PAF(0),VFR(0),o[0],0,0,0), C0,0); \
    GAPB(o[1]=__builtin_amdgcn_mfma_f32_32x32x16_bf16(PAF(0),VFR(4),o[1],0,0,0), C0,4); \
    KRD(GL,0); GAPB(o[0]=__builtin_amdgcn_mfma_f32_32x32x16_bf16(PAF(1),VFR(1),o[0],0,0,0), C0,8); \
    KRD(GL,1); GAPB(o[1]=__builtin_amdgcn_mfma_f32_32x32x16_bf16(PAF(1),VFR(5),o[1],0,0,0), C0,12); \
    KRD(GL,2); GAPB(o[0]=__builtin_amdgcn_mfma_f32_32x32x16_bf16(PAF(2),VFR(2),o[0],0,0,0), C1,0); \
    KRD(GL,3); GAPB(o[1]=__builtin_amdgcn_mfma_f32_32x32x16_bf16(PAF(2),VFR(6),o[1],0,0,0), C1,4); \
    GAPB(o[0]=__builtin_amdgcn_mfma_f32_32x32x16_bf16(PAF(3),VFR(3),o[0],0,0,0), C1,8); \
    GAPB(o[1]=__builtin_amdgcn_mfma_f32_32x32x16_bf16(PAF(3),VFR(7),o[1],0,0,0), C1,12); \
    }while(0)
  int t=1;
  #define ENDW(tt) do{ if((tt)+3<NT){WAIT_BAR(2);} else if((tt)+2<NT){WAIT_BAR(1);} else {WAIT_BAR(0);} }while(0)
  for(;t<5&&t+1<NT;t+=2){
    STEP(pB0,pB1,pA0,pA1,t,(t+3<NT),(t+1<NT),(t+1<NT));       ENDW(t);   RESC(); ROT();
    STEP(pA0,pA1,pB0,pB1,t+1,(t+4<NT),(t+2<NT),(t+2<NT));     ENDW(t+1); RESC(); ROT();
  }
  #undef CMASK
  #define CMASK(P0,P1,t) do{}while(0)
  for(;t+5<NT;t+=2){
    STEP(pB0,pB1,pA0,pA1,t,true,true,true);     WAIT_BAR(2); RESC(); ROT();
    STEP(pA0,pA1,pB0,pB1,t+1,true,true,true);   WAIT_BAR(2); RESC(); ROT();
  }
  #undef CMASK
  #define CMASK(P0,P1,t) do{ if((t)<4)cmask(P0,P1,(t),qrel,hi); }while(0)
  for(;t+1<NT;t+=2){
    STEP(pB0,pB1,pA0,pA1,t,(t+3<NT),(t+1<NT),(t+1<NT));       ENDW(t);   RESC(); ROT();
    STEP(pA0,pA1,pB0,pB1,t+1,(t+4<NT),(t+2<NT),(t+2<NT));     ENDW(t+1); RESC(); ROT();
  }
  STEP(pB0,pB1,pA0,pA1,NT-1,false,false,false); RESC();
  { float sacc=pB0[0]+pB0[1]; _Pragma("unroll") for(int r=2;r<16;++r)sacc+=pB0[r]; _Pragma("unroll") for(int r=0;r<16;++r)sacc+=pB1[r]; l_reg+=sacc;
    pw0=(u32x4){PKW(pB0,0),PKW(pB0,2),PKW(pB0,4),PKW(pB0,6)};pw1=(u32x4){PKW(pB0,8),PKW(pB0,10),PKW(pB0,12),PKW(pB0,14)};pw2=(u32x4){PKW(pB1,0),PKW(pB1,2),PKW(pB1,4),PKW(pB1,6)};pw3=(u32x4){PKW(pB1,8),PKW(pB1,10),PKW(pB1,12),PKW(pB1,14)};
    SBAR(); pv(o,vb0+sl_cur,PAF(0),PAF(1),PAF(2),PAF(3)); }
  #undef PKW
  #undef PAF
  #undef VFR
  #undef PIN
  #undef MX3
  #undef GAPA
  #undef GAPB
  #undef EX
  #undef VRD
  #undef KRD
  #undef STEP
  #undef ENDW
  {auto rr=__builtin_amdgcn_permlane32_swap(__float_as_uint(l_reg),__float_as_uint(l_reg),false,false);l_reg=__uint_as_float(rr[0])+__uint_as_float(rr[1]);}
  if(hi==0)wsf[32+r32]=l_reg;asm volatile("s_waitcnt lgkmcnt(0)":::"memory");
  float rli[16];
  #pragma unroll
  for(int r=0;r<16;++r)rli[r]=__builtin_amdgcn_rcpf(wsf[32+crow(r,hi)]);
  bf16*Ow=O+(rowbase+q0+wid*QBLK)*OPITCH+h*D;
  { bf16*stg=(bf16*)(shm+LDS_OST)+wid*2048;
    #pragma unroll
    for(int r=0;r<16;++r){const int orow=crow(r,hi);
      #pragma unroll
      for(int d0=0;d0<2;++d0)stg[orow*64+d0*32+r32]=__float2bfloat16(o[d0][r]*rli[r]);}
    asm volatile("s_waitcnt lgkmcnt(0)":::"memory");
    const int ch=lane&7; float gg[8];
    #pragma unroll
    for(int i=0;i<8;++i)gg[i]=GG[h*D+ch*8+i];
    #pragma unroll
    for(int i=0;i<4;++i){const int row=i*8+(lane>>3); const u32x4 v=*(const u32x4*)(stg+row*64+ch*8);
      float x[8]; x[0]=__uint_as_float(v.x<<16);x[1]=__uint_as_float(v.x&0xffff0000u);x[2]=__uint_as_float(v.y<<16);x[3]=__uint_as_float(v.y&0xffff0000u);
      x[4]=__uint_as_float(v.z<<16);x[5]=__uint_as_float(v.z&0xffff0000u);x[6]=__uint_as_float(v.w<<16);x[7]=__uint_as_float(v.w&0xffff0000u);
      float ss=0.f;
      #pragma unroll
      for(int k=0;k<8;++k)ss+=x[k]*x[k];
      ss+=__shfl_xor(ss,1);ss+=__shfl_xor(ss,2);ss+=__shfl_xor(ss,4);
      const float rs=rsqrtf(ss*(1.f/64.f)+1e-6f);
      const float qn=rs*ATTN_YQ; unsigned w0=0u,w1=0u;
      #pragma unroll
      for(int k=0;k<4;++k){const int a=(int)fminf(fmaxf(__builtin_rintf(x[k]*qn),-127.f),127.f),b=(int)fminf(fmaxf(__builtin_rintf(x[4+k]*qn),-127.f),127.f); w0|=((unsigned)a&0xffu)<<(8*k); w1|=((unsigned)b&0xffu)<<(8*k);}
      st8_wt((void*)((unsigned char*)O+((rowbase+q0+wid*QBLK+row)*(long)OPITCH+h*D+ch*8)),(unsigned long long)w0|((unsigned long long)w1<<32));} }
  asm volatile("s_waitcnt lgkmcnt(0)\n\ts_barrier":::"memory");
  #undef DMA_K
  #undef PT
  #undef DMA_V
  #undef CMASK
  #undef START
  #undef RESC
  #undef ROT
}
constexpr int ATTN_LDS_BYTES=LDS_BYTES;
struct AttnTensors { const bf16* Q; const bf16* K; const bf16* V; bf16* O; const float* KSUM; const float* GG; };
struct AttnUnit { int bh; int qb; };
struct StaticOrder {
  int vcu,G;
  __device__ __forceinline__ explicit StaticOrder(int grid,int block):vcu((grid%8==0)?(block%8)*(grid/8)+block/8:block),G(grid){}
  __device__ __forceinline__ bool next(int i,AttnUnit&u)const{ const int pr=vcu+(i>>1)*G; if(pr>=256)return false; const int s=pr&7; u.bh=pr>>3; u.qb=(i&1)?s:15-s; return true; }
  __device__ __forceinline__ void a_ready(const AttnUnit&)const{}
  __device__ __forceinline__ void done(const AttnUnit&)const{}
};
template<class Sched,int THRL=8> __device__ __forceinline__ void attn_phase(char*lds,const AttnTensors&T,const Sched&S){
  AttnUnit u;
  for(int i=0;S.next(i,u);++i){ S.a_ready(u); attn_unit<THRL>(u.bh/NHEAD,u.bh%NHEAD,u.qb,T.Q,T.K,T.V,T.O,T.KSUM,T.GG,lds); S.done(u); }
}
#undef SBAR
#undef WAIT_BAR
}

#define GAS __attribute__((address_space(1)))
#define LAS __attribute__((address_space(3)))
typedef unsigned short bf16;
typedef unsigned v4u __attribute__((ext_vector_type(4)));
typedef float f32x4 __attribute__((ext_vector_type(4)));
typedef short bf16x8 __attribute__((ext_vector_type(8)));
typedef GAS unsigned gu32;
typedef GAS unsigned long long gu64;
#define RLX_AGENT __ATOMIC_RELAXED, __HIP_MEMORY_SCOPE_AGENT
#define LDS_WAIT() asm volatile("s_waitcnt lgkmcnt(0)" ::: "memory")
#define VM_WAIT() asm volatile("s_waitcnt vmcnt(0)" ::: "memory")
__device__ __forceinline__ unsigned long long rt() { return __builtin_amdgcn_s_memrealtime(); }
__device__ __forceinline__ unsigned f2bf(float f) { unsigned u = __builtin_bit_cast(unsigned, f); return (u + 0x7fffu + ((u >> 16) & 1u)) >> 16; }
__device__ __forceinline__ unsigned pk2(float lo, float hi) { return f2bf(lo) | (f2bf(hi) << 16); }

#define XB_TMO      128
#define XB_XCNT(j)  (256  + 64 * (j))
#define XB_XSUB(j)  (1280 + 64 * (j))
#define XB_XGEN(j)  (2304 + 64 * (j))
#define XB_TOP      3328
#define XB_TOPGEN   3392
#define XCD_BAR_WORDS 3456
#define XB_SPIN_CAP (1u << 18)

__device__ __forceinline__ unsigned xb_ld(unsigned* p)              { return __hip_atomic_load(p, __ATOMIC_RELAXED, __HIP_MEMORY_SCOPE_AGENT); }
__device__ __forceinline__ unsigned xb_add(unsigned* p, unsigned v) { return __hip_atomic_fetch_add(p, v, __ATOMIC_RELAXED, __HIP_MEMORY_SCOPE_AGENT); }
__device__ __forceinline__ unsigned xb_xcc_id() { return (unsigned)__builtin_amdgcn_s_getreg((3 << 11) | 20) & 0xFu; }
#define XB_SPIN(cond, bar) do { unsigned _sp = 0; while (cond) { __builtin_amdgcn_s_sleep(1); \
    if ((++_sp & 255u) == 0u) { if (xb_ld(&(bar)[XB_TMO])) break; if (_sp > XB_SPIN_CAP) { atomicAdd(&(bar)[XB_TMO], 1u); break; } } } } while (0)

struct XcdBarrier {
    unsigned* bar; unsigned x;
    volatile LAS unsigned* st;
};

__device__ __forceinline__ XcdBarrier xcd_barrier_post(unsigned* bar, volatile LAS unsigned* st) {
    XcdBarrier b; b.bar = bar; b.x = xb_xcc_id(); b.st = st;
    if (threadIdx.x == 0) (void)xb_add(&bar[XB_XCNT(b.x)], 1u);
    return b;
}
__device__ __forceinline__ void xcd_barrier_complete(unsigned* bar, unsigned x, unsigned& nloc, unsigned& nx) {
    const unsigned G = gridDim.x * gridDim.y * gridDim.z;
    unsigned sum, cnt, mine, sp = 0u;
    for (;;) {
        sum = 0u; cnt = 0u; mine = 0u;
#pragma unroll
        for (unsigned j = 0; j < 16; ++j) { const unsigned c = xb_ld(&bar[XB_XCNT(j)]); sum += c; cnt += (c > 0u) ? 1u : 0u; mine = (j == x) ? c : mine; }
        if (sum == G) break;
        __builtin_amdgcn_s_sleep(1);
        if ((++sp & 255u) == 0u) { if (xb_ld(&bar[XB_TMO])) break; if (sp > XB_SPIN_CAP) { atomicAdd(&bar[XB_TMO], 1u); break; } }
    }
    nloc = mine > 0u ? mine : 1u; nx = cnt > 0u ? cnt : 1u;
}

__device__ __forceinline__ void xcd_barrier(const XcdBarrier& b) {
    asm volatile("s_waitcnt vmcnt(0)" ::: "memory");
    __syncthreads();
    if (threadIdx.x == 0) {
        unsigned* bar = b.bar;
        __builtin_amdgcn_s_waitcnt(0);
        unsigned nloc = b.st[0], nx = b.st[1];
        if (nloc == 0u) { xcd_barrier_complete(bar, b.x, nloc, nx); b.st[0] = nloc; b.st[1] = nx; }
        const unsigned old = xb_add(&bar[XB_XSUB(b.x)], 1u);
        const unsigned gen = old / nloc;
        if (old + 1u == (gen + 1u) * nloc) {
            asm volatile("s_waitcnt vmcnt(0)" ::: "memory");
            const unsigned og = xb_add(&bar[XB_TOP], 1u);
            const unsigned tg = og / nx;
            if (og + 1u == (tg + 1u) * nx) xb_add(&bar[XB_TOPGEN], 1u);
            else XB_SPIN(xb_ld(&bar[XB_TOPGEN]) == tg, bar);
            __builtin_amdgcn_fence(__ATOMIC_ACQUIRE, "agent");
            xb_add(&bar[XB_XGEN(b.x)], 1u);
            asm volatile("s_waitcnt vmcnt(0)" ::: "memory");
        } else {
            XB_SPIN(xb_ld(&bar[XB_XGEN(b.x)]) == gen, bar);
            __builtin_amdgcn_fence(__ATOMIC_ACQUIRE, "agent");
            asm volatile("s_waitcnt vmcnt(0)" ::: "memory");
        }
    }
    __syncthreads();
}

constexpr int NWAVES = 8;
constexpr int NB = 4, S = 4096, D = 1024, M = NB * S;
constexpr int NIN = 3072, NQ = 2048, NEXP = 16384;
constexpr float EPS = 1e-6f;
constexpr float C2 = 0.125f * 1.4426950408889634f;

constexpr size_t MiB = 1u << 20;
constexpr size_t WS_CTL = 0, CTL_ZERO_BYTES = 256 * 1024;
constexpr size_t WS_MOD = 1 * MiB;
constexpr size_t WS_KMEAN = 128 * 1024;
constexpr size_t WS_KEYS = 1 * MiB + 512 * 1024;
constexpr size_t WS_WIN = 2 * MiB, WS_WO = 8 * MiB, WS_WQ = 10 * MiB;
constexpr size_t WS_EIDX = 14 * MiB, WS_G = 22 * MiB;
constexpr size_t WS_U = 32 * MiB, WS_V = 64 * MiB;
constexpr size_t WS_SU = 48 * MiB, WS_SV = 48 * MiB + 64 * 1024;
constexpr size_t WS_H = 96 * MiB;
constexpr size_t WS_P = 128 * MiB;
constexpr size_t WS_QP = 128 * MiB, WS_O = 192 * MiB;
constexpr size_t WS_Y = 224 * MiB, WS_END = 256 * MiB;
constexpr int CW_BAR = 1024;
constexpr int CW_CMAX = 8192;
constexpr int CW_CMAX3 = CW_CMAX + 3072 + 2048;
constexpr float YQ = 127.f / 6.f;
constexpr int CW_CMAX2 = CW_CMAX + 3072;
constexpr size_t WS_WO8 = 47 * MiB;
constexpr size_t WS_WQ8 = 45 * MiB, WS_RS2 = 44 * MiB + 65536;
constexpr size_t WS_WIN8 = 40 * MiB, WS_RS = 44 * MiB;

constexpr int LDS_BYTES = 153600;
constexpr int LDSCTL_OFF = LDS_BYTES - 512, MISC_OFF = LDSCTL_OFF + 320;
constexpr int RING_BYTES = 131072;

struct Frame {
    LAS unsigned char* lds;
    volatile LAS unsigned* MISC;
    gu32* ctl;
    int tid, lane, wave, G;
    const float *x, *c, *ada_w, *ada_b, *pre_gain, *post_gain, *w_in, *conv_w, *group_gain, *w_out, *fpre_gain, *fpost_gain, *wq, *keys, *pu, *pv;
    float* out;
    float* mod; float* kmean; bf16* keysb; bf16 *WinT, *WoT, *WqT; int* eidx; float* gw; unsigned char *U8, *V8; float *su, *sv; bf16 *H, *P, *QP, *O, *Y; float* scratch; unsigned char* Win8; float* rs; unsigned char* Wq8; float* rs2; unsigned char* Wo8;
};

__device__ __forceinline__ float wave_sum(float v) {
#pragma unroll
    for (int o = 1; o < 64; o <<= 1) v += __shfl_xor(v, o);
    return v;
}
__device__ __forceinline__ float bflo(unsigned u) { return __uint_as_float(u << 16); }
__device__ __forceinline__ float bfhi(unsigned u) { return __uint_as_float(u & 0xffff0000u); }

template <bool CMAX = false, bool KSC = false> __device__ __forceinline__ void p0_transpose_item(const float* W, int K, int N, bf16* WT, LAS float* scr, int item, int lane, unsigned* cmax = nullptr, const float* ksc = nullptr) {
    const int nblk = N / 32, kb = item / nblk, nb = item % nblk, k0 = 64 * kb, n0 = 32 * nb;
#pragma unroll 8
    for (int i = 0; i < 32; ++i) { const int kk = 2 * i + (lane >> 5); float wv = W[(size_t)(k0 + kk) * N + n0 + (lane & 31)]; if (KSC) wv *= ksc[k0 + kk] * (1.f / YQ); scr[kk * 33 + (lane & 31)] = wv; }
    LDS_WAIT(); asm volatile("" ::: "memory");
    const int c = lane & 7;
#pragma unroll
    for (int j = 0; j < 4; ++j) { const int n = (lane >> 3) + 8 * j; const LAS float* s = scr + (8 * c) * 33 + n;
        v4u o; o.x = pk2(s[0 * 33], s[1 * 33]); o.y = pk2(s[2 * 33], s[3 * 33]); o.z = pk2(s[4 * 33], s[5 * 33]); o.w = pk2(s[6 * 33], s[7 * 33]);
        st16_wt((void*)(WT + (size_t)(n0 + n) * K + k0 + 8 * c), o);
        if (CMAX) {
            float am = fmaxf(fmaxf(fmaxf(fabsf(s[0 * 33]), fabsf(s[1 * 33])), fmaxf(fabsf(s[2 * 33]), fabsf(s[3 * 33]))), fmaxf(fmaxf(fabsf(s[4 * 33]), fabsf(s[5 * 33])), fmaxf(fabsf(s[6 * 33]), fabsf(s[7 * 33]))));
            am = fmaxf(am, __shfl_xor(am, 1)); am = fmaxf(am, __shfl_xor(am, 2)); am = fmaxf(am, __shfl_xor(am, 4));
            if (c == 0) atomicMax(cmax + n0 + n, __float_as_uint(am));
        } }
    LDS_WAIT(); asm volatile("" ::: "memory");
}
__device__ __forceinline__ void cvt8(const float* src, bf16* dst, size_t i8) {
    const f32x4 a = *(const GAS f32x4*)(src + i8 * 8), b = *(const GAS f32x4*)(src + i8 * 8 + 4);
    v4u o; o.x = pk2(a.x, a.y); o.y = pk2(a.z, a.w); o.z = pk2(b.x, b.y); o.w = pk2(b.z, b.w);
    st16_wt((void*)(dst + i8 * 8), o);
}
__device__ __forceinline__ void p0_prep(Frame& F) {
    {
        LAS float* sc = (LAS float*)F.lds;
        LAS float* red = sc + 4096;
        bool did = false;
        for (int it = blockIdx.x; it < 192; it += F.G) {
            if (!did) { for (int i = F.tid; i < 4096; i += 512) { const float v = F.c[i]; sc[i] = v / (1.f + __expf(-v)); } did = true; }
            __syncthreads();
            const int c4 = F.tid & 7, ks = F.tid >> 3, j0 = it * 32 + 4 * c4;
            f32x4 w[16];
#pragma unroll
            for (int i = 0; i < 16; ++i) w[i] = *(const GAS f32x4*)(F.ada_w + (size_t)(ks * 16 + i) * 6144 + j0);
            f32x4 a0 = {0.f, 0.f, 0.f, 0.f}, a1 = a0, a2 = a0, a3 = a0;
#pragma unroll
            for (int i = 0; i < 16; ++i) { const int r = ks * 16 + i; a0 += w[i] * sc[r]; a1 += w[i] * sc[1024 + r]; a2 += w[i] * sc[2048 + r]; a3 += w[i] * sc[3072 + r]; }
            *(LAS f32x4*)(red + (ks * 4 + 0) * 32 + 4 * c4) = a0; *(LAS f32x4*)(red + (ks * 4 + 1) * 32 + 4 * c4) = a1;
            *(LAS f32x4*)(red + (ks * 4 + 2) * 32 + 4 * c4) = a2; *(LAS f32x4*)(red + (ks * 4 + 3) * 32 + 4 * c4) = a3;
            __syncthreads();
            if (F.tid < 128) { const int b = F.tid >> 5, jj = F.tid & 31; float s = 0.f;
#pragma unroll 16
                for (int k = 0; k < 64; ++k) s += red[(k * 4 + b) * 32 + jj];
                __hip_atomic_store(F.mod + b * 6144 + it * 32 + jj, s + F.ada_b[it * 32 + jj], __ATOMIC_RELAXED, __HIP_MEMORY_SCOPE_AGENT); }
        }
        __syncthreads();
    }
    LAS float* scr = (LAS float*)(F.lds + F.wave * 16384);
    const int gwv = blockIdx.x * NWAVES + F.wave, NGW = F.G * NWAVES;
    constexpr int I_IN = (D / 64) * (NIN / 32), I_O = (D / 64) * (D / 32), I_Q = (D / 64) * (NQ / 32);
    for (int it = gwv; it < I_IN + I_O + I_Q; it += NGW) {
        int r = it;
        if (r < I_IN) { p0_transpose_item<true>(F.w_in, D, NIN, F.WinT, scr, r, F.lane, (unsigned*)(F.ctl + CW_CMAX)); continue; } r -= I_IN;
        if (r < I_O) { p0_transpose_item<true, true>(F.w_out, D, D, F.WoT, scr, r, F.lane, (unsigned*)(F.ctl + CW_CMAX3), F.group_gain); continue; } r -= I_O;
        p0_transpose_item<true>(F.wq, D, NQ, F.WqT, scr, r, F.lane, (unsigned*)(F.ctl + CW_CMAX2));
    }
    const size_t gt = (size_t)blockIdx.x * 512 + F.tid, NT = (size_t)F.G * 512;
    for (size_t i = gt; i < (size_t)16 * 128 * 128 / 8; i += NT) cvt8(F.keys, F.keysb, i);
}
__device__ __forceinline__ void p0_tables(Frame& F) {
    const int gwv = blockIdx.x * NWAVES + F.wave, NGW = F.G * NWAVES;
    for (int row0 = gwv; row0 < 2 * NEXP; row0 += 2 * NGW) {
      f32x4 a2[2][4];
#pragma unroll
      for (int rr = 0; rr < 2; ++rr) { const int row = row0 + rr * NGW; if (row < 2 * NEXP) { const GAS f32x4* src = (const GAS f32x4*)(((row >> 14) ? F.pv : F.pu) + (size_t)(row & (NEXP - 1)) * D + 16 * F.lane);
#pragma unroll
          for (int i = 0; i < 4; ++i) a2[rr][i] = src[i]; } }
#pragma unroll
      for (int rr = 0; rr < 2; ++rr) { const int row = row0 + rr * NGW; if (row >= 2 * NEXP) break;
        const int tabv = row >> 14, e = row & (NEXP - 1);
        f32x4 a[4]; float ssq = 0.f;
#pragma unroll
        for (int i = 0; i < 4; ++i) { a[i] = a2[rr][i]; ssq += (a[i].x * a[i].x + a[i].y * a[i].y) + (a[i].z * a[i].z + a[i].w * a[i].w); }
        ssq = wave_sum(ssq);
        const float rms = sqrtf(ssq * (1.f / D));
        if (tabv == 0) {
            const float stepq = 0.34f * rms, isq = stepq > 0.f ? 1.f / stepq : 0.f;
            unsigned d0 = 0u, d1 = 0u;
#pragma unroll
            for (int i = 0; i < 4; ++i) { const float xs[4] = {a[i].x, a[i].y, a[i].z, a[i].w};
#pragma unroll
                for (int c = 0; c < 4; ++c) { const int q = (int)fminf(fmaxf(__builtin_rintf(xs[c] * isq), -7.f), 7.f); const int el = 4 * i + c;
                    if (el < 8) d0 |= (unsigned)(q & 15) << (4 * el); else d1 |= (unsigned)(q & 15) << (4 * (el - 8)); } }
            st8_wt((void*)(F.U8 + (size_t)e * 512 + 8 * F.lane), (unsigned long long)d0 | ((unsigned long long)d1 << 32));
            if (F.lane == 0) __hip_atomic_store(F.su + e, stepq, __ATOMIC_RELAXED, __HIP_MEMORY_SCOPE_AGENT);
        } else {
            const float unit = 0.5f * rms, iu = unit > 0.f ? 1.f / unit : 0.f;
            unsigned d0 = 0u, d1 = 0u;
            d0 = __builtin_amdgcn_cvt_scalef32_pk_fp4_f32(d0, a[0].x * iu, a[0].y * iu, 1.0f, 0); d0 = __builtin_amdgcn_cvt_scalef32_pk_fp4_f32(d0, a[0].z * iu, a[0].w * iu, 1.0f, 1);
            d0 = __builtin_amdgcn_cvt_scalef32_pk_fp4_f32(d0, a[1].x * iu, a[1].y * iu, 1.0f, 2); d0 = __builtin_amdgcn_cvt_scalef32_pk_fp4_f32(d0, a[1].z * iu, a[1].w * iu, 1.0f, 3);
            d1 = __builtin_amdgcn_cvt_scalef32_pk_fp4_f32(d1, a[2].x * iu, a[2].y * iu, 1.0f, 0); d1 = __builtin_amdgcn_cvt_scalef32_pk_fp4_f32(d1, a[2].z * iu, a[2].w * iu, 1.0f, 1);
            d1 = __builtin_amdgcn_cvt_scalef32_pk_fp4_f32(d1, a[3].x * iu, a[3].y * iu, 1.0f, 2); d1 = __builtin_amdgcn_cvt_scalef32_pk_fp4_f32(d1, a[3].z * iu, a[3].w * iu, 1.0f, 3);
            st8_wt((void*)(F.V8 + (size_t)(F.lane >> 4) * (NEXP * 128) + (size_t)e * 128 + (F.lane & 15) * 8), (unsigned long long)d0 | ((unsigned long long)d1 << 32));
            if (F.lane == 0) __hip_atomic_store(F.sv + e, unit, __ATOMIC_RELAXED, __HIP_MEMORY_SCOPE_AGENT);
        }
      }
    }
}

__device__ __forceinline__ unsigned q8x4(const f32x4 v, float qs) {
    const int a = (int)__builtin_rintf(v.x * qs), b = (int)__builtin_rintf(v.y * qs), c = (int)__builtin_rintf(v.z * qs), d = (int)__builtin_rintf(v.w * qs);
    return ((unsigned)a & 0xffu) | (((unsigned)b & 0xffu) << 8) | (((unsigned)c & 0xffu) << 16) | ((unsigned)d << 24);
}
__device__ __forceinline__ unsigned q8x4c(const f32x4 v, float qs) {
    const int a = (int)fminf(fmaxf(__builtin_rintf(v.x * qs), -127.f), 127.f), b = (int)fminf(fmaxf(__builtin_rintf(v.y * qs), -127.f), 127.f);
    const int c = (int)fminf(fmaxf(__builtin_rintf(v.z * qs), -127.f), 127.f), d = (int)fminf(fmaxf(__builtin_rintf(v.w * qs), -127.f), 127.f);
    return ((unsigned)a & 0xffu) | (((unsigned)b & 0xffu) << 8) | (((unsigned)c & 0xffu) << 16) | ((unsigned)d << 24);
}
__device__ __forceinline__ void p1_hnorm(Frame& F) {
    const int gwv = blockIdx.x * NWAVES + F.wave, NGW = F.G * NWAVES;
    for (int m0 = gwv * 4; m0 < M; m0 += NGW * 4) {
        const int b = m0 >> 12;
        f32x4 v[4][4];
#pragma unroll
        for (int r = 0; r < 4; ++r) { const GAS f32x4* xr = (const GAS f32x4*)(F.x + (size_t)(m0 + r) * D) + F.lane;
#pragma unroll
            for (int j = 0; j < 4; ++j) v[r][j] = xr[64 * j]; }
        f32x4 gs[4], sh[4];
#pragma unroll
        for (int j = 0; j < 4; ++j) { const int col = 4 * F.lane + 256 * j;
            gs[j] = *(const GAS f32x4*)(F.pre_gain + col) * (*(const GAS f32x4*)(F.mod + b * 6144 + 1024 + col) + 1.f); sh[j] = *(const GAS f32x4*)(F.mod + b * 6144 + col); }
#pragma unroll
        for (int r = 0; r < 4; ++r) {
            float ss = 0.f;
#pragma unroll
            for (int j = 0; j < 4; ++j) ss += (v[r][j].x * v[r][j].x + v[r][j].y * v[r][j].y) + (v[r][j].z * v[r][j].z + v[r][j].w * v[r][j].w);
            const float rstd = rsqrtf(wave_sum(ss) * (1.f / D) + EPS);
            f32x4 o[4]; float am = 0.f;
#pragma unroll
            for (int j = 0; j < 4; ++j) { o[j] = v[r][j] * rstd * gs[j] + sh[j]; am = fmaxf(am, fmaxf(fmaxf(fabsf(o[j].x), fabsf(o[j].y)), fmaxf(fabsf(o[j].z), fabsf(o[j].w)))); }
#pragma unroll
            for (int of = 1; of < 64; of <<= 1) am = fmaxf(am, __shfl_xor(am, of));
            const float qs = am > 0.f ? 127.f / am : 0.f;
            v4u w; w.x = q8x4(o[0], qs); w.y = q8x4(o[1], qs); w.z = q8x4(o[2], qs); w.w = q8x4(o[3], qs);
            st16_wt((void*)((unsigned char*)F.H + (size_t)(m0 + r) * D + 16 * F.lane), w);
            if (F.lane == 0) __hip_atomic_store(F.rs + m0 + r, am * (1.f / 127.f), __ATOMIC_RELAXED, __HIP_MEMORY_SCOPE_AGENT);
        }
    }
    for (int n = gwv; n < NIN; n += NGW) {
        const float cm = __uint_as_float(F.ctl[CW_CMAX + n]); const float qs = cm > 0.f ? 127.f / cm : 0.f;
        const GAS unsigned long long* src = (const GAS unsigned long long*)(F.WinT + (size_t)n * D) + F.lane;
        unsigned long long q[4];
#pragma unroll
        for (int j = 0; j < 4; ++j) q[j] = src[64 * j];
        unsigned wd[4];
#pragma unroll
        for (int j = 0; j < 4; ++j) { const unsigned lo = (unsigned)q[j], hi = (unsigned)(q[j] >> 32); wd[j] = q8x4((f32x4){bflo(lo), bfhi(lo), bflo(hi), bfhi(hi)}, qs); }
        v4u w; w.x = wd[0]; w.y = wd[1]; w.z = wd[2]; w.w = wd[3];
        st16_wt((void*)(F.Win8 + (size_t)n * D + 16 * F.lane), w);
    }
    for (int n = gwv; n < NQ; n += NGW) {
        const float cm = __uint_as_float(F.ctl[CW_CMAX2 + n]); const float qs = cm > 0.f ? 127.f / cm : 0.f;
        const GAS v4u* src = (const GAS v4u*)(F.WqT + (size_t)n * D + 16 * F.lane);
        const v4u q0 = src[0], q1 = src[1];
        v4u w; w.x = q8x4((f32x4){bflo(q0.x), bfhi(q0.x), bflo(q0.y), bfhi(q0.y)}, qs); w.y = q8x4((f32x4){bflo(q0.z), bfhi(q0.z), bflo(q0.w), bfhi(q0.w)}, qs);
        w.z = q8x4((f32x4){bflo(q1.x), bfhi(q1.x), bflo(q1.y), bfhi(q1.y)}, qs); w.w = q8x4((f32x4){bflo(q1.z), bfhi(q1.z), bflo(q1.w), bfhi(q1.w)}, qs);
        st16_wt((void*)(F.Wq8 + (size_t)n * D + 16 * F.lane), w);
    }
    for (int n = gwv; n < D; n += NGW) {
        const float cm = __uint_as_float(F.ctl[CW_CMAX3 + n]); const float qs = cm > 0.f ? 127.f / cm : 0.f;
        const GAS v4u* src = (const GAS v4u*)(F.WoT + (size_t)n * D + 16 * F.lane);
        const v4u q0 = src[0], q1 = src[1];
        v4u w; w.x = q8x4((f32x4){bflo(q0.x), bfhi(q0.x), bflo(q0.y), bfhi(q0.y)}, qs); w.y = q8x4((f32x4){bflo(q0.z), bfhi(q0.z), bflo(q0.w), bfhi(q0.w)}, qs);
        w.z = q8x4((f32x4){bflo(q1.x), bfhi(q1.x), bflo(q1.y), bfhi(q1.y)}, qs); w.w = q8x4((f32x4){bflo(q1.z), bfhi(q1.z), bflo(q1.w), bfhi(q1.w)}, qs);
        st16_wt((void*)(F.Wo8 + (size_t)n * D + 16 * F.lane), w);
    }
}

__device__ __forceinline__ void unpack8(const v4u w, float* f) { f[0] = bflo(w.x); f[1] = bfhi(w.x); f[2] = bflo(w.y); f[3] = bfhi(w.y); f[4] = bflo(w.z); f[5] = bfhi(w.z); f[6] = bflo(w.w); f[7] = bfhi(w.w); }
__device__ __forceinline__ void p6_conv(Frame& F) {
    const int gwv = blockIdx.x * NWAVES + F.wave, NGW = F.G * NWAVES;
    const int col = 8 * F.lane;
    float cw[3][8], gg[8];
#pragma unroll
    for (int j = 0; j < 3; ++j)
#pragma unroll
        for (int i = 0; i < 8; ++i) cw[j][i] = F.conv_w[j * 512 + col + i];
#pragma unroll
    for (int i = 0; i < 8; ++i) gg[i] = F.group_gain[col + i];
    for (int t0 = gwv * 4; t0 < M; t0 += NGW * 4) {
        const int s0 = t0 & 4095;
        v4u gbw[4], gcw[6], hxw[6];
#pragma unroll
        for (int r = 0; r < 4; ++r) gbw[r] = *(const GAS v4u*)(F.P + (size_t)(t0 + r) * NIN + col);
#pragma unroll
        for (int k = 0; k < 6; ++k) { const int tt = (s0 == 0 && k < 2) ? t0 : (t0 - 2 + k);
            const bf16* rp = F.P + (size_t)tt * NIN + col; gcw[k] = *(const GAS v4u*)(rp + 512); hxw[k] = *(const GAS v4u*)(rp + 1024); }
        float u[6][8];
#pragma unroll
        for (int k = 0; k < 6; ++k) { float gc[8], hx[8]; unpack8(gcw[k], gc); unpack8(hxw[k], hx); const float keep = (s0 == 0 && k < 2) ? 0.f : 1.f;
#pragma unroll
            for (int i = 0; i < 8; ++i) u[k][i] = keep * gc[i] * hx[i]; }
#pragma unroll
        for (int r = 0; r < 4; ++r) {
            float acc[8], gb[8]; unpack8(gbw[r], gb);
            float ss = 0.f;
#pragma unroll
            for (int i = 0; i < 8; ++i) { acc[i] = gb[i] * (cw[0][i] * u[r][i] + cw[1][i] * u[r + 1][i] + cw[2][i] * u[r + 2][i]); ss += acc[i] * acc[i]; }
            ss += __shfl_xor(ss, 1); ss += __shfl_xor(ss, 2); ss += __shfl_xor(ss, 4);
            const float rstd = rsqrtf(ss * (1.f / 64.f) + EPS);
            const float qn = rstd * YQ;
            const unsigned w0 = q8x4c((f32x4){acc[0], acc[1], acc[2], acc[3]}, qn), w1 = q8x4c((f32x4){acc[4], acc[5], acc[6], acc[7]}, qn);
            st8_wt((void*)((unsigned char*)F.Y + (size_t)(t0 + r) * D + col), (unsigned long long)w0 | ((unsigned long long)w1 << 32));
        }
    }
}
__device__ __forceinline__ void p8_resid(Frame& F) {
    const int gwv = blockIdx.x * NWAVES + F.wave, NGW = F.G * NWAVES;
    for (int m0 = gwv * 2; m0 < M; m0 += NGW * 2) {
        const float* md = F.mod + (m0 >> 12) * 6144;
        unsigned long long ow[2][4]; f32x4 xv[2][4];
#pragma unroll
        for (int r = 0; r < 2; ++r) {
            const GAS unsigned long long* orow = (const GAS unsigned long long*)(F.O + (size_t)(m0 + r) * D) + F.lane; const GAS f32x4* xr = (const GAS f32x4*)(F.x + (size_t)(m0 + r) * D) + F.lane;
#pragma unroll
            for (int j = 0; j < 4; ++j) { ow[r][j] = orow[64 * j]; xv[r][j] = xr[64 * j]; } }
        f32x4 gg[4], gs[4], sh[4];
#pragma unroll
        for (int j = 0; j < 4; ++j) { const int col = 4 * F.lane + 256 * j;
            gg[j] = *(const GAS f32x4*)(F.post_gain + col) * *(const GAS f32x4*)(md + 2048 + col);
            gs[j] = *(const GAS f32x4*)(F.fpre_gain + col) * (*(const GAS f32x4*)(md + 4096 + col) + 1.f); sh[j] = *(const GAS f32x4*)(md + 3072 + col); }
#pragma unroll
        for (int r = 0; r < 2; ++r) { const int m = m0 + r;
            f32x4 ov[4]; float ss = 0.f;
#pragma unroll
            for (int j = 0; j < 4; ++j) { const unsigned lo = (unsigned)ow[r][j], hi = (unsigned)(ow[r][j] >> 32); ov[j] = (f32x4){bflo(lo), bfhi(lo), bflo(hi), bfhi(hi)};
                ss += (ov[j].x * ov[j].x + ov[j].y * ov[j].y) + (ov[j].z * ov[j].z + ov[j].w * ov[j].w); }
            const float rstd = rsqrtf(wave_sum(ss) * (1.f / D) + EPS);
            GAS unsigned long long* x1r = (GAS unsigned long long*)(F.QP + (size_t)m * D) + F.lane;
            f32x4 x1[4]; float s2 = 0.f;
#pragma unroll
            for (int j = 0; j < 4; ++j) { x1[j] = xv[r][j] + gg[j] * (ov[j] * rstd); st8_wt((void*)(x1r + 64 * j), (unsigned long long)pk2(x1[j].x, x1[j].y) | ((unsigned long long)pk2(x1[j].z, x1[j].w) << 32));
                s2 += (x1[j].x * x1[j].x + x1[j].y * x1[j].y) + (x1[j].z * x1[j].z + x1[j].w * x1[j].w); }
            const float rstd2 = rsqrtf(wave_sum(s2) * (1.f / D) + EPS);
            f32x4 o[4]; float am = 0.f;
#pragma unroll
            for (int j = 0; j < 4; ++j) { o[j] = x1[j] * rstd2 * gs[j] + sh[j]; am = fmaxf(am, fmaxf(fmaxf(fabsf(o[j].x), fabsf(o[j].y)), fmaxf(fabsf(o[j].z), fabsf(o[j].w)))); }
#pragma unroll
            for (int of = 1; of < 64; of <<= 1) am = fmaxf(am, __shfl_xor(am, of));
            const float qs = am > 0.f ? 119.f / am : 0.f;
#pragma unroll
            for (int j = 0; j < 4; ++j) st4_wt((void*)((unsigned char*)F.H + (size_t)m * D + 4 * F.lane + 256 * j), q8x4(o[j], qs));
            if (F.lane == 0) __hip_atomic_store(F.rs2 + m, am * (1.f / 119.f), __ATOMIC_RELAXED, __HIP_MEMORY_SCOPE_AGENT);
        }
    }
}
typedef float f32x16 __attribute__((ext_vector_type(16)));
__device__ __forceinline__ float vmaxf(float a, float b) { float r; asm("v_max_f32_e32 %0, %1, %2" : "=v"(r) : "v"(a), "v"(b)); return r; }
__device__ __forceinline__ float vminf(float a, float b) { float r; asm("v_min_f32_e32 %0, %1, %2" : "=v"(r) : "v"(a), "v"(b)); return r; }
#define CE_D(a, b) do { const float hi_ = vmaxf(a, b), lo_ = vminf(a, b); a = hi_; b = lo_; } while (0)
template <int N> __device__ __forceinline__ void bitonic_sort_desc(float (&v)[N]) {
#pragma unroll
    for (int k = 2; k <= N; k <<= 1)
#pragma unroll
        for (int j = k >> 1; j > 0; j >>= 1)
#pragma unroll
            for (int i = 0; i < N; ++i) { const int l = i ^ j; if (l > i) { if ((i & k) == 0) CE_D(v[i], v[l]); else CE_D(v[l], v[i]); } }
}
template <int N> __device__ __forceinline__ void bitonic_merge_desc(float (&v)[N]) {
#pragma unroll
    for (int j = N >> 1; j > 0; j >>= 1)
#pragma unroll
        for (int i = 0; i < N; ++i) { const int l = i ^ j; if (l > i) CE_D(v[i], v[l]); }
}
__device__ __forceinline__ void sort16_desc(float (&v)[16]) {
    CE_D(v[0], v[1]); CE_D(v[2], v[3]); CE_D(v[0], v[2]); CE_D(v[1], v[3]); CE_D(v[1], v[2]); CE_D(v[4], v[5]); CE_D(v[6], v[7]); CE_D(v[4], v[6]); CE_D(v[5], v[7]); CE_D(v[5], v[6]); CE_D(v[0], v[4]); CE_D(v[2], v[6]); CE_D(v[2], v[4]); CE_D(v[1], v[5]); CE_D(v[3], v[7]); CE_D(v[3], v[5]); CE_D(v[1], v[2]); CE_D(v[3], v[4]); CE_D(v[5], v[6]); CE_D(v[8], v[9]); CE_D(v[10], v[11]); CE_D(v[8], v[10]); CE_D(v[9], v[11]); CE_D(v[9], v[10]); CE_D(v[12], v[13]); CE_D(v[14], v[15]); CE_D(v[12], v[14]); CE_D(v[13], v[15]); CE_D(v[13], v[14]); CE_D(v[8], v[12]); CE_D(v[10], v[14]); CE_D(v[10], v[12]); CE_D(v[9], v[13]); CE_D(v[11], v[15]); CE_D(v[11], v[13]); CE_D(v[9], v[10]); CE_D(v[11], v[12]); CE_D(v[13], v[14]); CE_D(v[0], v[8]); CE_D(v[4], v[12]); CE_D(v[4], v[8]); CE_D(v[2], v[10]); CE_D(v[6], v[14]); CE_D(v[6], v[10]); CE_D(v[2], v[4]); CE_D(v[6], v[8]); CE_D(v[10], v[12]); CE_D(v[1], v[9]); CE_D(v[5], v[13]); CE_D(v[5], v[9]); CE_D(v[3], v[11]); CE_D(v[7], v[15]); CE_D(v[7], v[11]); CE_D(v[3], v[5]); CE_D(v[7], v[9]); CE_D(v[11], v[13]); CE_D(v[1], v[2]); CE_D(v[3], v[4]); CE_D(v[5], v[6]); CE_D(v[7], v[8]); CE_D(v[9], v[10]); CE_D(v[11], v[12]); CE_D(v[13], v[14]);
}
__device__ __forceinline__ void top16_merge(float (&a)[16], const float (&b)[16]) {
#pragma unroll
    for (int i = 0; i < 16; ++i) a[i] = vmaxf(a[i], b[15 - i]);
    bitonic_merge_desc<16>(a);
}
__device__ __forceinline__ void top16_of_64(const float (&v)[64], float (&out)[16]) {
    float g1[16], g2[16], g3[16];
#pragma unroll
    for (int i = 0; i < 16; ++i) { out[i] = v[i]; g1[i] = v[16 + i]; g2[i] = v[32 + i]; g3[i] = v[48 + i]; }
    sort16_desc(out); sort16_desc(g1); sort16_desc(g2); sort16_desc(g3);
    top16_merge(out, g1); top16_merge(g2, g3); top16_merge(out, g2);
}
constexpr int KROW = 272, KIMG = 128 * KROW;
__device__ __forceinline__ void route_half(const bf16x8 (&bq)[8], const LAS unsigned char* kimg, int r32, int hh, float (&svp)[16], unsigned (&ivp)[16]) {
    const LAS unsigned char* krow = kimg + r32 * KROW + 16 * hh;
    f32x16 acc[4];
#pragma unroll
    for (int nt = 0; nt < 4; ++nt) {
        acc[nt] = (f32x16){0.f, 0.f, 0.f, 0.f, 0.f, 0.f, 0.f, 0.f, 0.f, 0.f, 0.f, 0.f, 0.f, 0.f, 0.f, 0.f};
#pragma unroll
        for (int ks = 0; ks < 8; ++ks) { const bf16x8 ak = *(const LAS bf16x8*)(krow + nt * 32 * KROW + 32 * ks);
            acc[nt] = __builtin_amdgcn_mfma_f32_32x32x16_bf16(ak, bq[ks], acc[nt], 0, 0, 0); }
    }
    float v[64];
#pragma unroll
    for (int nt = 0; nt < 4; ++nt)
#pragma unroll
        for (int i = 0; i < 16; ++i) { const unsigned code = (unsigned)(32 * nt + 8 * (i >> 2) + (i & 3)); v[nt * 16 + i] = __uint_as_float((__float_as_uint(acc[nt][i]) & ~127u) | code); }
    float L[16], Pn[16];
    top16_of_64(v, L);
#pragma unroll
    for (int i = 0; i < 16; ++i) { L[i] = __uint_as_float(__float_as_uint(L[i]) | (unsigned)(hh << 2)); Pn[i] = __shfl_xor(L[i], 32); }
    top16_merge(L, Pn);
#pragma unroll
    for (int i = 0; i < 16; ++i) { const unsigned bits = __float_as_uint(L[i]); svp[i] = __uint_as_float(bits & ~127u); ivp[i] = bits & 127u; }
}
__device__ __forceinline__ void route_finish(const float (&sv)[2][16], const unsigned (&iv)[2][16], LAS unsigned* tab, int lane, int hh, int* epi, float* gpf, float rst) {
#define CAND(a, b) __uint_as_float((__float_as_uint(sv[0][a] + sv[1][b]) & ~255u) | (unsigned)((a) * 16 + (b)))
    float W[16], g1[16], g2[16];
#pragma unroll
    for (int i = 0; i < 16; ++i) W[i] = CAND(0, i);
#pragma unroll
    for (int i = 0; i < 15; ++i) g1[i] = CAND(i + 1, 0);
    g1[15] = -3e38f;
    g2[0] = CAND(1, 1); g2[1] = CAND(1, 2); g2[2] = CAND(1, 3); g2[3] = CAND(1, 4); g2[4] = CAND(1, 5); g2[5] = CAND(1, 6); g2[6] = CAND(1, 7);
    g2[7] = CAND(2, 1); g2[8] = CAND(2, 2); g2[9] = CAND(2, 3); g2[10] = CAND(2, 4); g2[11] = CAND(3, 1); g2[12] = CAND(3, 2); g2[13] = CAND(3, 3); g2[14] = CAND(4, 1); g2[15] = CAND(4, 2);
    sort16_desc(g2);
    g2[13] = vmaxf(g2[13], CAND(7, 1)); g2[14] = vmaxf(g2[14], CAND(6, 1)); g2[15] = vmaxf(g2[15], CAND(5, 1));
    bitonic_merge_desc<16>(g2);
    top16_merge(W, g1); top16_merge(W, g2);
#undef CAND
#pragma unroll
    for (int j = 0; j < 16; ++j) { tab[j * 64 + lane] = iv[0][j]; tab[(16 + j) * 64 + lane] = iv[1][j]; }
    float e[16], sum = 0.f; unsigned ex[16];
    const float s0 = __uint_as_float(__float_as_uint(W[0]) & ~255u);
#pragma unroll
    for (int j = 0; j < 16; ++j) { const unsigned bits = __float_as_uint(W[j]); const unsigned code = bits & 255u;
        e[j] = __expf((__uint_as_float(bits & ~255u) - s0) * rst); sum += e[j];
        ex[j] = tab[(code >> 4) * 64 + lane] * 128u + tab[(16 + (code & 15u)) * 64 + lane]; }
    const float inv = 1.f / sum;
    v4u eo0, eo1; f32x4 go0, go1;
    eo0.x = hh ? ex[8] : ex[0]; eo0.y = hh ? ex[9] : ex[1]; eo0.z = hh ? ex[10] : ex[2]; eo0.w = hh ? ex[11] : ex[3];
    eo1.x = hh ? ex[12] : ex[4]; eo1.y = hh ? ex[13] : ex[5]; eo1.z = hh ? ex[14] : ex[6]; eo1.w = hh ? ex[15] : ex[7];
    go0.x = (hh ? e[8] : e[0]) * inv; go0.y = (hh ? e[9] : e[1]) * inv; go0.z = (hh ? e[10] : e[2]) * inv; go0.w = (hh ? e[11] : e[3]) * inv;
    go1.x = (hh ? e[12] : e[4]) * inv; go1.y = (hh ? e[13] : e[5]) * inv; go1.z = (hh ? e[14] : e[6]) * inv; go1.w = (hh ? e[15] : e[7]) * inv;
    GAS v4u* ep = (GAS v4u*)epi; GAS f32x4* gp = (GAS f32x4*)gpf;
    st16_wt((void*)ep, eo0); st16_wt((void*)(ep + 1), eo1); st16_wt((void*)gp, __builtin_bit_cast(wt_v4u, go0)); st16_wt((void*)(gp + 1), __builtin_bit_cast(wt_v4u, go1));
}
__device__ __forceinline__ pg8::f32x4 i2f(const pg8::f32x4 a) { const pg8::i32x4 i = __builtin_bit_cast(pg8::i32x4, a); return (pg8::f32x4){(float)i[0], (float)i[1], (float)i[2], (float)i[3]}; }
struct EpiRoute {
    static constexpr bool PERM = true, AFTER_DRAIN = true;
    const bf16* keysb; int* eidx; float* gw; const unsigned* cmax2; const float* rs2;
    __device__ __forceinline__ void fused(pg8::f32x4 (&acc)[2][2][4][2], const pg8::Unit& u, int wr, int wc, int fr, int fq, LAS unsigned char* lds, int wid, int lane) const {
        int tid_ = threadIdx.x; asm volatile("" : "+v"(tid_)); const int h = u.pn, r32 = lane & 31, hh = lane >> 5, tid = tid_;
        LAS unsigned char* Qs = lds; LAS unsigned char* Ks = lds + 256 * KROW;
        v4u q1[2][4];
#pragma unroll
        for (int ai = 0; ai < 2; ++ai)
#pragma unroll
            for (int m = 0; m < 4; ++m) { const pg8::f32x4 a = i2f(acc[ai][1][m][0]), b = i2f(acc[ai][1][m][1]);
                q1[ai][m] = (v4u){pg8::cvt_pk_bf16(a[0], a[1]), pg8::cvt_pk_bf16(a[2], a[3]), pg8::cvt_pk_bf16(b[0], b[1]), pg8::cvt_pk_bf16(b[2], b[3])}; }
        float sv[2][16]; unsigned iv[2][16];
#pragma unroll
        for (int p = 0; p < 2; ++p) {
            if (p == 1) { asm volatile("s_waitcnt lgkmcnt(0)" ::: "memory"); __builtin_amdgcn_s_barrier(); asm volatile("" ::: "memory"); }
#pragma unroll
            for (int ai = 0; ai < 2; ++ai)
#pragma unroll
                for (int m = 0; m < 4; ++m) { v4u w;
                    if (p == 0) { const pg8::f32x4 a = i2f(acc[ai][0][m][0]), b = i2f(acc[ai][0][m][1]);
                        w = (v4u){pg8::cvt_pk_bf16(a[0], a[1]), pg8::cvt_pk_bf16(a[2], a[3]), pg8::cvt_pk_bf16(b[0], b[1]), pg8::cvt_pk_bf16(b[2], b[3])}; }
                    else w = q1[ai][m];
                    *(LAS v4u*)(Qs + (128 * ai + 64 * wr + 16 * m + fr) * KROW + (32 * wc + 8 * fq) * 2) = w; }
            { const int ch = tid & 15; const pg8::u32x4 c0 = *(const pg8::u32x4*)(cmax2 + h * 256 + p * 128 + ch * 8), c1 = *(const pg8::u32x4*)(cmax2 + h * 256 + p * 128 + ch * 8 + 4);
              float cs[8] = {__uint_as_float(c0.x), __uint_as_float(c0.y), __uint_as_float(c0.z), __uint_as_float(c0.w), __uint_as_float(c1.x), __uint_as_float(c1.y), __uint_as_float(c1.z), __uint_as_float(c1.w)};
#pragma unroll
              for (int i = 0; i < 8; ++i) cs[i] *= (1.f / 127.f);
              for (int c = tid; c < 128 * 16; c += NWAVES * 64) { const int row = c >> 4;
                const v4u kq = *(const GAS v4u*)(keysb + (size_t)((h * 2 + p) * 128 + row) * 128 + ch * 8);
                v4u ko; ko.x = pk2(bflo(kq.x) * cs[0], bfhi(kq.x) * cs[1]); ko.y = pk2(bflo(kq.y) * cs[2], bfhi(kq.y) * cs[3]); ko.z = pk2(bflo(kq.z) * cs[4], bfhi(kq.z) * cs[5]); ko.w = pk2(bflo(kq.w) * cs[6], bfhi(kq.w) * cs[7]);
                *(LAS v4u*)(Ks + row * KROW + ch * 16) = ko; } }
            asm volatile("s_waitcnt vmcnt(0) lgkmcnt(0)" ::: "memory"); __builtin_amdgcn_s_barrier(); asm volatile("" ::: "memory");
            bf16x8 bq[8];
#pragma unroll
            for (int ks = 0; ks < 8; ++ks) bq[ks] = *(const LAS bf16x8*)(Qs + (32 * wid + r32) * KROW + 32 * ks + 16 * hh);
            route_half(bq, Ks, r32, hh, sv[p], iv[p]);
        }
        asm volatile("s_waitcnt lgkmcnt(0)" ::: "memory"); __builtin_amdgcn_s_barrier(); asm volatile("" ::: "memory");
        const int t = u.pm * 256 + 32 * wid + r32;
        route_finish(sv, iv, (LAS unsigned*)(lds + wid * 8192), lane, hh, eidx + (size_t)t * 128 + h * 16 + 8 * hh, gw + (size_t)t * 128 + h * 16 + 8 * hh, rs2[t]);
        asm volatile("s_waitcnt lgkmcnt(0)" ::: "memory"); __builtin_amdgcn_s_barrier(); asm volatile("" ::: "memory");
    }
};
struct OneUnit {
    pg8::Unit u;
    __device__ __forceinline__ bool next(int i, pg8::Unit& o) const { if (i != 0) return false; o = u; return true; }
    __device__ __forceinline__ void a_ready(const pg8::Unit&) const {}
    __device__ __forceinline__ void done(const pg8::Unit&) const {}
};
__device__ __forceinline__ float gelu_tanh(float a) {
    const float z = 0.7978845608028654f * (a + 0.044715f * a * a * a);
    const float e = __expf(2.f * z);
    const float th = 1.f - 2.f / (e + 1.f);
    return 0.5f * a * (1.f + th);
}
typedef float f32x2v __attribute__((ext_vector_type(2)));
__device__ __forceinline__ void fp8x16_to_f32(const v4u w, float* f) {
    f32x2v t;
    t = __builtin_amdgcn_cvt_pk_f32_fp8((int)w.x, false); f[0] = t.x; f[1] = t.y; t = __builtin_amdgcn_cvt_pk_f32_fp8((int)w.x, true); f[2] = t.x; f[3] = t.y;
    t = __builtin_amdgcn_cvt_pk_f32_fp8((int)w.y, false); f[4] = t.x; f[5] = t.y; t = __builtin_amdgcn_cvt_pk_f32_fp8((int)w.y, true); f[6] = t.x; f[7] = t.y;
    t = __builtin_amdgcn_cvt_pk_f32_fp8((int)w.z, false); f[8] = t.x; f[9] = t.y; t = __builtin_amdgcn_cvt_pk_f32_fp8((int)w.z, true); f[10] = t.x; f[11] = t.y;
    t = __builtin_amdgcn_cvt_pk_f32_fp8((int)w.w, false); f[12] = t.x; f[13] = t.y; t = __builtin_amdgcn_cvt_pk_f32_fp8((int)w.w, true); f[14] = t.x; f[15] = t.y;
}
#define DPPF(x, ctrl) __uint_as_float((unsigned)__builtin_amdgcn_mov_dpp((int)__float_as_uint(x), ctrl, 0xf, 0xf, true))
__device__ __forceinline__ void swap16_add(float& a, float b) { auto r = __builtin_amdgcn_permlane16_swap(__float_as_uint(a), __float_as_uint(b), false, false); a = __uint_as_float(r[0]) + __uint_as_float(r[1]); }
__device__ __forceinline__ void swap32_add(float& a, float b) { auto r = __builtin_amdgcn_permlane32_swap(__float_as_uint(a), __float_as_uint(b), false, false); a = __uint_as_float(r[0]) + __uint_as_float(r[1]); }
constexpr int PW_BUF0 = 0, PW_SG = 4096, PW_BUF1 = 8192, PW_E = 16384, PW_WH = 17408, PW_WL = 17920, PW_YP = 18432, PW_IK = 18944, PW_BYTES = 18976;
static_assert(PW_BYTES * NWAVES <= LDSCTL_OFF, "PEER per-wave LDS blocks must stay below the control words");
typedef int v8i_t __attribute__((ext_vector_type(8)));
typedef int v2i_t __attribute__((ext_vector_type(2)));
__device__ __forceinline__ void peer_u_issue(v4u (&uw)[8], const unsigned char* U4, LAS unsigned char* wl, int it, int lane) {
    const int grp = it >> 2, j = it & 3, hw = lane >> 5, li = lane & 31;
#pragma unroll
    for (int q = 0; q < 8; ++q) { const unsigned e = *(const LAS unsigned short*)(wl + PW_E + (j * 128 + grp * 16 + 2 * q + hw) * 2);
        uw[q] = *(const GAS v4u*)(U4 + (e * 512u + 16u * (unsigned)li)); }
}
__device__ __forceinline__ void peer_u_compute(const v4u (&uw)[8], LAS unsigned char* wl, int it, int lane) {
    const int grp = it >> 2, j = it & 3, li = lane & 31;
    const v4u hh = *(LAS v4u*)(wl + j * 1024 + 16 * li), hl = *(LAS v4u*)(wl + j * 1024 + 512 + 16 * li);
    float pa[8];
#pragma unroll
    for (int q = 0; q < 8; ++q) {
        int dh = __builtin_amdgcn_sdot8((int)uw[q].x, (int)hh.x, 0, false); dh = __builtin_amdgcn_sdot8((int)uw[q].y, (int)hh.y, dh, false);
        dh = __builtin_amdgcn_sdot8((int)uw[q].z, (int)hh.z, dh, false); dh = __builtin_amdgcn_sdot8((int)uw[q].w, (int)hh.w, dh, false);
        int dl = __builtin_amdgcn_sdot8((int)uw[q].x, (int)hl.x, 0, false); dl = __builtin_amdgcn_sdot8((int)uw[q].y, (int)hl.y, dl, false);
        dl = __builtin_amdgcn_sdot8((int)uw[q].z, (int)hl.z, dl, false); dl = __builtin_amdgcn_sdot8((int)uw[q].w, (int)hl.w, dl, false);
        pa[q] = (float)(16 * dh + dl); }
    swap16_add(pa[0], pa[4]); swap16_add(pa[1], pa[5]); swap16_add(pa[2], pa[6]); swap16_add(pa[3], pa[7]);
#pragma unroll
    for (int i = 0; i < 4; ++i) { pa[i] += DPPF(pa[i], 0xB1); pa[i] += DPPF(pa[i], 0x4E); pa[i] += DPPF(pa[i], 0x141); pa[i] += DPPF(pa[i], 0x140); }
    if ((lane & 12) == 0) {
        const int q = lane & 3, r = lane >> 4;
        const int idx = j * 128 + grp * 16 + 2 * (q + 4 * (r & 1)) + (r >> 1);
        const f32x2v sg = *(const LAS f32x2v*)(wl + PW_SG + idx * 8);
        const float a = (q == 0 ? pa[0] : q == 1 ? pa[1] : q == 2 ? pa[2] : pa[3]) * sg.x;
        *(LAS float*)(wl + PW_BUF1 + idx * 4) = sg.y * gelu_tanh(a);
    }
}
__device__ __forceinline__ void peer_v_issue(const unsigned char* V8, LAS unsigned char* wl, unsigned lbase, int it, int lane, unsigned c16e, unsigned c16o) {
    const int sl = it >> 3, j = (it >> 1) & 3, hf = it & 1;
    const unsigned char* vbase = V8 + (size_t)sl * (NEXP * 128);
    const unsigned dst = lbase + PW_BUF0 + (it & 1) * 8192;
    unsigned go[8];
#pragma unroll
    for (int q = 0; q < 8; ++q) { const unsigned e = *(const LAS unsigned short*)(wl + PW_E + (j * 128 + 64 * hf + 8 * q + (lane >> 3)) * 2); go[q] = e * 128u + ((q & 1) ? c16o : c16e); }
#pragma unroll
    for (int q = 0; q < 8; ++q) attn_body::glds16s(vbase, go[q], (unsigned)__builtin_amdgcn_readfirstlane((int)(dst + q * 1024)));
}
__device__ __forceinline__ void peer_v_compute(LAS unsigned char* wl, f32x4 (&acc)[8], bf16* yrow0, int it, int lane) {
    const int sl = it >> 3, j = (it >> 1) & 3, hf = it & 1;
    const int m = lane & 15, kg = lane >> 4;
    const LAS unsigned char* wsrc = wl + ((m & 1) ? PW_WL : PW_WH) + j * 128 + 64 * hf + 16 * (kg & 1);
    const v4u a0 = *(const LAS v4u*)wsrc, a1 = *(const LAS v4u*)(wsrc + 32);
    const bool valid = (m < 4) && ((m >> 1) == (kg >> 1));
    v8i_t A;
    A[0] = valid ? (int)a0.x : 0; A[1] = valid ? (int)a0.y : 0; A[2] = valid ? (int)a0.z : 0; A[3] = valid ? (int)a0.w : 0;
    A[4] = valid ? (int)a1.x : 0; A[5] = valid ? (int)a1.y : 0; A[6] = valid ? (int)a1.z : 0; A[7] = valid ? (int)a1.w : 0;
    if (hf == 0) {
#pragma unroll
        for (int T = 0; T < 8; ++T) acc[T] = (f32x4){0.f, 0.f, 0.f, 0.f};
    }
    const LAS unsigned char* bb = wl + PW_BUF0 + (it & 1) * 8192 + (32 * (kg >> 1) + m) * 128 + 8 * (kg & 1);
    const unsigned x16 = (unsigned)(m >> 1) * 16u;
#pragma unroll
    for (int T = 0; T < 8; ++T) {
        const LAS unsigned char* p = bb + ((16u * T) ^ x16);
        const v2i_t b0 = __builtin_amdgcn_ds_read_tr4_b64_v2i32((LAS v2i_t*)p), b1 = __builtin_amdgcn_ds_read_tr4_b64_v2i32((LAS v2i_t*)(p + 2048));
        const v8i_t B = {b0.x, b0.y, b1.x, b1.y, 0, 0, 0, 0};
        acc[T] = __builtin_amdgcn_mfma_scale_f32_16x16x128_f8f6f4(A, B, acc[T], 0, 4, 0, 0x7f7f7f7f, 0, 0x7f7f7f7f);
    }
    if (hf == 1) {
        const float ik = *(const LAS float*)(wl + PW_IK + j * 4);
        LAS unsigned char* yp = lane < 16 ? wl + PW_YP + m * 2 : wl + PW_IK + 16;
        const int ystep = lane < 16 ? 1 : 0;
#pragma unroll
        for (int T = 0; T < 8; ++T) {
            *(LAS unsigned short*)(yp + ystep * (64 * T)) = (unsigned short)f2bf((acc[T][0] + acc[T][1]) * ik);
            *(LAS unsigned short*)(yp + ystep * (64 * T + 32)) = (unsigned short)f2bf((acc[T][2] + acc[T][3]) * ik);
        }
        asm volatile("" ::: "memory");
        const unsigned long long pk = *(const LAS unsigned long long*)(wl + PW_YP + 8 * lane);
        *(GAS unsigned long long*)(yrow0 + (size_t)j * D + 256 * sl + 4 * lane) = pk;
    }
}
__device__ __forceinline__ void p11_peer(Frame& F, float* dst) {
    const int gwv = blockIdx.x * NWAVES + F.wave, NGW = F.G * NWAVES, lane = F.lane;
    LAS unsigned char* wl = F.lds + F.wave * PW_BYTES;
    const unsigned lbase = (unsigned)__builtin_amdgcn_readfirstlane((int)(unsigned)(size_t)wl);
    const unsigned c16e = (unsigned)(((lane & 7) ^ (lane >> 4)) * 16), c16o = (unsigned)(((lane & 7) ^ (4 + (lane >> 4))) * 16);
    const unsigned char* U8 = F.U8; const unsigned char* V8 = F.V8;
    for (int t0 = gwv * 4; t0 < M; t0 += NGW * 4) {
        bf16* yrow0 = F.Y + (size_t)t0 * D;
#pragma unroll
        for (int j = 0; j < 4; ++j) {
            const int t = t0 + j;
            const v4u hq = *(const GAS v4u*)((const unsigned char*)F.H + (size_t)t * D + 16 * lane);
            const float hinv = F.rs2[t];
            const unsigned hw[4] = {hq.x, hq.y, hq.z, hq.w};
            unsigned hh0 = 0u, hh1 = 0u, hl0 = 0u, hl1 = 0u;
#pragma unroll
            for (int i = 0; i < 16; ++i) { const int hv_ = (int)(signed char)((hw[i >> 2] >> (8 * (i & 3))) & 0xffu); const int lo = ((hv_ + 8) & 15) - 8; const int hi = (hv_ - lo) >> 4;
                if (i < 8) { hh0 |= (unsigned)(hi & 15) << (4 * i); hl0 |= (unsigned)(lo & 15) << (4 * i); } else { hh1 |= (unsigned)(hi & 15) << (4 * (i - 8)); hl1 |= (unsigned)(lo & 15) << (4 * (i - 8)); } }
            *(LAS unsigned long long*)(wl + j * 1024 + 8 * lane) = (unsigned long long)hh0 | ((unsigned long long)hh1 << 32);
            *(LAS unsigned long long*)(wl + j * 1024 + 512 + 8 * lane) = (unsigned long long)hl0 | ((unsigned long long)hl1 << 32);
            const int e0 = F.eidx[(size_t)t * 128 + lane], e1 = F.eidx[(size_t)t * 128 + 64 + lane];
            const f32x2v sg0 = (f32x2v){F.su[e0] * hinv, F.gw[(size_t)t * 128 + lane] * F.sv[e0]}, sg1 = (f32x2v){F.su[e1] * hinv, F.gw[(size_t)t * 128 + 64 + lane] * F.sv[e1]};
            int base = 0;
#pragma unroll
            for (int sl = 0; sl < 4; ++sl) {
                const bool m0 = (e0 >> 12) == sl, m1 = (e1 >> 12) == sl;
                const unsigned long long b0 = __ballot(m0), b1 = __ballot(m1);
                const int c0 = __popcll(b0), c1 = __popcll(b1);
                const int p0 = j * 128 + base + __builtin_amdgcn_mbcnt_hi((unsigned)(b0 >> 32), __builtin_amdgcn_mbcnt_lo((unsigned)b0, 0));
                const int p1 = j * 128 + base + c0 + __builtin_amdgcn_mbcnt_hi((unsigned)(b1 >> 32), __builtin_amdgcn_mbcnt_lo((unsigned)b1, 0));
                if (m0) { *(LAS unsigned short*)(wl + PW_E + p0 * 2) = (unsigned short)e0; *(LAS f32x2v*)(wl + PW_SG + p0 * 8) = sg0; }
                if (m1) { *(LAS unsigned short*)(wl + PW_E + p1 * 2) = (unsigned short)e1; *(LAS f32x2v*)(wl + PW_SG + p1 * 8) = sg1; }
                base += c0 + c1;
            }
        }
        asm volatile("" ::: "memory");
        {
            v4u ua[8], ub[8];
            peer_u_issue(ua, U8, wl, 0, lane);
#pragma unroll 1
            for (int it = 0; it < 32; it += 2) {
                peer_u_issue(ub, U8, wl, it + 1, lane);
                __builtin_amdgcn_sched_barrier(0);
                peer_u_compute(ua, wl, it, lane);
                __builtin_amdgcn_sched_barrier(0);
                if (it + 2 < 32) peer_u_issue(ua, U8, wl, it + 2, lane);
                __builtin_amdgcn_sched_barrier(0);
                peer_u_compute(ub, wl, it + 1, lane);
                __builtin_amdgcn_sched_barrier(0);
            }
        }
#pragma unroll
        for (int j = 0; j < 4; ++j) {
            const float w0 = *(const LAS float*)(wl + PW_BUF1 + (j * 128 + lane) * 4), w1 = *(const LAS float*)(wl + PW_BUF1 + (j * 128 + 64 + lane) * 4);
            float mx = fmaxf(fabsf(w0), fabsf(w1));
#pragma unroll
            for (int o = 1; o < 64; o <<= 1) mx = fmaxf(mx, __shfl_xor(mx, o));
            int ex = (int)((__float_as_uint(mx) >> 23) & 0xffu); ex = ex < 30 ? 127 : ex;
            const float sc = __uint_as_float((unsigned)(127 + 7 + 127 - ex) << 23), isc = __uint_as_float((unsigned)(ex - 7) << 23);
            const float s0 = w0 * sc, s1 = w1 * sc;
            const int ph = __builtin_amdgcn_cvt_pk_fp8_f32(s0, s1, 0, false);
            const f32x2v hb = __builtin_amdgcn_cvt_pk_f32_fp8(ph, false);
            const int pl = __builtin_amdgcn_cvt_pk_fp8_f32(s0 - hb.x, s1 - hb.y, 0, false);
            *(LAS unsigned char*)(wl + PW_WH + j * 128 + lane) = (unsigned char)(ph & 0xff); *(LAS unsigned char*)(wl + PW_WH + j * 128 + 64 + lane) = (unsigned char)((ph >> 8) & 0xff);
            *(LAS unsigned char*)(wl + PW_WL + j * 128 + lane) = (unsigned char)(pl & 0xff); *(LAS unsigned char*)(wl + PW_WL + j * 128 + 64 + lane) = (unsigned char)((pl >> 8) & 0xff);
            if (lane == 0) *(LAS float*)(wl + PW_IK + j * 4) = isc;
        }
        v4u x1w[4][2];
#pragma unroll
        for (int j = 0; j < 4; ++j) { const GAS v4u* op = (const GAS v4u*)(F.QP + (size_t)(t0 + j) * D + 16 * lane); x1w[j][0] = op[0]; x1w[j][1] = op[1]; }
        asm volatile("s_waitcnt lgkmcnt(0)" ::: "memory");
        {
            f32x4 acc[8];
            peer_v_issue(V8, wl, lbase, 0, lane, c16e, c16o);
#pragma unroll 1
            for (int it = 0; it < 32; it += 2) {
                peer_v_issue(V8, wl, lbase, it + 1, lane, c16e, c16o);
                asm volatile("s_waitcnt vmcnt(8)" ::: "memory");
                peer_v_compute(wl, acc, yrow0, it, lane);
                asm volatile("s_waitcnt lgkmcnt(0)" ::: "memory");
                if (it + 2 < 32) { peer_v_issue(V8, wl, lbase, it + 2, lane, c16e, c16o); asm volatile("s_waitcnt vmcnt(8)" ::: "memory"); }
                else asm volatile("s_waitcnt vmcnt(0)" ::: "memory");
                peer_v_compute(wl, acc, yrow0, it + 1, lane);
                asm volatile("s_waitcnt lgkmcnt(0)" ::: "memory");
            }
        }
        asm volatile("s_waitcnt vmcnt(0)" ::: "memory");
#pragma unroll
        for (int j = 0; j < 4; ++j) {
            const int t = t0 + j, b = t >> 12;
            float yv[16];
            { const GAS v4u* yp = (const GAS v4u*)(yrow0 + (size_t)j * D + 16 * lane); const v4u y0 = yp[0], y1 = yp[1]; unpack8(y0, yv); unpack8(y1, yv + 8); }
            float ss = 0.f;
#pragma unroll
            for (int i = 0; i < 16; ++i) ss += yv[i] * yv[i];
            const float rstd = rsqrtf(wave_sum(ss) * (1.f / D) + EPS);
            GAS f32x4* dp = (GAS f32x4*)(dst + (size_t)t * D + 16 * lane);
            const GAS f32x4* gp = (const GAS f32x4*)(F.fpost_gain + 16 * lane);
            const GAS f32x4* g2p = (const GAS f32x4*)(F.mod + b * 6144 + 5120 + 16 * lane);
            float x1f[16]; unpack8(x1w[j][0], x1f); unpack8(x1w[j][1], x1f + 8);
#pragma unroll
            for (int i = 0; i < 4; ++i) { const f32x4 x1 = (f32x4){x1f[4 * i], x1f[4 * i + 1], x1f[4 * i + 2], x1f[4 * i + 3]}, g = gp[i], g2 = g2p[i];
                const f32x4 y = (f32x4){yv[4 * i], yv[4 * i + 1], yv[4 * i + 2], yv[4 * i + 3]};
                dp[i] = x1 + g2 * (y * rstd * g); }
        }
    }
}

__device__ __forceinline__ unsigned long long ldp(const Frame& F, int i) {
    volatile LAS unsigned* pt = (volatile LAS unsigned*)(F.lds + LDSCTL_OFF);
    const unsigned lo = pt[2 * i], hi = pt[2 * i + 1];
    return ((unsigned long long)(unsigned)__builtin_amdgcn_readfirstlane((int)hi) << 32) | (unsigned)__builtin_amdgcn_readfirstlane((int)lo);
}
__device__ __forceinline__ void load_frame(Frame& F) {
    F.lane = lane_id_fresh(); F.tid = F.wave * 64 + F.lane;
    F.x = (const float*)ldp(F, 0); F.c = (const float*)ldp(F, 1); F.ada_w = (const float*)ldp(F, 2); F.ada_b = (const float*)ldp(F, 3); F.pre_gain = (const float*)ldp(F, 4); F.post_gain = (const float*)ldp(F, 5);
    F.w_in = (const float*)ldp(F, 6); F.conv_w = (const float*)ldp(F, 7); F.group_gain = (const float*)ldp(F, 8); F.w_out = (const float*)ldp(F, 9); F.fpre_gain = (const float*)ldp(F, 10); F.fpost_gain = (const float*)ldp(F, 11);
    F.wq = (const float*)ldp(F, 12); F.keys = (const float*)ldp(F, 13); F.pu = (const float*)ldp(F, 14); F.pv = (const float*)ldp(F, 15);
    F.out = (float*)ldp(F, 16);
    unsigned char* ws = (unsigned char*)ldp(F, 17);
    F.ctl = (gu32*)(ws + WS_CTL);
    F.mod = (float*)(ws + WS_MOD); F.kmean = (float*)(ws + WS_KMEAN); F.keysb = (bf16*)(ws + WS_KEYS);
    F.WinT = (bf16*)(ws + WS_WIN); F.WoT = (bf16*)(ws + WS_WO); F.WqT = (bf16*)(ws + WS_WQ); F.eidx = (int*)(ws + WS_EIDX); F.gw = (float*)(ws + WS_G);
    F.U8 = ws + WS_U; F.V8 = ws + WS_V; F.su = (float*)(ws + WS_SU); F.sv = (float*)(ws + WS_SV); F.H = (bf16*)(ws + WS_H);
    F.P = (bf16*)(ws + WS_P); F.QP = (bf16*)(ws + WS_QP); F.O = (bf16*)(ws + WS_O); F.Y = (bf16*)(ws + WS_Y); F.scratch = (float*)(ws + WS_O); F.Win8 = ws + WS_WIN8; F.rs = (float*)(ws + WS_RS); F.Wq8 = ws + WS_WQ8; F.rs2 = (float*)(ws + WS_RS2); F.Wo8 = ws + WS_WO8;
}
struct StagOrder {
    attn_body::StaticOrder base; Frame* F; bool mid;
    __device__ __forceinline__ bool next(int i, attn_body::AttnUnit& u) const { return base.next(i, u); }
    __device__ __forceinline__ void a_ready(const attn_body::AttnUnit&) const {}
    __device__ __forceinline__ void done(const attn_body::AttnUnit& u) const { if (mid && u.qb >= 8) { load_frame(*F); p0_tables(*F); p6_conv(*F); } }
};
struct Args { const float* in[16]; float* out; unsigned char* ws; int ph_lo, ph_hi; };
constexpr int NPHASE = 12;
template <unsigned PM> __global__ void __launch_bounds__(NWAVES * 64, 2) fwd_kernel(Args args) {
    extern __shared__ __attribute__((aligned(16))) unsigned char lds[];
    Frame F;
    F.lds = (LAS unsigned char*)lds;
    F.MISC = (volatile LAS unsigned*)(F.lds + MISC_OFF);
    F.tid = threadIdx.x; F.lane = F.tid & 63; F.wave = __builtin_amdgcn_readfirstlane(F.tid >> 6);
    F.G = gridDim.x;
    for (int u = F.tid; u < (LDS_BYTES - LDSCTL_OFF) / 4; u += NWAVES * 64) ((LAS unsigned*)(F.lds + LDSCTL_OFF))[u] = 0u;
    __syncthreads();
    if (F.tid == 0) { LAS unsigned long long* pt = (LAS unsigned long long*)(F.lds + LDSCTL_OFF);
#pragma unroll
        for (int i = 0; i < 16; ++i) pt[i] = (unsigned long long)args.in[i];
        pt[16] = (unsigned long long)args.out; pt[17] = (unsigned long long)args.ws; }
    __syncthreads();
    load_frame(F);
    const int lo = args.ph_lo, hi = args.ph_hi;
    const bool multi = (hi - lo) > 1;
    XcdBarrier bar; bar.bar = (unsigned*)(F.ctl + CW_BAR); bar.x = 0; bar.st = nullptr;
    if (multi) bar = xcd_barrier_post((unsigned*)(F.ctl + CW_BAR), F.MISC + 8);
#define IN(k) ((((PM) >> (k)) & 1u) && lo <= (k) && (k) < hi)
#define BOTH(k) (IN(k) && IN((k) + 1))
#ifndef SEAMREP
#define SEAMREP 1
#endif
#define SEAM(k) do { if (BOTH(k)) { for (int sr_ = 0; sr_ < SEAMREP; ++sr_) xcd_barrier(bar); } } while (0)
#ifndef REPMASK
#define REPMASK 0x000u
#endif
#define REPS(k) (1 + (int)(((REPMASK) >> (k)) & 1u))
    if (IN(0)) { load_frame(F); for (int r = 0; r < REPS(0); ++r) { p0_prep(F); __syncthreads(); } SEAM(0); }
    if (IN(1)) { load_frame(F); for (int r = 0; r < REPS(1); ++r) p1_hnorm(F); SEAM(1); }
    if (IN(2)) { load_frame(F);
        pg8::Gemm g{F.H, (const bf16*)F.Win8, M, NIN, D / 2}; pg8::StaticOrder So; So.init(M, NIN, F.G, (int)blockIdx.x);
        pg8::EpiBf16S<true> E{F.P, NIN, 6, 8, C2, F.kmean, 8, 10, F.rs, (const unsigned*)(F.ctl + CW_CMAX)};
        for (int r = 0; r < REPS(2); ++r) pg8::gemm_phase<pg8::EpiBf16S<true>, pg8::StaticOrder, true, true, false, true>(F.lds, g, So, E);
        if (IN(2) && IN(5)) { for (int sr_ = 0; sr_ < SEAMREP; ++sr_) xcd_barrier(bar); }
    }
    if (IN(5) && IN(6)) {
        const int sgrp = ((int)blockIdx.x >> 3) % 3;
        if (sgrp == 0) { load_frame(F); p0_tables(F); p6_conv(F); }
        { load_frame(F);
          const attn_body::AttnTensors AT{(const attn_body::bf16*)(F.P + 1536), (const attn_body::bf16*)(F.P + 2048), (const attn_body::bf16*)(F.P + 2560), (attn_body::bf16*)((unsigned char*)F.Y + 512), F.kmean, F.group_gain + 512};
          const StagOrder So{attn_body::StaticOrder((int)F.G, (int)blockIdx.x), &F, sgrp == 1};
          attn_body::attn_phase<StagOrder>((char*)lds, AT, So); }
        if (sgrp == 2) { load_frame(F); p0_tables(F); p6_conv(F); }
    }
    if (IN(6)) { SEAM(6); }
    if (IN(7)) { load_frame(F);
        pg8::Gemm g{F.Y, (const bf16*)F.Wo8, M, D, D / 2}; pg8::StaticOrder So; So.init(M, D, F.G, (int)blockIdx.x);
        pg8::EpiBf16S<true> E{F.O, D, 0, 0, 1.f, nullptr, 0, 0, nullptr, (const unsigned*)(F.ctl + CW_CMAX3)};
        for (int r = 0; r < REPS(7); ++r) pg8::gemm_phase<pg8::EpiBf16S<true>, pg8::StaticOrder, true, true, false, true>(F.lds, g, So, E);
        SEAM(7);
    }
    if (IN(8)) { load_frame(F); for (int r = 0; r < REPS(8); ++r) p8_resid(F); SEAM(8); }
    if (IN(9)) { load_frame(F);
        pg8::Gemm g{F.H, (const bf16*)F.Wq8, M, NQ, D / 2}; pg8::StaticOrder So; So.init(M, NQ, F.G, (int)blockIdx.x);
        EpiRoute E{F.keysb, F.eidx, F.gw, (const unsigned*)(F.ctl + CW_CMAX2), F.rs2};
        for (int r = 0; r < REPS(9); ++r)
            for (int i = 0; ; ++i) { OneUnit S1; if (!So.next(i, S1.u)) break; pg8::gemm_phase<EpiRoute, OneUnit, false, true, false, true>(F.lds, g, S1, E); }
        if (IN(9) && IN(11)) { for (int sr_ = 0; sr_ < SEAMREP; ++sr_) xcd_barrier(bar); }
    }
    if (IN(11)) { load_frame(F); if (REPS(11) > 1) p11_peer(F, F.scratch); p11_peer(F, F.out); }
#undef IN
#undef BOTH
#undef SEAM
}

#ifndef PMASK
#define PMASK 0xfffu
#endif
#ifndef N_LAUNCH_MODE
#define N_LAUNCH_MODE 1
#endif
template <unsigned PM> static bool set_lds() { return hipFuncSetAttribute((const void*)fwd_kernel<PM>, hipFuncAttributeMaxDynamicSharedMemorySize, LDS_BYTES) == hipSuccess; }
template <unsigned PM> static void launch1(int grid, hipStream_t stream, Args a) { hipLaunchKernelGGL(fwd_kernel<PM>, dim3(grid), dim3(NWAVES * 64), LDS_BYTES, stream, a); }
extern "C" void kernel_launch(void* const* d_in, const int* in_sizes, int n_in, void* d_out, int out_size, void* d_ws, size_t ws_size, hipStream_t stream) {
    static int grid = 0;
    if (grid == 0) {
        if (n_in != 16 || out_size != M * D || ws_size < WS_END) { fprintf(stderr, "kernel_launch: unexpected shapes n_in %d out %d ws %zu\n", n_in, out_size, ws_size); grid = -1; return; }
        int dev = 0, cus = 0;
        if (hipGetDevice(&dev) != hipSuccess || hipDeviceGetAttribute(&cus, hipDeviceAttributeMultiprocessorCount, dev) != hipSuccess) { grid = -1; return; }
        bool ok = true;
#if N_LAUNCH_MODE == 1
        ok = set_lds<PMASK>();
#elif N_LAUNCH_MODE == 3
        ok = set_lds<0x3ffu>() && set_lds<0x400u>() && set_lds<0x800u>();
#else
        ok = set_lds<1u>() && set_lds<2u>() && set_lds<4u>() && set_lds<8u>() && set_lds<16u>() && set_lds<32u>() && set_lds<64u>() && set_lds<128u>() && set_lds<256u>() && set_lds<512u>() && set_lds<1024u>() && set_lds<2048u>();
#endif
        if (!ok) { fprintf(stderr, "kernel_launch: hipFuncSetAttribute failed\n"); grid = -1; return; }
        grid = cus;
    }
    if (grid < 0) return;
    (void)hipMemsetAsync((char*)d_ws + WS_CTL, 0, CTL_ZERO_BYTES, stream);
    Args a{};
    for (int i = 0; i < 16; ++i) a.in[i] = (const float*)d_in[i];
    a.out = (float*)d_out; a.ws = (unsigned char*)d_ws;
#if N_LAUNCH_MODE == 1
    a.ph_lo = 0; a.ph_hi = NPHASE; launch1<PMASK>(grid, stream, a);
#elif N_LAUNCH_MODE == 3
    a.ph_lo = 0; a.ph_hi = 10; launch1<0x3ffu>(grid, stream, a);
    a.ph_lo = 10; a.ph_hi = 11; launch1<0x400u>(grid, stream, a);
    a.ph_lo = 11; a.ph_hi = 12; launch1<0x800u>(grid, stream, a);
#else
#define L1(p) do { a.ph_lo = (p); a.ph_hi = (p) + 1; launch1<(1u << (p))>(grid, stream, a); } while (0)
    L1(0); L1(1); L1(2); L1(3); L1(4); L1(5); L1(6); L1(7); L1(8); L1(9); L1(10); L1(11);
#undef L1
#endif
}
```

```cpp
#include <hip/hip_runtime.h>
#include <cstdio>
#include <cstdint>
#ifndef WT_STORES
#define WT_STORES 1
#endif
typedef unsigned wt_v4u __attribute__((ext_vector_type(4)));
__device__ __forceinline__ int lane_id_fresh() { int l; asm volatile("v_mbcnt_lo_u32_b32 %0, -1, 0\n\tv_mbcnt_hi_u32_b32 %0, -1, %0" : "=v"(l)); return l; }
__device__ __forceinline__ void st16_wt(void* p, wt_v4u v) {
#if WT_STORES
    asm volatile("global_store_dwordx4 %0, %1, off sc1\n\ts_nop 1" :: "v"(p), "v"(v) : "memory");
#else
    *(wt_v4u*)p = v;
#endif
}
__device__ __forceinline__ void st4_wt(void* p, unsigned v) {
#if WT_STORES
    asm volatile("global_store_dword %0, %1, off sc1\n\ts_nop 1" :: "v"(p), "v"(v) : "memory");
#else
    *(unsigned*)p = v;
#endif
}
__device__ __forceinline__ void st8_wt(void* p, unsigned long long v) {
#if WT_STORES
    asm volatile("global_store_dwordx2 %0, %1, off sc1\n\ts_nop 1" :: "v"(p), "v"(v) : "memory");
#else
    *(unsigned long long*)p = v;
#endif
}
namespace pg8 {
#define PG8_LAS __attribute__((address_space(3)))
typedef unsigned short bf16_t;
typedef short bf16x8 __attribute__((ext_vector_type(8)));
typedef float f32x4 __attribute__((ext_vector_type(4)));
typedef unsigned u32x4 __attribute__((ext_vector_type(4)));
typedef int i32x4 __attribute__((ext_vector_type(4)));
typedef int i32x8 __attribute__((ext_vector_type(8)));
constexpr int BM = 256, BK = 64, HALF = 128, HTB = HALF * BK * 2  , STAGE_BYTES = 8 * HTB, NXCD = 8, WGM = 8;

__host__ __device__ __forceinline__ int lds_byte(int r, int c) { const int st = (r >> 4) * 2 + (c >> 5), rr = r & 15, cc = c & 31, ob = rr * 64 + cc * 2; return st * 1024 + (ob ^ (((ob >> 9) & 1) << 5)); }
__host__ __device__ __forceinline__ void stage_rc(int b, int& R, int& C) { const int st = b / 1024, sb = b % 1024, swz = sb ^ (((sb >> 9) & 1) << 5); R = (st >> 1) * 16 + swz / 64; C = (st & 1) * 32 + (swz % 64) / 2; }
__host__ __device__ __forceinline__ int perm32(int rho) { const int n = rho >> 4, i = rho & 15; return 8 * (i >> 2) + 4 * n + (i & 3); }

struct Unit { int pm, pn; };
struct Gemm { const bf16_t* A; const bf16_t* Bt; int M, N, K; };

struct StaticOrder {
    int nM, nN, nwg, G, c;
    __host__ __device__ void init(int M, int N, int G_, int c_) { nM = M / BM; nN = N / BM; nwg = nM * nN; G = G_; c = c_; }
    __host__ __device__ bool next(int i, Unit& u) const {
        const long L = (long)i * G + c; if (L >= nwg) return false;
        int wgid = (int)L; { const int q = nwg / NXCD, r = nwg % NXCD, xcd = wgid % NXCD, off = wgid / NXCD; wgid = (xcd < r ? xcd * (q + 1) : r * (q + 1) + (xcd - r) * q) + off; }
        const int nig = WGM * nN, gid = wgid / nig, fm = gid * WGM, gsz = (nM - fm) < WGM ? (nM - fm) : WGM;
        u.pm = fm + ((wgid % nig) % gsz); u.pn = (wgid % nig) / gsz; return true;
    }
    __device__ __forceinline__ void a_ready(const Unit&) const {}
    __device__ __forceinline__ void done(const Unit&) const {}
};


__device__ __forceinline__ unsigned cvt_pk_bf16(float lo, float hi) { unsigned r; asm volatile("v_cvt_pk_bf16_f32 %0, %1, %2" : "=v"(r) : "v"(lo), "v"(hi)); return r; }
template <bool ACC_I32> struct EpiBf16S {
    static constexpr bool PERM = true, AFTER_DRAIN = false;
    bf16_t* O; int ldc; int sc_lo, sc_hi; float scv; float* ksum; int ks_lo, ks_hi; const float* rs; const unsigned* cmax;
    __device__ __forceinline__ void operator()(const f32x4 (&acc)[2][2][4][2], const Unit& u, int wr, int wc, int fr_, int fq_) const {
        (void)fr_; (void)fq_;
        const int lane_ = lane_id_fresh(); const int fr = lane_ & 15, fq = lane_ >> 4;
        const int row0 = u.pm * BM + wr * 64 + fr; const int colt = u.pn * BM;
        const float sc = ((u.pn >= sc_lo && u.pn < sc_hi) ? scv : 1.f) * (ACC_I32 ? (1.f / 127.f) : (1.f / 224.f));
        const int col0 = colt + wc * 32 + 8 * fq;
        float rsv[2][4];
#pragma unroll
        for (int ai = 0; ai < 2; ++ai)
#pragma unroll
            for (int m = 0; m < 4; ++m) rsv[ai][m] = rs != nullptr ? rs[row0 + ai * HALF + m * 16] : 1.f;
        const bool do_ks = ksum != nullptr && u.pn >= ks_lo && u.pn < ks_hi;
#pragma unroll
        for (int bj = 0; bj < 2; ++bj) {
            const u32x4 cb0 = *(const u32x4*)(cmax + col0 + bj * HALF), cb1 = *(const u32x4*)(cmax + col0 + bj * HALF + 4);
            const f32x4 cs0 = (f32x4){__uint_as_float(cb0.x), __uint_as_float(cb0.y), __uint_as_float(cb0.z), __uint_as_float(cb0.w)} * sc;
            const f32x4 cs1 = (f32x4){__uint_as_float(cb1.x), __uint_as_float(cb1.y), __uint_as_float(cb1.z), __uint_as_float(cb1.w)} * sc;
            f32x4 sum0 = {0.f, 0.f, 0.f, 0.f}, sum1 = sum0;
#pragma unroll
            for (int ai = 0; ai < 2; ++ai)
#pragma unroll
                for (int m = 0; m < 4; ++m) { f32x4 a0 = acc[ai][bj][m][0], a1 = acc[ai][bj][m][1];
                    if constexpr (ACC_I32) { const i32x4 i0 = __builtin_bit_cast(i32x4, a0), i1 = __builtin_bit_cast(i32x4, a1);
                        a0 = (f32x4){(float)i0[0], (float)i0[1], (float)i0[2], (float)i0[3]}; a1 = (f32x4){(float)i1[0], (float)i1[1], (float)i1[2], (float)i1[3]}; }
                    const f32x4 v0 = a0 * rsv[ai][m] * cs0, v1 = a1 * rsv[ai][m] * cs1;
                    sum0 += v0; sum1 += v1;
                    u32x4 w; w.x = cvt_pk_bf16(v0[0], v0[1]); w.y = cvt_pk_bf16(v0[2], v0[3]); w.z = cvt_pk_bf16(v1[0], v1[1]); w.w = cvt_pk_bf16(v1[2], v1[3]);
                    st16_wt(O + (size_t)(row0 + ai * HALF + m * 16) * ldc + col0 + bj * HALF, w); }
            if (do_ks) {
                float* kd = ksum + (size_t)u.pm * ((ks_hi - ks_lo) * BM) + (u.pn - ks_lo) * BM + wc * 32 + 8 * fq + bj * HALF;
#pragma unroll
                for (int n = 0; n < 2; ++n)
#pragma unroll
                    for (int i = 0; i < 4; ++i) {
                        float v = n ? sum1[i] : sum0[i];
                        v += __uint_as_float((unsigned)__builtin_amdgcn_mov_dpp((int)__float_as_uint(v), 0xB1, 0xf, 0xf, true));
                        v += __uint_as_float((unsigned)__builtin_amdgcn_mov_dpp((int)__float_as_uint(v), 0x4E, 0xf, 0xf, true));
                        v += __uint_as_float((unsigned)__builtin_amdgcn_mov_dpp((int)__float_as_uint(v), 0x141, 0xf, 0xf, true));
                        v += __uint_as_float((unsigned)__builtin_amdgcn_mov_dpp((int)__float_as_uint(v), 0x140, 0xf, 0xf, true));
                        if (fr == 0) atomicAdd(kd + 4 * n + i, v);
                    }
            }
        }
    }
};
struct EpiBf16 {
    static constexpr bool PERM = true, AFTER_DRAIN = false;
    bf16_t* O; int ldc; int sc_lo, sc_hi; float scv; float* ksum; int ks_lo, ks_hi;
    __device__ __forceinline__ void operator()(const f32x4 (&acc)[2][2][4][2], const Unit& u, int wr, int wc, int fr, int fq) const {
        const int row0 = u.pm * BM + wr * 64 + fr; const int colt = u.pn * BM;
        const float sc = (u.pn >= sc_lo && u.pn < sc_hi) ? scv : 1.f;
        const int col0 = colt + wc * 32 + 8 * fq;
#pragma unroll
        for (int ai = 0; ai < 2; ++ai)
#pragma unroll
            for (int m = 0; m < 4; ++m) { bf16_t* rowp = O + (size_t)(row0 + ai * HALF + m * 16) * ldc + col0;
#pragma unroll
                for (int bj = 0; bj < 2; ++bj) { f32x4 v0 = acc[ai][bj][m][0] * sc, v1 = acc[ai][bj][m][1] * sc;
                    u32x4 w; w.x = cvt_pk_bf16(v0[0], v0[1]); w.y = cvt_pk_bf16(v0[2], v0[3]); w.z = cvt_pk_bf16(v1[0], v1[1]); w.w = cvt_pk_bf16(v1[2], v1[3]);
                    st16_wt(rowp + bj * HALF, w); } }
        if (ksum != nullptr && u.pn >= ks_lo && u.pn < ks_hi) {
            float* kd = ksum + (size_t)u.pm * ((ks_hi - ks_lo) * BM) + (u.pn - ks_lo) * BM + wc * 32 + 8 * fq;
#pragma unroll
            for (int bj = 0; bj < 2; ++bj)
#pragma unroll
                for (int n = 0; n < 2; ++n) {
                    f32x4 cs = acc[0][bj][0][n];
#pragma unroll
                    for (int m = 1; m < 4; ++m) cs += acc[0][bj][m][n];
#pragma unroll
                    for (int m = 0; m < 4; ++m) cs += acc[1][bj][m][n];
#pragma unroll
                    for (int i = 0; i < 4; ++i) {
                        float v = cs[i];
                        v += __uint_as_float((unsigned)__builtin_amdgcn_mov_dpp((int)__float_as_uint(v), 0xB1, 0xf, 0xf, true));
                        v += __uint_as_float((unsigned)__builtin_amdgcn_mov_dpp((int)__float_as_uint(v), 0x4E, 0xf, 0xf, true));
                        v += __uint_as_float((unsigned)__builtin_amdgcn_mov_dpp((int)__float_as_uint(v), 0x141, 0xf, 0xf, true));
                        v += __uint_as_float((unsigned)__builtin_amdgcn_mov_dpp((int)__float_as_uint(v), 0x140, 0xf, 0xf, true));
                        if (fr == 0) atomicAdd(kd + bj * HALF + 4 * n + i, v);
                    }
                }
        }
    }
};

template <int OFF> __device__ __forceinline__ void dma16s(const void* sbase, unsigned voff, unsigned lds_base) { unsigned keep;
    asm volatile("s_mov_b32 %0, m0\n\ts_add_u32 m0, %3, %4\n\ts_nop 0\n\tglobal_load_lds_dwordx4 %1, %2\n\ts_mov_b32 m0, %0" : "=&s"(keep) : "v"(voff), "s"(sbase), "s"(lds_base), "i"(OFF) : "memory", "scc"); }
__device__ __forceinline__ const char* uni_ptr(const char* p) {
    const unsigned long long v = (unsigned long long)p;
    return (const char*)(((unsigned long long)(unsigned)__builtin_amdgcn_readfirstlane((int)(unsigned)(v >> 32)) << 32) | (unsigned)__builtin_amdgcn_readfirstlane((int)(unsigned)v));
}
template <class Epi, class Sched, bool ALIGN_EPI = false, bool SP2 = false, bool FP8 = false, bool I8 = false>
__device__ __forceinline__ void gemm_phase(PG8_LAS unsigned char* lds, const Gemm g, const Sched& S, const Epi& E) {
    int tid_ = threadIdx.x; asm volatile("" : "+v"(tid_));
    const int tid = tid_, wid = __builtin_amdgcn_readfirstlane(tid >> 6), lane = tid & 63, wr = wid >> 2, wc = wid & 3, fr = lane & 15, fq = lane >> 4;
    const int K = g.K, nt = K / BK;
    unsigned voffA[2], voffB[2];
#pragma unroll
    for (int i = 0; i < 2; ++i) { int R, C; stage_rc(tid * 16 + i * 8192, R, C); const int Rb = Epi::PERM ? ((R & ~31) + perm32(R & 31)) : R;
        voffA[i] = (unsigned)(R * K + C) * 2u; voffB[i] = (unsigned)(Rb * K + C) * 2u; }
    const size_t qstep = (size_t)64 * K * 2;
    const size_t kstep = (size_t)(BK * 2);
    const size_t hstep = (size_t)HALF * K * 2;
    const size_t tstep = 2 * hstep;
    const unsigned ldsn = (unsigned)(size_t)lds;
    const unsigned ldsw = (unsigned)wid * 1024u;
    const unsigned ldsb = (unsigned)__builtin_amdgcn_readfirstlane((int)(ldsn + ldsw));
    const int aoff = lds_byte(wr * 64 + fr, fq * 8), boff = lds_byte(wc * 32 + fr, fq * 8);
    unsigned ldsAn = ldsn + (unsigned)aoff, ldsBn = ldsn + (unsigned)(4 * HTB) + (unsigned)boff; asm volatile("" : "+v"(ldsAn), "+v"(ldsBn));
    PG8_LAS unsigned char* const ldsA = (PG8_LAS unsigned char*)(size_t)ldsAn; PG8_LAS unsigned char* const ldsB = (PG8_LAS unsigned char*)(size_t)ldsBn;
#define PG8_SA(b, h) (((b) * 2 + (h)) * HTB)
#define PG8_SB(b, h) ((4 + (b) * 2 + (h)) * HTB)
#define PG8_STAGE(bufoff, gbase, voff) do { if constexpr (FP8 || I8) { const char* gb_ = uni_ptr((const char*)(gbase)); dma16s<(bufoff)>(gb_, (voff)[0], ldsb); dma16s<(bufoff) + 8192>(uni_ptr(gb_ + qstep), (voff)[0], ldsb); }        \
    else { _Pragma("unroll") for (int _i = 0; _i < 2; ++_i) \
        __builtin_amdgcn_global_load_lds((const unsigned*)((const char*)(gbase) + (voff)[_i]), (PG8_LAS unsigned*)(lds + (bufoff) + ldsw + _i * 8192), 16, 0, 0); } } while (0)
#define PG8_LDA(dst, b, h) do { _Pragma("unroll") for (int m = 0; m < 4; ++m) _Pragma("unroll") for (int k = 0; k < 2; ++k) dst[m][k] = *(const PG8_LAS bf16x8*)(lds + PG8_SA(b, h) + aoff + m * 2048 + k * 1024); } while (0)
#define PG8_LDB(dst, b, h) do { _Pragma("unroll") for (int n = 0; n < 2; ++n) _Pragma("unroll") for (int k = 0; k < 2; ++k) dst[n][k] = *(const PG8_LAS bf16x8*)(lds + PG8_SB(b, h) + boff + n * 2048 + k * 1024); } while (0)
#define PG8_LDA8(dst, b, h) do { _Pragma("unroll") for (int m = 0; m < 4; ++m) dst[m] = __builtin_shufflevector(*(const PG8_LAS i32x4*)(ldsA + PG8_SA(b, h) + m * 2048), *(const PG8_LAS i32x4*)(ldsA + PG8_SA(b, h) + m * 2048 + 1024), 0, 1, 2, 3, 4, 5, 6, 7); } while (0)
#define PG8_LDB8(dst, b, h) do { _Pragma("unroll") for (int n = 0; n < 2; ++n) dst[n] = __builtin_shufflevector(*(const PG8_LAS i32x4*)(ldsB + (PG8_SB(b, h) - 4 * HTB) + n * 2048), *(const PG8_LAS i32x4*)(ldsB + (PG8_SB(b, h) - 4 * HTB) + n * 2048 + 1024), 0, 1, 2, 3, 4, 5, 6, 7); } while (0)
#define PG8_MMA8(ai, bj, A8, B8) do { __builtin_amdgcn_s_setprio(1); _Pragma("unroll") for (int m = 0; m < 4; ++m) _Pragma("unroll") for (int n = 0; n < 2; ++n) \
        acc[ai][bj][m][n] = __builtin_amdgcn_mfma_scale_f32_16x16x128_f8f6f4(B8[n], A8[m], acc[ai][bj][m][n], 0, 0, 0, 0, 0, 0); __builtin_amdgcn_s_setprio(0); } while (0)
#define PG8_MMA(ai, bj, At, Bt) do { __builtin_amdgcn_s_setprio(1); _Pragma("unroll") for (int m = 0; m < 4; ++m) _Pragma("unroll") for (int n = 0; n < 2; ++n) _Pragma("unroll") for (int k = 0; k < 2; ++k) { \
        if constexpr (I8) acc[ai][bj][m][n] = __builtin_bit_cast(f32x4, __builtin_amdgcn_mfma_i32_16x16x64_i8(__builtin_bit_cast(i32x4, Bt[n][k]), __builtin_bit_cast(i32x4, At[m][k]), __builtin_bit_cast(i32x4, acc[ai][bj][m][n]), 0, 0, 0)); \
        else acc[ai][bj][m][n] = __builtin_amdgcn_mfma_f32_16x16x32_bf16(Bt[n][k], At[m][k], acc[ai][bj][m][n], 0, 0, 0); } __builtin_amdgcn_s_setprio(0); } while (0)
#define PG8_WAIT_V(n) asm volatile("s_waitcnt vmcnt(" #n ")" ::: "memory")
#define PG8_WAIT_L(n) asm volatile("s_waitcnt lgkmcnt(" #n ")" ::: "memory")
#define PG8_BAR __builtin_amdgcn_s_barrier()
#define PG8_SCHED __builtin_amdgcn_sched_barrier(0)
    Unit cur, nxt; int ui = 0;
    if (!S.next(0, cur)) return;
    f32x4 acc[2][2][4][2];
#pragma unroll
    for (int a = 0; a < 2; ++a)
#pragma unroll
        for (int b = 0; b < 2; ++b)
#pragma unroll
            for (int m = 0; m < 4; ++m)
#pragma unroll
                for (int n = 0; n < 2; ++n) acc[a][b][m][n] = (f32x4){0.f, 0.f, 0.f, 0.f};
    bf16x8 At[4][2], B0[2][2], B1[2][2];
    i32x8 A8[4], B08[2], B18[2];
    const char* cA = (const char*)g.A + (size_t)cur.pm * tstep; const char* cB = (const char*)g.Bt + (size_t)cur.pn * tstep;
    if constexpr (FP8 || I8) { cA = uni_ptr(cA); cB = uni_ptr(cB); }
    S.a_ready(cur);
    if constexpr (SP2) {
        PG8_STAGE(PG8_SB(0, 0), cB, voffB); PG8_STAGE(PG8_SB(0, 1), cB + hstep, voffB); PG8_STAGE(PG8_SA(0, 0), cA, voffA); PG8_STAGE(PG8_SA(0, 1), cA + hstep, voffA);
        if (wr == 1) PG8_BAR;
        PG8_WAIT_V(2); PG8_BAR;
        PG8_STAGE(PG8_SB(1, 0), cB + kstep, voffB); PG8_STAGE(PG8_SA(1, 0), cA + kstep, voffA); PG8_STAGE(PG8_SB(1, 1), cB + hstep + kstep, voffB);
        PG8_WAIT_V(6); PG8_BAR;
    } else {
        PG8_STAGE(PG8_SB(0, 0), cB, voffB); PG8_STAGE(PG8_SA(0, 0), cA, voffA); PG8_STAGE(PG8_SB(0, 1), cB + hstep, voffB); PG8_STAGE(PG8_SA(0, 1), cA + hstep, voffA);
        if (wr == 1) PG8_BAR;
        PG8_WAIT_V(4); PG8_BAR;
        PG8_STAGE(PG8_SB(1, 0), cB + kstep, voffB); PG8_STAGE(PG8_SA(1, 0), cA + kstep, voffA); PG8_STAGE(PG8_SB(1, 1), cB + hstep + kstep, voffB);
        PG8_WAIT_V(6); PG8_BAR;
    }
    for (;;) {
        const bool has_next = S.next(ui + 1, nxt);
        const char* nA = has_next ? (const char*)g.A + (size_t)nxt.pm * tstep : cA; const char* nB = has_next ? (const char*)g.Bt + (size_t)nxt.pn * tstep : cB;
        if constexpr (FP8 || I8) { nA = uni_ptr(nA); nB = uni_ptr(nB); }
        for (int t = 0; t < nt; t += 2) {
            const bool last = (t == nt - 2);
            if constexpr (FP8 || I8) asm volatile("" : "+v"(voffA[0]), "+v"(voffB[0]));
            const char* a1 = cA + (size_t)(t + 1) * kstep;
            const char* a2 = last ? nA : cA + (size_t)(t + 2) * kstep; const char* b2 = last ? nB : cB + (size_t)(t + 2) * kstep;
            const char* a3 = a2 + kstep; const char* b3 = b2 + kstep;
            if (last && has_next) S.a_ready(nxt);
            if constexpr (SP2 && FP8) {
            PG8_LDB8(B08, 0, 0); PG8_LDB8(B18, 0, 1); PG8_SCHED; PG8_LDA8(A8, 0, 0); PG8_STAGE(PG8_SA(1, 1), a1 + hstep, voffA);
            PG8_WAIT_V(8); PG8_WAIT_L(0); PG8_BAR; PG8_MMA8(0, 0, A8, B08); PG8_MMA8(0, 1, A8, B18); PG8_BAR; PG8_SCHED;
            PG8_LDA8(A8, 0, 1); PG8_STAGE(PG8_SB(0, 0), b2, voffB); PG8_STAGE(PG8_SB(0, 1), b2 + hstep, voffB); PG8_STAGE(PG8_SA(0, 0), a2, voffA);
            PG8_WAIT_V(8); PG8_WAIT_L(0); PG8_BAR; PG8_MMA8(1, 0, A8, B08); PG8_MMA8(1, 1, A8, B18); PG8_BAR; PG8_SCHED;
            PG8_LDB8(B08, 1, 0); PG8_LDB8(B18, 1, 1); PG8_SCHED; PG8_LDA8(A8, 1, 0); PG8_STAGE(PG8_SA(0, 1), a2 + hstep, voffA);
            PG8_WAIT_V(8); PG8_WAIT_L(0); PG8_BAR; PG8_MMA8(0, 0, A8, B08); PG8_MMA8(0, 1, A8, B18); PG8_BAR; PG8_SCHED;
            PG8_LDA8(A8, 1, 1); PG8_STAGE(PG8_SB(1, 0), b3, voffB); PG8_STAGE(PG8_SB(1, 1), b3 + hstep, voffB); PG8_STAGE(PG8_SA(1, 0), a3, voffA);
            PG8_WAIT_V(8); PG8_WAIT_L(0); PG8_BAR; PG8_MMA8(1, 0, A8, B08); PG8_MMA8(1, 1, A8, B18); PG8_BAR; PG8_SCHED;
            } else if constexpr (SP2) {
            PG8_LDB(B0, 0, 0); PG8_LDB(B1, 0, 1); PG8_SCHED; PG8_LDA(At, 0, 0); PG8_STAGE(PG8_SA(1, 1), a1 + hstep, voffA);
            PG8_WAIT_V(8); PG8_WAIT_L(0); PG8_BAR; PG8_MMA(0, 0, At, B0); PG8_MMA(0, 1, At, B1); PG8_BAR; PG8_SCHED;
            PG8_LDA(At, 0, 1); PG8_STAGE(PG8_SB(0, 0), b2, voffB); PG8_STAGE(PG8_SB(0, 1), b2 + hstep, voffB); PG8_STAGE(PG8_SA(0, 0), a2, voffA);
            PG8_WAIT_V(8); PG8_WAIT_L(0); PG8_BAR; PG8_MMA(1, 0, At, B0); PG8_MMA(1, 1, At, B1); PG8_BAR; PG8_SCHED;
            PG8_LDB(B0, 1, 0); PG8_LDB(B1, 1, 1); PG8_SCHED; PG8_LDA(At, 1, 0); PG8_STAGE(PG8_SA(0, 1), a2 + hstep, voffA);
            PG8_WAIT_V(8); PG8_WAIT_L(0); PG8_BAR; PG8_MMA(0, 0, At, B0); PG8_MMA(0, 1, At, B1); PG8_BAR; PG8_SCHED;
            PG8_LDA(At, 1, 1); PG8_STAGE(PG8_SB(1, 0), b3, voffB); PG8_STAGE(PG8_SB(1, 1), b3 + hstep, voffB); PG8_STAGE(PG8_SA(1, 0), a3, voffA);
            PG8_WAIT_V(8); PG8_WAIT_L(0); PG8_BAR; PG8_MMA(1, 0, At, B0); PG8_MMA(1, 1, At, B1); PG8_BAR; PG8_SCHED;
            } else {
            PG8_LDB(B0, 0, 0); PG8_SCHED; PG8_LDA(At, 0, 0); PG8_STAGE(PG8_SA(1, 1), a1 + hstep, voffA);
            PG8_WAIT_L(8); PG8_BAR; PG8_WAIT_L(0); PG8_MMA(0, 0, At, B0); PG8_BAR; PG8_SCHED;
            PG8_LDB(B1, 0, 1); PG8_STAGE(PG8_SB(0, 0), b2, voffB);
            PG8_BAR; PG8_WAIT_L(0); PG8_MMA(0, 1, At, B1); PG8_BAR;
            PG8_LDA(At, 0, 1); PG8_STAGE(PG8_SA(0, 0), a2, voffA);
            PG8_BAR; PG8_WAIT_L(0); PG8_MMA(1, 0, At, B0); PG8_BAR; PG8_SCHED;
            PG8_STAGE(PG8_SB(0, 1), b2 + hstep, voffB);
            PG8_WAIT_V(6); PG8_BAR; PG8_MMA(1, 1, At, B1); PG8_BAR;
            PG8_LDB(B0, 1, 0); PG8_SCHED; PG8_LDA(At, 1, 0); PG8_STAGE(PG8_SA(0, 1), a2 + hstep, voffA);
            PG8_WAIT_L(8); PG8_BAR; PG8_WAIT_L(0); PG8_MMA(0, 0, At, B0); PG8_BAR; PG8_SCHED;
            PG8_LDB(B1, 1, 1); PG8_STAGE(PG8_SB(1, 0), b3, voffB);
            PG8_BAR; PG8_WAIT_L(0); PG8_MMA(0, 1, At, B1); PG8_BAR;
            PG8_LDA(At, 1, 1); PG8_STAGE(PG8_SA(1, 0), a3, voffA);
            PG8_BAR; PG8_WAIT_L(0); PG8_MMA(1, 0, At, B0); PG8_BAR; PG8_SCHED;
            PG8_STAGE(PG8_SB(1, 1), b3 + hstep, voffB);
            PG8_WAIT_V(6); PG8_BAR; PG8_MMA(1, 1, At, B1); PG8_BAR;
            }
        }
        if constexpr (ALIGN_EPI) { if (wr == 0) PG8_BAR; }
        if constexpr (!Epi::AFTER_DRAIN) { E(acc, cur, wr, wc, fr, fq); S.done(cur); }
        if (!has_next) break;
#pragma unroll
        for (int a = 0; a < 2; ++a)
#pragma unroll
            for (int b = 0; b < 2; ++b)
#pragma unroll
                for (int m = 0; m < 4; ++m)
#pragma unroll
                    for (int n = 0; n < 2; ++n) acc[a][b][m][n] = (f32x4){0.f, 0.f, 0.f, 0.f};
        cur = nxt; cA = nA; cB = nB; ++ui;
        if constexpr (ALIGN_EPI) { if (wr == 1) PG8_BAR; }
    }
    PG8_WAIT_V(0);
    if constexpr (!ALIGN_EPI) { if (wr == 0) PG8_BAR; }
    PG8_BAR;
    if constexpr (Epi::AFTER_DRAIN) { E.fused(acc, cur, wr, wc, fr, fq, lds, wid, lane); S.done(cur); }
#undef PG8_SA
#undef PG8_SB
#undef PG8_STAGE
#undef PG8_LDA
#undef PG8_LDB
#undef PG8_LDA8
#undef PG8_LDB8
#undef PG8_MMA8
#undef PG8_MMA
#undef PG8_WAIT_V
#undef PG8_WAIT_L
#undef PG8_BAR
#undef PG8_SCHED
}
}
#include <hip/hip_bf16.h>
#include <cmath>
namespace attn_body {
using bf16=__hip_bfloat16;
using bf16x8=__attribute__((ext_vector_type(8)))short;
using s16x4=__attribute__((ext_vector_type(4)))short;
using f32x16=__attribute__((ext_vector_type(16)))float;
using u32x4=__attribute__((ext_vector_type(4)))unsigned;
constexpr int BATCH=4,NHEAD=8,SEQ=4096,D=64,DM=3072,OPITCH=1024;
constexpr int NW=8,QBLK=32,QB=QBLK*NW,KVBLK=64,NQB=SEQ/QB;
constexpr int ATTN_UNIT_ROWS=QB;
__device__ __forceinline__ int crow(int r,int hi){return (r&3)+8*(r>>2)+4*hi;}
#define SBAR() __builtin_amdgcn_sched_barrier(0)
__device__ __forceinline__ void cmask(f32x16&p0,f32x16&p1,int jb,int qrel,int hi){
  const float NEG=-INFINITY; int kb=64*jb+4*hi;
  #pragma unroll
  for(int r=0;r<16;++r){int kv=kb+(r&3)+8*(r>>2); if(kv>qrel)p0[r]=NEG; if(kv+32>qrel)p1[r]=NEG;}
}

constexpr int NSLOT=3, SLOTB=8192;
constexpr int LDS_K=0, LDS_V=NSLOT*SLOTB, LDS_WS=2*NSLOT*SLOTB, LDS_OST=LDS_WS+NW*64*4, LDS_BYTES=LDS_OST+NW*4096;
constexpr float C2=0.125f*1.4426950408889634f;
__device__ __forceinline__ void glds16(const void*gsrc,unsigned lds_dst){unsigned keep;
  asm volatile("s_mov_b32 %0, m0\n\ts_mov_b32 m0, %2\n\ts_nop 0\n\tglobal_load_lds_dwordx4 %1, off\n\ts_mov_b32 m0, %0":"=&s"(keep):"v"(gsrc),"s"(lds_dst):"memory");}
__device__ __forceinline__ void glds16s(const void*sbase,unsigned voff,unsigned lds_dst){unsigned keep;
  asm volatile("s_mov_b32 %0, m0\n\ts_mov_b32 m0, %3\n\ts_nop 0\n\tglobal_load_lds_dwordx4 %1, %2\n\ts_mov_b32 m0, %0":"=&s"(keep):"v"(voff),"s"(sbase),"s"(lds_dst):"memory");}
__device__ __forceinline__ float max3f(float a,float b,float c){float r;asm("v_max3_f32 %0, %1, %2, %3":"=v"(r):"v"(a),"v"(b),"v"(c));return r;}
__device__ __forceinline__ float max2f(float a,float b){float r;asm("v_max_f32_e32 %0, %1, %2":"=v"(r):"v"(a),"v"(b));return r;}
__device__ __forceinline__ float fadd_s(float a,float b){float r;asm("v_add_f32_e32 %0, %1, %2":"=v"(r):"v"(a),"v"(b));return r;}
__device__ __forceinline__ float fsub_s(float a,float b){float r;asm("v_sub_f32_e32 %0, %1, %2":"=v"(r):"v"(a),"v"(b));return r;}
typedef float f32x2_t __attribute__((ext_vector_type(2))); typedef __bf16 bf16x2_t __attribute__((ext_vector_type(2)));
__device__ __forceinline__ unsigned cvtpk_s(float lo,float hi){f32x2_t v={lo,hi};bf16x2_t b=__builtin_convertvector(v,bf16x2_t);return __builtin_bit_cast(unsigned,b);}
#define WAIT_BAR(N) asm volatile("s_waitcnt vmcnt(" #N ") lgkmcnt(0)\n\ts_barrier":::"memory")

__device__ __forceinline__ void qkt(f32x16&p0,f32x16&p1,const char*Kslot,const bf16x8*qr,int r32,int hi){
  const f32x16 negm=f32x16{};
  const char*kb=Kslot+hi*1024+r32*16;
  #pragma unroll
  for(int d0=0;d0<4;++d0){
    const bf16x8 b0=*reinterpret_cast<const bf16x8*>(kb+d0*2048);
    const bf16x8 b1=*reinterpret_cast<const bf16x8*>(kb+d0*2048+512);
    if(d0==0){p0=__builtin_amdgcn_mfma_f32_32x32x16_bf16(b0,qr[0],negm,0,0,0);p1=__builtin_amdgcn_mfma_f32_32x32x16_bf16(b1,qr[0],negm,0,0,0);}
    else{p0=__builtin_amdgcn_mfma_f32_32x32x16_bf16(b0,qr[d0],p0,0,0,0);p1=__builtin_amdgcn_mfma_f32_32x32x16_bf16(b1,qr[d0],p1,0,0,0);}}
}
typedef __attribute__((address_space(3))) const char* lds_cptr;
typedef short v4i16_t __attribute__((ext_vector_type(4)));
__device__ __forceinline__ void kload8(bf16x8*kf,lds_cptr kp){
  kf[0]=*(const __attribute__((address_space(3))) bf16x8*)(kp);      kf[1]=*(const __attribute__((address_space(3))) bf16x8*)(kp+512);
  kf[2]=*(const __attribute__((address_space(3))) bf16x8*)(kp+2048); kf[3]=*(const __attribute__((address_space(3))) bf16x8*)(kp+2560);
  kf[4]=*(const __attribute__((address_space(3))) bf16x8*)(kp+4096); kf[5]=*(const __attribute__((address_space(3))) bf16x8*)(kp+4608);
  kf[6]=*(const __attribute__((address_space(3))) bf16x8*)(kp+6144); kf[7]=*(const __attribute__((address_space(3))) bf16x8*)(kp+6656);
}
__device__ __forceinline__ void kload2(bf16x8*kf,lds_cptr kp,int j){ kf[2*j]=*(const __attribute__((address_space(3))) bf16x8*)(kp+j*2048); kf[2*j+1]=*(const __attribute__((address_space(3))) bf16x8*)(kp+j*2048+512); }
__device__ __forceinline__ s16x4 vtr(lds_cptr p){ return __builtin_bit_cast(s16x4,__builtin_amdgcn_ds_read_tr16_b64_v4i16((__attribute__((address_space(3))) v4i16_t*)p)); }
__device__ __forceinline__ float rowmax(const f32x16&p0,const f32x16&p1){
  float a=max3f(p0[0],p0[1],p1[0]),b=max3f(p0[2],p0[3],p1[1]);a=max3f(a,p1[2],p1[3]);
  #pragma unroll
  for(int r=4;r<16;r+=4){a=max3f(a,p0[r],p0[r+1]);b=max3f(b,p0[r+2],p0[r+3]);a=max3f(a,p1[r],p1[r+1]);b=max3f(b,p1[r+2],p1[r+3]);}
  const float m=max2f(a,b);
  auto rr=__builtin_amdgcn_permlane32_swap(__float_as_uint(m),__float_as_uint(m),false,false);
  return max2f(__uint_as_float(rr[0]),__uint_as_float(rr[1]));
}
__device__ __forceinline__ void pv(f32x16*o,int vb,bf16x8 pa0,bf16x8 pa1,bf16x8 pa2,bf16x8 pa3){
  #pragma unroll
  for(int d0=0;d0<2;++d0){s16x4 lo[4],hi[4];
    #pragma unroll
    for(int ks=0;ks<4;++ks){
      asm volatile("ds_read_b64_tr_b16 %0,%1 offset:%c2":"=&v"(lo[ks]):"v"(vb),"i"(d0*4096+ks*1024):"memory");
      asm volatile("ds_read_b64_tr_b16 %0,%1 offset:%c2":"=&v"(hi[ks]):"v"(vb),"i"(d0*4096+ks*1024+512):"memory");}
    asm volatile("s_waitcnt lgkmcnt(0)":::"memory");SBAR();
    #define PK(k) (bf16x8){lo[k][0],lo[k][1],lo[k][2],lo[k][3],hi[k][0],hi[k][1],hi[k][2],hi[k][3]}
    o[d0]=__builtin_amdgcn_mfma_f32_32x32x16_bf16(pa0,PK(0),o[d0],0,0,0);
    o[d0]=__builtin_amdgcn_mfma_f32_32x32x16_bf16(pa1,PK(1),o[d0],0,0,0);
    o[d0]=__builtin_amdgcn_mfma_f32_32x32x16_bf16(pa2,PK(2),o[d0],0,0,0);
    o[d0]=__builtin_amdgcn_mfma_f32_32x32x16_bf16(pa3,PK(3),o[d0],0,0,0);
    #undef PK
  }
}

#define ATTN_YQ (127.f/6.f)
#ifndef ATTN_STORE16
#define ATTN_STORE16(p,v) st16_wt((p),(v))
#endif
template<int THRL> __device__ __forceinline__ void attn_unit(int b,int h,int qb,const bf16*Q,const bf16*__restrict__ K,const bf16*__restrict__ V,bf16*O,const float*KSUM,const float*GG,char*shm){
  int tid_=threadIdx.x; asm volatile("":"+v"(tid_)); const int tid=tid_,lane=tid&63,r32=lane&31,hi=lane>>5; const int wid=__builtin_amdgcn_readfirstlane(tid>>6);
  const long rowbase=(long)b*SEQ; const int q0=qb*QB;
  const bf16*Qw=Q+(rowbase+q0+wid*QBLK)*DM+h*D;
  const bf16*Kh=K+rowbase*DM+h*D,*Vh=V+rowbase*DM+h*D;
  const unsigned lds0=(unsigned)(uintptr_t)shm;
  float*wsf=(float*)(shm+LDS_WS)+wid*64;
  const unsigned koff=(unsigned)((lane*DM+wid*8)*2);
  const unsigned voffs=(unsigned)(((16*(wid&3)+(lane>>2))*DM+(wid>>2)*32+(lane&3)*8)*2);
  const unsigned kdst=lds0+LDS_K+wid*1024, vdst=lds0+LDS_V+wid*1024;
  #define PT(t) (((t)<4)?(NT-4+(t)):((t)-4))
  #define DMA_K(t,slot) glds16s((const char*)Kh+(long)PT(t)*(KVBLK*DM*2),koff,(unsigned)__builtin_amdgcn_readfirstlane(kdst+(slot)))
  #define DMA_V(t,slot) glds16s((const char*)Vh+(long)PT(t)*(KVBLK*DM*2),voffs,(unsigned)__builtin_amdgcn_readfirstlane(vdst+(slot)))
  const int vb0=(int)(lds0+LDS_V)+((lane>>4)&1)*32+(lane&3)*8+(4*hi+((lane&15)>>2))*64;
  const char*Kbase=shm+LDS_K; bf16x8 kf[8];
  const lds_cptr shm3=(lds_cptr)shm; const lds_cptr kp0=shm3+LDS_K+hi*1024+r32*16; const lds_cptr vp0=shm3+LDS_V+((lane>>4)&1)*32+(lane&3)*8+(4*hi+((lane&15)>>2))*64;
  const int NT=(q0+QB)/KVBLK;
  DMA_K(0,0);DMA_V(0,0);DMA_K(1,SLOTB);
  bf16x8 qr[4];
  #pragma unroll
  for(int d0=0;d0<4;++d0)qr[d0]=*reinterpret_cast<const bf16x8*>(&Qw[(long)r32*DM+d0*16+hi*8]);
  float mhat=0.f,l_reg=0.f;f32x16 o[2];o[0]=f32x16{};o[1]=f32x16{};const f32x16 z16=f32x16{};
  unsigned selm=(1u<<qb)-1u;
  if(qb>3){
    f32x16 gt=f32x16{};
    #pragma unroll
    for(int d0=0;d0<4;++d0){ const float*kp=KSUM+((long)(b*16+(r32&15)))*512+h*D+d0*16+hi*8;
      const float4 k0=*reinterpret_cast<const float4*>(kp),k1=*reinterpret_cast<const float4*>(kp+4);
      u32x4 kw; kw.x=cvtpk_s(k0.x,k0.y);kw.y=cvtpk_s(k0.z,k0.w);kw.z=cvtpk_s(k1.x,k1.y);kw.w=cvtpk_s(k1.z,k1.w);
      gt=__builtin_amdgcn_mfma_f32_32x32x16_bf16(__builtin_bit_cast(bf16x8,kw),qr[d0],gt,0,0,0); }
    float v0=-INFINITY,v1=-INFINITY,v2=-INFINITY; int i0=0,i1=0,i2=0;
    #define INS3(vv,ii) do{ const float x_=(vv); const int j_=(ii); \
      if(x_>v0){v2=v1;i2=i1;v1=v0;i1=i0;v0=x_;i0=j_;} else if(x_>v1){v2=v1;i2=i1;v1=x_;i1=j_;} else if(x_>v2){v2=x_;i2=j_;} }while(0)
    #pragma unroll
    for(int r=0;r<8;++r){ const int j=crow(r,hi); INS3(j<qb?gt[r]:-INFINITY,j); }
    const float p0=__shfl_xor(v0,32),p1=__shfl_xor(v1,32),p2=__shfl_xor(v2,32); const int q0i=__shfl_xor(i0,32),q1i=__shfl_xor(i1,32),q2i=__shfl_xor(i2,32);
    INS3(p0,q0i); INS3(p1,q1i); INS3(p2,q2i);
    #undef INS3
    selm=(1u<<i0)|(1u<<i1)|(1u<<i2);
  }
  const int qrel=wid*QBLK+r32;
  #define CMASK(P0,P1,t) do{ if((t)<4)cmask(P0,P1,(t),qrel,hi); }while(0)
  bool resc=false;
  #define START(P0,P1) do{ const float rm=rowmax(P0,P1); resc=false; \
    { const float dl=rm; mhat=fadd_s(mhat,dl); \
      _Pragma("unroll") for(int r=0;r<16;++r){P0[r]=fsub_s(P0[r],dl);P1[r]=fsub_s(P1[r],dl);} \
      } \
    _Pragma("unroll") for(int r=0;r<16;++r)P0[r]=__builtin_amdgcn_exp2f(P0[r]); }while(0)
  #define RESC() do{ if(resc){ asm volatile("s_waitcnt lgkmcnt(0)":::"memory"); \
      _Pragma("unroll") for(int d_=0;d_<2;++d_) _Pragma("unroll") for(int r=0;r<16;++r)o[d_][r]*=wsf[crow(r,hi)]; } }while(0)
  f32x16 pA0,pA1,pB0,pB1;
  int sl_prev=0,sl_cur=0,sl_next=SLOTB;
  #define ROT() do{sl_prev=sl_cur;sl_cur=sl_next;sl_next=(sl_next==(NSLOT-1)*SLOTB)?0:sl_next+SLOTB;}while(0)
  DMA_K(2,2*SLOTB);
  WAIT_BAR(3);
  qkt(pA0,pA1,Kbase,qr,r32,hi);asm volatile("s_nop 15\n\ts_nop 7":"+v"(pA0),"+v"(pA1));CMASK(pA0,pA1,0);
  START(pA0,pA1);
  _Pragma("unroll") for(int r=0;r<16;++r)pA1[r]=__builtin_amdgcn_exp2f(pA1[r]);
  WAIT_BAR(0);
  DMA_K(3,0);DMA_V(1,SLOTB);
  ROT();
  kload8(kf,kp0+sl_cur);
  WAIT_BAR(2);
  s16x4 vlo[8],vhi[8]; u32x4 pw0,pw1,pw2,pw3;
  #define PKW(P,B) cvtpk_s(P[B],P[B+1])
  #define PAF(k) __builtin_bit_cast(bf16x8,pw##k)
  #define VFR(i) (bf16x8){vlo[i][0],vlo[i][1],vlo[i][2],vlo[i][3],vhi[i][0],vhi[i][1],vhi[i][2],vhi[i][3]}
  #define PIN(x) asm volatile("":"+v"(x))
  #define MX3(a,b,c) __builtin_fmaxf(__builtin_fmaxf((a),(b)),(c))
  #define GAPA(MF,A0,A1,A2,A3,W0,W1,PW) do{ MF; sacc+=A0; sacc+=A1; sacc+=A2; sacc+=A3; PIN(sacc); W0; W1; PIN(PW); SBAR(); }while(0)
  #define EX(v) __builtin_amdgcn_exp2f(v)
  #define GAPB(MF,X,B) do{ MF; X[B]=EX(X[B]); X[B+1]=EX(X[B+1]); X[B+2]=EX(X[B+2]); X[B+3]=EX(X[B+3]); PIN(X); SBAR(); }while(0)
  #define VRD(i) do{ vlo[i]=vtr(vp_+(((i)>>2)*4096+((i)&3)*1024)); vhi[i]=vtr(vp_+(((i)>>2)*4096+((i)&3)*1024+512)); }while(0)
  #define KRD(G,j) do{ if(G){ kload2(kf,kp0+sl_next,j); SBAR(); } }while(0)
  #define STEP(C0,C1,P0,P1,t,GK,GV,GL) do{ SBAR(); \
    const lds_cptr vp_=vp0+sl_prev; \
    VRD(0); SBAR(); float sacc=(P0[0]+P0[1]); \
    GAPA(C0=__builtin_amdgcn_mfma_f32_32x32x16_bf16(kf[0],qr[0],z16,0,0,0), P0[2],P0[3],P0[4],P0[5],     pw0[0]=PKW(P0,0), pw0[1]=PKW(P0,2), pw0); \
    VRD(4); SBAR(); GAPA(C1=__builtin_amdgcn_mfma_f32_32x32x16_bf16(kf[1],qr[0],z16,0,0,0), P0[6],P0[7],P0[8],P0[9],     pw0[2]=PKW(P0,4), pw0[3]=PKW(P0,6), pw0); \
    VRD(1); SBAR(); GAPA(C0=__builtin_amdgcn_mfma_f32_32x32x16_bf16(kf[2],qr[1],C0,0,0,0),   P0[10],P0[11],P0[12],P0[13], pw1[0]=PKW(P0,8), pw1[1]=PKW(P0,10), pw1); \
    VRD(5); SBAR(); GAPA(C1=__builtin_amdgcn_mfma_f32_32x32x16_bf16(kf[3],qr[1],C1,0,0,0),   P0[14],P0[15],P1[0],P1[1],   pw1[2]=PKW(P0,12),pw1[3]=PKW(P0,14), pw1); \
    VRD(2); SBAR(); GAPA(C0=__builtin_amdgcn_mfma_f32_32x32x16_bf16(kf[4],qr[2],C0,0,0,0),   P1[2],P1[3],P1[4],P1[5],     pw2[0]=PKW(P1,0), pw2[1]=PKW(P1,2), pw2); \
    VRD(6); SBAR(); GAPA(C1=__builtin_amdgcn_mfma_f32_32x32x16_bf16(kf[5],qr[2],C1,0,0,0),   P1[6],P1[7],P1[8],P1[9],     pw2[2]=PKW(P1,4), pw2[3]=PKW(P1,6), pw2); \
    VRD(3); SBAR(); GAPA(C0=__builtin_amdgcn_mfma_f32_32x32x16_bf16(kf[6],qr[3],C0,0,0,0),   P1[10],P1[11],P1[12],P1[13], pw3[0]=PKW(P1,8), pw3[1]=PKW(P1,10), pw3); \
    VRD(7); SBAR(); GAPA(C1=__builtin_amdgcn_mfma_f32_32x32x16_bf16(kf[7],qr[3],C1,0,0,0),   P1[14],P1[15],0.f,0.f,       pw3[2]=PKW(P1,12),pw3[3]=PKW(P1,14), pw3); \
    l_reg+=sacc; \
    if(GK){DMA_K((t)+3,sl_cur);} if(GV){DMA_V((t)+1,sl_next);} \
    { const bool v_=((t)<4)||((selm>>(((t)-4)>>2))&1u); const float nm_=v_?-mhat:-INFINITY; \
      _Pragma("unroll") for(int r=0;r<16;++r){C0[r]+=nm_;C1[r]+=nm_;} } \
    CMASK(C0,C1,t); \
    { float a=MX3(C0[0],C0[1],C1[0]),b=MX3(C0[2],C0[3],C1[1]); a=MX3(a,C1[2],C1[3]); \
      _Pragma("unroll") for(int r=4;r<16;r+=4){a=MX3(a,C0[r],C0[r+1]);b=MX3(b,C0[r+2],C0[r+3]);a=MX3(a,C1[r],C1[r+1]);b=MX3(b,C1[r+2],C1[r+3]);} \
      float rm=__builtin_fmaxf(a,b); { auto rr=__builtin_amdgcn_permlane32_swap(__float_as_uint(rm),__float_as_uint(rm),false,false); rm=__builtin_fmaxf(__uint_as_float(rr[0]),__uint_as_float(rr[1])); } \
      resc=false; \
      if(__builtin_expect(__any(rm>(float)THRL),0)){ const float dl=__builtin_fmaxf(rm,0.f); mhat+=dl; \
        _Pragma("unroll") for(int r=0;r<16;++r){C0[r]-=dl;C1[r]-=dl;} \
        const float f=__builtin_amdgcn_exp2f(-dl); l_reg*=f; if(hi==0)wsf[r32]=f; resc=true; } } \
    SBAR(); \
    GAPB(o[0]=__builtin_amdgcn_mfma_f32_32x32x16_bf16(PAF(0),VFR(0),o[0],0,0,0), C0,0); \
    GAPB(o[1]=__builtin_amdgcn_mfma_f32_32x32x16_bf16(PAF(0),VFR(4),o[1],0,0,0), C0,4); \
    KRD(GL,0); GAPB(o[0]=__builtin_amdgcn_mfma_f32_32x32x16_bf16(PAF(1),VFR(1),o[0],0,0,0), C0,8); \
    KRD(GL,1); GAPB(o[1]=__builtin_amdgcn_mfma_f32_32x32x16_bf16(PAF(1),VFR(5),o[1],0,0,0), C0,12); \
    KRD(GL,2); GAPB(o[0]=__builtin_amdgcn_mfma_f32_32x32x16_bf16(PAF(2),VFR(2),o[0],0,0,0), C1,0); \
    KRD(GL,3); GAPB(o[1]=__builtin_amdgcn_mfma_f32_32x32x16_bf16(PAF(2),VFR(6),o[1],0,0,0), C1,4); \
    GAPB(o[0]=__builtin_amdgcn_mfma_f32_32x32x16_bf16(PAF(3),VFR(3),o[0],0,0,0), C1,8); \
    GAPB(o[1]=__builtin_amdgcn_mfma_f32_32x32x16_bf16(PAF(3),VFR(7),o[1],0,0,0), C1,12); \
    }while(0)
  int t=1;
  #define ENDW(tt) do{ if((tt)+3<NT){WAIT_BAR(2);} else if((tt)+2<NT){WAIT_BAR(1);} else {WAIT_BAR(0);} }while(0)
  for(;t<5&&t+1<NT;t+=2){
    STEP(pB0,pB1,pA0,pA1,t,(t+3<NT),(t+1<NT),(t+1<NT));       ENDW(t);   RESC(); ROT();
    STEP(pA0,pA1,pB0,pB1,t+1,(t+4<NT),(t+2<NT),(t+2<NT));     ENDW(t+1); RESC(); ROT();
  }
  #undef CMASK
  #define CMASK(P0,P1,t) do{}while(0)
  for(;t+5<NT;t+=2){
    STEP(pB0,pB1,pA0,pA1,t,true,true,true);     WAIT_BAR(2); RESC(); ROT();
    STEP(pA0,pA1,pB0,pB1,t+1,true,true,true);   WAIT_BAR(2); RESC(); ROT();
  }
  #undef CMASK
  #define CMASK(P0,P1,t) do{ if((t)<4)cmask(P0,P1,(t),qrel,hi); }while(0)
  for(;t+1<NT;t+=2){
    STEP(pB0,pB1,pA0,pA1,t,(t+3<NT),(t+1<NT),(t+1<NT));       ENDW(t);   RESC(); ROT();
    STEP(pA0,pA1,pB0,pB1,t+1,(t+4<NT),(t+2<NT),(t+2<NT));     ENDW(t+1); RESC(); ROT();
  }
  STEP(pB0,pB1,pA0,pA1,NT-1,false,false,false); RESC();
  { float sacc=pB0[0]+pB0[1]; _Pragma("unroll") for(int r=2;r<16;++r)sacc+=pB0[r]; _Pragma("unroll") for(int r=0;r<16;++r)sacc+=pB1[r]; l_reg+=sacc;
    pw0=(u32x4){PKW(pB0,0),PKW(pB0,2),PKW(pB0,4),PKW(pB0,6)};pw1=(u32x4){PKW(pB0,8),PKW(pB0,10),PKW(pB0,12),PKW(pB0,14)};pw2=(u32x4){PKW(pB1,0),PKW(pB1,2),PKW(pB1,4),PKW(pB1,6)};pw3=(u32x4){PKW(pB1,8),PKW(pB1,10),PKW(pB1,12),PKW(pB1,14)};
    SBAR(); pv(o,vb0+sl_cur,PAF(0),PAF(1),PAF(2),PAF(3)); }
  #undef PKW
  #undef PAF
  #undef VFR
  #undef PIN
  #undef MX3
  #undef GAPA
  #undef GAPB
  #undef EX
  #undef VRD
  #undef KRD
  #undef STEP
  #undef ENDW
  {auto rr=__builtin_amdgcn_permlane32_swap(__float_as_uint(l_reg),__float_as_uint(l_reg),false,false);l_reg=__uint_as_float(rr[0])+__uint_as_float(rr[1]);}
  if(hi==0)wsf[32+r32]=l_reg;asm volatile("s_waitcnt lgkmcnt(0)":::"memory");
  float rli[16];
  #pragma unroll
  for(int r=0;r<16;++r)rli[r]=__builtin_amdgcn_rcpf(wsf[32+crow(r,hi)]);
  bf16*Ow=O+(rowbase+q0+wid*QBLK)*OPITCH+h*D;
  { bf16*stg=(bf16*)(shm+LDS_OST)+wid*2048;
    #pragma unroll
    for(int r=0;r<16;++r){const int orow=crow(r,hi);
      #pragma unroll
      for(int d0=0;d0<2;++d0)stg[orow*64+d0*32+r32]=__float2bfloat16(o[d0][r]*rli[r]);}
    asm volatile("s_waitcnt lgkmcnt(0)":::"memory");
    const int ch=lane&7; float gg[8];
    #pragma unroll
    for(int i=0;i<8;++i)gg[i]=GG[h*D+ch*8+i];
    #pragma unroll
    for(int i=0;i<4;++i){const int row=i*8+(lane>>3); const u32x4 v=*(const u32x4*)(stg+row*64+ch*8);
      float x[8]; x[0]=__uint_as_float(v.x<<16);x[1]=__uint_as_float(v.x&0xffff0000u);x[2]=__uint_as_float(v.y<<16);x[3]=__uint_as_float(v.y&0xffff0000u);
      x[4]=__uint_as_float(v.z<<16);x[5]=__uint_as_float(v.z&0xffff0000u);x[6]=__uint_as_float(v.w<<16);x[7]=__uint_as_float(v.w&0xffff0000u);
      float ss=0.f;
      #pragma unroll
      for(int k=0;k<8;++k)ss+=x[k]*x[k];
      ss+=__shfl_xor(ss,1);ss+=__shfl_xor(ss,2);ss+=__shfl_xor(ss,4);
      const float rs=rsqrtf(ss*(1.f/64.f)+1e-6f);
      const float qn=rs*ATTN_YQ; unsigned w0=0u,w1=0u;
      #pragma unroll
      for(int k=0;k<4;++k){const int a=(int)fminf(fmaxf(__builtin_rintf(x[k]*qn),-127.f),127.f),b=(int)fminf(fmaxf(__builtin_rintf(x[4+k]*qn),-127.f),127.f); w0|=((unsigned)a&0xffu)<<(8*k); w1|=((unsigned)b&0xffu)<<(8*k);}
      st8_wt((void*)((unsigned char*)O+((rowbase+q0+wid*QBLK+row)*(long)OPITCH+h*D+ch*8)),(unsigned long long)w0|((unsigned long long)w1<<32));} }
  asm volatile("s_waitcnt lgkmcnt(0)\n\ts_barrier":::"memory");
  #undef DMA_K
  #undef PT
  #undef DMA_V
  #undef CMASK
  #undef START
  #undef RESC
  #undef ROT
}
constexpr int ATTN_LDS_BYTES=LDS_BYTES;
struct AttnTensors { const bf16* Q; const bf16* K; const bf16* V; bf16* O; const float* KSUM; const float* GG; };
struct AttnUnit { int bh; int qb; };
struct StaticOrder {
  int vcu,G;
  __device__ __forceinline__ explicit StaticOrder(int grid,int block):vcu((grid%8==0)?(block%8)*(grid/8)+block/8:block),G(grid){}
  __device__ __forceinline__ bool next(int i,AttnUnit&u)const{ const int pr=vcu+(i>>1)*G; if(pr>=256)return false; const int s=pr&7; u.bh=pr>>3; u.qb=(i&1)?s:15-s; return true; }
  __device__ __forceinline__ void a_ready(const AttnUnit&)const{}
  __device__ __forceinline__ void done(const AttnUnit&)const{}
};
template<class Sched,int THRL=8> __device__ __forceinline__ void attn_phase(char*lds,const AttnTensors&T,const Sched&S){
  AttnUnit u;
  for(int i=0;S.next(i,u);++i){ S.a_ready(u); attn_unit<THRL>(u.bh/NHEAD,u.bh%NHEAD,u.qb,T.Q,T.K,T.V,T.O,T.KSUM,T.GG,lds); S.done(u); }
}
#undef SBAR
#undef WAIT_BAR
}

#define GAS __attribute__((address_space(1)))
#define LAS __attribute__((address_space(3)))
typedef unsigned short bf16;
typedef unsigned v4u __attribute__((ext_vector_type(4)));
typedef float f32x4 __attribute__((ext_vector_type(4)));
typedef short bf16x8 __attribute__((ext_vector_type(8)));
typedef GAS unsigned gu32;
typedef GAS unsigned long long gu64;
#define RLX_AGENT __ATOMIC_RELAXED, __HIP_MEMORY_SCOPE_AGENT
#define LDS_WAIT() asm volatile("s_waitcnt lgkmcnt(0)" ::: "memory")
#define VM_WAIT() asm volatile("s_waitcnt vmcnt(0)" ::: "memory")
__device__ __forceinline__ unsigned long long rt() { return __builtin_amdgcn_s_memrealtime(); }
__device__ __forceinline__ unsigned f2bf(float f) { unsigned u = __builtin_bit_cast(unsigned, f); return (u + 0x7fffu + ((u >> 16) & 1u)) >> 16; }
__device__ __forceinline__ unsigned pk2(float lo, float hi) { return f2bf(lo) | (f2bf(hi) << 16); }

#define XB_TMO      128
#define XB_XCNT(j)  (256  + 64 * (j))
#define XB_XSUB(j)  (1280 + 64 * (j))
#define XB_XGEN(j)  (2304 + 64 * (j))
#define XB_TOP      3328
#define XB_TOPGEN   3392
#define XCD_BAR_WORDS 3456
#define XB_SPIN_CAP (1u << 18)

__device__ __forceinline__ unsigned xb_ld(unsigned* p)              { return __hip_atomic_load(p, __ATOMIC_RELAXED, __HIP_MEMORY_SCOPE_AGENT); }
__device__ __forceinline__ unsigned xb_add(unsigned* p, unsigned v) { return __hip_atomic_fetch_add(p, v, __ATOMIC_RELAXED, __HIP_MEMORY_SCOPE_AGENT); }
__device__ __forceinline__ unsigned xb_xcc_id() { return (unsigned)__builtin_amdgcn_s_getreg((3 << 11) | 20) & 0xFu; }
#define XB_SPIN(cond, bar) do { unsigned _sp = 0; while (cond) { __builtin_amdgcn_s_sleep(1); \
    if ((++_sp & 255u) == 0u) { if (xb_ld(&(bar)[XB_TMO])) break; if (_sp > XB_SPIN_CAP) { atomicAdd(&(bar)[XB_TMO], 1u); break; } } } } while (0)

struct XcdBarrier {
    unsigned* bar; unsigned x;
    volatile LAS unsigned* st;
};

__device__ __forceinline__ XcdBarrier xcd_barrier_post(unsigned* bar, volatile LAS unsigned* st) {
    XcdBarrier b; b.bar = bar; b.x = xb_xcc_id(); b.st = st;
    if (threadIdx.x == 0) (void)xb_add(&bar[XB_XCNT(b.x)], 1u);
    return b;
}
__device__ __forceinline__ void xcd_barrier_complete(unsigned* bar, unsigned x, unsigned& nloc, unsigned& nx) {
    const unsigned G = gridDim.x * gridDim.y * gridDim.z;
    unsigned sum, cnt, mine, sp = 0u;
    for (;;) {
        sum = 0u; cnt = 0u; mine = 0u;
#pragma unroll
        for (unsigned j = 0; j < 16; ++j) { const unsigned c = xb_ld(&bar[XB_XCNT(j)]); sum += c; cnt += (c > 0u) ? 1u : 0u; mine = (j == x) ? c : mine; }
        if (sum == G) break;
        __builtin_amdgcn_s_sleep(1);
        if ((++sp & 255u) == 0u) { if (xb_ld(&bar[XB_TMO])) break; if (sp > XB_SPIN_CAP) { atomicAdd(&bar[XB_TMO], 1u); break; } }
    }
    nloc = mine > 0u ? mine : 1u; nx = cnt > 0u ? cnt : 1u;
}

__device__ __forceinline__ void xcd_barrier(const XcdBarrier& b) {
    asm volatile("s_waitcnt vmcnt(0)" ::: "memory");
    __syncthreads();
    if (threadIdx.x == 0) {
        unsigned* bar = b.bar;
        __builtin_amdgcn_s_waitcnt(0);
        unsigned nloc = b.st[0], nx = b.st[1];
        if (nloc == 0u) { xcd_barrier_complete(bar, b.x, nloc, nx); b.st[0] = nloc; b.st[1] = nx; }
        const unsigned old = xb_add(&bar[XB_XSUB(b.x)], 1u);
        const unsigned gen = old / nloc;
        if (old + 1u == (gen + 1u) * nloc) {
            asm volatile("s_waitcnt vmcnt(0)" ::: "memory");
            const unsigned og = xb_add(&bar[XB_TOP], 1u);
            const unsigned tg = og / nx;
            if (og + 1u == (tg + 1u) * nx) xb_add(&bar[XB_TOPGEN], 1u);
            else XB_SPIN(xb_ld(&bar[XB_TOPGEN]) == tg, bar);
            __builtin_amdgcn_fence(__ATOMIC_ACQUIRE, "agent");
            xb_add(&bar[XB_XGEN(b.x)], 1u);
            asm volatile("s_waitcnt vmcnt(0)" ::: "memory");
        } else {
            XB_SPIN(xb_ld(&bar[XB_XGEN(b.x)]) == gen, bar);
            __builtin_amdgcn_fence(__ATOMIC_ACQUIRE, "agent");
            asm volatile("s_waitcnt vmcnt(0)" ::: "memory");
        }
    }
    __syncthreads();
}

constexpr int NWAVES = 8;
constexpr int NB = 4, S = 4096, D = 1024, M = NB * S;
constexpr int NIN = 3072, NQ = 2048, NEXP = 16384;
constexpr float EPS = 1e-6f;
constexpr float C2 = 0.125f * 1.4426950408889634f;

constexpr size_t MiB = 1u << 20;
constexpr size_t WS_CTL = 0, CTL_ZERO_BYTES = 256 * 1024;
constexpr size_t WS_MOD = 1 * MiB;
constexpr size_t WS_KMEAN = 128 * 1024;
constexpr size_t WS_KEYS = 1 * MiB + 512 * 1024;
constexpr size_t WS_WIN = 2 * MiB, WS_WO = 8 * MiB, WS_WQ = 10 * MiB;
constexpr size_t WS_EIDX = 14 * MiB, WS_G = 22 * MiB;
constexpr size_t WS_U = 32 * MiB, WS_V = 64 * MiB;
constexpr size_t WS_SU = 48 * MiB, WS_SV = 48 * MiB + 64 * 1024;
constexpr size_t WS_H = 96 * MiB;
constexpr size_t WS_P = 128 * MiB;
constexpr size_t WS_QP = 128 * MiB, WS_O = 192 * MiB;
constexpr size_t WS_Y = 224 * MiB, WS_END = 256 * MiB;
constexpr int CW_BAR = 1024;
constexpr int CW_CMAX = 8192;
constexpr int CW_CMAX3 = CW_CMAX + 3072 + 2048;
constexpr float YQ = 127.f / 6.f;
constexpr int CW_CMAX2 = CW_CMAX + 3072;
constexpr size_t WS_WO8 = 47 * MiB;
constexpr size_t WS_WQ8 = 45 * MiB, WS_RS2 = 44 * MiB + 65536;
constexpr size_t WS_WIN8 = 40 * MiB, WS_RS = 44 * MiB;

constexpr int LDS_BYTES = 153600;
constexpr int LDSCTL_OFF = LDS_BYTES - 512, MISC_OFF = LDSCTL_OFF + 320;
constexpr int RING_BYTES = 131072;

struct Frame {
    LAS unsigned char* lds;
    volatile LAS unsigned* MISC;
    gu32* ctl;
    int tid, lane, wave, G;
    const float *x, *c, *ada_w, *ada_b, *pre_gain, *post_gain, *w_in, *conv_w, *group_gain, *w_out, *fpre_gain, *fpost_gain, *wq, *keys, *pu, *pv;
    float* out;
    float* mod; float* kmean; bf16* keysb; bf16 *WinT, *WoT, *WqT; int* eidx; float* gw; unsigned char *U8, *V8; float *su, *sv; bf16 *H, *P, *QP, *O, *Y; float* scratch; unsigned char* Win8; float* rs; unsigned char* Wq8; float* rs2; unsigned char* Wo8;
};

__device__ __forceinline__ float wave_sum(float v) {
#pragma unroll
    for (int o = 1; o < 64; o <<= 1) v += __shfl_xor(v, o);
    return v;
}
__device__ __forceinline__ float bflo(unsigned u) { return __uint_as_float(u << 16); }
__device__ __forceinline__ float bfhi(unsigned u) { return __uint_as_float(u & 0xffff0000u); }

struct TItem { const float* W; bf16* WT; unsigned* cmax; const float* ksc; int N, k0, n0; };
__device__ __forceinline__ void p0_titem_load(const TItem& t, f32x4 (&v)[8], float (&ks)[8], int lane) {
#pragma unroll
    for (int i = 0; i < 8; ++i) { const int kk = 8 * i + (lane >> 3);
        v[i] = *(const GAS f32x4*)(t.W + (size_t)(t.k0 + kk) * t.N + t.n0 + 4 * (lane & 7));
        ks[i] = t.ksc != nullptr ? t.ksc[t.k0 + kk] * (1.f / YQ) : 1.f; }
}
__device__ __forceinline__ void p0_titem_process(const TItem& t, const f32x4 (&v)[8], const float (&ks)[8], LAS float* scr, int lane) {
#pragma unroll
    for (int i = 0; i < 8; ++i) { const int kk = 8 * i + (lane >> 3); LAS float* d = scr + kk * 33 + 4 * (lane & 7); const f32x4 w = v[i] * ks[i];
        d[0] = w.x; d[1] = w.y; d[2] = w.z; d[3] = w.w; }
    LDS_WAIT(); asm volatile("" ::: "memory");
    const int c = lane & 7;
#pragma unroll
    for (int j = 0; j < 4; ++j) { const int n = (lane >> 3) + 8 * j; const LAS float* s = scr + (8 * c) * 33 + n;
        v4u o; o.x = pk2(s[0 * 33], s[1 * 33]); o.y = pk2(s[2 * 33], s[3 * 33]); o.z = pk2(s[4 * 33], s[5 * 33]); o.w = pk2(s[6 * 33], s[7 * 33]);
        st16_wt((void*)(t.WT + (size_t)(t.n0 + n) * D + t.k0 + 8 * c), o);
        float am = fmaxf(fmaxf(fmaxf(fabsf(s[0 * 33]), fabsf(s[1 * 33])), fmaxf(fabsf(s[2 * 33]), fabsf(s[3 * 33]))), fmaxf(fmaxf(fabsf(s[4 * 33]), fabsf(s[5 * 33])), fmaxf(fabsf(s[6 * 33]), fabsf(s[7 * 33]))));
        am = fmaxf(am, __shfl_xor(am, 1)); am = fmaxf(am, __shfl_xor(am, 2)); am = fmaxf(am, __shfl_xor(am, 4));
        if (c == 0) atomicMax(t.cmax + t.n0 + n, __float_as_uint(am)); }
    LDS_WAIT(); asm volatile("" ::: "memory");
}
__device__ __forceinline__ void cvt8(const float* src, bf16* dst, size_t i8) {
    const f32x4 a = *(const GAS f32x4*)(src + i8 * 8), b = *(const GAS f32x4*)(src + i8 * 8 + 4);
    v4u o; o.x = pk2(a.x, a.y); o.y = pk2(a.z, a.w); o.z = pk2(b.x, b.y); o.w = pk2(b.z, b.w);
    st16_wt((void*)(dst + i8 * 8), o);
}
__device__ __forceinline__ void p0_prep(Frame& F) {
    {
        LAS float* sc = (LAS float*)F.lds;
        LAS float* red = sc + 4096;
        bool did = false;
        for (int it = blockIdx.x; it < 192; it += F.G) {
            if (!did) { for (int i = F.tid; i < 4096; i += 512) { const float v = F.c[i]; sc[i] = v / (1.f + __expf(-v)); } did = true; }
            __syncthreads();
            const int c4 = F.tid & 7, ks = F.tid >> 3, j0 = it * 32 + 4 * c4;
            f32x4 w[16];
#pragma unroll
            for (int i = 0; i < 16; ++i) w[i] = *(const GAS f32x4*)(F.ada_w + (size_t)(ks * 16 + i) * 6144 + j0);
            f32x4 a0 = {0.f, 0.f, 0.f, 0.f}, a1 = a0, a2 = a0, a3 = a0;
#pragma unroll
            for (int i = 0; i < 16; ++i) { const int r = ks * 16 + i; a0 += w[i] * sc[r]; a1 += w[i] * sc[1024 + r]; a2 += w[i] * sc[2048 + r]; a3 += w[i] * sc[3072 + r]; }
            *(LAS f32x4*)(red + (ks * 4 + 0) * 32 + 4 * c4) = a0; *(LAS f32x4*)(red + (ks * 4 + 1) * 32 + 4 * c4) = a1;
            *(LAS f32x4*)(red + (ks * 4 + 2) * 32 + 4 * c4) = a2; *(LAS f32x4*)(red + (ks * 4 + 3) * 32 + 4 * c4) = a3;
            __syncthreads();
            if (F.tid < 128) { const int b = F.tid >> 5, jj = F.tid & 31; float s = 0.f;
#pragma unroll 16
                for (int k = 0; k < 64; ++k) s += red[(k * 4 + b) * 32 + jj];
                __hip_atomic_store(F.mod + b * 6144 + it * 32 + jj, s + F.ada_b[it * 32 + jj], __ATOMIC_RELAXED, __HIP_MEMORY_SCOPE_AGENT); }
        }
        __syncthreads();
    }
    LAS float* scr = (LAS float*)(F.lds + F.wave * 16384);
    const int gwv = blockIdx.x * NWAVES + F.wave, NGW = F.G * NWAVES;
    constexpr int I_IN = (D / 64) * (NIN / 32), I_O = (D / 64) * (D / 32), I_Q = (D / 64) * (NQ / 32), I_ALL = I_IN + I_O + I_Q;
    auto titem = [&](int it) { TItem t; int r = it;
        if (r < I_IN) { t.W = F.w_in; t.WT = F.WinT; t.cmax = (unsigned*)(F.ctl + CW_CMAX); t.ksc = nullptr; t.N = NIN; }
        else if (r < I_IN + I_O) { r -= I_IN; t.W = F.w_out; t.WT = F.WoT; t.cmax = (unsigned*)(F.ctl + CW_CMAX3); t.ksc = F.group_gain; t.N = D; }
        else { r -= I_IN + I_O; t.W = F.wq; t.WT = F.WqT; t.cmax = (unsigned*)(F.ctl + CW_CMAX2); t.ksc = nullptr; t.N = NQ; }
        const int nblk = t.N / 32; t.k0 = 64 * (r / nblk); t.n0 = 32 * (r % nblk); return t; };
    { f32x4 va[8], vb[8]; float ka[8], kb[8]; TItem ta, tb;
      int it = gwv;
      if (it < I_ALL) { ta = titem(it); p0_titem_load(ta, va, ka, F.lane); }
      while (it < I_ALL) {
          const int i1 = it + NGW; const bool h1 = i1 < I_ALL;
          if (h1) { tb = titem(i1); p0_titem_load(tb, vb, kb, F.lane); }
          p0_titem_process(ta, va, ka, scr, F.lane);
          if (!h1) break;
          it = i1 + NGW;
          if (it < I_ALL) { ta = titem(it); p0_titem_load(ta, va, ka, F.lane); }
          p0_titem_process(tb, vb, kb, scr, F.lane);
      } }
    const size_t gt = (size_t)blockIdx.x * 512 + F.tid, NT = (size_t)F.G * 512;
    for (size_t i = gt; i < (size_t)16 * 128 * 128 / 8; i += NT) cvt8(F.keys, F.keysb, i);
}
__device__ __forceinline__ void p0_tables(Frame& F) {
    const int gwv = blockIdx.x * NWAVES + F.wave, NGW = F.G * NWAVES;
    for (int row0 = gwv; row0 < 2 * NEXP; row0 += 2 * NGW) {
      f32x4 a2[2][4];
#pragma unroll
      for (int rr = 0; rr < 2; ++rr) { const int row = row0 + rr * NGW; if (row < 2 * NEXP) { const GAS f32x4* src = (const GAS f32x4*)(((row >> 14) ? F.pv : F.pu) + (size_t)(row & (NEXP - 1)) * D + 16 * F.lane);
#pragma unroll
          for (int i = 0; i < 4; ++i) a2[rr][i] = src[i]; } }
#pragma unroll
      for (int rr = 0; rr < 2; ++rr) { const int row = row0 + rr * NGW; if (row >= 2 * NEXP) break;
        const int tabv = row >> 14, e = row & (NEXP - 1);
        f32x4 a[4]; float ssq = 0.f;
#pragma unroll
        for (int i = 0; i < 4; ++i) { a[i] = a2[rr][i]; ssq += (a[i].x * a[i].x + a[i].y * a[i].y) + (a[i].z * a[i].z + a[i].w * a[i].w); }
        ssq = wave_sum(ssq);
        const float rms = sqrtf(ssq * (1.f / D));
        if (tabv == 0) {
            const float stepq = 0.34f * rms, isq = stepq > 0.f ? 1.f / stepq : 0.f;
            unsigned d0 = 0u, d1 = 0u;
#pragma unroll
            for (int i = 0; i < 4; ++i) { const float xs[4] = {a[i].x, a[i].y, a[i].z, a[i].w};
#pragma unroll
                for (int c = 0; c < 4; ++c) { const int q = (int)fminf(fmaxf(__builtin_rintf(xs[c] * isq), -7.f), 7.f); const int el = 4 * i + c;
                    if (el < 8) d0 |= (unsigned)(q & 15) << (4 * el); else d1 |= (unsigned)(q & 15) << (4 * (el - 8)); } }
            st8_wt((void*)(F.U8 + (size_t)e * 512 + 8 * F.lane), (unsigned long long)d0 | ((unsigned long long)d1 << 32));
            if (F.lane == 0) __hip_atomic_store(F.su + e, stepq, __ATOMIC_RELAXED, __HIP_MEMORY_SCOPE_AGENT);
        } else {
            const float unit = 0.5f * rms, iu = unit > 0.f ? 1.f / unit : 0.f;
            unsigned d0 = 0u, d1 = 0u;
            d0 = __builtin_amdgcn_cvt_scalef32_pk_fp4_f32(d0, a[0].x * iu, a[0].y * iu, 1.0f, 0); d0 = __builtin_amdgcn_cvt_scalef32_pk_fp4_f32(d0, a[0].z * iu, a[0].w * iu, 1.0f, 1);
            d0 = __builtin_amdgcn_cvt_scalef32_pk_fp4_f32(d0, a[1].x * iu, a[1].y * iu, 1.0f, 2); d0 = __builtin_amdgcn_cvt_scalef32_pk_fp4_f32(d0, a[1].z * iu, a[1].w * iu, 1.0f, 3);
            d1 = __builtin_amdgcn_cvt_scalef32_pk_fp4_f32(d1, a[2].x * iu, a[2].y * iu, 1.0f, 0); d1 = __builtin_amdgcn_cvt_scalef32_pk_fp4_f32(d1, a[2].z * iu, a[2].w * iu, 1.0f, 1);
            d1 = __builtin_amdgcn_cvt_scalef32_pk_fp4_f32(d1, a[3].x * iu, a[3].y * iu, 1.0f, 2); d1 = __builtin_amdgcn_cvt_scalef32_pk_fp4_f32(d1, a[3].z * iu, a[3].w * iu, 1.0f, 3);
            st8_wt((void*)(F.V8 + (size_t)(F.lane >> 4) * (NEXP * 128) + (size_t)e * 128 + (F.lane & 15) * 8), (unsigned long long)d0 | ((unsigned long long)d1 << 32));
            if (F.lane == 0) __hip_atomic_store(F.sv + e, unit, __ATOMIC_RELAXED, __HIP_MEMORY_SCOPE_AGENT);
        }
      }
    }
}

__device__ __forceinline__ unsigned q8x4(const f32x4 v, float qs) {
    const int a = (int)__builtin_rintf(v.x * qs), b = (int)__builtin_rintf(v.y * qs), c = (int)__builtin_rintf(v.z * qs), d = (int)__builtin_rintf(v.w * qs);
    return ((unsigned)a & 0xffu) | (((unsigned)b & 0xffu) << 8) | (((unsigned)c & 0xffu) << 16) | ((unsigned)d << 24);
}
__device__ __forceinline__ unsigned q8x4c(const f32x4 v, float qs) {
    const int a = (int)fminf(fmaxf(__builtin_rintf(v.x * qs), -127.f), 127.f), b = (int)fminf(fmaxf(__builtin_rintf(v.y * qs), -127.f), 127.f);
    const int c = (int)fminf(fmaxf(__builtin_rintf(v.z * qs), -127.f), 127.f), d = (int)fminf(fmaxf(__builtin_rintf(v.w * qs), -127.f), 127.f);
    return ((unsigned)a & 0xffu) | (((unsigned)b & 0xffu) << 8) | (((unsigned)c & 0xffu) << 16) | ((unsigned)d << 24);
}
__device__ __forceinline__ void p1_hnorm(Frame& F) {
    const int gwv = blockIdx.x * NWAVES + F.wave, NGW = F.G * NWAVES;
    for (int m0 = gwv * 4; m0 < M; m0 += NGW * 4) {
        const int b = m0 >> 12;
        f32x4 v[4][4];
#pragma unroll
        for (int r = 0; r < 4; ++r) { const GAS f32x4* xr = (const GAS f32x4*)(F.x + (size_t)(m0 + r) * D) + F.lane;
#pragma unroll
            for (int j = 0; j < 4; ++j) v[r][j] = xr[64 * j]; }
        f32x4 gs[4], sh[4];
#pragma unroll
        for (int j = 0; j < 4; ++j) { const int col = 4 * F.lane + 256 * j;
            gs[j] = *(const GAS f32x4*)(F.pre_gain + col) * (*(const GAS f32x4*)(F.mod + b * 6144 + 1024 + col) + 1.f); sh[j] = *(const GAS f32x4*)(F.mod + b * 6144 + col); }
#pragma unroll
        for (int r = 0; r < 4; ++r) {
            float ss = 0.f;
#pragma unroll
            for (int j = 0; j < 4; ++j) ss += (v[r][j].x * v[r][j].x + v[r][j].y * v[r][j].y) + (v[r][j].z * v[r][j].z + v[r][j].w * v[r][j].w);
            const float rstd = rsqrtf(wave_sum(ss) * (1.f / D) + EPS);
            f32x4 o[4]; float am = 0.f;
#pragma unroll
            for (int j = 0; j < 4; ++j) { o[j] = v[r][j] * rstd * gs[j] + sh[j]; am = fmaxf(am, fmaxf(fmaxf(fabsf(o[j].x), fabsf(o[j].y)), fmaxf(fabsf(o[j].z), fabsf(o[j].w)))); }
#pragma unroll
            for (int of = 1; of < 64; of <<= 1) am = fmaxf(am, __shfl_xor(am, of));
            const float qs = am > 0.f ? 127.f / am : 0.f;
            v4u w; w.x = q8x4(o[0], qs); w.y = q8x4(o[1], qs); w.z = q8x4(o[2], qs); w.w = q8x4(o[3], qs);
            st16_wt((void*)((unsigned char*)F.H + (size_t)(m0 + r) * D + 16 * F.lane), w);
            if (F.lane == 0) __hip_atomic_store(F.rs + m0 + r, am * (1.f / 127.f), __ATOMIC_RELAXED, __HIP_MEMORY_SCOPE_AGENT);
        }
    }
    for (int n = gwv; n < NIN; n += NGW) {
        const float cm = __uint_as_float(F.ctl[CW_CMAX + n]); const float qs = cm > 0.f ? 127.f / cm : 0.f;
        const GAS unsigned long long* src = (const GAS unsigned long long*)(F.WinT + (size_t)n * D) + F.lane;
        unsigned long long q[4];
#pragma unroll
        for (int j = 0; j < 4; ++j) q[j] = src[64 * j];
        unsigned wd[4];
#pragma unroll
        for (int j = 0; j < 4; ++j) { const unsigned lo = (unsigned)q[j], hi = (unsigned)(q[j] >> 32); wd[j] = q8x4((f32x4){bflo(lo), bfhi(lo), bflo(hi), bfhi(hi)}, qs); }
        v4u w; w.x = wd[0]; w.y = wd[1]; w.z = wd[2]; w.w = wd[3];
        st16_wt((void*)(F.Win8 + (size_t)n * D + 16 * F.lane), w);
    }
    for (int n = gwv; n < NQ; n += NGW) {
        const float cm = __uint_as_float(F.ctl[CW_CMAX2 + n]); const float qs = cm > 0.f ? 127.f / cm : 0.f;
        const GAS v4u* src = (const GAS v4u*)(F.WqT + (size_t)n * D + 16 * F.lane);
        const v4u q0 = src[0], q1 = src[1];
        v4u w; w.x = q8x4((f32x4){bflo(q0.x), bfhi(q0.x), bflo(q0.y), bfhi(q0.y)}, qs); w.y = q8x4((f32x4){bflo(q0.z), bfhi(q0.z), bflo(q0.w), bfhi(q0.w)}, qs);
        w.z = q8x4((f32x4){bflo(q1.x), bfhi(q1.x), bflo(q1.y), bfhi(q1.y)}, qs); w.w = q8x4((f32x4){bflo(q1.z), bfhi(q1.z), bflo(q1.w), bfhi(q1.w)}, qs);
        st16_wt((void*)(F.Wq8 + (size_t)n * D + 16 * F.lane), w);
    }
    for (int n = gwv; n < D; n += NGW) {
        const float cm = __uint_as_float(F.ctl[CW_CMAX3 + n]); const float qs = cm > 0.f ? 127.f / cm : 0.f;
        const GAS v4u* src = (const GAS v4u*)(F.WoT + (size_t)n * D + 16 * F.lane);
        const v4u q0 = src[0], q1 = src[1];
        v4u w; w.x = q8x4((f32x4){bflo(q0.x), bfhi(q0.x), bflo(q0.y), bfhi(q0.y)}, qs); w.y = q8x4((f32x4){bflo(q0.z), bfhi(q0.z), bflo(q0.w), bfhi(q0.w)}, qs);
        w.z = q8x4((f32x4){bflo(q1.x), bfhi(q1.x), bflo(q1.y), bfhi(q1.y)}, qs); w.w = q8x4((f32x4){bflo(q1.z), bfhi(q1.z), bflo(q1.w), bfhi(q1.w)}, qs);
        st16_wt((void*)(F.Wo8 + (size_t)n * D + 16 * F.lane), w);
    }
}

__device__ __forceinline__ void unpack8(const v4u w, float* f) { f[0] = bflo(w.x); f[1] = bfhi(w.x); f[2] = bflo(w.y); f[3] = bfhi(w.y); f[4] = bflo(w.z); f[5] = bfhi(w.z); f[6] = bflo(w.w); f[7] = bfhi(w.w); }
__device__ __forceinline__ void p6_conv(Frame& F) {
    const int gwv = blockIdx.x * NWAVES + F.wave, NGW = F.G * NWAVES;
    const int col = 8 * F.lane;
    float cw[3][8], gg[8];
#pragma unroll
    for (int j = 0; j < 3; ++j)
#pragma unroll
        for (int i = 0; i < 8; ++i) cw[j][i] = F.conv_w[j * 512 + col + i];
#pragma unroll
    for (int i = 0; i < 8; ++i) gg[i] = F.group_gain[col + i];
    for (int t0 = gwv * 4; t0 < M; t0 += NGW * 4) {
        const int s0 = t0 & 4095;
        v4u gbw[4], gcw[6], hxw[6];
#pragma unroll
        for (int r = 0; r < 4; ++r) gbw[r] = *(const GAS v4u*)(F.P + (size_t)(t0 + r) * NIN + col);
#pragma unroll
        for (int k = 0; k < 6; ++k) { const int tt = (s0 == 0 && k < 2) ? t0 : (t0 - 2 + k);
            const bf16* rp = F.P + (size_t)tt * NIN + col; gcw[k] = *(const GAS v4u*)(rp + 512); hxw[k] = *(const GAS v4u*)(rp + 1024); }
        float u[6][8];
#pragma unroll
        for (int k = 0; k < 6; ++k) { float gc[8], hx[8]; unpack8(gcw[k], gc); unpack8(hxw[k], hx); const float keep = (s0 == 0 && k < 2) ? 0.f : 1.f;
#pragma unroll
            for (int i = 0; i < 8; ++i) u[k][i] = keep * gc[i] * hx[i]; }
#pragma unroll
        for (int r = 0; r < 4; ++r) {
            float acc[8], gb[8]; unpack8(gbw[r], gb);
            float ss = 0.f;
#pragma unroll
            for (int i = 0; i < 8; ++i) { acc[i] = gb[i] * (cw[0][i] * u[r][i] + cw[1][i] * u[r + 1][i] + cw[2][i] * u[r + 2][i]); ss += acc[i] * acc[i]; }
            ss += __shfl_xor(ss, 1); ss += __shfl_xor(ss, 2); ss += __shfl_xor(ss, 4);
            const float rstd = rsqrtf(ss * (1.f / 64.f) + EPS);
            const float qn = rstd * YQ;
            const unsigned w0 = q8x4c((f32x4){acc[0], acc[1], acc[2], acc[3]}, qn), w1 = q8x4c((f32x4){acc[4], acc[5], acc[6], acc[7]}, qn);
            st8_wt((void*)((unsigned char*)F.Y + (size_t)(t0 + r) * D + col), (unsigned long long)w0 | ((unsigned long long)w1 << 32));
        }
    }
}
__device__ __forceinline__ void p8_resid(Frame& F) {
    const int gwv = blockIdx.x * NWAVES + F.wave, NGW = F.G * NWAVES;
    for (int m0 = gwv * 2; m0 < M; m0 += NGW * 2) {
        const float* md = F.mod + (m0 >> 12) * 6144;
        unsigned long long ow[2][4]; f32x4 xv[2][4];
#pragma unroll
        for (int r = 0; r < 2; ++r) {
            const GAS unsigned long long* orow = (const GAS unsigned long long*)(F.O + (size_t)(m0 + r) * D) + F.lane; const GAS f32x4* xr = (const GAS f32x4*)(F.x + (size_t)(m0 + r) * D) + F.lane;
#pragma unroll
            for (int j = 0; j < 4; ++j) { ow[r][j] = orow[64 * j]; xv[r][j] = xr[64 * j]; } }
        f32x4 gg[4], gs[4], sh[4];
#pragma unroll
        for (int j = 0; j < 4; ++j) { const int col = 4 * F.lane + 256 * j;
            gg[j] = *(const GAS f32x4*)(F.post_gain + col) * *(const GAS f32x4*)(md + 2048 + col);
            gs[j] = *(const GAS f32x4*)(F.fpre_gain + col) * (*(const GAS f32x4*)(md + 4096 + col) + 1.f); sh[j] = *(const GAS f32x4*)(md + 3072 + col); }
#pragma unroll
        for (int r = 0; r < 2; ++r) { const int m = m0 + r;
            f32x4 ov[4]; float ss = 0.f;
#pragma unroll
            for (int j = 0; j < 4; ++j) { const unsigned lo = (unsigned)ow[r][j], hi = (unsigned)(ow[r][j] >> 32); ov[j] = (f32x4){bflo(lo), bfhi(lo), bflo(hi), bfhi(hi)};
                ss += (ov[j].x * ov[j].x + ov[j].y * ov[j].y) + (ov[j].z * ov[j].z + ov[j].w * ov[j].w); }
            const float rstd = rsqrtf(wave_sum(ss) * (1.f / D) + EPS);
            GAS unsigned long long* x1r = (GAS unsigned long long*)(F.QP + (size_t)m * D) + F.lane;
            f32x4 x1[4]; float s2 = 0.f;
#pragma unroll
            for (int j = 0; j < 4; ++j) { x1[j] = xv[r][j] + gg[j] * (ov[j] * rstd); st8_wt((void*)(x1r + 64 * j), (unsigned long long)pk2(x1[j].x, x1[j].y) | ((unsigned long long)pk2(x1[j].z, x1[j].w) << 32));
                s2 += (x1[j].x * x1[j].x + x1[j].y * x1[j].y) + (x1[j].z * x1[j].z + x1[j].w * x1[j].w); }
            const float rstd2 = rsqrtf(wave_sum(s2) * (1.f / D) + EPS);
            f32x4 o[4]; float am = 0.f;
#pragma unroll
            for (int j = 0; j < 4; ++j) { o[j] = x1[j] * rstd2 * gs[j] + sh[j]; am = fmaxf(am, fmaxf(fmaxf(fabsf(o[j].x), fabsf(o[j].y)), fmaxf(fabsf(o[j].z), fabsf(o[j].w)))); }
#pragma unroll
            for (int of = 1; of < 64; of <<= 1) am = fmaxf(am, __shfl_xor(am, of));
            const float qs = am > 0.f ? 119.f / am : 0.f;
#pragma unroll
            for (int j = 0; j < 4; ++j) st4_wt((void*)((unsigned char*)F.H + (size_t)m * D + 4 * F.lane + 256 * j), q8x4(o[j], qs));
            if (F.lane == 0) __hip_atomic_store(F.rs2 + m, am * (1.f / 119.f), __ATOMIC_RELAXED, __HIP_MEMORY_SCOPE_AGENT);
        }
    }
}
typedef float f32x16 __attribute__((ext_vector_type(16)));
__device__ __forceinline__ float vmaxf(float a, float b) { float r; asm("v_max_f32_e32 %0, %1, %2" : "=v"(r) : "v"(a), "v"(b)); return r; }
__device__ __forceinline__ float vminf(float a, float b) { float r; asm("v_min_f32_e32 %0, %1, %2" : "=v"(r) : "v"(a), "v"(b)); return r; }
#define CE_D(a, b) do { const float hi_ = vmaxf(a, b), lo_ = vminf(a, b); a = hi_; b = lo_; } while (0)
template <int N> __device__ __forceinline__ void bitonic_sort_desc(float (&v)[N]) {
#pragma unroll
    for (int k = 2; k <= N; k <<= 1)
#pragma unroll
        for (int j = k >> 1; j > 0; j >>= 1)
#pragma unroll
            for (int i = 0; i < N; ++i) { const int l = i ^ j; if (l > i) { if ((i & k) == 0) CE_D(v[i], v[l]); else CE_D(v[l], v[i]); } }
}
template <int N> __device__ __forceinline__ void bitonic_merge_desc(float (&v)[N]) {
#pragma unroll
    for (int j = N >> 1; j > 0; j >>= 1)
#pragma unroll
        for (int i = 0; i < N; ++i) { const int l = i ^ j; if (l > i) CE_D(v[i], v[l]); }
}
__device__ __forceinline__ void sort16_desc(float (&v)[16]) {
    CE_D(v[0], v[1]); CE_D(v[2], v[3]); CE_D(v[0], v[2]); CE_D(v[1], v[3]); CE_D(v[1], v[2]); CE_D(v[4], v[5]); CE_D(v[6], v[7]); CE_D(v[4], v[6]); CE_D(v[5], v[7]); CE_D(v[5], v[6]); CE_D(v[0], v[4]); CE_D(v[2], v[6]); CE_D(v[2], v[4]); CE_D(v[1], v[5]); CE_D(v[3], v[7]); CE_D(v[3], v[5]); CE_D(v[1], v[2]); CE_D(v[3], v[4]); CE_D(v[5], v[6]); CE_D(v[8], v[9]); CE_D(v[10], v[11]); CE_D(v[8], v[10]); CE_D(v[9], v[11]); CE_D(v[9], v[10]); CE_D(v[12], v[13]); CE_D(v[14], v[15]); CE_D(v[12], v[14]); CE_D(v[13], v[15]); CE_D(v[13], v[14]); CE_D(v[8], v[12]); CE_D(v[10], v[14]); CE_D(v[10], v[12]); CE_D(v[9], v[13]); CE_D(v[11], v[15]); CE_D(v[11], v[13]); CE_D(v[9], v[10]); CE_D(v[11], v[12]); CE_D(v[13], v[14]); CE_D(v[0], v[8]); CE_D(v[4], v[12]); CE_D(v[4], v[8]); CE_D(v[2], v[10]); CE_D(v[6], v[14]); CE_D(v[6], v[10]); CE_D(v[2], v[4]); CE_D(v[6], v[8]); CE_D(v[10], v[12]); CE_D(v[1], v[9]); CE_D(v[5], v[13]); CE_D(v[5], v[9]); CE_D(v[3], v[11]); CE_D(v[7], v[15]); CE_D(v[7], v[11]); CE_D(v[3], v[5]); CE_D(v[7], v[9]); CE_D(v[11], v[13]); CE_D(v[1], v[2]); CE_D(v[3], v[4]); CE_D(v[5], v[6]); CE_D(v[7], v[8]); CE_D(v[9], v[10]); CE_D(v[11], v[12]); CE_D(v[13], v[14]);
}
__device__ __forceinline__ void top16_merge(float (&a)[16], const float (&b)[16]) {
#pragma unroll
    for (int i = 0; i < 16; ++i) a[i] = vmaxf(a[i], b[15 - i]);
    bitonic_merge_desc<16>(a);
}
__device__ __forceinline__ void top16_of_64(const float (&v)[64], float (&out)[16]) {
    float g1[16], g2[16], g3[16];
#pragma unroll
    for (int i = 0; i < 16; ++i) { out[i] = v[i]; g1[i] = v[16 + i]; g2[i] = v[32 + i]; g3[i] = v[48 + i]; }
    sort16_desc(out); sort16_desc(g1); sort16_desc(g2); sort16_desc(g3);
    top16_merge(out, g1); top16_merge(g2, g3); top16_merge(out, g2);
}
constexpr int KROW = 272, KIMG = 128 * KROW;
__device__ __forceinline__ void route_half(const bf16x8 (&bq)[8], const LAS unsigned char* kimg, int r32, int hh, float (&svp)[16], unsigned (&ivp)[16]) {
    const LAS unsigned char* krow = kimg + r32 * KROW + 16 * hh;
    f32x16 acc[4];
#pragma unroll
    for (int nt = 0; nt < 4; ++nt) {
        acc[nt] = (f32x16){0.f, 0.f, 0.f, 0.f, 0.f, 0.f, 0.f, 0.f, 0.f, 0.f, 0.f, 0.f, 0.f, 0.f, 0.f, 0.f};
#pragma unroll
        for (int ks = 0; ks < 8; ++ks) { const bf16x8 ak = *(const LAS bf16x8*)(krow + nt * 32 * KROW + 32 * ks);
            acc[nt] = __builtin_amdgcn_mfma_f32_32x32x16_bf16(ak, bq[ks], acc[nt], 0, 0, 0); }
    }
    float v[64];
#pragma unroll
    for (int nt = 0; nt < 4; ++nt)
#pragma unroll
        for (int i = 0; i < 16; ++i) { const unsigned code = (unsigned)(32 * nt + 8 * (i >> 2) + (i & 3)); v[nt * 16 + i] = __uint_as_float((__float_as_uint(acc[nt][i]) & ~127u) | code); }
    float L[16], Pn[16];
    top16_of_64(v, L);
#pragma unroll
    for (int i = 0; i < 16; ++i) { L[i] = __uint_as_float(__float_as_uint(L[i]) | (unsigned)(hh << 2)); Pn[i] = __shfl_xor(L[i], 32); }
    top16_merge(L, Pn);
#pragma unroll
    for (int i = 0; i < 16; ++i) { const unsigned bits = __float_as_uint(L[i]); svp[i] = __uint_as_float(bits & ~127u); ivp[i] = bits & 127u; }
}
__device__ __forceinline__ void route_finish(const float (&sv)[2][16], const unsigned (&iv)[2][16], LAS unsigned* tab, int lane, int hh, int* epi, float* gpf, float rst) {
#define CAND(a, b) __uint_as_float((__float_as_uint(sv[0][a] + sv[1][b]) & ~255u) | (unsigned)((a) * 16 + (b)))
    float W[16], g1[16], g2[16];
#pragma unroll
    for (int i = 0; i < 16; ++i) W[i] = CAND(0, i);
#pragma unroll
    for (int i = 0; i < 15; ++i) g1[i] = CAND(i + 1, 0);
    g1[15] = -3e38f;
    g2[0] = CAND(1, 1); g2[1] = CAND(1, 2); g2[2] = CAND(1, 3); g2[3] = CAND(1, 4); g2[4] = CAND(1, 5); g2[5] = CAND(1, 6); g2[6] = CAND(1, 7);
    g2[7] = CAND(2, 1); g2[8] = CAND(2, 2); g2[9] = CAND(2, 3); g2[10] = CAND(2, 4); g2[11] = CAND(3, 1); g2[12] = CAND(3, 2); g2[13] = CAND(3, 3); g2[14] = CAND(4, 1); g2[15] = CAND(4, 2);
    sort16_desc(g2);
    g2[13] = vmaxf(g2[13], CAND(7, 1)); g2[14] = vmaxf(g2[14], CAND(6, 1)); g2[15] = vmaxf(g2[15], CAND(5, 1));
    bitonic_merge_desc<16>(g2);
    top16_merge(W, g1); top16_merge(W, g2);
#undef CAND
#pragma unroll
    for (int j = 0; j < 16; ++j) { tab[j * 64 + lane] = iv[0][j]; tab[(16 + j) * 64 + lane] = iv[1][j]; }
    float e[16], sum = 0.f; unsigned ex[16];
    const float s0 = __uint_as_float(__float_as_uint(W[0]) & ~255u);
#pragma unroll
    for (int j = 0; j < 16; ++j) { const unsigned bits = __float_as_uint(W[j]); const unsigned code = bits & 255u;
        e[j] = __expf((__uint_as_float(bits & ~255u) - s0) * rst); sum += e[j];
        ex[j] = tab[(code >> 4) * 64 + lane] * 128u + tab[(16 + (code & 15u)) * 64 + lane]; }
    const float inv = 1.f / sum;
    v4u eo0, eo1; f32x4 go0, go1;
    eo0.x = hh ? ex[8] : ex[0]; eo0.y = hh ? ex[9] : ex[1]; eo0.z = hh ? ex[10] : ex[2]; eo0.w = hh ? ex[11] : ex[3];
    eo1.x = hh ? ex[12] : ex[4]; eo1.y = hh ? ex[13] : ex[5]; eo1.z = hh ? ex[14] : ex[6]; eo1.w = hh ? ex[15] : ex[7];
    go0.x = (hh ? e[8] : e[0]) * inv; go0.y = (hh ? e[9] : e[1]) * inv; go0.z = (hh ? e[10] : e[2]) * inv; go0.w = (hh ? e[11] : e[3]) * inv;
    go1.x = (hh ? e[12] : e[4]) * inv; go1.y = (hh ? e[13] : e[5]) * inv; go1.z = (hh ? e[14] : e[6]) * inv; go1.w = (hh ? e[15] : e[7]) * inv;
    GAS v4u* ep = (GAS v4u*)epi; GAS f32x4* gp = (GAS f32x4*)gpf;
    st16_wt((void*)ep, eo0); st16_wt((void*)(ep + 1), eo1); st16_wt((void*)gp, __builtin_bit_cast(wt_v4u, go0)); st16_wt((void*)(gp + 1), __builtin_bit_cast(wt_v4u, go1));
}
__device__ __forceinline__ pg8::f32x4 i2f(const pg8::f32x4 a) { const pg8::i32x4 i = __builtin_bit_cast(pg8::i32x4, a); return (pg8::f32x4){(float)i[0], (float)i[1], (float)i[2], (float)i[3]}; }
struct EpiRoute {
    static constexpr bool PERM = true, AFTER_DRAIN = true;
    const bf16* keysb; int* eidx; float* gw; const unsigned* cmax2; const float* rs2;
    __device__ __forceinline__ void fused(pg8::f32x4 (&acc)[2][2][4][2], const pg8::Unit& u, int wr, int wc, int fr, int fq, LAS unsigned char* lds, int wid, int lane) const {
        int tid_ = threadIdx.x; asm volatile("" : "+v"(tid_)); const int h = u.pn, r32 = lane & 31, hh = lane >> 5, tid = tid_;
        LAS unsigned char* Qs = lds; LAS unsigned char* Ks = lds + 256 * KROW;
        v4u q1[2][4];
#pragma unroll
        for (int ai = 0; ai < 2; ++ai)
#pragma unroll
            for (int m = 0; m < 4; ++m) { const pg8::f32x4 a = i2f(acc[ai][1][m][0]), b = i2f(acc[ai][1][m][1]);
                q1[ai][m] = (v4u){pg8::cvt_pk_bf16(a[0], a[1]), pg8::cvt_pk_bf16(a[2], a[3]), pg8::cvt_pk_bf16(b[0], b[1]), pg8::cvt_pk_bf16(b[2], b[3])}; }
        float sv[2][16]; unsigned iv[2][16];
#pragma unroll
        for (int p = 0; p < 2; ++p) {
            if (p == 1) { asm volatile("s_waitcnt lgkmcnt(0)" ::: "memory"); __builtin_amdgcn_s_barrier(); asm volatile("" ::: "memory"); }
#pragma unroll
            for (int ai = 0; ai < 2; ++ai)
#pragma unroll
                for (int m = 0; m < 4; ++m) { v4u w;
                    if (p == 0) { const pg8::f32x4 a = i2f(acc[ai][0][m][0]), b = i2f(acc[ai][0][m][1]);
                        w = (v4u){pg8::cvt_pk_bf16(a[0], a[1]), pg8::cvt_pk_bf16(a[2], a[3]), pg8::cvt_pk_bf16(b[0], b[1]), pg8::cvt_pk_bf16(b[2], b[3])}; }
                    else w = q1[ai][m];
                    *(LAS v4u*)(Qs + (128 * ai + 64 * wr + 16 * m + fr) * KROW + (32 * wc + 8 * fq) * 2) = w; }
            { const int ch = tid & 15; const pg8::u32x4 c0 = *(const pg8::u32x4*)(cmax2 + h * 256 + p * 128 + ch * 8), c1 = *(const pg8::u32x4*)(cmax2 + h * 256 + p * 128 + ch * 8 + 4);
              float cs[8] = {__uint_as_float(c0.x), __uint_as_float(c0.y), __uint_as_float(c0.z), __uint_as_float(c0.w), __uint_as_float(c1.x), __uint_as_float(c1.y), __uint_as_float(c1.z), __uint_as_float(c1.w)};
#pragma unroll
              for (int i = 0; i < 8; ++i) cs[i] *= (1.f / 127.f);
              for (int c = tid; c < 128 * 16; c += NWAVES * 64) { const int row = c >> 4;
                const v4u kq = *(const GAS v4u*)(keysb + (size_t)((h * 2 + p) * 128 + row) * 128 + ch * 8);
                v4u ko; ko.x = pk2(bflo(kq.x) * cs[0], bfhi(kq.x) * cs[1]); ko.y = pk2(bflo(kq.y) * cs[2], bfhi(kq.y) * cs[3]); ko.z = pk2(bflo(kq.z) * cs[4], bfhi(kq.z) * cs[5]); ko.w = pk2(bflo(kq.w) * cs[6], bfhi(kq.w) * cs[7]);
                *(LAS v4u*)(Ks + row * KROW + ch * 16) = ko; } }
            asm volatile("s_waitcnt vmcnt(0) lgkmcnt(0)" ::: "memory"); __builtin_amdgcn_s_barrier(); asm volatile("" ::: "memory");
            bf16x8 bq[8];
#pragma unroll
            for (int ks = 0; ks < 8; ++ks) bq[ks] = *(const LAS bf16x8*)(Qs + (32 * wid + r32) * KROW + 32 * ks + 16 * hh);
            route_half(bq, Ks, r32, hh, sv[p], iv[p]);
        }
        asm volatile("s_waitcnt lgkmcnt(0)" ::: "memory"); __builtin_amdgcn_s_barrier(); asm volatile("" ::: "memory");
        const int t = u.pm * 256 + 32 * wid + r32;
        route_finish(sv, iv, (LAS unsigned*)(lds + wid * 8192), lane, hh, eidx + (size_t)t * 128 + h * 16 + 8 * hh, gw + (size_t)t * 128 + h * 16 + 8 * hh, rs2[t]);
        asm volatile("s_waitcnt lgkmcnt(0)" ::: "memory"); __builtin_amdgcn_s_barrier(); asm volatile("" ::: "memory");
    }
};
struct OneUnit {
    pg8::Unit u;
    __device__ __forceinline__ bool next(int i, pg8::Unit& o) const { if (i != 0) return false; o = u; return true; }
    __device__ __forceinline__ void a_ready(const pg8::Unit&) const {}
    __device__ __forceinline__ void done(const pg8::Unit&) const {}
};
__device__ __forceinline__ float gelu_tanh(float a) {
    const float z = 0.7978845608028654f * (a + 0.044715f * a * a * a);
    const float e = __expf(2.f * z);
    const float th = 1.f - 2.f / (e + 1.f);
    return 0.5f * a * (1.f + th);
}
typedef float f32x2v __attribute__((ext_vector_type(2)));
__device__ __forceinline__ void fp8x16_to_f32(const v4u w, float* f) {
    f32x2v t;
    t = __builtin_amdgcn_cvt_pk_f32_fp8((int)w.x, false); f[0] = t.x; f[1] = t.y; t = __builtin_amdgcn_cvt_pk_f32_fp8((int)w.x, true); f[2] = t.x; f[3] = t.y;
    t = __builtin_amdgcn_cvt_pk_f32_fp8((int)w.y, false); f[4] = t.x; f[5] = t.y; t = __builtin_amdgcn_cvt_pk_f32_fp8((int)w.y, true); f[6] = t.x; f[7] = t.y;
    t = __builtin_amdgcn_cvt_pk_f32_fp8((int)w.z, false); f[8] = t.x; f[9] = t.y; t = __builtin_amdgcn_cvt_pk_f32_fp8((int)w.z, true); f[10] = t.x; f[11] = t.y;
    t = __builtin_amdgcn_cvt_pk_f32_fp8((int)w.w, false); f[12] = t.x; f[13] = t.y; t = __builtin_amdgcn_cvt_pk_f32_fp8((int)w.w, true); f[14] = t.x; f[15] = t.y;
}
#define DPPF(x, ctrl) __uint_as_float((unsigned)__builtin_amdgcn_mov_dpp((int)__float_as_uint(x), ctrl, 0xf, 0xf, true))
__device__ __forceinline__ void swap16_add(float& a, float b) { auto r = __builtin_amdgcn_permlane16_swap(__float_as_uint(a), __float_as_uint(b), false, false); a = __uint_as_float(r[0]) + __uint_as_float(r[1]); }
__device__ __forceinline__ void swap32_add(float& a, float b) { auto r = __builtin_amdgcn_permlane32_swap(__float_as_uint(a), __float_as_uint(b), false, false); a = __uint_as_float(r[0]) + __uint_as_float(r[1]); }
constexpr int PW_BUF0 = 0, PW_SG = 4096, PW_BUF1 = 8192, PW_E = 16384, PW_WH = 17408, PW_WL = 17920, PW_YP = 18432, PW_IK = 18944, PW_BYTES = 18976;
static_assert(PW_BYTES * NWAVES <= LDSCTL_OFF, "PEER per-wave LDS blocks must stay below the control words");
typedef int v8i_t __attribute__((ext_vector_type(8)));
typedef int v2i_t __attribute__((ext_vector_type(2)));
__device__ __forceinline__ void peer_u_issue(v4u (&uw)[8], const unsigned char* U4, LAS unsigned char* wl, int it, int lane) {
    const int grp = it >> 2, j = it & 3, hw = lane >> 5, li = lane & 31;
#pragma unroll
    for (int q = 0; q < 8; ++q) { const unsigned e = *(const LAS unsigned short*)(wl + PW_E + (j * 128 + grp * 16 + 2 * q + hw) * 2);
        uw[q] = *(const GAS v4u*)(U4 + (e * 512u + 16u * (unsigned)li)); }
}
__device__ __forceinline__ void peer_u_compute(const v4u (&uw)[8], LAS unsigned char* wl, int it, int lane) {
    const int grp = it >> 2, j = it & 3, li = lane & 31;
    const v4u hh = *(LAS v4u*)(wl + j * 1024 + 16 * li), hl = *(LAS v4u*)(wl + j * 1024 + 512 + 16 * li);
    float pa[8];
#pragma unroll
    for (int q = 0; q < 8; ++q) {
        int dh = __builtin_amdgcn_sdot8((int)uw[q].x, (int)hh.x, 0, false); dh = __builtin_amdgcn_sdot8((int)uw[q].y, (int)hh.y, dh, false);
        dh = __builtin_amdgcn_sdot8((int)uw[q].z, (int)hh.z, dh, false); dh = __builtin_amdgcn_sdot8((int)uw[q].w, (int)hh.w, dh, false);
        int dl = __builtin_amdgcn_sdot8((int)uw[q].x, (int)hl.x, 0, false); dl = __builtin_amdgcn_sdot8((int)uw[q].y, (int)hl.y, dl, false);
        dl = __builtin_amdgcn_sdot8((int)uw[q].z, (int)hl.z, dl, false); dl = __builtin_amdgcn_sdot8((int)uw[q].w, (int)hl.w, dl, false);
        pa[q] = (float)(16 * dh + dl); }
    swap16_add(pa[0], pa[4]); swap16_add(pa[1], pa[5]); swap16_add(pa[2], pa[6]); swap16_add(pa[3], pa[7]);
#pragma unroll
    for (int i = 0; i < 4; ++i) { pa[i] += DPPF(pa[i], 0xB1); pa[i] += DPPF(pa[i], 0x4E); pa[i] += DPPF(pa[i], 0x141); pa[i] += DPPF(pa[i], 0x140); }
    if ((lane & 12) == 0) {
        const int q = lane & 3, r = lane >> 4;
        const int idx = j * 128 + grp * 16 + 2 * (q + 4 * (r & 1)) + (r >> 1);
        const f32x2v sg = *(const LAS f32x2v*)(wl + PW_SG + idx * 8);
        const float a = (q == 0 ? pa[0] : q == 1 ? pa[1] : q == 2 ? pa[2] : pa[3]) * sg.x;
        *(LAS float*)(wl + PW_BUF1 + idx * 4) = sg.y * gelu_tanh(a);
    }
}
__device__ __forceinline__ void peer_v_issue(const unsigned char* V8, LAS unsigned char* wl, unsigned lbase, int it, int lane, unsigned c16e, unsigned c16o) {
    const int sl = it >> 3, j = (it >> 1) & 3, hf = it & 1;
    const unsigned char* vbase = V8 + (size_t)sl * (NEXP * 128);
    const unsigned dst = lbase + PW_BUF0 + (it & 1) * 8192;
    unsigned go[8];
#pragma unroll
    for (int q = 0; q < 8; ++q) { const unsigned e = *(const LAS unsigned short*)(wl + PW_E + (j * 128 + 64 * hf + 8 * q + (lane >> 3)) * 2); go[q] = e * 128u + ((q & 1) ? c16o : c16e); }
#pragma unroll
    for (int q = 0; q < 8; ++q) attn_body::glds16s(vbase, go[q], (unsigned)__builtin_amdgcn_readfirstlane((int)(dst + q * 1024)));
}
__device__ __forceinline__ void peer_v_compute(LAS unsigned char* wl, f32x4 (&acc)[8], bf16* yrow0, int it, int lane) {
    const int sl = it >> 3, j = (it >> 1) & 3, hf = it & 1;
    const int m = lane & 15, kg = lane >> 4;
    const LAS unsigned char* wsrc = wl + ((m & 1) ? PW_WL : PW_WH) + j * 128 + 64 * hf + 16 * (kg & 1);
    const v4u a0 = *(const LAS v4u*)wsrc, a1 = *(const LAS v4u*)(wsrc + 32);
    const bool valid = (m < 4) && ((m >> 1) == (kg >> 1));
    v8i_t A;
    A[0] = valid ? (int)a0.x : 0; A[1] = valid ? (int)a0.y : 0; A[2] = valid ? (int)a0.z : 0; A[3] = valid ? (int)a0.w : 0;
    A[4] = valid ? (int)a1.x : 0; A[5] = valid ? (int)a1.y : 0; A[6] = valid ? (int)a1.z : 0; A[7] = valid ? (int)a1.w : 0;
    if (hf == 0) {
#pragma unroll
        for (int T = 0; T < 8; ++T) acc[T] = (f32x4){0.f, 0.f, 0.f, 0.f};
    }
    const LAS unsigned char* bb = wl + PW_BUF0 + (it & 1) * 8192 + (32 * (kg >> 1) + m) * 128 + 8 * (kg & 1);
    const unsigned x16 = (unsigned)(m >> 1) * 16u;
#pragma unroll
    for (int T = 0; T < 8; ++T) {
        const LAS unsigned char* p = bb + ((16u * T) ^ x16);
        const v2i_t b0 = __builtin_amdgcn_ds_read_tr4_b64_v2i32((LAS v2i_t*)p), b1 = __builtin_amdgcn_ds_read_tr4_b64_v2i32((LAS v2i_t*)(p + 2048));
        const v8i_t B = {b0.x, b0.y, b1.x, b1.y, 0, 0, 0, 0};
        acc[T] = __builtin_amdgcn_mfma_scale_f32_16x16x128_f8f6f4(A, B, acc[T], 0, 4, 0, 0x7f7f7f7f, 0, 0x7f7f7f7f);
    }
    if (hf == 1) {
        const float ik = *(const LAS float*)(wl + PW_IK + j * 4);
        LAS unsigned char* yp = lane < 16 ? wl + PW_YP + m * 2 : wl + PW_IK + 16;
        const int ystep = lane < 16 ? 1 : 0;
#pragma unroll
        for (int T = 0; T < 8; ++T) {
            *(LAS unsigned short*)(yp + ystep * (64 * T)) = (unsigned short)f2bf((acc[T][0] + acc[T][1]) * ik);
            *(LAS unsigned short*)(yp + ystep * (64 * T + 32)) = (unsigned short)f2bf((acc[T][2] + acc[T][3]) * ik);
        }
        asm volatile("" ::: "memory");
        const unsigned long long pk = *(const LAS unsigned long long*)(wl + PW_YP + 8 * lane);
        *(GAS unsigned long long*)(yrow0 + (size_t)j * D + 256 * sl + 4 * lane) = pk;
    }
}
__device__ __forceinline__ void p11_peer(Frame& F, float* dst) {
    const int gwv = blockIdx.x * NWAVES + F.wave, NGW = F.G * NWAVES, lane = F.lane;
    LAS unsigned char* wl = F.lds + F.wave * PW_BYTES;
    const unsigned lbase = (unsigned)__builtin_amdgcn_readfirstlane((int)(unsigned)(size_t)wl);
    const unsigned c16e = (unsigned)(((lane & 7) ^ (lane >> 4)) * 16), c16o = (unsigned)(((lane & 7) ^ (4 + (lane >> 4))) * 16);
    const unsigned char* U8 = F.U8; const unsigned char* V8 = F.V8;
    for (int t0 = gwv * 4; t0 < M; t0 += NGW * 4) {
        bf16* yrow0 = F.Y + (size_t)t0 * D;
#pragma unroll
        for (int j = 0; j < 4; ++j) {
            const int t = t0 + j;
            const v4u hq = *(const GAS v4u*)((const unsigned char*)F.H + (size_t)t * D + 16 * lane);
            const float hinv = F.rs2[t];
            const unsigned hw[4] = {hq.x, hq.y, hq.z, hq.w};
            unsigned hh0 = 0u, hh1 = 0u, hl0 = 0u, hl1 = 0u;
#pragma unroll
            for (int i = 0; i < 16; ++i) { const int hv_ = (int)(signed char)((hw[i >> 2] >> (8 * (i & 3))) & 0xffu); const int lo = ((hv_ + 8) & 15) - 8; const int hi = (hv_ - lo) >> 4;
                if (i < 8) { hh0 |= (unsigned)(hi & 15) << (4 * i); hl0 |= (unsigned)(lo & 15) << (4 * i); } else { hh1 |= (unsigned)(hi & 15) << (4 * (i - 8)); hl1 |= (unsigned)(lo & 15) << (4 * (i - 8)); } }
            *(LAS unsigned long long*)(wl + j * 1024 + 8 * lane) = (unsigned long long)hh0 | ((unsigned long long)hh1 << 32);
            *(LAS unsigned long long*)(wl + j * 1024 + 512 + 8 * lane) = (unsigned long long)hl0 | ((unsigned long long)hl1 << 32);
            const int e0 = F.eidx[(size_t)t * 128 + lane], e1 = F.eidx[(size_t)t * 128 + 64 + lane];
            const f32x2v sg0 = (f32x2v){F.su[e0] * hinv, F.gw[(size_t)t * 128 + lane] * F.sv[e0]}, sg1 = (f32x2v){F.su[e1] * hinv, F.gw[(size_t)t * 128 + 64 + lane] * F.sv[e1]};
            int base = 0;
#pragma unroll
            for (int sl = 0; sl < 4; ++sl) {
                const bool m0 = (e0 >> 12) == sl, m1 = (e1 >> 12) == sl;
                const unsigned long long b0 = __ballot(m0), b1 = __ballot(m1);
                const int c0 = __popcll(b0), c1 = __popcll(b1);
                const int p0 = j * 128 + base + __builtin_amdgcn_mbcnt_hi((unsigned)(b0 >> 32), __builtin_amdgcn_mbcnt_lo((unsigned)b0, 0));
                const int p1 = j * 128 + base + c0 + __builtin_amdgcn_mbcnt_hi((unsigned)(b1 >> 32), __builtin_amdgcn_mbcnt_lo((unsigned)b1, 0));
                if (m0) { *(LAS unsigned short*)(wl + PW_E + p0 * 2) = (unsigned short)e0; *(LAS f32x2v*)(wl + PW_SG + p0 * 8) = sg0; }
                if (m1) { *(LAS unsigned short*)(wl + PW_E + p1 * 2) = (unsigned short)e1; *(LAS f32x2v*)(wl + PW_SG + p1 * 8) = sg1; }
                base += c0 + c1;
            }
        }
        asm volatile("" ::: "memory");
        {
            v4u ua[8], ub[8];
            peer_u_issue(ua, U8, wl, 0, lane);
#pragma unroll 1
            for (int it = 0; it < 32; it += 2) {
                peer_u_issue(ub, U8, wl, it + 1, lane);
                __builtin_amdgcn_sched_barrier(0);
                peer_u_compute(ua, wl, it, lane);
                __builtin_amdgcn_sched_barrier(0);
                if (it + 2 < 32) peer_u_issue(ua, U8, wl, it + 2, lane);
                __builtin_amdgcn_sched_barrier(0);
                peer_u_compute(ub, wl, it + 1, lane);
                __builtin_amdgcn_sched_barrier(0);
            }
        }
#pragma unroll
        for (int j = 0; j < 4; ++j) {
            const float w0 = *(const LAS float*)(wl + PW_BUF1 + (j * 128 + lane) * 4), w1 = *(const LAS float*)(wl + PW_BUF1 + (j * 128 + 64 + lane) * 4);
            float mx = fmaxf(fabsf(w0), fabsf(w1));
#pragma unroll
            for (int o = 1; o < 64; o <<= 1) mx = fmaxf(mx, __shfl_xor(mx, o));
            int ex = (int)((__float_as_uint(mx) >> 23) & 0xffu); ex = ex < 30 ? 127 : ex;
            const float sc = __uint_as_float((unsigned)(127 + 7 + 127 - ex) << 23), isc = __uint_as_float((unsigned)(ex - 7) << 23);
            const float s0 = w0 * sc, s1 = w1 * sc;
            const int ph = __builtin_amdgcn_cvt_pk_fp8_f32(s0, s1, 0, false);
            const f32x2v hb = __builtin_amdgcn_cvt_pk_f32_fp8(ph, false);
            const int pl = __builtin_amdgcn_cvt_pk_fp8_f32(s0 - hb.x, s1 - hb.y, 0, false);
            *(LAS unsigned char*)(wl + PW_WH + j * 128 + lane) = (unsigned char)(ph & 0xff); *(LAS unsigned char*)(wl + PW_WH + j * 128 + 64 + lane) = (unsigned char)((ph >> 8) & 0xff);
            *(LAS unsigned char*)(wl + PW_WL + j * 128 + lane) = (unsigned char)(pl & 0xff); *(LAS unsigned char*)(wl + PW_WL + j * 128 + 64 + lane) = (unsigned char)((pl >> 8) & 0xff);
            if (lane == 0) *(LAS float*)(wl + PW_IK + j * 4) = isc;
        }
        v4u x1w[4][2];
#pragma unroll
        for (int j = 0; j < 4; ++j) { const GAS v4u* op = (const GAS v4u*)(F.QP + (size_t)(t0 + j) * D + 16 * lane); x1w[j][0] = op[0]; x1w[j][1] = op[1]; }
        asm volatile("s_waitcnt lgkmcnt(0)" ::: "memory");
        {
            f32x4 acc[8];
            peer_v_issue(V8, wl, lbase, 0, lane, c16e, c16o);
#pragma unroll 1
            for (int it = 0; it < 32; it += 2) {
                peer_v_issue(V8, wl, lbase, it + 1, lane, c16e, c16o);
                asm volatile("s_waitcnt vmcnt(8)" ::: "memory");
                peer_v_compute(wl, acc, yrow0, it, lane);
                asm volatile("s_waitcnt lgkmcnt(0)" ::: "memory");
                if (it + 2 < 32) { peer_v_issue(V8, wl, lbase, it + 2, lane, c16e, c16o); asm volatile("s_waitcnt vmcnt(8)" ::: "memory"); }
                else asm volatile("s_waitcnt vmcnt(0)" ::: "memory");
                peer_v_compute(wl, acc, yrow0, it + 1, lane);
                asm volatile("s_waitcnt lgkmcnt(0)" ::: "memory");
            }
        }
        asm volatile("s_waitcnt vmcnt(0)" ::: "memory");
#pragma unroll
        for (int j = 0; j < 4; ++j) {
            const int t = t0 + j, b = t >> 12;
            float yv[16];
            { const GAS v4u* yp = (const GAS v4u*)(yrow0 + (size_t)j * D + 16 * lane); const v4u y0 = yp[0], y1 = yp[1]; unpack8(y0, yv); unpack8(y1, yv + 8); }
            float ss = 0.f;
#pragma unroll
            for (int i = 0; i < 16; ++i) ss += yv[i] * yv[i];
            const float rstd = rsqrtf(wave_sum(ss) * (1.f / D) + EPS);
            GAS f32x4* dp = (GAS f32x4*)(dst + (size_t)t * D + 16 * lane);
            const GAS f32x4* gp = (const GAS f32x4*)(F.fpost_gain + 16 * lane);
            const GAS f32x4* g2p = (const GAS f32x4*)(F.mod + b * 6144 + 5120 + 16 * lane);
            float x1f[16]; unpack8(x1w[j][0], x1f); unpack8(x1w[j][1], x1f + 8);
#pragma unroll
            for (int i = 0; i < 4; ++i) { const f32x4 x1 = (f32x4){x1f[4 * i], x1f[4 * i + 1], x1f[4 * i + 2], x1f[4 * i + 3]}, g = gp[i], g2 = g2p[i];
                const f32x4 y = (f32x4){yv[4 * i], yv[4 * i + 1], yv[4 * i + 2], yv[4 * i + 3]};
                dp[i] = x1 + g2 * (y * rstd * g); }
        }
    }
}

__device__ __forceinline__ unsigned long long ldp(const Frame& F, int i) {
    volatile LAS unsigned* pt = (volatile LAS unsigned*)(F.lds + LDSCTL_OFF);
    const unsigned lo = pt[2 * i], hi = pt[2 * i + 1];
    return ((unsigned long long)(unsigned)__builtin_amdgcn_readfirstlane((int)hi) << 32) | (unsigned)__builtin_amdgcn_readfirstlane((int)lo);
}
__device__ __forceinline__ void load_frame(Frame& F) {
    F.lane = lane_id_fresh(); F.tid = F.wave * 64 + F.lane;
    F.x = (const float*)ldp(F, 0); F.c = (const float*)ldp(F, 1); F.ada_w = (const float*)ldp(F, 2); F.ada_b = (const float*)ldp(F, 3); F.pre_gain = (const float*)ldp(F, 4); F.post_gain = (const float*)ldp(F, 5);
    F.w_in = (const float*)ldp(F, 6); F.conv_w = (const float*)ldp(F, 7); F.group_gain = (const float*)ldp(F, 8); F.w_out = (const float*)ldp(F, 9); F.fpre_gain = (const float*)ldp(F, 10); F.fpost_gain = (const float*)ldp(F, 11);
    F.wq = (const float*)ldp(F, 12); F.keys = (const float*)ldp(F, 13); F.pu = (const float*)ldp(F, 14); F.pv = (const float*)ldp(F, 15);
    F.out = (float*)ldp(F, 16);
    unsigned char* ws = (unsigned char*)ldp(F, 17);
    F.ctl = (gu32*)(ws + WS_CTL);
    F.mod = (float*)(ws + WS_MOD); F.kmean = (float*)(ws + WS_KMEAN); F.keysb = (bf16*)(ws + WS_KEYS);
    F.WinT = (bf16*)(ws + WS_WIN); F.WoT = (bf16*)(ws + WS_WO); F.WqT = (bf16*)(ws + WS_WQ); F.eidx = (int*)(ws + WS_EIDX); F.gw = (float*)(ws + WS_G);
    F.U8 = ws + WS_U; F.V8 = ws + WS_V; F.su = (float*)(ws + WS_SU); F.sv = (float*)(ws + WS_SV); F.H = (bf16*)(ws + WS_H);
    F.P = (bf16*)(ws + WS_P); F.QP = (bf16*)(ws + WS_QP); F.O = (bf16*)(ws + WS_O); F.Y = (bf16*)(ws + WS_Y); F.scratch = (float*)(ws + WS_O); F.Win8 = ws + WS_WIN8; F.rs = (float*)(ws + WS_RS); F.Wq8 = ws + WS_WQ8; F.rs2 = (float*)(ws + WS_RS2); F.Wo8 = ws + WS_WO8;
}
struct Args { const float* in[16]; float* out; unsigned char* ws; int ph_lo, ph_hi; };
constexpr int NPHASE = 12;
template <unsigned PM> __global__ void __launch_bounds__(NWAVES * 64, 2) fwd_kernel(Args args) {
    extern __shared__ __attribute__((aligned(16))) unsigned char lds[];
    Frame F;
    F.lds = (LAS unsigned char*)lds;
    F.MISC = (volatile LAS unsigned*)(F.lds + MISC_OFF);
    F.tid = threadIdx.x; F.lane = F.tid & 63; F.wave = __builtin_amdgcn_readfirstlane(F.tid >> 6);
    F.G = gridDim.x;
    for (int u = F.tid; u < (LDS_BYTES - LDSCTL_OFF) / 4; u += NWAVES * 64) ((LAS unsigned*)(F.lds + LDSCTL_OFF))[u] = 0u;
    __syncthreads();
    if (F.tid == 0) { LAS unsigned long long* pt = (LAS unsigned long long*)(F.lds + LDSCTL_OFF);
#pragma unroll
        for (int i = 0; i < 16; ++i) pt[i] = (unsigned long long)args.in[i];
        pt[16] = (unsigned long long)args.out; pt[17] = (unsigned long long)args.ws; }
    __syncthreads();
    load_frame(F);
    const int lo = args.ph_lo, hi = args.ph_hi;
    const bool multi = (hi - lo) > 1;
    XcdBarrier bar; bar.bar = (unsigned*)(F.ctl + CW_BAR); bar.x = 0; bar.st = nullptr;
    if (multi) bar = xcd_barrier_post((unsigned*)(F.ctl + CW_BAR), F.MISC + 8);
#define IN(k) ((((PM) >> (k)) & 1u) && lo <= (k) && (k) < hi)
#define BOTH(k) (IN(k) && IN((k) + 1))
#ifndef SEAMREP
#define SEAMREP 1
#endif
#define SEAM(k) do { if (BOTH(k)) { for (int sr_ = 0; sr_ < SEAMREP; ++sr_) xcd_barrier(bar); } } while (0)
#ifndef REPMASK
#define REPMASK 0x000u
#endif
#define REPS(k) (1 + (int)(((REPMASK) >> (k)) & 1u))
    if (IN(0)) { load_frame(F); for (int r = 0; r < REPS(0); ++r) { p0_prep(F); __syncthreads(); } SEAM(0); }
    if (IN(1)) { load_frame(F); for (int r = 0; r < REPS(1); ++r) p1_hnorm(F); SEAM(1); }
    if (IN(2)) { load_frame(F);
        pg8::Gemm g{F.H, (const bf16*)F.Win8, M, NIN, D / 2}; pg8::StaticOrder So; So.init(M, NIN, F.G, (int)blockIdx.x);
        pg8::EpiBf16S<true> E{F.P, NIN, 6, 8, C2, F.kmean, 8, 10, F.rs, (const unsigned*)(F.ctl + CW_CMAX)};
        for (int r = 0; r < REPS(2); ++r) pg8::gemm_phase<pg8::EpiBf16S<true>, pg8::StaticOrder, true, true, false, true>(F.lds, g, So, E);
        if (IN(2) && IN(5)) { for (int sr_ = 0; sr_ < SEAMREP; ++sr_) xcd_barrier(bar); }
    }
    const bool stream_first = (((int)blockIdx.x >> 3) & 1) == 0;
    if (IN(5) && stream_first) { load_frame(F); p0_tables(F); }
    if (IN(6) && stream_first) { load_frame(F); p6_conv(F); }
    if (IN(5)) { load_frame(F);
        const attn_body::AttnTensors AT{(const attn_body::bf16*)(F.P + 1536), (const attn_body::bf16*)(F.P + 2048), (const attn_body::bf16*)(F.P + 2560), (attn_body::bf16*)((unsigned char*)F.Y + 512), F.kmean, F.group_gain + 512};
        const attn_body::StaticOrder So((int)F.G, (int)blockIdx.x);
        for (int r = 0; r < REPS(5); ++r) attn_body::attn_phase<attn_body::StaticOrder>((char*)lds, AT, So);
    }
    if (IN(6) && !stream_first) { load_frame(F); p6_conv(F); }
    if (IN(5) && !stream_first) { load_frame(F); p0_tables(F); }
    if (IN(6)) { SEAM(6); }
    if (IN(7)) { load_frame(F);
        pg8::Gemm g{F.Y, (const bf16*)F.Wo8, M, D, D / 2}; pg8::StaticOrder So; So.init(M, D, F.G, (int)blockIdx.x);
        pg8::EpiBf16S<true> E{F.O, D, 0, 0, 1.f, nullptr, 0, 0, nullptr, (const unsigned*)(F.ctl + CW_CMAX3)};
        for (int r = 0; r < REPS(7); ++r) pg8::gemm_phase<pg8::EpiBf16S<true>, pg8::StaticOrder, true, true, false, true>(F.lds, g, So, E);
        SEAM(7);
    }
    if (IN(8)) { load_frame(F); for (int r = 0; r < REPS(8); ++r) p8_resid(F); SEAM(8); }
    if (IN(9)) { load_frame(F);
        pg8::Gemm g{F.H, (const bf16*)F.Wq8, M, NQ, D / 2}; pg8::StaticOrder So; So.init(M, NQ, F.G, (int)blockIdx.x);
        EpiRoute E{F.keysb, F.eidx, F.gw, (const unsigned*)(F.ctl + CW_CMAX2), F.rs2};
        for (int r = 0; r < REPS(9); ++r)
            for (int i = 0; ; ++i) { OneUnit S1; if (!So.next(i, S1.u)) break; pg8::gemm_phase<EpiRoute, OneUnit, false, true, false, true>(F.lds, g, S1, E); }
        if (IN(9) && IN(11)) { for (int sr_ = 0; sr_ < SEAMREP; ++sr_) xcd_barrier(bar); }
    }
    if (IN(11)) { load_frame(F); if (REPS(11) > 1) p11_peer(F, F.scratch); p11_peer(F, F.out); }
#undef IN
#undef BOTH
#undef SEAM
}

#ifndef PMASK
#define PMASK 0xfffu
#endif
#ifndef N_LAUNCH_MODE
#define N_LAUNCH_MODE 1
#endif
template <unsigned PM> static bool set_lds() { return hipFuncSetAttribute((const void*)fwd_kernel<PM>, hipFuncAttributeMaxDynamicSharedMemorySize, LDS_BYTES) == hipSuccess; }
template <unsigned PM> static void launch1(int grid, hipStream_t stream, Args a) { hipLaunchKernelGGL(fwd_kernel<PM>, dim3(grid), dim3(NWAVES * 64), LDS_BYTES, stream, a); }
extern "C" void kernel_launch(void* const* d_in, const int* in_sizes, int n_in, void* d_out, int out_size, void* d_ws, size_t ws_size, hipStream_t stream) {
    static int grid = 0;
    if (grid == 0) {
        if (n_in != 16 || out_size != M * D || ws_size < WS_END) { fprintf(stderr, "kernel_launch: unexpected shapes n_in %d out %d ws %zu\n", n_in, out_size, ws_size); grid = -1; return; }
        int dev = 0, cus = 0;
        if (hipGetDevice(&dev) != hipSuccess || hipDeviceGetAttribute(&cus, hipDeviceAttributeMultiprocessorCount, dev) != hipSuccess) { grid = -1; return; }
        bool ok = true;
#if N_LAUNCH_MODE == 1
        ok = set_lds<PMASK>();
#elif N_LAUNCH_MODE == 3
        ok = set_lds<0x3ffu>() && set_lds<0x400u>() && set_lds<0x800u>();
#else
        ok = set_lds<1u>() && set_lds<2u>() && set_lds<4u>() && set_lds<8u>() && set_lds<16u>() && set_lds<32u>() && set_lds<64u>() && set_lds<128u>() && set_lds<256u>() && set_lds<512u>() && set_lds<1024u>() && set_lds<2048u>();
#endif
        if (!ok) { fprintf(stderr, "kernel_launch: hipFuncSetAttribute failed\n"); grid = -1; return; }
        grid = cus;
    }
    if (grid < 0) return;
    (void)hipMemsetAsync((char*)d_ws + WS_CTL, 0, CTL_ZERO_BYTES, stream);
    Args a{};
    for (int i = 0; i < 16; ++i) a.in[i] = (const float*)d_in[i];
    a.out = (float*)d_out; a.ws = (unsigned char*)d_ws;
#if N_LAUNCH_MODE == 1
    a.ph_lo = 0; a.ph_hi = NPHASE; launch1<PMASK>(grid, stream, a);
#elif N_LAUNCH_MODE == 3
    a.ph_lo = 0; a.ph_hi = 10; launch1<0x3ffu>(grid, stream, a);
    a.ph_lo = 10; a.ph_hi = 11; launch1<0x400u>(grid, stream, a);
    a.ph_lo = 11; a.ph_hi = 12; launch1<0x800u>(grid, stream, a);
#else
#define L1(p) do { a.ph_lo = (p); a.ph_hi = (p) + 1; launch1<(1u << (p))>(grid, stream, a); } while (0)
    L1(0); L1(1); L1(2); L1(3); L1(4); L1(5); L1(6); L1(7); L1(8); L1(9); L1(10); L1(11);
#undef L1
#endif
}
```

```cpp
#include <hip/hip_runtime.h>
#include <cstdio>
#include <cstdint>
#ifndef WT_STORES
#define WT_STORES 1
#endif
typedef unsigned wt_v4u __attribute__((ext_vector_type(4)));
__device__ __forceinline__ int lane_id_fresh() { int l; asm volatile("v_mbcnt_lo_u32_b32 %0, -1, 0\n\tv_mbcnt_hi_u32_b32 %0, -1, %0" : "=v"(l)); return l; }
__device__ __forceinline__ void st16_wt(void* p, wt_v4u v) {
#if WT_STORES
    asm volatile("global_store_dwordx4 %0, %1, off sc1\n\ts_nop 1" :: "v"(p), "v"(v) : "memory");
#else
    *(wt_v4u*)p = v;
#endif
}
__device__ __forceinline__ void st4_wt(void* p, unsigned v) {
#if WT_STORES
    asm volatile("global_store_dword %0, %1, off sc1\n\ts_nop 1" :: "v"(p), "v"(v) : "memory");
#else
    *(unsigned*)p = v;
#endif
}
__device__ __forceinline__ void st8_wt(void* p, unsigned long long v) {
#if WT_STORES
    asm volatile("global_store_dwordx2 %0, %1, off sc1\n\ts_nop 1" :: "v"(p), "v"(v) : "memory");
#else
    *(unsigned long long*)p = v;
#endif
}
namespace pg8 {
#define PG8_LAS __attribute__((address_space(3)))
typedef unsigned short bf16_t;
typedef short bf16x8 __attribute__((ext_vector_type(8)));
typedef float f32x4 __attribute__((ext_vector_type(4)));
typedef unsigned u32x4 __attribute__((ext_vector_type(4)));
typedef int i32x4 __attribute__((ext_vector_type(4)));
typedef int i32x8 __attribute__((ext_vector_type(8)));
constexpr int BM = 256, BK = 64, HALF = 128, HTB = HALF * BK * 2  , STAGE_BYTES = 8 * HTB, NXCD = 8, WGM = 8;

__host__ __device__ __forceinline__ int lds_byte(int r, int c) { const int st = (r >> 4) * 2 + (c >> 5), rr = r & 15, cc = c & 31, ob = rr * 64 + cc * 2; return st * 1024 + (ob ^ (((ob >> 9) & 1) << 5)); }
__host__ __device__ __forceinline__ void stage_rc(int b, int& R, int& C) { const int st = b / 1024, sb = b % 1024, swz = sb ^ (((sb >> 9) & 1) << 5); R = (st >> 1) * 16 + swz / 64; C = (st & 1) * 32 + (swz % 64) / 2; }
__host__ __device__ __forceinline__ int perm32(int rho) { const int n = rho >> 4, i = rho & 15; return 8 * (i >> 2) + 4 * n + (i & 3); }

struct Unit { int pm, pn; };
struct Gemm { const bf16_t* A; const bf16_t* Bt; int M, N, K; };

struct StaticOrder {
    int nM, nN, nwg, G, c;
    __host__ __device__ void init(int M, int N, int G_, int c_) { nM = M / BM; nN = N / BM; nwg = nM * nN; G = G_; c = c_; }
    __host__ __device__ bool next(int i, Unit& u) const {
        const long L = (long)i * G + c; if (L >= nwg) return false;
        int wgid = (int)L; { const int q = nwg / NXCD, r = nwg % NXCD, xcd = wgid % NXCD, off = wgid / NXCD; wgid = (xcd < r ? xcd * (q + 1) : r * (q + 1) + (xcd - r) * q) + off; }
        const int nig = WGM * nN, gid = wgid / nig, fm = gid * WGM, gsz = (nM - fm) < WGM ? (nM - fm) : WGM;
        u.pm = fm + ((wgid % nig) % gsz); u.pn = (wgid % nig) / gsz; return true;
    }
    __device__ __forceinline__ void a_ready(const Unit&) const {}
    __device__ __forceinline__ void done(const Unit&) const {}
};


__device__ __forceinline__ unsigned cvt_pk_bf16(float lo, float hi) { unsigned r; asm volatile("v_cvt_pk_bf16_f32 %0, %1, %2" : "=v"(r) : "v"(lo), "v"(hi)); return r; }
template <bool ACC_I32> struct EpiBf16S {
    static constexpr bool PERM = true, AFTER_DRAIN = false;
    bf16_t* O; int ldc; int sc_lo, sc_hi; float scv; float* ksum; int ks_lo, ks_hi; const float* rs; const unsigned* cmax;
    __device__ __forceinline__ void operator()(const f32x4 (&acc)[2][2][4][2], const Unit& u, int wr, int wc, int fr_, int fq_) const {
        (void)fr_; (void)fq_;
        const int lane_ = lane_id_fresh(); const int fr = lane_ & 15, fq = lane_ >> 4;
        const int row0 = u.pm * BM + wr * 64 + fr; const int colt = u.pn * BM;
        const float sc = ((u.pn >= sc_lo && u.pn < sc_hi) ? scv : 1.f) * (ACC_I32 ? (1.f / 127.f) : (1.f / 224.f));
        const int col0 = colt + wc * 32 + 8 * fq;
        float rsv[2][4];
#pragma unroll
        for (int ai = 0; ai < 2; ++ai)
#pragma unroll
            for (int m = 0; m < 4; ++m) rsv[ai][m] = rs != nullptr ? rs[row0 + ai * HALF + m * 16] : 1.f;
        const bool do_ks = ksum != nullptr && u.pn >= ks_lo && u.pn < ks_hi;
#pragma unroll
        for (int bj = 0; bj < 2; ++bj) {
            const u32x4 cb0 = *(const u32x4*)(cmax + col0 + bj * HALF), cb1 = *(const u32x4*)(cmax + col0 + bj * HALF + 4);
            const f32x4 cs0 = (f32x4){__uint_as_float(cb0.x), __uint_as_float(cb0.y), __uint_as_float(cb0.z), __uint_as_float(cb0.w)} * sc;
            const f32x4 cs1 = (f32x4){__uint_as_float(cb1.x), __uint_as_float(cb1.y), __uint_as_float(cb1.z), __uint_as_float(cb1.w)} * sc;
            f32x4 sum0 = {0.f, 0.f, 0.f, 0.f}, sum1 = sum0;
#pragma unroll
            for (int ai = 0; ai < 2; ++ai)
#pragma unroll
                for (int m = 0; m < 4; ++m) { f32x4 a0 = acc[ai][bj][m][0], a1 = acc[ai][bj][m][1];
                    if constexpr (ACC_I32) { const i32x4 i0 = __builtin_bit_cast(i32x4, a0), i1 = __builtin_bit_cast(i32x4, a1);
                        a0 = (f32x4){(float)i0[0], (float)i0[1], (float)i0[2], (float)i0[3]}; a1 = (f32x4){(float)i1[0], (float)i1[1], (float)i1[2], (float)i1[3]}; }
                    const f32x4 v0 = a0 * rsv[ai][m] * cs0, v1 = a1 * rsv[ai][m] * cs1;
                    sum0 += v0; sum1 += v1;
                    u32x4 w; w.x = cvt_pk_bf16(v0[0], v0[1]); w.y = cvt_pk_bf16(v0[2], v0[3]); w.z = cvt_pk_bf16(v1[0], v1[1]); w.w = cvt_pk_bf16(v1[2], v1[3]);
                    st16_wt(O + (size_t)(row0 + ai * HALF + m * 16) * ldc + col0 + bj * HALF, w); }
            if (do_ks) {
                float* kd = ksum + (size_t)u.pm * ((ks_hi - ks_lo) * BM) + (u.pn - ks_lo) * BM + wc * 32 + 8 * fq + bj * HALF;
#pragma unroll
                for (int n = 0; n < 2; ++n)
#pragma unroll
                    for (int i = 0; i < 4; ++i) {
                        float v = n ? sum1[i] : sum0[i];
                        v += __uint_as_float((unsigned)__builtin_amdgcn_mov_dpp((int)__float_as_uint(v), 0xB1, 0xf, 0xf, true));
                        v += __uint_as_float((unsigned)__builtin_amdgcn_mov_dpp((int)__float_as_uint(v), 0x4E, 0xf, 0xf, true));
                        v += __uint_as_float((unsigned)__builtin_amdgcn_mov_dpp((int)__float_as_uint(v), 0x141, 0xf, 0xf, true));
                        v += __uint_as_float((unsigned)__builtin_amdgcn_mov_dpp((int)__float_as_uint(v), 0x140, 0xf, 0xf, true));
                        if (fr == 0) atomicAdd(kd + 4 * n + i, v);
                    }
            }
        }
    }
};
struct EpiBf16 {
    static constexpr bool PERM = true, AFTER_DRAIN = false;
    bf16_t* O; int ldc; int sc_lo, sc_hi; float scv; float* ksum; int ks_lo, ks_hi;
    __device__ __forceinline__ void operator()(const f32x4 (&acc)[2][2][4][2], const Unit& u, int wr, int wc, int fr, int fq) const {
        const int row0 = u.pm * BM + wr * 64 + fr; const int colt = u.pn * BM;
        const float sc = (u.pn >= sc_lo && u.pn < sc_hi) ? scv : 1.f;
        const int col0 = colt + wc * 32 + 8 * fq;
#pragma unroll
        for (int ai = 0; ai < 2; ++ai)
#pragma unroll
            for (int m = 0; m < 4; ++m) { bf16_t* rowp = O + (size_t)(row0 + ai * HALF + m * 16) * ldc + col0;
#pragma unroll
                for (int bj = 0; bj < 2; ++bj) { f32x4 v0 = acc[ai][bj][m][0] * sc, v1 = acc[ai][bj][m][1] * sc;
                    u32x4 w; w.x = cvt_pk_bf16(v0[0], v0[1]); w.y = cvt_pk_bf16(v0[2], v0[3]); w.z = cvt_pk_bf16(v1[0], v1[1]); w.w = cvt_pk_bf16(v1[2], v1[3]);
                    st16_wt(rowp + bj * HALF, w); } }
        if (ksum != nullptr && u.pn >= ks_lo && u.pn < ks_hi) {
            float* kd = ksum + (size_t)u.pm * ((ks_hi - ks_lo) * BM) + (u.pn - ks_lo) * BM + wc * 32 + 8 * fq;
#pragma unroll
            for (int bj = 0; bj < 2; ++bj)
#pragma unroll
                for (int n = 0; n < 2; ++n) {
                    f32x4 cs = acc[0][bj][0][n];
#pragma unroll
                    for (int m = 1; m < 4; ++m) cs += acc[0][bj][m][n];
#pragma unroll
                    for (int m = 0; m < 4; ++m) cs += acc[1][bj][m][n];
#pragma unroll
                    for (int i = 0; i < 4; ++i) {
                        float v = cs[i];
                        v += __uint_as_float((unsigned)__builtin_amdgcn_mov_dpp((int)__float_as_uint(v), 0xB1, 0xf, 0xf, true));
                        v += __uint_as_float((unsigned)__builtin_amdgcn_mov_dpp((int)__float_as_uint(v), 0x4E, 0xf, 0xf, true));
                        v += __uint_as_float((unsigned)__builtin_amdgcn_mov_dpp((int)__float_as_uint(v), 0x141, 0xf, 0xf, true));
                        v += __uint_as_float((unsigned)__builtin_amdgcn_mov_dpp((int)__float_as_uint(v), 0x140, 0xf, 0xf, true));
                        if (fr == 0) atomicAdd(kd + bj * HALF + 4 * n + i, v);
                    }
                }
        }
    }
};

template <int OFF> __device__ __forceinline__ void dma16s(const void* sbase, unsigned voff, unsigned lds_base) { unsigned keep;
    asm volatile("s_mov_b32 %0, m0\n\ts_add_u32 m0, %3, %4\n\ts_nop 0\n\tglobal_load_lds_dwordx4 %1, %2\n\ts_mov_b32 m0, %0" : "=&s"(keep) : "v"(voff), "s"(sbase), "s"(lds_base), "i"(OFF) : "memory", "scc"); }
__device__ __forceinline__ const char* uni_ptr(const char* p) {
    const unsigned long long v = (unsigned long long)p;
    return (const char*)(((unsigned long long)(unsigned)__builtin_amdgcn_readfirstlane((int)(unsigned)(v >> 32)) << 32) | (unsigned)__builtin_amdgcn_readfirstlane((int)(unsigned)v));
}
template <class Epi, class Sched, bool ALIGN_EPI = false, bool SP2 = false, bool FP8 = false, bool I8 = false>
__device__ __forceinline__ void gemm_phase(PG8_LAS unsigned char* lds, const Gemm g, const Sched& S, const Epi& E) {
    int tid_ = threadIdx.x; asm volatile("" : "+v"(tid_));
    const int tid = tid_, wid = __builtin_amdgcn_readfirstlane(tid >> 6), lane = tid & 63, wr = wid >> 2, wc = wid & 3, fr = lane & 15, fq = lane >> 4;
    const int K = g.K, nt = K / BK;
    unsigned voffA[2], voffB[2];
#pragma unroll
    for (int i = 0; i < 2; ++i) { int R, C; stage_rc(tid * 16 + i * 8192, R, C); const int Rb = Epi::PERM ? ((R & ~31) + perm32(R & 31)) : R;
        voffA[i] = (unsigned)(R * K + C) * 2u; voffB[i] = (unsigned)(Rb * K + C) * 2u; }
    const size_t qstep = (size_t)64 * K * 2;
    const size_t kstep = (size_t)(BK * 2);
    const size_t hstep = (size_t)HALF * K * 2;
    const size_t tstep = 2 * hstep;
    const unsigned ldsn = (unsigned)(size_t)lds;
    const unsigned ldsw = (unsigned)wid * 1024u;
    const unsigned ldsb = (unsigned)__builtin_amdgcn_readfirstlane((int)(ldsn + ldsw));
    const int aoff = lds_byte(wr * 64 + fr, fq * 8), boff = lds_byte(wc * 32 + fr, fq * 8);
    unsigned ldsAn = ldsn + (unsigned)aoff, ldsBn = ldsn + (unsigned)(4 * HTB) + (unsigned)boff; asm volatile("" : "+v"(ldsAn), "+v"(ldsBn));
    PG8_LAS unsigned char* const ldsA = (PG8_LAS unsigned char*)(size_t)ldsAn; PG8_LAS unsigned char* const ldsB = (PG8_LAS unsigned char*)(size_t)ldsBn;
#define PG8_SA(b, h) (((b) * 2 + (h)) * HTB)
#define PG8_SB(b, h) ((4 + (b) * 2 + (h)) * HTB)
#define PG8_STAGE(bufoff, gbase, voff) do { if constexpr (FP8 || I8) { const char* gb_ = uni_ptr((const char*)(gbase)); dma16s<(bufoff)>(gb_, (voff)[0], ldsb); dma16s<(bufoff) + 8192>(uni_ptr(gb_ + qstep), (voff)[0], ldsb); }        \
    else { _Pragma("unroll") for (int _i = 0; _i < 2; ++_i) \
        __builtin_amdgcn_global_load_lds((const unsigned*)((const char*)(gbase) + (voff)[_i]), (PG8_LAS unsigned*)(lds + (bufoff) + ldsw + _i * 8192), 16, 0, 0); } } while (0)
#define PG8_LDA(dst, b, h) do { _Pragma("unroll") for (int m = 0; m < 4; ++m) _Pragma("unroll") for (int k = 0; k < 2; ++k) dst[m][k] = *(const PG8_LAS bf16x8*)(lds + PG8_SA(b, h) + aoff + m * 2048 + k * 1024); } while (0)
#define PG8_LDB(dst, b, h) do { _Pragma("unroll") for (int n = 0; n < 2; ++n) _Pragma("unroll") for (int k = 0; k < 2; ++k) dst[n][k] = *(const PG8_LAS bf16x8*)(lds + PG8_SB(b, h) + boff + n * 2048 + k * 1024); } while (0)
#define PG8_LDA8(dst, b, h) do { _Pragma("unroll") for (int m = 0; m < 4; ++m) dst[m] = __builtin_shufflevector(*(const PG8_LAS i32x4*)(ldsA + PG8_SA(b, h) + m * 2048), *(const PG8_LAS i32x4*)(ldsA + PG8_SA(b, h) + m * 2048 + 1024), 0, 1, 2, 3, 4, 5, 6, 7); } while (0)
#define PG8_LDB8(dst, b, h) do { _Pragma("unroll") for (int n = 0; n < 2; ++n) dst[n] = __builtin_shufflevector(*(const PG8_LAS i32x4*)(ldsB + (PG8_SB(b, h) - 4 * HTB) + n * 2048), *(const PG8_LAS i32x4*)(ldsB + (PG8_SB(b, h) - 4 * HTB) + n * 2048 + 1024), 0, 1, 2, 3, 4, 5, 6, 7); } while (0)
#define PG8_MMA8(ai, bj, A8, B8) do { __builtin_amdgcn_s_setprio(1); _Pragma("unroll") for (int m = 0; m < 4; ++m) _Pragma("unroll") for (int n = 0; n < 2; ++n) \
        acc[ai][bj][m][n] = __builtin_amdgcn_mfma_scale_f32_16x16x128_f8f6f4(B8[n], A8[m], acc[ai][bj][m][n], 0, 0, 0, 0, 0, 0); __builtin_amdgcn_s_setprio(0); } while (0)
#define PG8_MMA(ai, bj, At, Bt) do { __builtin_amdgcn_s_setprio(1); _Pragma("unroll") for (int m = 0; m < 4; ++m) _Pragma("unroll") for (int n = 0; n < 2; ++n) _Pragma("unroll") for (int k = 0; k < 2; ++k) { \
        if constexpr (I8) acc[ai][bj][m][n] = __builtin_bit_cast(f32x4, __builtin_amdgcn_mfma_i32_16x16x64_i8(__builtin_bit_cast(i32x4, Bt[n][k]), __builtin_bit_cast(i32x4, At[m][k]), __builtin_bit_cast(i32x4, acc[ai][bj][m][n]), 0, 0, 0)); \
        else acc[ai][bj][m][n] = __builtin_amdgcn_mfma_f32_16x16x32_bf16(Bt[n][k], At[m][k], acc[ai][bj][m][n], 0, 0, 0); } __builtin_amdgcn_s_setprio(0); } while (0)
#define PG8_WAIT_V(n) asm volatile("s_waitcnt vmcnt(" #n ")" ::: "memory")
#define PG8_WAIT_L(n) asm volatile("s_waitcnt lgkmcnt(" #n ")" ::: "memory")
#define PG8_BAR __builtin_amdgcn_s_barrier()
#define PG8_SCHED __builtin_amdgcn_sched_barrier(0)
    Unit cur, nxt; int ui = 0;
    if (!S.next(0, cur)) return;
    f32x4 acc[2][2][4][2];
#pragma unroll
    for (int a = 0; a < 2; ++a)
#pragma unroll
        for (int b = 0; b < 2; ++b)
#pragma unroll
            for (int m = 0; m < 4; ++m)
#pragma unroll
                for (int n = 0; n < 2; ++n) acc[a][b][m][n] = (f32x4){0.f, 0.f, 0.f, 0.f};
    bf16x8 At[4][2], B0[2][2], B1[2][2];
    i32x8 A8[4], B08[2], B18[2];
    const char* cA = (const char*)g.A + (size_t)cur.pm * tstep; const char* cB = (const char*)g.Bt + (size_t)cur.pn * tstep;
    if constexpr (FP8 || I8) { cA = uni_ptr(cA); cB = uni_ptr(cB); }
    S.a_ready(cur);
    if constexpr (SP2) {
        PG8_STAGE(PG8_SB(0, 0), cB, voffB); PG8_STAGE(PG8_SB(0, 1), cB + hstep, voffB); PG8_STAGE(PG8_SA(0, 0), cA, voffA); PG8_STAGE(PG8_SA(0, 1), cA + hstep, voffA);
        if (wr == 1) PG8_BAR;
        PG8_WAIT_V(2); PG8_BAR;
        PG8_STAGE(PG8_SB(1, 0), cB + kstep, voffB); PG8_STAGE(PG8_SA(1, 0), cA + kstep, voffA); PG8_STAGE(PG8_SB(1, 1), cB + hstep + kstep, voffB);
        PG8_WAIT_V(6); PG8_BAR;
    } else {
        PG8_STAGE(PG8_SB(0, 0), cB, voffB); PG8_STAGE(PG8_SA(0, 0), cA, voffA); PG8_STAGE(PG8_SB(0, 1), cB + hstep, voffB); PG8_STAGE(PG8_SA(0, 1), cA + hstep, voffA);
        if (wr == 1) PG8_BAR;
        PG8_WAIT_V(4); PG8_BAR;
        PG8_STAGE(PG8_SB(1, 0), cB + kstep, voffB); PG8_STAGE(PG8_SA(1, 0), cA + kstep, voffA); PG8_STAGE(PG8_SB(1, 1), cB + hstep + kstep, voffB);
        PG8_WAIT_V(6); PG8_BAR;
    }
    for (;;) {
        const bool has_next = S.next(ui + 1, nxt);
        const char* nA = has_next ? (const char*)g.A + (size_t)nxt.pm * tstep : cA; const char* nB = has_next ? (const char*)g.Bt + (size_t)nxt.pn * tstep : cB;
        if constexpr (FP8 || I8) { nA = uni_ptr(nA); nB = uni_ptr(nB); }
        for (int t = 0; t < nt; t += 2) {
            const bool last = (t == nt - 2);
            if constexpr (FP8 || I8) asm volatile("" : "+v"(voffA[0]), "+v"(voffB[0]));
            const char* a1 = cA + (size_t)(t + 1) * kstep;
            const char* a2 = last ? nA : cA + (size_t)(t + 2) * kstep; const char* b2 = last ? nB : cB + (size_t)(t + 2) * kstep;
            const char* a3 = a2 + kstep; const char* b3 = b2 + kstep;
            if (last && has_next) S.a_ready(nxt);
            if constexpr (SP2 && FP8) {
            PG8_LDB8(B08, 0, 0); PG8_LDB8(B18, 0, 1); PG8_SCHED; PG8_LDA8(A8, 0, 0); PG8_STAGE(PG8_SA(1, 1), a1 + hstep, voffA);
            PG8_WAIT_V(8); PG8_WAIT_L(0); PG8_BAR; PG8_MMA8(0, 0, A8, B08); PG8_MMA8(0, 1, A8, B18); PG8_BAR; PG8_SCHED;
            PG8_LDA8(A8, 0, 1); PG8_STAGE(PG8_SB(0, 0), b2, voffB); PG8_STAGE(PG8_SB(0, 1), b2 + hstep, voffB); PG8_STAGE(PG8_SA(0, 0), a2, voffA);
            PG8_WAIT_V(8); PG8_WAIT_L(0); PG8_BAR; PG8_MMA8(1, 0, A8, B08); PG8_MMA8(1, 1, A8, B18); PG8_BAR; PG8_SCHED;
            PG8_LDB8(B08, 1, 0); PG8_LDB8(B18, 1, 1); PG8_SCHED; PG8_LDA8(A8, 1, 0); PG8_STAGE(PG8_SA(0, 1), a2 + hstep, voffA);
            PG8_WAIT_V(8); PG8_WAIT_L(0); PG8_BAR; PG8_MMA8(0, 0, A8, B08); PG8_MMA8(0, 1, A8, B18); PG8_BAR; PG8_SCHED;
            PG8_LDA8(A8, 1, 1); PG8_STAGE(PG8_SB(1, 0), b3, voffB); PG8_STAGE(PG8_SB(1, 1), b3 + hstep, voffB); PG8_STAGE(PG8_SA(1, 0), a3, voffA);
            PG8_WAIT_V(8); PG8_WAIT_L(0); PG8_BAR; PG8_MMA8(1, 0, A8, B08); PG8_MMA8(1, 1, A8, B18); PG8_BAR; PG8_SCHED;
            } else if constexpr (SP2) {
            PG8_LDB(B0, 0, 0); PG8_LDB(B1, 0, 1); PG8_SCHED; PG8_LDA(At, 0, 0); PG8_STAGE(PG8_SA(1, 1), a1 + hstep, voffA);
            PG8_WAIT_V(8); PG8_WAIT_L(0); PG8_BAR; PG8_MMA(0, 0, At, B0); PG8_MMA(0, 1, At, B1); PG8_BAR; PG8_SCHED;
            PG8_LDA(At, 0, 1); PG8_STAGE(PG8_SB(0, 0), b2, voffB); PG8_STAGE(PG8_SB(0, 1), b2 + hstep, voffB); PG8_STAGE(PG8_SA(0, 0), a2, voffA);
            PG8_WAIT_V(8); PG8_WAIT_L(0); PG8_BAR; PG8_MMA(1, 0, At, B0); PG8_MMA(1, 1, At, B1); PG8_BAR; PG8_SCHED;
            PG8_LDB(B0, 1, 0); PG8_LDB(B1, 1, 1); PG8_SCHED; PG8_LDA(At, 1, 0); PG8_STAGE(PG8_SA(0, 1), a2 + hstep, voffA);
            PG8_WAIT_V(8); PG8_WAIT_L(0); PG8_BAR; PG8_MMA(0, 0, At, B0); PG8_MMA(0, 1, At, B1); PG8_BAR; PG8_SCHED;
            PG8_LDA(At, 1, 1); PG8_STAGE(PG8_SB(1, 0), b3, voffB); PG8_STAGE(PG8_SB(1, 1), b3 + hstep, voffB); PG8_STAGE(PG8_SA(1, 0), a3, voffA);
            PG8_WAIT_V(8); PG8_WAIT_L(0); PG8_BAR; PG8_MMA(1, 0, At, B0); PG8_MMA(1, 1, At, B1); PG8_BAR; PG8_SCHED;
            } else {
            PG8_LDB(B0, 0, 0); PG8_SCHED; PG8_LDA(At, 0, 0); PG8_STAGE(PG8_SA(1, 1), a1 + hstep, voffA);
            PG8_WAIT_L(8); PG8_BAR; PG8_WAIT_L(0); PG8_MMA(0, 0, At, B0); PG8_BAR; PG8_SCHED;
            PG8_LDB(B1, 0, 1); PG8_STAGE(PG8_SB(0, 0), b2, voffB);
            PG8_BAR; PG8_WAIT_L(0); PG8_MMA(0, 1, At, B1); PG8_BAR;
            PG8_LDA(At, 0, 1); PG8_STAGE(PG8_SA(0, 0), a2, voffA);
            PG8_BAR; PG8_WAIT_L(0); PG8_MMA(1, 0, At, B0); PG8_BAR; PG8_SCHED;
            PG8_STAGE(PG8_SB(0, 1), b2 + hstep, voffB);
            PG8_WAIT_V(6); PG8_BAR; PG8_MMA(1, 1, At, B1); PG8_BAR;
            PG8_LDB(B0, 1, 0); PG8_SCHED; PG8_LDA(At, 1, 0); PG8_STAGE(PG8_SA(0, 1), a2 + hstep, voffA);
            PG8_WAIT_L(8); PG8_BAR; PG8_WAIT_L(0); PG8_MMA(0, 0, At, B0); PG8_BAR; PG8_SCHED;
            PG8_LDB(B1, 1, 1); PG8_STAGE(PG8_SB(1, 0), b3, voffB);
            PG8_BAR; PG8_WAIT_L(0); PG8_MMA(0, 1, At, B1); PG8_BAR;
            PG8_LDA(At, 1, 1); PG8_STAGE(PG8_SA(1, 0), a3, voffA);
            PG8_BAR; PG8_WAIT_L(0); PG8_MMA(1, 0, At, B0); PG8_BAR; PG8_SCHED;
            PG8_STAGE(PG8_SB(1, 1), b3 + hstep, voffB);
            PG8_WAIT_V(6); PG8_BAR; PG8_MMA(1, 1, At, B1); PG8_BAR;
            }
        }
        if constexpr (ALIGN_EPI) { if (wr == 0) PG8_BAR; }
        if constexpr (!Epi::AFTER_DRAIN) { E(acc, cur, wr, wc, fr, fq); S.done(cur); }
        if (!has_next) break;
#pragma unroll
        for (int a = 0; a < 2; ++a)
#pragma unroll
            for (int b = 0; b < 2; ++b)
#pragma unroll
                for (int m = 0; m < 4; ++m)
#pragma unroll
                    for (int n = 0; n < 2; ++n) acc[a][b][m][n] = (f32x4){0.f, 0.f, 0.f, 0.f};
        cur = nxt; cA = nA; cB = nB; ++ui;
        if constexpr (ALIGN_EPI) { if (wr == 1) PG8_BAR; }
    }
    PG8_WAIT_V(0);
    if constexpr (!ALIGN_EPI) { if (wr == 0) PG8_BAR; }
    PG8_BAR;
    if constexpr (Epi::AFTER_DRAIN) { E.fused(acc, cur, wr, wc, fr, fq, lds, wid, lane); S.done(cur); }
#undef PG8_SA
#undef PG8_SB
#undef PG8_STAGE
#undef PG8_LDA
#undef PG8_LDB
#undef PG8_LDA8
#undef PG8_LDB8
#undef PG8_MMA8
#undef PG8_MMA
#undef PG8_WAIT_V
#undef PG8_WAIT_L
#undef PG8_BAR
#undef PG8_SCHED
}
}
#include <hip/hip_bf16.h>
#include <cmath>
namespace attn_body {
using bf16=__hip_bfloat16;
using bf16x8=__attribute__((ext_vector_type(8)))short;
using s16x4=__attribute__((ext_vector_type(4)))short;
using f32x16=__attribute__((ext_vector_type(16)))float;
using u32x4=__attribute__((ext_vector_type(4)))unsigned;
constexpr int BATCH=4,NHEAD=8,SEQ=4096,D=64,DM=3072,OPITCH=1024;
constexpr int NW=8,QBLK=32,QB=QBLK*NW,KVBLK=64,NQB=SEQ/QB;
constexpr int ATTN_UNIT_ROWS=QB;
__device__ __forceinline__ int crow(int r,int hi){return (r&3)+8*(r>>2)+4*hi;}
#define SBAR() __builtin_amdgcn_sched_barrier(0)
__device__ __forceinline__ void cmask(f32x16&p0,f32x16&p1,int jb,int qrel,int hi){
  const float NEG=-INFINITY; int kb=64*jb+4*hi;
  #pragma unroll
  for(int r=0;r<16;++r){int kv=kb+(r&3)+8*(r>>2); if(kv>qrel)p0[r]=NEG; if(kv+32>qrel)p1[r]=NEG;}
}

constexpr int NSLOT=3, SLOTB=8192;
constexpr int LDS_K=0, LDS_V=NSLOT*SLOTB, LDS_WS=2*NSLOT*SLOTB, LDS_OST=LDS_WS+NW*64*4, LDS_BYTES=LDS_OST+NW*4096;
constexpr float C2=0.125f*1.4426950408889634f;
__device__ __forceinline__ void glds16(const void*gsrc,unsigned lds_dst){unsigned keep;
  asm volatile("s_mov_b32 %0, m0\n\ts_mov_b32 m0, %2\n\ts_nop 0\n\tglobal_load_lds_dwordx4 %1, off\n\ts_mov_b32 m0, %0":"=&s"(keep):"v"(gsrc),"s"(lds_dst):"memory");}
__device__ __forceinline__ void glds16s(const void*sbase,unsigned voff,unsigned lds_dst){unsigned keep;
  asm volatile("s_mov_b32 %0, m0\n\ts_mov_b32 m0, %3\n\ts_nop 0\n\tglobal_load_lds_dwordx4 %1, %2\n\ts_mov_b32 m0, %0":"=&s"(keep):"v"(voff),"s"(sbase),"s"(lds_dst):"memory");}
__device__ __forceinline__ float max3f(float a,float b,float c){float r;asm("v_max3_f32 %0, %1, %2, %3":"=v"(r):"v"(a),"v"(b),"v"(c));return r;}
__device__ __forceinline__ float max2f(float a,float b){float r;asm("v_max_f32_e32 %0, %1, %2":"=v"(r):"v"(a),"v"(b));return r;}
__device__ __forceinline__ float fadd_s(float a,float b){float r;asm("v_add_f32_e32 %0, %1, %2":"=v"(r):"v"(a),"v"(b));return r;}
__device__ __forceinline__ float fsub_s(float a,float b){float r;asm("v_sub_f32_e32 %0, %1, %2":"=v"(r):"v"(a),"v"(b));return r;}
typedef float f32x2_t __attribute__((ext_vector_type(2))); typedef __bf16 bf16x2_t __attribute__((ext_vector_type(2)));
__device__ __forceinline__ unsigned cvtpk_s(float lo,float hi){f32x2_t v={lo,hi};bf16x2_t b=__builtin_convertvector(v,bf16x2_t);return __builtin_bit_cast(unsigned,b);}
#define WAIT_BAR(N) asm volatile("s_waitcnt vmcnt(" #N ") lgkmcnt(0)\n\ts_barrier":::"memory")

__device__ __forceinline__ void qkt(f32x16&p0,f32x16&p1,const char*Kslot,const bf16x8*qr,int r32,int hi){
  const f32x16 negm=f32x16{};
  const char*kb=Kslot+hi*1024+r32*16;
  #pragma unroll
  for(int d0=0;d0<4;++d0){
    const bf16x8 b0=*reinterpret_cast<const bf16x8*>(kb+d0*2048);
    const bf16x8 b1=*reinterpret_cast<const bf16x8*>(kb+d0*2048+512);
    if(d0==0){p0=__builtin_amdgcn_mfma_f32_32x32x16_bf16(b0,qr[0],negm,0,0,0);p1=__builtin_amdgcn_mfma_f32_32x32x16_bf16(b1,qr[0],negm,0,0,0);}
    else{p0=__builtin_amdgcn_mfma_f32_32x32x16_bf16(b0,qr[d0],p0,0,0,0);p1=__builtin_amdgcn_mfma_f32_32x32x16_bf16(b1,qr[d0],p1,0,0,0);}}
}
typedef __attribute__((address_space(3))) const char* lds_cptr;
typedef short v4i16_t __attribute__((ext_vector_type(4)));
__device__ __forceinline__ void kload8(bf16x8*kf,lds_cptr kp){
  kf[0]=*(const __attribute__((address_space(3))) bf16x8*)(kp);      kf[1]=*(const __attribute__((address_space(3))) bf16x8*)(kp+512);
  kf[2]=*(const __attribute__((address_space(3))) bf16x8*)(kp+2048); kf[3]=*(const __attribute__((address_space(3))) bf16x8*)(kp+2560);
  kf[4]=*(const __attribute__((address_space(3))) bf16x8*)(kp+4096); kf[5]=*(const __attribute__((address_space(3))) bf16x8*)(kp+4608);
  kf[6]=*(const __attribute__((address_space(3))) bf16x8*)(kp+6144); kf[7]=*(const __attribute__((address_space(3))) bf16x8*)(kp+6656);
}
__device__ __forceinline__ void kload2(bf16x8*kf,lds_cptr kp,int j){ kf[2*j]=*(const __attribute__((address_space(3))) bf16x8*)(kp+j*2048); kf[2*j+1]=*(const __attribute__((address_space(3))) bf16x8*)(kp+j*2048+512); }
__device__ __forceinline__ s16x4 vtr(lds_cptr p){ return __builtin_bit_cast(s16x4,__builtin_amdgcn_ds_read_tr16_b64_v4i16((__attribute__((address_space(3))) v4i16_t*)p)); }
__device__ __forceinline__ float rowmax(const f32x16&p0,const f32x16&p1){
  float a=max3f(p0[0],p0[1],p1[0]),b=max3f(p0[2],p0[3],p1[1]);a=max3f(a,p1[2],p1[3]);
  #pragma unroll
  for(int r=4;r<16;r+=4){a=max3f(a,p0[r],p0[r+1]);b=max3f(b,p0[r+2],p0[r+3]);a=max3f(a,p1[r],p1[r+1]);b=max3f(b,p1[r+2],p1[r+3]);}
  const float m=max2f(a,b);
  auto rr=__builtin_amdgcn_permlane32_swap(__float_as_uint(m),__float_as_uint(m),false,false);
  return max2f(__uint_as_float(rr[0]),__uint_as_float(rr[1]));
}
__device__ __forceinline__ void pv(f32x16*o,int vb,bf16x8 pa0,bf16x8 pa1,bf16x8 pa2,bf16x8 pa3){
  #pragma unroll
  for(int d0=0;d0<2;++d0){s16x4 lo[4],hi[4];
    #pragma unroll
    for(int ks=0;ks<4;++ks){
      asm volatile("ds_read_b64_tr_b16 %0,%1 offset:%c2":"=&v"(lo[ks]):"v"(vb),"i"(d0*4096+ks*1024):"memory");
      asm volatile("ds_read_b64_tr_b16 %0,%1 offset:%c2":"=&v"(hi[ks]):"v"(vb),"i"(d0*4096+ks*1024+512):"memory");}
    asm volatile("s_waitcnt lgkmcnt(0)":::"memory");SBAR();
    #define PK(k) (bf16x8){lo[k][0],lo[k][1],lo[k][2],lo[k][3],hi[k][0],hi[k][1],hi[k][2],hi[k][3]}
    o[d0]=__builtin_amdgcn_mfma_f32_32x32x16_bf16(pa0,PK(0),o[d0],0,0,0);
    o[d0]=__builtin_amdgcn_mfma_f32_32x32x16_bf16(pa1,PK(1),o[d0],0,0,0);
    o[d0]=__builtin_amdgcn_mfma_f32_32x32x16_bf16(pa2,PK(2),o[d0],0,0,0);
    o[d0]=__builtin_amdgcn_mfma_f32_32x32x16_bf16(pa3,PK(3),o[d0],0,0,0);
    #undef PK
  }
}

#define ATTN_YQ (127.f/6.f)
#ifndef ATTN_STORE16
#define ATTN_STORE16(p,v) st16_wt((p),(v))
#endif
template<int THRL> __device__ __forceinline__ void attn_unit(int b,int h,int qb,const bf16*Q,const bf16*__restrict__ K,const bf16*__restrict__ V,bf16*O,const float*KSUM,const float*GG,char*shm){
  int tid_=threadIdx.x; asm volatile("":"+v"(tid_)); const int tid=tid_,lane=tid&63,r32=lane&31,hi=lane>>5; const int wid=__builtin_amdgcn_readfirstlane(tid>>6);
  const long rowbase=(long)b*SEQ; const int q0=qb*QB;
  const bf16*Qw=Q+(rowbase+q0+wid*QBLK)*DM+h*D;
  const bf16*Kh=K+rowbase*DM+h*D,*Vh=V+rowbase*DM+h*D;
  const unsigned lds0=(unsigned)(uintptr_t)shm;
  float*wsf=(float*)(shm+LDS_WS)+wid*64;
  const unsigned koff=(unsigned)((lane*DM+wid*8)*2);
  const unsigned voffs=(unsigned)(((16*(wid&3)+(lane>>2))*DM+(wid>>2)*32+(lane&3)*8)*2);
  const unsigned kdst=lds0+LDS_K+wid*1024, vdst=lds0+LDS_V+wid*1024;
  #define PT(t) (((t)<4)?(NT-4+(t)):((t)-4))
  #define DMA_K(t,slot) glds16s((const char*)Kh+(long)PT(t)*(KVBLK*DM*2),koff,(unsigned)__builtin_amdgcn_readfirstlane(kdst+(slot)))
  #define DMA_V(t,slot) glds16s((const char*)Vh+(long)PT(t)*(KVBLK*DM*2),voffs,(unsigned)__builtin_amdgcn_readfirstlane(vdst+(slot)))
  const int vb0=(int)(lds0+LDS_V)+((lane>>4)&1)*32+(lane&3)*8+(4*hi+((lane&15)>>2))*64;
  const char*Kbase=shm+LDS_K; bf16x8 kf[8];
  const lds_cptr shm3=(lds_cptr)shm; const lds_cptr kp0=shm3+LDS_K+hi*1024+r32*16; const lds_cptr vp0=shm3+LDS_V+((lane>>4)&1)*32+(lane&3)*8+(4*hi+((lane&15)>>2))*64;
  const int NT=(q0+QB)/KVBLK;
  DMA_K(0,0);DMA_V(0,0);DMA_K(1,SLOTB);
  bf16x8 qr[4];
  #pragma unroll
  for(int d0=0;d0<4;++d0)qr[d0]=*reinterpret_cast<const bf16x8*>(&Qw[(long)r32*DM+d0*16+hi*8]);
  float mhat=0.f,l_reg=0.f;f32x16 o[2];o[0]=f32x16{};o[1]=f32x16{};const f32x16 z16=f32x16{};
  unsigned selm=(1u<<qb)-1u;
  if(qb>3){
    f32x16 gt=f32x16{};
    #pragma unroll
    for(int d0=0;d0<4;++d0){ const float*kp=KSUM+((long)(b*16+(r32&15)))*512+h*D+d0*16+hi*8;
      const float4 k0=*reinterpret_cast<const float4*>(kp),k1=*reinterpret_cast<const float4*>(kp+4);
      u32x4 kw; kw.x=cvtpk_s(k0.x,k0.y);kw.y=cvtpk_s(k0.z,k0.w);kw.z=cvtpk_s(k1.x,k1.y);kw.w=cvtpk_s(k1.z,k1.w);
      gt=__builtin_amdgcn_mfma_f32_32x32x16_bf16(__builtin_bit_cast(bf16x8,kw),qr[d0],gt,0,0,0); }
    float v0=-INFINITY,v1=-INFINITY,v2=-INFINITY; int i0=0,i1=0,i2=0;
    #define INS3(vv,ii) do{ const float x_=(vv); const int j_=(ii); \
      if(x_>v0){v2=v1;i2=i1;v1=v0;i1=i0;v0=x_;i0=j_;} else if(x_>v1){v2=v1;i2=i1;v1=x_;i1=j_;} else if(x_>v2){v2=x_;i2=j_;} }while(0)
    #pragma unroll
    for(int r=0;r<8;++r){ const int j=crow(r,hi); INS3(j<qb?gt[r]:-INFINITY,j); }
    const float p0=__shfl_xor(v0,32),p1=__shfl_xor(v1,32),p2=__shfl_xor(v2,32); const int q0i=__shfl_xor(i0,32),q1i=__shfl_xor(i1,32),q2i=__shfl_xor(i2,32);
    INS3(p0,q0i); INS3(p1,q1i); INS3(p2,q2i);
    #undef INS3
    selm=(1u<<i0)|(1u<<i1)|(1u<<i2);
  }
  const int qrel=wid*QBLK+r32;
  #define CMASK(P0,P1,t) do{ if((t)<4)cmask(P0,P1,(t),qrel,hi); }while(0)
  bool resc=false;
  #define START(P0,P1) do{ const float rm=rowmax(P0,P1); resc=false; \
    { const float dl=rm; mhat=fadd_s(mhat,dl); \
      _Pragma("unroll") for(int r=0;r<16;++r){P0[r]=fsub_s(P0[r],dl);P1[r]=fsub_s(P1[r],dl);} \
      } \
    _Pragma("unroll") for(int r=0;r<16;++r)P0[r]=__builtin_amdgcn_exp2f(P0[r]); }while(0)
  #define RESC() do{ if(resc){ asm volatile("s_waitcnt lgkmcnt(0)":::"memory"); \
      _Pragma("unroll") for(int d_=0;d_<2;++d_) _Pragma("unroll") for(int r=0;r<16;++r)o[d_][r]*=wsf[crow(r,hi)]; } }while(0)
  f32x16 pA0,pA1,pB0,pB1;
  int sl_prev=0,sl_cur=0,sl_next=SLOTB;
  #define ROT() do{sl_prev=sl_cur;sl_cur=sl_next;sl_next=(sl_next==(NSLOT-1)*SLOTB)?0:sl_next+SLOTB;}while(0)
  DMA_K(2,2*SLOTB);
  WAIT_BAR(3);
  qkt(pA0,pA1,Kbase,qr,r32,hi);asm volatile("s_nop 15\n\ts_nop 7":"+v"(pA0),"+v"(pA1));CMASK(pA0,pA1,0);
  START(pA0,pA1);
  _Pragma("unroll") for(int r=0;r<16;++r)pA1[r]=__builtin_amdgcn_exp2f(pA1[r]);
  WAIT_BAR(0);
  DMA_K(3,0);DMA_V(1,SLOTB);
  ROT();
  kload8(kf,kp0+sl_cur);
  WAIT_BAR(2);
  s16x4 vlo[8],vhi[8]; u32x4 pw0,pw1,pw2,pw3;
  #define PKW(P,B) cvtpk_s(P[B],P[B+1])
  #define PAF(k) __builtin_bit_cast(bf16x8,pw##k)
  #define VFR(i) (bf16x8){vlo[i][0],vlo[i][1],vlo[i][2],vlo[i][3],vhi[i][0],vhi[i][1],vhi[i][2],vhi[i][3]}
  #define PIN(x) asm volatile("":"+v"(x))
  #define MX3(a,b,c) __builtin_fmaxf(__builtin_fmaxf((a),(b)),(c))
  #define GAPA(MF,A0,A1,A2,A3,W0,W1,PW) do{ MF; sacc+=A0; sacc+=A1; sacc+=A2; sacc+=A3; PIN(sacc); W0; W1; PIN(PW); SBAR(); }while(0)
  #define EX(v) __builtin_amdgcn_exp2f(v)
  #define GAPB(MF,X,B) do{ MF; X[B]=EX(X[B]); X[B+1]=EX(X[B+1]); X[B+2]=EX(X[B+2]); X[B+3]=EX(X[B+3]); PIN(X); SBAR(); }while(0)
  #define VRD(i) do{ vlo[i]=vtr(vp_+(((i)>>2)*4096+((i)&3)*1024)); vhi[i]=vtr(vp_+(((i)>>2)*4096+((i)&3)*1024+512)); }while(0)
  #define KRD(G,j) do{ if(G){ kload2(kf,kp0+sl_next,j); SBAR(); } }while(0)
  #define STEP(C0,C1,P0,P1,t,GK,GV,GL) do{ SBAR(); \
    const lds_cptr vp_=vp0+sl_prev; \
    VRD(0); SBAR(); float sacc=(P0[0]+P0[1]); \
    GAPA(C0=__builtin_amdgcn_mfma_f32_32x32x16_bf16(kf[0],qr[0],z16,0,0,0), P0[2],P0[3],P0[4],P0[5],     pw0[0]=PKW(P0,0), pw0[1]=PKW(P0,2), pw0); \
    VRD(4); SBAR(); GAPA(C1=__builtin_amdgcn_mfma_f32_32x32x16_bf16(kf[1],qr[0],z16,0,0,0), P0[6],P0[7],P0[8],P0[9],     pw0[2]=PKW(P0,4), pw0[3]=PKW(P0,6), pw0); \
    VRD(1); SBAR(); GAPA(C0=__builtin_amdgcn_mfma_f32_32x32x16_bf16(kf[2],qr[1],C0,0,0,0),   P0[10],P0[11],P0[12],P0[13], pw1[0]=PKW(P0,8), pw1[1]=PKW(P0,10), pw1); \
    VRD(5); SBAR(); GAPA(C1=__builtin_amdgcn_mfma_f32_32x32x16_bf16(kf[3],qr[1],C1,0,0,0),   P0[14],P0[15],P1[0],P1[1],   pw1[2]=PKW(P0,12),pw1[3]=PKW(P0,14), pw1); \
    VRD(2); SBAR(); GAPA(C0=__builtin_amdgcn_mfma_f32_32x32x16_bf16(kf[4],qr[2],C0,0,0,0),   P1[2],P1[3],P1[4],P1[5],     pw2[0]=PKW(P1,0), pw2[1]=PKW(P1,2), pw2); \
    VRD(6); SBAR(); GAPA(C1=__builtin_amdgcn_mfma_f32_32x32x16_bf16(kf[5],qr[2],C1,0,0,0),   P1[6],P1[7],P1[8],P1[9],     pw2[2]=PKW(P1,4), pw2[3]=PKW(P1,6), pw2); \
    VRD(3); SBAR(); GAPA(C0=__builtin_amdgcn_mfma_f32_32x32x16_bf16(kf[6],qr[3],C0,0,0,0),   P1[10],P1[11],P1[12],P1[13], pw3[0]=PKW(P1,8), pw3[1]=PKW(P1,10), pw3); \
    VRD(7); SBAR(); GAPA(C1=__builtin_amdgcn_mfma_f32_32x32x16_bf16(kf[7],qr[3],C1,0,0,0),   P1[14],P1[15],0.f,0.f,       pw3[2]=PKW(P1,12),pw3[3]=PKW(P1,14), pw3); \
    l_reg+=sacc; \
    if(GK){DMA_K((t)+3,sl_cur);} if(GV){DMA_V((t)+1,sl_next);} \
    { const bool v_=((t)<4)||((selm>>(((t)-4)>>2))&1u); const float nm_=v_?-mhat:-INFINITY; \
      _Pragma("unroll") for(int r=0;r<16;++r){C0[r]+=nm_;C1[r]+=nm_;} } \
    CMASK(C0,C1,t); \
    { float a=MX3(C0[0],C0[1],C1[0]),b=MX3(C0[2],C0[3],C1[1]); a=MX3(a,C1[2],C1[3]); \
      _Pragma("unroll") for(int r=4;r<16;r+=4){a=MX3(a,C0[r],C0[r+1]);b=MX3(b,C0[r+2],C0[r+3]);a=MX3(a,C1[r],C1[r+1]);b=MX3(b,C1[r+2],C1[r+3]);} \
      float rm=__builtin_fmaxf(a,b); { auto rr=__builtin_amdgcn_permlane32_swap(__float_as_uint(rm),__float_as_uint(rm),false,false); rm=__builtin_fmaxf(__uint_as_float(rr[0]),__uint_as_float(rr[1])); } \
      resc=false; \
      if(__builtin_expect(__any(rm>(float)THRL),0)){ const float dl=__builtin_fmaxf(rm,0.f); mhat+=dl; \
        _Pragma("unroll") for(int r=0;r<16;++r){C0[r]-=dl;C1[r]-=dl;} \
        const float f=__builtin_amdgcn_exp2f(-dl); l_reg*=f; if(hi==0)wsf[r32]=f; resc=true; } } \
    SBAR(); \
    GAPB(o[0]=__builtin_amdgcn_mfma_f32_32x32x16_bf16(PAF(0),VFR(0),o[0],0,0,0), C0,0); \
    GAPB(o[1]=__builtin_amdgcn_mfma_f32_32x32x16_bf16(PAF(0),VFR(4),o[1],0,0,0), C0,4); \
    KRD(GL,0); GAPB(o[0]=__builtin_amdgcn_mfma_f32_32x32x16_bf16(PAF(1),VFR(1),o[0],0,0,0), C0,8); \
    KRD(GL,1); GAPB(o[1]=__builtin_amdgcn_mfma_f32_32x32x16_bf16(PAF(1),VFR(5),o[1],0,0,0), C0,12); \
    KRD(GL,2); GAPB(o[0]=__builtin_amdgcn_mfma_f32_32x32x16_bf16(PAF(2),VFR(2),o[0],0,0,0), C1,0); \
    KRD(GL,3); GAPB(o[1]=__builtin_amdgcn_mfma_f32_32x32x16_bf16(PAF(2),VFR(6),o[1],0,0,0), C1,4); \
    GAPB(o[0]=__builtin_amdgcn_mfma_f32_32x32x16_bf16(PAF(3),VFR(3),o[0],0,0,0), C1,8); \
    GAPB(o[1]=__builtin_amdgcn_mfma_f32_32x32x16_bf16(PAF(3),VFR(7),o[1],0,0,0), C1,12); \
    }while(0)
  int t=1;
  #define ENDW(tt) do{ if((tt)+3<NT){WAIT_BAR(2);} else if((tt)+2<NT){WAIT_BAR(1);} else {WAIT_BAR(0);} }while(0)
  for(;t<5&&t+1<NT;t+=2){
    STEP(pB0,pB1,pA0,pA1,t,(t+3<NT),(t+1<NT),(t+1<NT));       ENDW(t);   RESC(); ROT();
    STEP(pA0,pA1,pB0,pB1,t+1,(t+4<NT),(t+2<NT),(t+2<NT));     ENDW(t+1); RESC(); ROT();
  }
  #undef CMASK
  #define CMASK(P0,P1,t) do{}while(0)
  for(;t+5<NT;t+=2){
    STEP(pB0,pB1,pA0,pA1,t,true,true,true);     WAIT_BAR(2); RESC(); ROT();
    STEP(pA0,pA1,pB0,pB1,t+1,true,true,true);   WAIT_BAR(2); RESC(); ROT();
  }
  #undef CMASK
  #define CMASK(P0,P1,t) do{ if((t)<4)cmask(P0,P1,(t),qrel,hi); }while(0)
  for(;t+1<NT;t+=2){
    STEP(pB0,pB1,pA0,pA1,t,(t+3<NT),(t+1<NT),(t+1<NT));       ENDW(t);   RESC(); ROT();
    STEP(pA0,pA1,pB0,pB1,t+1,(t+4<NT),(t+2<NT),(t+2<NT));     ENDW(t+1); RESC(); ROT();
  }
  STEP(pB0,pB1,pA0,pA1,NT-1,false,false,false); RESC();
  { float sacc=pB0[0]+pB0[1]; _Pragma("unroll") for(int r=2;r<16;++r)sacc+=pB0[r]; _Pragma("unroll") for(int r=0;r<16;++r)sacc+=pB1[r]; l_reg+=sacc;
    pw0=(u32x4){PKW(pB0,0),PKW(pB0,2),PKW(pB0,4),PKW(pB0,6)};pw1=(u32x4){PKW(pB0,8),PKW(pB0,10),PKW(pB0,12),PKW(pB0,14)};pw2=(u32x4){PKW(pB1,0),PKW(pB1,2),PKW(pB1,4),PKW(pB1,6)};pw3=(u32x4){PKW(pB1,8),PKW(pB1,10),PKW(pB1,12),PKW(pB1,14)};
    SBAR(); pv(o,vb0+sl_cur,PAF(0),PAF(1),PAF(2),PAF(3)); }
  #undef PKW
  #undef PAF
  #undef VFR
  #undef PIN
  #undef MX3
  #undef GAPA
  #undef GAPB
  #undef EX
  #undef VRD
  #undef KRD
  #undef STEP
  #undef ENDW
  {auto rr=__builtin_amdgcn_permlane32_swap(__float_as_uint(l_reg),__float_as_uint(l_reg),false,false);l_reg=__uint_as_float(rr[0])+__uint_as_float(rr[1]);}
  if(hi==0)wsf[32+r32]=l_reg;asm volatile("s_waitcnt lgkmcnt(0)":::"memory");
  float rli[16];
  #pragma unroll
  for(int r=0;r<16;++r)rli[r]=__builtin_amdgcn_rcpf(wsf[32+crow(r,hi)]);
  bf16*Ow=O+(rowbase+q0+wid*QBLK)*OPITCH+h*D;
  { bf16*stg=(bf16*)(shm+LDS_OST)+wid*2048;
    #pragma unroll
    for(int r=0;r<16;++r){const int orow=crow(r,hi);
      #pragma unroll
      for(int d0=0;d0<2;++d0)stg[orow*64+d0*32+r32]=__float2bfloat16(o[d0][r]*rli[r]);}
    asm volatile("s_waitcnt lgkmcnt(0)":::"memory");
    const int ch=lane&7; float gg[8];
    #pragma unroll
    for(int i=0;i<8;++i)gg[i]=GG[h*D+ch*8+i];
    #pragma unroll
    for(int i=0;i<4;++i){const int row=i*8+(lane>>3); const u32x4 v=*(const u32x4*)(stg+row*64+ch*8);
      float x[8]; x[0]=__uint_as_float(v.x<<16);x[1]=__uint_as_float(v.x&0xffff0000u);x[2]=__uint_as_float(v.y<<16);x[3]=__uint_as_float(v.y&0xffff0000u);
      x[4]=__uint_as_float(v.z<<16);x[5]=__uint_as_float(v.z&0xffff0000u);x[6]=__uint_as_float(v.w<<16);x[7]=__uint_as_float(v.w&0xffff0000u);
      float ss=0.f;
      #pragma unroll
      for(int k=0;k<8;++k)ss+=x[k]*x[k];
      ss+=__shfl_xor(ss,1);ss+=__shfl_xor(ss,2);ss+=__shfl_xor(ss,4);
      const float rs=rsqrtf(ss*(1.f/64.f)+1e-6f);
      const float qn=rs*ATTN_YQ; unsigned w0=0u,w1=0u;
      #pragma unroll
      for(int k=0;k<4;++k){const int a=(int)fminf(fmaxf(__builtin_rintf(x[k]*qn),-127.f),127.f),b=(int)fminf(fmaxf(__builtin_rintf(x[4+k]*qn),-127.f),127.f); w0|=((unsigned)a&0xffu)<<(8*k); w1|=((unsigned)b&0xffu)<<(8*k);}
      st8_wt((void*)((unsigned char*)O+((rowbase+q0+wid*QBLK+row)*(long)OPITCH+h*D+ch*8)),(unsigned long long)w0|((unsigned long long)w1<<32));} }
  asm volatile("s_waitcnt lgkmcnt(0)\n\ts_barrier":::"memory");
  #undef DMA_K
  #undef PT
  #undef DMA_V
  #undef CMASK
  #undef START
  #undef RESC
  #undef ROT
}
constexpr int ATTN_LDS_BYTES=LDS_BYTES;
struct AttnTensors { const bf16* Q; const bf16* K; const bf16* V; bf16* O; const float* KSUM; const float* GG; };
struct AttnUnit { int bh; int qb; };
struct StaticOrder {
  int vcu,G;
  __device__ __forceinline__ explicit StaticOrder(int grid,int block):vcu((grid%8==0)?(block%8)*(grid/8)+block/8:block),G(grid){}
  __device__ __forceinline__ bool next(int i,AttnUnit&u)const{ const int pr=vcu+(i>>1)*G; if(pr>=256)return false; const int s=pr&7; u.bh=pr>>3; u.qb=(i&1)?s:15-s; return true; }
  __device__ __forceinline__ void a_ready(const AttnUnit&)const{}
  __device__ __forceinline__ void done(const AttnUnit&)const{}
};
template<class Sched,int THRL=8> __device__ __forceinline__ void attn_phase(char*lds,const AttnTensors&T,const Sched&S){
  AttnUnit u;
  for(int i=0;S.next(i,u);++i){ S.a_ready(u); attn_unit<THRL>(u.bh/NHEAD,u.bh%NHEAD,u.qb,T.Q,T.K,T.V,T.O,T.KSUM,T.GG,lds); S.done(u); }
}
#undef SBAR
#undef WAIT_BAR
}

#define GAS __attribute__((address_space(1)))
#define LAS __attribute__((address_space(3)))
typedef unsigned short bf16;
typedef unsigned v4u __attribute__((ext_vector_type(4)));
typedef float f32x4 __attribute__((ext_vector_type(4)));
typedef short bf16x8 __attribute__((ext_vector_type(8)));
typedef GAS unsigned gu32;
typedef GAS unsigned long long gu64;
#define RLX_AGENT __ATOMIC_RELAXED, __HIP_MEMORY_SCOPE_AGENT
#define LDS_WAIT() asm volatile("s_waitcnt lgkmcnt(0)" ::: "memory")
#define VM_WAIT() asm volatile("s_waitcnt vmcnt(0)" ::: "memory")
__device__ __forceinline__ unsigned long long rt() { return __builtin_amdgcn_s_memrealtime(); }
__device__ __forceinline__ unsigned f2bf(float f) { unsigned u = __builtin_bit_cast(unsigned, f); return (u + 0x7fffu + ((u >> 16) & 1u)) >> 16; }
__device__ __forceinline__ unsigned pk2(float lo, float hi) { return f2bf(lo) | (f2bf(hi) << 16); }

#define XB_TMO      128
#define XB_XCNT(j)  (256  + 64 * (j))
#define XB_XSUB(j)  (1280 + 64 * (j))
#define XB_XGEN(j)  (2304 + 64 * (j))
#define XB_TOP      3328
#define XB_TOPGEN   3392
#define XCD_BAR_WORDS 3456
#define XB_SPIN_CAP (1u << 18)

__device__ __forceinline__ unsigned xb_ld(unsigned* p)              { return __hip_atomic_load(p, __ATOMIC_RELAXED, __HIP_MEMORY_SCOPE_AGENT); }
__device__ __forceinline__ unsigned xb_add(unsigned* p, unsigned v) { return __hip_atomic_fetch_add(p, v, __ATOMIC_RELAXED, __HIP_MEMORY_SCOPE_AGENT); }
__device__ __forceinline__ unsigned xb_xcc_id() { return (unsigned)__builtin_amdgcn_s_getreg((3 << 11) | 20) & 0xFu; }
#define XB_SPIN(cond, bar) do { unsigned _sp = 0; while (cond) { __builtin_amdgcn_s_sleep(1); \
    if ((++_sp & 255u) == 0u) { if (xb_ld(&(bar)[XB_TMO])) break; if (_sp > XB_SPIN_CAP) { atomicAdd(&(bar)[XB_TMO], 1u); break; } } } } while (0)

struct XcdBarrier {
    unsigned* bar; unsigned x;
    volatile LAS unsigned* st;
};

__device__ __forceinline__ XcdBarrier xcd_barrier_post(unsigned* bar, volatile LAS unsigned* st) {
    XcdBarrier b; b.bar = bar; b.x = xb_xcc_id(); b.st = st;
    if (threadIdx.x == 0) (void)xb_add(&bar[XB_XCNT(b.x)], 1u);
    return b;
}
__device__ __forceinline__ void xcd_barrier_complete(unsigned* bar, unsigned x, unsigned& nloc, unsigned& nx) {
    const unsigned G = gridDim.x * gridDim.y * gridDim.z;
    unsigned sum, cnt, mine, sp = 0u;
    for (;;) {
        sum = 0u; cnt = 0u; mine = 0u;
#pragma unroll
        for (unsigned j = 0; j < 16; ++j) { const unsigned c = xb_ld(&bar[XB_XCNT(j)]); sum += c; cnt += (c > 0u) ? 1u : 0u; mine = (j == x) ? c : mine; }
        if (sum == G) break;
        __builtin_amdgcn_s_sleep(1);
        if ((++sp & 255u) == 0u) { if (xb_ld(&bar[XB_TMO])) break; if (sp > XB_SPIN_CAP) { atomicAdd(&bar[XB_TMO], 1u); break; } }
    }
    nloc = mine > 0u ? mine : 1u; nx = cnt > 0u ? cnt : 1u;
}

__device__ __forceinline__ void xcd_barrier(const XcdBarrier& b) {
    asm volatile("s_waitcnt vmcnt(0)" ::: "memory");
    __syncthreads();
    if (threadIdx.x == 0) {
        unsigned* bar = b.bar;
        __builtin_amdgcn_s_waitcnt(0);
        unsigned nloc = b.st[0], nx = b.st[1];
        if (nloc == 0u) { xcd_barrier_complete(bar, b.x, nloc, nx); b.st[0] = nloc; b.st[1] = nx; }
        const unsigned old = xb_add(&bar[XB_XSUB(b.x)], 1u);
        const unsigned gen = old / nloc;
        if (old + 1u == (gen + 1u) * nloc) {
            asm volatile("s_waitcnt vmcnt(0)" ::: "memory");
            const unsigned og = xb_add(&bar[XB_TOP], 1u);
            const unsigned tg = og / nx;
            if (og + 1u == (tg + 1u) * nx) xb_add(&bar[XB_TOPGEN], 1u);
            else XB_SPIN(xb_ld(&bar[XB_TOPGEN]) == tg, bar);
            __builtin_amdgcn_fence(__ATOMIC_ACQUIRE, "agent");
            xb_add(&bar[XB_XGEN(b.x)], 1u);
            asm volatile("s_waitcnt vmcnt(0)" ::: "memory");
        } else {
            XB_SPIN(xb_ld(&bar[XB_XGEN(b.x)]) == gen, bar);
            __builtin_amdgcn_fence(__ATOMIC_ACQUIRE, "agent");
            asm volatile("s_waitcnt vmcnt(0)" ::: "memory");
        }
    }
    __syncthreads();
}

constexpr int NWAVES = 8;
constexpr int NB = 4, S = 4096, D = 1024, M = NB * S;
constexpr int NIN = 3072, NQ = 2048, NEXP = 16384;
constexpr float EPS = 1e-6f;
constexpr float C2 = 0.125f * 1.4426950408889634f;

constexpr size_t MiB = 1u << 20;
constexpr size_t WS_CTL = 0, CTL_ZERO_BYTES = 256 * 1024;
constexpr size_t WS_MOD = 1 * MiB;
constexpr size_t WS_KMEAN = 128 * 1024;
constexpr size_t WS_KEYS = 1 * MiB + 512 * 1024;
constexpr size_t WS_WIN = 2 * MiB, WS_WO = 8 * MiB, WS_WQ = 10 * MiB;
constexpr size_t WS_EIDX = 14 * MiB, WS_G = 22 * MiB;
constexpr size_t WS_U = 32 * MiB, WS_V = 64 * MiB;
constexpr size_t WS_SU = 48 * MiB, WS_SV = 48 * MiB + 64 * 1024;
constexpr size_t WS_H = 96 * MiB;
constexpr size_t WS_P = 128 * MiB;
constexpr size_t WS_QP = 128 * MiB, WS_O = 192 * MiB;
constexpr size_t WS_Y = 224 * MiB, WS_END = 256 * MiB;
constexpr int CW_BAR = 1024;
constexpr int CW_CMAX = 8192;
constexpr int CW_CMAX3 = CW_CMAX + 3072 + 2048;
constexpr float YQ = 127.f / 6.f;
constexpr int CW_CMAX2 = CW_CMAX + 3072;
constexpr size_t WS_WO8 = 47 * MiB;
constexpr size_t WS_WQ8 = 45 * MiB, WS_RS2 = 44 * MiB + 65536;
constexpr size_t WS_WIN8 = 40 * MiB, WS_RS = 44 * MiB;

constexpr int LDS_BYTES = 153600;
constexpr int LDSCTL_OFF = LDS_BYTES - 512, MISC_OFF = LDSCTL_OFF + 320;
constexpr int RING_BYTES = 131072;

struct Frame {
    LAS unsigned char* lds;
    volatile LAS unsigned* MISC;
    gu32* ctl;
    int tid, lane, wave, G;
    const float *x, *c, *ada_w, *ada_b, *pre_gain, *post_gain, *w_in, *conv_w, *group_gain, *w_out, *fpre_gain, *fpost_gain, *wq, *keys, *pu, *pv;
    float* out;
    float* mod; float* kmean; bf16* keysb; bf16 *WinT, *WoT, *WqT; int* eidx; float* gw; unsigned char *U8, *V8; float *su, *sv; bf16 *H, *P, *QP, *O, *Y; float* scratch; unsigned char* Win8; float* rs; unsigned char* Wq8; float* rs2; unsigned char* Wo8;
};

__device__ __forceinline__ float wave_sum(float v) {
#pragma unroll
    for (int o = 1; o < 64; o <<= 1) v += __shfl_xor(v, o);
    return v;
}
__device__ __forceinline__ float bflo(unsigned u) { return __uint_as_float(u << 16); }
__device__ __forceinline__ float bfhi(unsigned u) { return __uint_as_float(u & 0xffff0000u); }

struct TItem { const float* W; bf16* WT; unsigned* cmax; const float* ksc; int N, k0, n0; };
__device__ __forceinline__ void p0_titem_load(const TItem& t, f32x4 (&v)[8], float (&ks)[8], int lane) {
#pragma unroll
    for (int i = 0; i < 8; ++i) { const int kk = 8 * i + (lane >> 3);
        v[i] = *(const GAS f32x4*)(t.W + (size_t)(t.k0 + kk) * t.N + t.n0 + 4 * (lane & 7));
        ks[i] = t.ksc != nullptr ? t.ksc[t.k0 + kk] * (1.f / YQ) : 1.f; }
}
__device__ __forceinline__ void p0_titem_process(const TItem& t, const f32x4 (&v)[8], const float (&ks)[8], LAS float* scr, int lane) {
#pragma unroll
    for (int i = 0; i < 8; ++i) { const int kk = 8 * i + (lane >> 3); LAS float* d = scr + kk * 33 + 4 * (lane & 7); const f32x4 w = v[i] * ks[i];
        d[0] = w.x; d[1] = w.y; d[2] = w.z; d[3] = w.w; }
    LDS_WAIT(); asm volatile("" ::: "memory");
    const int c = lane & 7;
#pragma unroll
    for (int j = 0; j < 4; ++j) { const int n = (lane >> 3) + 8 * j; const LAS float* s = scr + (8 * c) * 33 + n;
        v4u o; o.x = pk2(s[0 * 33], s[1 * 33]); o.y = pk2(s[2 * 33], s[3 * 33]); o.z = pk2(s[4 * 33], s[5 * 33]); o.w = pk2(s[6 * 33], s[7 * 33]);
        st16_wt((void*)(t.WT + (size_t)(t.n0 + n) * D + t.k0 + 8 * c), o);
        float am = fmaxf(fmaxf(fmaxf(fabsf(s[0 * 33]), fabsf(s[1 * 33])), fmaxf(fabsf(s[2 * 33]), fabsf(s[3 * 33]))), fmaxf(fmaxf(fabsf(s[4 * 33]), fabsf(s[5 * 33])), fmaxf(fabsf(s[6 * 33]), fabsf(s[7 * 33]))));
        am = fmaxf(am, __shfl_xor(am, 1)); am = fmaxf(am, __shfl_xor(am, 2)); am = fmaxf(am, __shfl_xor(am, 4));
        if (c == 0) atomicMax(t.cmax + t.n0 + n, __float_as_uint(am)); }
    LDS_WAIT(); asm volatile("" ::: "memory");
}
__device__ __forceinline__ void cvt8(const float* src, bf16* dst, size_t i8) {
    const f32x4 a = *(const GAS f32x4*)(src + i8 * 8), b = *(const GAS f32x4*)(src + i8 * 8 + 4);
    v4u o; o.x = pk2(a.x, a.y); o.y = pk2(a.z, a.w); o.z = pk2(b.x, b.y); o.w = pk2(b.z, b.w);
    st16_wt((void*)(dst + i8 * 8), o);
}
__device__ __forceinline__ void p0_prep(Frame& F) {
    {
        LAS float* sc = (LAS float*)F.lds;
        LAS float* red = sc + 4096;
        bool did = false;
        for (int it = blockIdx.x; it < 192; it += F.G) {
            if (!did) { for (int i = F.tid; i < 4096; i += 512) { const float v = F.c[i]; sc[i] = v / (1.f + __expf(-v)); } did = true; }
            __syncthreads();
            const int c4 = F.tid & 7, ks = F.tid >> 3, j0 = it * 32 + 4 * c4;
            f32x4 w[16];
#pragma unroll
            for (int i = 0; i < 16; ++i) w[i] = *(const GAS f32x4*)(F.ada_w + (size_t)(ks * 16 + i) * 6144 + j0);
            f32x4 a0 = {0.f, 0.f, 0.f, 0.f}, a1 = a0, a2 = a0, a3 = a0;
#pragma unroll
            for (int i = 0; i < 16; ++i) { const int r = ks * 16 + i; a0 += w[i] * sc[r]; a1 += w[i] * sc[1024 + r]; a2 += w[i] * sc[2048 + r]; a3 += w[i] * sc[3072 + r]; }
            *(LAS f32x4*)(red + (ks * 4 + 0) * 32 + 4 * c4) = a0; *(LAS f32x4*)(red + (ks * 4 + 1) * 32 + 4 * c4) = a1;
            *(LAS f32x4*)(red + (ks * 4 + 2) * 32 + 4 * c4) = a2; *(LAS f32x4*)(red + (ks * 4 + 3) * 32 + 4 * c4) = a3;
            __syncthreads();
            if (F.tid < 128) { const int b = F.tid >> 5, jj = F.tid & 31; float s = 0.f;
#pragma unroll 16
                for (int k = 0; k < 64; ++k) s += red[(k * 4 + b) * 32 + jj];
                __hip_atomic_store(F.mod + b * 6144 + it * 32 + jj, s + F.ada_b[it * 32 + jj], __ATOMIC_RELAXED, __HIP_MEMORY_SCOPE_AGENT); }
        }
        __syncthreads();
    }
    LAS float* scr = (LAS float*)(F.lds + F.wave * 16384);
    const int gwv = blockIdx.x * NWAVES + F.wave, NGW = F.G * NWAVES;
    constexpr int I_IN = (D / 64) * (NIN / 32), I_O = (D / 64) * (D / 32), I_Q = (D / 64) * (NQ / 32), I_ALL = I_IN + I_O + I_Q;
    auto titem = [&](int it) { TItem t; int r = it;
        if (r < I_IN) { t.W = F.w_in; t.WT = F.WinT; t.cmax = (unsigned*)(F.ctl + CW_CMAX); t.ksc = nullptr; t.N = NIN; }
        else if (r < I_IN + I_O) { r -= I_IN; t.W = F.w_out; t.WT = F.WoT; t.cmax = (unsigned*)(F.ctl + CW_CMAX3); t.ksc = F.group_gain; t.N = D; }
        else { r -= I_IN + I_O; t.W = F.wq; t.WT = F.WqT; t.cmax = (unsigned*)(F.ctl + CW_CMAX2); t.ksc = nullptr; t.N = NQ; }
        const int nblk = t.N / 32; t.k0 = 64 * (r / nblk); t.n0 = 32 * (r % nblk); return t; };
    { f32x4 va[8], vb[8]; float ka[8], kb[8]; TItem ta, tb;
      int it = gwv;
      if (it < I_ALL) { ta = titem(it); p0_titem_load(ta, va, ka, F.lane); }
      while (it < I_ALL) {
          const int i1 = it + NGW; const bool h1 = i1 < I_ALL;
          if (h1) { tb = titem(i1); p0_titem_load(tb, vb, kb, F.lane); }
          p0_titem_process(ta, va, ka, scr, F.lane);
          if (!h1) break;
          it = i1 + NGW;
          if (it < I_ALL) { ta = titem(it); p0_titem_load(ta, va, ka, F.lane); }
          p0_titem_process(tb, vb, kb, scr, F.lane);
      } }
    const size_t gt = (size_t)blockIdx.x * 512 + F.tid, NT = (size_t)F.G * 512;
    for (size_t i = gt; i < (size_t)16 * 128 * 128 / 8; i += NT) cvt8(F.keys, F.keysb, i);
}
__device__ __forceinline__ void p0_tables(Frame& F) {
    const int gwv = blockIdx.x * NWAVES + F.wave, NGW = F.G * NWAVES;
    for (int row0 = gwv; row0 < 2 * NEXP; row0 += 2 * NGW) {
      f32x4 a2[2][4];
#pragma unroll
      for (int rr = 0; rr < 2; ++rr) { const int row = row0 + rr * NGW; if (row < 2 * NEXP) { const GAS f32x4* src = (const GAS f32x4*)(((row >> 14) ? F.pv : F.pu) + (size_t)(row & (NEXP - 1)) * D + 16 * F.lane);
#pragma unroll
          for (int i = 0; i < 4; ++i) a2[rr][i] = src[i]; } }
#pragma unroll
      for (int rr = 0; rr < 2; ++rr) { const int row = row0 + rr * NGW; if (row >= 2 * NEXP) break;
        const int tabv = row >> 14, e = row & (NEXP - 1);
        f32x4 a[4]; float ssq = 0.f;
#pragma unroll
        for (int i = 0; i < 4; ++i) { a[i] = a2[rr][i]; ssq += (a[i].x * a[i].x + a[i].y * a[i].y) + (a[i].z * a[i].z + a[i].w * a[i].w); }
        ssq = wave_sum(ssq);
        const float rms = sqrtf(ssq * (1.f / D));
        if (tabv == 0) {
            const float stepq = 0.34f * rms, isq = stepq > 0.f ? 1.f / stepq : 0.f;
            unsigned d0 = 0u, d1 = 0u;
#pragma unroll
            for (int i = 0; i < 4; ++i) { const float xs[4] = {a[i].x, a[i].y, a[i].z, a[i].w};
#pragma unroll
                for (int c = 0; c < 4; ++c) { const int q = (int)fminf(fmaxf(__builtin_rintf(xs[c] * isq), -7.f), 7.f); const int el = 4 * i + c;
                    if (el < 8) d0 |= (unsigned)(q & 15) << (4 * el); else d1 |= (unsigned)(q & 15) << (4 * (el - 8)); } }
            st8_wt((void*)(F.U8 + (size_t)e * 512 + 8 * F.lane), (unsigned long long)d0 | ((unsigned long long)d1 << 32));
            if (F.lane == 0) __hip_atomic_store(F.su + e, stepq, __ATOMIC_RELAXED, __HIP_MEMORY_SCOPE_AGENT);
        } else {
            const float unit = 0.5f * rms, iu = unit > 0.f ? 1.f / unit : 0.f;
            unsigned d0 = 0u, d1 = 0u;
            d0 = __builtin_amdgcn_cvt_scalef32_pk_fp4_f32(d0, a[0].x * iu, a[0].y * iu, 1.0f, 0); d0 = __builtin_amdgcn_cvt_scalef32_pk_fp4_f32(d0, a[0].z * iu, a[0].w * iu, 1.0f, 1);
            d0 = __builtin_amdgcn_cvt_scalef32_pk_fp4_f32(d0, a[1].x * iu, a[1].y * iu, 1.0f, 2); d0 = __builtin_amdgcn_cvt_scalef32_pk_fp4_f32(d0, a[1].z * iu, a[1].w * iu, 1.0f, 3);
            d1 = __builtin_amdgcn_cvt_scalef32_pk_fp4_f32(d1, a[2].x * iu, a[2].y * iu, 1.0f, 0); d1 = __builtin_amdgcn_cvt_scalef32_pk_fp4_f32(d1, a[2].z * iu, a[2].w * iu, 1.0f, 1);
            d1 = __builtin_amdgcn_cvt_scalef32_pk_fp4_f32(d1, a[3].x * iu, a[3].y * iu, 1.0f, 2); d1 = __builtin_amdgcn_cvt_scalef32_pk_fp4_f32(d1, a[3].z * iu, a[3].w * iu, 1.0f, 3);
            st8_wt((void*)(F.V8 + (size_t)(F.lane >> 4) * (NEXP * 128) + (size_t)e * 128 + (F.lane & 15) * 8), (unsigned long long)d0 | ((unsigned long long)d1 << 32));
            if (F.lane == 0) __hip_atomic_store(F.sv + e, unit, __ATOMIC_RELAXED, __HIP_MEMORY_SCOPE_AGENT);
        }
      }
    }
}

__device__ __forceinline__ unsigned q8x4(const f32x4 v, float qs) {
    const int a = (int)__builtin_rintf(v.x * qs), b = (int)__builtin_rintf(v.y * qs), c = (int)__builtin_rintf(v.z * qs), d = (int)__builtin_rintf(v.w * qs);
    return ((unsigned)a & 0xffu) | (((unsigned)b & 0xffu) << 8) | (((unsigned)c & 0xffu) << 16) | ((unsigned)d << 24);
}
__device__ __forceinline__ unsigned q8x4c(const f32x4 v, float qs) {
    const int a = (int)fminf(fmaxf(__builtin_rintf(v.x * qs), -127.f), 127.f), b = (int)fminf(fmaxf(__builtin_rintf(v.y * qs), -127.f), 127.f);
    const int c = (int)fminf(fmaxf(__builtin_rintf(v.z * qs), -127.f), 127.f), d = (int)fminf(fmaxf(__builtin_rintf(v.w * qs), -127.f), 127.f);
    return ((unsigned)a & 0xffu) | (((unsigned)b & 0xffu) << 8) | (((unsigned)c & 0xffu) << 16) | ((unsigned)d << 24);
}
__device__ __forceinline__ void p1_hnorm(Frame& F) {
    const int gwv = blockIdx.x * NWAVES + F.wave, NGW = F.G * NWAVES;
    for (int m0 = gwv * 4; m0 < M; m0 += NGW * 4) {
        const int b = m0 >> 12;
        f32x4 v[4][4];
#pragma unroll
        for (int r = 0; r < 4; ++r) { const GAS f32x4* xr = (const GAS f32x4*)(F.x + (size_t)(m0 + r) * D) + F.lane;
#pragma unroll
            for (int j = 0; j < 4; ++j) v[r][j] = xr[64 * j]; }
        f32x4 gs[4], sh[4];
#pragma unroll
        for (int j = 0; j < 4; ++j) { const int col = 4 * F.lane + 256 * j;
            gs[j] = *(const GAS f32x4*)(F.pre_gain + col) * (*(const GAS f32x4*)(F.mod + b * 6144 + 1024 + col) + 1.f); sh[j] = *(const GAS f32x4*)(F.mod + b * 6144 + col); }
#pragma unroll
        for (int r = 0; r < 4; ++r) {
            float ss = 0.f;
#pragma unroll
            for (int j = 0; j < 4; ++j) ss += (v[r][j].x * v[r][j].x + v[r][j].y * v[r][j].y) + (v[r][j].z * v[r][j].z + v[r][j].w * v[r][j].w);
            const float rstd = rsqrtf(wave_sum(ss) * (1.f / D) + EPS);
            f32x4 o[4]; float am = 0.f;
#pragma unroll
            for (int j = 0; j < 4; ++j) { o[j] = v[r][j] * rstd * gs[j] + sh[j]; am = fmaxf(am, fmaxf(fmaxf(fabsf(o[j].x), fabsf(o[j].y)), fmaxf(fabsf(o[j].z), fabsf(o[j].w)))); }
#pragma unroll
            for (int of = 1; of < 64; of <<= 1) am = fmaxf(am, __shfl_xor(am, of));
            const float qs = am > 0.f ? 127.f / am : 0.f;
            v4u w; w.x = q8x4(o[0], qs); w.y = q8x4(o[1], qs); w.z = q8x4(o[2], qs); w.w = q8x4(o[3], qs);
            st16_wt((void*)((unsigned char*)F.H + (size_t)(m0 + r) * D + 16 * F.lane), w);
            if (F.lane == 0) __hip_atomic_store(F.rs + m0 + r, am * (1.f / 127.f), __ATOMIC_RELAXED, __HIP_MEMORY_SCOPE_AGENT);
        }
    }
    for (int n = gwv; n < NIN; n += NGW) {
        const float cm = __uint_as_float(F.ctl[CW_CMAX + n]); const float qs = cm > 0.f ? 127.f / cm : 0.f;
        const GAS unsigned long long* src = (const GAS unsigned long long*)(F.WinT + (size_t)n * D) + F.lane;
        unsigned long long q[4];
#pragma unroll
        for (int j = 0; j < 4; ++j) q[j] = src[64 * j];
        unsigned wd[4];
#pragma unroll
        for (int j = 0; j < 4; ++j) { const unsigned lo = (unsigned)q[j], hi = (unsigned)(q[j] >> 32); wd[j] = q8x4((f32x4){bflo(lo), bfhi(lo), bflo(hi), bfhi(hi)}, qs); }
        v4u w; w.x = wd[0]; w.y = wd[1]; w.z = wd[2]; w.w = wd[3];
        st16_wt((void*)(F.Win8 + (size_t)n * D + 16 * F.lane), w);
    }
    for (int n = gwv; n < NQ; n += NGW) {
        const float cm = __uint_as_float(F.ctl[CW_CMAX2 + n]); const float qs = cm > 0.f ? 127.f / cm : 0.f;
        const GAS v4u* src = (const GAS v4u*)(F.WqT + (size_t)n * D + 16 * F.lane);
        const v4u q0 = src[0], q1 = src[1];
        v4u w; w.x = q8x4((f32x4){bflo(q0.x), bfhi(q0.x), bflo(q0.y), bfhi(q0.y)}, qs); w.y = q8x4((f32x4){bflo(q0.z), bfhi(q0.z), bflo(q0.w), bfhi(q0.w)}, qs);
        w.z = q8x4((f32x4){bflo(q1.x), bfhi(q1.x), bflo(q1.y), bfhi(q1.y)}, qs); w.w = q8x4((f32x4){bflo(q1.z), bfhi(q1.z), bflo(q1.w), bfhi(q1.w)}, qs);
        st16_wt((void*)(F.Wq8 + (size_t)n * D + 16 * F.lane), w);
    }
    for (int n = gwv; n < D; n += NGW) {
        const float cm = __uint_as_float(F.ctl[CW_CMAX3 + n]); const float qs = cm > 0.f ? 127.f / cm : 0.f;
        const GAS v4u* src = (const GAS v4u*)(F.WoT + (size_t)n * D + 16 * F.lane);
        const v4u q0 = src[0], q1 = src[1];
        v4u w; w.x = q8x4((f32x4){bflo(q0.x), bfhi(q0.x), bflo(q0.y), bfhi(q0.y)}, qs); w.y = q8x4((f32x4){bflo(q0.z), bfhi(q0.z), bflo(q0.w), bfhi(q0.w)}, qs);
        w.z = q8x4((f32x4){bflo(q1.x), bfhi(q1.x), bflo(q1.y), bfhi(q1.y)}, qs); w.w = q8x4((f32x4){bflo(q1.z), bfhi(q1.z), bflo(q1.w), bfhi(q1.w)}, qs);
        st16_wt((void*)(F.Wo8 + (size_t)n * D + 16 * F.lane), w);
    }
}

__device__ __forceinline__ void unpack8(const v4u w, float* f) { f[0] = bflo(w.x); f[1] = bfhi(w.x); f[2] = bflo(w.y); f[3] = bfhi(w.y); f[4] = bflo(w.z); f[5] = bfhi(w.z); f[6] = bflo(w.w); f[7] = bfhi(w.w); }
__device__ __forceinline__ void p6_conv(Frame& F) {
    const int gwv = blockIdx.x * NWAVES + F.wave, NGW = F.G * NWAVES;
    const int col = 8 * F.lane;
    float cw[3][8], gg[8];
#pragma unroll
    for (int j = 0; j < 3; ++j)
#pragma unroll
        for (int i = 0; i < 8; ++i) cw[j][i] = F.conv_w[j * 512 + col + i];
#pragma unroll
    for (int i = 0; i < 8; ++i) gg[i] = F.group_gain[col + i];
    for (int t0 = gwv * 4; t0 < M; t0 += NGW * 4) {
        const int s0 = t0 & 4095;
        v4u gbw[4], gcw[6], hxw[6];
#pragma unroll
        for (int r = 0; r < 4; ++r) gbw[r] = *(const GAS v4u*)(F.P + (size_t)(t0 + r) * NIN + col);
#pragma unroll
        for (int k = 0; k < 6; ++k) { const int tt = (s0 == 0 && k < 2) ? t0 : (t0 - 2 + k);
            const bf16* rp = F.P + (size_t)tt * NIN + col; gcw[k] = *(const GAS v4u*)(rp + 512); hxw[k] = *(const GAS v4u*)(rp + 1024); }
        float u[6][8];
#pragma unroll
        for (int k = 0; k < 6; ++k) { float gc[8], hx[8]; unpack8(gcw[k], gc); unpack8(hxw[k], hx); const float keep = (s0 == 0 && k < 2) ? 0.f : 1.f;
#pragma unroll
            for (int i = 0; i < 8; ++i) u[k][i] = keep * gc[i] * hx[i]; }
#pragma unroll
        for (int r = 0; r < 4; ++r) {
            float acc[8], gb[8]; unpack8(gbw[r], gb);
            float ss = 0.f;
#pragma unroll
            for (int i = 0; i < 8; ++i) { acc[i] = gb[i] * (cw[0][i] * u[r][i] + cw[1][i] * u[r + 1][i] + cw[2][i] * u[r + 2][i]); ss += acc[i] * acc[i]; }
            ss += __shfl_xor(ss, 1); ss += __shfl_xor(ss, 2); ss += __shfl_xor(ss, 4);
            const float rstd = rsqrtf(ss * (1.f / 64.f) + EPS);
            const float qn = rstd * YQ;
            const unsigned w0 = q8x4c((f32x4){acc[0], acc[1], acc[2], acc[3]}, qn), w1 = q8x4c((f32x4){acc[4], acc[5], acc[6], acc[7]}, qn);
            st8_wt((void*)((unsigned char*)F.Y + (size_t)(t0 + r) * D + col), (unsigned long long)w0 | ((unsigned long long)w1 << 32));
        }
    }
}
__device__ __forceinline__ void p8_resid(Frame& F) {
    const int gwv = blockIdx.x * NWAVES + F.wave, NGW = F.G * NWAVES;
    for (int m0 = gwv * 2; m0 < M; m0 += NGW * 2) {
        const float* md = F.mod + (m0 >> 12) * 6144;
        unsigned long long ow[2][4]; f32x4 xv[2][4];
#pragma unroll
        for (int r = 0; r < 2; ++r) {
            const GAS unsigned long long* orow = (const GAS unsigned long long*)(F.O + (size_t)(m0 + r) * D) + F.lane; const GAS f32x4* xr = (const GAS f32x4*)(F.x + (size_t)(m0 + r) * D) + F.lane;
#pragma unroll
            for (int j = 0; j < 4; ++j) { ow[r][j] = orow[64 * j]; xv[r][j] = xr[64 * j]; } }
        f32x4 gg[4], gs[4], sh[4];
#pragma unroll
        for (int j = 0; j < 4; ++j) { const int col = 4 * F.lane + 256 * j;
            gg[j] = *(const GAS f32x4*)(F.post_gain + col) * *(const GAS f32x4*)(md + 2048 + col);
            gs[j] = *(const GAS f32x4*)(F.fpre_gain + col) * (*(const GAS f32x4*)(md + 4096 + col) + 1.f); sh[j] = *(const GAS f32x4*)(md + 3072 + col); }
#pragma unroll
        for (int r = 0; r < 2; ++r) { const int m = m0 + r;
            f32x4 ov[4]; float ss = 0.f;
#pragma unroll
            for (int j = 0; j < 4; ++j) { const unsigned lo = (unsigned)ow[r][j], hi = (unsigned)(ow[r][j] >> 32); ov[j] = (f32x4){bflo(lo), bfhi(lo), bflo(hi), bfhi(hi)};
                ss += (ov[j].x * ov[j].x + ov[j].y * ov[j].y) + (ov[j].z * ov[j].z + ov[j].w * ov[j].w); }
            const float rstd = rsqrtf(wave_sum(ss) * (1.f / D) + EPS);
            GAS unsigned long long* x1r = (GAS unsigned long long*)(F.QP + (size_t)m * D) + F.lane;
            f32x4 x1[4]; float s2 = 0.f;
#pragma unroll
            for (int j = 0; j < 4; ++j) { x1[j] = xv[r][j] + gg[j] * (ov[j] * rstd); st8_wt((void*)(x1r + 64 * j), (unsigned long long)pk2(x1[j].x, x1[j].y) | ((unsigned long long)pk2(x1[j].z, x1[j].w) << 32));
                s2 += (x1[j].x * x1[j].x + x1[j].y * x1[j].y) + (x1[j].z * x1[j].z + x1[j].w * x1[j].w); }
            const float rstd2 = rsqrtf(wave_sum(s2) * (1.f / D) + EPS);
            f32x4 o[4]; float am = 0.f;
#pragma unroll
            for (int j = 0; j < 4; ++j) { o[j] = x1[j] * rstd2 * gs[j] + sh[j]; am = fmaxf(am, fmaxf(fmaxf(fabsf(o[j].x), fabsf(o[j].y)), fmaxf(fabsf(o[j].z), fabsf(o[j].w)))); }
#pragma unroll
            for (int of = 1; of < 64; of <<= 1) am = fmaxf(am, __shfl_xor(am, of));
            const float qs = am > 0.f ? 119.f / am : 0.f;
#pragma unroll
            for (int j = 0; j < 4; ++j) st4_wt((void*)((unsigned char*)F.H + (size_t)m * D + 4 * F.lane + 256 * j), q8x4(o[j], qs));
            if (F.lane == 0) __hip_atomic_store(F.rs2 + m, am * (1.f / 119.f), __ATOMIC_RELAXED, __HIP_MEMORY_SCOPE_AGENT);
        }
    }
}
typedef float f32x16 __attribute__((ext_vector_type(16)));
__device__ __forceinline__ float vmaxf(float a, float b) { float r; asm("v_max_f32_e32 %0, %1, %2" : "=v"(r) : "v"(a), "v"(b)); return r; }
__device__ __forceinline__ float vminf(float a, float b) { float r; asm("v_min_f32_e32 %0, %1, %2" : "=v"(r) : "v"(a), "v"(b)); return r; }
#define CE_D(a, b) do { const float hi_ = vmaxf(a, b), lo_ = vminf(a, b); a = hi_; b = lo_; } while (0)
template <int N> __device__ __forceinline__ void bitonic_sort_desc(float (&v)[N]) {
#pragma unroll
    for (int k = 2; k <= N; k <<= 1)
#pragma unroll
        for (int j = k >> 1; j > 0; j >>= 1)
#pragma unroll
            for (int i = 0; i < N; ++i) { const int l = i ^ j; if (l > i) { if ((i & k) == 0) CE_D(v[i], v[l]); else CE_D(v[l], v[i]); } }
}
template <int N> __device__ __forceinline__ void bitonic_merge_desc(float (&v)[N]) {
#pragma unroll
    for (int j = N >> 1; j > 0; j >>= 1)
#pragma unroll
        for (int i = 0; i < N; ++i) { const int l = i ^ j; if (l > i) CE_D(v[i], v[l]); }
}
__device__ __forceinline__ void sort16_desc(float (&v)[16]) {
    CE_D(v[0], v[1]); CE_D(v[2], v[3]); CE_D(v[0], v[2]); CE_D(v[1], v[3]); CE_D(v[1], v[2]); CE_D(v[4], v[5]); CE_D(v[6], v[7]); CE_D(v[4], v[6]); CE_D(v[5], v[7]); CE_D(v[5], v[6]); CE_D(v[0], v[4]); CE_D(v[2], v[6]); CE_D(v[2], v[4]); CE_D(v[1], v[5]); CE_D(v[3], v[7]); CE_D(v[3], v[5]); CE_D(v[1], v[2]); CE_D(v[3], v[4]); CE_D(v[5], v[6]); CE_D(v[8], v[9]); CE_D(v[10], v[11]); CE_D(v[8], v[10]); CE_D(v[9], v[11]); CE_D(v[9], v[10]); CE_D(v[12], v[13]); CE_D(v[14], v[15]); CE_D(v[12], v[14]); CE_D(v[13], v[15]); CE_D(v[13], v[14]); CE_D(v[8], v[12]); CE_D(v[10], v[14]); CE_D(v[10], v[12]); CE_D(v[9], v[13]); CE_D(v[11], v[15]); CE_D(v[11], v[13]); CE_D(v[9], v[10]); CE_D(v[11], v[12]); CE_D(v[13], v[14]); CE_D(v[0], v[8]); CE_D(v[4], v[12]); CE_D(v[4], v[8]); CE_D(v[2], v[10]); CE_D(v[6], v[14]); CE_D(v[6], v[10]); CE_D(v[2], v[4]); CE_D(v[6], v[8]); CE_D(v[10], v[12]); CE_D(v[1], v[9]); CE_D(v[5], v[13]); CE_D(v[5], v[9]); CE_D(v[3], v[11]); CE_D(v[7], v[15]); CE_D(v[7], v[11]); CE_D(v[3], v[5]); CE_D(v[7], v[9]); CE_D(v[11], v[13]); CE_D(v[1], v[2]); CE_D(v[3], v[4]); CE_D(v[5], v[6]); CE_D(v[7], v[8]); CE_D(v[9], v[10]); CE_D(v[11], v[12]); CE_D(v[13], v[14]);
}
__device__ __forceinline__ void top16_merge(float (&a)[16], const float (&b)[16]) {
#pragma unroll
    for (int i = 0; i < 16; ++i) a[i] = vmaxf(a[i], b[15 - i]);
    bitonic_merge_desc<16>(a);
}
__device__ __forceinline__ void top16_of_64(const float (&v)[64], float (&out)[16]) {
    float g1[16], g2[16], g3[16];
#pragma unroll
    for (int i = 0; i < 16; ++i) { out[i] = v[i]; g1[i] = v[16 + i]; g2[i] = v[32 + i]; g3[i] = v[48 + i]; }
    sort16_desc(out); sort16_desc(g1); sort16_desc(g2); sort16_desc(g3);
    top16_merge(out, g1); top16_merge(g2, g3); top16_merge(out, g2);
}
constexpr int KROW = 272, KIMG = 128 * KROW;
__device__ __forceinline__ void route_half(const bf16x8 (&bq)[8], const LAS unsigned char* kimg, int r32, int hh, float (&svp)[16], unsigned (&ivp)[16]) {
    const LAS unsigned char* krow = kimg + r32 * KROW + 16 * hh;
    f32x16 acc[4];
#pragma unroll
    for (int nt = 0; nt < 4; ++nt) {
        acc[nt] = (f32x16){0.f, 0.f, 0.f, 0.f, 0.f, 0.f, 0.f, 0.f, 0.f, 0.f, 0.f, 0.f, 0.f, 0.f, 0.f, 0.f};
#pragma unroll
        for (int ks = 0; ks < 8; ++ks) { const bf16x8 ak = *(const LAS bf16x8*)(krow + nt * 32 * KROW + 32 * ks);
            acc[nt] = __builtin_amdgcn_mfma_f32_32x32x16_bf16(ak, bq[ks], acc[nt], 0, 0, 0); }
    }
    float v[64];
#pragma unroll
    for (int nt = 0; nt < 4; ++nt)
#pragma unroll
        for (int i = 0; i < 16; ++i) { const unsigned code = (unsigned)(32 * nt + 8 * (i >> 2) + (i & 3)); v[nt * 16 + i] = __uint_as_float((__float_as_uint(acc[nt][i]) & ~127u) | code); }
    float L[16], Pn[16];
    top16_of_64(v, L);
#pragma unroll
    for (int i = 0; i < 16; ++i) { L[i] = __uint_as_float(__float_as_uint(L[i]) | (unsigned)(hh << 2)); Pn[i] = __shfl_xor(L[i], 32); }
    top16_merge(L, Pn);
#pragma unroll
    for (int i = 0; i < 16; ++i) { const unsigned bits = __float_as_uint(L[i]); svp[i] = __uint_as_float(bits & ~127u); ivp[i] = bits & 127u; }
}
__device__ __forceinline__ void route_finish(const float (&sv)[2][16], const unsigned (&iv)[2][16], LAS unsigned* tab, int lane, int hh, int* epi, float* gpf, float rst) {
#define CAND(a, b) __uint_as_float((__float_as_uint(sv[0][a] + sv[1][b]) & ~255u) | (unsigned)((a) * 16 + (b)))
    float W[16], g1[16], g2[16];
#pragma unroll
    for (int i = 0; i < 16; ++i) W[i] = CAND(0, i);
#pragma unroll
    for (int i = 0; i < 15; ++i) g1[i] = CAND(i + 1, 0);
    g1[15] = -3e38f;
    g2[0] = CAND(1, 1); g2[1] = CAND(1, 2); g2[2] = CAND(1, 3); g2[3] = CAND(1, 4); g2[4] = CAND(1, 5); g2[5] = CAND(1, 6); g2[6] = CAND(1, 7);
    g2[7] = CAND(2, 1); g2[8] = CAND(2, 2); g2[9] = CAND(2, 3); g2[10] = CAND(2, 4); g2[11] = CAND(3, 1); g2[12] = CAND(3, 2); g2[13] = CAND(3, 3); g2[14] = CAND(4, 1); g2[15] = CAND(4, 2);
    sort16_desc(g2);
    g2[13] = vmaxf(g2[13], CAND(7, 1)); g2[14] = vmaxf(g2[14], CAND(6, 1)); g2[15] = vmaxf(g2[15], CAND(5, 1));
    bitonic_merge_desc<16>(g2);
    top16_merge(W, g1); top16_merge(W, g2);
#undef CAND
#pragma unroll
    for (int j = 0; j < 16; ++j) { tab[j * 64 + lane] = iv[0][j]; tab[(16 + j) * 64 + lane] = iv[1][j]; }
    float e[16], sum = 0.f; unsigned ex[16];
    const float s0 = __uint_as_float(__float_as_uint(W[0]) & ~255u);
#pragma unroll
    for (int j = 0; j < 16; ++j) { const unsigned bits = __float_as_uint(W[j]); const unsigned code = bits & 255u;
        e[j] = __expf((__uint_as_float(bits & ~255u) - s0) * rst); sum += e[j];
        ex[j] = tab[(code >> 4) * 64 + lane] * 128u + tab[(16 + (code & 15u)) * 64 + lane]; }
    const float inv = 1.f / sum;
    v4u eo0, eo1; f32x4 go0, go1;
    eo0.x = hh ? ex[8] : ex[0]; eo0.y = hh ? ex[9] : ex[1]; eo0.z = hh ? ex[10] : ex[2]; eo0.w = hh ? ex[11] : ex[3];
    eo1.x = hh ? ex[12] : ex[4]; eo1.y = hh ? ex[13] : ex[5]; eo1.z = hh ? ex[14] : ex[6]; eo1.w = hh ? ex[15] : ex[7];
    go0.x = (hh ? e[8] : e[0]) * inv; go0.y = (hh ? e[9] : e[1]) * inv; go0.z = (hh ? e[10] : e[2]) * inv; go0.w = (hh ? e[11] : e[3]) * inv;
    go1.x = (hh ? e[12] : e[4]) * inv; go1.y = (hh ? e[13] : e[5]) * inv; go1.z = (hh ? e[14] : e[6]) * inv; go1.w = (hh ? e[15] : e[7]) * inv;
    GAS v4u* ep = (GAS v4u*)epi; GAS f32x4* gp = (GAS f32x4*)gpf;
    st16_wt((void*)ep, eo0); st16_wt((void*)(ep + 1), eo1); st16_wt((void*)gp, __builtin_bit_cast(wt_v4u, go0)); st16_wt((void*)(gp + 1), __builtin_bit_cast(wt_v4u, go1));
}
__device__ __forceinline__ pg8::f32x4 i2f(const pg8::f32x4 a) { const pg8::i32x4 i = __builtin_bit_cast(pg8::i32x4, a); return (pg8::f32x4){(float)i[0], (float)i[1], (float)i[2], (float)i[3]}; }
struct EpiRoute {
    static constexpr bool PERM = true, AFTER_DRAIN = true;
    const bf16* keysb; int* eidx; float* gw; const unsigned* cmax2; const float* rs2;
    __device__ __forceinline__ void fused(pg8::f32x4 (&acc)[2][2][4][2], const pg8::Unit& u, int wr, int wc, int fr, int fq, LAS unsigned char* lds, int wid, int lane) const {
        int tid_ = threadIdx.x; asm volatile("" : "+v"(tid_)); const int h = u.pn, r32 = lane & 31, hh = lane >> 5, tid = tid_;
        LAS unsigned char* Qs = lds; LAS unsigned char* Ks = lds + 256 * KROW;
        const float rst = rs2[u.pm * 256 + 32 * wid + r32];
        v4u q1[2][4];
#pragma unroll
        for (int ai = 0; ai < 2; ++ai)
#pragma unroll
            for (int m = 0; m < 4; ++m) { const pg8::f32x4 a = i2f(acc[ai][1][m][0]), b = i2f(acc[ai][1][m][1]);
                q1[ai][m] = (v4u){pg8::cvt_pk_bf16(a[0], a[1]), pg8::cvt_pk_bf16(a[2], a[3]), pg8::cvt_pk_bf16(b[0], b[1]), pg8::cvt_pk_bf16(b[2], b[3])}; }
        float sv[2][16]; unsigned iv[2][16];
#pragma unroll
        for (int p = 0; p < 2; ++p) {
            if (p == 1) { asm volatile("s_waitcnt lgkmcnt(0)" ::: "memory"); __builtin_amdgcn_s_barrier(); asm volatile("" ::: "memory"); }
#pragma unroll
            for (int ai = 0; ai < 2; ++ai)
#pragma unroll
                for (int m = 0; m < 4; ++m) { v4u w;
                    if (p == 0) { const pg8::f32x4 a = i2f(acc[ai][0][m][0]), b = i2f(acc[ai][0][m][1]);
                        w = (v4u){pg8::cvt_pk_bf16(a[0], a[1]), pg8::cvt_pk_bf16(a[2], a[3]), pg8::cvt_pk_bf16(b[0], b[1]), pg8::cvt_pk_bf16(b[2], b[3])}; }
                    else w = q1[ai][m];
                    *(LAS v4u*)(Qs + (128 * ai + 64 * wr + 16 * m + fr) * KROW + (32 * wc + 8 * fq) * 2) = w; }
            { const int ch = tid & 15, kr = tid >> 4;
              const pg8::u32x4 c0 = *(const pg8::u32x4*)(cmax2 + h * 256 + p * 128 + ch * 8), c1 = *(const pg8::u32x4*)(cmax2 + h * 256 + p * 128 + ch * 8 + 4);
              v4u kq[4];
#pragma unroll
              for (int i = 0; i < 4; ++i) kq[i] = *(const GAS v4u*)(keysb + (size_t)((h * 2 + p) * 128 + kr + 32 * i) * 128 + ch * 8);
              float cs[8] = {__uint_as_float(c0.x), __uint_as_float(c0.y), __uint_as_float(c0.z), __uint_as_float(c0.w), __uint_as_float(c1.x), __uint_as_float(c1.y), __uint_as_float(c1.z), __uint_as_float(c1.w)};
#pragma unroll
              for (int i = 0; i < 8; ++i) cs[i] *= (1.f / 127.f);
#pragma unroll
              for (int i = 0; i < 4; ++i) { const v4u q = kq[i];
                v4u ko; ko.x = pk2(bflo(q.x) * cs[0], bfhi(q.x) * cs[1]); ko.y = pk2(bflo(q.y) * cs[2], bfhi(q.y) * cs[3]); ko.z = pk2(bflo(q.z) * cs[4], bfhi(q.z) * cs[5]); ko.w = pk2(bflo(q.w) * cs[6], bfhi(q.w) * cs[7]);
                *(LAS v4u*)(Ks + (kr + 32 * i) * KROW + ch * 16) = ko; } }
            asm volatile("s_waitcnt vmcnt(0) lgkmcnt(0)" ::: "memory"); __builtin_amdgcn_s_barrier(); asm volatile("" ::: "memory");
            bf16x8 bq[8];
#pragma unroll
            for (int ks = 0; ks < 8; ++ks) bq[ks] = *(const LAS bf16x8*)(Qs + (32 * wid + r32) * KROW + 32 * ks + 16 * hh);
            route_half(bq, Ks, r32, hh, sv[p], iv[p]);
        }
        asm volatile("s_waitcnt lgkmcnt(0)" ::: "memory"); __builtin_amdgcn_s_barrier(); asm volatile("" ::: "memory");
        const int t = u.pm * 256 + 32 * wid + r32;
        route_finish(sv, iv, (LAS unsigned*)(lds + wid * 8192), lane, hh, eidx + (size_t)t * 128 + h * 16 + 8 * hh, gw + (size_t)t * 128 + h * 16 + 8 * hh, rst);
        asm volatile("s_waitcnt lgkmcnt(0)" ::: "memory"); __builtin_amdgcn_s_barrier(); asm volatile("" ::: "memory");
    }
};
struct OneUnit {
    pg8::Unit u;
    __device__ __forceinline__ bool next(int i, pg8::Unit& o) const { if (i != 0) return false; o = u; return true; }
    __device__ __forceinline__ void a_ready(const pg8::Unit&) const {}
    __device__ __forceinline__ void done(const pg8::Unit&) const {}
};
__device__ __forceinline__ float gelu_tanh(float a) {
    const float z = 0.7978845608028654f * (a + 0.044715f * a * a * a);
    const float e = __expf(2.f * z);
    const float th = 1.f - 2.f / (e + 1.f);
    return 0.5f * a * (1.f + th);
}
typedef float f32x2v __attribute__((ext_vector_type(2)));
__device__ __forceinline__ void fp8x16_to_f32(const v4u w, float* f) {
    f32x2v t;
    t = __builtin_amdgcn_cvt_pk_f32_fp8((int)w.x, false); f[0] = t.x; f[1] = t.y; t = __builtin_amdgcn_cvt_pk_f32_fp8((int)w.x, true); f[2] = t.x; f[3] = t.y;
    t = __builtin_amdgcn_cvt_pk_f32_fp8((int)w.y, false); f[4] = t.x; f[5] = t.y; t = __builtin_amdgcn_cvt_pk_f32_fp8((int)w.y, true); f[6] = t.x; f[7] = t.y;
    t = __builtin_amdgcn_cvt_pk_f32_fp8((int)w.z, false); f[8] = t.x; f[9] = t.y; t = __builtin_amdgcn_cvt_pk_f32_fp8((int)w.z, true); f[10] = t.x; f[11] = t.y;
    t = __builtin_amdgcn_cvt_pk_f32_fp8((int)w.w, false); f[12] = t.x; f[13] = t.y; t = __builtin_amdgcn_cvt_pk_f32_fp8((int)w.w, true); f[14] = t.x; f[15] = t.y;
}
#define DPPF(x, ctrl) __uint_as_float((unsigned)__builtin_amdgcn_mov_dpp((int)__float_as_uint(x), ctrl, 0xf, 0xf, true))
__device__ __forceinline__ void swap16_add(float& a, float b) { auto r = __builtin_amdgcn_permlane16_swap(__float_as_uint(a), __float_as_uint(b), false, false); a = __uint_as_float(r[0]) + __uint_as_float(r[1]); }
__device__ __forceinline__ void swap32_add(float& a, float b) { auto r = __builtin_amdgcn_permlane32_swap(__float_as_uint(a), __float_as_uint(b), false, false); a = __uint_as_float(r[0]) + __uint_as_float(r[1]); }
constexpr int PW_BUF0 = 0, PW_SG = 4096, PW_BUF1 = 8192, PW_E = 16384, PW_WH = 17408, PW_WL = 17920, PW_YP = 18432, PW_IK = 18944, PW_BYTES = 18976;
static_assert(PW_BYTES * NWAVES <= LDSCTL_OFF, "PEER per-wave LDS blocks must stay below the control words");
typedef int v8i_t __attribute__((ext_vector_type(8)));
typedef int v2i_t __attribute__((ext_vector_type(2)));
__device__ __forceinline__ void peer_u_issue(v4u (&uw)[8], const unsigned char* U4, LAS unsigned char* wl, int it, int lane) {
    const int grp = it >> 2, j = it & 3, hw = lane >> 5, li = lane & 31;
#pragma unroll
    for (int q = 0; q < 8; ++q) { const unsigned e = *(const LAS unsigned short*)(wl + PW_E + (j * 128 + grp * 16 + 2 * q + hw) * 2);
        uw[q] = *(const GAS v4u*)(U4 + (e * 512u + 16u * (unsigned)li)); }
}
__device__ __forceinline__ void peer_u_compute(const v4u (&uw)[8], LAS unsigned char* wl, int it, int lane) {
    const int grp = it >> 2, j = it & 3, li = lane & 31;
    const v4u hh = *(LAS v4u*)(wl + j * 1024 + 16 * li), hl = *(LAS v4u*)(wl + j * 1024 + 512 + 16 * li);
    float pa[8];
#pragma unroll
    for (int q = 0; q < 8; ++q) {
        int dh = __builtin_amdgcn_sdot8((int)uw[q].x, (int)hh.x, 0, false); dh = __builtin_amdgcn_sdot8((int)uw[q].y, (int)hh.y, dh, false);
        dh = __builtin_amdgcn_sdot8((int)uw[q].z, (int)hh.z, dh, false); dh = __builtin_amdgcn_sdot8((int)uw[q].w, (int)hh.w, dh, false);
        int dl = __builtin_amdgcn_sdot8((int)uw[q].x, (int)hl.x, 0, false); dl = __builtin_amdgcn_sdot8((int)uw[q].y, (int)hl.y, dl, false);
        dl = __builtin_amdgcn_sdot8((int)uw[q].z, (int)hl.z, dl, false); dl = __builtin_amdgcn_sdot8((int)uw[q].w, (int)hl.w, dl, false);
        pa[q] = (float)(16 * dh + dl); }
    swap16_add(pa[0], pa[4]); swap16_add(pa[1], pa[5]); swap16_add(pa[2], pa[6]); swap16_add(pa[3], pa[7]);
#pragma unroll
    for (int i = 0; i < 4; ++i) { pa[i] += DPPF(pa[i], 0xB1); pa[i] += DPPF(pa[i], 0x4E); pa[i] += DPPF(pa[i], 0x141); pa[i] += DPPF(pa[i], 0x140); }
    if ((lane & 12) == 0) {
        const int q = lane & 3, r = lane >> 4;
        const int idx = j * 128 + grp * 16 + 2 * (q + 4 * (r & 1)) + (r >> 1);
        const f32x2v sg = *(const LAS f32x2v*)(wl + PW_SG + idx * 8);
        const float a = (q == 0 ? pa[0] : q == 1 ? pa[1] : q == 2 ? pa[2] : pa[3]) * sg.x;
        *(LAS float*)(wl + PW_BUF1 + idx * 4) = sg.y * gelu_tanh(a);
    }
}
__device__ __forceinline__ void peer_v_issue(const unsigned char* V8, LAS unsigned char* wl, unsigned lbase, int it, int lane, unsigned c16e, unsigned c16o) {
    const int sl = it >> 3, j = (it >> 1) & 3, hf = it & 1;
    const unsigned char* vbase = V8 + (size_t)sl * (NEXP * 128);
    const unsigned dst = lbase + PW_BUF0 + (it & 1) * 8192;
    unsigned go[8];
#pragma unroll
    for (int q = 0; q < 8; ++q) { const unsigned e = *(const LAS unsigned short*)(wl + PW_E + (j * 128 + 64 * hf + 8 * q + (lane >> 3)) * 2); go[q] = e * 128u + ((q & 1) ? c16o : c16e); }
#pragma unroll
    for (int q = 0; q < 8; ++q) attn_body::glds16s(vbase, go[q], (unsigned)__builtin_amdgcn_readfirstlane((int)(dst + q * 1024)));
}
__device__ __forceinline__ void peer_v_compute(LAS unsigned char* wl, f32x4 (&acc)[8], bf16* yrow0, int it, int lane) {
    const int sl = it >> 3, j = (it >> 1) & 3, hf = it & 1;
    const int m = lane & 15, kg = lane >> 4;
    const LAS unsigned char* wsrc = wl + ((m & 1) ? PW_WL : PW_WH) + j * 128 + 64 * hf + 16 * (kg & 1);
    const v4u a0 = *(const LAS v4u*)wsrc, a1 = *(const LAS v4u*)(wsrc + 32);
    const bool valid = (m < 4) && ((m >> 1) == (kg >> 1));
    v8i_t A;
    A[0] = valid ? (int)a0.x : 0; A[1] = valid ? (int)a0.y : 0; A[2] = valid ? (int)a0.z : 0; A[3] = valid ? (int)a0.w : 0;
    A[4] = valid ? (int)a1.x : 0; A[5] = valid ? (int)a1.y : 0; A[6] = valid ? (int)a1.z : 0; A[7] = valid ? (int)a1.w : 0;
    if (hf == 0) {
#pragma unroll
        for (int T = 0; T < 8; ++T) acc[T] = (f32x4){0.f, 0.f, 0.f, 0.f};
    }
    const LAS unsigned char* bb = wl + PW_BUF0 + (it & 1) * 8192 + (32 * (kg >> 1) + m) * 128 + 8 * (kg & 1);
    const unsigned x16 = (unsigned)(m >> 1) * 16u;
#pragma unroll
    for (int T = 0; T < 8; ++T) {
        const LAS unsigned char* p = bb + ((16u * T) ^ x16);
        const v2i_t b0 = __builtin_amdgcn_ds_read_tr4_b64_v2i32((LAS v2i_t*)p), b1 = __builtin_amdgcn_ds_read_tr4_b64_v2i32((LAS v2i_t*)(p + 2048));
        const v8i_t B = {b0.x, b0.y, b1.x, b1.y, 0, 0, 0, 0};
        acc[T] = __builtin_amdgcn_mfma_scale_f32_16x16x128_f8f6f4(A, B, acc[T], 0, 4, 0, 0x7f7f7f7f, 0, 0x7f7f7f7f);
    }
    if (hf == 1) {
        const float ik = *(const LAS float*)(wl + PW_IK + j * 4);
        LAS unsigned char* yp = lane < 16 ? wl + PW_YP + m * 2 : wl + PW_IK + 16;
        const int ystep = lane < 16 ? 1 : 0;
#pragma unroll
        for (int T = 0; T < 8; ++T) {
            *(LAS unsigned short*)(yp + ystep * (64 * T)) = (unsigned short)f2bf((acc[T][0] + acc[T][1]) * ik);
            *(LAS unsigned short*)(yp + ystep * (64 * T + 32)) = (unsigned short)f2bf((acc[T][2] + acc[T][3]) * ik);
        }
        asm volatile("" ::: "memory");
        const unsigned long long pk = *(const LAS unsigned long long*)(wl + PW_YP + 8 * lane);
        *(GAS unsigned long long*)(yrow0 + (size_t)j * D + 256 * sl + 4 * lane) = pk;
    }
}
__device__ __forceinline__ void p11_peer(Frame& F, float* dst) {
    const int gwv = blockIdx.x * NWAVES + F.wave, NGW = F.G * NWAVES, lane = F.lane;
    LAS unsigned char* wl = F.lds + F.wave * PW_BYTES;
    const unsigned lbase = (unsigned)__builtin_amdgcn_readfirstlane((int)(unsigned)(size_t)wl);
    const unsigned c16e = (unsigned)(((lane & 7) ^ (lane >> 4)) * 16), c16o = (unsigned)(((lane & 7) ^ (4 + (lane >> 4))) * 16);
    const unsigned char* U8 = F.U8; const unsigned char* V8 = F.V8;
    for (int t0 = gwv * 4; t0 < M; t0 += NGW * 4) {
        bf16* yrow0 = F.Y + (size_t)t0 * D;
#pragma unroll
        for (int j = 0; j < 4; ++j) {
            const int t = t0 + j;
            const v4u hq = *(const GAS v4u*)((const unsigned char*)F.H + (size_t)t * D + 16 * lane);
            const float hinv = F.rs2[t];
            const unsigned hw[4] = {hq.x, hq.y, hq.z, hq.w};
            unsigned hh0 = 0u, hh1 = 0u, hl0 = 0u, hl1 = 0u;
#pragma unroll
            for (int i = 0; i < 16; ++i) { const int hv_ = (int)(signed char)((hw[i >> 2] >> (8 * (i & 3))) & 0xffu); const int lo = ((hv_ + 8) & 15) - 8; const int hi = (hv_ - lo) >> 4;
                if (i < 8) { hh0 |= (unsigned)(hi & 15) << (4 * i); hl0 |= (unsigned)(lo & 15) << (4 * i); } else { hh1 |= (unsigned)(hi & 15) << (4 * (i - 8)); hl1 |= (unsigned)(lo & 15) << (4 * (i - 8)); } }
            *(LAS unsigned long long*)(wl + j * 1024 + 8 * lane) = (unsigned long long)hh0 | ((unsigned long long)hh1 << 32);
            *(LAS unsigned long long*)(wl + j * 1024 + 512 + 8 * lane) = (unsigned long long)hl0 | ((unsigned long long)hl1 << 32);
            const int e0 = F.eidx[(size_t)t * 128 + lane], e1 = F.eidx[(size_t)t * 128 + 64 + lane];
            const f32x2v sg0 = (f32x2v){F.su[e0] * hinv, F.gw[(size_t)t * 128 + lane] * F.sv[e0]}, sg1 = (f32x2v){F.su[e1] * hinv, F.gw[(size_t)t * 128 + 64 + lane] * F.sv[e1]};
            int base = 0;
#pragma unroll
            for (int sl = 0; sl < 4; ++sl) {
                const bool m0 = (e0 >> 12) == sl, m1 = (e1 >> 12) == sl;
                const unsigned long long b0 = __ballot(m0), b1 = __ballot(m1);
                const int c0 = __popcll(b0), c1 = __popcll(b1);
                const int p0 = j * 128 + base + __builtin_amdgcn_mbcnt_hi((unsigned)(b0 >> 32), __builtin_amdgcn_mbcnt_lo((unsigned)b0, 0));
                const int p1 = j * 128 + base + c0 + __builtin_amdgcn_mbcnt_hi((unsigned)(b1 >> 32), __builtin_amdgcn_mbcnt_lo((unsigned)b1, 0));
                if (m0) { *(LAS unsigned short*)(wl + PW_E + p0 * 2) = (unsigned short)e0; *(LAS f32x2v*)(wl + PW_SG + p0 * 8) = sg0; }
                if (m1) { *(LAS unsigned short*)(wl + PW_E + p1 * 2) = (unsigned short)e1; *(LAS f32x2v*)(wl + PW_SG + p1 * 8) = sg1; }
                base += c0 + c1;
            }
        }
        asm volatile("" ::: "memory");
        {
            v4u ua[8], ub[8];
            peer_u_issue(ua, U8, wl, 0, lane);
#pragma unroll 1
            for (int it = 0; it < 32; it += 2) {
                peer_u_issue(ub, U8, wl, it + 1, lane);
                __builtin_amdgcn_sched_barrier(0);
                peer_u_compute(ua, wl, it, lane);
                __builtin_amdgcn_sched_barrier(0);
                if (it + 2 < 32) peer_u_issue(ua, U8, wl, it + 2, lane);
                __builtin_amdgcn_sched_barrier(0);
                peer_u_compute(ub, wl, it + 1, lane);
                __builtin_amdgcn_sched_barrier(0);
            }
        }
#pragma unroll
        for (int j = 0; j < 4; ++j) {
            const float w0 = *(const LAS float*)(wl + PW_BUF1 + (j * 128 + lane) * 4), w1 = *(const LAS float*)(wl + PW_BUF1 + (j * 128 + 64 + lane) * 4);
            float mx = fmaxf(fabsf(w0), fabsf(w1));
#pragma unroll
            for (int o = 1; o < 64; o <<= 1) mx = fmaxf(mx, __shfl_xor(mx, o));
            int ex = (int)((__float_as_uint(mx) >> 23) & 0xffu); ex = ex < 30 ? 127 : ex;
            const float sc = __uint_as_float((unsigned)(127 + 7 + 127 - ex) << 23), isc = __uint_as_float((unsigned)(ex - 7) << 23);
            const float s0 = w0 * sc, s1 = w1 * sc;
            const int ph = __builtin_amdgcn_cvt_pk_fp8_f32(s0, s1, 0, false);
            const f32x2v hb = __builtin_amdgcn_cvt_pk_f32_fp8(ph, false);
            const int pl = __builtin_amdgcn_cvt_pk_fp8_f32(s0 - hb.x, s1 - hb.y, 0, false);
            *(LAS unsigned char*)(wl + PW_WH + j * 128 + lane) = (unsigned char)(ph & 0xff); *(LAS unsigned char*)(wl + PW_WH + j * 128 + 64 + lane) = (unsigned char)((ph >> 8) & 0xff);
            *(LAS unsigned char*)(wl + PW_WL + j * 128 + lane) = (unsigned char)(pl & 0xff); *(LAS unsigned char*)(wl + PW_WL + j * 128 + 64 + lane) = (unsigned char)((pl >> 8) & 0xff);
            if (lane == 0) *(LAS float*)(wl + PW_IK + j * 4) = isc;
        }
        v4u x1w[4][2];
#pragma unroll
        for (int j = 0; j < 4; ++j) { const GAS v4u* op = (const GAS v4u*)(F.QP + (size_t)(t0 + j) * D + 16 * lane); x1w[j][0] = op[0]; x1w[j][1] = op[1]; }
        asm volatile("s_waitcnt lgkmcnt(0)" ::: "memory");
        {
            f32x4 acc[8];
            peer_v_issue(V8, wl, lbase, 0, lane, c16e, c16o);
#pragma unroll 1
            for (int it = 0; it < 32; it += 2) {
                peer_v_issue(V8, wl, lbase, it + 1, lane, c16e, c16o);
                asm volatile("s_waitcnt vmcnt(8)" ::: "memory");
                peer_v_compute(wl, acc, yrow0, it, lane);
                asm volatile("s_waitcnt lgkmcnt(0)" ::: "memory");
                if (it + 2 < 32) { peer_v_issue(V8, wl, lbase, it + 2, lane, c16e, c16o); asm volatile("s_waitcnt vmcnt(8)" ::: "memory"); }
                else asm volatile("s_waitcnt vmcnt(0)" ::: "memory");
                peer_v_compute(wl, acc, yrow0, it + 1, lane);
                asm volatile("s_waitcnt lgkmcnt(0)" ::: "memory");
            }
        }
        asm volatile("s_waitcnt vmcnt(0)" ::: "memory");
#pragma unroll
        for (int j = 0; j < 4; ++j) {
            const int t = t0 + j, b = t >> 12;
            float yv[16];
            { const GAS v4u* yp = (const GAS v4u*)(yrow0 + (size_t)j * D + 16 * lane); const v4u y0 = yp[0], y1 = yp[1]; unpack8(y0, yv); unpack8(y1, yv + 8); }
            float ss = 0.f;
#pragma unroll
            for (int i = 0; i < 16; ++i) ss += yv[i] * yv[i];
            const float rstd = rsqrtf(wave_sum(ss) * (1.f / D) + EPS);
            GAS f32x4* dp = (GAS f32x4*)(dst + (size_t)t * D + 16 * lane);
            const GAS f32x4* gp = (const GAS f32x4*)(F.fpost_gain + 16 * lane);
            const GAS f32x4* g2p = (const GAS f32x4*)(F.mod + b * 6144 + 5120 + 16 * lane);
            float x1f[16]; unpack8(x1w[j][0], x1f); unpack8(x1w[j][1], x1f + 8);
#pragma unroll
            for (int i = 0; i < 4; ++i) { const f32x4 x1 = (f32x4){x1f[4 * i], x1f[4 * i + 1], x1f[4 * i + 2], x1f[4 * i + 3]}, g = gp[i], g2 = g2p[i];
                const f32x4 y = (f32x4){yv[4 * i], yv[4 * i + 1], yv[4 * i + 2], yv[4 * i + 3]};
                dp[i] = x1 + g2 * (y * rstd * g); }
        }
    }
}

__device__ __forceinline__ unsigned long long ldp(const Frame& F, int i) {
    volatile LAS unsigned* pt = (volatile LAS unsigned*)(F.lds + LDSCTL_OFF);
    const unsigned lo = pt[2 * i], hi = pt[2 * i + 1];
    return ((unsigned long long)(unsigned)__builtin_amdgcn_readfirstlane((int)hi) << 32) | (unsigned)__builtin_amdgcn_readfirstlane((int)lo);
}
__device__ __forceinline__ void load_frame(Frame& F) {
    F.lane = lane_id_fresh(); F.tid = F.wave * 64 + F.lane;
    F.x = (const float*)ldp(F, 0); F.c = (const float*)ldp(F, 1); F.ada_w = (const float*)ldp(F, 2); F.ada_b = (const float*)ldp(F, 3); F.pre_gain = (const float*)ldp(F, 4); F.post_gain = (const float*)ldp(F, 5);
    F.w_in = (const float*)ldp(F, 6); F.conv_w = (const float*)ldp(F, 7); F.group_gain = (const float*)ldp(F, 8); F.w_out = (const float*)ldp(F, 9); F.fpre_gain = (const float*)ldp(F, 10); F.fpost_gain = (const float*)ldp(F, 11);
    F.wq = (const float*)ldp(F, 12); F.keys = (const float*)ldp(F, 13); F.pu = (const float*)ldp(F, 14); F.pv = (const float*)ldp(F, 15);
    F.out = (float*)ldp(F, 16);
    unsigned char* ws = (unsigned char*)ldp(F, 17);
    F.ctl = (gu32*)(ws + WS_CTL);
    F.mod = (float*)(ws + WS_MOD); F.kmean = (float*)(ws + WS_KMEAN); F.keysb = (bf16*)(ws + WS_KEYS);
    F.WinT = (bf16*)(ws + WS_WIN); F.WoT = (bf16*)(ws + WS_WO); F.WqT = (bf16*)(ws + WS_WQ); F.eidx = (int*)(ws + WS_EIDX); F.gw = (float*)(ws + WS_G);
    F.U8 = ws + WS_U; F.V8 = ws + WS_V; F.su = (float*)(ws + WS_SU); F.sv = (float*)(ws + WS_SV); F.H = (bf16*)(ws + WS_H);
    F.P = (bf16*)(ws + WS_P); F.QP = (bf16*)(ws + WS_QP); F.O = (bf16*)(ws + WS_O); F.Y = (bf16*)(ws + WS_Y); F.scratch = (float*)(ws + WS_O); F.Win8 = ws + WS_WIN8; F.rs = (float*)(ws + WS_RS); F.Wq8 = ws + WS_WQ8; F.rs2 = (float*)(ws + WS_RS2); F.Wo8 = ws + WS_WO8;
}
struct Args { const float* in[16]; float* out; unsigned char* ws; int ph_lo, ph_hi; };
constexpr int NPHASE = 12;
template <unsigned PM> __global__ void __launch_bounds__(NWAVES * 64, 2) fwd_kernel(Args args) {
    extern __shared__ __attribute__((aligned(16))) unsigned char lds[];
    Frame F;
    F.lds = (LAS unsigned char*)lds;
    F.MISC = (volatile LAS unsigned*)(F.lds + MISC_OFF);
    F.tid = threadIdx.x; F.lane = F.tid & 63; F.wave = __builtin_amdgcn_readfirstlane(F.tid >> 6);
    F.G = gridDim.x;
    for (int u = F.tid; u < (LDS_BYTES - LDSCTL_OFF) / 4; u += NWAVES * 64) ((LAS unsigned*)(F.lds + LDSCTL_OFF))[u] = 0u;
    __syncthreads();
    if (F.tid == 0) { LAS unsigned long long* pt = (LAS unsigned long long*)(F.lds + LDSCTL_OFF);
#pragma unroll
        for (int i = 0; i < 16; ++i) pt[i] = (unsigned long long)args.in[i];
        pt[16] = (unsigned long long)args.out; pt[17] = (unsigned long long)args.ws; }
    __syncthreads();
    load_frame(F);
    const int lo = args.ph_lo, hi = args.ph_hi;
    const bool multi = (hi - lo) > 1;
    XcdBarrier bar; bar.bar = (unsigned*)(F.ctl + CW_BAR); bar.x = 0; bar.st = nullptr;
    if (multi) bar = xcd_barrier_post((unsigned*)(F.ctl + CW_BAR), F.MISC + 8);
#define IN(k) ((((PM) >> (k)) & 1u) && lo <= (k) && (k) < hi)
#define BOTH(k) (IN(k) && IN((k) + 1))
#ifndef SEAMREP
#define SEAMREP 1
#endif
#define SEAM(k) do { if (BOTH(k)) { for (int sr_ = 0; sr_ < SEAMREP; ++sr_) xcd_barrier(bar); } } while (0)
#ifndef REPMASK
#define REPMASK 0x000u
#endif
#define REPS(k) (1 + (int)(((REPMASK) >> (k)) & 1u))
    if (IN(0)) { load_frame(F); for (int r = 0; r < REPS(0); ++r) { p0_prep(F); __syncthreads(); } SEAM(0); }
    if (IN(1)) { load_frame(F); for (int r = 0; r < REPS(1); ++r) p1_hnorm(F); SEAM(1); }
    if (IN(2)) { load_frame(F);
        pg8::Gemm g{F.H, (const bf16*)F.Win8, M, NIN, D / 2}; pg8::StaticOrder So; So.init(M, NIN, F.G, (int)blockIdx.x);
        pg8::EpiBf16S<true> E{F.P, NIN, 6, 8, C2, F.kmean, 8, 10, F.rs, (const unsigned*)(F.ctl + CW_CMAX)};
        for (int r = 0; r < REPS(2); ++r) pg8::gemm_phase<pg8::EpiBf16S<true>, pg8::StaticOrder, true, true, false, true>(F.lds, g, So, E);
        if (IN(2) && IN(5)) { for (int sr_ = 0; sr_ < SEAMREP; ++sr_) xcd_barrier(bar); }
    }
    const bool stream_first = (((int)blockIdx.x >> 3) & 1) == 0;
    if (IN(5) && stream_first) { load_frame(F); p0_tables(F); }
    if (IN(6) && stream_first) { load_frame(F); p6_conv(F); }
    if (IN(5)) { load_frame(F);
        const attn_body::AttnTensors AT{(const attn_body::bf16*)(F.P + 1536), (const attn_body::bf16*)(F.P + 2048), (const attn_body::bf16*)(F.P + 2560), (attn_body::bf16*)((unsigned char*)F.Y + 512), F.kmean, F.group_gain + 512};
        const attn_body::StaticOrder So((int)F.G, (int)blockIdx.x);
        for (int r = 0; r < REPS(5); ++r) attn_body::attn_phase<attn_body::StaticOrder>((char*)lds, AT, So);
    }
    if (IN(6) && !stream_first) { load_frame(F); p6_conv(F); }
    if (IN(5) && !stream_first) { load_frame(F); p0_tables(F); }
    if (IN(6)) { SEAM(6); }
    if (IN(7)) { load_frame(F);
        pg8::Gemm g{F.Y, (const bf16*)F.Wo8, M, D, D / 2}; pg8::StaticOrder So; So.init(M, D, F.G, (int)blockIdx.x);
        pg8::EpiBf16S<true> E{F.O, D, 0, 0, 1.f, nullptr, 0, 0, nullptr, (const unsigned*)(F.ctl + CW_CMAX3)};
        for (int r = 0; r < REPS(7); ++r) pg8::gemm_phase<pg8::EpiBf16S<true>, pg8::StaticOrder, true, true, false, true>(F.lds, g, So, E);
        SEAM(7);
    }
    if (IN(8)) { load_frame(F); for (int r = 0; r < REPS(8); ++r) p8_resid(F); SEAM(8); }
    if (IN(9)) { load_frame(F);
        pg8::Gemm g{F.H, (const bf16*)F.Wq8, M, NQ, D / 2}; pg8::StaticOrder So; So.init(M, NQ, F.G, (int)blockIdx.x);
        EpiRoute E{F.keysb, F.eidx, F.gw, (const unsigned*)(F.ctl + CW_CMAX2), F.rs2};
        for (int r = 0; r < REPS(9); ++r)
            for (int i = 0; ; ++i) { OneUnit S1; if (!So.next(i, S1.u)) break; pg8::gemm_phase<EpiRoute, OneUnit, false, true, false, true>(F.lds, g, S1, E); }
        if (IN(9) && IN(11)) { for (int sr_ = 0; sr_ < SEAMREP; ++sr_) xcd_barrier(bar); }
    }
    if (IN(11)) { load_frame(F); if (REPS(11) > 1) p11_peer(F, F.scratch); p11_peer(F, F.out); }
#undef IN
#undef BOTH
#undef SEAM
}

#ifndef PMASK
#define PMASK 0xfffu
#endif
#ifndef N_LAUNCH_MODE
#define N_LAUNCH_MODE 1
#endif
template <unsigned PM> static bool set_lds() { return hipFuncSetAttribute((const void*)fwd_kernel<PM>, hipFuncAttributeMaxDynamicSharedMemorySize, LDS_BYTES) == hipSuccess; }
template <unsigned PM> static void launch1(int grid, hipStream_t stream, Args a) { hipLaunchKernelGGL(fwd_kernel<PM>, dim3(grid), dim3(NWAVES * 64), LDS_BYTES, stream, a); }
extern "C" void kernel_launch(void* const* d_in, const int* in_sizes, int n_in, void* d_out, int out_size, void* d_ws, size_t ws_size, hipStream_t stream) {
    static int grid = 0;
    if (grid == 0) {
        if (n_in != 16 || out_size != M * D || ws_size < WS_END) { fprintf(stderr, "kernel_launch: unexpected shapes n_in %d out %d ws %zu\n", n_in, out_size, ws_size); grid = -1; return; }
        int dev = 0, cus = 0;
        if (hipGetDevice(&dev) != hipSuccess || hipDeviceGetAttribute(&cus, hipDeviceAttributeMultiprocessorCount, dev) != hipSuccess) { grid = -1; return; }
        bool ok = true;
#if N_LAUNCH_MODE == 1
        ok = set_lds<PMASK>();
#elif N_LAUNCH_MODE == 3
        ok = set_lds<0x3ffu>() && set_lds<0x400u>() && set_lds<0x800u>();
#else
        ok = set_lds<1u>() && set_lds<2u>() && set_lds<4u>() && set_lds<8u>() && set_lds<16u>() && set_lds<32u>() && set_lds<64u>() && set_lds<128u>() && set_lds<256u>() && set_lds<512u>() && set_lds<1024u>() && set_lds<2048u>();
#endif
        if (!ok) { fprintf(stderr, "kernel_launch: hipFuncSetAttribute failed\n"); grid = -1; return; }
        grid = cus;
    }
    if (grid < 0) return;
    (void)hipMemsetAsync((char*)d_ws + WS_CTL, 0, CTL_ZERO_BYTES, stream);
    Args a{};
    for (int i = 0; i < 16; ++i) a.in[i] = (const float*)d_in[i];
    a.out = (float*)d_out; a.ws = (unsigned char*)d_ws;
#if N_LAUNCH_MODE == 1
    a.ph_lo = 0; a.ph_hi = NPHASE; launch1<PMASK>(grid, stream, a);
#elif N_LAUNCH_MODE == 3
    a.ph_lo = 0; a.ph_hi = 10; launch1<0x3ffu>(grid, stream, a);
    a.ph_lo = 10; a.ph_hi = 11; launch1<0x400u>(grid, stream, a);
    a.ph_lo = 11; a.ph_hi = 12; launch1<0x800u>(grid, stream, a);
#else
#define L1(p) do { a.ph_lo = (p); a.ph_hi = (p) + 1; launch1<(1u << (p))>(grid, stream, a); } while (0)
    L1(0); L1(1); L1(2); L1(3); L1(4); L1(5); L1(6); L1(7); L1(8); L1(9); L1(10); L1(11);
#undef L1
#endif
}
```

```cpp
#include <hip/hip_runtime.h>
#include <cstdio>
#include <cstdint>
#ifndef WT_STORES
#define WT_STORES 1
#endif
typedef unsigned wt_v4u __attribute__((ext_vector_type(4)));
__device__ __forceinline__ int lane_id_fresh() { int l; asm volatile("v_mbcnt_lo_u32_b32 %0, -1, 0\n\tv_mbcnt_hi_u32_b32 %0, -1, %0" : "=v"(l)); return l; }
__device__ __forceinline__ void st16_wt(void* p, wt_v4u v) {
#if WT_STORES
    asm volatile("global_store_dwordx4 %0, %1, off sc1\n\ts_nop 1" :: "v"(p), "v"(v) : "memory");
#else
    *(wt_v4u*)p = v;
#endif
}
__device__ __forceinline__ void st4_wt(void* p, unsigned v) {
#if WT_STORES
    asm volatile("global_store_dword %0, %1, off sc1\n\ts_nop 1" :: "v"(p), "v"(v) : "memory");
#else
    *(unsigned*)p = v;
#endif
}
__device__ __forceinline__ void st8_wt(void* p, unsigned long long v) {
#if WT_STORES
    asm volatile("global_store_dwordx2 %0, %1, off sc1\n\ts_nop 1" :: "v"(p), "v"(v) : "memory");
#else
    *(unsigned long long*)p = v;
#endif
}
namespace pg8 {
#define PG8_LAS __attribute__((address_space(3)))
typedef unsigned short bf16_t;
typedef short bf16x8 __attribute__((ext_vector_type(8)));
typedef float f32x4 __attribute__((ext_vector_type(4)));
typedef unsigned u32x4 __attribute__((ext_vector_type(4)));
typedef int i32x4 __attribute__((ext_vector_type(4)));
typedef int i32x8 __attribute__((ext_vector_type(8)));
constexpr int BM = 256, BK = 64, HALF = 128, HTB = HALF * BK * 2  , STAGE_BYTES = 8 * HTB, NXCD = 8, WGM = 8;

__host__ __device__ __forceinline__ int lds_byte(int r, int c) { const int st = (r >> 4) * 2 + (c >> 5), rr = r & 15, cc = c & 31, ob = rr * 64 + cc * 2; return st * 1024 + (ob ^ (((ob >> 9) & 1) << 5)); }
__host__ __device__ __forceinline__ void stage_rc(int b, int& R, int& C) { const int st = b / 1024, sb = b % 1024, swz = sb ^ (((sb >> 9) & 1) << 5); R = (st >> 1) * 16 + swz / 64; C = (st & 1) * 32 + (swz % 64) / 2; }
__host__ __device__ __forceinline__ int perm32(int rho) { const int n = rho >> 4, i = rho & 15; return 8 * (i >> 2) + 4 * n + (i & 3); }

struct Unit { int pm, pn; };
struct Gemm { const bf16_t* A; const bf16_t* Bt; int M, N, K; };

struct StaticOrder {
    int nM, nN, nwg, G, c;
    __host__ __device__ void init(int M, int N, int G_, int c_) { nM = M / BM; nN = N / BM; nwg = nM * nN; G = G_; c = c_; }
    __host__ __device__ bool next(int i, Unit& u) const {
        const long L = (long)i * G + c; if (L >= nwg) return false;
        int wgid = (int)L; { const int q = nwg / NXCD, r = nwg % NXCD, xcd = wgid % NXCD, off = wgid / NXCD; wgid = (xcd < r ? xcd * (q + 1) : r * (q + 1) + (xcd - r) * q) + off; }
        const int nig = WGM * nN, gid = wgid / nig, fm = gid * WGM, gsz = (nM - fm) < WGM ? (nM - fm) : WGM;
        u.pm = fm + ((wgid % nig) % gsz); u.pn = (wgid % nig) / gsz; return true;
    }
    __device__ __forceinline__ void a_ready(const Unit&) const {}
    __device__ __forceinline__ void done(const Unit&) const {}
};


__device__ __forceinline__ unsigned cvt_pk_bf16(float lo, float hi) { unsigned r; asm volatile("v_cvt_pk_bf16_f32 %0, %1, %2" : "=v"(r) : "v"(lo), "v"(hi)); return r; }
template <bool ACC_I32> struct EpiBf16S {
    static constexpr bool PERM = true, AFTER_DRAIN = false;
    bf16_t* O; int ldc; int sc_lo, sc_hi; float scv; float* ksum; int ks_lo, ks_hi; const float* rs; const unsigned* cmax;
    __device__ __forceinline__ void operator()(const f32x4 (&acc)[2][2][4][2], const Unit& u, int wr, int wc, int fr_, int fq_) const {
        (void)fr_; (void)fq_;
        const int lane_ = lane_id_fresh(); const int fr = lane_ & 15, fq = lane_ >> 4;
        const int row0 = u.pm * BM + wr * 64 + fr; const int colt = u.pn * BM;
        const float sc = ((u.pn >= sc_lo && u.pn < sc_hi) ? scv : 1.f) * (ACC_I32 ? (1.f / 127.f) : (1.f / 224.f));
        const int col0 = colt + wc * 32 + 8 * fq;
        float rsv[2][4];
#pragma unroll
        for (int ai = 0; ai < 2; ++ai)
#pragma unroll
            for (int m = 0; m < 4; ++m) rsv[ai][m] = rs != nullptr ? rs[row0 + ai * HALF + m * 16] : 1.f;
        const bool do_ks = ksum != nullptr && u.pn >= ks_lo && u.pn < ks_hi;
#pragma unroll
        for (int bj = 0; bj < 2; ++bj) {
            const u32x4 cb0 = *(const u32x4*)(cmax + col0 + bj * HALF), cb1 = *(const u32x4*)(cmax + col0 + bj * HALF + 4);
            const f32x4 cs0 = (f32x4){__uint_as_float(cb0.x), __uint_as_float(cb0.y), __uint_as_float(cb0.z), __uint_as_float(cb0.w)} * sc;
            const f32x4 cs1 = (f32x4){__uint_as_float(cb1.x), __uint_as_float(cb1.y), __uint_as_float(cb1.z), __uint_as_float(cb1.w)} * sc;
            f32x4 sum0 = {0.f, 0.f, 0.f, 0.f}, sum1 = sum0;
#pragma unroll
            for (int ai = 0; ai < 2; ++ai)
#pragma unroll
                for (int m = 0; m < 4; ++m) { f32x4 a0 = acc[ai][bj][m][0], a1 = acc[ai][bj][m][1];
                    if constexpr (ACC_I32) { const i32x4 i0 = __builtin_bit_cast(i32x4, a0), i1 = __builtin_bit_cast(i32x4, a1);
                        a0 = (f32x4){(float)i0[0], (float)i0[1], (float)i0[2], (float)i0[3]}; a1 = (f32x4){(float)i1[0], (float)i1[1], (float)i1[2], (float)i1[3]}; }
                    const f32x4 v0 = a0 * rsv[ai][m] * cs0, v1 = a1 * rsv[ai][m] * cs1;
                    sum0 += v0; sum1 += v1;
                    u32x4 w; w.x = cvt_pk_bf16(v0[0], v0[1]); w.y = cvt_pk_bf16(v0[2], v0[3]); w.z = cvt_pk_bf16(v1[0], v1[1]); w.w = cvt_pk_bf16(v1[2], v1[3]);
                    st16_wt(O + (size_t)(row0 + ai * HALF + m * 16) * ldc + col0 + bj * HALF, w); }
            if (do_ks) {
                float* kd = ksum + (size_t)u.pm * ((ks_hi - ks_lo) * BM) + (u.pn - ks_lo) * BM + wc * 32 + 8 * fq + bj * HALF;
#pragma unroll
                for (int n = 0; n < 2; ++n)
#pragma unroll
                    for (int i = 0; i < 4; ++i) {
                        float v = n ? sum1[i] : sum0[i];
                        v += __uint_as_float((unsigned)__builtin_amdgcn_mov_dpp((int)__float_as_uint(v), 0xB1, 0xf, 0xf, true));
                        v += __uint_as_float((unsigned)__builtin_amdgcn_mov_dpp((int)__float_as_uint(v), 0x4E, 0xf, 0xf, true));
                        v += __uint_as_float((unsigned)__builtin_amdgcn_mov_dpp((int)__float_as_uint(v), 0x141, 0xf, 0xf, true));
                        v += __uint_as_float((unsigned)__builtin_amdgcn_mov_dpp((int)__float_as_uint(v), 0x140, 0xf, 0xf, true));
                        if (fr == 0) atomicAdd(kd + 4 * n + i, v);
                    }
            }
        }
    }
};
struct EpiBf16 {
    static constexpr bool PERM = true, AFTER_DRAIN = false;
    bf16_t* O; int ldc; int sc_lo, sc_hi; float scv; float* ksum; int ks_lo, ks_hi;
    __device__ __forceinline__ void operator()(const f32x4 (&acc)[2][2][4][2], const Unit& u, int wr, int wc, int fr, int fq) const {
        const int row0 = u.pm * BM + wr * 64 + fr; const int colt = u.pn * BM;
        const float sc = (u.pn >= sc_lo && u.pn < sc_hi) ? scv : 1.f;
        const int col0 = colt + wc * 32 + 8 * fq;
#pragma unroll
        for (int ai = 0; ai < 2; ++ai)
#pragma unroll
            for (int m = 0; m < 4; ++m) { bf16_t* rowp = O + (size_t)(row0 + ai * HALF + m * 16) * ldc + col0;
#pragma unroll
                for (int bj = 0; bj < 2; ++bj) { f32x4 v0 = acc[ai][bj][m][0] * sc, v1 = acc[ai][bj][m][1] * sc;
                    u32x4 w; w.x = cvt_pk_bf16(v0[0], v0[1]); w.y = cvt_pk_bf16(v0[2], v0[3]); w.z = cvt_pk_bf16(v1[0], v1[1]); w.w = cvt_pk_bf16(v1[2], v1[3]);
                    st16_wt(rowp + bj * HALF, w); } }
        if (ksum != nullptr && u.pn >= ks_lo && u.pn < ks_hi) {
            float* kd = ksum + (size_t)u.pm * ((ks_hi - ks_lo) * BM) + (u.pn - ks_lo) * BM + wc * 32 + 8 * fq;
#pragma unroll
            for (int bj = 0; bj < 2; ++bj)
#pragma unroll
                for (int n = 0; n < 2; ++n) {
                    f32x4 cs = acc[0][bj][0][n];
#pragma unroll
                    for (int m = 1; m < 4; ++m) cs += acc[0][bj][m][n];
#pragma unroll
                    for (int m = 0; m < 4; ++m) cs += acc[1][bj][m][n];
#pragma unroll
                    for (int i = 0; i < 4; ++i) {
                        float v = cs[i];
                        v += __uint_as_float((unsigned)__builtin_amdgcn_mov_dpp((int)__float_as_uint(v), 0xB1, 0xf, 0xf, true));
                        v += __uint_as_float((unsigned)__builtin_amdgcn_mov_dpp((int)__float_as_uint(v), 0x4E, 0xf, 0xf, true));
                        v += __uint_as_float((unsigned)__builtin_amdgcn_mov_dpp((int)__float_as_uint(v), 0x141, 0xf, 0xf, true));
                        v += __uint_as_float((unsigned)__builtin_amdgcn_mov_dpp((int)__float_as_uint(v), 0x140, 0xf, 0xf, true));
                        if (fr == 0) atomicAdd(kd + bj * HALF + 4 * n + i, v);
                    }
                }
        }
    }
};

template <int OFF> __device__ __forceinline__ void dma16s(const void* sbase, unsigned voff, unsigned lds_base) { unsigned keep;
    asm volatile("s_mov_b32 %0, m0\n\ts_add_u32 m0, %3, %4\n\ts_nop 0\n\tglobal_load_lds_dwordx4 %1, %2\n\ts_mov_b32 m0, %0" : "=&s"(keep) : "v"(voff), "s"(sbase), "s"(lds_base), "i"(OFF) : "memory", "scc"); }
__device__ __forceinline__ const char* uni_ptr(const char* p) {
    const unsigned long long v = (unsigned long long)p;
    return (const char*)(((unsigned long long)(unsigned)__builtin_amdgcn_readfirstlane((int)(unsigned)(v >> 32)) << 32) | (unsigned)__builtin_amdgcn_readfirstlane((int)(unsigned)v));
}
template <class Epi, class Sched, bool ALIGN_EPI = false, bool SP2 = false, bool FP8 = false, bool I8 = false>
__device__ __forceinline__ void gemm_phase(PG8_LAS unsigned char* lds, const Gemm g, const Sched& S, const Epi& E) {
    int tid_ = threadIdx.x; asm volatile("" : "+v"(tid_));
    const int tid = tid_, wid = __builtin_amdgcn_readfirstlane(tid >> 6), lane = tid & 63, wr = wid >> 2, wc = wid & 3, fr = lane & 15, fq = lane >> 4;
    const int K = g.K, nt = K / BK;
    unsigned voffA[2], voffB[2];
#pragma unroll
    for (int i = 0; i < 2; ++i) { int R, C; stage_rc(tid * 16 + i * 8192, R, C); const int Rb = Epi::PERM ? ((R & ~31) + perm32(R & 31)) : R;
        voffA[i] = (unsigned)(R * K + C) * 2u; voffB[i] = (unsigned)(Rb * K + C) * 2u; }
    const size_t qstep = (size_t)64 * K * 2;
    const size_t kstep = (size_t)(BK * 2);
    const size_t hstep = (size_t)HALF * K * 2;
    const size_t tstep = 2 * hstep;
    const unsigned ldsn = (unsigned)(size_t)lds;
    const unsigned ldsw = (unsigned)wid * 1024u;
    const unsigned ldsb = (unsigned)__builtin_amdgcn_readfirstlane((int)(ldsn + ldsw));
    const int aoff = lds_byte(wr * 64 + fr, fq * 8), boff = lds_byte(wc * 32 + fr, fq * 8);
    unsigned ldsAn = ldsn + (unsigned)aoff, ldsBn = ldsn + (unsigned)(4 * HTB) + (unsigned)boff; asm volatile("" : "+v"(ldsAn), "+v"(ldsBn));
    PG8_LAS unsigned char* const ldsA = (PG8_LAS unsigned char*)(size_t)ldsAn; PG8_LAS unsigned char* const ldsB = (PG8_LAS unsigned char*)(size_t)ldsBn;
#define PG8_SA(b, h) (((b) * 2 + (h)) * HTB)
#define PG8_SB(b, h) ((4 + (b) * 2 + (h)) * HTB)
#define PG8_STAGE(bufoff, gbase, voff) do { if constexpr (FP8 || I8) { const char* gb_ = uni_ptr((const char*)(gbase)); dma16s<(bufoff)>(gb_, (voff)[0], ldsb); dma16s<(bufoff) + 8192>(uni_ptr(gb_ + qstep), (voff)[0], ldsb); }        \
    else { _Pragma("unroll") for (int _i = 0; _i < 2; ++_i) \
        __builtin_amdgcn_global_load_lds((const unsigned*)((const char*)(gbase) + (voff)[_i]), (PG8_LAS unsigned*)(lds + (bufoff) + ldsw + _i * 8192), 16, 0, 0); } } while (0)
#define PG8_LDA(dst, b, h) do { _Pragma("unroll") for (int m = 0; m < 4; ++m) _Pragma("unroll") for (int k = 0; k < 2; ++k) dst[m][k] = *(const PG8_LAS bf16x8*)(lds + PG8_SA(b, h) + aoff + m * 2048 + k * 1024); } while (0)
#define PG8_LDB(dst, b, h) do { _Pragma("unroll") for (int n = 0; n < 2; ++n) _Pragma("unroll") for (int k = 0; k < 2; ++k) dst[n][k] = *(const PG8_LAS bf16x8*)(lds + PG8_SB(b, h) + boff + n * 2048 + k * 1024); } while (0)
#define PG8_LDA8(dst, b, h) do { _Pragma("unroll") for (int m = 0; m < 4; ++m) dst[m] = __builtin_shufflevector(*(const PG8_LAS i32x4*)(ldsA + PG8_SA(b, h) + m * 2048), *(const PG8_LAS i32x4*)(ldsA + PG8_SA(b, h) + m * 2048 + 1024), 0, 1, 2, 3, 4, 5, 6, 7); } while (0)
#define PG8_LDB8(dst, b, h) do { _Pragma("unroll") for (int n = 0; n < 2; ++n) dst[n] = __builtin_shufflevector(*(const PG8_LAS i32x4*)(ldsB + (PG8_SB(b, h) - 4 * HTB) + n * 2048), *(const PG8_LAS i32x4*)(ldsB + (PG8_SB(b, h) - 4 * HTB) + n * 2048 + 1024), 0, 1, 2, 3, 4, 5, 6, 7); } while (0)
#define PG8_MMA8(ai, bj, A8, B8) do { __builtin_amdgcn_s_setprio(1); _Pragma("unroll") for (int m = 0; m < 4; ++m) _Pragma("unroll") for (int n = 0; n < 2; ++n) \
        acc[ai][bj][m][n] = __builtin_amdgcn_mfma_scale_f32_16x16x128_f8f6f4(B8[n], A8[m], acc[ai][bj][m][n], 0, 0, 0, 0, 0, 0); __builtin_amdgcn_s_setprio(0); } while (0)
#define PG8_MMA(ai, bj, At, Bt) do { __builtin_amdgcn_s_setprio(1); _Pragma("unroll") for (int m = 0; m < 4; ++m) _Pragma("unroll") for (int n = 0; n < 2; ++n) _Pragma("unroll") for (int k = 0; k < 2; ++k) { \
        if constexpr (I8) acc[ai][bj][m][n] = __builtin_bit_cast(f32x4, __builtin_amdgcn_mfma_i32_16x16x64_i8(__builtin_bit_cast(i32x4, Bt[n][k]), __builtin_bit_cast(i32x4, At[m][k]), __builtin_bit_cast(i32x4, acc[ai][bj][m][n]), 0, 0, 0)); \
        else acc[ai][bj][m][n] = __builtin_amdgcn_mfma_f32_16x16x32_bf16(Bt[n][k], At[m][k], acc[ai][bj][m][n], 0, 0, 0); } __builtin_amdgcn_s_setprio(0); } while (0)
#define PG8_WAIT_V(n) asm volatile("s_waitcnt vmcnt(" #n ")" ::: "memory")
#define PG8_WAIT_L(n) asm volatile("s_waitcnt lgkmcnt(" #n ")" ::: "memory")
#define PG8_BAR __builtin_amdgcn_s_barrier()
#define PG8_SCHED __builtin_amdgcn_sched_barrier(0)
    Unit cur, nxt; int ui = 0;
    if (!S.next(0, cur)) return;
    f32x4 acc[2][2][4][2];
#pragma unroll
    for (int a = 0; a < 2; ++a)
#pragma unroll
        for (int b = 0; b < 2; ++b)
#pragma unroll
            for (int m = 0; m < 4; ++m)
#pragma unroll
                for (int n = 0; n < 2; ++n) acc[a][b][m][n] = (f32x4){0.f, 0.f, 0.f, 0.f};
    bf16x8 At[4][2], B0[2][2], B1[2][2];
    i32x8 A8[4], B08[2], B18[2];
    const char* cA = (const char*)g.A + (size_t)cur.pm * tstep; const char* cB = (const char*)g.Bt + (size_t)cur.pn * tstep;
    if constexpr (FP8 || I8) { cA = uni_ptr(cA); cB = uni_ptr(cB); }
    S.a_ready(cur);
    if constexpr (SP2) {
        PG8_STAGE(PG8_SB(0, 0), cB, voffB); PG8_STAGE(PG8_SB(0, 1), cB + hstep, voffB); PG8_STAGE(PG8_SA(0, 0), cA, voffA); PG8_STAGE(PG8_SA(0, 1), cA + hstep, voffA);
        if (wr == 1) PG8_BAR;
        PG8_WAIT_V(2); PG8_BAR;
        PG8_STAGE(PG8_SB(1, 0), cB + kstep, voffB); PG8_STAGE(PG8_SA(1, 0), cA + kstep, voffA); PG8_STAGE(PG8_SB(1, 1), cB + hstep + kstep, voffB);
        PG8_WAIT_V(6); PG8_BAR;
    } else {
        PG8_STAGE(PG8_SB(0, 0), cB, voffB); PG8_STAGE(PG8_SA(0, 0), cA, voffA); PG8_STAGE(PG8_SB(0, 1), cB + hstep, voffB); PG8_STAGE(PG8_SA(0, 1), cA + hstep, voffA);
        if (wr == 1) PG8_BAR;
        PG8_WAIT_V(4); PG8_BAR;
        PG8_STAGE(PG8_SB(1, 0), cB + kstep, voffB); PG8_STAGE(PG8_SA(1, 0), cA + kstep, voffA); PG8_STAGE(PG8_SB(1, 1), cB + hstep + kstep, voffB);
        PG8_WAIT_V(6); PG8_BAR;
    }
    for (;;) {
        const bool has_next = S.next(ui + 1, nxt);
        const char* nA = has_next ? (const char*)g.A + (size_t)nxt.pm * tstep : cA; const char* nB = has_next ? (const char*)g.Bt + (size_t)nxt.pn * tstep : cB;
        if constexpr (FP8 || I8) { nA = uni_ptr(nA); nB = uni_ptr(nB); }
        for (int t = 0; t < nt; t += 2) {
            const bool last = (t == nt - 2);
            if constexpr (FP8 || I8) asm volatile("" : "+v"(voffA[0]), "+v"(voffB[0]));
            const char* a1 = cA + (size_t)(t + 1) * kstep;
            const char* a2 = last ? nA : cA + (size_t)(t + 2) * kstep; const char* b2 = last ? nB : cB + (size_t)(t + 2) * kstep;
            const char* a3 = a2 + kstep; const char* b3 = b2 + kstep;
            if (last && has_next) S.a_ready(nxt);
            if constexpr (SP2 && FP8) {
            PG8_LDB8(B08, 0, 0); PG8_LDB8(B18, 0, 1); PG8_SCHED; PG8_LDA8(A8, 0, 0); PG8_STAGE(PG8_SA(1, 1), a1 + hstep, voffA);
            PG8_WAIT_V(8); PG8_WAIT_L(0); PG8_BAR; PG8_MMA8(0, 0, A8, B08); PG8_MMA8(0, 1, A8, B18); PG8_BAR; PG8_SCHED;
            PG8_LDA8(A8, 0, 1); PG8_STAGE(PG8_SB(0, 0), b2, voffB); PG8_STAGE(PG8_SB(0, 1), b2 + hstep, voffB); PG8_STAGE(PG8_SA(0, 0), a2, voffA);
            PG8_WAIT_V(8); PG8_WAIT_L(0); PG8_BAR; PG8_MMA8(1, 0, A8, B08); PG8_MMA8(1, 1, A8, B18); PG8_BAR; PG8_SCHED;
            PG8_LDB8(B08, 1, 0); PG8_LDB8(B18, 1, 1); PG8_SCHED; PG8_LDA8(A8, 1, 0); PG8_STAGE(PG8_SA(0, 1), a2 + hstep, voffA);
            PG8_WAIT_V(8); PG8_WAIT_L(0); PG8_BAR; PG8_MMA8(0, 0, A8, B08); PG8_MMA8(0, 1, A8, B18); PG8_BAR; PG8_SCHED;
            PG8_LDA8(A8, 1, 1); PG8_STAGE(PG8_SB(1, 0), b3, voffB); PG8_STAGE(PG8_SB(1, 1), b3 + hstep, voffB); PG8_STAGE(PG8_SA(1, 0), a3, voffA);
            PG8_WAIT_V(8); PG8_WAIT_L(0); PG8_BAR; PG8_MMA8(1, 0, A8, B08); PG8_MMA8(1, 1, A8, B18); PG8_BAR; PG8_SCHED;
            } else if constexpr (SP2) {
            PG8_LDB(B0, 0, 0); PG8_LDB(B1, 0, 1); PG8_SCHED; PG8_LDA(At, 0, 0); PG8_STAGE(PG8_SA(1, 1), a1 + hstep, voffA);
            PG8_WAIT_V(8); PG8_WAIT_L(0); PG8_BAR; PG8_MMA(0, 0, At, B0); PG8_MMA(0, 1, At, B1); PG8_BAR; PG8_SCHED;
            PG8_LDA(At, 0, 1); PG8_STAGE(PG8_SB(0, 0), b2, voffB); PG8_STAGE(PG8_SB(0, 1), b2 + hstep, voffB); PG8_STAGE(PG8_SA(0, 0), a2, voffA);
            PG8_WAIT_V(8); PG8_WAIT_L(0); PG8_BAR; PG8_MMA(1, 0, At, B0); PG8_MMA(1, 1, At, B1); PG8_BAR; PG8_SCHED;
            PG8_LDB(B0, 1, 0); PG8_LDB(B1, 1, 1); PG8_SCHED; PG8_LDA(At, 1, 0); PG8_STAGE(PG8_SA(0, 1), a2 + hstep, voffA);
            PG8_WAIT_V(8); PG8_WAIT_L(0); PG8_BAR; PG8_MMA(0, 0, At, B0); PG8_MMA(0, 1, At, B1); PG8_BAR; PG8_SCHED;
            PG8_LDA(At, 1, 1); PG8_STAGE(PG8_SB(1, 0), b3, voffB); PG8_STAGE(PG8_SB(1, 1), b3 + hstep, voffB); PG8_STAGE(PG8_SA(1, 0), a3, voffA);
            PG8_WAIT_V(8); PG8_WAIT_L(0); PG8_BAR; PG8_MMA(1, 0, At, B0); PG8_MMA(1, 1, At, B1); PG8_BAR; PG8_SCHED;
            } else {
            PG8_LDB(B0, 0, 0); PG8_SCHED; PG8_LDA(At, 0, 0); PG8_STAGE(PG8_SA(1, 1), a1 + hstep, voffA);
            PG8_WAIT_L(8); PG8_BAR; PG8_WAIT_L(0); PG8_MMA(0, 0, At, B0); PG8_BAR; PG8_SCHED;
            PG8_LDB(B1, 0, 1); PG8_STAGE(PG8_SB(0, 0), b2, voffB);
            PG8_BAR; PG8_WAIT_L(0); PG8_MMA(0, 1, At, B1); PG8_BAR;
            PG8_LDA(At, 0, 1); PG8_STAGE(PG8_SA(0, 0), a2, voffA);
            PG8_BAR; PG8_WAIT_L(0); PG8_MMA(1, 0, At, B0); PG8_BAR; PG8_SCHED;
            PG8_STAGE(PG8_SB(0, 1), b2 + hstep, voffB);
            PG8_WAIT_V(6); PG8_BAR; PG8_MMA(1, 1, At, B1); PG8_BAR;
            PG8_LDB(B0, 1, 0); PG8_SCHED; PG8_LDA(At, 1, 0); PG8_STAGE(PG8_SA(0, 1), a2 + hstep, voffA);
            PG8_WAIT_L(8); PG8_BAR; PG8_WAIT_L(0); PG8_MMA(0, 0, At, B0); PG8_BAR; PG8_SCHED;
            PG8_LDB(B1, 1, 1); PG8_STAGE(PG8_SB(1, 0), b3, voffB);
            PG8_BAR; PG8_WAIT_L(0); PG8_MMA(0, 1, At, B1); PG8_BAR;
            PG8_LDA(At, 1, 1); PG8_STAGE(PG8_SA(1, 0), a3, voffA);
            PG8_BAR; PG8_WAIT_L(0); PG8_MMA(1, 0, At, B0); PG8_BAR; PG8_SCHED;
            PG8_STAGE(PG8_SB(1, 1), b3 + hstep, voffB);
            PG8_WAIT_V(6); PG8_BAR; PG8_MMA(1, 1, At, B1); PG8_BAR;
            }
        }
        if constexpr (ALIGN_EPI) { if (wr == 0) PG8_BAR; }
        if constexpr (!Epi::AFTER_DRAIN) { E(acc, cur, wr, wc, fr, fq); S.done(cur); }
        if (!has_next) break;
#pragma unroll
        for (int a = 0; a < 2; ++a)
#pragma unroll
            for (int b = 0; b < 2; ++b)
#pragma unroll
                for (int m = 0; m < 4; ++m)
#pragma unroll
                    for (int n = 0; n < 2; ++n) acc[a][b][m][n] = (f32x4){0.f, 0.f, 0.f, 0.f};
        cur = nxt; cA = nA; cB = nB; ++ui;
        if constexpr (ALIGN_EPI) { if (wr == 1) PG8_BAR; }
    }
    PG8_WAIT_V(0);
    if constexpr (!ALIGN_EPI) { if (wr == 0) PG8_BAR; }
    PG8_BAR;
    if constexpr (Epi::AFTER_DRAIN) { E.fused(acc, cur, wr, wc, fr, fq, lds, wid, lane); S.done(cur); }
#undef PG8_SA
#undef PG8_SB
#undef PG8_STAGE
#undef PG8_LDA
#undef PG8_LDB
#undef PG8_LDA8
#undef PG8_LDB8
#undef PG8_MMA8
#undef PG8_MMA
#undef PG8_WAIT_V
#undef PG8_WAIT_L
#undef PG8_BAR
#undef PG8_SCHED
}
}
#include <hip/hip_bf16.h>
#include <cmath>
namespace attn_body {
using bf16=__hip_bfloat16;
using bf16x8=__attribute__((ext_vector_type(8)))short;
using s16x4=__attribute__((ext_vector_type(4)))short;
using f32x16=__attribute__((ext_vector_type(16)))float;
using u32x4=__attribute__((ext_vector_type(4)))unsigned;
constexpr int BATCH=4,NHEAD=8,SEQ=4096,D=64,DM=3072,OPITCH=1024;
constexpr int NW=8,QBLK=32,QB=QBLK*NW,KVBLK=64,NQB=SEQ/QB;
constexpr int ATTN_UNIT_ROWS=QB;
__device__ __forceinline__ int crow(int r,int hi){return (r&3)+8*(r>>2)+4*hi;}
#define SBAR() __builtin_amdgcn_sched_barrier(0)
__device__ __forceinline__ void cmask(f32x16&p0,f32x16&p1,int jb,int qrel,int hi){
  const float NEG=-INFINITY; int kb=64*jb+4*hi;
  #pragma unroll
  for(int r=0;r<16;++r){int kv=kb+(r&3)+8*(r>>2); if(kv>qrel)p0[r]=NEG; if(kv+32>qrel)p1[r]=NEG;}
}

constexpr int NSLOT=3, SLOTB=8192;
constexpr int LDS_K=0, LDS_V=NSLOT*SLOTB, LDS_WS=2*NSLOT*SLOTB, LDS_OST=LDS_WS+NW*64*4, LDS_BYTES=LDS_OST+NW*4096;
constexpr float C2=0.125f*1.4426950408889634f;
__device__ __forceinline__ void glds16(const void*gsrc,unsigned lds_dst){unsigned keep;
  asm volatile("s_mov_b32 %0, m0\n\ts_mov_b32 m0, %2\n\ts_nop 0\n\tglobal_load_lds_dwordx4 %1, off\n\ts_mov_b32 m0, %0":"=&s"(keep):"v"(gsrc),"s"(lds_dst):"memory");}
__device__ __forceinline__ void glds16s(const void*sbase,unsigned voff,unsigned lds_dst){unsigned keep;
  asm volatile("s_mov_b32 %0, m0\n\ts_mov_b32 m0, %3\n\ts_nop 0\n\tglobal_load_lds_dwordx4 %1, %2\n\ts_mov_b32 m0, %0":"=&s"(keep):"v"(voff),"s"(sbase),"s"(lds_dst):"memory");}
__device__ __forceinline__ float max3f(float a,float b,float c){float r;asm("v_max3_f32 %0, %1, %2, %3":"=v"(r):"v"(a),"v"(b),"v"(c));return r;}
__device__ __forceinline__ float max2f(float a,float b){float r;asm("v_max_f32_e32 %0, %1, %2":"=v"(r):"v"(a),"v"(b));return r;}
__device__ __forceinline__ float fadd_s(float a,float b){float r;asm("v_add_f32_e32 %0, %1, %2":"=v"(r):"v"(a),"v"(b));return r;}
__device__ __forceinline__ float fsub_s(float a,float b){float r;asm("v_sub_f32_e32 %0, %1, %2":"=v"(r):"v"(a),"v"(b));return r;}
typedef float f32x2_t __attribute__((ext_vector_type(2))); typedef __bf16 bf16x2_t __attribute__((ext_vector_type(2)));
__device__ __forceinline__ unsigned cvtpk_s(float lo,float hi){f32x2_t v={lo,hi};bf16x2_t b=__builtin_convertvector(v,bf16x2_t);return __builtin_bit_cast(unsigned,b);}
#define WAIT_BAR(N) asm volatile("s_waitcnt vmcnt(" #N ") lgkmcnt(0)\n\ts_barrier":::"memory")

__device__ __forceinline__ void qkt(f32x16&p0,f32x16&p1,const char*Kslot,const bf16x8*qr,int r32,int hi){
  const f32x16 negm=f32x16{};
  const char*kb=Kslot+hi*1024+r32*16;
  #pragma unroll
  for(int d0=0;d0<4;++d0){
    const bf16x8 b0=*reinterpret_cast<const bf16x8*>(kb+d0*2048);
    const bf16x8 b1=*reinterpret_cast<const bf16x8*>(kb+d0*2048+512);
    if(d0==0){p0=__builtin_amdgcn_mfma_f32_32x32x16_bf16(b0,qr[0],negm,0,0,0);p1=__builtin_amdgcn_mfma_f32_32x32x16_bf16(b1,qr[0],negm,0,0,0);}
    else{p0=__builtin_amdgcn_mfma_f32_32x32x16_bf16(b0,qr[d0],p0,0,0,0);p1=__builtin_amdgcn_mfma_f32_32x32x16_bf16(b1,qr[d0],p1,0,0,0);}}
}
typedef __attribute__((address_space(3))) const char* lds_cptr;
typedef short v4i16_t __attribute__((ext_vector_type(4)));
__device__ __forceinline__ void kload8(bf16x8*kf,lds_cptr kp){
  kf[0]=*(const __attribute__((address_space(3))) bf16x8*)(kp);      kf[1]=*(const __attribute__((address_space(3))) bf16x8*)(kp+512);
  kf[2]=*(const __attribute__((address_space(3))) bf16x8*)(kp+2048); kf[3]=*(const __attribute__((address_space(3))) bf16x8*)(kp+2560);
  kf[4]=*(const __attribute__((address_space(3))) bf16x8*)(kp+4096); kf[5]=*(const __attribute__((address_space(3))) bf16x8*)(kp+4608);
  kf[6]=*(const __attribute__((address_space(3))) bf16x8*)(kp+6144); kf[7]=*(const __attribute__((address_space(3))) bf16x8*)(kp+6656);
}
__device__ __forceinline__ void kload2(bf16x8*kf,lds_cptr kp,int j){ kf[2*j]=*(const __attribute__((address_space(3))) bf16x8*)(kp+j*2048); kf[2*j+1]=*(const __attribute__((address_space(3))) bf16x8*)(kp+j*2048+512); }
__device__ __forceinline__ s16x4 vtr(lds_cptr p){ return __builtin_bit_cast(s16x4,__builtin_amdgcn_ds_read_tr16_b64_v4i16((__attribute__((address_space(3))) v4i16_t*)p)); }
__device__ __forceinline__ float rowmax(const f32x16&p0,const f32x16&p1){
  float a=max3f(p0[0],p0[1],p1[0]),b=max3f(p0[2],p0[3],p1[1]);a=max3f(a,p1[2],p1[3]);
  #pragma unroll
  for(int r=4;r<16;r+=4){a=max3f(a,p0[r],p0[r+1]);b=max3f(b,p0[r+2],p0[r+3]);a=max3f(a,p1[r],p1[r+1]);b=max3f(b,p1[r+2],p1[r+3]);}
  const float m=max2f(a,b);
  auto rr=__builtin_amdgcn_permlane32_swap(__float_as_uint(m),__float_as_uint(m),false,false);
  return max2f(__uint_as_float(rr[0]),__uint_as_float(rr[1]));
}
__device__ __forceinline__ void pv(f32x16*o,int vb,bf16x8 pa0,bf16x8 pa1,bf16x8 pa2,bf16x8 pa3){
  #pragma unroll
  for(int d0=0;d0<2;++d0){s16x4 lo[4],hi[4];
    #pragma unroll
    for(int ks=0;ks<4;++ks){
      asm volatile("ds_read_b64_tr_b16 %0,%1 offset:%c2":"=&v"(lo[ks]):"v"(vb),"i"(d0*4096+ks*1024):"memory");
      asm volatile("ds_read_b64_tr_b16 %0,%1 offset:%c2":"=&v"(hi[ks]):"v"(vb),"i"(d0*4096+ks*1024+512):"memory");}
    asm volatile("s_waitcnt lgkmcnt(0)":::"memory");SBAR();
    #define PK(k) (bf16x8){lo[k][0],lo[k][1],lo[k][2],lo[k][3],hi[k][0],hi[k][1],hi[k][2],hi[k][3]}
    o[d0]=__builtin_amdgcn_mfma_f32_32x32x16_bf16(pa0,PK(0),o[d0],0,0,0);
    o[d0]=__builtin_amdgcn_mfma_f32_32x32x16_bf16(pa1,PK(1),o[d0],0,0,0);
    o[d0]=__builtin_amdgcn_mfma_f32_32x32x16_bf16(pa2,PK(2),o[d0],0,0,0);
    o[d0]=__builtin_amdgcn_mfma_f32_32x32x16_bf16(pa3,PK(3),o[d0],0,0,0);
    #undef PK
  }
}

#define ATTN_YQ (127.f/6.f)
#ifndef ATTN_STORE16
#define ATTN_STORE16(p,v) st16_wt((p),(v))
#endif
template<int THRL> __device__ __forceinline__ void attn_unit(int b,int h,int qb,const bf16*Q,const bf16*__restrict__ K,const bf16*__restrict__ V,bf16*O,const float*KSUM,const float*GG,char*shm){
  int tid_=threadIdx.x; asm volatile("":"+v"(tid_)); const int tid=tid_,lane=tid&63,r32=lane&31,hi=lane>>5; const int wid=__builtin_amdgcn_readfirstlane(tid>>6);
  const long rowbase=(long)b*SEQ; const int q0=qb*QB;
  const bf16*Qw=Q+(rowbase+q0+wid*QBLK)*DM+h*D;
  const bf16*Kh=K+rowbase*DM+h*D,*Vh=V+rowbase*DM+h*D;
  const unsigned lds0=(unsigned)(uintptr_t)shm;
  float*wsf=(float*)(shm+LDS_WS)+wid*64;
  const unsigned koff=(unsigned)((lane*DM+wid*8)*2);
  const unsigned voffs=(unsigned)(((16*(wid&3)+(lane>>2))*DM+(wid>>2)*32+(lane&3)*8)*2);
  const unsigned kdst=lds0+LDS_K+wid*1024, vdst=lds0+LDS_V+wid*1024;
  #define PT(t) (((t)<4)?(NT-4+(t)):((t)-4))
  #define DMA_K(t,slot) glds16s((const char*)Kh+(long)PT(t)*(KVBLK*DM*2),koff,(unsigned)__builtin_amdgcn_readfirstlane(kdst+(slot)))
  #define DMA_V(t,slot) glds16s((const char*)Vh+(long)PT(t)*(KVBLK*DM*2),voffs,(unsigned)__builtin_amdgcn_readfirstlane(vdst+(slot)))
  const int vb0=(int)(lds0+LDS_V)+((lane>>4)&1)*32+(lane&3)*8+(4*hi+((lane&15)>>2))*64;
  const char*Kbase=shm+LDS_K; bf16x8 kf[8];
  const lds_cptr shm3=(lds_cptr)shm; const lds_cptr kp0=shm3+LDS_K+hi*1024+r32*16; const lds_cptr vp0=shm3+LDS_V+((lane>>4)&1)*32+(lane&3)*8+(4*hi+((lane&15)>>2))*64;
  const int NT=(q0+QB)/KVBLK;
  DMA_K(0,0);DMA_V(0,0);DMA_K(1,SLOTB);
  bf16x8 qr[4];
  #pragma unroll
  for(int d0=0;d0<4;++d0)qr[d0]=*reinterpret_cast<const bf16x8*>(&Qw[(long)r32*DM+d0*16+hi*8]);
  float mhat=0.f,l_reg=0.f;f32x16 o[2];o[0]=f32x16{};o[1]=f32x16{};const f32x16 z16=f32x16{};
  unsigned selm=(1u<<qb)-1u;
  if(qb>3){
    f32x16 gt=f32x16{};
    #pragma unroll
    for(int d0=0;d0<4;++d0){ const float*kp=KSUM+((long)(b*16+(r32&15)))*512+h*D+d0*16+hi*8;
      const float4 k0=*reinterpret_cast<const float4*>(kp),k1=*reinterpret_cast<const float4*>(kp+4);
      u32x4 kw; kw.x=cvtpk_s(k0.x,k0.y);kw.y=cvtpk_s(k0.z,k0.w);kw.z=cvtpk_s(k1.x,k1.y);kw.w=cvtpk_s(k1.z,k1.w);
      gt=__builtin_amdgcn_mfma_f32_32x32x16_bf16(__builtin_bit_cast(bf16x8,kw),qr[d0],gt,0,0,0); }
    float v0=-INFINITY,v1=-INFINITY,v2=-INFINITY; int i0=0,i1=0,i2=0;
    #define INS3(vv,ii) do{ const float x_=(vv); const int j_=(ii); \
      if(x_>v0){v2=v1;i2=i1;v1=v0;i1=i0;v0=x_;i0=j_;} else if(x_>v1){v2=v1;i2=i1;v1=x_;i1=j_;} else if(x_>v2){v2=x_;i2=j_;} }while(0)
    #pragma unroll
    for(int r=0;r<8;++r){ const int j=crow(r,hi); INS3(j<qb?gt[r]:-INFINITY,j); }
    const float p0=__shfl_xor(v0,32),p1=__shfl_xor(v1,32),p2=__shfl_xor(v2,32); const int q0i=__shfl_xor(i0,32),q1i=__shfl_xor(i1,32),q2i=__shfl_xor(i2,32);
    INS3(p0,q0i); INS3(p1,q1i); INS3(p2,q2i);
    #undef INS3
    selm=(1u<<i0)|(1u<<i1)|(1u<<i2);
  }
  const int qrel=wid*QBLK+r32;
  #define CMASK(P0,P1,t) do{ if((t)<4)cmask(P0,P1,(t),qrel,hi); }while(0)
  bool resc=false;
  #define START(P0,P1) do{ const float rm=rowmax(P0,P1); resc=false; \
    { const float dl=rm; mhat=fadd_s(mhat,dl); \
      _Pragma("unroll") for(int r=0;r<16;++r){P0[r]=fsub_s(P0[r],dl);P1[r]=fsub_s(P1[r],dl);} \
      } \
    _Pragma("unroll") for(int r=0;r<16;++r)P0[r]=__builtin_amdgcn_exp2f(P0[r]); }while(0)
  #define RESC() do{ if(resc){ asm volatile("s_waitcnt lgkmcnt(0)":::"memory"); \
      _Pragma("unroll") for(int d_=0;d_<2;++d_) _Pragma("unroll") for(int r=0;r<16;++r)o[d_][r]*=wsf[crow(r,hi)]; } }while(0)
  f32x16 pA0,pA1,pB0,pB1;
  int sl_prev=0,sl_cur=0,sl_next=SLOTB;
  #define ROT() do{sl_prev=sl_cur;sl_cur=sl_next;sl_next=(sl_next==(NSLOT-1)*SLOTB)?0:sl_next+SLOTB;}while(0)
  DMA_K(2,2*SLOTB);
  WAIT_BAR(3);
  qkt(pA0,pA1,Kbase,qr,r32,hi);asm volatile("s_nop 15\n\ts_nop 7":"+v"(pA0),"+v"(pA1));CMASK(pA0,pA1,0);
  START(pA0,pA1);
  _Pragma("unroll") for(int r=0;r<16;++r)pA1[r]=__builtin_amdgcn_exp2f(pA1[r]);
  WAIT_BAR(0);
  DMA_K(3,0);DMA_V(1,SLOTB);
  ROT();
  kload8(kf,kp0+sl_cur);
  WAIT_BAR(2);
  s16x4 vlo[8],vhi[8]; u32x4 pw0,pw1,pw2,pw3;
  #define PKW(P,B) cvtpk_s(P[B],P[B+1])
  #define PAF(k) __builtin_bit_cast(bf16x8,pw##k)
  #define VFR(i) (bf16x8){vlo[i][0],vlo[i][1],vlo[i][2],vlo[i][3],vhi[i][0],vhi[i][1],vhi[i][2],vhi[i][3]}
  #define PIN(x) asm volatile("":"+v"(x))
  #define MX3(a,b,c) __builtin_fmaxf(__builtin_fmaxf((a),(b)),(c))
  #define GAPA(MF,A0,A1,A2,A3,W0,W1,PW) do{ MF; sacc+=A0; sacc+=A1; sacc+=A2; sacc+=A3; PIN(sacc); W0; W1; PIN(PW); SBAR(); }while(0)
  #define EX(v) __builtin_amdgcn_exp2f(v)
  #define GAPB(MF,X,B) do{ MF; X[B]=EX(X[B]); X[B+1]=EX(X[B+1]); X[B+2]=EX(X[B+2]); X[B+3]=EX(X[B+3]); PIN(X); SBAR(); }while(0)
  #define VRD(i) do{ vlo[i]=vtr(vp_+(((i)>>2)*4096+((i)&3)*1024)); vhi[i]=vtr(vp_+(((i)>>2)*4096+((i)&3)*1024+512)); }while(0)
  #define KRD(G,j) do{ if(G){ kload2(kf,kp0+sl_next,j); SBAR(); } }while(0)
  #define STEP(C0,C1,P0,P1,t,GK,GV,GL) do{ SBAR(); \
    const lds_cptr vp_=vp0+sl_prev; \
    VRD(0); SBAR(); float sacc=(P0[0]+P0[1]); \
    GAPA(C0=__builtin_amdgcn_mfma_f32_32x32x16_bf16(kf[0],qr[0],z16,0,0,0), P0[2],P0[3],P0[4],P0[5],     pw0[0]=PKW(P0,0), pw0[1]=PKW(P0,2), pw0); \
    VRD(4); SBAR(); GAPA(C1=__builtin_amdgcn_mfma_f32_32x32x16_bf16(kf[1],qr[0],z16,0,0,0), P0[6],P0[7],P0[8],P0[9],     pw0[2]=PKW(P0,4), pw0[3]=PKW(P0,6), pw0); \
    VRD(1); SBAR(); GAPA(C0=__builtin_amdgcn_mfma_f32_32x32x16_bf16(kf[2],qr[1],C0,0,0,0),   P0[10],P0[11],P0[12],P0[13], pw1[0]=PKW(P0,8), pw1[1]=PKW(P0,10), pw1); \
    VRD(5); SBAR(); GAPA(C1=__builtin_amdgcn_mfma_f32_32x32x16_bf16(kf[3],qr[1],C1,0,0,0),   P0[14],P0[15],P1[0],P1[1],   pw1[2]=PKW(P0,12),pw1[3]=PKW(P0,14), pw1); \
    VRD(2); SBAR(); GAPA(C0=__builtin_amdgcn_mfma_f32_32x32x16_bf16(kf[4],qr[2],C0,0,0,0),   P1[2],P1[3],P1[4],P1[5],     pw2[0]=PKW(P1,0), pw2[1]=PKW(P1,2), pw2); \
    VRD(6); SBAR(); GAPA(C1=__builtin_amdgcn_mfma_f32_32x32x16_bf16(kf[5],qr[2],C1,0,0,0),   P1[6],P1[7],P1[8],P1[9],     pw2[2]=PKW(P1,4), pw2[3]=PKW(P1,6), pw2); \
    VRD(3); SBAR(); GAPA(C0=__builtin_amdgcn_mfma_f32_32x32x16_bf16(kf[6],qr[3],C0,0,0,0),   P1[10],P1[11],P1[12],P1[13], pw3[0]=PKW(P1,8), pw3[1]=PKW(P1,10), pw3); \
    VRD(7); SBAR(); GAPA(C1=__builtin_amdgcn_mfma_f32_32x32x16_bf16(kf[7],qr[3],C1,0,0,0),   P1[14],P1[15],0.f,0.f,       pw3[2]=PKW(P1,12),pw3[3]=PKW(P1,14), pw3); \
    l_reg+=sacc; \
    if(GK){DMA_K((t)+3,sl_cur);} if(GV){DMA_V((t)+1,sl_next);} \
    { const bool v_=((t)<4)||((selm>>(((t)-4)>>2))&1u); const float nm_=v_?-mhat:-INFINITY; \
      _Pragma("unroll") for(int r=0;r<16;++r){C0[r]+=nm_;C1[r]+=nm_;} } \
    CMASK(C0,C1,t); \
    { float a=MX3(C0[0],C0[1],C1[0]),b=MX3(C0[2],C0[3],C1[1]); a=MX3(a,C1[2],C1[3]); \
      _Pragma("unroll") for(int r=4;r<16;r+=4){a=MX3(a,C0[r],C0[r+1]);b=MX3(b,C0[r+2],C0[r+3]);a=MX3(a,C1[r],C1[r+1]);b=MX3(b,C1[r+2],C1[r+3]);} \
      float rm=__builtin_fmaxf(a,b); { auto rr=__builtin_amdgcn_permlane32_swap(__float_as_uint(rm),__float_as_uint(rm),false,false); rm=__builtin_fmaxf(__uint_as_float(rr[0]),__uint_as_float(rr[1])); } \
      resc=false; \
      if(__builtin_expect(__any(rm>(float)THRL),0)){ const float dl=__builtin_fmaxf(rm,0.f); mhat+=dl; \
        _Pragma("unroll") for(int r=0;r<16;++r){C0[r]-=dl;C1[r]-=dl;} \
        const float f=__builtin_amdgcn_exp2f(-dl); l_reg*=f; if(hi==0)wsf[r32]=f; resc=true; } } \
    SBAR(); \
    GAPB(o[0]=__builtin_amdgcn_mfma_f32_32x32x16_bf16(PAF(0),VFR(0),o[0],0,0,0), C0,0); \
    GAPB(o[1]=__builtin_amdgcn_mfma_f32_32x32x16_bf16(PAF(0),VFR(4),o[1],0,0,0), C0,4); \
    KRD(GL,0); GAPB(o[0]=__builtin_amdgcn_mfma_f32_32x32x16_bf16(PAF(1),VFR(1),o[0],0,0,0), C0,8); \
    KRD(GL,1); GAPB(o[1]=__builtin_amdgcn_mfma_f32_32x32x16_bf16(PAF(1),VFR(5),o[1],0,0,0), C0,12); \
    KRD(GL,2); GAPB(o[0]=__builtin_amdgcn_mfma_f32_32x32x16_bf16(PAF(2),VFR(2),o[0],0,0,0), C1,0); \
    KRD(GL,3); GAPB(o[1]=__builtin_amdgcn_mfma_f32_32x32x16_bf16(PAF(2),VFR(6),o[1],0,0,0), C1,4); \
    GAPB(o[0]=__builtin_amdgcn_mfma_f32_32x32x16_bf16(PAF(3),VFR(3),o[0],0,0,0), C1,8); \
    GAPB(o[1]=__builtin_amdgcn_mfma_f32_32x32x16_bf16(PAF(3),VFR(7),o[1],0,0,0), C1,12); \
    }while(0)
  int t=1;
  #define ENDW(tt) do{ if((tt)+3<NT){WAIT_BAR(2);} else if((tt)+2<NT){WAIT_BAR(1);} else {WAIT_BAR(0);} }while(0)
  for(;t<5&&t+1<NT;t+=2){
    STEP(pB0,pB1,pA0,pA1,t,(t+3<NT),(t+1<NT),(t+1<NT));       ENDW(t);   RESC(); ROT();
    STEP(pA0,pA1,pB0,pB1,t+1,(t+4<NT),(t+2<NT),(t+2<NT));     ENDW(t+1); RESC(); ROT();
  }
  #undef CMASK
  #define CMASK(P0,P1,t) do{}while(0)
  for(;t+5<NT;t+=2){
    STEP(pB0,pB1,pA0,pA1,t,true,true,true);     WAIT_BAR(2); RESC(); ROT();
    STEP(pA0,pA1,pB0,pB1,t+1,true,true,true);   WAIT_BAR(2); RESC(); ROT();
  }
  #undef CMASK
  #define CMASK(P0,P1,t) do{ if((t)<4)cmask(P0,P1,(t),qrel,hi); }while(0)
  for(;t+1<NT;t+=2){
    STEP(pB0,pB1,pA0,pA1,t,(t+3<NT),(t+1<NT),(t+1<NT));       ENDW(t);   RESC(); ROT();
    STEP(pA0,pA1,pB0,pB1,t+1,(t+4<NT),(t+2<NT),(t+2<NT));     ENDW(t+1); RESC(); ROT();
  }
  STEP(pB0,pB1,pA0,pA1,NT-1,false,false,false); RESC();
  { float sacc=pB0[0]+pB0[1]; _Pragma("unroll") for(int r=2;r<16;++r)sacc+=pB0[r]; _Pragma("unroll") for(int r=0;r<16;++r)sacc+=pB1[r]; l_reg+=sacc;
    pw0=(u32x4){PKW(pB0,0),PKW(pB0,2),PKW(pB0,4),PKW(pB0,6)};pw1=(u32x4){PKW(pB0,8),PKW(pB0,10),PKW(pB0,12),PKW(pB0,14)};pw2=(u32x4){PKW(pB1,0),PKW(pB1,2),PKW(pB1,4),PKW(pB1,6)};pw3=(u32x4){PKW(pB1,8),PKW(pB1,10),PKW(pB1,12),PKW(pB1,14)};
    SBAR(); pv(o,vb0+sl_cur,PAF(0),PAF(1),PAF(2),PAF(3)); }
  #undef PKW
  #undef PAF
  #undef VFR
  #undef PIN
  #undef MX3
  #undef GAPA
  #undef GAPB
  #undef EX
  #undef VRD
  #undef KRD
  #undef STEP
  #undef ENDW
  {auto rr=__builtin_amdgcn_permlane32_swap(__float_as_uint(l_reg),__float_as_uint(l_reg),false,false);l_reg=__uint_as_float(rr[0])+__uint_as_float(rr[1]);}
  if(hi==0)wsf[32+r32]=l_reg;asm volatile("s_waitcnt lgkmcnt(0)":::"memory");
  float rli[16];
  #pragma unroll
  for(int r=0;r<16;++r)rli[r]=__builtin_amdgcn_rcpf(wsf[32+crow(r,hi)]);
  bf16*Ow=O+(rowbase+q0+wid*QBLK)*OPITCH+h*D;
  { bf16*stg=(bf16*)(shm+LDS_OST)+wid*2048;
    #pragma unroll
    for(int r=0;r<16;++r){const int orow=crow(r,hi);
      #pragma unroll
      for(int d0=0;d0<2;++d0)stg[orow*64+d0*32+r32]=__float2bfloat16(o[d0][r]*rli[r]);}
    asm volatile("s_waitcnt lgkmcnt(0)":::"memory");
    const int ch=lane&7; float gg[8];
    #pragma unroll
    for(int i=0;i<8;++i)gg[i]=GG[h*D+ch*8+i];
    #pragma unroll
    for(int i=0;i<4;++i){const int row=i*8+(lane>>3); const u32x4 v=*(const u32x4*)(stg+row*64+ch*8);
      float x[8]; x[0]=__uint_as_float(v.x<<16);x[1]=__uint_as_float(v.x&0xffff0000u);x[2]=__uint_as_float(v.y<<16);x[3]=__uint_as_float(v.y&0xffff0000u);
      x[4]=__uint_as_float(v.z<<16);x[5]=__uint_as_float(v.z&0xffff0000u);x[6]=__uint_as_float(v.w<<16);x[7]=__uint_as_float(v.w&0xffff0000u);
      float ss=0.f;
      #pragma unroll
      for(int k=0;k<8;++k)ss+=x[k]*x[k];
      ss+=__shfl_xor(ss,1);ss+=__shfl_xor(ss,2);ss+=__shfl_xor(ss,4);
      const float rs=rsqrtf(ss*(1.f/64.f)+1e-6f);
      const float qn=rs*ATTN_YQ; unsigned w0=0u,w1=0u;
      #pragma unroll
      for(int k=0;k<4;++k){const int a=(int)fminf(fmaxf(__builtin_rintf(x[k]*qn),-127.f),127.f),b=(int)fminf(fmaxf(__builtin_rintf(x[4+k]*qn),-127.f),127.f); w0|=((unsigned)a&0xffu)<<(8*k); w1|=((unsigned)b&0xffu)<<(8*k);}
      st8_wt((void*)((unsigned char*)O+((rowbase+q0+wid*QBLK+row)*(long)OPITCH+h*D+ch*8)),(unsigned long long)w0|((unsigned long long)w1<<32));} }
  asm volatile("s_waitcnt lgkmcnt(0)\n\ts_barrier":::"memory");
  #undef DMA_K
  #undef PT
  #undef DMA_V
  #undef CMASK
  #undef START
  #undef RESC
  #undef ROT
}
constexpr int ATTN_LDS_BYTES=LDS_BYTES;
struct AttnTensors { const bf16* Q; const bf16* K; const bf16* V; bf16* O; const float* KSUM; const float* GG; };
struct AttnUnit { int bh; int qb; };
struct StaticOrder {
  int vcu,G;
  __device__ __forceinline__ explicit StaticOrder(int grid,int block):vcu((grid%8==0)?(block%8)*(grid/8)+block/8:block),G(grid){}
  __device__ __forceinline__ bool next(int i,AttnUnit&u)const{ const int pr=vcu+(i>>1)*G; if(pr>=256)return false; const int s=pr&7; u.bh=pr>>3; u.qb=(i&1)?s:15-s; return true; }
  __device__ __forceinline__ void a_ready(const AttnUnit&)const{}
  __device__ __forceinline__ void done(const AttnUnit&)const{}
};
template<class Sched,int THRL=8> __device__ __forceinline__ void attn_phase(char*lds,const AttnTensors&T,const Sched&S){
  AttnUnit u;
  for(int i=0;S.next(i,u);++i){ S.a_ready(u); attn_unit<THRL>(u.bh/NHEAD,u.bh%NHEAD,u.qb,T.Q,T.K,T.V,T.O,T.KSUM,T.GG,lds); S.done(u); }
}
#undef SBAR
#undef WAIT_BAR
}

#define GAS __attribute__((address_space(1)))
#define LAS __attribute__((address_space(3)))
typedef unsigned short bf16;
typedef unsigned v4u __attribute__((ext_vector_type(4)));
typedef float f32x4 __attribute__((ext_vector_type(4)));
typedef short bf16x8 __attribute__((ext_vector_type(8)));
typedef GAS unsigned gu32;
typedef GAS unsigned long long gu64;
#define RLX_AGENT __ATOMIC_RELAXED, __HIP_MEMORY_SCOPE_AGENT
#define LDS_WAIT() asm volatile("s_waitcnt lgkmcnt(0)" ::: "memory")
#define VM_WAIT() asm volatile("s_waitcnt vmcnt(0)" ::: "memory")
__device__ __forceinline__ unsigned long long rt() { return __builtin_amdgcn_s_memrealtime(); }
__device__ __forceinline__ unsigned f2bf(float f) { unsigned u = __builtin_bit_cast(unsigned, f); return (u + 0x7fffu + ((u >> 16) & 1u)) >> 16; }
__device__ __forceinline__ unsigned pk2(float lo, float hi) { return f2bf(lo) | (f2bf(hi) << 16); }

#define XB_TMO      128
#define XB_XCNT(j)  (256  + 64 * (j))
#define XB_XSUB(j)  (1280 + 64 * (j))
#define XB_XGEN(j)  (2304 + 64 * (j))
#define XB_TOP      3328
#define XB_TOPGEN   3392
#define XCD_BAR_WORDS 3456
#define XB_SPIN_CAP (1u << 18)

__device__ __forceinline__ unsigned xb_ld(unsigned* p)              { return __hip_atomic_load(p, __ATOMIC_RELAXED, __HIP_MEMORY_SCOPE_AGENT); }
__device__ __forceinline__ unsigned xb_add(unsigned* p, unsigned v) { return __hip_atomic_fetch_add(p, v, __ATOMIC_RELAXED, __HIP_MEMORY_SCOPE_AGENT); }
__device__ __forceinline__ unsigned xb_xcc_id() { return (unsigned)__builtin_amdgcn_s_getreg((3 << 11) | 20) & 0xFu; }
#define XB_SPIN(cond, bar) do { unsigned _sp = 0; while (cond) { __builtin_amdgcn_s_sleep(1); \
    if ((++_sp & 255u) == 0u) { if (xb_ld(&(bar)[XB_TMO])) break; if (_sp > XB_SPIN_CAP) { atomicAdd(&(bar)[XB_TMO], 1u); break; } } } } while (0)

struct XcdBarrier {
    unsigned* bar; unsigned x;
    volatile LAS unsigned* st;
};

__device__ __forceinline__ XcdBarrier xcd_barrier_post(unsigned* bar, volatile LAS unsigned* st) {
    XcdBarrier b; b.bar = bar; b.x = xb_xcc_id(); b.st = st;
    if (threadIdx.x == 0) (void)xb_add(&bar[XB_XCNT(b.x)], 1u);
    return b;
}
__device__ __forceinline__ void xcd_barrier_complete(unsigned* bar, unsigned x, unsigned& nloc, unsigned& nx) {
    const unsigned G = gridDim.x * gridDim.y * gridDim.z;
    unsigned sum, cnt, mine, sp = 0u;
    for (;;) {
        sum = 0u; cnt = 0u; mine = 0u;
#pragma unroll
        for (unsigned j = 0; j < 16; ++j) { const unsigned c = xb_ld(&bar[XB_XCNT(j)]); sum += c; cnt += (c > 0u) ? 1u : 0u; mine = (j == x) ? c : mine; }
        if (sum == G) break;
        __builtin_amdgcn_s_sleep(1);
        if ((++sp & 255u) == 0u) { if (xb_ld(&bar[XB_TMO])) break; if (sp > XB_SPIN_CAP) { atomicAdd(&bar[XB_TMO], 1u); break; } }
    }
    nloc = mine > 0u ? mine : 1u; nx = cnt > 0u ? cnt : 1u;
}

__device__ __forceinline__ void xcd_barrier(const XcdBarrier& b) {
    asm volatile("s_waitcnt vmcnt(0)" ::: "memory");
    __syncthreads();
    if (threadIdx.x == 0) {
        unsigned* bar = b.bar;
        __builtin_amdgcn_s_waitcnt(0);
        unsigned nloc = b.st[0], nx = b.st[1];
        if (nloc == 0u) { xcd_barrier_complete(bar, b.x, nloc, nx); b.st[0] = nloc; b.st[1] = nx; }
        const unsigned old = xb_add(&bar[XB_XSUB(b.x)], 1u);
        const unsigned gen = old / nloc;
        if (old + 1u == (gen + 1u) * nloc) {
            asm volatile("s_waitcnt vmcnt(0)" ::: "memory");
            const unsigned og = xb_add(&bar[XB_TOP], 1u);
            const unsigned tg = og / nx;
            if (og + 1u == (tg + 1u) * nx) xb_add(&bar[XB_TOPGEN], 1u);
            else XB_SPIN(xb_ld(&bar[XB_TOPGEN]) == tg, bar);
            __builtin_amdgcn_fence(__ATOMIC_ACQUIRE, "agent");
            xb_add(&bar[XB_XGEN(b.x)], 1u);
            asm volatile("s_waitcnt vmcnt(0)" ::: "memory");
        } else {
            XB_SPIN(xb_ld(&bar[XB_XGEN(b.x)]) == gen, bar);
            __builtin_amdgcn_fence(__ATOMIC_ACQUIRE, "agent");
            asm volatile("s_waitcnt vmcnt(0)" ::: "memory");
        }
    }
    __syncthreads();
}

constexpr int NWAVES = 8;
constexpr int NB = 4, S = 4096, D = 1024, M = NB * S;
constexpr int NIN = 3072, NQ = 2048, NEXP = 16384;
constexpr float EPS = 1e-6f;
constexpr float C2 = 0.125f * 1.4426950408889634f;

constexpr size_t MiB = 1u << 20;
constexpr size_t WS_CTL = 0, CTL_ZERO_BYTES = 256 * 1024;
constexpr size_t WS_MOD = 1 * MiB;
constexpr size_t WS_KMEAN = 128 * 1024;
constexpr size_t WS_KEYS = 1 * MiB + 512 * 1024;
constexpr size_t WS_WIN = 2 * MiB, WS_WO = 8 * MiB, WS_WQ = 10 * MiB;
constexpr size_t WS_EIDX = 14 * MiB, WS_G = 22 * MiB;
constexpr size_t WS_U = 32 * MiB, WS_V = 64 * MiB;
constexpr size_t WS_SU = 48 * MiB, WS_SV = 48 * MiB + 64 * 1024;
constexpr size_t WS_H = 96 * MiB;
constexpr size_t WS_P = 128 * MiB;
constexpr size_t WS_QP = 128 * MiB, WS_O = 192 * MiB;
constexpr size_t WS_Y = 224 * MiB, WS_END = 256 * MiB;
constexpr int CW_BAR = 1024;
constexpr int CW_CMAX = 8192;
constexpr int CW_CMAX3 = CW_CMAX + 3072 + 2048;
constexpr float YQ = 127.f / 6.f;
constexpr int CW_CMAX2 = CW_CMAX + 3072;
constexpr size_t WS_WO8 = 47 * MiB;
constexpr size_t WS_WQ8 = 45 * MiB, WS_RS2 = 44 * MiB + 65536;
constexpr size_t WS_WIN8 = 40 * MiB, WS_RS = 44 * MiB;

constexpr int LDS_BYTES = 153600;
constexpr int LDSCTL_OFF = LDS_BYTES - 512, MISC_OFF = LDSCTL_OFF + 320;
constexpr int RING_BYTES = 131072;

struct Frame {
    LAS unsigned char* lds;
    volatile LAS unsigned* MISC;
    gu32* ctl;
    int tid, lane, wave, G;
    const float *x, *c, *ada_w, *ada_b, *pre_gain, *post_gain, *w_in, *conv_w, *group_gain, *w_out, *fpre_gain, *fpost_gain, *wq, *keys, *pu, *pv;
    float* out;
    float* mod; float* kmean; bf16* keysb; bf16 *WinT, *WoT, *WqT; int* eidx; float* gw; unsigned char *U8, *V8; float *su, *sv; bf16 *H, *P, *QP, *O, *Y; float* scratch; unsigned char* Win8; float* rs; unsigned char* Wq8; float* rs2; unsigned char* Wo8;
};

__device__ __forceinline__ float wave_sum(float v) {
#pragma unroll
    for (int o = 1; o < 64; o <<= 1) v += __shfl_xor(v, o);
    return v;
}
__device__ __forceinline__ float bflo(unsigned u) { return __uint_as_float(u << 16); }
__device__ __forceinline__ float bfhi(unsigned u) { return __uint_as_float(u & 0xffff0000u); }

struct TItem { const float* W; bf16* WT; int N, k0, n0; };
__device__ __forceinline__ void p0_titem_load(const TItem& t, f32x4 (&v)[8], int lane) {
#pragma unroll
    for (int i = 0; i < 8; ++i) { const int kk = 8 * i + (lane >> 3); v[i] = *(const GAS f32x4*)(t.W + (size_t)(t.k0 + kk) * t.N + t.n0 + 4 * (lane & 7)); }
}
__device__ __forceinline__ void p0_titem_process(const TItem& t, const f32x4 (&v)[8], LAS float* scr, int lane) {
#pragma unroll
    for (int i = 0; i < 8; ++i) { const int kk = 8 * i + (lane >> 3); LAS float* d = scr + kk * 33 + 4 * (lane & 7); d[0] = v[i].x; d[1] = v[i].y; d[2] = v[i].z; d[3] = v[i].w; }
    LDS_WAIT(); asm volatile("" ::: "memory");
    const int c = lane & 7;
#pragma unroll
    for (int j = 0; j < 4; ++j) { const int n = (lane >> 3) + 8 * j; const LAS float* s = scr + (8 * c) * 33 + n;
        v4u o; o.x = pk2(s[0 * 33], s[1 * 33]); o.y = pk2(s[2 * 33], s[3 * 33]); o.z = pk2(s[4 * 33], s[5 * 33]); o.w = pk2(s[6 * 33], s[7 * 33]);
        st16_wt((void*)(t.WT + (size_t)(t.n0 + n) * D + t.k0 + 8 * c), o); }
    LDS_WAIT(); asm volatile("" ::: "memory");
}
__device__ __forceinline__ void cvt8(const float* src, bf16* dst, size_t i8) {
    const f32x4 a = *(const GAS f32x4*)(src + i8 * 8), b = *(const GAS f32x4*)(src + i8 * 8 + 4);
    v4u o; o.x = pk2(a.x, a.y); o.y = pk2(a.z, a.w); o.z = pk2(b.x, b.y); o.w = pk2(b.z, b.w);
    st16_wt((void*)(dst + i8 * 8), o);
}
__device__ __forceinline__ void p0_prep(Frame& F) {
    {
        LAS float* sc = (LAS float*)F.lds;
        LAS float* red = sc + 4096;
        bool did = false;
        for (int it = blockIdx.x; it < 192; it += F.G) {
            if (!did) { for (int i = F.tid; i < 4096; i += 512) { const float v = F.c[i]; sc[i] = v / (1.f + __expf(-v)); } did = true; }
            __syncthreads();
            const int c4 = F.tid & 7, ks = F.tid >> 3, j0 = it * 32 + 4 * c4;
            f32x4 w[16];
#pragma unroll
            for (int i = 0; i < 16; ++i) w[i] = *(const GAS f32x4*)(F.ada_w + (size_t)(ks * 16 + i) * 6144 + j0);
            f32x4 a0 = {0.f, 0.f, 0.f, 0.f}, a1 = a0, a2 = a0, a3 = a0;
#pragma unroll
            for (int i = 0; i < 16; ++i) { const int r = ks * 16 + i; a0 += w[i] * sc[r]; a1 += w[i] * sc[1024 + r]; a2 += w[i] * sc[2048 + r]; a3 += w[i] * sc[3072 + r]; }
            *(LAS f32x4*)(red + (ks * 4 + 0) * 32 + 4 * c4) = a0; *(LAS f32x4*)(red + (ks * 4 + 1) * 32 + 4 * c4) = a1;
            *(LAS f32x4*)(red + (ks * 4 + 2) * 32 + 4 * c4) = a2; *(LAS f32x4*)(red + (ks * 4 + 3) * 32 + 4 * c4) = a3;
            __syncthreads();
            if (F.tid < 128) { const int b = F.tid >> 5, jj = F.tid & 31; float s = 0.f;
#pragma unroll 16
                for (int k = 0; k < 64; ++k) s += red[(k * 4 + b) * 32 + jj];
                __hip_atomic_store(F.mod + b * 6144 + it * 32 + jj, s + F.ada_b[it * 32 + jj], __ATOMIC_RELAXED, __HIP_MEMORY_SCOPE_AGENT); }
        }
        __syncthreads();
    }
    LAS float* scr = (LAS float*)(F.lds + F.wave * 16384);
    const int gwv = blockIdx.x * NWAVES + F.wave, NGW = F.G * NWAVES;
    constexpr int I_IN = (D / 64) * (NIN / 32), I_O = (D / 64) * (D / 32), I_Q = (D / 64) * (NQ / 32), I_ALL = I_IN + I_O + I_Q;
    auto titem = [&](int it) { TItem t; int r = it;
        if (r < I_IN) { t.W = F.w_in; t.WT = F.WinT; t.N = NIN; }
        else if (r < I_IN + I_O) { r -= I_IN; t.W = F.w_out; t.WT = F.WoT; t.N = D; }
        else { r -= I_IN + I_O; t.W = F.wq; t.WT = F.WqT; t.N = NQ; }
        const int nblk = t.N / 32; t.k0 = 64 * (r / nblk); t.n0 = 32 * (r % nblk); return t; };
    { f32x4 va[8], vb[8]; TItem ta, tb;
      int it = gwv;
      if (it < I_ALL) { ta = titem(it); p0_titem_load(ta, va, F.lane); }
      while (it < I_ALL) {
          const int i1 = it + NGW; const bool h1 = i1 < I_ALL;
          if (h1) { tb = titem(i1); p0_titem_load(tb, vb, F.lane); }
          p0_titem_process(ta, va, scr, F.lane);
          if (!h1) break;
          it = i1 + NGW;
          if (it < I_ALL) { ta = titem(it); p0_titem_load(ta, va, F.lane); }
          p0_titem_process(tb, vb, scr, F.lane);
      } }
    const size_t gt = (size_t)blockIdx.x * 512 + F.tid, NT = (size_t)F.G * 512;
    for (size_t i = gt; i < (size_t)16 * 128 * 128 / 8; i += NT) cvt8(F.keys, F.keysb, i);
}
__device__ __forceinline__ void p0_tables(Frame& F) {
    const int gwv = blockIdx.x * NWAVES + F.wave, NGW = F.G * NWAVES;
    for (int row0 = gwv; row0 < 2 * NEXP; row0 += 2 * NGW) {
      f32x4 a2[2][4];
#pragma unroll
      for (int rr = 0; rr < 2; ++rr) { const int row = row0 + rr * NGW; if (row < 2 * NEXP) { const GAS f32x4* src = (const GAS f32x4*)(((row >> 14) ? F.pv : F.pu) + (size_t)(row & (NEXP - 1)) * D + 16 * F.lane);
#pragma unroll
          for (int i = 0; i < 4; ++i) a2[rr][i] = src[i]; } }
#pragma unroll
      for (int rr = 0; rr < 2; ++rr) { const int row = row0 + rr * NGW; if (row >= 2 * NEXP) break;
        const int tabv = row >> 14, e = row & (NEXP - 1);
        f32x4 a[4]; float ssq = 0.f;
#pragma unroll
        for (int i = 0; i < 4; ++i) { a[i] = a2[rr][i]; ssq += (a[i].x * a[i].x + a[i].y * a[i].y) + (a[i].z * a[i].z + a[i].w * a[i].w); }
        ssq = wave_sum(ssq);
        const float rms = sqrtf(ssq * (1.f / D));
        if (tabv == 0) {
            const float stepq = 0.34f * rms, isq = stepq > 0.f ? 1.f / stepq : 0.f;
            unsigned d0 = 0u, d1 = 0u;
#pragma unroll
            for (int i = 0; i < 4; ++i) { const float xs[4] = {a[i].x, a[i].y, a[i].z, a[i].w};
#pragma unroll
                for (int c = 0; c < 4; ++c) { const int q = (int)fminf(fmaxf(__builtin_rintf(xs[c] * isq), -7.f), 7.f); const int el = 4 * i + c;
                    if (el < 8) d0 |= (unsigned)(q & 15) << (4 * el); else d1 |= (unsigned)(q & 15) << (4 * (el - 8)); } }
            st8_wt((void*)(F.U8 + (size_t)e * 512 + 8 * F.lane), (unsigned long long)d0 | ((unsigned long long)d1 << 32));
            if (F.lane == 0) __hip_atomic_store(F.su + e, stepq, __ATOMIC_RELAXED, __HIP_MEMORY_SCOPE_AGENT);
        } else {
            const float unit = 0.5f * rms, iu = unit > 0.f ? 1.f / unit : 0.f;
            unsigned d0 = 0u, d1 = 0u;
            d0 = __builtin_amdgcn_cvt_scalef32_pk_fp4_f32(d0, a[0].x * iu, a[0].y * iu, 1.0f, 0); d0 = __builtin_amdgcn_cvt_scalef32_pk_fp4_f32(d0, a[0].z * iu, a[0].w * iu, 1.0f, 1);
            d0 = __builtin_amdgcn_cvt_scalef32_pk_fp4_f32(d0, a[1].x * iu, a[1].y * iu, 1.0f, 2); d0 = __builtin_amdgcn_cvt_scalef32_pk_fp4_f32(d0, a[1].z * iu, a[1].w * iu, 1.0f, 3);
            d1 = __builtin_amdgcn_cvt_scalef32_pk_fp4_f32(d1, a[2].x * iu, a[2].y * iu, 1.0f, 0); d1 = __builtin_amdgcn_cvt_scalef32_pk_fp4_f32(d1, a[2].z * iu, a[2].w * iu, 1.0f, 1);
            d1 = __builtin_amdgcn_cvt_scalef32_pk_fp4_f32(d1, a[3].x * iu, a[3].y * iu, 1.0f, 2); d1 = __builtin_amdgcn_cvt_scalef32_pk_fp4_f32(d1, a[3].z * iu, a[3].w * iu, 1.0f, 3);
            st8_wt((void*)(F.V8 + (size_t)(F.lane >> 4) * (NEXP * 128) + (size_t)e * 128 + (F.lane & 15) * 8), (unsigned long long)d0 | ((unsigned long long)d1 << 32));
            if (F.lane == 0) __hip_atomic_store(F.sv + e, unit, __ATOMIC_RELAXED, __HIP_MEMORY_SCOPE_AGENT);
        }
      }
    }
}

__device__ __forceinline__ unsigned q8x4(const f32x4 v, float qs) {
    const int a = (int)__builtin_rintf(v.x * qs), b = (int)__builtin_rintf(v.y * qs), c = (int)__builtin_rintf(v.z * qs), d = (int)__builtin_rintf(v.w * qs);
    return ((unsigned)a & 0xffu) | (((unsigned)b & 0xffu) << 8) | (((unsigned)c & 0xffu) << 16) | ((unsigned)d << 24);
}
__device__ __forceinline__ unsigned q8x4c(const f32x4 v, float qs) {
    const int a = (int)fminf(fmaxf(__builtin_rintf(v.x * qs), -127.f), 127.f), b = (int)fminf(fmaxf(__builtin_rintf(v.y * qs), -127.f), 127.f);
    const int c = (int)fminf(fmaxf(__builtin_rintf(v.z * qs), -127.f), 127.f), d = (int)fminf(fmaxf(__builtin_rintf(v.w * qs), -127.f), 127.f);
    return ((unsigned)a & 0xffu) | (((unsigned)b & 0xffu) << 8) | (((unsigned)c & 0xffu) << 16) | ((unsigned)d << 24);
}
__device__ __forceinline__ void p1_hnorm(Frame& F) {
    const int gwv = blockIdx.x * NWAVES + F.wave, NGW = F.G * NWAVES;
    for (int m0 = gwv * 4; m0 < M; m0 += NGW * 4) {
        const int b = m0 >> 12;
        f32x4 v[4][4];
#pragma unroll
        for (int r = 0; r < 4; ++r) { const GAS f32x4* xr = (const GAS f32x4*)(F.x + (size_t)(m0 + r) * D) + F.lane;
#pragma unroll
            for (int j = 0; j < 4; ++j) v[r][j] = xr[64 * j]; }
        f32x4 gs[4], sh[4];
#pragma unroll
        for (int j = 0; j < 4; ++j) { const int col = 4 * F.lane + 256 * j;
            gs[j] = *(const GAS f32x4*)(F.pre_gain + col) * (*(const GAS f32x4*)(F.mod + b * 6144 + 1024 + col) + 1.f); sh[j] = *(const GAS f32x4*)(F.mod + b * 6144 + col); }
#pragma unroll
        for (int r = 0; r < 4; ++r) {
            float ss = 0.f;
#pragma unroll
            for (int j = 0; j < 4; ++j) ss += (v[r][j].x * v[r][j].x + v[r][j].y * v[r][j].y) + (v[r][j].z * v[r][j].z + v[r][j].w * v[r][j].w);
            const float rstd = rsqrtf(wave_sum(ss) * (1.f / D) + EPS);
            f32x4 o[4]; float am = 0.f;
#pragma unroll
            for (int j = 0; j < 4; ++j) { o[j] = v[r][j] * rstd * gs[j] + sh[j]; am = fmaxf(am, fmaxf(fmaxf(fabsf(o[j].x), fabsf(o[j].y)), fmaxf(fabsf(o[j].z), fabsf(o[j].w)))); }
#pragma unroll
            for (int of = 1; of < 64; of <<= 1) am = fmaxf(am, __shfl_xor(am, of));
            const float qs = am > 0.f ? 127.f / am : 0.f;
            v4u w; w.x = q8x4(o[0], qs); w.y = q8x4(o[1], qs); w.z = q8x4(o[2], qs); w.w = q8x4(o[3], qs);
            st16_wt((void*)((unsigned char*)F.H + (size_t)(m0 + r) * D + 16 * F.lane), w);
            if (F.lane == 0) __hip_atomic_store(F.rs + m0 + r, am * (1.f / 127.f), __ATOMIC_RELAXED, __HIP_MEMORY_SCOPE_AGENT);
        }
    }
    for (int n = gwv; n < NIN; n += NGW) {
        const GAS unsigned long long* src = (const GAS unsigned long long*)(F.WinT + (size_t)n * D) + F.lane;
        unsigned long long q[4];
#pragma unroll
        for (int j = 0; j < 4; ++j) q[j] = src[64 * j];
        f32x4 wv[4]; float am = 0.f;
#pragma unroll
        for (int j = 0; j < 4; ++j) { const unsigned lo = (unsigned)q[j], hi = (unsigned)(q[j] >> 32); wv[j] = (f32x4){bflo(lo), bfhi(lo), bflo(hi), bfhi(hi)};
            am = fmaxf(am, fmaxf(fmaxf(fabsf(wv[j].x), fabsf(wv[j].y)), fmaxf(fabsf(wv[j].z), fabsf(wv[j].w)))); }
#pragma unroll
        for (int of = 1; of < 64; of <<= 1) am = fmaxf(am, __shfl_xor(am, of));
        const float qs = am > 0.f ? 127.f / am : 0.f;
        v4u w; w.x = q8x4(wv[0], qs); w.y = q8x4(wv[1], qs); w.z = q8x4(wv[2], qs); w.w = q8x4(wv[3], qs);
        st16_wt((void*)(F.Win8 + (size_t)n * D + 16 * F.lane), w);
        if (F.lane == 0) __hip_atomic_store((unsigned*)(F.ctl + CW_CMAX + n), __float_as_uint(am), __ATOMIC_RELAXED, __HIP_MEMORY_SCOPE_AGENT);
    }
    f32x4 gk[4];
#pragma unroll
    for (int i = 0; i < 4; ++i) gk[i] = *(const GAS f32x4*)(F.group_gain + 16 * F.lane + 4 * i) * (1.f / YQ);
    for (int n = gwv; n < NQ + D; n += NGW) {
        const bool isq = n < NQ; const int nn = isq ? n : n - NQ;
        const GAS v4u* src = (const GAS v4u*)((isq ? F.WqT : F.WoT) + (size_t)nn * D + 16 * F.lane);
        const v4u q0 = src[0], q1 = src[1];
        f32x4 wv[4] = {(f32x4){bflo(q0.x), bfhi(q0.x), bflo(q0.y), bfhi(q0.y)}, (f32x4){bflo(q0.z), bfhi(q0.z), bflo(q0.w), bfhi(q0.w)}, (f32x4){bflo(q1.x), bfhi(q1.x), bflo(q1.y), bfhi(q1.y)}, (f32x4){bflo(q1.z), bfhi(q1.z), bflo(q1.w), bfhi(q1.w)}};
        float am = 0.f;
#pragma unroll
        for (int j = 0; j < 4; ++j) { if (!isq) wv[j] = wv[j] * gk[j]; am = fmaxf(am, fmaxf(fmaxf(fabsf(wv[j].x), fabsf(wv[j].y)), fmaxf(fabsf(wv[j].z), fabsf(wv[j].w)))); }
#pragma unroll
        for (int of = 1; of < 64; of <<= 1) am = fmaxf(am, __shfl_xor(am, of));
        const float qs = am > 0.f ? 127.f / am : 0.f;
        v4u w; w.x = q8x4(wv[0], qs); w.y = q8x4(wv[1], qs); w.z = q8x4(wv[2], qs); w.w = q8x4(wv[3], qs);
        st16_wt((void*)((isq ? F.Wq8 : F.Wo8) + (size_t)nn * D + 16 * F.lane), w);
        if (F.lane == 0) __hip_atomic_store((unsigned*)(F.ctl + (isq ? CW_CMAX2 : CW_CMAX3) + nn), __float_as_uint(am), __ATOMIC_RELAXED, __HIP_MEMORY_SCOPE_AGENT);
    }
}

__device__ __forceinline__ void unpack8(const v4u w, float* f) { f[0] = bflo(w.x); f[1] = bfhi(w.x); f[2] = bflo(w.y); f[3] = bfhi(w.y); f[4] = bflo(w.z); f[5] = bfhi(w.z); f[6] = bflo(w.w); f[7] = bfhi(w.w); }
__device__ __forceinline__ void p6_conv(Frame& F) {
    const int gwv = blockIdx.x * NWAVES + F.wave, NGW = F.G * NWAVES;
    const int col = 8 * F.lane;
    float cw[3][8], gg[8];
#pragma unroll
    for (int j = 0; j < 3; ++j)
#pragma unroll
        for (int i = 0; i < 8; ++i) cw[j][i] = F.conv_w[j * 512 + col + i];
#pragma unroll
    for (int i = 0; i < 8; ++i) gg[i] = F.group_gain[col + i];
    for (int t0 = gwv * 4; t0 < M; t0 += NGW * 4) {
        const int s0 = t0 & 4095;
        v4u gbw[4], gcw[6], hxw[6];
#pragma unroll
        for (int r = 0; r < 4; ++r) gbw[r] = *(const GAS v4u*)(F.P + (size_t)(t0 + r) * NIN + col);
#pragma unroll
        for (int k = 0; k < 6; ++k) { const int tt = (s0 == 0 && k < 2) ? t0 : (t0 - 2 + k);
            const bf16* rp = F.P + (size_t)tt * NIN + col; gcw[k] = *(const GAS v4u*)(rp + 512); hxw[k] = *(const GAS v4u*)(rp + 1024); }
        float u[6][8];
#pragma unroll
        for (int k = 0; k < 6; ++k) { float gc[8], hx[8]; unpack8(gcw[k], gc); unpack8(hxw[k], hx); const float keep = (s0 == 0 && k < 2) ? 0.f : 1.f;
#pragma unroll
            for (int i = 0; i < 8; ++i) u[k][i] = keep * gc[i] * hx[i]; }
#pragma unroll
        for (int r = 0; r < 4; ++r) {
            float acc[8], gb[8]; unpack8(gbw[r], gb);
            float ss = 0.f;
#pragma unroll
            for (int i = 0; i < 8; ++i) { acc[i] = gb[i] * (cw[0][i] * u[r][i] + cw[1][i] * u[r + 1][i] + cw[2][i] * u[r + 2][i]); ss += acc[i] * acc[i]; }
            ss += __shfl_xor(ss, 1); ss += __shfl_xor(ss, 2); ss += __shfl_xor(ss, 4);
            const float rstd = rsqrtf(ss * (1.f / 64.f) + EPS);
            const float qn = rstd * YQ;
            const unsigned w0 = q8x4c((f32x4){acc[0], acc[1], acc[2], acc[3]}, qn), w1 = q8x4c((f32x4){acc[4], acc[5], acc[6], acc[7]}, qn);
            st8_wt((void*)((unsigned char*)F.Y + (size_t)(t0 + r) * D + col), (unsigned long long)w0 | ((unsigned long long)w1 << 32));
        }
    }
}
__device__ __forceinline__ void p8_resid(Frame& F) {
    const int gwv = blockIdx.x * NWAVES + F.wave, NGW = F.G * NWAVES;
    for (int m0 = gwv * 2; m0 < M; m0 += NGW * 2) {
        const float* md = F.mod + (m0 >> 12) * 6144;
        unsigned long long ow[2][4]; f32x4 xv[2][4];
#pragma unroll
        for (int r = 0; r < 2; ++r) {
            const GAS unsigned long long* orow = (const GAS unsigned long long*)(F.O + (size_t)(m0 + r) * D) + F.lane; const GAS f32x4* xr = (const GAS f32x4*)(F.x + (size_t)(m0 + r) * D) + F.lane;
#pragma unroll
            for (int j = 0; j < 4; ++j) { ow[r][j] = orow[64 * j]; xv[r][j] = xr[64 * j]; } }
        f32x4 gg[4], gs[4], sh[4];
#pragma unroll
        for (int j = 0; j < 4; ++j) { const int col = 4 * F.lane + 256 * j;
            gg[j] = *(const GAS f32x4*)(F.post_gain + col) * *(const GAS f32x4*)(md + 2048 + col);
            gs[j] = *(const GAS f32x4*)(F.fpre_gain + col) * (*(const GAS f32x4*)(md + 4096 + col) + 1.f); sh[j] = *(const GAS f32x4*)(md + 3072 + col); }
#pragma unroll
        for (int r = 0; r < 2; ++r) { const int m = m0 + r;
            f32x4 ov[4]; float ss = 0.f;
#pragma unroll
            for (int j = 0; j < 4; ++j) { const unsigned lo = (unsigned)ow[r][j], hi = (unsigned)(ow[r][j] >> 32); ov[j] = (f32x4){bflo(lo), bfhi(lo), bflo(hi), bfhi(hi)};
                ss += (ov[j].x * ov[j].x + ov[j].y * ov[j].y) + (ov[j].z * ov[j].z + ov[j].w * ov[j].w); }
            const float rstd = rsqrtf(wave_sum(ss) * (1.f / D) + EPS);
            GAS unsigned long long* x1r = (GAS unsigned long long*)(F.QP + (size_t)m * D) + F.lane;
            f32x4 x1[4]; float s2 = 0.f;
#pragma unroll
            for (int j = 0; j < 4; ++j) { x1[j] = xv[r][j] + gg[j] * (ov[j] * rstd); st8_wt((void*)(x1r + 64 * j), (unsigned long long)pk2(x1[j].x, x1[j].y) | ((unsigned long long)pk2(x1[j].z, x1[j].w) << 32));
                s2 += (x1[j].x * x1[j].x + x1[j].y * x1[j].y) + (x1[j].z * x1[j].z + x1[j].w * x1[j].w); }
            const float rstd2 = rsqrtf(wave_sum(s2) * (1.f / D) + EPS);
            f32x4 o[4]; float am = 0.f;
#pragma unroll
            for (int j = 0; j < 4; ++j) { o[j] = x1[j] * rstd2 * gs[j] + sh[j]; am = fmaxf(am, fmaxf(fmaxf(fabsf(o[j].x), fabsf(o[j].y)), fmaxf(fabsf(o[j].z), fabsf(o[j].w)))); }
#pragma unroll
            for (int of = 1; of < 64; of <<= 1) am = fmaxf(am, __shfl_xor(am, of));
            const float qs = am > 0.f ? 119.f / am : 0.f;
#pragma unroll
            for (int j = 0; j < 4; ++j) st4_wt((void*)((unsigned char*)F.H + (size_t)m * D + 4 * F.lane + 256 * j), q8x4(o[j], qs));
            if (F.lane == 0) __hip_atomic_store(F.rs2 + m, am * (1.f / 119.f), __ATOMIC_RELAXED, __HIP_MEMORY_SCOPE_AGENT);
        }
    }
}
typedef float f32x16 __attribute__((ext_vector_type(16)));
__device__ __forceinline__ float vmaxf(float a, float b) { float r; asm("v_max_f32_e32 %0, %1, %2" : "=v"(r) : "v"(a), "v"(b)); return r; }
__device__ __forceinline__ float vminf(float a, float b) { float r; asm("v_min_f32_e32 %0, %1, %2" : "=v"(r) : "v"(a), "v"(b)); return r; }
#define CE_D(a, b) do { const float hi_ = vmaxf(a, b), lo_ = vminf(a, b); a = hi_; b = lo_; } while (0)
template <int N> __device__ __forceinline__ void bitonic_sort_desc(float (&v)[N]) {
#pragma unroll
    for (int k = 2; k <= N; k <<= 1)
#pragma unroll
        for (int j = k >> 1; j > 0; j >>= 1)
#pragma unroll
            for (int i = 0; i < N; ++i) { const int l = i ^ j; if (l > i) { if ((i & k) == 0) CE_D(v[i], v[l]); else CE_D(v[l], v[i]); } }
}
template <int N> __device__ __forceinline__ void bitonic_merge_desc(float (&v)[N]) {
#pragma unroll
    for (int j = N >> 1; j > 0; j >>= 1)
#pragma unroll
        for (int i = 0; i < N; ++i) { const int l = i ^ j; if (l > i) CE_D(v[i], v[l]); }
}
__device__ __forceinline__ void sort16_desc(float (&v)[16]) {
    CE_D(v[0], v[1]); CE_D(v[2], v[3]); CE_D(v[0], v[2]); CE_D(v[1], v[3]); CE_D(v[1], v[2]); CE_D(v[4], v[5]); CE_D(v[6], v[7]); CE_D(v[4], v[6]); CE_D(v[5], v[7]); CE_D(v[5], v[6]); CE_D(v[0], v[4]); CE_D(v[2], v[6]); CE_D(v[2], v[4]); CE_D(v[1], v[5]); CE_D(v[3], v[7]); CE_D(v[3], v[5]); CE_D(v[1], v[2]); CE_D(v[3], v[4]); CE_D(v[5], v[6]); CE_D(v[8], v[9]); CE_D(v[10], v[11]); CE_D(v[8], v[10]); CE_D(v[9], v[11]); CE_D(v[9], v[10]); CE_D(v[12], v[13]); CE_D(v[14], v[15]); CE_D(v[12], v[14]); CE_D(v[13], v[15]); CE_D(v[13], v[14]); CE_D(v[8], v[12]); CE_D(v[10], v[14]); CE_D(v[10], v[12]); CE_D(v[9], v[13]); CE_D(v[11], v[15]); CE_D(v[11], v[13]); CE_D(v[9], v[10]); CE_D(v[11], v[12]); CE_D(v[13], v[14]); CE_D(v[0], v[8]); CE_D(v[4], v[12]); CE_D(v[4], v[8]); CE_D(v[2], v[10]); CE_D(v[6], v[14]); CE_D(v[6], v[10]); CE_D(v[2], v[4]); CE_D(v[6], v[8]); CE_D(v[10], v[12]); CE_D(v[1], v[9]); CE_D(v[5], v[13]); CE_D(v[5], v[9]); CE_D(v[3], v[11]); CE_D(v[7], v[15]); CE_D(v[7], v[11]); CE_D(v[3], v[5]); CE_D(v[7], v[9]); CE_D(v[11], v[13]); CE_D(v[1], v[2]); CE_D(v[3], v[4]); CE_D(v[5], v[6]); CE_D(v[7], v[8]); CE_D(v[9], v[10]); CE_D(v[11], v[12]); CE_D(v[13], v[14]);
}
__device__ __forceinline__ void top16_merge(float (&a)[16], const float (&b)[16]) {
#pragma unroll
    for (int i = 0; i < 16; ++i) a[i] = vmaxf(a[i], b[15 - i]);
    bitonic_merge_desc<16>(a);
}
__device__ __forceinline__ void top16_of_64(const float (&v)[64], float (&out)[16]) {
    float g1[16], g2[16], g3[16];
#pragma unroll
    for (int i = 0; i < 16; ++i) { out[i] = v[i]; g1[i] = v[16 + i]; g2[i] = v[32 + i]; g3[i] = v[48 + i]; }
    sort16_desc(out); sort16_desc(g1); sort16_desc(g2); sort16_desc(g3);
    top16_merge(out, g1); top16_merge(g2, g3); top16_merge(out, g2);
}
constexpr int KROW = 272, KIMG = 128 * KROW;
__device__ __forceinline__ void route_half(const bf16x8 (&bq)[8], const LAS unsigned char* kimg, int r32, int hh, float (&svp)[16], unsigned (&ivp)[16]) {
    const LAS unsigned char* krow = kimg + r32 * KROW + 16 * hh;
    f32x16 acc[4];
#pragma unroll
    for (int nt = 0; nt < 4; ++nt) {
        acc[nt] = (f32x16){0.f, 0.f, 0.f, 0.f, 0.f, 0.f, 0.f, 0.f, 0.f, 0.f, 0.f, 0.f, 0.f, 0.f, 0.f, 0.f};
#pragma unroll
        for (int ks = 0; ks < 8; ++ks) { const bf16x8 ak = *(const LAS bf16x8*)(krow + nt * 32 * KROW + 32 * ks);
            acc[nt] = __builtin_amdgcn_mfma_f32_32x32x16_bf16(ak, bq[ks], acc[nt], 0, 0, 0); }
    }
    float v[64];
#pragma unroll
    for (int nt = 0; nt < 4; ++nt)
#pragma unroll
        for (int i = 0; i < 16; ++i) { const unsigned code = (unsigned)(32 * nt + 8 * (i >> 2) + (i & 3)); v[nt * 16 + i] = __uint_as_float((__float_as_uint(acc[nt][i]) & ~127u) | code); }
    float L[16], Pn[16];
    top16_of_64(v, L);
#pragma unroll
    for (int i = 0; i < 16; ++i) { L[i] = __uint_as_float(__float_as_uint(L[i]) | (unsigned)(hh << 2)); Pn[i] = __shfl_xor(L[i], 32); }
    top16_merge(L, Pn);
#pragma unroll
    for (int i = 0; i < 16; ++i) { const unsigned bits = __float_as_uint(L[i]); svp[i] = __uint_as_float(bits & ~127u); ivp[i] = bits & 127u; }
}
__device__ __forceinline__ void route_finish(const float (&sv)[2][16], const unsigned (&iv)[2][16], LAS unsigned* tab, int lane, int hh, int* epi, float* gpf, float rst) {
#define CAND(a, b) __uint_as_float((__float_as_uint(sv[0][a] + sv[1][b]) & ~255u) | (unsigned)((a) * 16 + (b)))
    float W[16], g1[16], g2[16];
#pragma unroll
    for (int i = 0; i < 16; ++i) W[i] = CAND(0, i);
#pragma unroll
    for (int i = 0; i < 15; ++i) g1[i] = CAND(i + 1, 0);
    g1[15] = -3e38f;
    g2[0] = CAND(1, 1); g2[1] = CAND(1, 2); g2[2] = CAND(1, 3); g2[3] = CAND(1, 4); g2[4] = CAND(1, 5); g2[5] = CAND(1, 6); g2[6] = CAND(1, 7);
    g2[7] = CAND(2, 1); g2[8] = CAND(2, 2); g2[9] = CAND(2, 3); g2[10] = CAND(2, 4); g2[11] = CAND(3, 1); g2[12] = CAND(3, 2); g2[13] = CAND(3, 3); g2[14] = CAND(4, 1); g2[15] = CAND(4, 2);
    sort16_desc(g2);
    g2[13] = vmaxf(g2[13], CAND(7, 1)); g2[14] = vmaxf(g2[14], CAND(6, 1)); g2[15] = vmaxf(g2[15], CAND(5, 1));
    bitonic_merge_desc<16>(g2);
    top16_merge(W, g1); top16_merge(W, g2);
#undef CAND
#pragma unroll
    for (int j = 0; j < 16; ++j) { tab[j * 64 + lane] = iv[0][j]; tab[(16 + j) * 64 + lane] = iv[1][j]; }
    float e[16], sum = 0.f; unsigned ex[16];
    const float s0 = __uint_as_float(__float_as_uint(W[0]) & ~255u);
#pragma unroll
    for (int j = 0; j < 16; ++j) { const unsigned bits = __float_as_uint(W[j]); const unsigned code = bits & 255u;
        e[j] = __expf((__uint_as_float(bits & ~255u) - s0) * rst); sum += e[j];
        ex[j] = tab[(code >> 4) * 64 + lane] * 128u + tab[(16 + (code & 15u)) * 64 + lane]; }
    const float inv = 1.f / sum;
    v4u eo0, eo1; f32x4 go0, go1;
    eo0.x = hh ? ex[8] : ex[0]; eo0.y = hh ? ex[9] : ex[1]; eo0.z = hh ? ex[10] : ex[2]; eo0.w = hh ? ex[11] : ex[3];
    eo1.x = hh ? ex[12] : ex[4]; eo1.y = hh ? ex[13] : ex[5]; eo1.z = hh ? ex[14] : ex[6]; eo1.w = hh ? ex[15] : ex[7];
    go0.x = (hh ? e[8] : e[0]) * inv; go0.y = (hh ? e[9] : e[1]) * inv; go0.z = (hh ? e[10] : e[2]) * inv; go0.w = (hh ? e[11] : e[3]) * inv;
    go1.x = (hh ? e[12] : e[4]) * inv; go1.y = (hh ? e[13] : e[5]) * inv; go1.z = (hh ? e[14] : e[6]) * inv; go1.w = (hh ? e[15] : e[7]) * inv;
    GAS v4u* ep = (GAS v4u*)epi; GAS f32x4* gp = (GAS f32x4*)gpf;
    st16_wt((void*)ep, eo0); st16_wt((void*)(ep + 1), eo1); st16_wt((void*)gp, __builtin_bit_cast(wt_v4u, go0)); st16_wt((void*)(gp + 1), __builtin_bit_cast(wt_v4u, go1));
}
__device__ __forceinline__ pg8::f32x4 i2f(const pg8::f32x4 a) { const pg8::i32x4 i = __builtin_bit_cast(pg8::i32x4, a); return (pg8::f32x4){(float)i[0], (float)i[1], (float)i[2], (float)i[3]}; }
struct EpiRoute {
    static constexpr bool PERM = true, AFTER_DRAIN = true;
    const bf16* keysb; int* eidx; float* gw; const unsigned* cmax2; const float* rs2;
    __device__ __forceinline__ void fused(pg8::f32x4 (&acc)[2][2][4][2], const pg8::Unit& u, int wr, int wc, int fr, int fq, LAS unsigned char* lds, int wid, int lane) const {
        int tid_ = threadIdx.x; asm volatile("" : "+v"(tid_)); const int h = u.pn, r32 = lane & 31, hh = lane >> 5, tid = tid_;
        LAS unsigned char* Qs = lds; LAS unsigned char* Ks = lds + 256 * KROW;
        const float rst = rs2[u.pm * 256 + 32 * wid + r32];
        v4u q1[2][4];
#pragma unroll
        for (int ai = 0; ai < 2; ++ai)
#pragma unroll
            for (int m = 0; m < 4; ++m) { const pg8::f32x4 a = i2f(acc[ai][1][m][0]), b = i2f(acc[ai][1][m][1]);
                q1[ai][m] = (v4u){pg8::cvt_pk_bf16(a[0], a[1]), pg8::cvt_pk_bf16(a[2], a[3]), pg8::cvt_pk_bf16(b[0], b[1]), pg8::cvt_pk_bf16(b[2], b[3])}; }
        float sv[2][16]; unsigned iv[2][16];
#pragma unroll
        for (int p = 0; p < 2; ++p) {
            if (p == 1) { asm volatile("s_waitcnt lgkmcnt(0)" ::: "memory"); __builtin_amdgcn_s_barrier(); asm volatile("" ::: "memory"); }
#pragma unroll
            for (int ai = 0; ai < 2; ++ai)
#pragma unroll
                for (int m = 0; m < 4; ++m) { v4u w;
                    if (p == 0) { const pg8::f32x4 a = i2f(acc[ai][0][m][0]), b = i2f(acc[ai][0][m][1]);
                        w = (v4u){pg8::cvt_pk_bf16(a[0], a[1]), pg8::cvt_pk_bf16(a[2], a[3]), pg8::cvt_pk_bf16(b[0], b[1]), pg8::cvt_pk_bf16(b[2], b[3])}; }
                    else w = q1[ai][m];
                    *(LAS v4u*)(Qs + (128 * ai + 64 * wr + 16 * m + fr) * KROW + (32 * wc + 8 * fq) * 2) = w; }
            { const int ch = tid & 15, kr = tid >> 4;
              const pg8::u32x4 c0 = *(const pg8::u32x4*)(cmax2 + h * 256 + p * 128 + ch * 8), c1 = *(const pg8::u32x4*)(cmax2 + h * 256 + p * 128 + ch * 8 + 4);
              v4u kq[4];
#pragma unroll
              for (int i = 0; i < 4; ++i) kq[i] = *(const GAS v4u*)(keysb + (size_t)((h * 2 + p) * 128 + kr + 32 * i) * 128 + ch * 8);
              float cs[8] = {__uint_as_float(c0.x), __uint_as_float(c0.y), __uint_as_float(c0.z), __uint_as_float(c0.w), __uint_as_float(c1.x), __uint_as_float(c1.y), __uint_as_float(c1.z), __uint_as_float(c1.w)};
#pragma unroll
              for (int i = 0; i < 8; ++i) cs[i] *= (1.f / 127.f);
#pragma unroll
              for (int i = 0; i < 4; ++i) { const v4u q = kq[i];
                v4u ko; ko.x = pk2(bflo(q.x) * cs[0], bfhi(q.x) * cs[1]); ko.y = pk2(bflo(q.y) * cs[2], bfhi(q.y) * cs[3]); ko.z = pk2(bflo(q.z) * cs[4], bfhi(q.z) * cs[5]); ko.w = pk2(bflo(q.w) * cs[6], bfhi(q.w) * cs[7]);
                *(LAS v4u*)(Ks + (kr + 32 * i) * KROW + ch * 16) = ko; } }
            asm volatile("s_waitcnt vmcnt(0) lgkmcnt(0)" ::: "memory"); __builtin_amdgcn_s_barrier(); asm volatile("" ::: "memory");
            bf16x8 bq[8];
#pragma unroll
            for (int ks = 0; ks < 8; ++ks) bq[ks] = *(const LAS bf16x8*)(Qs + (32 * wid + r32) * KROW + 32 * ks + 16 * hh);
            route_half(bq, Ks, r32, hh, sv[p], iv[p]);
        }
        asm volatile("s_waitcnt lgkmcnt(0)" ::: "memory"); __builtin_amdgcn_s_barrier(); asm volatile("" ::: "memory");
        const int t = u.pm * 256 + 32 * wid + r32;
        route_finish(sv, iv, (LAS unsigned*)(lds + wid * 8192), lane, hh, eidx + (size_t)t * 128 + h * 16 + 8 * hh, gw + (size_t)t * 128 + h * 16 + 8 * hh, rst);
        asm volatile("s_waitcnt lgkmcnt(0)" ::: "memory"); __builtin_amdgcn_s_barrier(); asm volatile("" ::: "memory");
    }
};
struct OneUnit {
    pg8::Unit u;
    __device__ __forceinline__ bool next(int i, pg8::Unit& o) const { if (i != 0) return false; o = u; return true; }
    __device__ __forceinline__ void a_ready(const pg8::Unit&) const {}
    __device__ __forceinline__ void done(const pg8::Unit&) const {}
};
__device__ __forceinline__ float gelu_tanh(float a) {
    const float z = 0.7978845608028654f * (a + 0.044715f * a * a * a);
    const float e = __expf(2.f * z);
    const float th = 1.f - 2.f / (e + 1.f);
    return 0.5f * a * (1.f + th);
}
typedef float f32x2v __attribute__((ext_vector_type(2)));
__device__ __forceinline__ void fp8x16_to_f32(const v4u w, float* f) {
    f32x2v t;
    t = __builtin_amdgcn_cvt_pk_f32_fp8((int)w.x, false); f[0] = t.x; f[1] = t.y; t = __builtin_amdgcn_cvt_pk_f32_fp8((int)w.x, true); f[2] = t.x; f[3] = t.y;
    t = __builtin_amdgcn_cvt_pk_f32_fp8((int)w.y, false); f[4] = t.x; f[5] = t.y; t = __builtin_amdgcn_cvt_pk_f32_fp8((int)w.y, true); f[6] = t.x; f[7] = t.y;
    t = __builtin_amdgcn_cvt_pk_f32_fp8((int)w.z, false); f[8] = t.x; f[9] = t.y; t = __builtin_amdgcn_cvt_pk_f32_fp8((int)w.z, true); f[10] = t.x; f[11] = t.y;
    t = __builtin_amdgcn_cvt_pk_f32_fp8((int)w.w, false); f[12] = t.x; f[13] = t.y; t = __builtin_amdgcn_cvt_pk_f32_fp8((int)w.w, true); f[14] = t.x; f[15] = t.y;
}
#define DPPF(x, ctrl) __uint_as_float((unsigned)__builtin_amdgcn_mov_dpp((int)__float_as_uint(x), ctrl, 0xf, 0xf, true))
__device__ __forceinline__ void swap16_add(float& a, float b) { auto r = __builtin_amdgcn_permlane16_swap(__float_as_uint(a), __float_as_uint(b), false, false); a = __uint_as_float(r[0]) + __uint_as_float(r[1]); }
__device__ __forceinline__ void swap32_add(float& a, float b) { auto r = __builtin_amdgcn_permlane32_swap(__float_as_uint(a), __float_as_uint(b), false, false); a = __uint_as_float(r[0]) + __uint_as_float(r[1]); }
constexpr int PW_BUF0 = 0, PW_SG = 4096, PW_BUF1 = 8192, PW_E = 16384, PW_WH = 17408, PW_WL = 17920, PW_YP = 18432, PW_IK = 18944, PW_BYTES = 18976;
static_assert(PW_BYTES * NWAVES <= LDSCTL_OFF, "PEER per-wave LDS blocks must stay below the control words");
typedef int v8i_t __attribute__((ext_vector_type(8)));
typedef int v2i_t __attribute__((ext_vector_type(2)));
__device__ __forceinline__ void peer_u_issue(v4u (&uw)[8], const unsigned char* U4, LAS unsigned char* wl, int it, int lane) {
    const int grp = it >> 2, j = it & 3, hw = lane >> 5, li = lane & 31;
#pragma unroll
    for (int q = 0; q < 8; ++q) { const unsigned e = *(const LAS unsigned short*)(wl + PW_E + (j * 128 + grp * 16 + 2 * q + hw) * 2);
        uw[q] = *(const GAS v4u*)(U4 + (e * 512u + 16u * (unsigned)li)); }
}
__device__ __forceinline__ void peer_u_compute(const v4u (&uw)[8], LAS unsigned char* wl, int it, int lane) {
    const int grp = it >> 2, j = it & 3, li = lane & 31;
    const v4u hh = *(LAS v4u*)(wl + j * 1024 + 16 * li), hl = *(LAS v4u*)(wl + j * 1024 + 512 + 16 * li);
    float pa[8];
#pragma unroll
    for (int q = 0; q < 8; ++q) {
        int dh = __builtin_amdgcn_sdot8((int)uw[q].x, (int)hh.x, 0, false); dh = __builtin_amdgcn_sdot8((int)uw[q].y, (int)hh.y, dh, false);
        dh = __builtin_amdgcn_sdot8((int)uw[q].z, (int)hh.z, dh, false); dh = __builtin_amdgcn_sdot8((int)uw[q].w, (int)hh.w, dh, false);
        int dl = __builtin_amdgcn_sdot8((int)uw[q].x, (int)hl.x, 0, false); dl = __builtin_amdgcn_sdot8((int)uw[q].y, (int)hl.y, dl, false);
        dl = __builtin_amdgcn_sdot8((int)uw[q].z, (int)hl.z, dl, false); dl = __builtin_amdgcn_sdot8((int)uw[q].w, (int)hl.w, dl, false);
        pa[q] = (float)(16 * dh + dl); }
    swap16_add(pa[0], pa[4]); swap16_add(pa[1], pa[5]); swap16_add(pa[2], pa[6]); swap16_add(pa[3], pa[7]);
#pragma unroll
    for (int i = 0; i < 4; ++i) { pa[i] += DPPF(pa[i], 0xB1); pa[i] += DPPF(pa[i], 0x4E); pa[i] += DPPF(pa[i], 0x141); pa[i] += DPPF(pa[i], 0x140); }
    if ((lane & 12) == 0) {
        const int q = lane & 3, r = lane >> 4;
        const int idx = j * 128 + grp * 16 + 2 * (q + 4 * (r & 1)) + (r >> 1);
        const f32x2v sg = *(const LAS f32x2v*)(wl + PW_SG + idx * 8);
        const float a = (q == 0 ? pa[0] : q == 1 ? pa[1] : q == 2 ? pa[2] : pa[3]) * sg.x;
        *(LAS float*)(wl + PW_BUF1 + idx * 4) = sg.y * gelu_tanh(a);
    }
}
__device__ __forceinline__ void peer_v_issue(const unsigned char* V8, LAS unsigned char* wl, unsigned lbase, int it, int lane, unsigned c16e, unsigned c16o) {
    const int sl = it >> 3, j = (it >> 1) & 3, hf = it & 1;
    const unsigned char* vbase = V8 + (size_t)sl * (NEXP * 128);
    const unsigned dst = lbase + PW_BUF0 + (it & 1) * 8192;
    unsigned go[8];
#pragma unroll
    for (int q = 0; q < 8; ++q) { const unsigned e = *(const LAS unsigned short*)(wl + PW_E + (j * 128 + 64 * hf + 8 * q + (lane >> 3)) * 2); go[q] = e * 128u + ((q & 1) ? c16o : c16e); }
#pragma unroll
    for (int q = 0; q < 8; ++q) attn_body::glds16s(vbase, go[q], (unsigned)__builtin_amdgcn_readfirstlane((int)(dst + q * 1024)));
}
__device__ __forceinline__ void peer_v_compute(LAS unsigned char* wl, f32x4 (&acc)[8], bf16* yrow0, int it, int lane) {
    const int sl = it >> 3, j = (it >> 1) & 3, hf = it & 1;
    const int m = lane & 15, kg = lane >> 4;
    const LAS unsigned char* wsrc = wl + ((m & 1) ? PW_WL : PW_WH) + j * 128 + 64 * hf + 16 * (kg & 1);
    const v4u a0 = *(const LAS v4u*)wsrc, a1 = *(const LAS v4u*)(wsrc + 32);
    const bool valid = (m < 4) && ((m >> 1) == (kg >> 1));
    v8i_t A;
    A[0] = valid ? (int)a0.x : 0; A[1] = valid ? (int)a0.y : 0; A[2] = valid ? (int)a0.z : 0; A[3] = valid ? (int)a0.w : 0;
    A[4] = valid ? (int)a1.x : 0; A[5] = valid ? (int)a1.y : 0; A[6] = valid ? (int)a1.z : 0; A[7] = valid ? (int)a1.w : 0;
    if (hf == 0) {
#pragma unroll
        for (int T = 0; T < 8; ++T) acc[T] = (f32x4){0.f, 0.f, 0.f, 0.f};
    }
    const LAS unsigned char* bb = wl + PW_BUF0 + (it & 1) * 8192 + (32 * (kg >> 1) + m) * 128 + 8 * (kg & 1);
    const unsigned x16 = (unsigned)(m >> 1) * 16u;
#pragma unroll
    for (int T = 0; T < 8; ++T) {
        const LAS unsigned char* p = bb + ((16u * T) ^ x16);
        const v2i_t b0 = __builtin_amdgcn_ds_read_tr4_b64_v2i32((LAS v2i_t*)p), b1 = __builtin_amdgcn_ds_read_tr4_b64_v2i32((LAS v2i_t*)(p + 2048));
        const v8i_t B = {b0.x, b0.y, b1.x, b1.y, 0, 0, 0, 0};
        acc[T] = __builtin_amdgcn_mfma_scale_f32_16x16x128_f8f6f4(A, B, acc[T], 0, 4, 0, 0x7f7f7f7f, 0, 0x7f7f7f7f);
    }
    if (hf == 1) {
        const float ik = *(const LAS float*)(wl + PW_IK + j * 4);
        LAS unsigned char* yp = lane < 16 ? wl + PW_YP + m * 2 : wl + PW_IK + 16;
        const int ystep = lane < 16 ? 1 : 0;
#pragma unroll
        for (int T = 0; T < 8; ++T) {
            *(LAS unsigned short*)(yp + ystep * (64 * T)) = (unsigned short)f2bf((acc[T][0] + acc[T][1]) * ik);
            *(LAS unsigned short*)(yp + ystep * (64 * T + 32)) = (unsigned short)f2bf((acc[T][2] + acc[T][3]) * ik);
        }
        asm volatile("" ::: "memory");
        const unsigned long long pk = *(const LAS unsigned long long*)(wl + PW_YP + 8 * lane);
        *(GAS unsigned long long*)(yrow0 + (size_t)j * D + 256 * sl + 4 * lane) = pk;
    }
}
__device__ __forceinline__ void p11_peer(Frame& F, float* dst) {
    const int gwv = blockIdx.x * NWAVES + F.wave, NGW = F.G * NWAVES, lane = F.lane;
    LAS unsigned char* wl = F.lds + F.wave * PW_BYTES;
    const unsigned lbase = (unsigned)__builtin_amdgcn_readfirstlane((int)(unsigned)(size_t)wl);
    const unsigned c16e = (unsigned)(((lane & 7) ^ (lane >> 4)) * 16), c16o = (unsigned)(((lane & 7) ^ (4 + (lane >> 4))) * 16);
    const unsigned char* U8 = F.U8; const unsigned char* V8 = F.V8;
    for (int t0 = gwv * 4; t0 < M; t0 += NGW * 4) {
        bf16* yrow0 = F.Y + (size_t)t0 * D;
#pragma unroll
        for (int j = 0; j < 4; ++j) {
            const int t = t0 + j;
            const v4u hq = *(const GAS v4u*)((const unsigned char*)F.H + (size_t)t * D + 16 * lane);
            const float hinv = F.rs2[t];
            const unsigned hw[4] = {hq.x, hq.y, hq.z, hq.w};
            unsigned hh0 = 0u, hh1 = 0u, hl0 = 0u, hl1 = 0u;
#pragma unroll
            for (int i = 0; i < 16; ++i) { const int hv_ = (int)(signed char)((hw[i >> 2] >> (8 * (i & 3))) & 0xffu); const int lo = ((hv_ + 8) & 15) - 8; const int hi = (hv_ - lo) >> 4;
                if (i < 8) { hh0 |= (unsigned)(hi & 15) << (4 * i); hl0 |= (unsigned)(lo & 15) << (4 * i); } else { hh1 |= (unsigned)(hi & 15) << (4 * (i - 8)); hl1 |= (unsigned)(lo & 15) << (4 * (i - 8)); } }
            *(LAS unsigned long long*)(wl + j * 1024 + 8 * lane) = (unsigned long long)hh0 | ((unsigned long long)hh1 << 32);
            *(LAS unsigned long long*)(wl + j * 1024 + 512 + 8 * lane) = (unsigned long long)hl0 | ((unsigned long long)hl1 << 32);
            const int e0 = F.eidx[(size_t)t * 128 + lane], e1 = F.eidx[(size_t)t * 128 + 64 + lane];
            const f32x2v sg0 = (f32x2v){F.su[e0] * hinv, F.gw[(size_t)t * 128 + lane] * F.sv[e0]}, sg1 = (f32x2v){F.su[e1] * hinv, F.gw[(size_t)t * 128 + 64 + lane] * F.sv[e1]};
            int base = 0;
#pragma unroll
            for (int sl = 0; sl < 4; ++sl) {
                const bool m0 = (e0 >> 12) == sl, m1 = (e1 >> 12) == sl;
                const unsigned long long b0 = __ballot(m0), b1 = __ballot(m1);
                const int c0 = __popcll(b0), c1 = __popcll(b1);
                const int p0 = j * 128 + base + __builtin_amdgcn_mbcnt_hi((unsigned)(b0 >> 32), __builtin_amdgcn_mbcnt_lo((unsigned)b0, 0));
                const int p1 = j * 128 + base + c0 + __builtin_amdgcn_mbcnt_hi((unsigned)(b1 >> 32), __builtin_amdgcn_mbcnt_lo((unsigned)b1, 0));
                if (m0) { *(LAS unsigned short*)(wl + PW_E + p0 * 2) = (unsigned short)e0; *(LAS f32x2v*)(wl + PW_SG + p0 * 8) = sg0; }
                if (m1) { *(LAS unsigned short*)(wl + PW_E + p1 * 2) = (unsigned short)e1; *(LAS f32x2v*)(wl + PW_SG + p1 * 8) = sg1; }
                base += c0 + c1;
            }
        }
        asm volatile("" ::: "memory");
        {
            v4u ua[8], ub[8];
            peer_u_issue(ua, U8, wl, 0, lane);
#pragma unroll 1
            for (int it = 0; it < 32; it += 2) {
                peer_u_issue(ub, U8, wl, it + 1, lane);
                __builtin_amdgcn_sched_barrier(0);
                peer_u_compute(ua, wl, it, lane);
                __builtin_amdgcn_sched_barrier(0);
                if (it + 2 < 32) peer_u_issue(ua, U8, wl, it + 2, lane);
                __builtin_amdgcn_sched_barrier(0);
                peer_u_compute(ub, wl, it + 1, lane);
                __builtin_amdgcn_sched_barrier(0);
            }
        }
#pragma unroll
        for (int j = 0; j < 4; ++j) {
            const float w0 = *(const LAS float*)(wl + PW_BUF1 + (j * 128 + lane) * 4), w1 = *(const LAS float*)(wl + PW_BUF1 + (j * 128 + 64 + lane) * 4);
            float mx = fmaxf(fabsf(w0), fabsf(w1));
#pragma unroll
            for (int o = 1; o < 64; o <<= 1) mx = fmaxf(mx, __shfl_xor(mx, o));
            int ex = (int)((__float_as_uint(mx) >> 23) & 0xffu); ex = ex < 30 ? 127 : ex;
            const float sc = __uint_as_float((unsigned)(127 + 7 + 127 - ex) << 23), isc = __uint_as_float((unsigned)(ex - 7) << 23);
            const float s0 = w0 * sc, s1 = w1 * sc;
            const int ph = __builtin_amdgcn_cvt_pk_fp8_f32(s0, s1, 0, false);
            const f32x2v hb = __builtin_amdgcn_cvt_pk_f32_fp8(ph, false);
            const int pl = __builtin_amdgcn_cvt_pk_fp8_f32(s0 - hb.x, s1 - hb.y, 0, false);
            *(LAS unsigned char*)(wl + PW_WH + j * 128 + lane) = (unsigned char)(ph & 0xff); *(LAS unsigned char*)(wl + PW_WH + j * 128 + 64 + lane) = (unsigned char)((ph >> 8) & 0xff);
            *(LAS unsigned char*)(wl + PW_WL + j * 128 + lane) = (unsigned char)(pl & 0xff); *(LAS unsigned char*)(wl + PW_WL + j * 128 + 64 + lane) = (unsigned char)((pl >> 8) & 0xff);
            if (lane == 0) *(LAS float*)(wl + PW_IK + j * 4) = isc;
        }
        v4u x1w[4][2];
#pragma unroll
        for (int j = 0; j < 4; ++j) { const GAS v4u* op = (const GAS v4u*)(F.QP + (size_t)(t0 + j) * D + 16 * lane); x1w[j][0] = op[0]; x1w[j][1] = op[1]; }
        asm volatile("s_waitcnt lgkmcnt(0)" ::: "memory");
        {
            f32x4 acc[8];
            peer_v_issue(V8, wl, lbase, 0, lane, c16e, c16o);
#pragma unroll 1
            for (int it = 0; it < 32; it += 2) {
                peer_v_issue(V8, wl, lbase, it + 1, lane, c16e, c16o);
                asm volatile("s_waitcnt vmcnt(8)" ::: "memory");
                peer_v_compute(wl, acc, yrow0, it, lane);
                asm volatile("s_waitcnt lgkmcnt(0)" ::: "memory");
                if (it + 2 < 32) { peer_v_issue(V8, wl, lbase, it + 2, lane, c16e, c16o); asm volatile("s_waitcnt vmcnt(8)" ::: "memory"); }
                else asm volatile("s_waitcnt vmcnt(0)" ::: "memory");
                peer_v_compute(wl, acc, yrow0, it + 1, lane);
                asm volatile("s_waitcnt lgkmcnt(0)" ::: "memory");
            }
        }
        asm volatile("s_waitcnt vmcnt(0)" ::: "memory");
#pragma unroll
        for (int j = 0; j < 4; ++j) {
            const int t = t0 + j, b = t >> 12;
            float yv[16];
            { const GAS v4u* yp = (const GAS v4u*)(yrow0 + (size_t)j * D + 16 * lane); const v4u y0 = yp[0], y1 = yp[1]; unpack8(y0, yv); unpack8(y1, yv + 8); }
            float ss = 0.f;
#pragma unroll
            for (int i = 0; i < 16; ++i) ss += yv[i] * yv[i];
            const float rstd = rsqrtf(wave_sum(ss) * (1.f / D) + EPS);
            GAS f32x4* dp = (GAS f32x4*)(dst + (size_t)t * D + 16 * lane);
            const GAS f32x4* gp = (const GAS f32x4*)(F.fpost_gain + 16 * lane);
            const GAS f32x4* g2p = (const GAS f32x4*)(F.mod + b * 6144 + 5120 + 16 * lane);
            float x1f[16]; unpack8(x1w[j][0], x1f); unpack8(x1w[j][1], x1f + 8);
#pragma unroll
            for (int i = 0; i < 4; ++i) { const f32x4 x1 = (f32x4){x1f[4 * i], x1f[4 * i + 1], x1f[4 * i + 2], x1f[4 * i + 3]}, g = gp[i], g2 = g2p[i];
                const f32x4 y = (f32x4){yv[4 * i], yv[4 * i + 1], yv[4 * i + 2], yv[4 * i + 3]};
                dp[i] = x1 + g2 * (y * rstd * g); }
        }
    }
}

__device__ __forceinline__ unsigned long long ldp(const Frame& F, int i) {
    volatile LAS unsigned* pt = (volatile LAS unsigned*)(F.lds + LDSCTL_OFF);
    const unsigned lo = pt[2 * i], hi = pt[2 * i + 1];
    return ((unsigned long long)(unsigned)__builtin_amdgcn_readfirstlane((int)hi) << 32) | (unsigned)__builtin_amdgcn_readfirstlane((int)lo);
}
__device__ __forceinline__ void load_frame(Frame& F) {
    F.lane = lane_id_fresh(); F.tid = F.wave * 64 + F.lane;
    F.x = (const float*)ldp(F, 0); F.c = (const float*)ldp(F, 1); F.ada_w = (const float*)ldp(F, 2); F.ada_b = (const float*)ldp(F, 3); F.pre_gain = (const float*)ldp(F, 4); F.post_gain = (const float*)ldp(F, 5);
    F.w_in = (const float*)ldp(F, 6); F.conv_w = (const float*)ldp(F, 7); F.group_gain = (const float*)ldp(F, 8); F.w_out = (const float*)ldp(F, 9); F.fpre_gain = (const float*)ldp(F, 10); F.fpost_gain = (const float*)ldp(F, 11);
    F.wq = (const float*)ldp(F, 12); F.keys = (const float*)ldp(F, 13); F.pu = (const float*)ldp(F, 14); F.pv = (const float*)ldp(F, 15);
    F.out = (float*)ldp(F, 16);
    unsigned char* ws = (unsigned char*)ldp(F, 17);
    F.ctl = (gu32*)(ws + WS_CTL);
    F.mod = (float*)(ws + WS_MOD); F.kmean = (float*)(ws + WS_KMEAN); F.keysb = (bf16*)(ws + WS_KEYS);
    F.WinT = (bf16*)(ws + WS_WIN); F.WoT = (bf16*)(ws + WS_WO); F.WqT = (bf16*)(ws + WS_WQ); F.eidx = (int*)(ws + WS_EIDX); F.gw = (float*)(ws + WS_G);
    F.U8 = ws + WS_U; F.V8 = ws + WS_V; F.su = (float*)(ws + WS_SU); F.sv = (float*)(ws + WS_SV); F.H = (bf16*)(ws + WS_H);
    F.P = (bf16*)(ws + WS_P); F.QP = (bf16*)(ws + WS_QP); F.O = (bf16*)(ws + WS_O); F.Y = (bf16*)(ws + WS_Y); F.scratch = (float*)(ws + WS_O); F.Win8 = ws + WS_WIN8; F.rs = (float*)(ws + WS_RS); F.Wq8 = ws + WS_WQ8; F.rs2 = (float*)(ws + WS_RS2); F.Wo8 = ws + WS_WO8;
}
struct Args { const float* in[16]; float* out; unsigned char* ws; int ph_lo, ph_hi; };
constexpr int NPHASE = 12;
template <unsigned PM> __global__ void __launch_bounds__(NWAVES * 64, 2) fwd_kernel(Args args) {
    extern __shared__ __attribute__((aligned(16))) unsigned char lds[];
    Frame F;
    F.lds = (LAS unsigned char*)lds;
    F.MISC = (volatile LAS unsigned*)(F.lds + MISC_OFF);
    F.tid = threadIdx.x; F.lane = F.tid & 63; F.wave = __builtin_amdgcn_readfirstlane(F.tid >> 6);
    F.G = gridDim.x;
    for (int u = F.tid; u < (LDS_BYTES - LDSCTL_OFF) / 4; u += NWAVES * 64) ((LAS unsigned*)(F.lds + LDSCTL_OFF))[u] = 0u;
    __syncthreads();
    if (F.tid == 0) { LAS unsigned long long* pt = (LAS unsigned long long*)(F.lds + LDSCTL_OFF);
#pragma unroll
        for (int i = 0; i < 16; ++i) pt[i] = (unsigned long long)args.in[i];
        pt[16] = (unsigned long long)args.out; pt[17] = (unsigned long long)args.ws; }
    __syncthreads();
    load_frame(F);
    const int lo = args.ph_lo, hi = args.ph_hi;
    const bool multi = (hi - lo) > 1;
    XcdBarrier bar; bar.bar = (unsigned*)(F.ctl + CW_BAR); bar.x = 0; bar.st = nullptr;
    if (multi) bar = xcd_barrier_post((unsigned*)(F.ctl + CW_BAR), F.MISC + 8);
#define IN(k) ((((PM) >> (k)) & 1u) && lo <= (k) && (k) < hi)
#define BOTH(k) (IN(k) && IN((k) + 1))
#ifndef SEAMREP
#define SEAMREP 1
#endif
#define SEAM(k) do { if (BOTH(k)) { for (int sr_ = 0; sr_ < SEAMREP; ++sr_) xcd_barrier(bar); } } while (0)
#ifndef REPMASK
#define REPMASK 0x000u
#endif
#define REPS(k) (1 + (int)(((REPMASK) >> (k)) & 1u))
    if (IN(0)) { load_frame(F); for (int r = 0; r < REPS(0); ++r) { p0_prep(F); __syncthreads(); } SEAM(0); }
    if (IN(1)) { load_frame(F); for (int r = 0; r < REPS(1); ++r) p1_hnorm(F); SEAM(1); }
    if (IN(2)) { load_frame(F);
        pg8::Gemm g{F.H, (const bf16*)F.Win8, M, NIN, D / 2}; pg8::StaticOrder So; So.init(M, NIN, F.G, (int)blockIdx.x);
        pg8::EpiBf16S<true> E{F.P, NIN, 6, 8, C2, F.kmean, 8, 10, F.rs, (const unsigned*)(F.ctl + CW_CMAX)};
        for (int r = 0; r < REPS(2); ++r) pg8::gemm_phase<pg8::EpiBf16S<true>, pg8::StaticOrder, true, true, false, true>(F.lds, g, So, E);
        if (IN(2) && IN(5)) { for (int sr_ = 0; sr_ < SEAMREP; ++sr_) xcd_barrier(bar); }
    }
    const bool stream_first = (((int)blockIdx.x >> 3) & 1) == 0;
    if (IN(5) && stream_first) { load_frame(F); p0_tables(F); }
    if (IN(6) && stream_first) { load_frame(F); p6_conv(F); }
    if (IN(5)) { load_frame(F);
        const attn_body::AttnTensors AT{(const attn_body::bf16*)(F.P + 1536), (const attn_body::bf16*)(F.P + 2048), (const attn_body::bf16*)(F.P + 2560), (attn_body::bf16*)((unsigned char*)F.Y + 512), F.kmean, F.group_gain + 512};
        const attn_body::StaticOrder So((int)F.G, (int)blockIdx.x);
        for (int r = 0; r < REPS(5); ++r) attn_body::attn_phase<attn_body::StaticOrder>((char*)lds, AT, So);
    }
    if (IN(6) && !stream_first) { load_frame(F); p6_conv(F); }
    if (IN(5) && !stream_first) { load_frame(F); p0_tables(F); }
    if (IN(6)) { SEAM(6); }
    if (IN(7)) { load_frame(F);
        pg8::Gemm g{F.Y, (const bf16*)F.Wo8, M, D, D / 2}; pg8::StaticOrder So; So.init(M, D, F.G, (int)blockIdx.x);
        pg8::EpiBf16S<true> E{F.O, D, 0, 0, 1.f, nullptr, 0, 0, nullptr, (const unsigned*)(F.ctl + CW_CMAX3)};
        for (int r = 0; r < REPS(7); ++r) pg8::gemm_phase<pg8::EpiBf16S<true>, pg8::StaticOrder, true, true, false, true>(F.lds, g, So, E);
        SEAM(7);
    }
    if (IN(8)) { load_frame(F); for (int r = 0; r < REPS(8); ++r) p8_resid(F); SEAM(8); }
    if (IN(9)) { load_frame(F);
        pg8::Gemm g{F.H, (const bf16*)F.Wq8, M, NQ, D / 2}; pg8::StaticOrder So; So.init(M, NQ, F.G, (int)blockIdx.x);
        EpiRoute E{F.keysb, F.eidx, F.gw, (const unsigned*)(F.ctl + CW_CMAX2), F.rs2};
        for (int r = 0; r < REPS(9); ++r)
            for (int i = 0; ; ++i) { OneUnit S1; if (!So.next(i, S1.u)) break; pg8::gemm_phase<EpiRoute, OneUnit, false, true, false, true>(F.lds, g, S1, E); }
        if (IN(9) && IN(11)) { for (int sr_ = 0; sr_ < SEAMREP; ++sr_) xcd_barrier(bar); }
    }
    if (IN(11)) { load_frame(F); if (REPS(11) > 1) p11_peer(F, F.scratch); p11_peer(F, F.out); }
#undef IN
#undef BOTH
#undef SEAM
}

#ifndef PMASK
#define PMASK 0xfffu
#endif
#ifndef N_LAUNCH_MODE
#define N_LAUNCH_MODE 1
#endif
template <unsigned PM> static bool set_lds() { return hipFuncSetAttribute((const void*)fwd_kernel<PM>, hipFuncAttributeMaxDynamicSharedMemorySize, LDS_BYTES) == hipSuccess; }
template <unsigned PM> static void launch1(int grid, hipStream_t stream, Args a) { hipLaunchKernelGGL(fwd_kernel<PM>, dim3(grid), dim3(NWAVES * 64), LDS_BYTES, stream, a); }
extern "C" void kernel_launch(void* const* d_in, const int* in_sizes, int n_in, void* d_out, int out_size, void* d_ws, size_t ws_size, hipStream_t stream) {
    static int grid = 0;
    if (grid == 0) {
        if (n_in != 16 || out_size != M * D || ws_size < WS_END) { fprintf(stderr, "kernel_launch: unexpected shapes n_in %d out %d ws %zu\n", n_in, out_size, ws_size); grid = -1; return; }
        int dev = 0, cus = 0;
        if (hipGetDevice(&dev) != hipSuccess || hipDeviceGetAttribute(&cus, hipDeviceAttributeMultiprocessorCount, dev) != hipSuccess) { grid = -1; return; }
        bool ok = true;
#if N_LAUNCH_MODE == 1
        ok = set_lds<PMASK>();
#elif N_LAUNCH_MODE == 3
        ok = set_lds<0x3ffu>() && set_lds<0x400u>() && set_lds<0x800u>();
#else
        ok = set_lds<1u>() && set_lds<2u>() && set_lds<4u>() && set_lds<8u>() && set_lds<16u>() && set_lds<32u>() && set_lds<64u>() && set_lds<128u>() && set_lds<256u>() && set_lds<512u>() && set_lds<1024u>() && set_lds<2048u>();
#endif
        if (!ok) { fprintf(stderr, "kernel_launch: hipFuncSetAttribute failed\n"); grid = -1; return; }
        grid = cus;
    }
    if (grid < 0) return;
    (void)hipMemsetAsync((char*)d_ws + WS_CTL, 0, CTL_ZERO_BYTES, stream);
    Args a{};
    for (int i = 0; i < 16; ++i) a.in[i] = (const float*)d_in[i];
    a.out = (float*)d_out; a.ws = (unsigned char*)d_ws;
#if N_LAUNCH_MODE == 1
    a.ph_lo = 0; a.ph_hi = NPHASE; launch1<PMASK>(grid, stream, a);
#elif N_LAUNCH_MODE == 3
    a.ph_lo = 0; a.ph_hi = 10; launch1<0x3ffu>(grid, stream, a);
    a.ph_lo = 10; a.ph_hi = 11; launch1<0x400u>(grid, stream, a);
    a.ph_lo = 11; a.ph_hi = 12; launch1<0x800u>(grid, stream, a);
#else
#define L1(p) do { a.ph_lo = (p); a.ph_hi = (p) + 1; launch1<(1u << (p))>(grid, stream, a); } while (0)
    L1(0); L1(1); L1(2); L1(3); L1(4); L1(5); L1(6); L1(7); L1(8); L1(9); L1(10); L1(11);
#undef L1
#endif
}
```

```cpp
#include <hip/hip_runtime.h>
#include <cstdio>
#include <cstdint>
#ifndef WT_STORES
#define WT_STORES 1
#endif
typedef unsigned wt_v4u __attribute__((ext_vector_type(4)));
__device__ __forceinline__ int lane_id_fresh() { int l; asm volatile("v_mbcnt_lo_u32_b32 %0, -1, 0\n\tv_mbcnt_hi_u32_b32 %0, -1, %0" : "=v"(l)); return l; }
__device__ __forceinline__ void st16_wt(void* p, wt_v4u v) {
#if WT_STORES
    asm volatile("global_store_dwordx4 %0, %1, off sc1\n\ts_nop 1" :: "v"(p), "v"(v) : "memory");
#else
    *(wt_v4u*)p = v;
#endif
}
__device__ __forceinline__ void st4_wt(void* p, unsigned v) {
#if WT_STORES
    asm volatile("global_store_dword %0, %1, off sc1\n\ts_nop 1" :: "v"(p), "v"(v) : "memory");
#else
    *(unsigned*)p = v;
#endif
}
__device__ __forceinline__ void st8_wt(void* p, unsigned long long v) {
#if WT_STORES
    asm volatile("global_store_dwordx2 %0, %1, off sc1\n\ts_nop 1" :: "v"(p), "v"(v) : "memory");
#else
    *(unsigned long long*)p = v;
#endif
}
namespace pg8 {
#define PG8_LAS __attribute__((address_space(3)))
typedef unsigned short bf16_t;
typedef short bf16x8 __attribute__((ext_vector_type(8)));
typedef float f32x4 __attribute__((ext_vector_type(4)));
typedef unsigned u32x4 __attribute__((ext_vector_type(4)));
typedef int i32x4 __attribute__((ext_vector_type(4)));
typedef int i32x8 __attribute__((ext_vector_type(8)));
constexpr int BM = 256, BK = 64, HALF = 128, HTB = HALF * BK * 2  , STAGE_BYTES = 8 * HTB, NXCD = 8, WGM = 8;

__host__ __device__ __forceinline__ int lds_byte(int r, int c) { const int st = (r >> 4) * 2 + (c >> 5), rr = r & 15, cc = c & 31, ob = rr * 64 + cc * 2; return st * 1024 + (ob ^ (((ob >> 9) & 1) << 5)); }
__host__ __device__ __forceinline__ void stage_rc(int b, int& R, int& C) { const int st = b / 1024, sb = b % 1024, swz = sb ^ (((sb >> 9) & 1) << 5); R = (st >> 1) * 16 + swz / 64; C = (st & 1) * 32 + (swz % 64) / 2; }
__host__ __device__ __forceinline__ int perm32(int rho) { const int n = rho >> 4, i = rho & 15; return 8 * (i >> 2) + 4 * n + (i & 3); }

struct Unit { int pm, pn; };
struct Gemm { const bf16_t* A; const bf16_t* Bt; int M, N, K; };

struct StaticOrder {
    int nM, nN, nwg, G, c;
    __host__ __device__ void init(int M, int N, int G_, int c_) { nM = M / BM; nN = N / BM; nwg = nM * nN; G = G_; c = c_; }
    __host__ __device__ bool next(int i, Unit& u) const {
        const long L = (long)i * G + c; if (L >= nwg) return false;
        int wgid = (int)L; { const int q = nwg / NXCD, r = nwg % NXCD, xcd = wgid % NXCD, off = wgid / NXCD; wgid = (xcd < r ? xcd * (q + 1) : r * (q + 1) + (xcd - r) * q) + off; }
        const int nig = WGM * nN, gid = wgid / nig, fm = gid * WGM, gsz = (nM - fm) < WGM ? (nM - fm) : WGM;
        u.pm = fm + ((wgid % nig) % gsz); u.pn = (wgid % nig) / gsz; return true;
    }
    __device__ __forceinline__ void a_ready(const Unit&) const {}
    __device__ __forceinline__ void done(const Unit&) const {}
};


__device__ __forceinline__ unsigned cvt_pk_bf16(float lo, float hi) { unsigned r; asm volatile("v_cvt_pk_bf16_f32 %0, %1, %2" : "=v"(r) : "v"(lo), "v"(hi)); return r; }
template <bool ACC_I32> struct EpiBf16S {
    static constexpr bool PERM = true, AFTER_DRAIN = false;
    bf16_t* O; int ldc; int sc_lo, sc_hi; float scv; float* ksum; int ks_lo, ks_hi; const float* rs; const unsigned* cmax;
    __device__ __forceinline__ void operator()(const f32x4 (&acc)[2][2][4][2], const Unit& u, int wr, int wc, int fr_, int fq_) const {
        (void)fr_; (void)fq_;
        const int lane_ = lane_id_fresh(); const int fr = lane_ & 15, fq = lane_ >> 4;
        const int row0 = u.pm * BM + wr * 64 + fr; const int colt = u.pn * BM;
        const float sc = ((u.pn >= sc_lo && u.pn < sc_hi) ? scv : 1.f) * (ACC_I32 ? (1.f / 127.f) : (1.f / 224.f));
        const int col0 = colt + wc * 32 + 8 * fq;
        float rsv[2][4];
#pragma unroll
        for (int ai = 0; ai < 2; ++ai)
#pragma unroll
            for (int m = 0; m < 4; ++m) rsv[ai][m] = rs != nullptr ? rs[row0 + ai * HALF + m * 16] : 1.f;
        const bool do_ks = ksum != nullptr && u.pn >= ks_lo && u.pn < ks_hi;
#pragma unroll
        for (int bj = 0; bj < 2; ++bj) {
            const u32x4 cb0 = *(const u32x4*)(cmax + col0 + bj * HALF), cb1 = *(const u32x4*)(cmax + col0 + bj * HALF + 4);
            const f32x4 cs0 = (f32x4){__uint_as_float(cb0.x), __uint_as_float(cb0.y), __uint_as_float(cb0.z), __uint_as_float(cb0.w)} * sc;
            const f32x4 cs1 = (f32x4){__uint_as_float(cb1.x), __uint_as_float(cb1.y), __uint_as_float(cb1.z), __uint_as_float(cb1.w)} * sc;
            f32x4 sum0 = {0.f, 0.f, 0.f, 0.f}, sum1 = sum0;
#pragma unroll
            for (int ai = 0; ai < 2; ++ai)
#pragma unroll
                for (int m = 0; m < 4; ++m) { f32x4 a0 = acc[ai][bj][m][0], a1 = acc[ai][bj][m][1];
                    if constexpr (ACC_I32) { const i32x4 i0 = __builtin_bit_cast(i32x4, a0), i1 = __builtin_bit_cast(i32x4, a1);
                        a0 = (f32x4){(float)i0[0], (float)i0[1], (float)i0[2], (float)i0[3]}; a1 = (f32x4){(float)i1[0], (float)i1[1], (float)i1[2], (float)i1[3]}; }
                    const f32x4 v0 = a0 * rsv[ai][m] * cs0, v1 = a1 * rsv[ai][m] * cs1;
                    sum0 += v0; sum1 += v1;
                    u32x4 w; w.x = cvt_pk_bf16(v0[0], v0[1]); w.y = cvt_pk_bf16(v0[2], v0[3]); w.z = cvt_pk_bf16(v1[0], v1[1]); w.w = cvt_pk_bf16(v1[2], v1[3]);
                    st16_wt(O + (size_t)(row0 + ai * HALF + m * 16) * ldc + col0 + bj * HALF, w); }
            if (do_ks) {
                float* kd = ksum + (size_t)u.pm * ((ks_hi - ks_lo) * BM) + (u.pn - ks_lo) * BM + wc * 32 + 8 * fq + bj * HALF;
#pragma unroll
                for (int n = 0; n < 2; ++n)
#pragma unroll
                    for (int i = 0; i < 4; ++i) {
                        float v = n ? sum1[i] : sum0[i];
                        v += __uint_as_float((unsigned)__builtin_amdgcn_mov_dpp((int)__float_as_uint(v), 0xB1, 0xf, 0xf, true));
                        v += __uint_as_float((unsigned)__builtin_amdgcn_mov_dpp((int)__float_as_uint(v), 0x4E, 0xf, 0xf, true));
                        v += __uint_as_float((unsigned)__builtin_amdgcn_mov_dpp((int)__float_as_uint(v), 0x141, 0xf, 0xf, true));
                        v += __uint_as_float((unsigned)__builtin_amdgcn_mov_dpp((int)__float_as_uint(v), 0x140, 0xf, 0xf, true));
                        if (fr == 0) atomicAdd(kd + 4 * n + i, v);
                    }
            }
        }
    }
};
struct EpiBf16 {
    static constexpr bool PERM = true, AFTER_DRAIN = false;
    bf16_t* O; int ldc; int sc_lo, sc_hi; float scv; float* ksum; int ks_lo, ks_hi;
    __device__ __forceinline__ void operator()(const f32x4 (&acc)[2][2][4][2], const Unit& u, int wr, int wc, int fr, int fq) const {
        const int row0 = u.pm * BM + wr * 64 + fr; const int colt = u.pn * BM;
        const float sc = (u.pn >= sc_lo && u.pn < sc_hi) ? scv : 1.f;
        const int col0 = colt + wc * 32 + 8 * fq;
#pragma unroll
        for (int ai = 0; ai < 2; ++ai)
#pragma unroll
            for (int m = 0; m < 4; ++m) { bf16_t* rowp = O + (size_t)(row0 + ai * HALF + m * 16) * ldc + col0;
#pragma unroll
                for (int bj = 0; bj < 2; ++bj) { f32x4 v0 = acc[ai][bj][m][0] * sc, v1 = acc[ai][bj][m][1] * sc;
                    u32x4 w; w.x = cvt_pk_bf16(v0[0], v0[1]); w.y = cvt_pk_bf16(v0[2], v0[3]); w.z = cvt_pk_bf16(v1[0], v1[1]); w.w = cvt_pk_bf16(v1[2], v1[3]);
                    st16_wt(rowp + bj * HALF, w); } }
        if (ksum != nullptr && u.pn >= ks_lo && u.pn < ks_hi) {
            float* kd = ksum + (size_t)u.pm * ((ks_hi - ks_lo) * BM) + (u.pn - ks_lo) * BM + wc * 32 + 8 * fq;
#pragma unroll
            for (int bj = 0; bj < 2; ++bj)
#pragma unroll
                for (int n = 0; n < 2; ++n) {
                    f32x4 cs = acc[0][bj][0][n];
#pragma unroll
                    for (int m = 1; m < 4; ++m) cs += acc[0][bj][m][n];
#pragma unroll
                    for (int m = 0; m < 4; ++m) cs += acc[1][bj][m][n];
#pragma unroll
                    for (int i = 0; i < 4; ++i) {
                        float v = cs[i];
                        v += __uint_as_float((unsigned)__builtin_amdgcn_mov_dpp((int)__float_as_uint(v), 0xB1, 0xf, 0xf, true));
                        v += __uint_as_float((unsigned)__builtin_amdgcn_mov_dpp((int)__float_as_uint(v), 0x4E, 0xf, 0xf, true));
                        v += __uint_as_float((unsigned)__builtin_amdgcn_mov_dpp((int)__float_as_uint(v), 0x141, 0xf, 0xf, true));
                        v += __uint_as_float((unsigned)__builtin_amdgcn_mov_dpp((int)__float_as_uint(v), 0x140, 0xf, 0xf, true));
                        if (fr == 0) atomicAdd(kd + bj * HALF + 4 * n + i, v);
                    }
                }
        }
    }
};

template <int OFF> __device__ __forceinline__ void dma16s(const void* sbase, unsigned voff, unsigned lds_base) { unsigned keep;
    asm volatile("s_mov_b32 %0, m0\n\ts_add_u32 m0, %3, %4\n\ts_nop 0\n\tglobal_load_lds_dwordx4 %1, %2\n\ts_mov_b32 m0, %0" : "=&s"(keep) : "v"(voff), "s"(sbase), "s"(lds_base), "i"(OFF) : "memory", "scc"); }
__device__ __forceinline__ const char* uni_ptr(const char* p) {
    const unsigned long long v = (unsigned long long)p;
    return (const char*)(((unsigned long long)(unsigned)__builtin_amdgcn_readfirstlane((int)(unsigned)(v >> 32)) << 32) | (unsigned)__builtin_amdgcn_readfirstlane((int)(unsigned)v));
}
template <class Epi, class Sched, bool ALIGN_EPI = false, bool SP2 = false, bool FP8 = false, bool I8 = false>
__device__ __forceinline__ void gemm_phase(PG8_LAS unsigned char* lds, const Gemm g, const Sched& S, const Epi& E) {
    int tid_ = threadIdx.x; asm volatile("" : "+v"(tid_));
    const int tid = tid_, wid = __builtin_amdgcn_readfirstlane(tid >> 6), lane = tid & 63, wr = wid >> 2, wc = wid & 3, fr = lane & 15, fq = lane >> 4;
    const int K = g.K, nt = K / BK;
    unsigned voffA[2], voffB[2];
#pragma unroll
    for (int i = 0; i < 2; ++i) { int R, C; stage_rc(tid * 16 + i * 8192, R, C); const int Rb = Epi::PERM ? ((R & ~31) + perm32(R & 31)) : R;
        voffA[i] = (unsigned)(R * K + C) * 2u; voffB[i] = (unsigned)(Rb * K + C) * 2u; }
    const size_t qstep = (size_t)64 * K * 2;
    const size_t kstep = (size_t)(BK * 2);
    const size_t hstep = (size_t)HALF * K * 2;
    const size_t tstep = 2 * hstep;
    const unsigned ldsn = (unsigned)(size_t)lds;
    const unsigned ldsw = (unsigned)wid * 1024u;
    const unsigned ldsb = (unsigned)__builtin_amdgcn_readfirstlane((int)(ldsn + ldsw));
    const int aoff = lds_byte(wr * 64 + fr, fq * 8), boff = lds_byte(wc * 32 + fr, fq * 8);
    unsigned ldsAn = ldsn + (unsigned)aoff, ldsBn = ldsn + (unsigned)(4 * HTB) + (unsigned)boff; asm volatile("" : "+v"(ldsAn), "+v"(ldsBn));
    PG8_LAS unsigned char* const ldsA = (PG8_LAS unsigned char*)(size_t)ldsAn; PG8_LAS unsigned char* const ldsB = (PG8_LAS unsigned char*)(size_t)ldsBn;
#define PG8_SA(b, h) (((b) * 2 + (h)) * HTB)
#define PG8_SB(b, h) ((4 + (b) * 2 + (h)) * HTB)
#define PG8_STAGE(bufoff, gbase, voff) do { if constexpr (FP8 || I8) { const char* gb_ = uni_ptr((const char*)(gbase)); dma16s<(bufoff)>(gb_, (voff)[0], ldsb); dma16s<(bufoff) + 8192>(uni_ptr(gb_ + qstep), (voff)[0], ldsb); }        \
    else { _Pragma("unroll") for (int _i = 0; _i < 2; ++_i) \
        __builtin_amdgcn_global_load_lds((const unsigned*)((const char*)(gbase) + (voff)[_i]), (PG8_LAS unsigned*)(lds + (bufoff) + ldsw + _i * 8192), 16, 0, 0); } } while (0)
#define PG8_LDA(dst, b, h) do { _Pragma("unroll") for (int m = 0; m < 4; ++m) _Pragma("unroll") for (int k = 0; k < 2; ++k) dst[m][k] = *(const PG8_LAS bf16x8*)(lds + PG8_SA(b, h) + aoff + m * 2048 + k * 1024); } while (0)
#define PG8_LDB(dst, b, h) do { _Pragma("unroll") for (int n = 0; n < 2; ++n) _Pragma("unroll") for (int k = 0; k < 2; ++k) dst[n][k] = *(const PG8_LAS bf16x8*)(lds + PG8_SB(b, h) + boff + n * 2048 + k * 1024); } while (0)
#define PG8_LDA8(dst, b, h) do { _Pragma("unroll") for (int m = 0; m < 4; ++m) dst[m] = __builtin_shufflevector(*(const PG8_LAS i32x4*)(ldsA + PG8_SA(b, h) + m * 2048), *(const PG8_LAS i32x4*)(ldsA + PG8_SA(b, h) + m * 2048 + 1024), 0, 1, 2, 3, 4, 5, 6, 7); } while (0)
#define PG8_LDB8(dst, b, h) do { _Pragma("unroll") for (int n = 0; n < 2; ++n) dst[n] = __builtin_shufflevector(*(const PG8_LAS i32x4*)(ldsB + (PG8_SB(b, h) - 4 * HTB) + n * 2048), *(const PG8_LAS i32x4*)(ldsB + (PG8_SB(b, h) - 4 * HTB) + n * 2048 + 1024), 0, 1, 2, 3, 4, 5, 6, 7); } while (0)
#define PG8_MMA8(ai, bj, A8, B8) do { __builtin_amdgcn_s_setprio(1); _Pragma("unroll") for (int m = 0; m < 4; ++m) _Pragma("unroll") for (int n = 0; n < 2; ++n) \
        acc[ai][bj][m][n] = __builtin_amdgcn_mfma_scale_f32_16x16x128_f8f6f4(B8[n], A8[m], acc[ai][bj][m][n], 0, 0, 0, 0, 0, 0); __builtin_amdgcn_s_setprio(0); } while (0)
#define PG8_MMA(ai, bj, At, Bt) do { __builtin_amdgcn_s_setprio(1); _Pragma("unroll") for (int m = 0; m < 4; ++m) _Pragma("unroll") for (int n = 0; n < 2; ++n) _Pragma("unroll") for (int k = 0; k < 2; ++k) { \
        if constexpr (I8) acc[ai][bj][m][n] = __builtin_bit_cast(f32x4, __builtin_amdgcn_mfma_i32_16x16x64_i8(__builtin_bit_cast(i32x4, Bt[n][k]), __builtin_bit_cast(i32x4, At[m][k]), __builtin_bit_cast(i32x4, acc[ai][bj][m][n]), 0, 0, 0)); \
        else acc[ai][bj][m][n] = __builtin_amdgcn_mfma_f32_16x16x32_bf16(Bt[n][k], At[m][k], acc[ai][bj][m][n], 0, 0, 0); } __builtin_amdgcn_s_setprio(0); } while (0)
#define PG8_WAIT_V(n) asm volatile("s_waitcnt vmcnt(" #n ")" ::: "memory")
#define PG8_WAIT_L(n) asm volatile("s_waitcnt lgkmcnt(" #n ")" ::: "memory")
#define PG8_BAR __builtin_amdgcn_s_barrier()
#define PG8_SCHED __builtin_amdgcn_sched_barrier(0)
    Unit cur, nxt; int ui = 0;
    if (!S.next(0, cur)) return;
    f32x4 acc[2][2][4][2];
#pragma unroll
    for (int a = 0; a < 2; ++a)
#pragma unroll
        for (int b = 0; b < 2; ++b)
#pragma unroll
            for (int m = 0; m < 4; ++m)
#pragma unroll
                for (int n = 0; n < 2; ++n) acc[a][b][m][n] = (f32x4){0.f, 0.f, 0.f, 0.f};
    bf16x8 At[4][2], B0[2][2], B1[2][2];
    i32x8 A8[4], B08[2], B18[2];
    const char* cA = (const char*)g.A + (size_t)cur.pm * tstep; const char* cB = (const char*)g.Bt + (size_t)cur.pn * tstep;
    if constexpr (FP8 || I8) { cA = uni_ptr(cA); cB = uni_ptr(cB); }
    S.a_ready(cur);
    if constexpr (SP2) {
        PG8_STAGE(PG8_SB(0, 0), cB, voffB); PG8_STAGE(PG8_SB(0, 1), cB + hstep, voffB); PG8_STAGE(PG8_SA(0, 0), cA, voffA); PG8_STAGE(PG8_SA(0, 1), cA + hstep, voffA);
        if (wr == 1) PG8_BAR;
        PG8_WAIT_V(2); PG8_BAR;
        PG8_STAGE(PG8_SB(1, 0), cB + kstep, voffB); PG8_STAGE(PG8_SA(1, 0), cA + kstep, voffA); PG8_STAGE(PG8_SB(1, 1), cB + hstep + kstep, voffB);
        PG8_WAIT_V(6); PG8_BAR;
    } else {
        PG8_STAGE(PG8_SB(0, 0), cB, voffB); PG8_STAGE(PG8_SA(0, 0), cA, voffA); PG8_STAGE(PG8_SB(0, 1), cB + hstep, voffB); PG8_STAGE(PG8_SA(0, 1), cA + hstep, voffA);
        if (wr == 1) PG8_BAR;
        PG8_WAIT_V(4); PG8_BAR;
        PG8_STAGE(PG8_SB(1, 0), cB + kstep, voffB); PG8_STAGE(PG8_SA(1, 0), cA + kstep, voffA); PG8_STAGE(PG8_SB(1, 1), cB + hstep + kstep, voffB);
        PG8_WAIT_V(6); PG8_BAR;
    }
    for (;;) {
        const bool has_next = S.next(ui + 1, nxt);
        const char* nA = has_next ? (const char*)g.A + (size_t)nxt.pm * tstep : cA; const char* nB = has_next ? (const char*)g.Bt + (size_t)nxt.pn * tstep : cB;
        if constexpr (FP8 || I8) { nA = uni_ptr(nA); nB = uni_ptr(nB); }
        for (int t = 0; t < nt; t += 2) {
            const bool last = (t == nt - 2);
            if constexpr (FP8 || I8) asm volatile("" : "+v"(voffA[0]), "+v"(voffB[0]));
            const char* a1 = cA + (size_t)(t + 1) * kstep;
            const char* a2 = last ? nA : cA + (size_t)(t + 2) * kstep; const char* b2 = last ? nB : cB + (size_t)(t + 2) * kstep;
            const char* a3 = a2 + kstep; const char* b3 = b2 + kstep;
            if (last && has_next) S.a_ready(nxt);
            if constexpr (SP2 && FP8) {
            PG8_LDB8(B08, 0, 0); PG8_LDB8(B18, 0, 1); PG8_SCHED; PG8_LDA8(A8, 0, 0); PG8_STAGE(PG8_SA(1, 1), a1 + hstep, voffA);
            PG8_WAIT_V(8); PG8_WAIT_L(0); PG8_BAR; PG8_MMA8(0, 0, A8, B08); PG8_MMA8(0, 1, A8, B18); PG8_BAR; PG8_SCHED;
            PG8_LDA8(A8, 0, 1); PG8_STAGE(PG8_SB(0, 0), b2, voffB); PG8_STAGE(PG8_SB(0, 1), b2 + hstep, voffB); PG8_STAGE(PG8_SA(0, 0), a2, voffA);
            PG8_WAIT_V(8); PG8_WAIT_L(0); PG8_BAR; PG8_MMA8(1, 0, A8, B08); PG8_MMA8(1, 1, A8, B18); PG8_BAR; PG8_SCHED;
            PG8_LDB8(B08, 1, 0); PG8_LDB8(B18, 1, 1); PG8_SCHED; PG8_LDA8(A8, 1, 0); PG8_STAGE(PG8_SA(0, 1), a2 + hstep, voffA);
            PG8_WAIT_V(8); PG8_WAIT_L(0); PG8_BAR; PG8_MMA8(0, 0, A8, B08); PG8_MMA8(0, 1, A8, B18); PG8_BAR; PG8_SCHED;
            PG8_LDA8(A8, 1, 1); PG8_STAGE(PG8_SB(1, 0), b3, voffB); PG8_STAGE(PG8_SB(1, 1), b3 + hstep, voffB); PG8_STAGE(PG8_SA(1, 0), a3, voffA);
            PG8_WAIT_V(8); PG8_WAIT_L(0); PG8_BAR; PG8_MMA8(1, 0, A8, B08); PG8_MMA8(1, 1, A8, B18); PG8_BAR; PG8_SCHED;
            } else if constexpr (SP2) {
            PG8_LDB(B0, 0, 0); PG8_LDB(B1, 0, 1); PG8_SCHED; PG8_LDA(At, 0, 0); PG8_STAGE(PG8_SA(1, 1), a1 + hstep, voffA);
            PG8_WAIT_V(8); PG8_WAIT_L(0); PG8_BAR; PG8_MMA(0, 0, At, B0); PG8_MMA(0, 1, At, B1); PG8_BAR; PG8_SCHED;
            PG8_LDA(At, 0, 1); PG8_STAGE(PG8_SB(0, 0), b2, voffB); PG8_STAGE(PG8_SB(0, 1), b2 + hstep, voffB); PG8_STAGE(PG8_SA(0, 0), a2, voffA);
            PG8_WAIT_V(8); PG8_WAIT_L(0); PG8_BAR; PG8_MMA(1, 0, At, B0); PG8_MMA(1, 1, At, B1); PG8_BAR; PG8_SCHED;
            PG8_LDB(B0, 1, 0); PG8_LDB(B1, 1, 1); PG8_SCHED; PG8_LDA(At, 1, 0); PG8_STAGE(PG8_SA(0, 1), a2 + hstep, voffA);
            PG8_WAIT_V(8); PG8_WAIT_L(0); PG8_BAR; PG8_MMA(0, 0, At, B0); PG8_MMA(0, 1, At, B1); PG8_BAR; PG8_SCHED;
            PG8_LDA(At, 1, 1); PG8_STAGE(PG8_SB(1, 0), b3, voffB); PG8_STAGE(PG8_SB(1, 1), b3 + hstep, voffB); PG8_STAGE(PG8_SA(1, 0), a3, voffA);
            PG8_WAIT_V(8); PG8_WAIT_L(0); PG8_BAR; PG8_MMA(1, 0, At, B0); PG8_MMA(1, 1, At, B1); PG8_BAR; PG8_SCHED;
            } else {
            PG8_LDB(B0, 0, 0); PG8_SCHED; PG8_LDA(At, 0, 0); PG8_STAGE(PG8_SA(1, 1), a1 + hstep, voffA);
            PG8_WAIT_L(8); PG8_BAR; PG8_WAIT_L(0); PG8_MMA(0, 0, At, B0); PG8_BAR; PG8_SCHED;
            PG8_LDB(B1, 0, 1); PG8_STAGE(PG8_SB(0, 0), b2, voffB);
            PG8_BAR; PG8_WAIT_L(0); PG8_MMA(0, 1, At, B1); PG8_BAR;
            PG8_LDA(At, 0, 1); PG8_STAGE(PG8_SA(0, 0), a2, voffA);
            PG8_BAR; PG8_WAIT_L(0); PG8_MMA(1, 0, At, B0); PG8_BAR; PG8_SCHED;
            PG8_STAGE(PG8_SB(0, 1), b2 + hstep, voffB);
            PG8_WAIT_V(6); PG8_BAR; PG8_MMA(1, 1, At, B1); PG8_BAR;
            PG8_LDB(B0, 1, 0); PG8_SCHED; PG8_LDA(At, 1, 0); PG8_STAGE(PG8_SA(0, 1), a2 + hstep, voffA);
            PG8_WAIT_L(8); PG8_BAR; PG8_WAIT_L(0); PG8_MMA(0, 0, At, B0); PG8_BAR; PG8_SCHED;
            PG8_LDB(B1, 1, 1); PG8_STAGE(PG8_SB(1, 0), b3, voffB);
            PG8_BAR; PG8_WAIT_L(0); PG8_MMA(0, 1, At, B1); PG8_BAR;
            PG8_LDA(At, 1, 1); PG8_STAGE(PG8_SA(1, 0), a3, voffA);
            PG8_BAR; PG8_WAIT_L(0); PG8_MMA(1, 0, At, B0); PG8_BAR; PG8_SCHED;
            PG8_STAGE(PG8_SB(1, 1), b3 + hstep, voffB);
            PG8_WAIT_V(6); PG8_BAR; PG8_MMA(1, 1, At, B1); PG8_BAR;
            }
        }
        if constexpr (ALIGN_EPI) { if (wr == 0) PG8_BAR; }
        if constexpr (!Epi::AFTER_DRAIN) { E(acc, cur, wr, wc, fr, fq); S.done(cur); }
        if (!has_next) break;
#pragma unroll
        for (int a = 0; a < 2; ++a)
#pragma unroll
            for (int b = 0; b < 2; ++b)
#pragma unroll
                for (int m = 0; m < 4; ++m)
#pragma unroll
                    for (int n = 0; n < 2; ++n) acc[a][b][m][n] = (f32x4){0.f, 0.f, 0.f, 0.f};
        cur = nxt; cA = nA; cB = nB; ++ui;
        if constexpr (ALIGN_EPI) { if (wr == 1) PG8_BAR; }
    }
    PG8_WAIT_V(0);
    if constexpr (!ALIGN_EPI) { if (wr == 0) PG8_BAR; }
    PG8_BAR;
    if constexpr (Epi::AFTER_DRAIN) { E.fused(acc, cur, wr, wc, fr, fq, lds, wid, lane); S.done(cur); }
#undef PG8_SA
#undef PG8_SB
#undef PG8_STAGE
#undef PG8_LDA
#undef PG8_LDB
#undef PG8_LDA8
#undef PG8_LDB8
#undef PG8_MMA8
#undef PG8_MMA
#undef PG8_WAIT_V
#undef PG8_WAIT_L
#undef PG8_BAR
#undef PG8_SCHED
}
}
#include <hip/hip_bf16.h>
#include <cmath>
namespace attn_body {
using bf16=__hip_bfloat16;
using bf16x8=__attribute__((ext_vector_type(8)))short;
using s16x4=__attribute__((ext_vector_type(4)))short;
using f32x16=__attribute__((ext_vector_type(16)))float;
using u32x4=__attribute__((ext_vector_type(4)))unsigned;
constexpr int BATCH=4,NHEAD=8,SEQ=4096,D=64,DM=3072,OPITCH=1024;
constexpr int NW=8,QBLK=32,QB=QBLK*NW,KVBLK=64,NQB=SEQ/QB;
constexpr int ATTN_UNIT_ROWS=QB;
__device__ __forceinline__ int crow(int r,int hi){return (r&3)+8*(r>>2)+4*hi;}
#define SBAR() __builtin_amdgcn_sched_barrier(0)
__device__ __forceinline__ void cmask(f32x16&p0,f32x16&p1,int jb,int qrel,int hi){
  const float NEG=-INFINITY; int kb=64*jb+4*hi;
  #pragma unroll
  for(int r=0;r<16;++r){int kv=kb+(r&3)+8*(r>>2); if(kv>qrel)p0[r]=NEG; if(kv+32>qrel)p1[r]=NEG;}
}

constexpr int NSLOT=3, SLOTB=8192;
constexpr int LDS_K=0, LDS_V=NSLOT*SLOTB, LDS_WS=2*NSLOT*SLOTB, LDS_OST=LDS_WS+NW*64*4, LDS_BYTES=LDS_OST+NW*4096;
constexpr float C2=0.125f*1.4426950408889634f;
__device__ __forceinline__ void glds16(const void*gsrc,unsigned lds_dst){unsigned keep;
  asm volatile("s_mov_b32 %0, m0\n\ts_mov_b32 m0, %2\n\ts_nop 0\n\tglobal_load_lds_dwordx4 %1, off\n\ts_mov_b32 m0, %0":"=&s"(keep):"v"(gsrc),"s"(lds_dst):"memory");}
__device__ __forceinline__ void glds16s(const void*sbase,unsigned voff,unsigned lds_dst){unsigned keep;
  asm volatile("s_mov_b32 %0, m0\n\ts_mov_b32 m0, %3\n\ts_nop 0\n\tglobal_load_lds_dwordx4 %1, %2\n\ts_mov_b32 m0, %0":"=&s"(keep):"v"(voff),"s"(sbase),"s"(lds_dst):"memory");}
__device__ __forceinline__ float max3f(float a,float b,float c){float r;asm("v_max3_f32 %0, %1, %2, %3":"=v"(r):"v"(a),"v"(b),"v"(c));return r;}
__device__ __forceinline__ float max2f(float a,float b){float r;asm("v_max_f32_e32 %0, %1, %2":"=v"(r):"v"(a),"v"(b));return r;}
__device__ __forceinline__ float fadd_s(float a,float b){float r;asm("v_add_f32_e32 %0, %1, %2":"=v"(r):"v"(a),"v"(b));return r;}
__device__ __forceinline__ float fsub_s(float a,float b){float r;asm("v_sub_f32_e32 %0, %1, %2":"=v"(r):"v"(a),"v"(b));return r;}
typedef float f32x2_t __attribute__((ext_vector_type(2))); typedef __bf16 bf16x2_t __attribute__((ext_vector_type(2)));
__device__ __forceinline__ unsigned cvtpk_s(float lo,float hi){f32x2_t v={lo,hi};bf16x2_t b=__builtin_convertvector(v,bf16x2_t);return __builtin_bit_cast(unsigned,b);}
#define WAIT_BAR(N) asm volatile("s_waitcnt vmcnt(" #N ") lgkmcnt(0)\n\ts_barrier":::"memory")

__device__ __forceinline__ void qkt(f32x16&p0,f32x16&p1,const char*Kslot,const bf16x8*qr,int r32,int hi){
  const f32x16 negm=f32x16{};
  const char*kb=Kslot+hi*1024+r32*16;
  #pragma unroll
  for(int d0=0;d0<4;++d0){
    const bf16x8 b0=*reinterpret_cast<const bf16x8*>(kb+d0*2048);
    const bf16x8 b1=*reinterpret_cast<const bf16x8*>(kb+d0*2048+512);
    if(d0==0){p0=__builtin_amdgcn_mfma_f32_32x32x16_bf16(b0,qr[0],negm,0,0,0);p1=__builtin_amdgcn_mfma_f32_32x32x16_bf16(b1,qr[0],negm,0,0,0);}
    else{p0=__builtin_amdgcn_mfma_f32_32x32x16_bf16(b0,qr[d0],p0,0,0,0);p1=__builtin_amdgcn_mfma_f32_32x32x16_bf16(b1,qr[d0],p1,0,0,0);}}
}
typedef __attribute__((address_space(3))) const char* lds_cptr;
typedef short v4i16_t __attribute__((ext_vector_type(4)));
__device__ __forceinline__ void kload8(bf16x8*kf,lds_cptr kp){
  kf[0]=*(const __attribute__((address_space(3))) bf16x8*)(kp);      kf[1]=*(const __attribute__((address_space(3))) bf16x8*)(kp+512);
  kf[2]=*(const __attribute__((address_space(3))) bf16x8*)(kp+2048); kf[3]=*(const __attribute__((address_space(3))) bf16x8*)(kp+2560);
  kf[4]=*(const __attribute__((address_space(3))) bf16x8*)(kp+4096); kf[5]=*(const __attribute__((address_space(3))) bf16x8*)(kp+4608);
  kf[6]=*(const __attribute__((address_space(3))) bf16x8*)(kp+6144); kf[7]=*(const __attribute__((address_space(3))) bf16x8*)(kp+6656);
}
__device__ __forceinline__ void kload2(bf16x8*kf,lds_cptr kp,int j){ kf[2*j]=*(const __attribute__((address_space(3))) bf16x8*)(kp+j*2048); kf[2*j+1]=*(const __attribute__((address_space(3))) bf16x8*)(kp+j*2048+512); }
__device__ __forceinline__ s16x4 vtr(lds_cptr p){ return __builtin_bit_cast(s16x4,__builtin_amdgcn_ds_read_tr16_b64_v4i16((__attribute__((address_space(3))) v4i16_t*)p)); }
__device__ __forceinline__ float rowmax(const f32x16&p0,const f32x16&p1){
  float a=max3f(p0[0],p0[1],p1[0]),b=max3f(p0[2],p0[3],p1[1]);a=max3f(a,p1[2],p1[3]);
  #pragma unroll
  for(int r=4;r<16;r+=4){a=max3f(a,p0[r],p0[r+1]);b=max3f(b,p0[r+2],p0[r+3]);a=max3f(a,p1[r],p1[r+1]);b=max3f(b,p1[r+2],p1[r+3]);}
  const float m=max2f(a,b);
  auto rr=__builtin_amdgcn_permlane32_swap(__float_as_uint(m),__float_as_uint(m),false,false);
  return max2f(__uint_as_float(rr[0]),__uint_as_float(rr[1]));
}
__device__ __forceinline__ void pv(f32x16*o,int vb,bf16x8 pa0,bf16x8 pa1,bf16x8 pa2,bf16x8 pa3){
  #pragma unroll
  for(int d0=0;d0<2;++d0){s16x4 lo[4],hi[4];
    #pragma unroll
    for(int ks=0;ks<4;++ks){
      asm volatile("ds_read_b64_tr_b16 %0,%1 offset:%c2":"=&v"(lo[ks]):"v"(vb),"i"(d0*4096+ks*1024):"memory");
      asm volatile("ds_read_b64_tr_b16 %0,%1 offset:%c2":"=&v"(hi[ks]):"v"(vb),"i"(d0*4096+ks*1024+512):"memory");}
    asm volatile("s_waitcnt lgkmcnt(0)":::"memory");SBAR();
    #define PK(k) (bf16x8){lo[k][0],lo[k][1],lo[k][2],lo[k][3],hi[k][0],hi[k][1],hi[k][2],hi[k][3]}
    o[d0]=__builtin_amdgcn_mfma_f32_32x32x16_bf16(pa0,PK(0),o[d0],0,0,0);
    o[d0]=__builtin_amdgcn_mfma_f32_32x32x16_bf16(pa1,PK(1),o[d0],0,0,0);
    o[d0]=__builtin_amdgcn_mfma_f32_32x32x16_bf16(pa2,PK(2),o[d0],0,0,0);
    o[d0]=__builtin_amdgcn_mfma_f32_32x32x16_bf16(pa3,PK(3),o[d0],0,0,0);
    #undef PK
  }
}

#define ATTN_YQ (127.f/6.f)
#ifndef ATTN_STORE16
#define ATTN_STORE16(p,v) st16_wt((p),(v))
#endif
template<int THRL> __device__ __forceinline__ void attn_unit(int b,int h,int qb,const bf16*Q,const bf16*__restrict__ K,const bf16*__restrict__ V,bf16*O,const float*KSUM,const float*GG,char*shm){
  int tid_=threadIdx.x; asm volatile("":"+v"(tid_)); const int tid=tid_,lane=tid&63,r32=lane&31,hi=lane>>5; const int wid=__builtin_amdgcn_readfirstlane(tid>>6);
  const long rowbase=(long)b*SEQ; const int q0=qb*QB;
  const bf16*Qw=Q+(rowbase+q0+wid*QBLK)*DM+h*D;
  const bf16*Kh=K+rowbase*DM+h*D,*Vh=V+rowbase*DM+h*D;
  const unsigned lds0=(unsigned)(uintptr_t)shm;
  float*wsf=(float*)(shm+LDS_WS)+wid*64;
  const unsigned koff=(unsigned)((lane*DM+wid*8)*2);
  const unsigned voffs=(unsigned)(((16*(wid&3)+(lane>>2))*DM+(wid>>2)*32+(lane&3)*8)*2);
  const unsigned kdst=lds0+LDS_K+wid*1024, vdst=lds0+LDS_V+wid*1024;
  #define PT(t) (((t)<4)?(NT-4+(t)):((t)-4))
  #define DMA_K(t,slot) glds16s((const char*)Kh+(long)PT(t)*(KVBLK*DM*2),koff,(unsigned)__builtin_amdgcn_readfirstlane(kdst+(slot)))
  #define DMA_V(t,slot) glds16s((const char*)Vh+(long)PT(t)*(KVBLK*DM*2),voffs,(unsigned)__builtin_amdgcn_readfirstlane(vdst+(slot)))
  const int vb0=(int)(lds0+LDS_V)+((lane>>4)&1)*32+(lane&3)*8+(4*hi+((lane&15)>>2))*64;
  const char*Kbase=shm+LDS_K; bf16x8 kf[8];
  const lds_cptr shm3=(lds_cptr)shm; const lds_cptr kp0=shm3+LDS_K+hi*1024+r32*16; const lds_cptr vp0=shm3+LDS_V+((lane>>4)&1)*32+(lane&3)*8+(4*hi+((lane&15)>>2))*64;
  const int NT=(q0+QB)/KVBLK;
  DMA_K(0,0);DMA_V(0,0);DMA_K(1,SLOTB);
  bf16x8 qr[4];
  #pragma unroll
  for(int d0=0;d0<4;++d0)qr[d0]=*reinterpret_cast<const bf16x8*>(&Qw[(long)r32*DM+d0*16+hi*8]);
  float mhat=0.f,l_reg=0.f;f32x16 o[2];o[0]=f32x16{};o[1]=f32x16{};const f32x16 z16=f32x16{};
  unsigned selm=(1u<<qb)-1u;
  if(qb>3){
    f32x16 gt=f32x16{};
    #pragma unroll
    for(int d0=0;d0<4;++d0){ const float*kp=KSUM+((long)(b*16+(r32&15)))*512+h*D+d0*16+hi*8;
      const float4 k0=*reinterpret_cast<const float4*>(kp),k1=*reinterpret_cast<const float4*>(kp+4);
      u32x4 kw; kw.x=cvtpk_s(k0.x,k0.y);kw.y=cvtpk_s(k0.z,k0.w);kw.z=cvtpk_s(k1.x,k1.y);kw.w=cvtpk_s(k1.z,k1.w);
      gt=__builtin_amdgcn_mfma_f32_32x32x16_bf16(__builtin_bit_cast(bf16x8,kw),qr[d0],gt,0,0,0); }
    float v0=-INFINITY,v1=-INFINITY,v2=-INFINITY; int i0=0,i1=0,i2=0;
    #define INS3(vv,ii) do{ const float x_=(vv); const int j_=(ii); \
      if(x_>v0){v2=v1;i2=i1;v1=v0;i1=i0;v0=x_;i0=j_;} else if(x_>v1){v2=v1;i2=i1;v1=x_;i1=j_;} else if(x_>v2){v2=x_;i2=j_;} }while(0)
    #pragma unroll
    for(int r=0;r<8;++r){ const int j=crow(r,hi); INS3(j<qb?gt[r]:-INFINITY,j); }
    const float p0=__shfl_xor(v0,32),p1=__shfl_xor(v1,32),p2=__shfl_xor(v2,32); const int q0i=__shfl_xor(i0,32),q1i=__shfl_xor(i1,32),q2i=__shfl_xor(i2,32);
    INS3(p0,q0i); INS3(p1,q1i); INS3(p2,q2i);
    #undef INS3
    selm=(1u<<i0)|(1u<<i1)|(1u<<i2);
  }
  const int qrel=wid*QBLK+r32;
  #define CMASK(P0,P1,t) do{ if((t)<4)cmask(P0,P1,(t),qrel,hi); }while(0)
  bool resc=false;
  #define START(P0,P1) do{ const float rm=rowmax(P0,P1); resc=false; \
    { const float dl=rm; mhat=fadd_s(mhat,dl); \
      _Pragma("unroll") for(int r=0;r<16;++r){P0[r]=fsub_s(P0[r],dl);P1[r]=fsub_s(P1[r],dl);} \
      } \
    _Pragma("unroll") for(int r=0;r<16;++r)P0[r]=__builtin_amdgcn_exp2f(P0[r]); }while(0)
  #define RESC() do{ if(resc){ asm volatile("s_waitcnt lgkmcnt(0)":::"memory"); \
      _Pragma("unroll") for(int d_=0;d_<2;++d_) _Pragma("unroll") for(int r=0;r<16;++r)o[d_][r]*=wsf[crow(r,hi)]; } }while(0)
  f32x16 pA0,pA1,pB0,pB1;
  int sl_prev=0,sl_cur=0,sl_next=SLOTB;
  #define ROT() do{sl_prev=sl_cur;sl_cur=sl_next;sl_next=(sl_next==(NSLOT-1)*SLOTB)?0:sl_next+SLOTB;}while(0)
  DMA_K(2,2*SLOTB);
  WAIT_BAR(3);
  qkt(pA0,pA1,Kbase,qr,r32,hi);asm volatile("s_nop 15\n\ts_nop 7":"+v"(pA0),"+v"(pA1));CMASK(pA0,pA1,0);
  START(pA0,pA1);
  _Pragma("unroll") for(int r=0;r<16;++r)pA1[r]=__builtin_amdgcn_exp2f(pA1[r]);
  WAIT_BAR(0);
  DMA_K(3,0);DMA_V(1,SLOTB);
  ROT();
  kload8(kf,kp0+sl_cur);
  WAIT_BAR(2);
  s16x4 vlo[8],vhi[8]; u32x4 pw0,pw1,pw2,pw3;
  #define PKW(P,B) cvtpk_s(P[B],P[B+1])
  #define PAF(k) __builtin_bit_cast(bf16x8,pw##k)
  #define VFR(i) (bf16x8){vlo[i][0],vlo[i][1],vlo[i][2],vlo[i][3],vhi[i][0],vhi[i][1],vhi[i][2],vhi[i][3]}
  #define PIN(x) asm volatile("":"+v"(x))
  #define MX3(a,b,c) __builtin_fmaxf(__builtin_fmaxf((a),(b)),(c))
  #define GAPA(MF,A0,A1,A2,A3,W0,W1,PW) do{ MF; sacc+=A0; sacc+=A1; sacc+=A2; sacc+=A3; PIN(sacc); W0; W1; PIN(PW); SBAR(); }while(0)
  #define EX(v) __builtin_amdgcn_exp2f(v)
  #define GAPB(MF,X,B) do{ MF; X[B]=EX(X[B]); X[B+1]=EX(X[B+1]); X[B+2]=EX(X[B+2]); X[B+3]=EX(X[B+3]); PIN(X); SBAR(); }while(0)
  #define VRD(i) do{ vlo[i]=vtr(vp_+(((i)>>2)*4096+((i)&3)*1024)); vhi[i]=vtr(vp_+(((i)>>2)*4096+((i)&3)*1024+512)); }while(0)
  #define KRD(G,j) do{ if(G){ kload2(kf,kp0+sl_next,j); SBAR(); } }while(0)
  #define STEP(C0,C1,P0,P1,t,GK,GV,GL) do{ SBAR(); \
    const lds_cptr vp_=vp0+sl_prev; \
    VRD(0); SBAR(); float sacc=(P0[0]+P0[1]); \
    GAPA(C0=__builtin_amdgcn_mfma_f32_32x32x16_bf16(kf[0],qr[0],z16,0,0,0), P0[2],P0[3],P0[4],P0[5],     pw0[0]=PKW(P0,0), pw0[1]=PKW(P0,2), pw0); \
    VRD(4); SBAR(); GAPA(C1=__builtin_amdgcn_mfma_f32_32x32x16_bf16(kf[1],qr[0],z16,0,0,0), P0[6],P0[7],P0[8],P0[9],     pw0[2]=PKW(P0,4), pw0[3]=PKW(P0,6), pw0); \
    VRD(1); SBAR(); GAPA(C0=__builtin_amdgcn_mfma_f32_32x32x16_bf16(kf[2],qr[1],C0,0,0,0),   P0[10],P0[11],P0[12],P0[13], pw1[0]=PKW(P0,8), pw1[1]=PKW(P0,10), pw1); \
    VRD(5); SBAR(); GAPA(C1=__builtin_amdgcn_mfma_f32_32x32x16_bf16(kf[3],qr[1],C1,0,0,0),   P0[14],P0[15],P1[0],P1[1],   pw1[2]=PKW(P0,12),pw1[3]=PKW(P0,14), pw1); \
    VRD(2); SBAR(); GAPA(C0=__builtin_amdgcn_mfma_f32_32x32x16_bf16(kf[4],qr[2],C0,0,0,0),   P1[2],P1[3],P1[4],P1[5],     pw2[0]=PKW(P1,0), pw2[1]=PKW(P1,2), pw2); \
    VRD(6); SBAR(); GAPA(C1=__builtin_amdgcn_mfma_f32_32x32x16_bf16(kf[5],qr[2],C1,0,0,0),   P1[6],P1[7],P1[8],P1[9],     pw2[2]=PKW(P1,4), pw2[3]=PKW(P1,6), pw2); \
    VRD(3); SBAR(); GAPA(C0=__builtin_amdgcn_mfma_f32_32x32x16_bf16(kf[6],qr[3],C0,0,0,0),   P1[10],P1[11],P1[12],P1[13], pw3[0]=PKW(P1,8), pw3[1]=PKW(P1,10), pw3); \
    VRD(7); SBAR(); GAPA(C1=__builtin_amdgcn_mfma_f32_32x32x16_bf16(kf[7],qr[3],C1,0,0,0),   P1[14],P1[15],0.f,0.f,       pw3[2]=PKW(P1,12),pw3[3]=PKW(P1,14), pw3); \
    l_reg+=sacc; \
    if(GK){DMA_K((t)+3,sl_cur);} if(GV){DMA_V((t)+1,sl_next);} \
    { const bool v_=((t)<4)||((selm>>(((t)-4)>>2))&1u); const float nm_=v_?-mhat:-INFINITY; \
      _Pragma("unroll") for(int r=0;r<16;++r){C0[r]+=nm_;C1[r]+=nm_;} } \
    CMASK(C0,C1,t); \
    { float a=MX3(C0[0],C0[1],C1[0]),b=MX3(C0[2],C0[3],C1[1]); a=MX3(a,C1[2],C1[3]); \
      _Pragma("unroll") for(int r=4;r<16;r+=4){a=MX3(a,C0[r],C0[r+1]);b=MX3(b,C0[r+2],C0[r+3]);a=MX3(a,C1[r],C1[r+1]);b=MX3(b,C1[r+2],C1[r+3]);} \
      float rm=__builtin_fmaxf(a,b); { auto rr=__builtin_amdgcn_permlane32_swap(__float_as_uint(rm),__float_as_uint(rm),false,false); rm=__builtin_fmaxf(__uint_as_float(rr[0]),__uint_as_float(rr[1])); } \
      resc=false; \
      if(__builtin_expect(__any(rm>(float)THRL),0)){ const float dl=__builtin_fmaxf(rm,0.f); mhat+=dl; \
        _Pragma("unroll") for(int r=0;r<16;++r){C0[r]-=dl;C1[r]-=dl;} \
        const float f=__builtin_amdgcn_exp2f(-dl); l_reg*=f; if(hi==0)wsf[r32]=f; resc=true; } } \
    SBAR(); \
    GAPB(o[0]=__builtin_amdgcn_mfma_f32_32x32x16_bf16(PAF(0),VFR(0),o[0],0,0,0), C0,0); \
    GAPB(o[1]=__builtin_amdgcn_mfma_f32_32x32x16_bf16(PAF(0),VFR(4),o[1],0,0,0), C0,4); \
    KRD(GL,0); GAPB(o[0]=__builtin_amdgcn_mfma_f32_32x32x16_bf16(PAF(1),VFR(1),o[0],0,0,0), C0,8); \
    KRD(GL,1); GAPB(o[1]=__builtin_amdgcn_mfma_f32_32x32x16_bf16(PAF(1),VFR(5),o[1],0,0,0), C0,12); \
    KRD(GL,2); GAPB(o[0]=__builtin_amdgcn_mfma_f32_32x32x16_bf16(PAF(2),VFR(2),o[0],0,0,0), C1,0); \
    KRD(GL,3); GAPB(o[1]=__builtin_amdgcn_mfma_f32_32x32x16_bf16(PAF(2),VFR(6),o[1],0,0,0), C1,4); \
    GAPB(o[0]=__builtin_amdgcn_mfma_f32_32x32x16_bf16(PAF(3),VFR(3),o[0],0,0,0), C1,8); \
    GAPB(o[1]=__builtin_amdgcn_mfma_f32_32x32x16_bf16(PAF(3),VFR(7),o[1],0,0,0), C1,12); \
    }while(0)
  int t=1;
  #define ENDW(tt) do{ if((tt)+3<NT){WAIT_BAR(2);} else if((tt)+2<NT){WAIT_BAR(1);} else {WAIT_BAR(0);} }while(0)
  for(;t<5&&t+1<NT;t+=2){
    STEP(pB0,pB1,pA0,pA1,t,(t+3<NT),(t+1<NT),(t+1<NT));       ENDW(t);   RESC(); ROT();
    STEP(pA0,pA1,pB0,pB1,t+1,(t+4<NT),(t+2<NT),(t+2<NT));     ENDW(t+1); RESC(); ROT();
  }
  #undef CMASK
  #define CMASK(P0,P1,t) do{}while(0)
  for(;t+5<NT;t+=2){
    STEP(pB0,pB1,pA0,pA1,t,true,true,true);     WAIT_BAR(2); RESC(); ROT();
    STEP(pA0,pA1,pB0,pB1,t+1,true,true,true);   WAIT_BAR(2); RESC(); ROT();
  }
  #undef CMASK
  #define CMASK(P0,P1,t) do{ if((t)<4)cmask(P0,P1,(t),qrel,hi); }while(0)
  for(;t+1<NT;t+=2){
    STEP(pB0,pB1,pA0,pA1,t,(t+3<NT),(t+1<NT),(t+1<NT));       ENDW(t);   RESC(); ROT();
    STEP(pA0,pA1,pB0,pB1,t+1,(t+4<NT),(t+2<NT),(t+2<NT));     ENDW(t+1); RESC(); ROT();
  }
  STEP(pB0,pB1,pA0,pA1,NT-1,false,false,false); RESC();
  { float sacc=pB0[0]+pB0[1]; _Pragma("unroll") for(int r=2;r<16;++r)sacc+=pB0[r]; _Pragma("unroll") for(int r=0;r<16;++r)sacc+=pB1[r]; l_reg+=sacc;
    pw0=(u32x4){PKW(pB0,0),PKW(pB0,2),PKW(pB0,4),PKW(pB0,6)};pw1=(u32x4){PKW(pB0,8),PKW(pB0,10),PKW(pB0,12),PKW(pB0,14)};pw2=(u32x4){PKW(pB1,0),PKW(pB1,2),PKW(pB1,4),PKW(pB1,6)};pw3=(u32x4){PKW(pB1,8),PKW(pB1,10),PKW(pB1,12),PKW(pB1,14)};
    SBAR(); pv(o,vb0+sl_cur,PAF(0),PAF(1),PAF(2),PAF(3)); }
  #undef PKW
  #undef PAF
  #undef VFR
  #undef PIN
  #undef MX3
  #undef GAPA
  #undef GAPB
  #undef EX
  #undef VRD
  #undef KRD
  #undef STEP
  #undef ENDW
  {auto rr=__builtin_amdgcn_permlane32_swap(__float_as_uint(l_reg),__float_as_uint(l_reg),false,false);l_reg=__uint_as_float(rr[0])+__uint_as_float(rr[1]);}
  if(hi==0)wsf[32+r32]=l_reg;asm volatile("s_waitcnt lgkmcnt(0)":::"memory");
  float rli[16];
  #pragma unroll
  for(int r=0;r<16;++r)rli[r]=__builtin_amdgcn_rcpf(wsf[32+crow(r,hi)]);
  bf16*Ow=O+(rowbase+q0+wid*QBLK)*OPITCH+h*D;
  { bf16*stg=(bf16*)(shm+LDS_OST)+wid*2048;
    #pragma unroll
    for(int r=0;r<16;++r){const int orow=crow(r,hi);
      #pragma unroll
      for(int d0=0;d0<2;++d0)stg[orow*64+d0*32+r32]=__float2bfloat16(o[d0][r]*rli[r]);}
    asm volatile("s_waitcnt lgkmcnt(0)":::"memory");
    const int ch=lane&7; float gg[8];
    #pragma unroll
    for(int i=0;i<8;++i)gg[i]=GG[h*D+ch*8+i];
    #pragma unroll
    for(int i=0;i<4;++i){const int row=i*8+(lane>>3); const u32x4 v=*(const u32x4*)(stg+row*64+ch*8);
      float x[8]; x[0]=__uint_as_float(v.x<<16);x[1]=__uint_as_float(v.x&0xffff0000u);x[2]=__uint_as_float(v.y<<16);x[3]=__uint_as_float(v.y&0xffff0000u);
      x[4]=__uint_as_float(v.z<<16);x[5]=__uint_as_float(v.z&0xffff0000u);x[6]=__uint_as_float(v.w<<16);x[7]=__uint_as_float(v.w&0xffff0000u);
      float ss=0.f;
      #pragma unroll
      for(int k=0;k<8;++k)ss+=x[k]*x[k];
      ss+=__shfl_xor(ss,1);ss+=__shfl_xor(ss,2);ss+=__shfl_xor(ss,4);
      const float rs=rsqrtf(ss*(1.f/64.f)+1e-6f);
      const float qn=rs*ATTN_YQ; unsigned w0=0u,w1=0u;
      #pragma unroll
      for(int k=0;k<4;++k){const int a=(int)fminf(fmaxf(__builtin_rintf(x[k]*qn),-127.f),127.f),b=(int)fminf(fmaxf(__builtin_rintf(x[4+k]*qn),-127.f),127.f); w0|=((unsigned)a&0xffu)<<(8*k); w1|=((unsigned)b&0xffu)<<(8*k);}
      st8_wt((void*)((unsigned char*)O+((rowbase+q0+wid*QBLK+row)*(long)OPITCH+h*D+ch*8)),(unsigned long long)w0|((unsigned long long)w1<<32));} }
  asm volatile("s_waitcnt lgkmcnt(0)\n\ts_barrier":::"memory");
  #undef DMA_K
  #undef PT
  #undef DMA_V
  #undef CMASK
  #undef START
  #undef RESC
  #undef ROT
}
constexpr int ATTN_LDS_BYTES=LDS_BYTES;
struct AttnTensors { const bf16* Q; const bf16* K; const bf16* V; bf16* O; const float* KSUM; const float* GG; };
struct AttnUnit { int bh; int qb; };
struct StaticOrder {
  int vcu,G;
  __device__ __forceinline__ explicit StaticOrder(int grid,int block):vcu((grid%8==0)?(block%8)*(grid/8)+block/8:block),G(grid){}
  __device__ __forceinline__ bool next(int i,AttnUnit&u)const{ const int pr=vcu+(i>>1)*G; if(pr>=256)return false; const int s=pr&7; u.bh=pr>>3; u.qb=(i&1)?s:15-s; return true; }
  __device__ __forceinline__ void a_ready(const AttnUnit&)const{}
  __device__ __forceinline__ void done(const AttnUnit&)const{}
};
template<class Sched,int THRL=8> __device__ __forceinline__ void attn_phase(char*lds,const AttnTensors&T,const Sched&S){
  AttnUnit u;
  for(int i=0;S.next(i,u);++i){ S.a_ready(u); attn_unit<THRL>(u.bh/NHEAD,u.bh%NHEAD,u.qb,T.Q,T.K,T.V,T.O,T.KSUM,T.GG,lds); S.done(u); }
}
#undef SBAR
#undef WAIT_BAR
}

#define GAS __attribute__((address_space(1)))
#define LAS __attribute__((address_space(3)))
typedef unsigned short bf16;
typedef unsigned v4u __attribute__((ext_vector_type(4)));
typedef float f32x4 __attribute__((ext_vector_type(4)));
typedef short bf16x8 __attribute__((ext_vector_type(8)));
typedef GAS unsigned gu32;
typedef GAS unsigned long long gu64;
#define RLX_AGENT __ATOMIC_RELAXED, __HIP_MEMORY_SCOPE_AGENT
#define LDS_WAIT() asm volatile("s_waitcnt lgkmcnt(0)" ::: "memory")
#define VM_WAIT() asm volatile("s_waitcnt vmcnt(0)" ::: "memory")
__device__ __forceinline__ unsigned long long rt() { return __builtin_amdgcn_s_memrealtime(); }
__device__ __forceinline__ unsigned f2bf(float f) { unsigned u = __builtin_bit_cast(unsigned, f); return (u + 0x7fffu + ((u >> 16) & 1u)) >> 16; }
__device__ __forceinline__ unsigned pk2(float lo, float hi) { return f2bf(lo) | (f2bf(hi) << 16); }

#define XB_TMO      128
#define XB_XCNT(j)  (256  + 64 * (j))
#define XB_XSUB(j)  (1280 + 64 * (j))
#define XB_XGEN(j)  (2304 + 64 * (j))
#define XB_TOP      3328
#define XB_TOPGEN   3392
#define XCD_BAR_WORDS 3456
#define XB_SPIN_CAP (1u << 18)

__device__ __forceinline__ unsigned xb_ld(unsigned* p)              { return __hip_atomic_load(p, __ATOMIC_RELAXED, __HIP_MEMORY_SCOPE_AGENT); }
__device__ __forceinline__ unsigned xb_add(unsigned* p, unsigned v) { return __hip_atomic_fetch_add(p, v, __ATOMIC_RELAXED, __HIP_MEMORY_SCOPE_AGENT); }
__device__ __forceinline__ unsigned xb_xcc_id() { return (unsigned)__builtin_amdgcn_s_getreg((3 << 11) | 20) & 0xFu; }
#define XB_SPIN(cond, bar) do { unsigned _sp = 0; while (cond) { __builtin_amdgcn_s_sleep(1); \
    if ((++_sp & 255u) == 0u) { if (xb_ld(&(bar)[XB_TMO])) break; if (_sp > XB_SPIN_CAP) { atomicAdd(&(bar)[XB_TMO], 1u); break; } } } } while (0)

struct XcdBarrier {
    unsigned* bar; unsigned x;
    volatile LAS unsigned* st;
};

__device__ __forceinline__ XcdBarrier xcd_barrier_post(unsigned* bar, volatile LAS unsigned* st) {
    XcdBarrier b; b.bar = bar; b.x = xb_xcc_id(); b.st = st;
    if (threadIdx.x == 0) (void)xb_add(&bar[XB_XCNT(b.x)], 1u);
    return b;
}
__device__ __forceinline__ void xcd_barrier_complete(unsigned* bar, unsigned x, unsigned& nloc, unsigned& nx) {
    const unsigned G = gridDim.x * gridDim.y * gridDim.z;
    unsigned sum, cnt, mine, sp = 0u;
    for (;;) {
        sum = 0u; cnt = 0u; mine = 0u;
#pragma unroll
        for (unsigned j = 0; j < 16; ++j) { const unsigned c = xb_ld(&bar[XB_XCNT(j)]); sum += c; cnt += (c > 0u) ? 1u : 0u; mine = (j == x) ? c : mine; }
        if (sum == G) break;
        __builtin_amdgcn_s_sleep(1);
        if ((++sp & 255u) == 0u) { if (xb_ld(&bar[XB_TMO])) break; if (sp > XB_SPIN_CAP) { atomicAdd(&bar[XB_TMO], 1u); break; } }
    }
    nloc = mine > 0u ? mine : 1u; nx = cnt > 0u ? cnt : 1u;
}

__device__ __forceinline__ void xcd_barrier(const XcdBarrier& b) {
    asm volatile("s_waitcnt vmcnt(0)" ::: "memory");
    __syncthreads();
    if (threadIdx.x == 0) {
        unsigned* bar = b.bar;
        __builtin_amdgcn_s_waitcnt(0);
        unsigned nloc = b.st[0], nx = b.st[1];
        if (nloc == 0u) { xcd_barrier_complete(bar, b.x, nloc, nx); b.st[0] = nloc; b.st[1] = nx; }
        const unsigned old = xb_add(&bar[XB_XSUB(b.x)], 1u);
        const unsigned gen = old / nloc;
        if (old + 1u == (gen + 1u) * nloc) {
            asm volatile("s_waitcnt vmcnt(0)" ::: "memory");
            const unsigned og = xb_add(&bar[XB_TOP], 1u);
            const unsigned tg = og / nx;
            if (og + 1u == (tg + 1u) * nx) xb_add(&bar[XB_TOPGEN], 1u);
            else XB_SPIN(xb_ld(&bar[XB_TOPGEN]) == tg, bar);
            __builtin_amdgcn_fence(__ATOMIC_ACQUIRE, "agent");
            xb_add(&bar[XB_XGEN(b.x)], 1u);
            asm volatile("s_waitcnt vmcnt(0)" ::: "memory");
        } else {
            XB_SPIN(xb_ld(&bar[XB_XGEN(b.x)]) == gen, bar);
            __builtin_amdgcn_fence(__ATOMIC_ACQUIRE, "agent");
            asm volatile("s_waitcnt vmcnt(0)" ::: "memory");
        }
    }
    __syncthreads();
}

constexpr int NWAVES = 8;
constexpr int NB = 4, S = 4096, D = 1024, M = NB * S;
constexpr int NIN = 3072, NQ = 2048, NEXP = 16384;
constexpr float EPS = 1e-6f;
constexpr float C2 = 0.125f * 1.4426950408889634f;

constexpr size_t MiB = 1u << 20;
constexpr size_t WS_CTL = 0, CTL_ZERO_BYTES = 256 * 1024;
constexpr size_t WS_MOD = 1 * MiB;
constexpr size_t WS_KMEAN = 128 * 1024;
constexpr size_t WS_KEYS = 1 * MiB + 512 * 1024;
constexpr size_t WS_WIN = 2 * MiB, WS_WO = 8 * MiB, WS_WQ = 10 * MiB;
constexpr size_t WS_EIDX = 14 * MiB, WS_G = 22 * MiB;
constexpr size_t WS_U = 32 * MiB, WS_V = 64 * MiB;
constexpr size_t WS_SU = 48 * MiB, WS_SV = 48 * MiB + 64 * 1024;
constexpr size_t WS_H = 96 * MiB;
constexpr size_t WS_P = 128 * MiB;
constexpr size_t WS_QP = 128 * MiB, WS_O = 192 * MiB;
constexpr size_t WS_Y = 224 * MiB, WS_END = 256 * MiB;
constexpr int CW_BAR = 1024;
constexpr int CW_CMAX = 8192;
constexpr int CW_CMAX3 = CW_CMAX + 3072 + 2048;
constexpr float YQ = 127.f / 6.f;
constexpr int CW_CMAX2 = CW_CMAX + 3072;
constexpr size_t WS_WO8 = 47 * MiB;
constexpr size_t WS_WQ8 = 45 * MiB, WS_RS2 = 44 * MiB + 65536;
constexpr size_t WS_WIN8 = 40 * MiB, WS_RS = 44 * MiB;

constexpr int LDS_BYTES = 153600;
constexpr int LDSCTL_OFF = LDS_BYTES - 512, MISC_OFF = LDSCTL_OFF + 320;
constexpr int RING_BYTES = 131072;

struct Frame {
    LAS unsigned char* lds;
    volatile LAS unsigned* MISC;
    gu32* ctl;
    int tid, lane, wave, G;
    const float *x, *c, *ada_w, *ada_b, *pre_gain, *post_gain, *w_in, *conv_w, *group_gain, *w_out, *fpre_gain, *fpost_gain, *wq, *keys, *pu, *pv;
    float* out;
    float* mod; float* kmean; bf16* keysb; bf16 *WinT, *WoT, *WqT; int* eidx; float* gw; unsigned char *U8, *V8; float *su, *sv; bf16 *H, *P, *QP, *O, *Y; float* scratch; unsigned char* Win8; float* rs; unsigned char* Wq8; float* rs2; unsigned char* Wo8;
};

__device__ __forceinline__ float wave_sum(float v) {
#pragma unroll
    for (int o = 1; o < 64; o <<= 1) v += __shfl_xor(v, o);
    return v;
}
__device__ __forceinline__ float bflo(unsigned u) { return __uint_as_float(u << 16); }
__device__ __forceinline__ float bfhi(unsigned u) { return __uint_as_float(u & 0xffff0000u); }

struct TItem { const float* W; bf16* WT; int N, k0, n0; };
__device__ __forceinline__ void p0_titem_load(const TItem& t, f32x4 (&v)[8], int lane) {
#pragma unroll
    for (int i = 0; i < 8; ++i) { const int kk = 8 * i + (lane >> 3); v[i] = *(const GAS f32x4*)(t.W + (size_t)(t.k0 + kk) * t.N + t.n0 + 4 * (lane & 7)); }
}
__device__ __forceinline__ void p0_titem_process(const TItem& t, const f32x4 (&v)[8], LAS float* scr, int lane) {
#pragma unroll
    for (int i = 0; i < 8; ++i) { const int kk = 8 * i + (lane >> 3); LAS float* d = scr + kk * 33 + 4 * (lane & 7); d[0] = v[i].x; d[1] = v[i].y; d[2] = v[i].z; d[3] = v[i].w; }
    LDS_WAIT(); asm volatile("" ::: "memory");
    const int c = lane & 7;
#pragma unroll
    for (int j = 0; j < 4; ++j) { const int n = (lane >> 3) + 8 * j; const LAS float* s = scr + (8 * c) * 33 + n;
        v4u o; o.x = pk2(s[0 * 33], s[1 * 33]); o.y = pk2(s[2 * 33], s[3 * 33]); o.z = pk2(s[4 * 33], s[5 * 33]); o.w = pk2(s[6 * 33], s[7 * 33]);
        st16_wt((void*)(t.WT + (size_t)(t.n0 + n) * D + t.k0 + 8 * c), o); }
    LDS_WAIT(); asm volatile("" ::: "memory");
}
__device__ __forceinline__ void cvt8(const float* src, bf16* dst, size_t i8) {
    const f32x4 a = *(const GAS f32x4*)(src + i8 * 8), b = *(const GAS f32x4*)(src + i8 * 8 + 4);
    v4u o; o.x = pk2(a.x, a.y); o.y = pk2(a.z, a.w); o.z = pk2(b.x, b.y); o.w = pk2(b.z, b.w);
    st16_wt((void*)(dst + i8 * 8), o);
}
__device__ __forceinline__ void p0_prep(Frame& F) {
    {
        LAS float* sc = (LAS float*)F.lds;
        LAS float* red = sc + 4096;
        bool did = false;
        for (int it = blockIdx.x; it < 192; it += F.G) {
            if (!did) { float cv[8];
#pragma unroll
                for (int i = 0; i < 8; ++i) cv[i] = *(const GAS float*)(F.c + F.tid + 512 * i);
#pragma unroll
                for (int i = 0; i < 8; ++i) sc[F.tid + 512 * i] = cv[i] * __builtin_amdgcn_rcpf(1.f + __expf(-cv[i]));
                did = true; }
            __syncthreads();
            const int c4 = F.tid & 7, ks = F.tid >> 3, j0 = it * 32 + 4 * c4;
            f32x4 w[16];
#pragma unroll
            for (int i = 0; i < 16; ++i) w[i] = *(const GAS f32x4*)(F.ada_w + (size_t)(ks * 16 + i) * 6144 + j0);
            f32x4 a0 = {0.f, 0.f, 0.f, 0.f}, a1 = a0, a2 = a0, a3 = a0;
#pragma unroll
            for (int i = 0; i < 16; ++i) { const int r = ks * 16 + i; a0 += w[i] * sc[r]; a1 += w[i] * sc[1024 + r]; a2 += w[i] * sc[2048 + r]; a3 += w[i] * sc[3072 + r]; }
            *(LAS f32x4*)(red + (ks * 4 + 0) * 32 + 4 * c4) = a0; *(LAS f32x4*)(red + (ks * 4 + 1) * 32 + 4 * c4) = a1;
            *(LAS f32x4*)(red + (ks * 4 + 2) * 32 + 4 * c4) = a2; *(LAS f32x4*)(red + (ks * 4 + 3) * 32 + 4 * c4) = a3;
            __syncthreads();
            if (F.tid < 128) { const int b = F.tid >> 5, jj = F.tid & 31; float s = 0.f;
#pragma unroll 16
                for (int k = 0; k < 64; ++k) s += red[(k * 4 + b) * 32 + jj];
                __hip_atomic_store(F.mod + b * 6144 + it * 32 + jj, s + F.ada_b[it * 32 + jj], __ATOMIC_RELAXED, __HIP_MEMORY_SCOPE_AGENT); }
        }
        __syncthreads();
    }
    LAS float* scr = (LAS float*)(F.lds + F.wave * 16384);
    const int gwv = blockIdx.x * NWAVES + F.wave, NGW = F.G * NWAVES;
    constexpr int I_IN = (D / 64) * (NIN / 32), I_O = (D / 64) * (D / 32), I_Q = (D / 64) * (NQ / 32), I_ALL = I_IN + I_O + I_Q;
    auto titem = [&](int it) { TItem t; int r = it;
        if (r < I_IN) { t.W = F.w_in; t.WT = F.WinT; t.N = NIN; }
        else if (r < I_IN + I_O) { r -= I_IN; t.W = F.w_out; t.WT = F.WoT; t.N = D; }
        else { r -= I_IN + I_O; t.W = F.wq; t.WT = F.WqT; t.N = NQ; }
        const int nblk = t.N / 32; t.k0 = 64 * (r / nblk); t.n0 = 32 * (r % nblk); return t; };
    { f32x4 va[8], vb[8]; TItem ta, tb;
      int it = gwv;
      if (it < I_ALL) { ta = titem(it); p0_titem_load(ta, va, F.lane); }
      while (it < I_ALL) {
          const int i1 = it + NGW; const bool h1 = i1 < I_ALL;
          if (h1) { tb = titem(i1); p0_titem_load(tb, vb, F.lane); }
          p0_titem_process(ta, va, scr, F.lane);
          if (!h1) break;
          it = i1 + NGW;
          if (it < I_ALL) { ta = titem(it); p0_titem_load(ta, va, F.lane); }
          p0_titem_process(tb, vb, scr, F.lane);
      } }
    const size_t gt = (size_t)blockIdx.x * 512 + F.tid, NT = (size_t)F.G * 512;
    for (size_t i = gt; i < (size_t)16 * 128 * 128 / 8; i += NT) cvt8(F.keys, F.keysb, i);
}
__device__ __forceinline__ void p0_tables(Frame& F) {
    const int gwv = blockIdx.x * NWAVES + F.wave, NGW = F.G * NWAVES;
    for (int row0 = gwv; row0 < 2 * NEXP; row0 += 2 * NGW) {
      f32x4 a2[2][4];
#pragma unroll
      for (int rr = 0; rr < 2; ++rr) { const int row = row0 + rr * NGW; if (row < 2 * NEXP) { const GAS f32x4* src = (const GAS f32x4*)(((row >> 14) ? F.pv : F.pu) + (size_t)(row & (NEXP - 1)) * D + 16 * F.lane);
#pragma unroll
          for (int i = 0; i < 4; ++i) a2[rr][i] = src[i]; } }
#pragma unroll
      for (int rr = 0; rr < 2; ++rr) { const int row = row0 + rr * NGW; if (row >= 2 * NEXP) break;
        const int tabv = row >> 14, e = row & (NEXP - 1);
        f32x4 a[4]; float ssq = 0.f;
#pragma unroll
        for (int i = 0; i < 4; ++i) { a[i] = a2[rr][i]; ssq += (a[i].x * a[i].x + a[i].y * a[i].y) + (a[i].z * a[i].z + a[i].w * a[i].w); }
        ssq = wave_sum(ssq);
        const float rms = sqrtf(ssq * (1.f / D));
        if (tabv == 0) {
            const float stepq = 0.34f * rms, isq = stepq > 0.f ? 1.f / stepq : 0.f;
            unsigned d0 = 0u, d1 = 0u;
#pragma unroll
            for (int i = 0; i < 4; ++i) { const float xs[4] = {a[i].x, a[i].y, a[i].z, a[i].w};
#pragma unroll
                for (int c = 0; c < 4; ++c) { const int q = (int)fminf(fmaxf(__builtin_rintf(xs[c] * isq), -7.f), 7.f); const int el = 4 * i + c;
                    if (el < 8) d0 |= (unsigned)(q & 15) << (4 * el); else d1 |= (unsigned)(q & 15) << (4 * (el - 8)); } }
            st8_wt((void*)(F.U8 + (size_t)e * 512 + 8 * F.lane), (unsigned long long)d0 | ((unsigned long long)d1 << 32));
            if (F.lane == 0) __hip_atomic_store(F.su + e, stepq, __ATOMIC_RELAXED, __HIP_MEMORY_SCOPE_AGENT);
        } else {
            const float unit = 0.5f * rms, iu = unit > 0.f ? 1.f / unit : 0.f;
            unsigned d0 = 0u, d1 = 0u;
            d0 = __builtin_amdgcn_cvt_scalef32_pk_fp4_f32(d0, a[0].x * iu, a[0].y * iu, 1.0f, 0); d0 = __builtin_amdgcn_cvt_scalef32_pk_fp4_f32(d0, a[0].z * iu, a[0].w * iu, 1.0f, 1);
            d0 = __builtin_amdgcn_cvt_scalef32_pk_fp4_f32(d0, a[1].x * iu, a[1].y * iu, 1.0f, 2); d0 = __builtin_amdgcn_cvt_scalef32_pk_fp4_f32(d0, a[1].z * iu, a[1].w * iu, 1.0f, 3);
            d1 = __builtin_amdgcn_cvt_scalef32_pk_fp4_f32(d1, a[2].x * iu, a[2].y * iu, 1.0f, 0); d1 = __builtin_amdgcn_cvt_scalef32_pk_fp4_f32(d1, a[2].z * iu, a[2].w * iu, 1.0f, 1);
            d1 = __builtin_amdgcn_cvt_scalef32_pk_fp4_f32(d1, a[3].x * iu, a[3].y * iu, 1.0f, 2); d1 = __builtin_amdgcn_cvt_scalef32_pk_fp4_f32(d1, a[3].z * iu, a[3].w * iu, 1.0f, 3);
            st8_wt((void*)(F.V8 + (size_t)(F.lane >> 4) * (NEXP * 128) + (size_t)e * 128 + (F.lane & 15) * 8), (unsigned long long)d0 | ((unsigned long long)d1 << 32));
            if (F.lane == 0) __hip_atomic_store(F.sv + e, unit, __ATOMIC_RELAXED, __HIP_MEMORY_SCOPE_AGENT);
        }
      }
    }
}

__device__ __forceinline__ unsigned q8x4(const f32x4 v, float qs) {
    const int a = (int)__builtin_rintf(v.x * qs), b = (int)__builtin_rintf(v.y * qs), c = (int)__builtin_rintf(v.z * qs), d = (int)__builtin_rintf(v.w * qs);
    return ((unsigned)a & 0xffu) | (((unsigned)b & 0xffu) << 8) | (((unsigned)c & 0xffu) << 16) | ((unsigned)d << 24);
}
__device__ __forceinline__ unsigned q8x4c(const f32x4 v, float qs) {
    const int a = (int)fminf(fmaxf(__builtin_rintf(v.x * qs), -127.f), 127.f), b = (int)fminf(fmaxf(__builtin_rintf(v.y * qs), -127.f), 127.f);
    const int c = (int)fminf(fmaxf(__builtin_rintf(v.z * qs), -127.f), 127.f), d = (int)fminf(fmaxf(__builtin_rintf(v.w * qs), -127.f), 127.f);
    return ((unsigned)a & 0xffu) | (((unsigned)b & 0xffu) << 8) | (((unsigned)c & 0xffu) << 16) | ((unsigned)d << 24);
}
__device__ __forceinline__ void p1_hnorm(Frame& F) {
    const int gwv = blockIdx.x * NWAVES + F.wave, NGW = F.G * NWAVES;
    for (int m0 = gwv * 4; m0 < M; m0 += NGW * 4) {
        const int b = m0 >> 12;
        f32x4 v[4][4];
#pragma unroll
        for (int r = 0; r < 4; ++r) { const GAS f32x4* xr = (const GAS f32x4*)(F.x + (size_t)(m0 + r) * D) + F.lane;
#pragma unroll
            for (int j = 0; j < 4; ++j) v[r][j] = xr[64 * j]; }
        f32x4 gs[4], sh[4];
#pragma unroll
        for (int j = 0; j < 4; ++j) { const int col = 4 * F.lane + 256 * j;
            gs[j] = *(const GAS f32x4*)(F.pre_gain + col) * (*(const GAS f32x4*)(F.mod + b * 6144 + 1024 + col) + 1.f); sh[j] = *(const GAS f32x4*)(F.mod + b * 6144 + col); }
#pragma unroll
        for (int r = 0; r < 4; ++r) {
            float ss = 0.f;
#pragma unroll
            for (int j = 0; j < 4; ++j) ss += (v[r][j].x * v[r][j].x + v[r][j].y * v[r][j].y) + (v[r][j].z * v[r][j].z + v[r][j].w * v[r][j].w);
            const float rstd = rsqrtf(wave_sum(ss) * (1.f / D) + EPS);
            f32x4 o[4]; float am = 0.f;
#pragma unroll
            for (int j = 0; j < 4; ++j) { o[j] = v[r][j] * rstd * gs[j] + sh[j]; am = fmaxf(am, fmaxf(fmaxf(fabsf(o[j].x), fabsf(o[j].y)), fmaxf(fabsf(o[j].z), fabsf(o[j].w)))); }
#pragma unroll
            for (int of = 1; of < 64; of <<= 1) am = fmaxf(am, __shfl_xor(am, of));
            const float qs = am > 0.f ? 127.f / am : 0.f;
            v4u w; w.x = q8x4(o[0], qs); w.y = q8x4(o[1], qs); w.z = q8x4(o[2], qs); w.w = q8x4(o[3], qs);
            st16_wt((void*)((unsigned char*)F.H + (size_t)(m0 + r) * D + 16 * F.lane), w);
            if (F.lane == 0) __hip_atomic_store(F.rs + m0 + r, am * (1.f / 127.f), __ATOMIC_RELAXED, __HIP_MEMORY_SCOPE_AGENT);
        }
    }
    for (int n = gwv; n < NIN; n += NGW) {
        const GAS unsigned long long* src = (const GAS unsigned long long*)(F.WinT + (size_t)n * D) + F.lane;
        unsigned long long q[4];
#pragma unroll
        for (int j = 0; j < 4; ++j) q[j] = src[64 * j];
        f32x4 wv[4]; float am = 0.f;
#pragma unroll
        for (int j = 0; j < 4; ++j) { const unsigned lo = (unsigned)q[j], hi = (unsigned)(q[j] >> 32); wv[j] = (f32x4){bflo(lo), bfhi(lo), bflo(hi), bfhi(hi)};
            am = fmaxf(am, fmaxf(fmaxf(fabsf(wv[j].x), fabsf(wv[j].y)), fmaxf(fabsf(wv[j].z), fabsf(wv[j].w)))); }
#pragma unroll
        for (int of = 1; of < 64; of <<= 1) am = fmaxf(am, __shfl_xor(am, of));
        const float qs = am > 0.f ? 127.f / am : 0.f;
        v4u w; w.x = q8x4(wv[0], qs); w.y = q8x4(wv[1], qs); w.z = q8x4(wv[2], qs); w.w = q8x4(wv[3], qs);
        st16_wt((void*)(F.Win8 + (size_t)n * D + 16 * F.lane), w);
        if (F.lane == 0) __hip_atomic_store((unsigned*)(F.ctl + CW_CMAX + n), __float_as_uint(am), __ATOMIC_RELAXED, __HIP_MEMORY_SCOPE_AGENT);
    }
    f32x4 gk[4];
#pragma unroll
    for (int i = 0; i < 4; ++i) gk[i] = *(const GAS f32x4*)(F.group_gain + 16 * F.lane + 4 * i) * (1.f / YQ);
    for (int n = gwv; n < NQ + D; n += NGW) {
        const bool isq = n < NQ; const int nn = isq ? n : n - NQ;
        const GAS v4u* src = (const GAS v4u*)((isq ? F.WqT : F.WoT) + (size_t)nn * D + 16 * F.lane);
        const v4u q0 = src[0], q1 = src[1];
        f32x4 wv[4] = {(f32x4){bflo(q0.x), bfhi(q0.x), bflo(q0.y), bfhi(q0.y)}, (f32x4){bflo(q0.z), bfhi(q0.z), bflo(q0.w), bfhi(q0.w)}, (f32x4){bflo(q1.x), bfhi(q1.x), bflo(q1.y), bfhi(q1.y)}, (f32x4){bflo(q1.z), bfhi(q1.z), bflo(q1.w), bfhi(q1.w)}};
        float am = 0.f;
#pragma unroll
        for (int j = 0; j < 4; ++j) { if (!isq) wv[j] = wv[j] * gk[j]; am = fmaxf(am, fmaxf(fmaxf(fabsf(wv[j].x), fabsf(wv[j].y)), fmaxf(fabsf(wv[j].z), fabsf(wv[j].w)))); }
#pragma unroll
        for (int of = 1; of < 64; of <<= 1) am = fmaxf(am, __shfl_xor(am, of));
        const float qs = am > 0.f ? 127.f / am : 0.f;
        v4u w; w.x = q8x4(wv[0], qs); w.y = q8x4(wv[1], qs); w.z = q8x4(wv[2], qs); w.w = q8x4(wv[3], qs);
        st16_wt((void*)((isq ? F.Wq8 : F.Wo8) + (size_t)nn * D + 16 * F.lane), w);
        if (F.lane == 0) __hip_atomic_store((unsigned*)(F.ctl + (isq ? CW_CMAX2 : CW_CMAX3) + nn), __float_as_uint(am), __ATOMIC_RELAXED, __HIP_MEMORY_SCOPE_AGENT);
    }
}

__device__ __forceinline__ void unpack8(const v4u w, float* f) { f[0] = bflo(w.x); f[1] = bfhi(w.x); f[2] = bflo(w.y); f[3] = bfhi(w.y); f[4] = bflo(w.z); f[5] = bfhi(w.z); f[6] = bflo(w.w); f[7] = bfhi(w.w); }
__device__ __forceinline__ void p6_conv(Frame& F) {
    const int gwv = blockIdx.x * NWAVES + F.wave, NGW = F.G * NWAVES;
    const int col = 8 * F.lane;
    float cw[3][8], gg[8];
#pragma unroll
    for (int j = 0; j < 3; ++j)
#pragma unroll
        for (int i = 0; i < 8; ++i) cw[j][i] = F.conv_w[j * 512 + col + i];
#pragma unroll
    for (int i = 0; i < 8; ++i) gg[i] = F.group_gain[col + i];
    for (int t0 = gwv * 4; t0 < M; t0 += NGW * 4) {
        const int s0 = t0 & 4095;
        v4u gbw[4], gcw[6], hxw[6];
#pragma unroll
        for (int r = 0; r < 4; ++r) gbw[r] = *(const GAS v4u*)(F.P + (size_t)(t0 + r) * NIN + col);
#pragma unroll
        for (int k = 0; k < 6; ++k) { const int tt = (s0 == 0 && k < 2) ? t0 : (t0 - 2 + k);
            const bf16* rp = F.P + (size_t)tt * NIN + col; gcw[k] = *(const GAS v4u*)(rp + 512); hxw[k] = *(const GAS v4u*)(rp + 1024); }
        float u[6][8];
#pragma unroll
        for (int k = 0; k < 6; ++k) { float gc[8], hx[8]; unpack8(gcw[k], gc); unpack8(hxw[k], hx); const float keep = (s0 == 0 && k < 2) ? 0.f : 1.f;
#pragma unroll
            for (int i = 0; i < 8; ++i) u[k][i] = keep * gc[i] * hx[i]; }
#pragma unroll
        for (int r = 0; r < 4; ++r) {
            float acc[8], gb[8]; unpack8(gbw[r], gb);
            float ss = 0.f;
#pragma unroll
            for (int i = 0; i < 8; ++i) { acc[i] = gb[i] * (cw[0][i] * u[r][i] + cw[1][i] * u[r + 1][i] + cw[2][i] * u[r + 2][i]); ss += acc[i] * acc[i]; }
            ss += __shfl_xor(ss, 1); ss += __shfl_xor(ss, 2); ss += __shfl_xor(ss, 4);
            const float rstd = rsqrtf(ss * (1.f / 64.f) + EPS);
            const float qn = rstd * YQ;
            const unsigned w0 = q8x4c((f32x4){acc[0], acc[1], acc[2], acc[3]}, qn), w1 = q8x4c((f32x4){acc[4], acc[5], acc[6], acc[7]}, qn);
            st8_wt((void*)((unsigned char*)F.Y + (size_t)(t0 + r) * D + col), (unsigned long long)w0 | ((unsigned long long)w1 << 32));
        }
    }
}
__device__ __forceinline__ void p8_resid(Frame& F) {
    const int gwv = blockIdx.x * NWAVES + F.wave, NGW = F.G * NWAVES;
    for (int m0 = gwv * 2; m0 < M; m0 += NGW * 2) {
        const float* md = F.mod + (m0 >> 12) * 6144;
        unsigned long long ow[2][4]; f32x4 xv[2][4];
#pragma unroll
        for (int r = 0; r < 2; ++r) {
            const GAS unsigned long long* orow = (const GAS unsigned long long*)(F.O + (size_t)(m0 + r) * D) + F.lane; const GAS f32x4* xr = (const GAS f32x4*)(F.x + (size_t)(m0 + r) * D) + F.lane;
#pragma unroll
            for (int j = 0; j < 4; ++j) { ow[r][j] = orow[64 * j]; xv[r][j] = xr[64 * j]; } }
        f32x4 gg[4], gs[4], sh[4];
#pragma unroll
        for (int j = 0; j < 4; ++j) { const int col = 4 * F.lane + 256 * j;
            gg[j] = *(const GAS f32x4*)(F.post_gain + col) * *(const GAS f32x4*)(md + 2048 + col);
            gs[j] = *(const GAS f32x4*)(F.fpre_gain + col) * (*(const GAS f32x4*)(md + 4096 + col) + 1.f); sh[j] = *(const GAS f32x4*)(md + 3072 + col); }
#pragma unroll
        for (int r = 0; r < 2; ++r) { const int m = m0 + r;
            f32x4 ov[4]; float ss = 0.f;
#pragma unroll
            for (int j = 0; j < 4; ++j) { const unsigned lo = (unsigned)ow[r][j], hi = (unsigned)(ow[r][j] >> 32); ov[j] = (f32x4){bflo(lo), bfhi(lo), bflo(hi), bfhi(hi)};
                ss += (ov[j].x * ov[j].x + ov[j].y * ov[j].y) + (ov[j].z * ov[j].z + ov[j].w * ov[j].w); }
            const float rstd = rsqrtf(wave_sum(ss) * (1.f / D) + EPS);
            GAS unsigned long long* x1r = (GAS unsigned long long*)(F.QP + (size_t)m * D) + F.lane;
            f32x4 x1[4]; float s2 = 0.f;
#pragma unroll
            for (int j = 0; j < 4; ++j) { x1[j] = xv[r][j] + gg[j] * (ov[j] * rstd); st8_wt((void*)(x1r + 64 * j), (unsigned long long)pk2(x1[j].x, x1[j].y) | ((unsigned long long)pk2(x1[j].z, x1[j].w) << 32));
                s2 += (x1[j].x * x1[j].x + x1[j].y * x1[j].y) + (x1[j].z * x1[j].z + x1[j].w * x1[j].w); }
            const float rstd2 = rsqrtf(wave_sum(s2) * (1.f / D) + EPS);
            f32x4 o[4]; float am = 0.f;
#pragma unroll
            for (int j = 0; j < 4; ++j) { o[j] = x1[j] * rstd2 * gs[j] + sh[j]; am = fmaxf(am, fmaxf(fmaxf(fabsf(o[j].x), fabsf(o[j].y)), fmaxf(fabsf(o[j].z), fabsf(o[j].w)))); }
#pragma unroll
            for (int of = 1; of < 64; of <<= 1) am = fmaxf(am, __shfl_xor(am, of));
            const float qs = am > 0.f ? 119.f / am : 0.f;
#pragma unroll
            for (int j = 0; j < 4; ++j) st4_wt((void*)((unsigned char*)F.H + (size_t)m * D + 4 * F.lane + 256 * j), q8x4(o[j], qs));
            if (F.lane == 0) __hip_atomic_store(F.rs2 + m, am * (1.f / 119.f), __ATOMIC_RELAXED, __HIP_MEMORY_SCOPE_AGENT);
        }
    }
}
typedef float f32x16 __attribute__((ext_vector_type(16)));
__device__ __forceinline__ float vmaxf(float a, float b) { float r; asm("v_max_f32_e32 %0, %1, %2" : "=v"(r) : "v"(a), "v"(b)); return r; }
__device__ __forceinline__ float vminf(float a, float b) { float r; asm("v_min_f32_e32 %0, %1, %2" : "=v"(r) : "v"(a), "v"(b)); return r; }
#define CE_D(a, b) do { const float hi_ = vmaxf(a, b), lo_ = vminf(a, b); a = hi_; b = lo_; } while (0)
template <int N> __device__ __forceinline__ void bitonic_sort_desc(float (&v)[N]) {
#pragma unroll
    for (int k = 2; k <= N; k <<= 1)
#pragma unroll
        for (int j = k >> 1; j > 0; j >>= 1)
#pragma unroll
            for (int i = 0; i < N; ++i) { const int l = i ^ j; if (l > i) { if ((i & k) == 0) CE_D(v[i], v[l]); else CE_D(v[l], v[i]); } }
}
template <int N> __device__ __forceinline__ void bitonic_merge_desc(float (&v)[N]) {
#pragma unroll
    for (int j = N >> 1; j > 0; j >>= 1)
#pragma unroll
        for (int i = 0; i < N; ++i) { const int l = i ^ j; if (l > i) CE_D(v[i], v[l]); }
}
__device__ __forceinline__ void sort16_desc(float (&v)[16]) {
    CE_D(v[0], v[1]); CE_D(v[2], v[3]); CE_D(v[0], v[2]); CE_D(v[1], v[3]); CE_D(v[1], v[2]); CE_D(v[4], v[5]); CE_D(v[6], v[7]); CE_D(v[4], v[6]); CE_D(v[5], v[7]); CE_D(v[5], v[6]); CE_D(v[0], v[4]); CE_D(v[2], v[6]); CE_D(v[2], v[4]); CE_D(v[1], v[5]); CE_D(v[3], v[7]); CE_D(v[3], v[5]); CE_D(v[1], v[2]); CE_D(v[3], v[4]); CE_D(v[5], v[6]); CE_D(v[8], v[9]); CE_D(v[10], v[11]); CE_D(v[8], v[10]); CE_D(v[9], v[11]); CE_D(v[9], v[10]); CE_D(v[12], v[13]); CE_D(v[14], v[15]); CE_D(v[12], v[14]); CE_D(v[13], v[15]); CE_D(v[13], v[14]); CE_D(v[8], v[12]); CE_D(v[10], v[14]); CE_D(v[10], v[12]); CE_D(v[9], v[13]); CE_D(v[11], v[15]); CE_D(v[11], v[13]); CE_D(v[9], v[10]); CE_D(v[11], v[12]); CE_D(v[13], v[14]); CE_D(v[0], v[8]); CE_D(v[4], v[12]); CE_D(v[4], v[8]); CE_D(v[2], v[10]); CE_D(v[6], v[14]); CE_D(v[6], v[10]); CE_D(v[2], v[4]); CE_D(v[6], v[8]); CE_D(v[10], v[12]); CE_D(v[1], v[9]); CE_D(v[5], v[13]); CE_D(v[5], v[9]); CE_D(v[3], v[11]); CE_D(v[7], v[15]); CE_D(v[7], v[11]); CE_D(v[3], v[5]); CE_D(v[7], v[9]); CE_D(v[11], v[13]); CE_D(v[1], v[2]); CE_D(v[3], v[4]); CE_D(v[5], v[6]); CE_D(v[7], v[8]); CE_D(v[9], v[10]); CE_D(v[11], v[12]); CE_D(v[13], v[14]);
}
__device__ __forceinline__ void top16_merge(float (&a)[16], const float (&b)[16]) {
#pragma unroll
    for (int i = 0; i < 16; ++i) a[i] = vmaxf(a[i], b[15 - i]);
    bitonic_merge_desc<16>(a);
}
__device__ __forceinline__ void top16_of_64(const float (&v)[64], float (&out)[16]) {
    float g1[16], g2[16], g3[16];
#pragma unroll
    for (int i = 0; i < 16; ++i) { out[i] = v[i]; g1[i] = v[16 + i]; g2[i] = v[32 + i]; g3[i] = v[48 + i]; }
    sort16_desc(out); sort16_desc(g1); sort16_desc(g2); sort16_desc(g3);
    top16_merge(out, g1); top16_merge(g2, g3); top16_merge(out, g2);
}
constexpr int KROW = 272, KIMG = 128 * KROW;
__device__ __forceinline__ void route_half(const bf16x8 (&bq)[8], const LAS unsigned char* kimg, int r32, int hh, float (&svp)[16], unsigned (&ivp)[16]) {
    const LAS unsigned char* krow = kimg + r32 * KROW + 16 * hh;
    f32x16 acc[4];
#pragma unroll
    for (int nt = 0; nt < 4; ++nt) {
        acc[nt] = (f32x16){0.f, 0.f, 0.f, 0.f, 0.f, 0.f, 0.f, 0.f, 0.f, 0.f, 0.f, 0.f, 0.f, 0.f, 0.f, 0.f};
#pragma unroll
        for (int ks = 0; ks < 8; ++ks) { const bf16x8 ak = *(const LAS bf16x8*)(krow + nt * 32 * KROW + 32 * ks);
            acc[nt] = __builtin_amdgcn_mfma_f32_32x32x16_bf16(ak, bq[ks], acc[nt], 0, 0, 0); }
    }
    float v[64];
#pragma unroll
    for (int nt = 0; nt < 4; ++nt)
#pragma unroll
        for (int i = 0; i < 16; ++i) { const unsigned code = (unsigned)(32 * nt + 8 * (i >> 2) + (i & 3)); v[nt * 16 + i] = __uint_as_float((__float_as_uint(acc[nt][i]) & ~127u) | code); }
    float L[16], Pn[16];
    top16_of_64(v, L);
#pragma unroll
    for (int i = 0; i < 16; ++i) { L[i] = __uint_as_float(__float_as_uint(L[i]) | (unsigned)(hh << 2)); Pn[i] = __shfl_xor(L[i], 32); }
    top16_merge(L, Pn);
#pragma unroll
    for (int i = 0; i < 16; ++i) { const unsigned bits = __float_as_uint(L[i]); svp[i] = __uint_as_float(bits & ~127u); ivp[i] = bits & 127u; }
}
__device__ __forceinline__ void route_finish(const float (&sv)[2][16], const unsigned (&iv)[2][16], LAS unsigned* tab, int lane, int hh, int* epi, float* gpf, float rst) {
#define CAND(a, b) __uint_as_float((__float_as_uint(sv[0][a] + sv[1][b]) & ~255u) | (unsigned)((a) * 16 + (b)))
    float W[16], g1[16], g2[16];
#pragma unroll
    for (int i = 0; i < 16; ++i) W[i] = CAND(0, i);
#pragma unroll
    for (int i = 0; i < 15; ++i) g1[i] = CAND(i + 1, 0);
    g1[15] = -3e38f;
    g2[0] = CAND(1, 1); g2[1] = CAND(1, 2); g2[2] = CAND(1, 3); g2[3] = CAND(1, 4); g2[4] = CAND(1, 5); g2[5] = CAND(1, 6); g2[6] = CAND(1, 7);
    g2[7] = CAND(2, 1); g2[8] = CAND(2, 2); g2[9] = CAND(2, 3); g2[10] = CAND(2, 4); g2[11] = CAND(3, 1); g2[12] = CAND(3, 2); g2[13] = CAND(3, 3); g2[14] = CAND(4, 1); g2[15] = CAND(4, 2);
    sort16_desc(g2);
    g2[13] = vmaxf(g2[13], CAND(7, 1)); g2[14] = vmaxf(g2[14], CAND(6, 1)); g2[15] = vmaxf(g2[15], CAND(5, 1));
    bitonic_merge_desc<16>(g2);
    top16_merge(W, g1); top16_merge(W, g2);
#undef CAND
#pragma unroll
    for (int j = 0; j < 16; ++j) { tab[j * 64 + lane] = iv[0][j]; tab[(16 + j) * 64 + lane] = iv[1][j]; }
    float e[16], sum = 0.f; unsigned ex[16];
    const float s0 = __uint_as_float(__float_as_uint(W[0]) & ~255u);
#pragma unroll
    for (int j = 0; j < 16; ++j) { const unsigned bits = __float_as_uint(W[j]); const unsigned code = bits & 255u;
        e[j] = __expf((__uint_as_float(bits & ~255u) - s0) * rst); sum += e[j];
        ex[j] = tab[(code >> 4) * 64 + lane] * 128u + tab[(16 + (code & 15u)) * 64 + lane]; }
    const float inv = 1.f / sum;
    v4u eo0, eo1; f32x4 go0, go1;
    eo0.x = hh ? ex[8] : ex[0]; eo0.y = hh ? ex[9] : ex[1]; eo0.z = hh ? ex[10] : ex[2]; eo0.w = hh ? ex[11] : ex[3];
    eo1.x = hh ? ex[12] : ex[4]; eo1.y = hh ? ex[13] : ex[5]; eo1.z = hh ? ex[14] : ex[6]; eo1.w = hh ? ex[15] : ex[7];
    go0.x = (hh ? e[8] : e[0]) * inv; go0.y = (hh ? e[9] : e[1]) * inv; go0.z = (hh ? e[10] : e[2]) * inv; go0.w = (hh ? e[11] : e[3]) * inv;
    go1.x = (hh ? e[12] : e[4]) * inv; go1.y = (hh ? e[13] : e[5]) * inv; go1.z = (hh ? e[14] : e[6]) * inv; go1.w = (hh ? e[15] : e[7]) * inv;
    GAS v4u* ep = (GAS v4u*)epi; GAS f32x4* gp = (GAS f32x4*)gpf;
    st16_wt((void*)ep, eo0); st16_wt((void*)(ep + 1), eo1); st16_wt((void*)gp, __builtin_bit_cast(wt_v4u, go0)); st16_wt((void*)(gp + 1), __builtin_bit_cast(wt_v4u, go1));
}
__device__ __forceinline__ pg8::f32x4 i2f(const pg8::f32x4 a) { const pg8::i32x4 i = __builtin_bit_cast(pg8::i32x4, a); return (pg8::f32x4){(float)i[0], (float)i[1], (float)i[2], (float)i[3]}; }
struct EpiRoute {
    static constexpr bool PERM = true, AFTER_DRAIN = true;
    const bf16* keysb; int* eidx; float* gw; const unsigned* cmax2; const float* rs2;
    __device__ __forceinline__ void fused(pg8::f32x4 (&acc)[2][2][4][2], const pg8::Unit& u, int wr, int wc, int fr, int fq, LAS unsigned char* lds, int wid, int lane) const {
        int tid_ = threadIdx.x; asm volatile("" : "+v"(tid_)); const int h = u.pn, r32 = lane & 31, hh = lane >> 5, tid = tid_;
        LAS unsigned char* Qs = lds; LAS unsigned char* Ks = lds + 256 * KROW;
        const float rst = rs2[u.pm * 256 + 32 * wid + r32];
        v4u q1[2][4];
#pragma unroll
        for (int ai = 0; ai < 2; ++ai)
#pragma unroll
            for (int m = 0; m < 4; ++m) { const pg8::f32x4 a = i2f(acc[ai][1][m][0]), b = i2f(acc[ai][1][m][1]);
                q1[ai][m] = (v4u){pg8::cvt_pk_bf16(a[0], a[1]), pg8::cvt_pk_bf16(a[2], a[3]), pg8::cvt_pk_bf16(b[0], b[1]), pg8::cvt_pk_bf16(b[2], b[3])}; }
        float sv[2][16]; unsigned iv[2][16];
#pragma unroll
        for (int p = 0; p < 2; ++p) {
            if (p == 1) { asm volatile("s_waitcnt lgkmcnt(0)" ::: "memory"); __builtin_amdgcn_s_barrier(); asm volatile("" ::: "memory"); }
#pragma unroll
            for (int ai = 0; ai < 2; ++ai)
#pragma unroll
                for (int m = 0; m < 4; ++m) { v4u w;
                    if (p == 0) { const pg8::f32x4 a = i2f(acc[ai][0][m][0]), b = i2f(acc[ai][0][m][1]);
                        w = (v4u){pg8::cvt_pk_bf16(a[0], a[1]), pg8::cvt_pk_bf16(a[2], a[3]), pg8::cvt_pk_bf16(b[0], b[1]), pg8::cvt_pk_bf16(b[2], b[3])}; }
                    else w = q1[ai][m];
                    *(LAS v4u*)(Qs + (128 * ai + 64 * wr + 16 * m + fr) * KROW + (32 * wc + 8 * fq) * 2) = w; }
            { const int ch = tid & 15, kr = tid >> 4;
              const pg8::u32x4 c0 = *(const pg8::u32x4*)(cmax2 + h * 256 + p * 128 + ch * 8), c1 = *(const pg8::u32x4*)(cmax2 + h * 256 + p * 128 + ch * 8 + 4);
              v4u kq[4];
#pragma unroll
              for (int i = 0; i < 4; ++i) kq[i] = *(const GAS v4u*)(keysb + (size_t)((h * 2 + p) * 128 + kr + 32 * i) * 128 + ch * 8);
              float cs[8] = {__uint_as_float(c0.x), __uint_as_float(c0.y), __uint_as_float(c0.z), __uint_as_float(c0.w), __uint_as_float(c1.x), __uint_as_float(c1.y), __uint_as_float(c1.z), __uint_as_float(c1.w)};
#pragma unroll
              for (int i = 0; i < 8; ++i) cs[i] *= (1.f / 127.f);
#pragma unroll
              for (int i = 0; i < 4; ++i) { const v4u q = kq[i];
                v4u ko; ko.x = pk2(bflo(q.x) * cs[0], bfhi(q.x) * cs[1]); ko.y = pk2(bflo(q.y) * cs[2], bfhi(q.y) * cs[3]); ko.z = pk2(bflo(q.z) * cs[4], bfhi(q.z) * cs[5]); ko.w = pk2(bflo(q.w) * cs[6], bfhi(q.w) * cs[7]);
                *(LAS v4u*)(Ks + (kr + 32 * i) * KROW + ch * 16) = ko; } }
            asm volatile("s_waitcnt vmcnt(0) lgkmcnt(0)" ::: "memory"); __builtin_amdgcn_s_barrier(); asm volatile("" ::: "memory");
            bf16x8 bq[8];
#pragma unroll
            for (int ks = 0; ks < 8; ++ks) bq[ks] = *(const LAS bf16x8*)(Qs + (32 * wid + r32) * KROW + 32 * ks + 16 * hh);
            route_half(bq, Ks, r32, hh, sv[p], iv[p]);
        }
        asm volatile("s_waitcnt lgkmcnt(0)" ::: "memory"); __builtin_amdgcn_s_barrier(); asm volatile("" ::: "memory");
        const int t = u.pm * 256 + 32 * wid + r32;
        route_finish(sv, iv, (LAS unsigned*)(lds + wid * 8192), lane, hh, eidx + (size_t)t * 128 + h * 16 + 8 * hh, gw + (size_t)t * 128 + h * 16 + 8 * hh, rst);
        asm volatile("s_waitcnt lgkmcnt(0)" ::: "memory"); __builtin_amdgcn_s_barrier(); asm volatile("" ::: "memory");
    }
};
struct OneUnit {
    pg8::Unit u;
    __device__ __forceinline__ bool next(int i, pg8::Unit& o) const { if (i != 0) return false; o = u; return true; }
    __device__ __forceinline__ void a_ready(const pg8::Unit&) const {}
    __device__ __forceinline__ void done(const pg8::Unit&) const {}
};
__device__ __forceinline__ float gelu_tanh(float a) {
    const float z = 0.7978845608028654f * (a + 0.044715f * a * a * a);
    const float e = __expf(2.f * z);
    const float th = 1.f - 2.f / (e + 1.f);
    return 0.5f * a * (1.f + th);
}
typedef float f32x2v __attribute__((ext_vector_type(2)));
__device__ __forceinline__ void fp8x16_to_f32(const v4u w, float* f) {
    f32x2v t;
    t = __builtin_amdgcn_cvt_pk_f32_fp8((int)w.x, false); f[0] = t.x; f[1] = t.y; t = __builtin_amdgcn_cvt_pk_f32_fp8((int)w.x, true); f[2] = t.x; f[3] = t.y;
    t = __builtin_amdgcn_cvt_pk_f32_fp8((int)w.y, false); f[4] = t.x; f[5] = t.y; t = __builtin_amdgcn_cvt_pk_f32_fp8((int)w.y, true); f[6] = t.x; f[7] = t.y;
    t = __builtin_amdgcn_cvt_pk_f32_fp8((int)w.z, false); f[8] = t.x; f[9] = t.y; t = __builtin_amdgcn_cvt_pk_f32_fp8((int)w.z, true); f[10] = t.x; f[11] = t.y;
    t = __builtin_amdgcn_cvt_pk_f32_fp8((int)w.w, false); f[12] = t.x; f[13] = t.y; t = __builtin_amdgcn_cvt_pk_f32_fp8((int)w.w, true); f[14] = t.x; f[15] = t.y;
}
#define DPPF(x, ctrl) __uint_as_float((unsigned)__builtin_amdgcn_mov_dpp((int)__float_as_uint(x), ctrl, 0xf, 0xf, true))
__device__ __forceinline__ void swap16_add(float& a, float b) { auto r = __builtin_amdgcn_permlane16_swap(__float_as_uint(a), __float_as_uint(b), false, false); a = __uint_as_float(r[0]) + __uint_as_float(r[1]); }
__device__ __forceinline__ void swap32_add(float& a, float b) { auto r = __builtin_amdgcn_permlane32_swap(__float_as_uint(a), __float_as_uint(b), false, false); a = __uint_as_float(r[0]) + __uint_as_float(r[1]); }
constexpr int PW_BUF0 = 0, PW_SG = 4096, PW_BUF1 = 8192, PW_E = 16384, PW_WH = 17408, PW_WL = 17920, PW_YP = 18432, PW_IK = 18944, PW_BYTES = 18976;
static_assert(PW_BYTES * NWAVES <= LDSCTL_OFF, "PEER per-wave LDS blocks must stay below the control words");
typedef int v8i_t __attribute__((ext_vector_type(8)));
typedef int v2i_t __attribute__((ext_vector_type(2)));
__device__ __forceinline__ void peer_u_issue(v4u (&uw)[8], const unsigned char* U4, LAS unsigned char* wl, int it, int lane) {
    const int grp = it >> 2, j = it & 3, hw = lane >> 5, li = lane & 31;
#pragma unroll
    for (int q = 0; q < 8; ++q) { const unsigned e = *(const LAS unsigned short*)(wl + PW_E + (j * 128 + grp * 16 + 2 * q + hw) * 2);
        uw[q] = *(const GAS v4u*)(U4 + (e * 512u + 16u * (unsigned)li)); }
}
__device__ __forceinline__ void peer_u_compute(const v4u (&uw)[8], LAS unsigned char* wl, int it, int lane) {
    const int grp = it >> 2, j = it & 3, li = lane & 31;
    const v4u hh = *(LAS v4u*)(wl + j * 1024 + 16 * li), hl = *(LAS v4u*)(wl + j * 1024 + 512 + 16 * li);
    float pa[8];
#pragma unroll
    for (int q = 0; q < 8; ++q) {
        int dh = __builtin_amdgcn_sdot8((int)uw[q].x, (int)hh.x, 0, false); dh = __builtin_amdgcn_sdot8((int)uw[q].y, (int)hh.y, dh, false);
        dh = __builtin_amdgcn_sdot8((int)uw[q].z, (int)hh.z, dh, false); dh = __builtin_amdgcn_sdot8((int)uw[q].w, (int)hh.w, dh, false);
        int dl = __builtin_amdgcn_sdot8((int)uw[q].x, (int)hl.x, 0, false); dl = __builtin_amdgcn_sdot8((int)uw[q].y, (int)hl.y, dl, false);
        dl = __builtin_amdgcn_sdot8((int)uw[q].z, (int)hl.z, dl, false); dl = __builtin_amdgcn_sdot8((int)uw[q].w, (int)hl.w, dl, false);
        pa[q] = (float)(16 * dh + dl); }
    swap16_add(pa[0], pa[4]); swap16_add(pa[1], pa[5]); swap16_add(pa[2], pa[6]); swap16_add(pa[3], pa[7]);
#pragma unroll
    for (int i = 0; i < 4; ++i) { pa[i] += DPPF(pa[i], 0xB1); pa[i] += DPPF(pa[i], 0x4E); pa[i] += DPPF(pa[i], 0x141); pa[i] += DPPF(pa[i], 0x140); }
    if ((lane & 12) == 0) {
        const int q = lane & 3, r = lane >> 4;
        const int idx = j * 128 + grp * 16 + 2 * (q + 4 * (r & 1)) + (r >> 1);
        const f32x2v sg = *(const LAS f32x2v*)(wl + PW_SG + idx * 8);
        const float a = (q == 0 ? pa[0] : q == 1 ? pa[1] : q == 2 ? pa[2] : pa[3]) * sg.x;
        *(LAS float*)(wl + PW_BUF1 + idx * 4) = sg.y * gelu_tanh(a);
    }
}
__device__ __forceinline__ void peer_v_issue(const unsigned char* V8, LAS unsigned char* wl, unsigned lbase, int it, int lane, unsigned c16e, unsigned c16o) {
    const int sl = it >> 3, j = (it >> 1) & 3, hf = it & 1;
    const unsigned char* vbase = V8 + (size_t)sl * (NEXP * 128);
    const unsigned dst = lbase + PW_BUF0 + (it & 1) * 8192;
    unsigned go[8];
#pragma unroll
    for (int q = 0; q < 8; ++q) { const unsigned e = *(const LAS unsigned short*)(wl + PW_E + (j * 128 + 64 * hf + 8 * q + (lane >> 3)) * 2); go[q] = e * 128u + ((q & 1) ? c16o : c16e); }
#pragma unroll
    for (int q = 0; q < 8; ++q) attn_body::glds16s(vbase, go[q], (unsigned)__builtin_amdgcn_readfirstlane((int)(dst + q * 1024)));
}
__device__ __forceinline__ void peer_v_compute(LAS unsigned char* wl, f32x4 (&acc)[8], bf16* yrow0, int it, int lane) {
    const int sl = it >> 3, j = (it >> 1) & 3, hf = it & 1;
    const int m = lane & 15, kg = lane >> 4;
    const LAS unsigned char* wsrc = wl + ((m & 1) ? PW_WL : PW_WH) + j * 128 + 64 * hf + 16 * (kg & 1);
    const v4u a0 = *(const LAS v4u*)wsrc, a1 = *(const LAS v4u*)(wsrc + 32);
    const bool valid = (m < 4) && ((m >> 1) == (kg >> 1));
    v8i_t A;
    A[0] = valid ? (int)a0.x : 0; A[1] = valid ? (int)a0.y : 0; A[2] = valid ? (int)a0.z : 0; A[3] = valid ? (int)a0.w : 0;
    A[4] = valid ? (int)a1.x : 0; A[5] = valid ? (int)a1.y : 0; A[6] = valid ? (int)a1.z : 0; A[7] = valid ? (int)a1.w : 0;
    if (hf == 0) {
#pragma unroll
        for (int T = 0; T < 8; ++T) acc[T] = (f32x4){0.f, 0.f, 0.f, 0.f};
    }
    const LAS unsigned char* bb = wl + PW_BUF0 + (it & 1) * 8192 + (32 * (kg >> 1) + m) * 128 + 8 * (kg & 1);
    const unsigned x16 = (unsigned)(m >> 1) * 16u;
#pragma unroll
    for (int T = 0; T < 8; ++T) {
        const LAS unsigned char* p = bb + ((16u * T) ^ x16);
        const v2i_t b0 = __builtin_amdgcn_ds_read_tr4_b64_v2i32((LAS v2i_t*)p), b1 = __builtin_amdgcn_ds_read_tr4_b64_v2i32((LAS v2i_t*)(p + 2048));
        const v8i_t B = {b0.x, b0.y, b1.x, b1.y, 0, 0, 0, 0};
        acc[T] = __builtin_amdgcn_mfma_scale_f32_16x16x128_f8f6f4(A, B, acc[T], 0, 4, 0, 0x7f7f7f7f, 0, 0x7f7f7f7f);
    }
    if (hf == 1) {
        const float ik = *(const LAS float*)(wl + PW_IK + j * 4);
        LAS unsigned char* yp = lane < 16 ? wl + PW_YP + m * 2 : wl + PW_IK + 16;
        const int ystep = lane < 16 ? 1 : 0;
#pragma unroll
        for (int T = 0; T < 8; ++T) {
            *(LAS unsigned short*)(yp + ystep * (64 * T)) = (unsigned short)f2bf((acc[T][0] + acc[T][1]) * ik);
            *(LAS unsigned short*)(yp + ystep * (64 * T + 32)) = (unsigned short)f2bf((acc[T][2] + acc[T][3]) * ik);
        }
        asm volatile("" ::: "memory");
        const unsigned long long pk = *(const LAS unsigned long long*)(wl + PW_YP + 8 * lane);
        *(GAS unsigned long long*)(yrow0 + (size_t)j * D + 256 * sl + 4 * lane) = pk;
    }
}
__device__ __forceinline__ void p11_peer(Frame& F, float* dst) {
    const int gwv = blockIdx.x * NWAVES + F.wave, NGW = F.G * NWAVES, lane = F.lane;
    LAS unsigned char* wl = F.lds + F.wave * PW_BYTES;
    const unsigned lbase = (unsigned)__builtin_amdgcn_readfirstlane((int)(unsigned)(size_t)wl);
    const unsigned c16e = (unsigned)(((lane & 7) ^ (lane >> 4)) * 16), c16o = (unsigned)(((lane & 7) ^ (4 + (lane >> 4))) * 16);
    const unsigned char* U8 = F.U8; const unsigned char* V8 = F.V8;
    for (int t0 = gwv * 4; t0 < M; t0 += NGW * 4) {
        bf16* yrow0 = F.Y + (size_t)t0 * D;
        v4u hq4[4]; float hinv4[4]; int e4[4][2]; float g4[4][2], su4[4][2], sv4[4][2];
#pragma unroll
        for (int j = 0; j < 4; ++j) { const int t = t0 + j;
            hq4[j] = *(const GAS v4u*)((const unsigned char*)F.H + (size_t)t * D + 16 * lane); hinv4[j] = *(const GAS float*)(F.rs2 + t);
            e4[j][0] = *(const GAS int*)(F.eidx + (size_t)t * 128 + lane); e4[j][1] = *(const GAS int*)(F.eidx + (size_t)t * 128 + 64 + lane);
            g4[j][0] = *(const GAS float*)(F.gw + (size_t)t * 128 + lane); g4[j][1] = *(const GAS float*)(F.gw + (size_t)t * 128 + 64 + lane); }
#pragma unroll
        for (int j = 0; j < 4; ++j)
#pragma unroll
            for (int k = 0; k < 2; ++k) { su4[j][k] = *(const GAS float*)(F.su + e4[j][k]); sv4[j][k] = *(const GAS float*)(F.sv + e4[j][k]); }
#pragma unroll
        for (int j = 0; j < 4; ++j) {
            const float hinv = hinv4[j];
            const unsigned hw[4] = {hq4[j].x, hq4[j].y, hq4[j].z, hq4[j].w};
            unsigned hh0 = 0u, hh1 = 0u, hl0 = 0u, hl1 = 0u;
#pragma unroll
            for (int i = 0; i < 16; ++i) { const int hv_ = (int)(signed char)((hw[i >> 2] >> (8 * (i & 3))) & 0xffu); const int lo = ((hv_ + 8) & 15) - 8; const int hi = (hv_ - lo) >> 4;
                if (i < 8) { hh0 |= (unsigned)(hi & 15) << (4 * i); hl0 |= (unsigned)(lo & 15) << (4 * i); } else { hh1 |= (unsigned)(hi & 15) << (4 * (i - 8)); hl1 |= (unsigned)(lo & 15) << (4 * (i - 8)); } }
            *(LAS unsigned long long*)(wl + j * 1024 + 8 * lane) = (unsigned long long)hh0 | ((unsigned long long)hh1 << 32);
            *(LAS unsigned long long*)(wl + j * 1024 + 512 + 8 * lane) = (unsigned long long)hl0 | ((unsigned long long)hl1 << 32);
            const int e0 = e4[j][0], e1 = e4[j][1];
            const f32x2v sg0 = (f32x2v){su4[j][0] * hinv, g4[j][0] * sv4[j][0]}, sg1 = (f32x2v){su4[j][1] * hinv, g4[j][1] * sv4[j][1]};
            int base = 0;
#pragma unroll
            for (int sl = 0; sl < 4; ++sl) {
                const bool m0 = (e0 >> 12) == sl, m1 = (e1 >> 12) == sl;
                const unsigned long long b0 = __ballot(m0), b1 = __ballot(m1);
                const int c0 = __popcll(b0), c1 = __popcll(b1);
                const int p0 = j * 128 + base + __builtin_amdgcn_mbcnt_hi((unsigned)(b0 >> 32), __builtin_amdgcn_mbcnt_lo((unsigned)b0, 0));
                const int p1 = j * 128 + base + c0 + __builtin_amdgcn_mbcnt_hi((unsigned)(b1 >> 32), __builtin_amdgcn_mbcnt_lo((unsigned)b1, 0));
                if (m0) { *(LAS unsigned short*)(wl + PW_E + p0 * 2) = (unsigned short)e0; *(LAS f32x2v*)(wl + PW_SG + p0 * 8) = sg0; }
                if (m1) { *(LAS unsigned short*)(wl + PW_E + p1 * 2) = (unsigned short)e1; *(LAS f32x2v*)(wl + PW_SG + p1 * 8) = sg1; }
                base += c0 + c1;
            }
        }
        asm volatile("" ::: "memory");
        {
            v4u ua[8], ub[8];
            peer_u_issue(ua, U8, wl, 0, lane);
#pragma unroll 1
            for (int it = 0; it < 32; it += 2) {
                peer_u_issue(ub, U8, wl, it + 1, lane);
                __builtin_amdgcn_sched_barrier(0);
                peer_u_compute(ua, wl, it, lane);
                __builtin_amdgcn_sched_barrier(0);
                if (it + 2 < 32) peer_u_issue(ua, U8, wl, it + 2, lane);
                __builtin_amdgcn_sched_barrier(0);
                peer_u_compute(ub, wl, it + 1, lane);
                __builtin_amdgcn_sched_barrier(0);
            }
        }
#pragma unroll
        for (int j = 0; j < 4; ++j) {
            const float w0 = *(const LAS float*)(wl + PW_BUF1 + (j * 128 + lane) * 4), w1 = *(const LAS float*)(wl + PW_BUF1 + (j * 128 + 64 + lane) * 4);
            float mx = fmaxf(fabsf(w0), fabsf(w1));
#pragma unroll
            for (int o = 1; o < 64; o <<= 1) mx = fmaxf(mx, __shfl_xor(mx, o));
            int ex = (int)((__float_as_uint(mx) >> 23) & 0xffu); ex = ex < 30 ? 127 : ex;
            const float sc = __uint_as_float((unsigned)(127 + 7 + 127 - ex) << 23), isc = __uint_as_float((unsigned)(ex - 7) << 23);
            const float s0 = w0 * sc, s1 = w1 * sc;
            const int ph = __builtin_amdgcn_cvt_pk_fp8_f32(s0, s1, 0, false);
            const f32x2v hb = __builtin_amdgcn_cvt_pk_f32_fp8(ph, false);
            const int pl = __builtin_amdgcn_cvt_pk_fp8_f32(s0 - hb.x, s1 - hb.y, 0, false);
            *(LAS unsigned char*)(wl + PW_WH + j * 128 + lane) = (unsigned char)(ph & 0xff); *(LAS unsigned char*)(wl + PW_WH + j * 128 + 64 + lane) = (unsigned char)((ph >> 8) & 0xff);
            *(LAS unsigned char*)(wl + PW_WL + j * 128 + lane) = (unsigned char)(pl & 0xff); *(LAS unsigned char*)(wl + PW_WL + j * 128 + 64 + lane) = (unsigned char)((pl >> 8) & 0xff);
            if (lane == 0) *(LAS float*)(wl + PW_IK + j * 4) = isc;
        }
        v4u x1w[4][2];
#pragma unroll
        for (int j = 0; j < 4; ++j) { const GAS v4u* op = (const GAS v4u*)(F.QP + (size_t)(t0 + j) * D + 16 * lane); x1w[j][0] = op[0]; x1w[j][1] = op[1]; }
        asm volatile("s_waitcnt lgkmcnt(0)" ::: "memory");
        {
            f32x4 acc[8];
            peer_v_issue(V8, wl, lbase, 0, lane, c16e, c16o);
#pragma unroll 1
            for (int it = 0; it < 32; it += 2) {
                peer_v_issue(V8, wl, lbase, it + 1, lane, c16e, c16o);
                asm volatile("s_waitcnt vmcnt(8)" ::: "memory");
                peer_v_compute(wl, acc, yrow0, it, lane);
                asm volatile("s_waitcnt lgkmcnt(0)" ::: "memory");
                if (it + 2 < 32) { peer_v_issue(V8, wl, lbase, it + 2, lane, c16e, c16o); asm volatile("s_waitcnt vmcnt(8)" ::: "memory"); }
                else asm volatile("s_waitcnt vmcnt(0)" ::: "memory");
                peer_v_compute(wl, acc, yrow0, it + 1, lane);
                asm volatile("s_waitcnt lgkmcnt(0)" ::: "memory");
            }
        }
        asm volatile("s_waitcnt vmcnt(0)" ::: "memory");
        {
            v4u yw[4][2]; f32x4 gv[4], g2v[4];
#pragma unroll
            for (int j = 0; j < 4; ++j) { const GAS v4u* yp = (const GAS v4u*)(yrow0 + (size_t)j * D + 16 * lane); yw[j][0] = yp[0]; yw[j][1] = yp[1]; }
            { const int b = t0 >> 12;
              const GAS f32x4* gp = (const GAS f32x4*)(F.fpost_gain + 16 * lane); const GAS f32x4* g2p = (const GAS f32x4*)(F.mod + b * 6144 + 5120 + 16 * lane);
#pragma unroll
              for (int i = 0; i < 4; ++i) { gv[i] = gp[i]; g2v[i] = g2p[i] * gv[i]; } }
#pragma unroll
            for (int j = 0; j < 4; ++j) {
                const int t = t0 + j;
                float yv[16]; unpack8(yw[j][0], yv); unpack8(yw[j][1], yv + 8);
                float ss = 0.f;
#pragma unroll
                for (int i = 0; i < 16; ++i) ss += yv[i] * yv[i];
                const float rstd = rsqrtf(wave_sum(ss) * (1.f / D) + EPS);
                GAS f32x4* dp = (GAS f32x4*)(dst + (size_t)t * D + 16 * lane);
                float x1f[16]; unpack8(x1w[j][0], x1f); unpack8(x1w[j][1], x1f + 8);
#pragma unroll
                for (int i = 0; i < 4; ++i) { const f32x4 x1 = (f32x4){x1f[4 * i], x1f[4 * i + 1], x1f[4 * i + 2], x1f[4 * i + 3]};
                    const f32x4 y = (f32x4){yv[4 * i], yv[4 * i + 1], yv[4 * i + 2], yv[4 * i + 3]};
                    dp[i] = x1 + g2v[i] * (y * rstd); }
            }
        }
    }
}

__device__ __forceinline__ unsigned long long ldp(const Frame& F, int i) {
    volatile LAS unsigned* pt = (volatile LAS unsigned*)(F.lds + LDSCTL_OFF);
    const unsigned lo = pt[2 * i], hi = pt[2 * i + 1];
    return ((unsigned long long)(unsigned)__builtin_amdgcn_readfirstlane((int)hi) << 32) | (unsigned)__builtin_amdgcn_readfirstlane((int)lo);
}
__device__ __forceinline__ void load_frame(Frame& F) {
    F.lane = lane_id_fresh(); F.tid = F.wave * 64 + F.lane;
    F.x = (const float*)ldp(F, 0); F.c = (const float*)ldp(F, 1); F.ada_w = (const float*)ldp(F, 2); F.ada_b = (const float*)ldp(F, 3); F.pre_gain = (const float*)ldp(F, 4); F.post_gain = (const float*)ldp(F, 5);
    F.w_in = (const float*)ldp(F, 6); F.conv_w = (const float*)ldp(F, 7); F.group_gain = (const float*)ldp(F, 8); F.w_out = (const float*)ldp(F, 9); F.fpre_gain = (const float*)ldp(F, 10); F.fpost_gain = (const float*)ldp(F, 11);
    F.wq = (const float*)ldp(F, 12); F.keys = (const float*)ldp(F, 13); F.pu = (const float*)ldp(F, 14); F.pv = (const float*)ldp(F, 15);
    F.out = (float*)ldp(F, 16);
    unsigned char* ws = (unsigned char*)ldp(F, 17);
    F.ctl = (gu32*)(ws + WS_CTL);
    F.mod = (float*)(ws + WS_MOD); F.kmean = (float*)(ws + WS_KMEAN); F.keysb = (bf16*)(ws + WS_KEYS);
    F.WinT = (bf16*)(ws + WS_WIN); F.WoT = (bf16*)(ws + WS_WO); F.WqT = (bf16*)(ws + WS_WQ); F.eidx = (int*)(ws + WS_EIDX); F.gw = (float*)(ws + WS_G);
    F.U8 = ws + WS_U; F.V8 = ws + WS_V; F.su = (float*)(ws + WS_SU); F.sv = (float*)(ws + WS_SV); F.H = (bf16*)(ws + WS_H);
    F.P = (bf16*)(ws + WS_P); F.QP = (bf16*)(ws + WS_QP); F.O = (bf16*)(ws + WS_O); F.Y = (bf16*)(ws + WS_Y); F.scratch = (float*)(ws + WS_O); F.Win8 = ws + WS_WIN8; F.rs = (float*)(ws + WS_RS); F.Wq8 = ws + WS_WQ8; F.rs2 = (float*)(ws + WS_RS2); F.Wo8 = ws + WS_WO8;
}
struct Args { const float* in[16]; float* out; unsigned char* ws; int ph_lo, ph_hi; };
constexpr int NPHASE = 12;
template <unsigned PM> __global__ void __launch_bounds__(NWAVES * 64, 2) fwd_kernel(Args args) {
    extern __shared__ __attribute__((aligned(16))) unsigned char lds[];
    Frame F;
    F.lds = (LAS unsigned char*)lds;
    F.MISC = (volatile LAS unsigned*)(F.lds + MISC_OFF);
    F.tid = threadIdx.x; F.lane = F.tid & 63; F.wave = __builtin_amdgcn_readfirstlane(F.tid >> 6);
    F.G = gridDim.x;
    for (int u = F.tid; u < (LDS_BYTES - LDSCTL_OFF) / 4; u += NWAVES * 64) ((LAS unsigned*)(F.lds + LDSCTL_OFF))[u] = 0u;
    __syncthreads();
    if (F.tid == 0) { LAS unsigned long long* pt = (LAS unsigned long long*)(F.lds + LDSCTL_OFF);
#pragma unroll
        for (int i = 0; i < 16; ++i) pt[i] = (unsigned long long)args.in[i];
        pt[16] = (unsigned long long)args.out; pt[17] = (unsigned long long)args.ws; }
    __syncthreads();
    load_frame(F);
    const int lo = args.ph_lo, hi = args.ph_hi;
    const bool multi = (hi - lo) > 1;
    XcdBarrier bar; bar.bar = (unsigned*)(F.ctl + CW_BAR); bar.x = 0; bar.st = nullptr;
    if (multi) bar = xcd_barrier_post((unsigned*)(F.ctl + CW_BAR), F.MISC + 8);
#define IN(k) ((((PM) >> (k)) & 1u) && lo <= (k) && (k) < hi)
#define BOTH(k) (IN(k) && IN((k) + 1))
#ifndef SEAMREP
#define SEAMREP 1
#endif
#define SEAM(k) do { if (BOTH(k)) { for (int sr_ = 0; sr_ < SEAMREP; ++sr_) xcd_barrier(bar); } } while (0)
#ifndef REPMASK
#define REPMASK 0x000u
#endif
#define REPS(k) (1 + (int)(((REPMASK) >> (k)) & 1u))
    if (IN(0)) { load_frame(F); for (int r = 0; r < REPS(0); ++r) { p0_prep(F); __syncthreads(); } SEAM(0); }
    if (IN(1)) { load_frame(F); for (int r = 0; r < REPS(1); ++r) p1_hnorm(F); SEAM(1); }
    if (IN(2)) { load_frame(F);
        pg8::Gemm g{F.H, (const bf16*)F.Win8, M, NIN, D / 2}; pg8::StaticOrder So; So.init(M, NIN, F.G, (int)blockIdx.x);
        pg8::EpiBf16S<true> E{F.P, NIN, 6, 8, C2, F.kmean, 8, 10, F.rs, (const unsigned*)(F.ctl + CW_CMAX)};
        for (int r = 0; r < REPS(2); ++r) pg8::gemm_phase<pg8::EpiBf16S<true>, pg8::StaticOrder, true, true, false, true>(F.lds, g, So, E);
        if (IN(2) && IN(5)) { for (int sr_ = 0; sr_ < SEAMREP; ++sr_) xcd_barrier(bar); }
    }
    const bool stream_first = (((int)blockIdx.x >> 3) & 1) == 0;
    if (IN(5) && stream_first) { load_frame(F); p0_tables(F); }
    if (IN(6) && stream_first) { load_frame(F); p6_conv(F); }
    if (IN(5)) { load_frame(F);
        const attn_body::AttnTensors AT{(const attn_body::bf16*)(F.P + 1536), (const attn_body::bf16*)(F.P + 2048), (const attn_body::bf16*)(F.P + 2560), (attn_body::bf16*)((unsigned char*)F.Y + 512), F.kmean, F.group_gain + 512};
        const attn_body::StaticOrder So((int)F.G, (int)blockIdx.x);
        for (int r = 0; r < REPS(5); ++r) attn_body::attn_phase<attn_body::StaticOrder>((char*)lds, AT, So);
    }
    if (IN(6) && !stream_first) { load_frame(F); p6_conv(F); }
    if (IN(5) && !stream_first) { load_frame(F); p0_tables(F); }
    if (IN(6)) { SEAM(6); }
    if (IN(7)) { load_frame(F);
        pg8::Gemm g{F.Y, (const bf16*)F.Wo8, M, D, D / 2}; pg8::StaticOrder So; So.init(M, D, F.G, (int)blockIdx.x);
        pg8::EpiBf16S<true> E{F.O, D, 0, 0, 1.f, nullptr, 0, 0, nullptr, (const unsigned*)(F.ctl + CW_CMAX3)};
        for (int r = 0; r < REPS(7); ++r) pg8::gemm_phase<pg8::EpiBf16S<true>, pg8::StaticOrder, true, true, false, true>(F.lds, g, So, E);
        SEAM(7);
    }
    if (IN(8)) { load_frame(F); for (int r = 0; r < REPS(8); ++r) p8_resid(F); SEAM(8); }
    if (IN(9)) { load_frame(F);
        pg8::Gemm g{F.H, (const bf16*)F.Wq8, M, NQ, D / 2}; pg8::StaticOrder So; So.init(M, NQ, F.G, (int)blockIdx.x);
        EpiRoute E{F.keysb, F.eidx, F.gw, (const unsigned*)(F.ctl + CW_CMAX2), F.rs2};
        for (int r = 0; r < REPS(9); ++r)
            for (int i = 0; ; ++i) { OneUnit S1; if (!So.next(i, S1.u)) break; pg8::gemm_phase<EpiRoute, OneUnit, false, true, false, true>(F.lds, g, S1, E); }
        if (IN(9) && IN(11)) { for (int sr_ = 0; sr_ < SEAMREP; ++sr_) xcd_barrier(bar); }
    }
    if (IN(11)) { load_frame(F); if (REPS(11) > 1) p11_peer(F, F.scratch); p11_peer(F, F.out); }
#undef IN
#undef BOTH
#undef SEAM
}

#ifndef PMASK
#define PMASK 0xfffu
#endif
#ifndef N_LAUNCH_MODE
#define N_LAUNCH_MODE 1
#endif
template <unsigned PM> static bool set_lds() { return hipFuncSetAttribute((const void*)fwd_kernel<PM>, hipFuncAttributeMaxDynamicSharedMemorySize, LDS_BYTES) == hipSuccess; }
template <unsigned PM> static void launch1(int grid, hipStream_t stream, Args a) { hipLaunchKernelGGL(fwd_kernel<PM>, dim3(grid), dim3(NWAVES * 64), LDS_BYTES, stream, a); }
extern "C" void kernel_launch(void* const* d_in, const int* in_sizes, int n_in, void* d_out, int out_size, void* d_ws, size_t ws_size, hipStream_t stream) {
    static int grid = 0;
    if (grid == 0) {
        if (n_in != 16 || out_size != M * D || ws_size < WS_END) { fprintf(stderr, "kernel_launch: unexpected shapes n_in %d out %d ws %zu\n", n_in, out_size, ws_size); grid = -1; return; }
        int dev = 0, cus = 0;
        if (hipGetDevice(&dev) != hipSuccess || hipDeviceGetAttribute(&cus, hipDeviceAttributeMultiprocessorCount, dev) != hipSuccess) { grid = -1; return; }
        bool ok = true;
#if N_LAUNCH_MODE == 1
        ok = set_lds<PMASK>();
#elif N_LAUNCH_MODE == 3
        ok = set_lds<0x3ffu>() && set_lds<0x400u>() && set_lds<0x800u>();
#else
        ok = set_lds<1u>() && set_lds<2u>() && set_lds<4u>() && set_lds<8u>() && set_lds<16u>() && set_lds<32u>() && set_lds<64u>() && set_lds<128u>() && set_lds<256u>() && set_lds<512u>() && set_lds<1024u>() && set_lds<2048u>();
#endif
        if (!ok) { fprintf(stderr, "kernel_launch: hipFuncSetAttribute failed\n"); grid = -1; return; }
        grid = cus;
    }
    if (grid < 0) return;
    (void)hipMemsetAsync((char*)d_ws + WS_CTL, 0, CTL_ZERO_BYTES, stream);
    Args a{};
    for (int i = 0; i < 16; ++i) a.in[i] = (const float*)d_in[i];
    a.out = (float*)d_out; a.ws = (unsigned char*)d_ws;
#if N_LAUNCH_MODE == 1
    a.ph_lo = 0; a.ph_hi = NPHASE; launch1<PMASK>(grid, stream, a);
#elif N_LAUNCH_MODE == 3
    a.ph_lo = 0; a.ph_hi = 10; launch1<0x3ffu>(grid, stream, a);
    a.ph_lo = 10; a.ph_hi = 11; launch1<0x400u>(grid, stream, a);
    a.ph_lo = 11; a.ph_hi = 12; launch1<0x800u>(grid, stream, a);
#else
#define L1(p) do { a.ph_lo = (p); a.ph_hi = (p) + 1; launch1<(1u << (p))>(grid, stream, a); } while (0)
    L1(0); L1(1); L1(2); L1(3); L1(4); L1(5); L1(6); L1(7); L1(8); L1(9); L1(10); L1(11);
#undef L1
#endif
}
```

```cpp
#include <hip/hip_runtime.h>
#include <cstdio>
#include <cstdint>
#ifndef WT_STORES
#define WT_STORES 1
#endif
typedef unsigned wt_v4u __attribute__((ext_vector_type(4)));
__device__ __forceinline__ int lane_id_fresh() { int l; asm volatile("v_mbcnt_lo_u32_b32 %0, -1, 0\n\tv_mbcnt_hi_u32_b32 %0, -1, %0" : "=v"(l)); return l; }
__device__ __forceinline__ void st16_wt(void* p, wt_v4u v) {
#if WT_STORES
    asm volatile("global_store_dwordx4 %0, %1, off sc1\n\ts_nop 1" :: "v"(p), "v"(v) : "memory");
#else
    *(wt_v4u*)p = v;
#endif
}
__device__ __forceinline__ void st4_wt(void* p, unsigned v) {
#if WT_STORES
    asm volatile("global_store_dword %0, %1, off sc1\n\ts_nop 1" :: "v"(p), "v"(v) : "memory");
#else
    *(unsigned*)p = v;
#endif
}
__device__ __forceinline__ void st8_wt(void* p, unsigned long long v) {
#if WT_STORES
    asm volatile("global_store_dwordx2 %0, %1, off sc1\n\ts_nop 1" :: "v"(p), "v"(v) : "memory");
#else
    *(unsigned long long*)p = v;
#endif
}
namespace pg8 {
#define PG8_LAS __attribute__((address_space(3)))
typedef unsigned short bf16_t;
typedef short bf16x8 __attribute__((ext_vector_type(8)));
typedef float f32x4 __attribute__((ext_vector_type(4)));
typedef unsigned u32x4 __attribute__((ext_vector_type(4)));
typedef int i32x4 __attribute__((ext_vector_type(4)));
typedef int i32x8 __attribute__((ext_vector_type(8)));
constexpr int BM = 256, BK = 64, HALF = 128, HTB = HALF * BK * 2  , STAGE_BYTES = 8 * HTB, NXCD = 8, WGM = 8;

__host__ __device__ __forceinline__ int lds_byte(int r, int c) { const int st = (r >> 4) * 2 + (c >> 5), rr = r & 15, cc = c & 31, ob = rr * 64 + cc * 2; return st * 1024 + (ob ^ (((ob >> 9) & 1) << 5)); }
__host__ __device__ __forceinline__ void stage_rc(int b, int& R, int& C) { const int st = b / 1024, sb = b % 1024, swz = sb ^ (((sb >> 9) & 1) << 5); R = (st >> 1) * 16 + swz / 64; C = (st & 1) * 32 + (swz % 64) / 2; }
__host__ __device__ __forceinline__ int perm32(int rho) { const int n = rho >> 4, i = rho & 15; return 8 * (i >> 2) + 4 * n + (i & 3); }

struct Unit { int pm, pn; };
struct Gemm { const bf16_t* A; const bf16_t* Bt; int M, N, K; };

struct StaticOrder {
    int nM, nN, nwg, G, c;
    __host__ __device__ void init(int M, int N, int G_, int c_) { nM = M / BM; nN = N / BM; nwg = nM * nN; G = G_; c = c_; }
    __host__ __device__ bool next(int i, Unit& u) const {
        const long L = (long)i * G + c; if (L >= nwg) return false;
        int wgid = (int)L; { const int q = nwg / NXCD, r = nwg % NXCD, xcd = wgid % NXCD, off = wgid / NXCD; wgid = (xcd < r ? xcd * (q + 1) : r * (q + 1) + (xcd - r) * q) + off; }
        const int nig = WGM * nN, gid = wgid / nig, fm = gid * WGM, gsz = (nM - fm) < WGM ? (nM - fm) : WGM;
        u.pm = fm + ((wgid % nig) % gsz); u.pn = (wgid % nig) / gsz; return true;
    }
    __device__ __forceinline__ void a_ready(const Unit&) const {}
    __device__ __forceinline__ void done(const Unit&) const {}
};


__device__ __forceinline__ unsigned cvt_pk_bf16(float lo, float hi) { unsigned r; asm volatile("v_cvt_pk_bf16_f32 %0, %1, %2" : "=v"(r) : "v"(lo), "v"(hi)); return r; }
template <bool ACC_I32> struct EpiBf16S {
    static constexpr bool PERM = true, AFTER_DRAIN = false;
    bf16_t* O; int ldc; int sc_lo, sc_hi; float scv; float* ksum; int ks_lo, ks_hi; const float* rs; const unsigned* cmax; int fu_lo, fu_hi;
    __device__ __forceinline__ void operator()(const f32x4 (&acc)[2][2][4][2], const Unit& u, int wr, int wc, int fr_, int fq_) const {
        (void)fr_; (void)fq_;
        const int lane_ = lane_id_fresh(); const int fr = lane_ & 15, fq = lane_ >> 4;
        const int row0 = u.pm * BM + wr * 64 + fr; const int colt = u.pn * BM;
        const float sc = ((u.pn >= sc_lo && u.pn < sc_hi) ? scv : 1.f) * (ACC_I32 ? (1.f / 127.f) : (1.f / 224.f));
        const int col0 = colt + wc * 32 + 8 * fq;
        if (u.pn >= fu_lo && u.pn < fu_hi) {
            const int ocol = 512 + 128 * (u.pn - fu_lo) + wc * 32 + 8 * fq;
#pragma unroll
            for (int ai = 0; ai < 2; ++ai)
#pragma unroll
                for (int m = 0; m < 4; ++m) { f32x4 p0, p1;
                    if constexpr (ACC_I32) { const i32x4 a0 = __builtin_bit_cast(i32x4, acc[ai][0][m][0]), a1 = __builtin_bit_cast(i32x4, acc[ai][0][m][1]), b0 = __builtin_bit_cast(i32x4, acc[ai][1][m][0]), b1 = __builtin_bit_cast(i32x4, acc[ai][1][m][1]);
                        p0 = (f32x4){(float)a0[0] * (float)b0[0], (float)a0[1] * (float)b0[1], (float)a0[2] * (float)b0[2], (float)a0[3] * (float)b0[3]};
                        p1 = (f32x4){(float)a1[0] * (float)b1[0], (float)a1[1] * (float)b1[1], (float)a1[2] * (float)b1[2], (float)a1[3] * (float)b1[3]}; }
                    else { p0 = acc[ai][0][m][0] * acc[ai][1][m][0]; p1 = acc[ai][0][m][1] * acc[ai][1][m][1]; }
                    const float r1 = rs[row0 + ai * HALF + m * 16], r2 = r1 * r1;
                    const f32x4 v0 = p0 * r2, v1 = p1 * r2;
                    u32x4 w; w.x = cvt_pk_bf16(v0[0], v0[1]); w.y = cvt_pk_bf16(v0[2], v0[3]); w.z = cvt_pk_bf16(v1[0], v1[1]); w.w = cvt_pk_bf16(v1[2], v1[3]);
                    st16_wt(O + (size_t)(row0 + ai * HALF + m * 16) * ldc + ocol, w); }
            return;
        }
        float rsv[2][4];
#pragma unroll
        for (int ai = 0; ai < 2; ++ai)
#pragma unroll
            for (int m = 0; m < 4; ++m) rsv[ai][m] = rs != nullptr ? rs[row0 + ai * HALF + m * 16] : 1.f;
        const bool do_ks = ksum != nullptr && u.pn >= ks_lo && u.pn < ks_hi;
#pragma unroll
        for (int bj = 0; bj < 2; ++bj) {
            const u32x4 cb0 = *(const u32x4*)(cmax + col0 + bj * HALF), cb1 = *(const u32x4*)(cmax + col0 + bj * HALF + 4);
            const f32x4 cs0 = (f32x4){__uint_as_float(cb0.x), __uint_as_float(cb0.y), __uint_as_float(cb0.z), __uint_as_float(cb0.w)} * sc;
            const f32x4 cs1 = (f32x4){__uint_as_float(cb1.x), __uint_as_float(cb1.y), __uint_as_float(cb1.z), __uint_as_float(cb1.w)} * sc;
            f32x4 sum0 = {0.f, 0.f, 0.f, 0.f}, sum1 = sum0;
#pragma unroll
            for (int ai = 0; ai < 2; ++ai)
#pragma unroll
                for (int m = 0; m < 4; ++m) { f32x4 a0 = acc[ai][bj][m][0], a1 = acc[ai][bj][m][1];
                    if constexpr (ACC_I32) { const i32x4 i0 = __builtin_bit_cast(i32x4, a0), i1 = __builtin_bit_cast(i32x4, a1);
                        a0 = (f32x4){(float)i0[0], (float)i0[1], (float)i0[2], (float)i0[3]}; a1 = (f32x4){(float)i1[0], (float)i1[1], (float)i1[2], (float)i1[3]}; }
                    const f32x4 v0 = a0 * rsv[ai][m] * cs0, v1 = a1 * rsv[ai][m] * cs1;
                    sum0 += v0; sum1 += v1;
                    u32x4 w; w.x = cvt_pk_bf16(v0[0], v0[1]); w.y = cvt_pk_bf16(v0[2], v0[3]); w.z = cvt_pk_bf16(v1[0], v1[1]); w.w = cvt_pk_bf16(v1[2], v1[3]);
                    st16_wt(O + (size_t)(row0 + ai * HALF + m * 16) * ldc + col0 + bj * HALF, w); }
            if (do_ks) {
                float* kd = ksum + (size_t)u.pm * ((ks_hi - ks_lo) * BM) + (u.pn - ks_lo) * BM + wc * 32 + 8 * fq + bj * HALF;
#pragma unroll
                for (int n = 0; n < 2; ++n)
#pragma unroll
                    for (int i = 0; i < 4; ++i) {
                        float v = n ? sum1[i] : sum0[i];
                        v += __uint_as_float((unsigned)__builtin_amdgcn_mov_dpp((int)__float_as_uint(v), 0xB1, 0xf, 0xf, true));
                        v += __uint_as_float((unsigned)__builtin_amdgcn_mov_dpp((int)__float_as_uint(v), 0x4E, 0xf, 0xf, true));
                        v += __uint_as_float((unsigned)__builtin_amdgcn_mov_dpp((int)__float_as_uint(v), 0x141, 0xf, 0xf, true));
                        v += __uint_as_float((unsigned)__builtin_amdgcn_mov_dpp((int)__float_as_uint(v), 0x140, 0xf, 0xf, true));
                        if (fr == 0) atomicAdd(kd + 4 * n + i, v);
                    }
            }
        }
    }
};
struct EpiBf16 {
    static constexpr bool PERM = true, AFTER_DRAIN = false;
    bf16_t* O; int ldc; int sc_lo, sc_hi; float scv; float* ksum; int ks_lo, ks_hi;
    __device__ __forceinline__ void operator()(const f32x4 (&acc)[2][2][4][2], const Unit& u, int wr, int wc, int fr, int fq) const {
        const int row0 = u.pm * BM + wr * 64 + fr; const int colt = u.pn * BM;
        const float sc = (u.pn >= sc_lo && u.pn < sc_hi) ? scv : 1.f;
        const int col0 = colt + wc * 32 + 8 * fq;
#pragma unroll
        for (int ai = 0; ai < 2; ++ai)
#pragma unroll
            for (int m = 0; m < 4; ++m) { bf16_t* rowp = O + (size_t)(row0 + ai * HALF + m * 16) * ldc + col0;
#pragma unroll
                for (int bj = 0; bj < 2; ++bj) { f32x4 v0 = acc[ai][bj][m][0] * sc, v1 = acc[ai][bj][m][1] * sc;
                    u32x4 w; w.x = cvt_pk_bf16(v0[0], v0[1]); w.y = cvt_pk_bf16(v0[2], v0[3]); w.z = cvt_pk_bf16(v1[0], v1[1]); w.w = cvt_pk_bf16(v1[2], v1[3]);
                    st16_wt(rowp + bj * HALF, w); } }
        if (ksum != nullptr && u.pn >= ks_lo && u.pn < ks_hi) {
            float* kd = ksum + (size_t)u.pm * ((ks_hi - ks_lo) * BM) + (u.pn - ks_lo) * BM + wc * 32 + 8 * fq;
#pragma unroll
            for (int bj = 0; bj < 2; ++bj)
#pragma unroll
                for (int n = 0; n < 2; ++n) {
                    f32x4 cs = acc[0][bj][0][n];
#pragma unroll
                    for (int m = 1; m < 4; ++m) cs += acc[0][bj][m][n];
#pragma unroll
                    for (int m = 0; m < 4; ++m) cs += acc[1][bj][m][n];
#pragma unroll
                    for (int i = 0; i < 4; ++i) {
                        float v = cs[i];
                        v += __uint_as_float((unsigned)__builtin_amdgcn_mov_dpp((int)__float_as_uint(v), 0xB1, 0xf, 0xf, true));
                        v += __uint_as_float((unsigned)__builtin_amdgcn_mov_dpp((int)__float_as_uint(v), 0x4E, 0xf, 0xf, true));
                        v += __uint_as_float((unsigned)__builtin_amdgcn_mov_dpp((int)__float_as_uint(v), 0x141, 0xf, 0xf, true));
                        v += __uint_as_float((unsigned)__builtin_amdgcn_mov_dpp((int)__float_as_uint(v), 0x140, 0xf, 0xf, true));
                        if (fr == 0) atomicAdd(kd + bj * HALF + 4 * n + i, v);
                    }
                }
        }
    }
};

template <int OFF> __device__ __forceinline__ void dma16s(const void* sbase, unsigned voff, unsigned lds_base) { unsigned keep;
    asm volatile("s_mov_b32 %0, m0\n\ts_add_u32 m0, %3, %4\n\ts_nop 0\n\tglobal_load_lds_dwordx4 %1, %2\n\ts_mov_b32 m0, %0" : "=&s"(keep) : "v"(voff), "s"(sbase), "s"(lds_base), "i"(OFF) : "memory", "scc"); }
__device__ __forceinline__ const char* uni_ptr(const char* p) {
    const unsigned long long v = (unsigned long long)p;
    return (const char*)(((unsigned long long)(unsigned)__builtin_amdgcn_readfirstlane((int)(unsigned)(v >> 32)) << 32) | (unsigned)__builtin_amdgcn_readfirstlane((int)(unsigned)v));
}
template <class Epi, class Sched, bool ALIGN_EPI = false, bool SP2 = false, bool FP8 = false, bool I8 = false>
__device__ __forceinline__ void gemm_phase(PG8_LAS unsigned char* lds, const Gemm g, const Sched& S, const Epi& E, int tid_in) {
    int tid_ = tid_in; asm volatile("" : "+v"(tid_));
    const int tid = tid_, wid = __builtin_amdgcn_readfirstlane(tid >> 6), lane = tid & 63, wr = wid >> 2, wc = wid & 3, fr = lane & 15, fq = lane >> 4;
    const int K = g.K, nt = K / BK;
    unsigned voffA[2], voffB[2];
#pragma unroll
    for (int i = 0; i < 2; ++i) { int R, C; stage_rc(tid * 16 + i * 8192, R, C); const int Rb = Epi::PERM ? ((R & ~31) + perm32(R & 31)) : R;
        voffA[i] = (unsigned)(R * K + C) * 2u; voffB[i] = (unsigned)(Rb * K + C) * 2u; }
    const size_t qstep = (size_t)64 * K * 2;
    const size_t kstep = (size_t)(BK * 2);
    const size_t hstep = (size_t)HALF * K * 2;
    const size_t tstep = 2 * hstep;
    const unsigned ldsn = (unsigned)(size_t)lds;
    const unsigned ldsw = (unsigned)wid * 1024u;
    const unsigned ldsb = (unsigned)__builtin_amdgcn_readfirstlane((int)(ldsn + ldsw));
    const int aoff = lds_byte(wr * 64 + fr, fq * 8), boff = lds_byte(wc * 32 + fr, fq * 8);
    unsigned ldsAn = ldsn + (unsigned)aoff, ldsBn = ldsn + (unsigned)(4 * HTB) + (unsigned)boff; asm volatile("" : "+v"(ldsAn), "+v"(ldsBn));
    PG8_LAS unsigned char* const ldsA = (PG8_LAS unsigned char*)(size_t)ldsAn; PG8_LAS unsigned char* const ldsB = (PG8_LAS unsigned char*)(size_t)ldsBn;
#define PG8_SA(b, h) (((b) * 2 + (h)) * HTB)
#define PG8_SB(b, h) ((4 + (b) * 2 + (h)) * HTB)
#define PG8_STAGE(bufoff, gbase, voff) do { if constexpr (FP8 || I8) { const char* gb_ = uni_ptr((const char*)(gbase)); dma16s<(bufoff)>(gb_, (voff)[0], ldsb); dma16s<(bufoff) + 8192>(uni_ptr(gb_ + qstep), (voff)[0], ldsb); }        \
    else { _Pragma("unroll") for (int _i = 0; _i < 2; ++_i) \
        __builtin_amdgcn_global_load_lds((const unsigned*)((const char*)(gbase) + (voff)[_i]), (PG8_LAS unsigned*)(lds + (bufoff) + ldsw + _i * 8192), 16, 0, 0); } } while (0)
#define PG8_LDA(dst, b, h) do { _Pragma("unroll") for (int m = 0; m < 4; ++m) _Pragma("unroll") for (int k = 0; k < 2; ++k) dst[m][k] = *(const PG8_LAS bf16x8*)(lds + PG8_SA(b, h) + aoff + m * 2048 + k * 1024); } while (0)
#define PG8_LDB(dst, b, h) do { _Pragma("unroll") for (int n = 0; n < 2; ++n) _Pragma("unroll") for (int k = 0; k < 2; ++k) dst[n][k] = *(const PG8_LAS bf16x8*)(lds + PG8_SB(b, h) + boff + n * 2048 + k * 1024); } while (0)
#define PG8_LDA8(dst, b, h) do { _Pragma("unroll") for (int m = 0; m < 4; ++m) dst[m] = __builtin_shufflevector(*(const PG8_LAS i32x4*)(ldsA + PG8_SA(b, h) + m * 2048), *(const PG8_LAS i32x4*)(ldsA + PG8_SA(b, h) + m * 2048 + 1024), 0, 1, 2, 3, 4, 5, 6, 7); } while (0)
#define PG8_LDB8(dst, b, h) do { _Pragma("unroll") for (int n = 0; n < 2; ++n) dst[n] = __builtin_shufflevector(*(const PG8_LAS i32x4*)(ldsB + (PG8_SB(b, h) - 4 * HTB) + n * 2048), *(const PG8_LAS i32x4*)(ldsB + (PG8_SB(b, h) - 4 * HTB) + n * 2048 + 1024), 0, 1, 2, 3, 4, 5, 6, 7); } while (0)
#define PG8_MMA8(ai, bj, A8, B8) do { __builtin_amdgcn_s_setprio(1); _Pragma("unroll") for (int m = 0; m < 4; ++m) _Pragma("unroll") for (int n = 0; n < 2; ++n) \
        acc[ai][bj][m][n] = __builtin_amdgcn_mfma_scale_f32_16x16x128_f8f6f4(B8[n], A8[m], acc[ai][bj][m][n], 0, 0, 0, 0, 0, 0); __builtin_amdgcn_s_setprio(0); } while (0)
#define PG8_MMA(ai, bj, At, Bt) do { __builtin_amdgcn_s_setprio(1); _Pragma("unroll") for (int m = 0; m < 4; ++m) _Pragma("unroll") for (int n = 0; n < 2; ++n) _Pragma("unroll") for (int k = 0; k < 2; ++k) { \
        if constexpr (I8) acc[ai][bj][m][n] = __builtin_bit_cast(f32x4, __builtin_amdgcn_mfma_i32_16x16x64_i8(__builtin_bit_cast(i32x4, Bt[n][k]), __builtin_bit_cast(i32x4, At[m][k]), __builtin_bit_cast(i32x4, acc[ai][bj][m][n]), 0, 0, 0)); \
        else acc[ai][bj][m][n] = __builtin_amdgcn_mfma_f32_16x16x32_bf16(Bt[n][k], At[m][k], acc[ai][bj][m][n], 0, 0, 0); } __builtin_amdgcn_s_setprio(0); } while (0)
#define PG8_WAIT_V(n) asm volatile("s_waitcnt vmcnt(" #n ")" ::: "memory")
#define PG8_WAIT_L(n) asm volatile("s_waitcnt lgkmcnt(" #n ")" ::: "memory")
#define PG8_BAR __builtin_amdgcn_s_barrier()
#define PG8_SCHED __builtin_amdgcn_sched_barrier(0)
    Unit cur, nxt; int ui = 0;
    if (!S.next(0, cur)) return;
    f32x4 acc[2][2][4][2];
#pragma unroll
    for (int a = 0; a < 2; ++a)
#pragma unroll
        for (int b = 0; b < 2; ++b)
#pragma unroll
            for (int m = 0; m < 4; ++m)
#pragma unroll
                for (int n = 0; n < 2; ++n) acc[a][b][m][n] = (f32x4){0.f, 0.f, 0.f, 0.f};
    bf16x8 At[4][2], B0[2][2], B1[2][2];
    i32x8 A8[4], B08[2], B18[2];
    const char* cA = (const char*)g.A + (size_t)cur.pm * tstep; const char* cB = (const char*)g.Bt + (size_t)cur.pn * tstep;
    if constexpr (FP8 || I8) { cA = uni_ptr(cA); cB = uni_ptr(cB); }
    S.a_ready(cur);
    if constexpr (SP2) {
        PG8_STAGE(PG8_SB(0, 0), cB, voffB); PG8_STAGE(PG8_SB(0, 1), cB + hstep, voffB); PG8_STAGE(PG8_SA(0, 0), cA, voffA); PG8_STAGE(PG8_SA(0, 1), cA + hstep, voffA);
        if (wr == 1) PG8_BAR;
        PG8_WAIT_V(2); PG8_BAR;
        PG8_STAGE(PG8_SB(1, 0), cB + kstep, voffB); PG8_STAGE(PG8_SA(1, 0), cA + kstep, voffA); PG8_STAGE(PG8_SB(1, 1), cB + hstep + kstep, voffB);
        PG8_WAIT_V(6); PG8_BAR;
    } else {
        PG8_STAGE(PG8_SB(0, 0), cB, voffB); PG8_STAGE(PG8_SA(0, 0), cA, voffA); PG8_STAGE(PG8_SB(0, 1), cB + hstep, voffB); PG8_STAGE(PG8_SA(0, 1), cA + hstep, voffA);
        if (wr == 1) PG8_BAR;
        PG8_WAIT_V(4); PG8_BAR;
        PG8_STAGE(PG8_SB(1, 0), cB + kstep, voffB); PG8_STAGE(PG8_SA(1, 0), cA + kstep, voffA); PG8_STAGE(PG8_SB(1, 1), cB + hstep + kstep, voffB);
        PG8_WAIT_V(6); PG8_BAR;
    }
    for (;;) {
        const bool has_next = S.next(ui + 1, nxt);
        const char* nA = has_next ? (const char*)g.A + (size_t)nxt.pm * tstep : cA; const char* nB = has_next ? (const char*)g.Bt + (size_t)nxt.pn * tstep : cB;
        if constexpr (FP8 || I8) { nA = uni_ptr(nA); nB = uni_ptr(nB); }
        for (int t = 0; t < nt; t += 2) {
            const bool last = (t == nt - 2);
            if constexpr (FP8 || I8) asm volatile("" : "+v"(voffA[0]), "+v"(voffB[0]));
            const char* a1 = cA + (size_t)(t + 1) * kstep;
            const char* a2 = last ? nA : cA + (size_t)(t + 2) * kstep; const char* b2 = last ? nB : cB + (size_t)(t + 2) * kstep;
            const char* a3 = a2 + kstep; const char* b3 = b2 + kstep;
            if (last && has_next) S.a_ready(nxt);
            if constexpr (SP2 && FP8) {
            PG8_LDB8(B08, 0, 0); PG8_LDB8(B18, 0, 1); PG8_SCHED; PG8_LDA8(A8, 0, 0); PG8_STAGE(PG8_SA(1, 1), a1 + hstep, voffA);
            PG8_WAIT_V(8); PG8_WAIT_L(0); PG8_BAR; PG8_MMA8(0, 0, A8, B08); PG8_MMA8(0, 1, A8, B18); PG8_BAR; PG8_SCHED;
            PG8_LDA8(A8, 0, 1); PG8_STAGE(PG8_SB(0, 0), b2, voffB); PG8_STAGE(PG8_SB(0, 1), b2 + hstep, voffB); PG8_STAGE(PG8_SA(0, 0), a2, voffA);
            PG8_WAIT_V(8); PG8_WAIT_L(0); PG8_BAR; PG8_MMA8(1, 0, A8, B08); PG8_MMA8(1, 1, A8, B18); PG8_BAR; PG8_SCHED;
            PG8_LDB8(B08, 1, 0); PG8_LDB8(B18, 1, 1); PG8_SCHED; PG8_LDA8(A8, 1, 0); PG8_STAGE(PG8_SA(0, 1), a2 + hstep, voffA);
            PG8_WAIT_V(8); PG8_WAIT_L(0); PG8_BAR; PG8_MMA8(0, 0, A8, B08); PG8_MMA8(0, 1, A8, B18); PG8_BAR; PG8_SCHED;
            PG8_LDA8(A8, 1, 1); PG8_STAGE(PG8_SB(1, 0), b3, voffB); PG8_STAGE(PG8_SB(1, 1), b3 + hstep, voffB); PG8_STAGE(PG8_SA(1, 0), a3, voffA);
            PG8_WAIT_V(8); PG8_WAIT_L(0); PG8_BAR; PG8_MMA8(1, 0, A8, B08); PG8_MMA8(1, 1, A8, B18); PG8_BAR; PG8_SCHED;
            } else if constexpr (SP2) {
            PG8_LDB(B0, 0, 0); PG8_LDB(B1, 0, 1); PG8_SCHED; PG8_LDA(At, 0, 0); PG8_STAGE(PG8_SA(1, 1), a1 + hstep, voffA);
            PG8_WAIT_V(8); PG8_WAIT_L(0); PG8_BAR; PG8_MMA(0, 0, At, B0); PG8_MMA(0, 1, At, B1); PG8_BAR; PG8_SCHED;
            PG8_LDA(At, 0, 1); PG8_STAGE(PG8_SB(0, 0), b2, voffB); PG8_STAGE(PG8_SB(0, 1), b2 + hstep, voffB); PG8_STAGE(PG8_SA(0, 0), a2, voffA);
            PG8_WAIT_V(8); PG8_WAIT_L(0); PG8_BAR; PG8_MMA(1, 0, At, B0); PG8_MMA(1, 1, At, B1); PG8_BAR; PG8_SCHED;
            PG8_LDB(B0, 1, 0); PG8_LDB(B1, 1, 1); PG8_SCHED; PG8_LDA(At, 1, 0); PG8_STAGE(PG8_SA(0, 1), a2 + hstep, voffA);
            PG8_WAIT_V(8); PG8_WAIT_L(0); PG8_BAR; PG8_MMA(0, 0, At, B0); PG8_MMA(0, 1, At, B1); PG8_BAR; PG8_SCHED;
            PG8_LDA(At, 1, 1); PG8_STAGE(PG8_SB(1, 0), b3, voffB); PG8_STAGE(PG8_SB(1, 1), b3 + hstep, voffB); PG8_STAGE(PG8_SA(1, 0), a3, voffA);
            PG8_WAIT_V(8); PG8_WAIT_L(0); PG8_BAR; PG8_MMA(1, 0, At, B0); PG8_MMA(1, 1, At, B1); PG8_BAR; PG8_SCHED;
            } else {
            PG8_LDB(B0, 0, 0); PG8_SCHED; PG8_LDA(At, 0, 0); PG8_STAGE(PG8_SA(1, 1), a1 + hstep, voffA);
            PG8_WAIT_L(8); PG8_BAR; PG8_WAIT_L(0); PG8_MMA(0, 0, At, B0); PG8_BAR; PG8_SCHED;
            PG8_LDB(B1, 0, 1); PG8_STAGE(PG8_SB(0, 0), b2, voffB);
            PG8_BAR; PG8_WAIT_L(0); PG8_MMA(0, 1, At, B1); PG8_BAR;
            PG8_LDA(At, 0, 1); PG8_STAGE(PG8_SA(0, 0), a2, voffA);
            PG8_BAR; PG8_WAIT_L(0); PG8_MMA(1, 0, At, B0); PG8_BAR; PG8_SCHED;
            PG8_STAGE(PG8_SB(0, 1), b2 + hstep, voffB);
            PG8_WAIT_V(6); PG8_BAR; PG8_MMA(1, 1, At, B1); PG8_BAR;
            PG8_LDB(B0, 1, 0); PG8_SCHED; PG8_LDA(At, 1, 0); PG8_STAGE(PG8_SA(0, 1), a2 + hstep, voffA);
            PG8_WAIT_L(8); PG8_BAR; PG8_WAIT_L(0); PG8_MMA(0, 0, At, B0); PG8_BAR; PG8_SCHED;
            PG8_LDB(B1, 1, 1); PG8_STAGE(PG8_SB(1, 0), b3, voffB);
            PG8_BAR; PG8_WAIT_L(0); PG8_MMA(0, 1, At, B1); PG8_BAR;
            PG8_LDA(At, 1, 1); PG8_STAGE(PG8_SA(1, 0), a3, voffA);
            PG8_BAR; PG8_WAIT_L(0); PG8_MMA(1, 0, At, B0); PG8_BAR; PG8_SCHED;
            PG8_STAGE(PG8_SB(1, 1), b3 + hstep, voffB);
            PG8_WAIT_V(6); PG8_BAR; PG8_MMA(1, 1, At, B1); PG8_BAR;
            }
        }
        if constexpr (ALIGN_EPI) { if (wr == 0) PG8_BAR; }
        if constexpr (!Epi::AFTER_DRAIN) { E(acc, cur, wr, wc, fr, fq); S.done(cur); }
        if (!has_next) break;
#pragma unroll
        for (int a = 0; a < 2; ++a)
#pragma unroll
            for (int b = 0; b < 2; ++b)
#pragma unroll
                for (int m = 0; m < 4; ++m)
#pragma unroll
                    for (int n = 0; n < 2; ++n) acc[a][b][m][n] = (f32x4){0.f, 0.f, 0.f, 0.f};
        cur = nxt; cA = nA; cB = nB; ++ui;
        if constexpr (ALIGN_EPI) { if (wr == 1) PG8_BAR; }
    }
    PG8_WAIT_V(0);
    if constexpr (!ALIGN_EPI) { if (wr == 0) PG8_BAR; }
    PG8_BAR;
    if constexpr (Epi::AFTER_DRAIN) { E.fused(acc, cur, wr, wc, fr, fq, lds, wid, lane); S.done(cur); }
#undef PG8_SA
#undef PG8_SB
#undef PG8_STAGE
#undef PG8_LDA
#undef PG8_LDB
#undef PG8_LDA8
#undef PG8_LDB8
#undef PG8_MMA8
#undef PG8_MMA
#undef PG8_WAIT_V
#undef PG8_WAIT_L
#undef PG8_BAR
#undef PG8_SCHED
}
}
#include <hip/hip_bf16.h>
#include <cmath>
namespace attn_body {
using bf16=__hip_bfloat16;
using bf16x8=__attribute__((ext_vector_type(8)))short;
using s16x4=__attribute__((ext_vector_type(4)))short;
using f32x16=__attribute__((ext_vector_type(16)))float;
using u32x4=__attribute__((ext_vector_type(4)))unsigned;
constexpr int BATCH=4,NHEAD=8,SEQ=4096,D=64,DM=3072,OPITCH=1024;
constexpr int NW=8,QBLK=32,QB=QBLK*NW,KVBLK=64,NQB=SEQ/QB;
constexpr int ATTN_UNIT_ROWS=QB;
__device__ __forceinline__ int crow(int r,int hi){return (r&3)+8*(r>>2)+4*hi;}
#define SBAR() __builtin_amdgcn_sched_barrier(0)
__device__ __forceinline__ void cmask(f32x16&p0,f32x16&p1,int jb,int qrel,int hi){
  const float NEG=-INFINITY; int kb=64*jb+4*hi;
  #pragma unroll
  for(int r=0;r<16;++r){int kv=kb+(r&3)+8*(r>>2); if(kv>qrel)p0[r]=NEG; if(kv+32>qrel)p1[r]=NEG;}
}

constexpr int NSLOT=3, SLOTB=8192;
constexpr int LDS_K=0, LDS_V=NSLOT*SLOTB, LDS_WS=2*NSLOT*SLOTB, LDS_OST=LDS_WS+NW*64*4, LDS_BYTES=LDS_OST+NW*4096;
constexpr float C2=0.125f*1.4426950408889634f;
__device__ __forceinline__ void glds16(const void*gsrc,unsigned lds_dst){unsigned keep;
  asm volatile("s_mov_b32 %0, m0\n\ts_mov_b32 m0, %2\n\ts_nop 0\n\tglobal_load_lds_dwordx4 %1, off\n\ts_mov_b32 m0, %0":"=&s"(keep):"v"(gsrc),"s"(lds_dst):"memory");}
__device__ __forceinline__ void glds16s(const void*sbase,unsigned voff,unsigned lds_dst){unsigned keep;
  asm volatile("s_mov_b32 %0, m0\n\ts_mov_b32 m0, %3\n\ts_nop 0\n\tglobal_load_lds_dwordx4 %1, %2\n\ts_mov_b32 m0, %0":"=&s"(keep):"v"(voff),"s"(sbase),"s"(lds_dst):"memory");}
__device__ __forceinline__ float max3f(float a,float b,float c){float r;asm("v_max3_f32 %0, %1, %2, %3":"=v"(r):"v"(a),"v"(b),"v"(c));return r;}
__device__ __forceinline__ float max2f(float a,float b){float r;asm("v_max_f32_e32 %0, %1, %2":"=v"(r):"v"(a),"v"(b));return r;}
__device__ __forceinline__ float fadd_s(float a,float b){float r;asm("v_add_f32_e32 %0, %1, %2":"=v"(r):"v"(a),"v"(b));return r;}
__device__ __forceinline__ float fsub_s(float a,float b){float r;asm("v_sub_f32_e32 %0, %1, %2":"=v"(r):"v"(a),"v"(b));return r;}
typedef float f32x2_t __attribute__((ext_vector_type(2))); typedef __bf16 bf16x2_t __attribute__((ext_vector_type(2)));
__device__ __forceinline__ unsigned cvtpk_s(float lo,float hi){f32x2_t v={lo,hi};bf16x2_t b=__builtin_convertvector(v,bf16x2_t);return __builtin_bit_cast(unsigned,b);}
#define WAIT_BAR(N) asm volatile("s_waitcnt vmcnt(" #N ") lgkmcnt(0)\n\ts_barrier":::"memory")

__device__ __forceinline__ void qkt(f32x16&p0,f32x16&p1,const char*Kslot,const bf16x8*qr,int r32,int hi){
  const f32x16 negm=f32x16{};
  const char*kb=Kslot+hi*1024+r32*16;
  #pragma unroll
  for(int d0=0;d0<4;++d0){
    const bf16x8 b0=*reinterpret_cast<const bf16x8*>(kb+d0*2048);
    const bf16x8 b1=*reinterpret_cast<const bf16x8*>(kb+d0*2048+512);
    if(d0==0){p0=__builtin_amdgcn_mfma_f32_32x32x16_bf16(b0,qr[0],negm,0,0,0);p1=__builtin_amdgcn_mfma_f32_32x32x16_bf16(b1,qr[0],negm,0,0,0);}
    else{p0=__builtin_amdgcn_mfma_f32_32x32x16_bf16(b0,qr[d0],p0,0,0,0);p1=__builtin_amdgcn_mfma_f32_32x32x16_bf16(b1,qr[d0],p1,0,0,0);}}
}
typedef __attribute__((address_space(3))) const char* lds_cptr;
typedef short v4i16_t __attribute__((ext_vector_type(4)));
__device__ __forceinline__ void kload8(bf16x8*kf,lds_cptr kp){
  kf[0]=*(const __attribute__((address_space(3))) bf16x8*)(kp);      kf[1]=*(const __attribute__((address_space(3))) bf16x8*)(kp+512);
  kf[2]=*(const __attribute__((address_space(3))) bf16x8*)(kp+2048); kf[3]=*(const __attribute__((address_space(3))) bf16x8*)(kp+2560);
  kf[4]=*(const __attribute__((address_space(3))) bf16x8*)(kp+4096); kf[5]=*(const __attribute__((address_space(3))) bf16x8*)(kp+4608);
  kf[6]=*(const __attribute__((address_space(3))) bf16x8*)(kp+6144); kf[7]=*(const __attribute__((address_space(3))) bf16x8*)(kp+6656);
}
__device__ __forceinline__ void kload2(bf16x8*kf,lds_cptr kp,int j){ kf[2*j]=*(const __attribute__((address_space(3))) bf16x8*)(kp+j*2048); kf[2*j+1]=*(const __attribute__((address_space(3))) bf16x8*)(kp+j*2048+512); }
__device__ __forceinline__ s16x4 vtr(lds_cptr p){ return __builtin_bit_cast(s16x4,__builtin_amdgcn_ds_read_tr16_b64_v4i16((__attribute__((address_space(3))) v4i16_t*)p)); }
__device__ __forceinline__ float rowmax(const f32x16&p0,const f32x16&p1){
  float a=max3f(p0[0],p0[1],p1[0]),b=max3f(p0[2],p0[3],p1[1]);a=max3f(a,p1[2],p1[3]);
  #pragma unroll
  for(int r=4;r<16;r+=4){a=max3f(a,p0[r],p0[r+1]);b=max3f(b,p0[r+2],p0[r+3]);a=max3f(a,p1[r],p1[r+1]);b=max3f(b,p1[r+2],p1[r+3]);}
  const float m=max2f(a,b);
  auto rr=__builtin_amdgcn_permlane32_swap(__float_as_uint(m),__float_as_uint(m),false,false);
  return max2f(__uint_as_float(rr[0]),__uint_as_float(rr[1]));
}
__device__ __forceinline__ void pv(f32x16*o,int vb,bf16x8 pa0,bf16x8 pa1,bf16x8 pa2,bf16x8 pa3){
  #pragma unroll
  for(int d0=0;d0<2;++d0){s16x4 lo[4],hi[4];
    #pragma unroll
    for(int ks=0;ks<4;++ks){
      asm volatile("ds_read_b64_tr_b16 %0,%1 offset:%c2":"=&v"(lo[ks]):"v"(vb),"i"(d0*4096+ks*1024):"memory");
      asm volatile("ds_read_b64_tr_b16 %0,%1 offset:%c2":"=&v"(hi[ks]):"v"(vb),"i"(d0*4096+ks*1024+512):"memory");}
    asm volatile("s_waitcnt lgkmcnt(0)":::"memory");SBAR();
    #define PK(k) (bf16x8){lo[k][0],lo[k][1],lo[k][2],lo[k][3],hi[k][0],hi[k][1],hi[k][2],hi[k][3]}
    o[d0]=__builtin_amdgcn_mfma_f32_32x32x16_bf16(pa0,PK(0),o[d0],0,0,0);
    o[d0]=__builtin_amdgcn_mfma_f32_32x32x16_bf16(pa1,PK(1),o[d0],0,0,0);
    o[d0]=__builtin_amdgcn_mfma_f32_32x32x16_bf16(pa2,PK(2),o[d0],0,0,0);
    o[d0]=__builtin_amdgcn_mfma_f32_32x32x16_bf16(pa3,PK(3),o[d0],0,0,0);
    #undef PK
  }
}

#define ATTN_YQ (127.f/6.f)
#ifndef ATTN_STORE16
#define ATTN_STORE16(p,v) st16_wt((p),(v))
#endif
template<int THRL> __device__ __forceinline__ void attn_unit(int b,int h,int qb,const bf16*Q,const bf16*__restrict__ K,const bf16*__restrict__ V,bf16*O,const float*KSUM,const float*GG,char*shm,int tid_in){
  int tid_=tid_in; asm volatile("":"+v"(tid_)); const int tid=tid_,lane=tid&63,r32=lane&31,hi=lane>>5; const int wid=__builtin_amdgcn_readfirstlane(tid>>6);
  const long rowbase=(long)b*SEQ; const int q0=qb*QB;
  const bf16*Qw=Q+(rowbase+q0+wid*QBLK)*DM+h*D;
  const bf16*Kh=K+rowbase*DM+h*D,*Vh=V+rowbase*DM+h*D;
  const unsigned lds0=(unsigned)(uintptr_t)shm;
  float*wsf=(float*)(shm+LDS_WS)+wid*64;
  const unsigned koff=(unsigned)((lane*DM+wid*8)*2);
  const unsigned voffs=(unsigned)(((16*(wid&3)+(lane>>2))*DM+(wid>>2)*32+(lane&3)*8)*2);
  const unsigned kdst=lds0+LDS_K+wid*1024, vdst=lds0+LDS_V+wid*1024;
  #define PT(t) (((t)<4)?(NT-4+(t)):((t)-4))
  #define DMA_K(t,slot) glds16s((const char*)Kh+(long)PT(t)*(KVBLK*DM*2),koff,(unsigned)__builtin_amdgcn_readfirstlane(kdst+(slot)))
  #define DMA_V(t,slot) glds16s((const char*)Vh+(long)PT(t)*(KVBLK*DM*2),voffs,(unsigned)__builtin_amdgcn_readfirstlane(vdst+(slot)))
  const int vb0=(int)(lds0+LDS_V)+((lane>>4)&1)*32+(lane&3)*8+(4*hi+((lane&15)>>2))*64;
  const char*Kbase=shm+LDS_K; bf16x8 kf[8];
  const lds_cptr shm3=(lds_cptr)shm; const lds_cptr kp0=shm3+LDS_K+hi*1024+r32*16; const lds_cptr vp0=shm3+LDS_V+((lane>>4)&1)*32+(lane&3)*8+(4*hi+((lane&15)>>2))*64;
  const int NT=(q0+QB)/KVBLK;
  DMA_K(0,0);DMA_V(0,0);DMA_K(1,SLOTB);
  bf16x8 qr[4];
  #pragma unroll
  for(int d0=0;d0<4;++d0)qr[d0]=*reinterpret_cast<const bf16x8*>(&Qw[(long)r32*DM+d0*16+hi*8]);
  float mhat=0.f,l_reg=0.f;f32x16 o[2];o[0]=f32x16{};o[1]=f32x16{};const f32x16 z16=f32x16{};
  unsigned selm=(1u<<qb)-1u;
  if(qb>3){
    f32x16 gt=f32x16{};
    #pragma unroll
    for(int d0=0;d0<4;++d0){ const float*kp=KSUM+((long)(b*16+(r32&15)))*512+h*D+d0*16+hi*8;
      const float4 k0=*reinterpret_cast<const float4*>(kp),k1=*reinterpret_cast<const float4*>(kp+4);
      u32x4 kw; kw.x=cvtpk_s(k0.x,k0.y);kw.y=cvtpk_s(k0.z,k0.w);kw.z=cvtpk_s(k1.x,k1.y);kw.w=cvtpk_s(k1.z,k1.w);
      gt=__builtin_amdgcn_mfma_f32_32x32x16_bf16(__builtin_bit_cast(bf16x8,kw),qr[d0],gt,0,0,0); }
    float v0=-INFINITY,v1=-INFINITY,v2=-INFINITY; int i0=0,i1=0,i2=0;
    #define INS3(vv,ii) do{ const float x_=(vv); const int j_=(ii); \
      if(x_>v0){v2=v1;i2=i1;v1=v0;i1=i0;v0=x_;i0=j_;} else if(x_>v1){v2=v1;i2=i1;v1=x_;i1=j_;} else if(x_>v2){v2=x_;i2=j_;} }while(0)
    #pragma unroll
    for(int r=0;r<8;++r){ const int j=crow(r,hi); INS3(j<qb?gt[r]:-INFINITY,j); }
    const float p0=__shfl_xor(v0,32),p1=__shfl_xor(v1,32),p2=__shfl_xor(v2,32); const int q0i=__shfl_xor(i0,32),q1i=__shfl_xor(i1,32),q2i=__shfl_xor(i2,32);
    INS3(p0,q0i); INS3(p1,q1i); INS3(p2,q2i);
    #undef INS3
    selm=(1u<<i0)|(1u<<i1)|(1u<<i2);
  }
  const int qrel=wid*QBLK+r32;
  #define CMASK(P0,P1,t) do{ if((t)<4)cmask(P0,P1,(t),qrel,hi); }while(0)
  bool resc=false;
  #define START(P0,P1) do{ const float rm=rowmax(P0,P1); resc=false; \
    { const float dl=rm; mhat=fadd_s(mhat,dl); \
      _Pragma("unroll") for(int r=0;r<16;++r){P0[r]=fsub_s(P0[r],dl);P1[r]=fsub_s(P1[r],dl);} \
      } \
    _Pragma("unroll") for(int r=0;r<16;++r)P0[r]=__builtin_amdgcn_exp2f(P0[r]); }while(0)
  #define RESC() do{ if(resc){ asm volatile("s_waitcnt lgkmcnt(0)":::"memory"); \
      _Pragma("unroll") for(int d_=0;d_<2;++d_) _Pragma("unroll") for(int r=0;r<16;++r)o[d_][r]*=wsf[crow(r,hi)]; } }while(0)
  f32x16 pA0,pA1,pB0,pB1;
  int sl_prev=0,sl_cur=0,sl_next=SLOTB;
  #define ROT() do{sl_prev=sl_cur;sl_cur=sl_next;sl_next=(sl_next==(NSLOT-1)*SLOTB)?0:sl_next+SLOTB;}while(0)
  DMA_K(2,2*SLOTB);
  WAIT_BAR(3);
  qkt(pA0,pA1,Kbase,qr,r32,hi);asm volatile("s_nop 15\n\ts_nop 7":"+v"(pA0),"+v"(pA1));CMASK(pA0,pA1,0);
  START(pA0,pA1);
  _Pragma("unroll") for(int r=0;r<16;++r)pA1[r]=__builtin_amdgcn_exp2f(pA1[r]);
  WAIT_BAR(0);
  DMA_K(3,0);DMA_V(1,SLOTB);
  ROT();
  kload8(kf,kp0+sl_cur);
  WAIT_BAR(2);
  s16x4 vlo[8],vhi[8]; u32x4 pw0,pw1,pw2,pw3;
  #define PKW(P,B) cvtpk_s(P[B],P[B+1])
  #define PAF(k) __builtin_bit_cast(bf16x8,pw##k)
  #define VFR(i) (bf16x8){vlo[i][0],vlo[i][1],vlo[i][2],vlo[i][3],vhi[i][0],vhi[i][1],vhi[i][2],vhi[i][3]}
  #define PIN(x) asm volatile("":"+v"(x))
  #define MX3(a,b,c) __builtin_fmaxf(__builtin_fmaxf((a),(b)),(c))
  #define GAPA(MF,A0,A1,A2,A3,W0,W1,PW) do{ MF; sacc+=A0; sacc+=A1; sacc+=A2; sacc+=A3; PIN(sacc); W0; W1; PIN(PW); SBAR(); }while(0)
  #define EX(v) __builtin_amdgcn_exp2f(v)
  #define GAPB(MF,X,B) do{ MF; X[B]=EX(X[B]); X[B+1]=EX(X[B+1]); X[B+2]=EX(X[B+2]); X[B+3]=EX(X[B+3]); PIN(X); SBAR(); }while(0)
  #define VRD(i) do{ vlo[i]=vtr(vp_+(((i)>>2)*4096+((i)&3)*1024)); vhi[i]=vtr(vp_+(((i)>>2)*4096+((i)&3)*1024+512)); }while(0)
  #define KRD(G,j) do{ if(G){ kload2(kf,kp0+sl_next,j); SBAR(); } }while(0)
  #define STEP(C0,C1,P0,P1,t,GK,GV,GL) do{ SBAR(); \
    const lds_cptr vp_=vp0+sl_prev; \
    f32x16 ng_; { const bool v_=((t)<4)||((selm>>(((t)-4)>>2))&1u); const float nm_=v_?-mhat:-INFINITY;   \
      _Pragma("unroll") for(int r=0;r<16;++r)ng_[r]=nm_; } PIN(ng_); \
    VRD(0); SBAR(); float sacc=(P0[0]+P0[1]); \
    GAPA(C0=__builtin_amdgcn_mfma_f32_32x32x16_bf16(kf[0],qr[0],ng_,0,0,0), P0[2],P0[3],P0[4],P0[5],     pw0[0]=PKW(P0,0), pw0[1]=PKW(P0,2), pw0); \
    VRD(4); SBAR(); GAPA(C1=__builtin_amdgcn_mfma_f32_32x32x16_bf16(kf[1],qr[0],ng_,0,0,0), P0[6],P0[7],P0[8],P0[9],     pw0[2]=PKW(P0,4), pw0[3]=PKW(P0,6), pw0); \
    VRD(1); SBAR(); GAPA(C0=__builtin_amdgcn_mfma_f32_32x32x16_bf16(kf[2],qr[1],C0,0,0,0),   P0[10],P0[11],P0[12],P0[13], pw1[0]=PKW(P0,8), pw1[1]=PKW(P0,10), pw1); \
    VRD(5); SBAR(); GAPA(C1=__builtin_amdgcn_mfma_f32_32x32x16_bf16(kf[3],qr[1],C1,0,0,0),   P0[14],P0[15],P1[0],P1[1],   pw1[2]=PKW(P0,12),pw1[3]=PKW(P0,14), pw1); \
    VRD(2); SBAR(); GAPA(C0=__builtin_amdgcn_mfma_f32_32x32x16_bf16(kf[4],qr[2],C0,0,0,0),   P1[2],P1[3],P1[4],P1[5],     pw2[0]=PKW(P1,0), pw2[1]=PKW(P1,2), pw2); \
    VRD(6); SBAR(); GAPA(C1=__builtin_amdgcn_mfma_f32_32x32x16_bf16(kf[5],qr[2],C1,0,0,0),   P1[6],P1[7],P1[8],P1[9],     pw2[2]=PKW(P1,4), pw2[3]=PKW(P1,6), pw2); \
    VRD(3); SBAR(); GAPA(C0=__builtin_amdgcn_mfma_f32_32x32x16_bf16(kf[6],qr[3],C0,0,0,0),   P1[10],P1[11],P1[12],P1[13], pw3[0]=PKW(P1,8), pw3[1]=PKW(P1,10), pw3); \
    VRD(7); SBAR(); GAPA(C1=__builtin_amdgcn_mfma_f32_32x32x16_bf16(kf[7],qr[3],C1,0,0,0),   P1[14],P1[15],0.f,0.f,       pw3[2]=PKW(P1,12),pw3[3]=PKW(P1,14), pw3); \
    l_reg+=sacc; \
    if(GK){DMA_K((t)+3,sl_cur);} if(GV){DMA_V((t)+1,sl_next);} \
    CMASK(C0,C1,t); \
    { float a=MX3(C0[0],C0[1],C1[0]),b=MX3(C0[2],C0[3],C1[1]); a=MX3(a,C1[2],C1[3]); \
      _Pragma("unroll") for(int r=4;r<16;r+=4){a=MX3(a,C0[r],C0[r+1]);b=MX3(b,C0[r+2],C0[r+3]);a=MX3(a,C1[r],C1[r+1]);b=MX3(b,C1[r+2],C1[r+3]);} \
      float rm=__builtin_fmaxf(a,b); { auto rr=__builtin_amdgcn_permlane32_swap(__float_as_uint(rm),__float_as_uint(rm),false,false); rm=__builtin_fmaxf(__uint_as_float(rr[0]),__uint_as_float(rr[1])); } \
      resc=false; \
      if(__builtin_expect(__any(rm>(float)THRL),0)){ const float dl=__builtin_fmaxf(rm,0.f); mhat+=dl; \
        _Pragma("unroll") for(int r=0;r<16;++r){C0[r]-=dl;C1[r]-=dl;} \
        const float f=__builtin_amdgcn_exp2f(-dl); l_reg*=f; if(hi==0)wsf[r32]=f; resc=true; } } \
    SBAR(); \
    GAPB(o[0]=__builtin_amdgcn_mfma_f32_32x32x16_bf16(PAF(0),VFR(0),o[0],0,0,0), C0,0); \
    GAPB(o[1]=__builtin_amdgcn_mfma_f32_32x32x16_bf16(PAF(0),VFR(4),o[1],0,0,0), C0,4); \
    KRD(GL,0); GAPB(o[0]=__builtin_amdgcn_mfma_f32_32x32x16_bf16(PAF(1),VFR(1),o[0],0,0,0), C0,8); \
    KRD(GL,1); GAPB(o[1]=__builtin_amdgcn_mfma_f32_32x32x16_bf16(PAF(1),VFR(5),o[1],0,0,0), C0,12); \
    KRD(GL,2); GAPB(o[0]=__builtin_amdgcn_mfma_f32_32x32x16_bf16(PAF(2),VFR(2),o[0],0,0,0), C1,0); \
    KRD(GL,3); GAPB(o[1]=__builtin_amdgcn_mfma_f32_32x32x16_bf16(PAF(2),VFR(6),o[1],0,0,0), C1,4); \
    GAPB(o[0]=__builtin_amdgcn_mfma_f32_32x32x16_bf16(PAF(3),VFR(3),o[0],0,0,0), C1,8); \
    GAPB(o[1]=__builtin_amdgcn_mfma_f32_32x32x16_bf16(PAF(3),VFR(7),o[1],0,0,0), C1,12); \
    }while(0)
  int t=1;
  #define ENDW(tt) do{ if((tt)+3<NT){WAIT_BAR(2);} else if((tt)+2<NT){WAIT_BAR(1);} else {WAIT_BAR(0);} }while(0)
  for(;t<5&&t+1<NT;t+=2){
    STEP(pB0,pB1,pA0,pA1,t,(t+3<NT),(t+1<NT),(t+1<NT));       ENDW(t);   RESC(); ROT();
    STEP(pA0,pA1,pB0,pB1,t+1,(t+4<NT),(t+2<NT),(t+2<NT));     ENDW(t+1); RESC(); ROT();
  }
  #undef CMASK
  #define CMASK(P0,P1,t) do{}while(0)
  for(;t+5<NT;t+=2){
    STEP(pB0,pB1,pA0,pA1,t,true,true,true);     WAIT_BAR(2); RESC(); ROT();
    STEP(pA0,pA1,pB0,pB1,t+1,true,true,true);   WAIT_BAR(2); RESC(); ROT();
  }
  #undef CMASK
  #define CMASK(P0,P1,t) do{ if((t)<4)cmask(P0,P1,(t),qrel,hi); }while(0)
  for(;t+1<NT;t+=2){
    STEP(pB0,pB1,pA0,pA1,t,(t+3<NT),(t+1<NT),(t+1<NT));       ENDW(t);   RESC(); ROT();
    STEP(pA0,pA1,pB0,pB1,t+1,(t+4<NT),(t+2<NT),(t+2<NT));     ENDW(t+1); RESC(); ROT();
  }
  STEP(pB0,pB1,pA0,pA1,NT-1,false,false,false); RESC();
  { float sacc=pB0[0]+pB0[1]; _Pragma("unroll") for(int r=2;r<16;++r)sacc+=pB0[r]; _Pragma("unroll") for(int r=0;r<16;++r)sacc+=pB1[r]; l_reg+=sacc;
    pw0=(u32x4){PKW(pB0,0),PKW(pB0,2),PKW(pB0,4),PKW(pB0,6)};pw1=(u32x4){PKW(pB0,8),PKW(pB0,10),PKW(pB0,12),PKW(pB0,14)};pw2=(u32x4){PKW(pB1,0),PKW(pB1,2),PKW(pB1,4),PKW(pB1,6)};pw3=(u32x4){PKW(pB1,8),PKW(pB1,10),PKW(pB1,12),PKW(pB1,14)};
    SBAR(); pv(o,vb0+sl_cur,PAF(0),PAF(1),PAF(2),PAF(3)); }
  #undef PKW
  #undef PAF
  #undef VFR
  #undef PIN
  #undef MX3
  #undef GAPA
  #undef GAPB
  #undef EX
  #undef VRD
  #undef KRD
  #undef STEP
  #undef ENDW
  {auto rr=__builtin_amdgcn_permlane32_swap(__float_as_uint(l_reg),__float_as_uint(l_reg),false,false);l_reg=__uint_as_float(rr[0])+__uint_as_float(rr[1]);}
  if(hi==0)wsf[32+r32]=l_reg;asm volatile("s_waitcnt lgkmcnt(0)":::"memory");
  float rli[16];
  #pragma unroll
  for(int r=0;r<16;++r)rli[r]=__builtin_amdgcn_rcpf(wsf[32+crow(r,hi)]);
  bf16*Ow=O+(rowbase+q0+wid*QBLK)*OPITCH+h*D;
  { bf16*stg=(bf16*)(shm+LDS_OST)+wid*2048;
    #pragma unroll
    for(int r=0;r<16;++r){const int orow=crow(r,hi);
      #pragma unroll
      for(int d0=0;d0<2;++d0)stg[orow*64+d0*32+r32]=__float2bfloat16(o[d0][r]*rli[r]);}
    asm volatile("s_waitcnt lgkmcnt(0)":::"memory");
    const int ch=lane&7; float gg[8];
    #pragma unroll
    for(int i=0;i<8;++i)gg[i]=GG[h*D+ch*8+i];
    #pragma unroll
    for(int i=0;i<4;++i){const int row=i*8+(lane>>3); const u32x4 v=*(const u32x4*)(stg+row*64+ch*8);
      float x[8]; x[0]=__uint_as_float(v.x<<16);x[1]=__uint_as_float(v.x&0xffff0000u);x[2]=__uint_as_float(v.y<<16);x[3]=__uint_as_float(v.y&0xffff0000u);
      x[4]=__uint_as_float(v.z<<16);x[5]=__uint_as_float(v.z&0xffff0000u);x[6]=__uint_as_float(v.w<<16);x[7]=__uint_as_float(v.w&0xffff0000u);
      float ss=0.f;
      #pragma unroll
      for(int k=0;k<8;++k)ss+=x[k]*x[k];
      ss+=__uint_as_float((unsigned)__builtin_amdgcn_mov_dpp((int)__float_as_uint(ss),0xB1,0xf,0xf,true));ss+=__uint_as_float((unsigned)__builtin_amdgcn_mov_dpp((int)__float_as_uint(ss),0x4E,0xf,0xf,true));ss+=__uint_as_float((unsigned)__builtin_amdgcn_mov_dpp((int)__float_as_uint(ss),0x141,0xf,0xf,true));
      const float rs=rsqrtf(ss*(1.f/64.f)+1e-6f);
      const float qn=rs*ATTN_YQ; unsigned w0=0u,w1=0u;
      #pragma unroll
      for(int k=0;k<4;++k){const int a=(int)fminf(fmaxf(__builtin_rintf(x[k]*qn),-127.f),127.f),b=(int)fminf(fmaxf(__builtin_rintf(x[4+k]*qn),-127.f),127.f); w0|=((unsigned)a&0xffu)<<(8*k); w1|=((unsigned)b&0xffu)<<(8*k);}
      st8_wt((void*)((unsigned char*)O+((rowbase+q0+wid*QBLK+row)*(long)OPITCH+h*D+ch*8)),(unsigned long long)w0|((unsigned long long)w1<<32));} }
  asm volatile("s_waitcnt lgkmcnt(0)\n\ts_barrier":::"memory");
  #undef DMA_K
  #undef PT
  #undef DMA_V
  #undef CMASK
  #undef START
  #undef RESC
  #undef ROT
}
constexpr int ATTN_LDS_BYTES=LDS_BYTES;
struct AttnTensors { const bf16* Q; const bf16* K; const bf16* V; bf16* O; const float* KSUM; const float* GG; };
struct AttnUnit { int bh; int qb; };
struct StaticOrder {
  int vcu,G;
  __device__ __forceinline__ explicit StaticOrder(int grid,int block):vcu((grid%8==0)?(block%8)*(grid/8)+block/8:block),G(grid){}
  __device__ __forceinline__ bool next(int i,AttnUnit&u)const{ const int pr=vcu+(i>>1)*G; if(pr>=256)return false; const int s=pr&7; u.bh=pr>>3; u.qb=(i&1)?s:15-s; return true; }
  __device__ __forceinline__ void a_ready(const AttnUnit&)const{}
  __device__ __forceinline__ void done(const AttnUnit&)const{}
};
template<class Sched,int THRL=8> __device__ __forceinline__ void attn_phase(char*lds,const AttnTensors&T,const Sched&S,int tid_in){
  AttnUnit u;
  for(int i=0;S.next(i,u);++i){ S.a_ready(u); attn_unit<THRL>(u.bh/NHEAD,u.bh%NHEAD,u.qb,T.Q,T.K,T.V,T.O,T.KSUM,T.GG,lds,tid_in); S.done(u); }
}
#undef SBAR
#undef WAIT_BAR
}

#define GAS __attribute__((address_space(1)))
#define LAS __attribute__((address_space(3)))
typedef unsigned short bf16;
typedef unsigned v4u __attribute__((ext_vector_type(4)));
typedef float f32x4 __attribute__((ext_vector_type(4)));
typedef short bf16x8 __attribute__((ext_vector_type(8)));
typedef GAS unsigned gu32;
typedef GAS unsigned long long gu64;
#define RLX_AGENT __ATOMIC_RELAXED, __HIP_MEMORY_SCOPE_AGENT
#define LDS_WAIT() asm volatile("s_waitcnt lgkmcnt(0)" ::: "memory")
#define VM_WAIT() asm volatile("s_waitcnt vmcnt(0)" ::: "memory")
__device__ __forceinline__ unsigned long long rt() { return __builtin_amdgcn_s_memrealtime(); }
__device__ __forceinline__ unsigned f2bf(float f) { unsigned u = __builtin_bit_cast(unsigned, f); return (u + 0x7fffu + ((u >> 16) & 1u)) >> 16; }
__device__ __forceinline__ unsigned pk2(float lo, float hi) { return f2bf(lo) | (f2bf(hi) << 16); }

#define XB_TMO      128
#define XB_XCNT(j)  (256  + 64 * (j))
#define XB_XSUB(j)  (1280 + 64 * (j))
#define XB_XGEN(j)  (2304 + 64 * (j))
#define XB_TOP      3328
#define XB_TOPGEN   3392
#define XCD_BAR_WORDS 3456
#define XB_SPIN_CAP (1u << 18)

__device__ __forceinline__ unsigned xb_ld(unsigned* p)              { return __hip_atomic_load(p, __ATOMIC_RELAXED, __HIP_MEMORY_SCOPE_AGENT); }
__device__ __forceinline__ unsigned xb_add(unsigned* p, unsigned v) { return __hip_atomic_fetch_add(p, v, __ATOMIC_RELAXED, __HIP_MEMORY_SCOPE_AGENT); }
__device__ __forceinline__ unsigned xb_xcc_id() { return (unsigned)__builtin_amdgcn_s_getreg((3 << 11) | 20) & 0xFu; }
#define XB_SPIN(cond, bar) do { unsigned _sp = 0; while (cond) { __builtin_amdgcn_s_sleep(1); \
    if ((++_sp & 255u) == 0u) { if (xb_ld(&(bar)[XB_TMO])) break; if (_sp > XB_SPIN_CAP) { atomicAdd(&(bar)[XB_TMO], 1u); break; } } } } while (0)

struct XcdBarrier {
    unsigned* bar; unsigned x;
    volatile LAS unsigned* st;
};

__device__ __forceinline__ XcdBarrier xcd_barrier_post(unsigned* bar, volatile LAS unsigned* st) {
    XcdBarrier b; b.bar = bar; b.x = xb_xcc_id(); b.st = st;
    if (threadIdx.x == 0) (void)xb_add(&bar[XB_XCNT(b.x)], 1u);
    return b;
}
__device__ __forceinline__ void xcd_barrier_complete(unsigned* bar, unsigned x, unsigned& nloc, unsigned& nx) {
    const unsigned G = gridDim.x * gridDim.y * gridDim.z;
    unsigned sum, cnt, mine, sp = 0u;
    for (;;) {
        sum = 0u; cnt = 0u; mine = 0u;
#pragma unroll
        for (unsigned j = 0; j < 16; ++j) { const unsigned c = xb_ld(&bar[XB_XCNT(j)]); sum += c; cnt += (c > 0u) ? 1u : 0u; mine = (j == x) ? c : mine; }
        if (sum == G) break;
        __builtin_amdgcn_s_sleep(1);
        if ((++sp & 255u) == 0u) { if (xb_ld(&bar[XB_TMO])) break; if (sp > XB_SPIN_CAP) { atomicAdd(&bar[XB_TMO], 1u); break; } }
    }
    nloc = mine > 0u ? mine : 1u; nx = cnt > 0u ? cnt : 1u;
}

__device__ __forceinline__ void xcd_barrier(const XcdBarrier& b, bool wb = false) {
    asm volatile("s_waitcnt vmcnt(0)" ::: "memory");
    __syncthreads();
    if (threadIdx.x == 0) {
        unsigned* bar = b.bar;
        __builtin_amdgcn_s_waitcnt(0);
        unsigned nloc = b.st[0], nx = b.st[1];
        if (nloc == 0u) { xcd_barrier_complete(bar, b.x, nloc, nx); b.st[0] = nloc; b.st[1] = nx; }
        const unsigned old = xb_add(&bar[XB_XSUB(b.x)], 1u);
        const unsigned gen = old / nloc;
        if (old + 1u == (gen + 1u) * nloc) {
            if (wb) asm volatile("buffer_wbl2 sc1" ::: "memory");
            asm volatile("s_waitcnt vmcnt(0)" ::: "memory");
            (void)xb_add(&bar[XB_TOP], 1u);
        }
        XB_SPIN(xb_ld(&bar[XB_TOP]) < (gen + 1u) * nx, bar);
        __builtin_amdgcn_fence(__ATOMIC_ACQUIRE, "agent");
        asm volatile("s_waitcnt vmcnt(0)" ::: "memory");
    }
    __syncthreads();
}
__device__ __forceinline__ void group_barrier(unsigned* cnt, unsigned target, unsigned* bar) {
    asm volatile("s_waitcnt vmcnt(0)" ::: "memory");
    __syncthreads();
    if (threadIdx.x == 0) {
        __builtin_amdgcn_s_waitcnt(0);
        (void)xb_add(cnt, 1u);
        XB_SPIN(xb_ld(cnt) < target, bar);
        __builtin_amdgcn_fence(__ATOMIC_ACQUIRE, "agent");
        asm volatile("s_waitcnt vmcnt(0)" ::: "memory");
    }
    __syncthreads();
}

constexpr int NWAVES = 8;
constexpr int NB = 4, S = 4096, D = 1024, M = NB * S;
constexpr int NIN = 3072, NQ = 2048, NEXP = 16384;
constexpr float EPS = 1e-6f;
constexpr float C2 = 0.125f * 1.4426950408889634f;

constexpr size_t MiB = 1u << 20;
constexpr size_t WS_CTL = 0, CTL_ZERO_BYTES = 256 * 1024;
constexpr size_t WS_MOD = 1 * MiB;
constexpr size_t WS_KMEAN = 128 * 1024;
constexpr size_t WS_KEYS = 1 * MiB + 512 * 1024;
constexpr size_t WS_WIN = 2 * MiB, WS_WO = 8 * MiB, WS_WQ = 10 * MiB;
constexpr size_t WS_EIDX = 14 * MiB, WS_G = 22 * MiB;
constexpr size_t WS_U = 32 * MiB, WS_V = 64 * MiB;
constexpr size_t WS_SU = 48 * MiB, WS_SV = 48 * MiB + 64 * 1024;
constexpr size_t WS_H = 96 * MiB;
constexpr size_t WS_P = 128 * MiB;
constexpr size_t WS_QP = 128 * MiB, WS_O = 192 * MiB;
constexpr size_t WS_Y = 224 * MiB, WS_END = 256 * MiB;
constexpr int CW_BAR = 1024;
constexpr int CW_GRP = 16384;
constexpr int CW_CMAX = 8192;
constexpr int CW_CMAX3 = CW_CMAX + 3072 + 2048;
constexpr float YQ = 127.f / 6.f;
constexpr int CW_CMAX2 = CW_CMAX + 3072;
constexpr size_t WS_WO8 = 47 * MiB;
constexpr size_t WS_WQ8 = 45 * MiB, WS_RS2 = 44 * MiB + 65536;
constexpr size_t WS_WIN8 = 40 * MiB, WS_RS = 44 * MiB;

constexpr int LDS_BYTES = 153600;
constexpr int LDSCTL_OFF = LDS_BYTES - 512, MISC_OFF = LDSCTL_OFF + 320;
constexpr int RING_BYTES = 131072;

struct Frame {
    LAS unsigned char* lds;
    volatile LAS unsigned* MISC;
    gu32* ctl;
    int tid, lane, wave, G;
    const float *x, *c, *ada_w, *ada_b, *pre_gain, *post_gain, *w_in, *conv_w, *group_gain, *w_out, *fpre_gain, *fpost_gain, *wq, *keys, *pu, *pv;
    float* out;
    float* mod; float* kmean; bf16* keysb; bf16 *WinT, *WoT, *WqT; int* eidx; float* gw; unsigned char *U8, *V8; float *su, *sv; bf16 *H, *P, *QP, *O, *Y; float* scratch; unsigned char* Win8; float* rs; unsigned char* Wq8; float* rs2; unsigned char* Wo8;
};

#define WR_DPP(x, ctrl) __uint_as_float((unsigned)__builtin_amdgcn_mov_dpp((int)__float_as_uint(x), ctrl, 0xf, 0xf, true))
__device__ __forceinline__ float wave_sum(float v) {
    v += WR_DPP(v, 0xB1); v += WR_DPP(v, 0x4E); v += WR_DPP(v, 0x141); v += WR_DPP(v, 0x140);
    { auto r = __builtin_amdgcn_permlane16_swap(__float_as_uint(v), __float_as_uint(v), false, false); v = __uint_as_float(r[0]) + __uint_as_float(r[1]); }
    { auto r = __builtin_amdgcn_permlane32_swap(__float_as_uint(v), __float_as_uint(v), false, false); v = __uint_as_float(r[0]) + __uint_as_float(r[1]); }
    return v;
}
__device__ __forceinline__ float wave_max(float v) {
    v = fmaxf(v, WR_DPP(v, 0xB1)); v = fmaxf(v, WR_DPP(v, 0x4E)); v = fmaxf(v, WR_DPP(v, 0x141)); v = fmaxf(v, WR_DPP(v, 0x140));
    { auto r = __builtin_amdgcn_permlane16_swap(__float_as_uint(v), __float_as_uint(v), false, false); v = fmaxf(__uint_as_float(r[0]), __uint_as_float(r[1])); }
    { auto r = __builtin_amdgcn_permlane32_swap(__float_as_uint(v), __float_as_uint(v), false, false); v = fmaxf(__uint_as_float(r[0]), __uint_as_float(r[1])); }
    return v;
}
__device__ __forceinline__ float bflo(unsigned u) { return __uint_as_float(u << 16); }
__device__ __forceinline__ float bfhi(unsigned u) { return __uint_as_float(u & 0xffff0000u); }

struct TItem { const float* W; bf16* WT; int N, k0, n0, nb; };
__device__ __forceinline__ void p0_titem_load(const TItem& t, f32x4 (&v)[8], int lane) {
#pragma unroll
    for (int i = 0; i < 8; ++i) { const int kk = 8 * i + (lane >> 3); v[i] = *(const GAS f32x4*)(t.W + (size_t)(t.k0 + kk) * t.N + t.n0 + 4 * (lane & 7)); }
}
__device__ __forceinline__ void p0_titem_process(const TItem& t, const f32x4 (&v)[8], LAS float* scr, int lane) {
#pragma unroll
    for (int i = 0; i < 8; ++i) { const int kk = 8 * i + (lane >> 3); LAS float* d = scr + kk * 33 + 4 * (lane & 7); d[0] = v[i].x; d[1] = v[i].y; d[2] = v[i].z; d[3] = v[i].w; }
    LDS_WAIT(); asm volatile("" ::: "memory");
    const int c = lane & 7;
#pragma unroll
    for (int j = 0; j < 4; ++j) { const int n = (lane >> 3) + 8 * j; const LAS float* s = scr + (8 * c) * 33 + n;
        v4u o; o.x = pk2(s[0 * 33], s[1 * 33]); o.y = pk2(s[2 * 33], s[3 * 33]); o.z = pk2(s[4 * 33], s[5 * 33]); o.w = pk2(s[6 * 33], s[7 * 33]);
        st16_wt((void*)(t.WT + (size_t)(t.nb + n) * D + t.k0 + 8 * c), o); }
    LDS_WAIT(); asm volatile("" ::: "memory");
}
__device__ __forceinline__ void cvt8(const float* src, bf16* dst, size_t i8) {
    const f32x4 a = *(const GAS f32x4*)(src + i8 * 8), b = *(const GAS f32x4*)(src + i8 * 8 + 4);
    v4u o; o.x = pk2(a.x, a.y); o.y = pk2(a.z, a.w); o.z = pk2(b.x, b.y); o.w = pk2(b.z, b.w);
    st16_wt((void*)(dst + i8 * 8), o);
}
__device__ __forceinline__ void p0_prep(Frame& F) {
    {
        LAS float* sc = (LAS float*)F.lds;
        LAS float* red = sc + 4096;
        bool did = false;
        for (int it = blockIdx.x; it < 192; it += F.G) {
            if (!did) { float cv[8];
#pragma unroll
                for (int i = 0; i < 8; ++i) cv[i] = *(const GAS float*)(F.c + F.tid + 512 * i);
#pragma unroll
                for (int i = 0; i < 8; ++i) sc[F.tid + 512 * i] = cv[i] * __builtin_amdgcn_rcpf(1.f + __expf(-cv[i]));
                did = true; }
            __syncthreads();
            const int c4 = F.tid & 7, ks = F.tid >> 3, j0 = it * 32 + 4 * c4;
            f32x4 w[16];
#pragma unroll
            for (int i = 0; i < 16; ++i) w[i] = *(const GAS f32x4*)(F.ada_w + (size_t)(ks * 16 + i) * 6144 + j0);
            f32x4 a0 = {0.f, 0.f, 0.f, 0.f}, a1 = a0, a2 = a0, a3 = a0;
#pragma unroll
            for (int i = 0; i < 16; ++i) { const int r = ks * 16 + i; a0 += w[i] * sc[r]; a1 += w[i] * sc[1024 + r]; a2 += w[i] * sc[2048 + r]; a3 += w[i] * sc[3072 + r]; }
            *(LAS f32x4*)(red + (ks * 4 + 0) * 32 + 4 * c4) = a0; *(LAS f32x4*)(red + (ks * 4 + 1) * 32 + 4 * c4) = a1;
            *(LAS f32x4*)(red + (ks * 4 + 2) * 32 + 4 * c4) = a2; *(LAS f32x4*)(red + (ks * 4 + 3) * 32 + 4 * c4) = a3;
            __syncthreads();
            if (F.tid < 128) { const int b = F.tid >> 5, jj = F.tid & 31; float s = 0.f;
#pragma unroll 16
                for (int k = 0; k < 64; ++k) s += red[(k * 4 + b) * 32 + jj];
                s += F.ada_b[it * 32 + jj];
                const int chn = it >> 5, col = (it & 31) * 32 + jj;
                if (chn == 1) s = F.pre_gain[col] * (s + 1.f); else if (chn == 2) s = F.post_gain[col] * s; else if (chn == 4) s = F.fpre_gain[col] * (s + 1.f); else if (chn == 5) s = s * F.fpost_gain[col];
                __hip_atomic_store(F.mod + b * 6144 + it * 32 + jj, s, __ATOMIC_RELAXED, __HIP_MEMORY_SCOPE_AGENT); }
        }
        __syncthreads();
    }
    LAS float* scr = (LAS float*)(F.lds + F.wave * 16384);
    const int gwv = blockIdx.x * NWAVES + F.wave, NGW = F.G * NWAVES;
    constexpr int I_IN = (D / 64) * (NIN / 32), I_O = (D / 64) * (D / 32), I_Q = (D / 64) * (NQ / 32), I_ALL = I_IN + I_O + I_Q;
    auto titem = [&](int it) { TItem t; int r = it;
        if (r < I_IN) { t.W = F.w_in; t.WT = F.WinT; t.N = NIN; }
        else if (r < I_IN + I_O) { r -= I_IN; t.W = F.w_out; t.WT = F.WoT; t.N = D; }
        else { r -= I_IN + I_O; t.W = F.wq; t.WT = F.WqT; t.N = NQ; }
        const int nblk = t.N / 32; t.k0 = 64 * (r / nblk); t.n0 = 32 * (r % nblk); t.nb = t.n0;
        if (it < I_IN && t.n0 >= 512 && t.n0 < 1536) { const int hx = t.n0 >= 1024, cc = t.n0 - (hx ? 1024 : 512); t.nb = 512 + 256 * (cc >> 7) + 128 * hx + (cc & 127); }
        return t; };
    { f32x4 va[8], vb[8]; TItem ta, tb;
      int it = gwv;
      if (it < I_ALL) { ta = titem(it); p0_titem_load(ta, va, F.lane); }
      while (it < I_ALL) {
          const int i1 = it + NGW; const bool h1 = i1 < I_ALL;
          if (h1) { tb = titem(i1); p0_titem_load(tb, vb, F.lane); }
          p0_titem_process(ta, va, scr, F.lane);
          if (!h1) break;
          it = i1 + NGW;
          if (it < I_ALL) { ta = titem(it); p0_titem_load(ta, va, F.lane); }
          p0_titem_process(tb, vb, scr, F.lane);
      } }
    const size_t gt = (size_t)blockIdx.x * 512 + F.tid, NT = (size_t)F.G * 512;
    for (size_t i = gt; i < (size_t)16 * 128 * 128 / 8; i += NT) cvt8(F.keys, F.keysb, i);
}
__device__ __forceinline__ void p0_tables(Frame& F) {
    const int gwv = blockIdx.x * NWAVES + F.wave, NGW = F.G * NWAVES;
    for (int row0 = gwv; row0 < 2 * NEXP; row0 += 2 * NGW) {
      f32x4 a2[2][4];
#pragma unroll
      for (int rr = 0; rr < 2; ++rr) { const int row = row0 + rr * NGW; if (row < 2 * NEXP) { const GAS f32x4* src = (const GAS f32x4*)(((row >> 14) ? F.pv : F.pu) + (size_t)(row & (NEXP - 1)) * D + 16 * F.lane);
#pragma unroll
          for (int i = 0; i < 4; ++i) a2[rr][i] = src[i]; } }
#pragma unroll
      for (int rr = 0; rr < 2; ++rr) { const int row = row0 + rr * NGW; if (row >= 2 * NEXP) break;
        const int tabv = row >> 14, e = row & (NEXP - 1);
        f32x4 a[4]; float ssq = 0.f;
#pragma unroll
        for (int i = 0; i < 4; ++i) { a[i] = a2[rr][i]; ssq += (a[i].x * a[i].x + a[i].y * a[i].y) + (a[i].z * a[i].z + a[i].w * a[i].w); }
        ssq = wave_sum(ssq);
        const float rms = sqrtf(ssq * (1.f / D));
        if (tabv == 0) {
            const float stepq = 0.34f * rms, isq = stepq > 0.f ? 1.f / stepq : 0.f;
            unsigned d0 = 0u, d1 = 0u;
#pragma unroll
            for (int i = 0; i < 4; ++i) { const float xs[4] = {a[i].x, a[i].y, a[i].z, a[i].w};
#pragma unroll
                for (int c = 0; c < 4; ++c) { const int q = (int)fminf(fmaxf(__builtin_rintf(xs[c] * isq), -7.f), 7.f); const int el = 4 * i + c;
                    if (el < 8) d0 |= (unsigned)(q & 15) << (4 * el); else d1 |= (unsigned)(q & 15) << (4 * (el - 8)); } }
            st8_wt((void*)(F.U8 + (size_t)e * 512 + 8 * F.lane), (unsigned long long)d0 | ((unsigned long long)d1 << 32));
            if (F.lane == 0) __hip_atomic_store(F.su + 2 * e, stepq, __ATOMIC_RELAXED, __HIP_MEMORY_SCOPE_AGENT);
        } else {
            const float unit = 0.5f * rms, iu = unit > 0.f ? 1.f / unit : 0.f;
            unsigned d0 = 0u, d1 = 0u;
            d0 = __builtin_amdgcn_cvt_scalef32_pk_fp4_f32(d0, a[0].x * iu, a[0].y * iu, 1.0f, 0); d0 = __builtin_amdgcn_cvt_scalef32_pk_fp4_f32(d0, a[0].z * iu, a[0].w * iu, 1.0f, 1);
            d0 = __builtin_amdgcn_cvt_scalef32_pk_fp4_f32(d0, a[1].x * iu, a[1].y * iu, 1.0f, 2); d0 = __builtin_amdgcn_cvt_scalef32_pk_fp4_f32(d0, a[1].z * iu, a[1].w * iu, 1.0f, 3);
            d1 = __builtin_amdgcn_cvt_scalef32_pk_fp4_f32(d1, a[2].x * iu, a[2].y * iu, 1.0f, 0); d1 = __builtin_amdgcn_cvt_scalef32_pk_fp4_f32(d1, a[2].z * iu, a[2].w * iu, 1.0f, 1);
            d1 = __builtin_amdgcn_cvt_scalef32_pk_fp4_f32(d1, a[3].x * iu, a[3].y * iu, 1.0f, 2); d1 = __builtin_amdgcn_cvt_scalef32_pk_fp4_f32(d1, a[3].z * iu, a[3].w * iu, 1.0f, 3);
            st8_wt((void*)(F.V8 + (size_t)(F.lane >> 4) * (NEXP * 128) + (size_t)e * 128 + (F.lane & 15) * 8), (unsigned long long)d0 | ((unsigned long long)d1 << 32));
            if (F.lane == 0) __hip_atomic_store(F.su + 2 * e + 1, unit, __ATOMIC_RELAXED, __HIP_MEMORY_SCOPE_AGENT);
        }
      }
    }
}

__device__ __forceinline__ unsigned q8x4(const f32x4 v, float qs) {
    const int a = (int)__builtin_rintf(v.x * qs), b = (int)__builtin_rintf(v.y * qs), c = (int)__builtin_rintf(v.z * qs), d = (int)__builtin_rintf(v.w * qs);
    return ((unsigned)a & 0xffu) | (((unsigned)b & 0xffu) << 8) | (((unsigned)c & 0xffu) << 16) | ((unsigned)d << 24);
}
__device__ __forceinline__ unsigned q8x4c(const f32x4 v, float qs) {
    const int a = (int)fminf(fmaxf(__builtin_rintf(v.x * qs), -127.f), 127.f), b = (int)fminf(fmaxf(__builtin_rintf(v.y * qs), -127.f), 127.f);
    const int c = (int)fminf(fmaxf(__builtin_rintf(v.z * qs), -127.f), 127.f), d = (int)fminf(fmaxf(__builtin_rintf(v.w * qs), -127.f), 127.f);
    return ((unsigned)a & 0xffu) | (((unsigned)b & 0xffu) << 8) | (((unsigned)c & 0xffu) << 16) | ((unsigned)d << 24);
}
__device__ __forceinline__ void p1_hnorm(Frame& F) {
    const int gwv = blockIdx.x * NWAVES + F.wave, NGW = F.G * NWAVES;
    for (int m0 = gwv * 4; m0 < M; m0 += NGW * 4) {
        const int b = m0 >> 12;
        f32x4 v[4][4];
#pragma unroll
        for (int r = 0; r < 4; ++r) { const GAS f32x4* xr = (const GAS f32x4*)(F.x + (size_t)(m0 + r) * D) + F.lane;
#pragma unroll
            for (int j = 0; j < 4; ++j) v[r][j] = xr[64 * j]; }
        f32x4 gs[4], sh[4];
#pragma unroll
        for (int j = 0; j < 4; ++j) { const int col = 4 * F.lane + 256 * j;
            gs[j] = *(const GAS f32x4*)(F.mod + b * 6144 + 1024 + col); sh[j] = *(const GAS f32x4*)(F.mod + b * 6144 + col); }
#pragma unroll
        for (int r = 0; r < 4; ++r) {
            float ss = 0.f;
#pragma unroll
            for (int j = 0; j < 4; ++j) ss += (v[r][j].x * v[r][j].x + v[r][j].y * v[r][j].y) + (v[r][j].z * v[r][j].z + v[r][j].w * v[r][j].w);
            const float rstd = rsqrtf(wave_sum(ss) * (1.f / D) + EPS);
            f32x4 o[4]; float am = 0.f;
#pragma unroll
            for (int j = 0; j < 4; ++j) { o[j] = v[r][j] * rstd * gs[j] + sh[j]; am = fmaxf(am, fmaxf(fmaxf(fabsf(o[j].x), fabsf(o[j].y)), fmaxf(fabsf(o[j].z), fabsf(o[j].w)))); }
            am = wave_max(am);
            const float qs = am > 0.f ? 127.f / am : 0.f;
            v4u w; w.x = q8x4(o[0], qs); w.y = q8x4(o[1], qs); w.z = q8x4(o[2], qs); w.w = q8x4(o[3], qs);
            st16_wt((void*)((unsigned char*)F.H + (size_t)(m0 + r) * D + 16 * F.lane), w);
            if (F.lane == 0) __hip_atomic_store(F.rs + m0 + r, am * (1.f / 127.f), __ATOMIC_RELAXED, __HIP_MEMORY_SCOPE_AGENT);
        }
    }
    for (int n = gwv; n < NIN; n += NGW) {
        const GAS unsigned long long* src = (const GAS unsigned long long*)(F.WinT + (size_t)n * D) + F.lane;
        unsigned long long q[4];
#pragma unroll
        for (int j = 0; j < 4; ++j) q[j] = src[64 * j];
        f32x4 wv[4]; float am = 0.f;
#pragma unroll
        for (int j = 0; j < 4; ++j) { const unsigned lo = (unsigned)q[j], hi = (unsigned)(q[j] >> 32); wv[j] = (f32x4){bflo(lo), bfhi(lo), bflo(hi), bfhi(hi)};
            am = fmaxf(am, fmaxf(fmaxf(fabsf(wv[j].x), fabsf(wv[j].y)), fmaxf(fabsf(wv[j].z), fabsf(wv[j].w)))); }
        am = wave_max(am);
        const float qs = am > 0.f ? 127.f / am : 0.f;
        v4u w; w.x = q8x4(wv[0], qs); w.y = q8x4(wv[1], qs); w.z = q8x4(wv[2], qs); w.w = q8x4(wv[3], qs);
        st16_wt((void*)(F.Win8 + (size_t)n * D + 16 * F.lane), w);
        if (F.lane == 0) __hip_atomic_store((unsigned*)(F.ctl + CW_CMAX + n), __float_as_uint(am), __ATOMIC_RELAXED, __HIP_MEMORY_SCOPE_AGENT);
    }
    f32x4 gk[4];
#pragma unroll
    for (int i = 0; i < 4; ++i) gk[i] = *(const GAS f32x4*)(F.group_gain + 16 * F.lane + 4 * i) * (1.f / YQ);
    for (int n = gwv; n < NQ + D; n += NGW) {
        const bool isq = n < NQ; const int nn = isq ? n : n - NQ;
        const GAS v4u* src = (const GAS v4u*)((isq ? F.WqT : F.WoT) + (size_t)nn * D + 16 * F.lane);
        const v4u q0 = src[0], q1 = src[1];
        f32x4 wv[4] = {(f32x4){bflo(q0.x), bfhi(q0.x), bflo(q0.y), bfhi(q0.y)}, (f32x4){bflo(q0.z), bfhi(q0.z), bflo(q0.w), bfhi(q0.w)}, (f32x4){bflo(q1.x), bfhi(q1.x), bflo(q1.y), bfhi(q1.y)}, (f32x4){bflo(q1.z), bfhi(q1.z), bflo(q1.w), bfhi(q1.w)}};
        float am = 0.f;
#pragma unroll
        for (int j = 0; j < 4; ++j) { if (!isq) wv[j] = wv[j] * gk[j]; am = fmaxf(am, fmaxf(fmaxf(fabsf(wv[j].x), fabsf(wv[j].y)), fmaxf(fabsf(wv[j].z), fabsf(wv[j].w)))); }
        am = wave_max(am);
        const float qs = am > 0.f ? 127.f / am : 0.f;
        v4u w; w.x = q8x4(wv[0], qs); w.y = q8x4(wv[1], qs); w.z = q8x4(wv[2], qs); w.w = q8x4(wv[3], qs);
        st16_wt((void*)((isq ? F.Wq8 : F.Wo8) + (size_t)nn * D + 16 * F.lane), w);
        if (F.lane == 0) __hip_atomic_store((unsigned*)(F.ctl + (isq ? CW_CMAX2 : CW_CMAX3) + nn), __float_as_uint(am), __ATOMIC_RELAXED, __HIP_MEMORY_SCOPE_AGENT);
    }
}

__device__ __forceinline__ void unpack8(const v4u w, float* f) { f[0] = bflo(w.x); f[1] = bfhi(w.x); f[2] = bflo(w.y); f[3] = bfhi(w.y); f[4] = bflo(w.z); f[5] = bfhi(w.z); f[6] = bflo(w.w); f[7] = bfhi(w.w); }
__device__ __forceinline__ void p6_conv(Frame& F, bool grouped) {
    const int gwv = blockIdx.x * NWAVES + F.wave, NGW = F.G * NWAVES;
    const int c_ = (int)blockIdx.x, tbase = grouped ? 256 * (8 * (c_ & 7) + ((c_ >> 3) & 7)) + 64 * (c_ >> 6) + 8 * F.wave : gwv * 4, tstep = grouped ? 4 : NGW * 4, tend = grouped ? tbase + 8 : M;
    const int col = 8 * F.lane;
    float cw[3][8], gg[8];
    { const int ng = 512 + 256 * (col >> 7) + (col & 127);
#pragma unroll
      for (int i = 0; i < 8; ++i) { const float kc = __uint_as_float(F.ctl[CW_CMAX + ng + i]) * __uint_as_float(F.ctl[CW_CMAX + ng + 128 + i]) * (1.f / (127.f * 127.f));
#pragma unroll
          for (int j = 0; j < 3; ++j) cw[j][i] = F.conv_w[j * 512 + col + i] * kc; } }
#pragma unroll
    for (int i = 0; i < 8; ++i) gg[i] = F.group_gain[col + i];
    for (int t0 = tbase; t0 < tend; t0 += tstep) {
        const int s0 = t0 & 4095;
        v4u gbw[4], uw[6];
#pragma unroll
        for (int r = 0; r < 4; ++r) gbw[r] = *(const GAS v4u*)(F.P + (size_t)(t0 + r) * NIN + col);
#pragma unroll
        for (int k = 0; k < 6; ++k) { const int tt = (s0 == 0 && k < 2) ? t0 : (t0 - 2 + k);
            uw[k] = *(const GAS v4u*)(F.P + (size_t)tt * NIN + 512 + col); }
        float u[6][8];
#pragma unroll
        for (int k = 0; k < 6; ++k) { unpack8(uw[k], u[k]); if (s0 == 0 && k < 2) {
#pragma unroll
            for (int i = 0; i < 8; ++i) u[k][i] = 0.f; } }
#pragma unroll
        for (int r = 0; r < 4; ++r) {
            float acc[8], gb[8]; unpack8(gbw[r], gb);
            float ss = 0.f;
#pragma unroll
            for (int i = 0; i < 8; ++i) { acc[i] = gb[i] * (cw[0][i] * u[r][i] + cw[1][i] * u[r + 1][i] + cw[2][i] * u[r + 2][i]); ss += acc[i] * acc[i]; }
            ss += WR_DPP(ss, 0xB1); ss += WR_DPP(ss, 0x4E); ss += WR_DPP(ss, 0x141);
            const float rstd = rsqrtf(ss * (1.f / 64.f) + EPS);
            const float qn = rstd * YQ;
            const unsigned w0 = q8x4c((f32x4){acc[0], acc[1], acc[2], acc[3]}, qn), w1 = q8x4c((f32x4){acc[4], acc[5], acc[6], acc[7]}, qn);
            st8_wt((void*)((unsigned char*)F.Y + (size_t)(t0 + r) * D + col), (unsigned long long)w0 | ((unsigned long long)w1 << 32));
        }
    }
}
__device__ __forceinline__ void p8_resid(Frame& F, bool grouped) {
    const int gwv = blockIdx.x * NWAVES + F.wave, NGW = F.G * NWAVES;
    const int c_ = (int)blockIdx.x, mbase = grouped ? 256 * (8 * (c_ & 7) + ((c_ >> 3) & 7)) + 64 * (c_ >> 6) + 8 * F.wave : gwv * 2, mstep = grouped ? 2 : NGW * 2, mend = grouped ? mbase + 8 : M;
    f32x4 gg[4], gs[4], sh[4];
#define P8_GAINS(MM) { const float* md = F.mod + ((MM) >> 12) * 6144; _Pragma("unroll") for (int j = 0; j < 4; ++j) { const int col = 4 * F.lane + 256 * j; \
        gg[j] = *(const GAS f32x4*)(md + 2048 + col); gs[j] = *(const GAS f32x4*)(md + 4096 + col); sh[j] = *(const GAS f32x4*)(md + 3072 + col); } }
    if (grouped) P8_GAINS(mbase)
    for (int m0 = mbase; m0 < mend; m0 += mstep) {
        unsigned long long ow[2][4]; f32x4 xv[2][4];
#pragma unroll
        for (int r = 0; r < 2; ++r) {
            const GAS unsigned long long* orow = (const GAS unsigned long long*)(F.O + (size_t)(m0 + r) * D) + F.lane; const GAS f32x4* xr = (const GAS f32x4*)(F.x + (size_t)(m0 + r) * D) + F.lane;
#pragma unroll
            for (int j = 0; j < 4; ++j) { ow[r][j] = orow[64 * j]; xv[r][j] = xr[64 * j]; } }
        if (!grouped) P8_GAINS(m0)
#pragma unroll
        for (int r = 0; r < 2; ++r) { const int m = m0 + r;
            f32x4 ov[4]; float ss = 0.f;
#pragma unroll
            for (int j = 0; j < 4; ++j) { const unsigned lo = (unsigned)ow[r][j], hi = (unsigned)(ow[r][j] >> 32); ov[j] = (f32x4){bflo(lo), bfhi(lo), bflo(hi), bfhi(hi)};
                ss += (ov[j].x * ov[j].x + ov[j].y * ov[j].y) + (ov[j].z * ov[j].z + ov[j].w * ov[j].w); }
            const float rstd = rsqrtf(wave_sum(ss) * (1.f / D) + EPS);
            GAS unsigned long long* x1r = (GAS unsigned long long*)(F.QP + (size_t)m * D) + F.lane;
            f32x4 x1[4]; float s2 = 0.f;
#pragma unroll
            for (int j = 0; j < 4; ++j) { x1[j] = xv[r][j] + gg[j] * (ov[j] * rstd); x1r[64 * j] = (unsigned long long)pk2(x1[j].x, x1[j].y) | ((unsigned long long)pk2(x1[j].z, x1[j].w) << 32);
                s2 += (x1[j].x * x1[j].x + x1[j].y * x1[j].y) + (x1[j].z * x1[j].z + x1[j].w * x1[j].w); }
            const float rstd2 = rsqrtf(wave_sum(s2) * (1.f / D) + EPS);
            f32x4 o[4]; float am = 0.f;
#pragma unroll
            for (int j = 0; j < 4; ++j) { o[j] = x1[j] * rstd2 * gs[j] + sh[j]; am = fmaxf(am, fmaxf(fmaxf(fabsf(o[j].x), fabsf(o[j].y)), fmaxf(fabsf(o[j].z), fabsf(o[j].w)))); }
            am = wave_max(am);
            const float qs = am > 0.f ? 119.f / am : 0.f;
#pragma unroll
            for (int j = 0; j < 4; ++j) st4_wt((void*)((unsigned char*)F.H + (size_t)m * D + 4 * F.lane + 256 * j), q8x4(o[j], qs));
            if (F.lane == 0) __hip_atomic_store(F.rs2 + m, am * (1.f / 119.f), __ATOMIC_RELAXED, __HIP_MEMORY_SCOPE_AGENT);
        }
    }
}
#undef P8_GAINS
typedef float f32x16 __attribute__((ext_vector_type(16)));
__device__ __forceinline__ float vmaxf(float a, float b) { float r; asm("v_max_f32_e32 %0, %1, %2" : "=v"(r) : "v"(a), "v"(b)); return r; }
__device__ __forceinline__ float vminf(float a, float b) { float r; asm("v_min_f32_e32 %0, %1, %2" : "=v"(r) : "v"(a), "v"(b)); return r; }
#define CE_D(a, b) do { const float hi_ = vmaxf(a, b), lo_ = vminf(a, b); a = hi_; b = lo_; } while (0)
template <int N> __device__ __forceinline__ void bitonic_sort_desc(float (&v)[N]) {
#pragma unroll
    for (int k = 2; k <= N; k <<= 1)
#pragma unroll
        for (int j = k >> 1; j > 0; j >>= 1)
#pragma unroll
            for (int i = 0; i < N; ++i) { const int l = i ^ j; if (l > i) { if ((i & k) == 0) CE_D(v[i], v[l]); else CE_D(v[l], v[i]); } }
}
template <int N> __device__ __forceinline__ void bitonic_merge_desc(float (&v)[N]) {
#pragma unroll
    for (int j = N >> 1; j > 0; j >>= 1)
#pragma unroll
        for (int i = 0; i < N; ++i) { const int l = i ^ j; if (l > i) CE_D(v[i], v[l]); }
}
__device__ __forceinline__ void sort16_desc(float (&v)[16]) {
    CE_D(v[0], v[1]); CE_D(v[2], v[3]); CE_D(v[0], v[2]); CE_D(v[1], v[3]); CE_D(v[1], v[2]); CE_D(v[4], v[5]); CE_D(v[6], v[7]); CE_D(v[4], v[6]); CE_D(v[5], v[7]); CE_D(v[5], v[6]); CE_D(v[0], v[4]); CE_D(v[2], v[6]); CE_D(v[2], v[4]); CE_D(v[1], v[5]); CE_D(v[3], v[7]); CE_D(v[3], v[5]); CE_D(v[1], v[2]); CE_D(v[3], v[4]); CE_D(v[5], v[6]); CE_D(v[8], v[9]); CE_D(v[10], v[11]); CE_D(v[8], v[10]); CE_D(v[9], v[11]); CE_D(v[9], v[10]); CE_D(v[12], v[13]); CE_D(v[14], v[15]); CE_D(v[12], v[14]); CE_D(v[13], v[15]); CE_D(v[13], v[14]); CE_D(v[8], v[12]); CE_D(v[10], v[14]); CE_D(v[10], v[12]); CE_D(v[9], v[13]); CE_D(v[11], v[15]); CE_D(v[11], v[13]); CE_D(v[9], v[10]); CE_D(v[11], v[12]); CE_D(v[13], v[14]); CE_D(v[0], v[8]); CE_D(v[4], v[12]); CE_D(v[4], v[8]); CE_D(v[2], v[10]); CE_D(v[6], v[14]); CE_D(v[6], v[10]); CE_D(v[2], v[4]); CE_D(v[6], v[8]); CE_D(v[10], v[12]); CE_D(v[1], v[9]); CE_D(v[5], v[13]); CE_D(v[5], v[9]); CE_D(v[3], v[11]); CE_D(v[7], v[15]); CE_D(v[7], v[11]); CE_D(v[3], v[5]); CE_D(v[7], v[9]); CE_D(v[11], v[13]); CE_D(v[1], v[2]); CE_D(v[3], v[4]); CE_D(v[5], v[6]); CE_D(v[7], v[8]); CE_D(v[9], v[10]); CE_D(v[11], v[12]); CE_D(v[13], v[14]);
}
__device__ __forceinline__ void top16_merge(float (&a)[16], const float (&b)[16]) {
#pragma unroll
    for (int i = 0; i < 16; ++i) a[i] = vmaxf(a[i], b[15 - i]);
    bitonic_merge_desc<16>(a);
}
__device__ __forceinline__ void top16_of_64(const float (&v)[64], float (&out)[16]) {
    float g1[16], g2[16], g3[16];
#pragma unroll
    for (int i = 0; i < 16; ++i) { out[i] = v[i]; g1[i] = v[16 + i]; g2[i] = v[32 + i]; g3[i] = v[48 + i]; }
    sort16_desc(out); sort16_desc(g1); sort16_desc(g2); sort16_desc(g3);
    top16_merge(out, g1); top16_merge(g2, g3); top16_merge(out, g2);
}
constexpr int KROW = 272, KIMG = 128 * KROW;
__device__ __forceinline__ void route_half(const bf16x8 (&bq)[8], const LAS unsigned char* kimg, int r32, int hh, float (&svp)[16], unsigned (&ivp)[16]) {
    const LAS unsigned char* krow = kimg + r32 * KROW + 16 * hh;
    f32x16 acc[4];
#pragma unroll
    for (int nt = 0; nt < 4; ++nt) {
        acc[nt] = (f32x16){0.f, 0.f, 0.f, 0.f, 0.f, 0.f, 0.f, 0.f, 0.f, 0.f, 0.f, 0.f, 0.f, 0.f, 0.f, 0.f};
#pragma unroll
        for (int ks = 0; ks < 8; ++ks) { const bf16x8 ak = *(const LAS bf16x8*)(krow + nt * 32 * KROW + 32 * ks);
            acc[nt] = __builtin_amdgcn_mfma_f32_32x32x16_bf16(ak, bq[ks], acc[nt], 0, 0, 0); }
    }
    float v[64];
#pragma unroll
    for (int nt = 0; nt < 4; ++nt)
#pragma unroll
        for (int i = 0; i < 16; ++i) { const unsigned code = (unsigned)(32 * nt + 8 * (i >> 2) + (i & 3)); v[nt * 16 + i] = __uint_as_float((__float_as_uint(acc[nt][i]) & ~127u) | code); }
    float L[16], Pn[16];
    top16_of_64(v, L);
#pragma unroll
    for (int i = 0; i < 16; ++i) { L[i] = __uint_as_float(__float_as_uint(L[i]) | (unsigned)(hh << 2));
        auto r_ = __builtin_amdgcn_permlane32_swap(__float_as_uint(L[i]), __float_as_uint(L[i]), false, false); Pn[i] = __uint_as_float(hh ? r_[0] : r_[1]); }
    top16_merge(L, Pn);
#pragma unroll
    for (int i = 0; i < 16; ++i) { const unsigned bits = __float_as_uint(L[i]); svp[i] = __uint_as_float(bits & ~127u); ivp[i] = bits & 127u; }
}
__device__ __forceinline__ void route_finish(const float (&sv)[2][16], const unsigned (&iv)[2][16], LAS unsigned* tab, int lane, int hh, unsigned short* epi, unsigned short* gpf, float rst) {
#define CAND(a, b) __uint_as_float((__float_as_uint(sv[0][a] + sv[1][b]) & ~255u) | (unsigned)((a) * 16 + (b)))
    float W[16], g1[16], g2[16];
#pragma unroll
    for (int i = 0; i < 16; ++i) W[i] = CAND(0, i);
#pragma unroll
    for (int i = 0; i < 15; ++i) g1[i] = CAND(i + 1, 0);
    g1[15] = -3e38f;
    g2[0] = CAND(1, 1); g2[1] = CAND(1, 2); g2[2] = CAND(1, 3); g2[3] = CAND(1, 4); g2[4] = CAND(1, 5); g2[5] = CAND(1, 6); g2[6] = CAND(1, 7);
    g2[7] = CAND(2, 1); g2[8] = CAND(2, 2); g2[9] = CAND(2, 3); g2[10] = CAND(2, 4); g2[11] = CAND(3, 1); g2[12] = CAND(3, 2); g2[13] = CAND(3, 3); g2[14] = CAND(4, 1); g2[15] = CAND(4, 2);
    sort16_desc(g2);
    g2[13] = vmaxf(g2[13], CAND(7, 1)); g2[14] = vmaxf(g2[14], CAND(6, 1)); g2[15] = vmaxf(g2[15], CAND(5, 1));
    bitonic_merge_desc<16>(g2);
    top16_merge(W, g1); top16_merge(W, g2);
#undef CAND
#pragma unroll
    for (int j = 0; j < 16; ++j) { tab[j * 64 + lane] = iv[0][j]; tab[(16 + j) * 64 + lane] = iv[1][j]; }
    float e[16], sum = 0.f; unsigned ex[16];
    const float s0 = __uint_as_float(__float_as_uint(W[0]) & ~255u);
#pragma unroll
    for (int j = 0; j < 16; ++j) { const unsigned bits = __float_as_uint(W[j]); const unsigned code = bits & 255u;
        e[j] = __expf((__uint_as_float(bits & ~255u) - s0) * rst); sum += e[j];
        ex[j] = tab[(code >> 4) * 64 + lane] * 128u + tab[(16 + (code & 15u)) * 64 + lane]; }
    const float inv = 1.f / sum;
    v4u eo, go;
    eo.x = (hh ? ex[8] : ex[0]) | ((hh ? ex[9] : ex[1]) << 16); eo.y = (hh ? ex[10] : ex[2]) | ((hh ? ex[11] : ex[3]) << 16);
    eo.z = (hh ? ex[12] : ex[4]) | ((hh ? ex[13] : ex[5]) << 16); eo.w = (hh ? ex[14] : ex[6]) | ((hh ? ex[15] : ex[7]) << 16);
    go.x = pk2((hh ? e[8] : e[0]) * inv, (hh ? e[9] : e[1]) * inv); go.y = pk2((hh ? e[10] : e[2]) * inv, (hh ? e[11] : e[3]) * inv);
    go.z = pk2((hh ? e[12] : e[4]) * inv, (hh ? e[13] : e[5]) * inv); go.w = pk2((hh ? e[14] : e[6]) * inv, (hh ? e[15] : e[7]) * inv);
    GAS v4u* ep = (GAS v4u*)epi; GAS v4u* gp = (GAS v4u*)gpf;
    st16_wt((void*)ep, eo); st16_wt((void*)gp, go);
}
__device__ __forceinline__ pg8::f32x4 i2f(const pg8::f32x4 a) { const pg8::i32x4 i = __builtin_bit_cast(pg8::i32x4, a); return (pg8::f32x4){(float)i[0], (float)i[1], (float)i[2], (float)i[3]}; }
struct EpiRoute {
    static constexpr bool PERM = true, AFTER_DRAIN = true;
    const bf16* keysb; int* eidx; float* gw; const unsigned* cmax2; const float* rs2;
    __device__ __forceinline__ void fused(pg8::f32x4 (&acc)[2][2][4][2], const pg8::Unit& u, int wr, int wc, int fr, int fq, LAS unsigned char* lds, int wid, int lane) const {
        int tid_ = wid * 64 + lane; asm volatile("" : "+v"(tid_)); const int h = u.pn, r32 = lane & 31, hh = lane >> 5, tid = tid_;
        LAS unsigned char* Qs = lds; LAS unsigned char* Ks = lds + 256 * KROW;
        const float rst = rs2[u.pm * 256 + 32 * wid + r32];
        v4u q1[2][4];
#pragma unroll
        for (int ai = 0; ai < 2; ++ai)
#pragma unroll
            for (int m = 0; m < 4; ++m) { const pg8::f32x4 a = i2f(acc[ai][1][m][0]), b = i2f(acc[ai][1][m][1]);
                q1[ai][m] = (v4u){pg8::cvt_pk_bf16(a[0], a[1]), pg8::cvt_pk_bf16(a[2], a[3]), pg8::cvt_pk_bf16(b[0], b[1]), pg8::cvt_pk_bf16(b[2], b[3])}; }
        float sv[2][16]; unsigned iv[2][16];
        const int ch = tid & 15, kr = tid >> 4;
        pg8::u32x4 c0[2], c1[2]; v4u kq[2][4];
#define ROUTE_KLOAD(p) { c0[p] = *(const pg8::u32x4*)(cmax2 + h * 256 + p * 128 + ch * 8); c1[p] = *(const pg8::u32x4*)(cmax2 + h * 256 + p * 128 + ch * 8 + 4); \
            _Pragma("unroll") for (int i = 0; i < 4; ++i) kq[p][i] = *(const GAS v4u*)(keysb + (size_t)((h * 2 + p) * 128 + kr + 32 * i) * 128 + ch * 8); }
        ROUTE_KLOAD(0)
#pragma unroll
        for (int p = 0; p < 2; ++p) {
            if (p == 1) { asm volatile("s_waitcnt lgkmcnt(0)" ::: "memory"); __builtin_amdgcn_s_barrier(); asm volatile("" ::: "memory"); }
#pragma unroll
            for (int ai = 0; ai < 2; ++ai)
#pragma unroll
                for (int m = 0; m < 4; ++m) { v4u w;
                    if (p == 0) { const pg8::f32x4 a = i2f(acc[ai][0][m][0]), b = i2f(acc[ai][0][m][1]);
                        w = (v4u){pg8::cvt_pk_bf16(a[0], a[1]), pg8::cvt_pk_bf16(a[2], a[3]), pg8::cvt_pk_bf16(b[0], b[1]), pg8::cvt_pk_bf16(b[2], b[3])}; }
                    else w = q1[ai][m];
                    *(LAS v4u*)(Qs + (128 * ai + 64 * wr + 16 * m + fr) * KROW + (32 * wc + 8 * fq) * 2) = w; }
            { float cs[8] = {__uint_as_float(c0[p].x), __uint_as_float(c0[p].y), __uint_as_float(c0[p].z), __uint_as_float(c0[p].w), __uint_as_float(c1[p].x), __uint_as_float(c1[p].y), __uint_as_float(c1[p].z), __uint_as_float(c1[p].w)};
#pragma unroll
              for (int i = 0; i < 8; ++i) cs[i] *= (1.f / 127.f);
#pragma unroll
              for (int i = 0; i < 4; ++i) { const v4u q = kq[p][i];
                v4u ko; ko.x = pk2(bflo(q.x) * cs[0], bfhi(q.x) * cs[1]); ko.y = pk2(bflo(q.y) * cs[2], bfhi(q.y) * cs[3]); ko.z = pk2(bflo(q.z) * cs[4], bfhi(q.z) * cs[5]); ko.w = pk2(bflo(q.w) * cs[6], bfhi(q.w) * cs[7]);
                *(LAS v4u*)(Ks + (kr + 32 * i) * KROW + ch * 16) = ko; } }
            asm volatile("s_waitcnt vmcnt(0) lgkmcnt(0)" ::: "memory"); __builtin_amdgcn_s_barrier(); asm volatile("" ::: "memory");
            if (p == 0) ROUTE_KLOAD(1)
            bf16x8 bq[8];
#pragma unroll
            for (int ks = 0; ks < 8; ++ks) bq[ks] = *(const LAS bf16x8*)(Qs + (32 * wid + r32) * KROW + 32 * ks + 16 * hh);
            route_half(bq, Ks, r32, hh, sv[p], iv[p]);
        }
#undef ROUTE_KLOAD
        asm volatile("s_waitcnt lgkmcnt(0)" ::: "memory"); __builtin_amdgcn_s_barrier(); asm volatile("" ::: "memory");
        const int t = u.pm * 256 + 32 * wid + r32;
        route_finish(sv, iv, (LAS unsigned*)(lds + wid * 8192), lane, hh, (unsigned short*)eidx + (size_t)t * 128 + h * 16 + 8 * hh, (unsigned short*)gw + (size_t)t * 128 + h * 16 + 8 * hh, rst);
        asm volatile("s_waitcnt lgkmcnt(0)" ::: "memory"); __builtin_amdgcn_s_barrier(); asm volatile("" ::: "memory");
    }
};
struct OneUnit {
    pg8::Unit u;
    __device__ __forceinline__ bool next(int i, pg8::Unit& o) const { if (i != 0) return false; o = u; return true; }
    __device__ __forceinline__ void a_ready(const pg8::Unit&) const {}
    __device__ __forceinline__ void done(const pg8::Unit&) const {}
};
__device__ __forceinline__ float gelu_tanh(float a) {
    const float z = 0.7978845608028654f * (a + 0.044715f * a * a * a);
    const float e = __expf(2.f * z);
    const float th = 1.f - 2.f / (e + 1.f);
    return 0.5f * a * (1.f + th);
}
typedef float f32x2v __attribute__((ext_vector_type(2)));
__device__ __forceinline__ void fp8x16_to_f32(const v4u w, float* f) {
    f32x2v t;
    t = __builtin_amdgcn_cvt_pk_f32_fp8((int)w.x, false); f[0] = t.x; f[1] = t.y; t = __builtin_amdgcn_cvt_pk_f32_fp8((int)w.x, true); f[2] = t.x; f[3] = t.y;
    t = __builtin_amdgcn_cvt_pk_f32_fp8((int)w.y, false); f[4] = t.x; f[5] = t.y; t = __builtin_amdgcn_cvt_pk_f32_fp8((int)w.y, true); f[6] = t.x; f[7] = t.y;
    t = __builtin_amdgcn_cvt_pk_f32_fp8((int)w.z, false); f[8] = t.x; f[9] = t.y; t = __builtin_amdgcn_cvt_pk_f32_fp8((int)w.z, true); f[10] = t.x; f[11] = t.y;
    t = __builtin_amdgcn_cvt_pk_f32_fp8((int)w.w, false); f[12] = t.x; f[13] = t.y; t = __builtin_amdgcn_cvt_pk_f32_fp8((int)w.w, true); f[14] = t.x; f[15] = t.y;
}
#define DPPF(x, ctrl) __uint_as_float((unsigned)__builtin_amdgcn_mov_dpp((int)__float_as_uint(x), ctrl, 0xf, 0xf, true))
__device__ __forceinline__ void swap16_add(float& a, float b) { auto r = __builtin_amdgcn_permlane16_swap(__float_as_uint(a), __float_as_uint(b), false, false); a = __uint_as_float(r[0]) + __uint_as_float(r[1]); }
__device__ __forceinline__ void swap32_add(float& a, float b) { auto r = __builtin_amdgcn_permlane32_swap(__float_as_uint(a), __float_as_uint(b), false, false); a = __uint_as_float(r[0]) + __uint_as_float(r[1]); }
constexpr int PW_BUF0 = 0, PW_SG = 4096, PW_BUF1 = 8192, PW_E = 16384, PW_WH = 17408, PW_WL = 17920, PW_YP = 18432, PW_IK = 18944, PW_BYTES = 18976;
static_assert(PW_BYTES * NWAVES <= LDSCTL_OFF, "PEER per-wave LDS blocks must stay below the control words");
typedef int v8i_t __attribute__((ext_vector_type(8)));
typedef int v2i_t __attribute__((ext_vector_type(2)));
__device__ __forceinline__ void peer_u_issue(v4u (&uw)[8], const unsigned char* U4, LAS unsigned char* wl, int it, int lane) {
    const int grp = it >> 2, j = it & 3, hw = lane >> 5, li = lane & 31;
#pragma unroll
    for (int q = 0; q < 8; ++q) { const unsigned e = *(const LAS unsigned short*)(wl + PW_E + (j * 128 + grp * 16 + 2 * q + hw) * 2);
        uw[q] = *(const GAS v4u*)(U4 + (e * 512u + 16u * (unsigned)li)); }
}
__device__ __forceinline__ void peer_u_compute(const v4u (&uw)[8], LAS unsigned char* wl, int it, int lane) {
    const int grp = it >> 2, j = it & 3, li = lane & 31;
    const v4u hh = *(LAS v4u*)(wl + j * 1024 + 16 * li), hl = *(LAS v4u*)(wl + j * 1024 + 512 + 16 * li);
    float pa[8];
#pragma unroll
    for (int q = 0; q < 8; ++q) {
        int dh = __builtin_amdgcn_sdot8((int)uw[q].x, (int)hh.x, 0, false); dh = __builtin_amdgcn_sdot8((int)uw[q].y, (int)hh.y, dh, false);
        dh = __builtin_amdgcn_sdot8((int)uw[q].z, (int)hh.z, dh, false); dh = __builtin_amdgcn_sdot8((int)uw[q].w, (int)hh.w, dh, false);
        int dl = __builtin_amdgcn_sdot8((int)uw[q].x, (int)hl.x, 0, false); dl = __builtin_amdgcn_sdot8((int)uw[q].y, (int)hl.y, dl, false);
        dl = __builtin_amdgcn_sdot8((int)uw[q].z, (int)hl.z, dl, false); dl = __builtin_amdgcn_sdot8((int)uw[q].w, (int)hl.w, dl, false);
        pa[q] = (float)(16 * dh + dl); }
    swap16_add(pa[0], pa[4]); swap16_add(pa[1], pa[5]); swap16_add(pa[2], pa[6]); swap16_add(pa[3], pa[7]);
#pragma unroll
    for (int i = 0; i < 4; ++i) { pa[i] += DPPF(pa[i], 0xB1); pa[i] += DPPF(pa[i], 0x4E); pa[i] += DPPF(pa[i], 0x141); pa[i] += DPPF(pa[i], 0x140); }
    if ((lane & 12) == 0) {
        const int q = lane & 3, r = lane >> 4;
        const int idx = j * 128 + grp * 16 + 2 * (q + 4 * (r & 1)) + (r >> 1);
        const f32x2v sg = *(const LAS f32x2v*)(wl + PW_SG + idx * 8);
        const float a = (q == 0 ? pa[0] : q == 1 ? pa[1] : q == 2 ? pa[2] : pa[3]) * sg.x;
        *(LAS float*)(wl + PW_BUF1 + idx * 4) = sg.y * gelu_tanh(a);
    }
}
__device__ __forceinline__ void peer_v_issue(const unsigned char* V8, LAS unsigned char* wl, unsigned lbase, int it, int lane, unsigned c16e, unsigned c16o) {
    const int sl = it >> 3, j = (it >> 1) & 3, hf = it & 1;
    const unsigned char* vbase = V8 + (size_t)sl * (NEXP * 128);
    const unsigned dst = lbase + PW_BUF0 + (it & 1) * 8192;
    unsigned go[8];
#pragma unroll
    for (int q = 0; q < 8; ++q) { const unsigned e = *(const LAS unsigned short*)(wl + PW_E + (j * 128 + 64 * hf + 8 * q + (lane >> 3)) * 2); go[q] = e * 128u + ((q & 1) ? c16o : c16e); }
#pragma unroll
    for (int q = 0; q < 8; ++q) attn_body::glds16s(vbase, go[q], (unsigned)__builtin_amdgcn_readfirstlane((int)(dst + q * 1024)));
}
__device__ __forceinline__ void peer_v_compute(LAS unsigned char* wl, f32x4 (&acc)[8], bf16* yrow0, int it, int lane) {
    const int sl = it >> 3, j = (it >> 1) & 3, hf = it & 1;
    const int m = lane & 15, kg = lane >> 4;
    const LAS unsigned char* wsrc = wl + ((m & 1) ? PW_WL : PW_WH) + j * 128 + 64 * hf + 16 * (kg & 1);
    const v4u a0 = *(const LAS v4u*)wsrc, a1 = *(const LAS v4u*)(wsrc + 32);
    const bool valid = (m < 4) && ((m >> 1) == (kg >> 1));
    v8i_t A;
    A[0] = valid ? (int)a0.x : 0; A[1] = valid ? (int)a0.y : 0; A[2] = valid ? (int)a0.z : 0; A[3] = valid ? (int)a0.w : 0;
    A[4] = valid ? (int)a1.x : 0; A[5] = valid ? (int)a1.y : 0; A[6] = valid ? (int)a1.z : 0; A[7] = valid ? (int)a1.w : 0;
    if (hf == 0) {
#pragma unroll
        for (int T = 0; T < 8; ++T) acc[T] = (f32x4){0.f, 0.f, 0.f, 0.f};
    }
    const LAS unsigned char* bb = wl + PW_BUF0 + (it & 1) * 8192 + (32 * (kg >> 1) + m) * 128 + 8 * (kg & 1);
    const unsigned x16 = (unsigned)(m >> 1) * 16u;
#pragma unroll
    for (int T = 0; T < 8; ++T) {
        const LAS unsigned char* p = bb + ((16u * T) ^ x16);
        const v2i_t b0 = __builtin_amdgcn_ds_read_tr4_b64_v2i32((LAS v2i_t*)p), b1 = __builtin_amdgcn_ds_read_tr4_b64_v2i32((LAS v2i_t*)(p + 2048));
        const v8i_t B = {b0.x, b0.y, b1.x, b1.y, 0, 0, 0, 0};
        acc[T] = __builtin_amdgcn_mfma_scale_f32_16x16x128_f8f6f4(A, B, acc[T], 0, 4, 0, 0x7f7f7f7f, 0, 0x7f7f7f7f);
    }
    if (hf == 1) {
        const float ik = *(const LAS float*)(wl + PW_IK + j * 4);
        LAS unsigned char* yp = lane < 16 ? wl + PW_YP + m * 2 : wl + PW_IK + 16;
        const int ystep = lane < 16 ? 1 : 0;
#pragma unroll
        for (int T = 0; T < 8; ++T) {
            *(LAS unsigned short*)(yp + ystep * (64 * T)) = (unsigned short)f2bf((acc[T][0] + acc[T][1]) * ik);
            *(LAS unsigned short*)(yp + ystep * (64 * T + 32)) = (unsigned short)f2bf((acc[T][2] + acc[T][3]) * ik);
        }
        asm volatile("" ::: "memory");
        const unsigned long long pk = *(const LAS unsigned long long*)(wl + PW_YP + 8 * lane);
        *(GAS unsigned long long*)(yrow0 + (size_t)j * D + 256 * sl + 4 * lane) = pk;
    }
}
__device__ __forceinline__ void p11_peer(Frame& F, float* dst, bool grouped) {
    const int gwv = blockIdx.x * NWAVES + F.wave, NGW = F.G * NWAVES, lane = F.lane;
    const int c_ = (int)blockIdx.x, tbase = grouped ? 256 * (8 * (c_ & 7) + ((c_ >> 3) & 7)) + 64 * (c_ >> 6) + 8 * F.wave : gwv * 4, tstep = grouped ? 4 : NGW * 4, tend = grouped ? tbase + 8 : M;
    LAS unsigned char* wl = F.lds + F.wave * PW_BYTES;
    const unsigned lbase = (unsigned)__builtin_amdgcn_readfirstlane((int)(unsigned)(size_t)wl);
    const unsigned c16e = (unsigned)(((lane & 7) ^ (lane >> 4)) * 16), c16o = (unsigned)(((lane & 7) ^ (4 + (lane >> 4))) * 16);
    const unsigned char* U8 = F.U8; const unsigned char* V8 = F.V8;
    v4u hq4[4]; float hinv4[4]; int e4[4][2]; float g4[4][2];
#define PEER_SETUP_LOADS(T0) { _Pragma("unroll") for (int j = 0; j < 4; ++j) { const int t = (T0) + j; \
            hq4[j] = *(const GAS v4u*)((const unsigned char*)F.H + (size_t)t * D + 16 * lane); hinv4[j] = *(const GAS float*)(F.rs2 + t); \
            { const GAS unsigned short* ep = (const GAS unsigned short*)F.eidx + (size_t)t * 128 + lane; const GAS unsigned short* gp = (const GAS unsigned short*)F.gw + (size_t)t * 128 + lane;        \
              e4[j][0] = ep[0]; e4[j][1] = ep[64]; g4[j][0] = __uint_as_float((unsigned)gp[0] << 16); g4[j][1] = __uint_as_float((unsigned)gp[64] << 16); } } }
    if (tbase < tend) PEER_SETUP_LOADS(tbase)
    for (int t0 = tbase; t0 < tend; t0 += tstep) {
        bf16* yrow0 = F.O + (size_t)t0 * D;
        float su4[4][2], sv4[4][2];
#pragma unroll
        for (int j = 0; j < 4; ++j)
#pragma unroll
            for (int k = 0; k < 2; ++k) { const f32x2v sc_ = *(const GAS f32x2v*)(F.su + 2 * e4[j][k]); su4[j][k] = sc_.x; sv4[j][k] = sc_.y; }
#pragma unroll
        for (int j = 0; j < 4; ++j) {
            const float hinv = hinv4[j];
            const unsigned hw[4] = {hq4[j].x, hq4[j].y, hq4[j].z, hq4[j].w};
            unsigned hh0 = 0u, hh1 = 0u, hl0 = 0u, hl1 = 0u;
#pragma unroll
            for (int i = 0; i < 16; ++i) { const int hv_ = (int)(signed char)((hw[i >> 2] >> (8 * (i & 3))) & 0xffu); const int lo = ((hv_ + 8) & 15) - 8; const int hi = (hv_ - lo) >> 4;
                if (i < 8) { hh0 |= (unsigned)(hi & 15) << (4 * i); hl0 |= (unsigned)(lo & 15) << (4 * i); } else { hh1 |= (unsigned)(hi & 15) << (4 * (i - 8)); hl1 |= (unsigned)(lo & 15) << (4 * (i - 8)); } }
            *(LAS unsigned long long*)(wl + j * 1024 + 8 * lane) = (unsigned long long)hh0 | ((unsigned long long)hh1 << 32);
            *(LAS unsigned long long*)(wl + j * 1024 + 512 + 8 * lane) = (unsigned long long)hl0 | ((unsigned long long)hl1 << 32);
            const int e0 = e4[j][0], e1 = e4[j][1];
            const f32x2v sg0 = (f32x2v){su4[j][0] * hinv, g4[j][0] * sv4[j][0]}, sg1 = (f32x2v){su4[j][1] * hinv, g4[j][1] * sv4[j][1]};
            int base = 0;
#pragma unroll
            for (int sl = 0; sl < 4; ++sl) {
                const bool m0 = (e0 >> 12) == sl, m1 = (e1 >> 12) == sl;
                const unsigned long long b0 = __ballot(m0), b1 = __ballot(m1);
                const int c0 = __popcll(b0), c1 = __popcll(b1);
                const int p0 = j * 128 + base + __builtin_amdgcn_mbcnt_hi((unsigned)(b0 >> 32), __builtin_amdgcn_mbcnt_lo((unsigned)b0, 0));
                const int p1 = j * 128 + base + c0 + __builtin_amdgcn_mbcnt_hi((unsigned)(b1 >> 32), __builtin_amdgcn_mbcnt_lo((unsigned)b1, 0));
                if (m0) { *(LAS unsigned short*)(wl + PW_E + p0 * 2) = (unsigned short)e0; *(LAS f32x2v*)(wl + PW_SG + p0 * 8) = sg0; }
                if (m1) { *(LAS unsigned short*)(wl + PW_E + p1 * 2) = (unsigned short)e1; *(LAS f32x2v*)(wl + PW_SG + p1 * 8) = sg1; }
                base += c0 + c1;
            }
        }
        asm volatile("" ::: "memory");
        {
            v4u ua[8], ub[8];
            peer_u_issue(ua, U8, wl, 0, lane);
#pragma unroll 1
            for (int it = 0; it < 32; it += 2) {
                peer_u_issue(ub, U8, wl, it + 1, lane);
                __builtin_amdgcn_sched_barrier(0);
                peer_u_compute(ua, wl, it, lane);
                __builtin_amdgcn_sched_barrier(0);
                if (it + 2 < 32) peer_u_issue(ua, U8, wl, it + 2, lane);
                __builtin_amdgcn_sched_barrier(0);
                peer_u_compute(ub, wl, it + 1, lane);
                __builtin_amdgcn_sched_barrier(0);
            }
        }
#pragma unroll
        for (int j = 0; j < 4; ++j) {
            const float w0 = *(const LAS float*)(wl + PW_BUF1 + (j * 128 + lane) * 4), w1 = *(const LAS float*)(wl + PW_BUF1 + (j * 128 + 64 + lane) * 4);
            float mx = fmaxf(fabsf(w0), fabsf(w1));
            mx = wave_max(mx);
            int ex = (int)((__float_as_uint(mx) >> 23) & 0xffu); ex = ex < 30 ? 127 : ex;
            const float sc = __uint_as_float((unsigned)(127 + 7 + 127 - ex) << 23), isc = __uint_as_float((unsigned)(ex - 7) << 23);
            const float s0 = w0 * sc, s1 = w1 * sc;
            const int ph = __builtin_amdgcn_cvt_pk_fp8_f32(s0, s1, 0, false);
            const f32x2v hb = __builtin_amdgcn_cvt_pk_f32_fp8(ph, false);
            const int pl = __builtin_amdgcn_cvt_pk_fp8_f32(s0 - hb.x, s1 - hb.y, 0, false);
            *(LAS unsigned char*)(wl + PW_WH + j * 128 + lane) = (unsigned char)(ph & 0xff); *(LAS unsigned char*)(wl + PW_WH + j * 128 + 64 + lane) = (unsigned char)((ph >> 8) & 0xff);
            *(LAS unsigned char*)(wl + PW_WL + j * 128 + lane) = (unsigned char)(pl & 0xff); *(LAS unsigned char*)(wl + PW_WL + j * 128 + 64 + lane) = (unsigned char)((pl >> 8) & 0xff);
            if (lane == 0) *(LAS float*)(wl + PW_IK + j * 4) = isc;
        }
        asm volatile("s_waitcnt lgkmcnt(0)" ::: "memory");
        {
            f32x4 acc[8];
            peer_v_issue(V8, wl, lbase, 0, lane, c16e, c16o);
#pragma unroll 1
            for (int it = 0; it < 32; it += 2) {
                peer_v_issue(V8, wl, lbase, it + 1, lane, c16e, c16o);
                asm volatile("s_waitcnt vmcnt(8)" ::: "memory");
                peer_v_compute(wl, acc, yrow0, it, lane);
                asm volatile("s_waitcnt lgkmcnt(0)" ::: "memory");
                if (it + 2 < 32) { peer_v_issue(V8, wl, lbase, it + 2, lane, c16e, c16o); asm volatile("s_waitcnt vmcnt(8)" ::: "memory"); }
                else asm volatile("s_waitcnt vmcnt(0)" ::: "memory");
                peer_v_compute(wl, acc, yrow0, it + 1, lane);
                asm volatile("s_waitcnt lgkmcnt(0)" ::: "memory");
            }
        }
        asm volatile("s_waitcnt vmcnt(0)" ::: "memory");
        {
            v4u yw[4][2]; f32x4 g2v[4];
            v4u x1w[4][2];
#pragma unroll
            for (int j = 0; j < 4; ++j) { const GAS v4u* op = (const GAS v4u*)(F.QP + (size_t)(t0 + j) * D + 16 * lane); x1w[j][0] = op[0]; x1w[j][1] = op[1]; }
#pragma unroll
            for (int j = 0; j < 4; ++j) { const GAS v4u* yp = (const GAS v4u*)(yrow0 + (size_t)j * D + 16 * lane); yw[j][0] = yp[0]; yw[j][1] = yp[1]; }
            { const int b = t0 >> 12;
              const GAS f32x4* g2p = (const GAS f32x4*)(F.mod + b * 6144 + 5120 + 16 * lane);
#pragma unroll
              for (int i = 0; i < 4; ++i) g2v[i] = g2p[i]; }
            if (t0 + tstep < tend) PEER_SETUP_LOADS(t0 + tstep)
#pragma unroll
            for (int j = 0; j < 4; ++j) {
                const int t = t0 + j;
                float yv[16]; unpack8(yw[j][0], yv); unpack8(yw[j][1], yv + 8);
                float ss = 0.f;
#pragma unroll
                for (int i = 0; i < 16; ++i) ss += yv[i] * yv[i];
                const float rstd = rsqrtf(wave_sum(ss) * (1.f / D) + EPS);
                GAS f32x4* dp = (GAS f32x4*)(dst + (size_t)t * D + 16 * lane);
                float x1f[16]; unpack8(x1w[j][0], x1f); unpack8(x1w[j][1], x1f + 8);
#pragma unroll
                for (int i = 0; i < 4; ++i) { const f32x4 x1 = (f32x4){x1f[4 * i], x1f[4 * i + 1], x1f[4 * i + 2], x1f[4 * i + 3]};
                    const f32x4 y = (f32x4){yv[4 * i], yv[4 * i + 1], yv[4 * i + 2], yv[4 * i + 3]};
                    dp[i] = x1 + g2v[i] * (y * rstd); }
            }
        }
    }
}
#undef PEER_SETUP_LOADS

__device__ __forceinline__ unsigned long long ldp(const Frame& F, int i) {
    volatile LAS unsigned* pt = (volatile LAS unsigned*)(F.lds + LDSCTL_OFF);
    const unsigned lo = pt[2 * i], hi = pt[2 * i + 1];
    return ((unsigned long long)(unsigned)__builtin_amdgcn_readfirstlane((int)hi) << 32) | (unsigned)__builtin_amdgcn_readfirstlane((int)lo);
}
__device__ __forceinline__ void load_frame(Frame& F) {
    F.lane = lane_id_fresh(); F.tid = F.wave * 64 + F.lane;
    F.x = (const float*)ldp(F, 0); F.c = (const float*)ldp(F, 1); F.ada_w = (const float*)ldp(F, 2); F.ada_b = (const float*)ldp(F, 3); F.pre_gain = (const float*)ldp(F, 4); F.post_gain = (const float*)ldp(F, 5);
    F.w_in = (const float*)ldp(F, 6); F.conv_w = (const float*)ldp(F, 7); F.group_gain = (const float*)ldp(F, 8); F.w_out = (const float*)ldp(F, 9); F.fpre_gain = (const float*)ldp(F, 10); F.fpost_gain = (const float*)ldp(F, 11);
    F.wq = (const float*)ldp(F, 12); F.keys = (const float*)ldp(F, 13); F.pu = (const float*)ldp(F, 14); F.pv = (const float*)ldp(F, 15);
    F.out = (float*)ldp(F, 16);
    unsigned char* ws = (unsigned char*)ldp(F, 17);
    F.ctl = (gu32*)(ws + WS_CTL);
    F.mod = (float*)(ws + WS_MOD); F.kmean = (float*)(ws + WS_KMEAN); F.keysb = (bf16*)(ws + WS_KEYS);
    F.WinT = (bf16*)(ws + WS_WIN); F.WoT = (bf16*)(ws + WS_WO); F.WqT = (bf16*)(ws + WS_WQ); F.eidx = (int*)(ws + WS_EIDX); F.gw = (float*)(ws + WS_G);
    F.U8 = ws + WS_U; F.V8 = ws + WS_V; F.su = (float*)(ws + WS_SU); F.sv = (float*)(ws + WS_SV); F.H = (bf16*)(ws + WS_H);
    F.P = (bf16*)(ws + WS_P); F.QP = (bf16*)(ws + WS_QP); F.O = (bf16*)(ws + WS_O); F.Y = (bf16*)(ws + WS_Y); F.scratch = (float*)(ws + WS_O); F.Win8 = ws + WS_WIN8; F.rs = (float*)(ws + WS_RS); F.Wq8 = ws + WS_WQ8; F.rs2 = (float*)(ws + WS_RS2); F.Wo8 = ws + WS_WO8;
}
struct Args { const float* in[16]; float* out; unsigned char* ws; int ph_lo, ph_hi; };
constexpr int NPHASE = 12;
template <unsigned PM> __global__ void __launch_bounds__(NWAVES * 64, 2) fwd_kernel(Args args) {
    extern __shared__ __attribute__((aligned(16))) unsigned char lds[];
    Frame F;
    F.lds = (LAS unsigned char*)lds;
    F.MISC = (volatile LAS unsigned*)(F.lds + MISC_OFF);
    F.tid = threadIdx.x; F.lane = F.tid & 63; F.wave = __builtin_amdgcn_readfirstlane(F.tid >> 6);
    F.G = gridDim.x;
    for (int u = F.tid; u < (LDS_BYTES - LDSCTL_OFF) / 4; u += NWAVES * 64) ((LAS unsigned*)(F.lds + LDSCTL_OFF))[u] = 0u;
    __syncthreads();
    if (F.tid == 0) { LAS unsigned long long* pt = (LAS unsigned long long*)(F.lds + LDSCTL_OFF);
#pragma unroll
        for (int i = 0; i < 16; ++i) pt[i] = (unsigned long long)args.in[i];
        pt[16] = (unsigned long long)args.out; pt[17] = (unsigned long long)args.ws; }
    __syncthreads();
    load_frame(F);
    const int lo = args.ph_lo, hi = args.ph_hi;
    const bool multi = (hi - lo) > 1;
    XcdBarrier bar; bar.bar = (unsigned*)(F.ctl + CW_BAR); bar.x = 0; bar.st = nullptr;
    if (multi) bar = xcd_barrier_post((unsigned*)(F.ctl + CW_BAR), F.MISC + 8);
#define IN(k) ((((PM) >> (k)) & 1u) && lo <= (k) && (k) < hi)
#define BOTH(k) (IN(k) && IN((k) + 1))
#ifndef SEAMREP
#define SEAMREP 1
#endif
#define SEAM(k) do { if (BOTH(k)) { for (int sr_ = 0; sr_ < SEAMREP; ++sr_) xcd_barrier(bar); } } while (0)
#ifndef REPMASK
#define REPMASK 0x000u
#endif
#define REPS(k) (1 + (int)(((REPMASK) >> (k)) & 1u))
    if (IN(0)) { load_frame(F); for (int r = 0; r < REPS(0); ++r) { p0_prep(F); __syncthreads(); } SEAM(0); }
    if (IN(1)) { load_frame(F); for (int r = 0; r < REPS(1); ++r) p1_hnorm(F); SEAM(1); }
    if (IN(2)) { load_frame(F);
        pg8::Gemm g{F.H, (const bf16*)F.Win8, M, NIN, D / 2}; pg8::StaticOrder So; So.init(M, NIN, F.G, (int)blockIdx.x);
        pg8::EpiBf16S<true> E{F.P, NIN, 6, 8, C2, F.kmean, 8, 10, F.rs, (const unsigned*)(F.ctl + CW_CMAX), 2, 6};
        for (int r = 0; r < REPS(2); ++r) pg8::gemm_phase<pg8::EpiBf16S<true>, pg8::StaticOrder, true, true, false, true>(F.lds, g, So, E, F.tid);
        if (IN(2) && IN(5)) { for (int sr_ = 0; sr_ < SEAMREP; ++sr_) xcd_barrier(bar); }
    }
    const bool stream_first = (((int)blockIdx.x >> 3) & 1) == 0;
    if (IN(5) && stream_first) { load_frame(F); p0_tables(F); }
    if (IN(6) && stream_first) { load_frame(F); p6_conv(F, F.G == 256); }
    if (IN(5)) { load_frame(F);
        const attn_body::AttnTensors AT{(const attn_body::bf16*)(F.P + 1536), (const attn_body::bf16*)(F.P + 2048), (const attn_body::bf16*)(F.P + 2560), (attn_body::bf16*)((unsigned char*)F.Y + 512), F.kmean, F.group_gain + 512};
        const attn_body::StaticOrder So((int)F.G, (int)blockIdx.x);
        for (int r = 0; r < REPS(5); ++r) attn_body::attn_phase<attn_body::StaticOrder>((char*)lds, AT, So, F.tid);
    }
    if (IN(6) && !stream_first) { load_frame(F); p6_conv(F, F.G == 256); }
    if (IN(5) && !stream_first) { load_frame(F); p0_tables(F); }
    if (IN(6)) { SEAM(6); }
    if (IN(7)) { load_frame(F);
        pg8::Gemm g{F.Y, (const bf16*)F.Wo8, M, D, D / 2}; pg8::StaticOrder So; So.init(M, D, F.G, (int)blockIdx.x);
        pg8::EpiBf16S<true> E{F.O, D, 0, 0, 1.f, nullptr, 0, 0, nullptr, (const unsigned*)(F.ctl + CW_CMAX3), 0, 0};
        for (int r = 0; r < REPS(7); ++r) pg8::gemm_phase<pg8::EpiBf16S<true>, pg8::StaticOrder, true, true, false, true>(F.lds, g, So, E, F.tid);
        if (BOTH(7)) { if (F.G == 256) group_barrier((unsigned*)(F.ctl + CW_GRP) + 64 * (8 * ((int)blockIdx.x & 7) + (((int)blockIdx.x >> 3) & 7)), 4u, (unsigned*)(F.ctl + CW_BAR)); else xcd_barrier(bar); }
    }
    if (IN(8)) { load_frame(F); for (int r = 0; r < REPS(8); ++r) p8_resid(F, F.G == 256);
        if (BOTH(8)) { if (F.G == 256) group_barrier((unsigned*)(F.ctl + CW_GRP) + 64 * (8 * ((int)blockIdx.x & 7) + (((int)blockIdx.x >> 3) & 7)), 8u, (unsigned*)(F.ctl + CW_BAR)); else xcd_barrier(bar); } }
    if (IN(9)) { load_frame(F);
        pg8::Gemm g{F.H, (const bf16*)F.Wq8, M, NQ, D / 2}; pg8::StaticOrder So; So.init(M, NQ, F.G, (int)blockIdx.x);
        EpiRoute E{F.keysb, F.eidx, F.gw, (const unsigned*)(F.ctl + CW_CMAX2), F.rs2};
        for (int r = 0; r < REPS(9); ++r)
            for (int i = 0; ; ++i) { OneUnit S1; if (!So.next(i, S1.u)) break; pg8::gemm_phase<EpiRoute, OneUnit, false, true, false, true>(F.lds, g, S1, E, F.tid); }
        if (IN(9) && IN(11)) { if (F.G == 256) group_barrier((unsigned*)(F.ctl + CW_GRP) + 64 * (8 * ((int)blockIdx.x & 7) + (((int)blockIdx.x >> 3) & 7)), 12u, (unsigned*)(F.ctl + CW_BAR)); else xcd_barrier(bar, true); }
    }
    if (IN(11)) { load_frame(F); if (REPS(11) > 1) p11_peer(F, F.scratch, F.G == 256); p11_peer(F, F.out, F.G == 256); }
#undef IN
#undef BOTH
#undef SEAM
}

#ifndef PMASK
#define PMASK 0xfffu
#endif
#ifndef N_LAUNCH_MODE
#define N_LAUNCH_MODE 1
#endif
template <unsigned PM> static bool set_lds() { return hipFuncSetAttribute((const void*)fwd_kernel<PM>, hipFuncAttributeMaxDynamicSharedMemorySize, LDS_BYTES) == hipSuccess; }
template <unsigned PM> static void launch1(int grid, hipStream_t stream, Args a) { hipLaunchKernelGGL(fwd_kernel<PM>, dim3(grid), dim3(NWAVES * 64), LDS_BYTES, stream, a); }
extern "C" void kernel_launch(void* const* d_in, const int* in_sizes, int n_in, void* d_out, int out_size, void* d_ws, size_t ws_size, hipStream_t stream) {
    static int grid = 0;
    if (grid == 0) {
        if (n_in != 16 || out_size != M * D || ws_size < WS_END) { fprintf(stderr, "kernel_launch: unexpected shapes n_in %d out %d ws %zu\n", n_in, out_size, ws_size); grid = -1; return; }
        int dev = 0, cus = 0;
        if (hipGetDevice(&dev) != hipSuccess || hipDeviceGetAttribute(&cus, hipDeviceAttributeMultiprocessorCount, dev) != hipSuccess) { grid = -1; return; }
        bool ok = true;
#if N_LAUNCH_MODE == 1
        ok = set_lds<PMASK>();
#elif N_LAUNCH_MODE == 3
        ok = set_lds<0x3ffu>() && set_lds<0x400u>() && set_lds<0x800u>();
#else
        ok = set_lds<1u>() && set_lds<2u>() && set_lds<4u>() && set_lds<8u>() && set_lds<16u>() && set_lds<32u>() && set_lds<64u>() && set_lds<128u>() && set_lds<256u>() && set_lds<512u>() && set_lds<1024u>() && set_lds<2048u>();
#endif
        if (!ok) { fprintf(stderr, "kernel_launch: hipFuncSetAttribute failed\n"); grid = -1; return; }
        grid = cus;
    }
    if (grid < 0) return;
    (void)hipMemsetAsync((char*)d_ws + WS_CTL, 0, CTL_ZERO_BYTES, stream);
    Args a{};
    for (int i = 0; i < 16; ++i) a.in[i] = (const float*)d_in[i];
    a.out = (float*)d_out; a.ws = (unsigned char*)d_ws;
#if N_LAUNCH_MODE == 1
    a.ph_lo = 0; a.ph_hi = NPHASE; launch1<PMASK>(grid, stream, a);
#elif N_LAUNCH_MODE == 3
    a.ph_lo = 0; a.ph_hi = 10; launch1<0x3ffu>(grid, stream, a);
    a.ph_lo = 10; a.ph_hi = 11; launch1<0x400u>(grid, stream, a);
    a.ph_lo = 11; a.ph_hi = 12; launch1<0x800u>(grid, stream, a);
#else
#define L1(p) do { a.ph_lo = (p); a.ph_hi = (p) + 1; launch1<(1u << (p))>(grid, stream, a); } while (0)
    L1(0); L1(1); L1(2); L1(3); L1(4); L1(5); L1(6); L1(7); L1(8); L1(9); L1(10); L1(11);
#undef L1
#endif
}
```
